# Optimizing an MI355X kernel written in HIP

```python
import jax
import jax.numpy as jnp
from jax import lax
import numpy as np

D_MODEL = 1024
BATCH = 8
SEQ = 4096
DEPTH = 2

MEM_LEN = 256
BRANCH_W = D_MODEL
NH_M = 4
DV_M = BRANCH_W // NH_M
DQK_M = DV_M // 2
MLSTM_CHUNK = 64
CONV_K = 4
SGU_GROUPS = 4
SGU_CHUNK = 128
D_SGU = BRANCH_W
NH_X = 4
DH_X = BRANCH_W // NH_X
N_BRANCH = 3
DFF = 256 * ((8 * D_MODEL // 3 + 255) // 256)
N_NORMS = 7
EPS = 1e-6
NEG_INIT = -1e30

W_IN_SIZES = (2 * NH_M * DQK_M, NH_M * DV_M, NH_M * DV_M, NH_M, NH_M, D_SGU, D_SGU, NH_X * DH_X, N_BRANCH * BRANCH_W)
W_IN_COLS = sum(W_IN_SIZES)

kernel_name = "hybrid_mlstm_sgu_memxattn_macaron"


def rmsnorm(x, g):
    xf = x.astype(jnp.float32)
    y = xf * lax.rsqrt(jnp.mean(xf * xf, axis=-1, keepdims=True) + EPS)
    return (y * g.astype(jnp.float32)).astype(x.dtype)


def layernorm(x, g, b=None):
    xf = x.astype(jnp.float32)
    mu = jnp.mean(xf, axis=-1, keepdims=True)
    xc = xf - mu
    y = xc * lax.rsqrt(jnp.mean(xc * xc, axis=-1, keepdims=True) + EPS) * g.astype(jnp.float32)
    if b is not None:
        y = y + b.astype(jnp.float32)
    return y.astype(x.dtype)


def swiglu(x, w_gu, w_d):
    a, b = jnp.split(x @ w_gu, 2, axis=-1)
    return (jax.nn.silu(a) * b) @ w_d


def split_cols(z):
    idx = [int(i) for i in np.cumsum(W_IN_SIZES)[:-1]]
    return jnp.split(z, idx, axis=-1)


def causal_dwconv(x, w, b):
    c = x.shape[-1]
    y = lax.conv_general_dilated(x, w[:, None, :].astype(x.dtype), window_strides=(1,),
                                 padding=[(CONV_K - 1, 0)],
                                 dimension_numbers=("NWC", "WIO", "NWC"),
                                 feature_group_count=c)
    return y + b


def mlstm_chunkwise(q, k, v, i_pre, f_pre):
    B_, S_, H, DK = q.shape
    DVv = v.shape[-1]
    NC = S_ // MLSTM_CHUNK
    f32 = jnp.float32

    def to_chunks(t):
        t = t.astype(f32).reshape((B_, NC, MLSTM_CHUNK, H) + t.shape[3:])
        return jnp.moveaxis(t, (1, 3), (0, 2))

    q_c = to_chunks(q)
    k_c = to_chunks(k) * (DK ** -0.5)
    v_c = to_chunks(v)
    i_c = to_chunks(i_pre)
    lf_c = jax.nn.log_sigmoid(to_chunks(f_pre))
    causal = jnp.tril(jnp.ones((MLSTM_CHUNK, MLSTM_CHUNK), dtype=bool))

    def step(carry, xs):
        C, n, m = carry
        qc, kc, vc, ic, fc = xs
        b = jnp.cumsum(fc, axis=-1)
        g = b[..., -1]
        log_d = jnp.where(causal, b[..., :, None] - b[..., None, :] + ic[..., None, :], -jnp.inf)
        m_inter = b + m[..., None]
        m_t = jnp.maximum(m_inter, jnp.max(log_d, axis=-1))
        d = jnp.exp(log_d - m_t[..., None])
        s = jnp.einsum("bhtd,bhsd->bhts", qc, kc) * d
        inter = jnp.exp(m_inter - m_t)
        num = jnp.einsum("bhts,bhsv->bhtv", s, vc) + inter[..., None] * jnp.einsum("bhtd,bhdv->bhtv", qc, C)
        den = jnp.sum(s, axis=-1) + inter * jnp.einsum("bhtd,bhd->bht", qc, n)
        h = num / jnp.maximum(jnp.abs(den), jnp.exp(-m_t))[..., None]
        a = g[..., None] - b + ic
        m_new = jnp.maximum(g + m, jnp.max(a, axis=-1))
        w = jnp.exp(a - m_new[..., None])
        decay = jnp.exp(g + m - m_new)
        C = decay[..., None, None] * C + jnp.einsum("bhs,bhsd,bhsv->bhdv", w, kc, vc)
        n = decay[..., None] * n + jnp.einsum("bhs,bhsd->bhd", w, kc)
        return (C, n, m_new), h

    init = (jnp.zeros((B_, H, DK, DVv), f32), jnp.zeros((B_, H, DK), f32),
            jnp.full((B_, H), NEG_INIT, f32))
    _, h = lax.scan(step, init, (q_c, k_c, v_c, i_c, lf_c))
    h = jnp.moveaxis(h, (0, 2), (1, 3)).reshape(B_, S_, H, DVv)
    return h.astype(v.dtype)


def spatial_gating(u, v, ln_g, ln_b, w_s, b_s):
    B_, S_, _ = u.shape
    nc = S_ // SGU_CHUNK
    dg = D_SGU // SGU_GROUPS
    shp = (B_, nc, SGU_CHUNK, SGU_GROUPS, dg)
    vn = layernorm(v.reshape(shp), ln_g.reshape(SGU_GROUPS, dg), ln_b.reshape(SGU_GROUPS, dg))
    w_causal = jnp.tril(w_s)
    mixed = jnp.einsum("gts,bcsgd->bctgd", w_causal, vn) + b_s.T[:, :, None]
    return (u.reshape(shp) * mixed).reshape(B_, S_, D_SGU)


def memory_cross_attention(xq, mem_n, w_mkv):
    B_, S_, _ = xq.shape
    q = xq.reshape(B_, S_, NH_X, DH_X)
    k, v = jnp.split(mem_n @ w_mkv, 2, axis=-1)
    k = k.reshape(B_, -1, NH_X, DH_X)
    v = v.reshape(B_, -1, NH_X, DH_X)
    s = jnp.einsum("bshd,bmhd->bhsm", q, k).astype(jnp.float32) * (DH_X ** -0.5)
    p = jax.nn.softmax(s, axis=-1).astype(v.dtype)
    return jnp.einsum("bhsm,bmhd->bshd", p, v).reshape(B_, S_, NH_X * DH_X)


def setup_inputs(seed: int = 0) -> dict:
    key = jax.random.key(seed)
    ks = jax.random.split(key, 18)
    nrm = jax.random.normal
    f32 = jnp.float32
    return {
        "x": nrm(ks[0], (BATCH, SEQ, D_MODEL), f32),
        "mem": nrm(ks[1], (BATCH, MEM_LEN, D_MODEL), f32),
        "norm_g": 1.0 + 0.05 * nrm(ks[2], (DEPTH, N_NORMS, D_MODEL), f32),
        "w_ffn_gu": nrm(ks[3], (DEPTH, 2, D_MODEL, 2 * DFF), f32) * D_MODEL ** -0.5,
        "w_ffn_down": nrm(ks[4], (DEPTH, 2, DFF, D_MODEL), f32) * DFF ** -0.5,
        "w_in": nrm(ks[5], (DEPTH, D_MODEL, W_IN_COLS), f32) * D_MODEL ** -0.5,
        "conv_w": nrm(ks[6], (DEPTH, CONV_K, 2 * NH_M * DQK_M), f32) * CONV_K ** -0.5,
        "conv_b": 0.02 * nrm(ks[7], (DEPTH, 2 * NH_M * DQK_M), f32),
        "b_i": 0.1 * nrm(ks[8], (DEPTH, NH_M), f32),
        "b_f": 3.0 + 0.5 * nrm(ks[9], (DEPTH, NH_M), f32),
        "mlstm_norm_g": 1.0 + 0.05 * nrm(ks[10], (DEPTH, NH_M * DV_M), f32),
        "sgu_ln_g": 1.0 + 0.05 * nrm(ks[11], (DEPTH, D_SGU), f32),
        "sgu_ln_b": 0.02 * nrm(ks[12], (DEPTH, D_SGU), f32),
        "sgu_w_s": nrm(ks[13], (DEPTH, SGU_GROUPS, SGU_CHUNK, SGU_CHUNK), f32) * SGU_CHUNK ** -0.5,
        "sgu_b_s": 1.0 + 0.1 * nrm(ks[14], (DEPTH, SGU_GROUPS, SGU_CHUNK), f32),
        "w_mkv": nrm(ks[15], (DEPTH, D_MODEL, 2 * NH_X * DH_X), f32) * D_MODEL ** -0.5,
        "w_branch": nrm(ks[16], (DEPTH, N_BRANCH, BRANCH_W, D_MODEL), f32) * BRANCH_W ** -0.5,
        "w_out": nrm(ks[17], (DEPTH, D_MODEL, D_MODEL), f32) * D_MODEL ** -0.5,
    }


def reference(x, mem, norm_g, w_ffn_gu, w_ffn_down, w_in, conv_w, conv_b, b_i, b_f,
              mlstm_norm_g, sgu_ln_g, sgu_ln_b, sgu_w_s, sgu_b_s, w_mkv, w_branch, w_out):
    h = x
    bs = x.shape[:2]
    for l in range(DEPTH):
        g = norm_g[l]
        f = swiglu(rmsnorm(h, g[0]), w_ffn_gu[l, 0], w_ffn_down[l, 0])
        h = h + 0.5 * rmsnorm(f, g[1])

        xn = rmsnorm(h, g[2])
        z = xn @ w_in[l]
        zqk, zv, zo, zi, zf, zu, zsv, zxq, zg = split_cols(z)

        qk = jax.nn.silu(causal_dwconv(zqk, conv_w[l], conv_b[l]))
        q, k = jnp.split(qk, 2, axis=-1)
        y_m = mlstm_chunkwise(q.reshape(bs + (NH_M, DQK_M)), k.reshape(bs + (NH_M, DQK_M)),
                              zv.reshape(bs + (NH_M, DV_M)), zi + b_i[l], zf + b_f[l])
        y_m = layernorm(y_m, mlstm_norm_g[l].reshape(NH_M, DV_M)).reshape(bs + (NH_M * DV_M,))
        y_m = y_m * jax.nn.sigmoid(zo)

        y_s = spatial_gating(jax.nn.gelu(zu), jax.nn.gelu(zsv), sgu_ln_g[l], sgu_ln_b[l],
                             sgu_w_s[l], sgu_b_s[l])

        y_x = memory_cross_attention(zxq, rmsnorm(mem, g[6]), w_mkv[l])

        gates = jax.nn.sigmoid(zg).reshape(bs + (N_BRANCH, D_MODEL))
        merged = (gates[..., 0, :] * (y_m @ w_branch[l, 0])
                  + gates[..., 1, :] * (y_s @ w_branch[l, 1])
                  + gates[..., 2, :] * (y_x @ w_branch[l, 2]))
        y = merged @ w_out[l]
        h = h + rmsnorm(y, g[3])

        f = swiglu(rmsnorm(h, g[4]), w_ffn_gu[l, 1], w_ffn_down[l, 1])
        h = h + 0.5 * rmsnorm(f, g[5])
    return h
```

```cpp
#include <hip/hip_runtime.h>
#include <cstdio>
#include <cstdint>

#define LAS __attribute__((address_space(3)))
#define GAS __attribute__((address_space(1)))
typedef unsigned short bf16;
typedef short bf16x8 __attribute__((ext_vector_type(8)));
typedef float f32x4 __attribute__((ext_vector_type(4)));
typedef float f32x16 __attribute__((ext_vector_type(16)));
typedef unsigned u32x4 __attribute__((ext_vector_type(4)));
typedef unsigned u32x2 __attribute__((ext_vector_type(2)));

constexpr int D = 1024, BATCH = 8, SEQ = 4096, DEPTH = 2, MEMLEN = 256, DFF = 2816, NNORM = 7;
constexpr int M = BATCH * SEQ, MH = M / 2, MMEM = BATCH * MEMLEN;
constexpr int WIN_COLS = 9224;
constexpr int LCH = 64, NCH = SEQ / LCH;
constexpr int ZLD = 7168;
constexpr int ZC_QK = 0, ZC_O = 1024, ZC_U = 2048, ZC_XQ = 3072, ZC_G = 4096;
constexpr int ZTLD = MH;
constexpr float EPS = 1e-6f;
constexpr int NWAVES = 8, NTHR = 512;

constexpr size_t MiB = 1u << 20;
constexpr size_t WS_CTL = 0, CTL_ZERO_BYTES = 1 * MiB;
constexpr size_t WS_WSGU = 1 * MiB;
constexpr size_t WS_GATE = 2 * MiB;
constexpr size_t WS_NST = 3 * MiB;
constexpr size_t WS_CSC = 4 * MiB;
constexpr size_t WS_MEMN = 5 * MiB;
constexpr size_t WS_KMEM = 9 * MiB;
constexpr size_t WS_VTMEM = 13 * MiB;
constexpr size_t WS_W = 17 * MiB;
constexpr size_t WO_GU0 = 0, WO_GU1 = 11 * MiB, WO_D0 = 22 * MiB, WO_D1 = WO_D0 + 5632 * 1024, WO_IN = 33 * MiB, WO_MKV = 51 * MiB, WO_BR = 55 * MiB, WO_OUT = 61 * MiB;
constexpr size_t WS_XN = 80 * MiB;
constexpr size_t WS_BIG = 144 * MiB;
constexpr size_t WS_HID = WS_BIG, WS_F = WS_BIG + 176 * MiB, WS_Z = WS_BIG, WS_ZT = WS_BIG + 224 * MiB;
constexpr size_t WS_ST = 432 * MiB;
constexpr size_t WS_END = 496 * MiB;

constexpr int LDS_BYTES = 147456;
constexpr int RING_BYTES = 131072;
constexpr int MISC_OFF = RING_BYTES + 320;

__device__ __forceinline__ unsigned f2bf(float f) { unsigned u = __builtin_bit_cast(unsigned, f); return (u + 0x7fffu + ((u >> 16) & 1u)) >> 16; }
__device__ __forceinline__ unsigned pk2(float lo, float hi) { return f2bf(lo) | (f2bf(hi) << 16); }
__device__ __forceinline__ float bflo(unsigned w) { return __uint_as_float(w << 16); }
__device__ __forceinline__ float bfhi(unsigned w) { return __uint_as_float(w & 0xffff0000u); }
__device__ __forceinline__ float bf1(bf16 b) { return __uint_as_float((unsigned)b << 16); }
__device__ __forceinline__ float wave_sum(float v) {
#pragma unroll
    for (int o = 1; o < 64; o <<= 1) v += __shfl_xor(v, o);
    return v;
}
__device__ __forceinline__ float sigmoidf_(float x) { return 1.f / (1.f + __expf(-x)); }
__device__ __forceinline__ float siluf_(float x) { return x / (1.f + __expf(-x)); }
__device__ __forceinline__ float gelu_tanh(float x) { const float u = 1.5957691216f * (x + 0.044715f * x * x * x); return x / (1.f + __expf(-u)); }
__device__ __forceinline__ float logsigmoidf_(float x) { return fminf(x, 0.f) - log1pf(__expf(-fabsf(x))); }
#define LDS_WAIT() asm volatile("s_waitcnt lgkmcnt(0)" ::: "memory")
#define VM_WAIT() asm volatile("s_waitcnt vmcnt(0)" ::: "memory")

namespace pg8 {
constexpr int BM = 256, BK = 64, HALF = 128, HTB = HALF * BK * 2, STAGE_BYTES = 8 * HTB, NXCD = 8, WGM = 8;
__host__ __device__ __forceinline__ int lds_byte(int r, int c) { const int st = (r >> 4) * 2 + (c >> 5), rr = r & 15, cc = c & 31, ob = rr * 64 + cc * 2; return st * 1024 + (ob ^ (((ob >> 9) & 1) << 5)); }
__host__ __device__ __forceinline__ void stage_rc(int b, int& R, int& C) { const int st = b / 1024, sb = b % 1024, swz = sb ^ (((sb >> 9) & 1) << 5); R = (st >> 1) * 16 + swz / 64; C = (st & 1) * 32 + (swz % 64) / 2; }
__host__ __device__ __forceinline__ int perm32(int rho) { const int n = rho >> 4, i = rho & 15; return 8 * (i >> 2) + 4 * n + (i & 3); }

struct Unit { int pm, pn, aux; const char* a; const char* b; };
struct Gemm { int K, lda, ldb; };

struct TileSched {
    int nM, nN, nwg, G, c, reps, pm_per_b;
    const char* A; const char* B;
    size_t a_tile, a_pn, a_rep, b_tile, b_batch, b_rep;
    __device__ __forceinline__ void init(int nM_, int nN_, int G_, int c_, const void* A_, size_t lda_bytes, const void* B_, size_t ldb_bytes) {
        nM = nM_; nN = nN_; nwg = nM * nN; G = G_; c = c_; reps = 1; pm_per_b = 1 << 30; A = (const char*)A_; B = (const char*)B_;
        a_tile = 256 * lda_bytes; a_pn = 0; a_rep = 0; b_tile = 256 * ldb_bytes; b_batch = 0; b_rep = 0;
    }
    __device__ __forceinline__ bool next(int i, Unit& u) const {
        const int ti = i / reps, aux = i - ti * reps;
        const long L = (long)ti * G + c; if (L >= nwg) return false;
        int wgid = (int)L; { const int q = nwg / NXCD, r = nwg % NXCD, xcd = wgid % NXCD, off = wgid / NXCD; wgid = (xcd < r ? xcd * (q + 1) : r * (q + 1) + (xcd - r) * q) + off; }
        const int nig = WGM * nN, gid = wgid / nig, fm = gid * WGM, gsz = (nM - fm) < WGM ? (nM - fm) : WGM;
        u.pm = fm + ((wgid % nig) % gsz); u.pn = (wgid % nig) / gsz; u.aux = aux;
        u.a = A + (size_t)u.pm * a_tile + (size_t)u.pn * a_pn + (size_t)aux * a_rep;
        u.b = B + (size_t)u.pn * b_tile + (size_t)(u.pm / pm_per_b) * b_batch + (size_t)aux * b_rep;
        return true;
    }
};

__device__ __forceinline__ unsigned cvt_pk_bf16(float lo, float hi) { unsigned r; asm volatile("v_cvt_pk_bf16_f32 %0, %1, %2" : "=v"(r) : "v"(lo), "v"(hi)); return r; }

template <int ACT> __device__ __forceinline__ float actf(float x) {
    if (ACT == 1) return sigmoidf_(x);
    if (ACT == 2) return gelu_tanh(x);
    if (ACT == 3) return x * 0.0625f;
    return x;
}
template <int ACT> __device__ __forceinline__ void store_tile_bf16(const f32x4 (&acc)[2][2][4][2], bf16* O, size_t ldc, int row0, int col0) {
#pragma unroll
    for (int ai = 0; ai < 2; ++ai)
#pragma unroll
        for (int m = 0; m < 4; ++m) { bf16* rowp = O + (size_t)(row0 + ai * HALF + m * 16) * ldc + col0;
#pragma unroll
            for (int bj = 0; bj < 2; ++bj) { const f32x4 v0 = acc[ai][bj][m][0], v1 = acc[ai][bj][m][1]; u32x4 w;
                w.x = cvt_pk_bf16(actf<ACT>(v0[0]), actf<ACT>(v0[1])); w.y = cvt_pk_bf16(actf<ACT>(v0[2]), actf<ACT>(v0[3]));
                w.z = cvt_pk_bf16(actf<ACT>(v1[0]), actf<ACT>(v1[1])); w.w = cvt_pk_bf16(actf<ACT>(v1[2]), actf<ACT>(v1[3]));
                *(u32x4*)(rowp + bj * HALF) = w; } }
}
struct EpiAct {
    static constexpr bool PERM = true;
    bf16* O; size_t ldc; int mode;
    __device__ __forceinline__ void operator()(const f32x4 (&acc)[2][2][4][2], const Unit& u, int wr, int wc, int fr, int fq) const {
        const int row0 = u.pm * BM + wr * 64 + fr, col0 = u.pn * BM + wc * 32 + 8 * fq;
        int act = 0;
        if (mode == 1) { const int g = u.pn >> 2; act = (g == 0) ? 0 : (g == 1) ? 1 : (g == 2) ? 2 : (g == 3) ? 3 : 1; }
        else if (mode == 2) act = (u.pm >= 4) ? 2 : 0;
        if (act == 0) store_tile_bf16<0>(acc, O, ldc, row0, col0);
        else if (act == 1) store_tile_bf16<1>(acc, O, ldc, row0, col0);
        else if (act == 2) store_tile_bf16<2>(acc, O, ldc, row0, col0);
        else store_tile_bf16<3>(acc, O, ldc, row0, col0);
    }
};
struct EpiGU {
    static constexpr bool PERM = true;
    bf16* O;
    __device__ __forceinline__ void operator()(const f32x4 (&acc)[2][2][4][2], const Unit& u, int wr, int wc, int fr, int fq) const {
        const int row0 = u.pm * BM + wr * 64 + fr, col0 = u.pn * HALF + wc * 32 + 8 * fq;
#pragma unroll
        for (int ai = 0; ai < 2; ++ai)
#pragma unroll
            for (int m = 0; m < 4; ++m) { bf16* rowp = O + (size_t)(row0 + ai * HALF + m * 16) * DFF + col0;
                const f32x4 g0 = acc[ai][0][m][0], g1 = acc[ai][0][m][1], u0 = acc[ai][1][m][0], u1 = acc[ai][1][m][1]; u32x4 w;
                w.x = cvt_pk_bf16(siluf_(g0[0]) * u0[0], siluf_(g0[1]) * u0[1]); w.y = cvt_pk_bf16(siluf_(g0[2]) * u0[2], siluf_(g0[3]) * u0[3]);
                w.z = cvt_pk_bf16(siluf_(g1[0]) * u1[0], siluf_(g1[1]) * u1[1]); w.w = cvt_pk_bf16(siluf_(g1[2]) * u1[2], siluf_(g1[3]) * u1[3]);
                *(u32x4*)rowp = w; }
    }
};
struct EpiBranch {
    static constexpr bool PERM = true;
    bf16* Zb;
    __device__ __forceinline__ void operator()(const f32x4 (&acc)[2][2][4][2], const Unit& u, int wr, int wc, int fr, int fq) const {
        const int row0 = u.pm * BM + wr * 64 + fr, col0 = u.pn * BM + wc * 32 + 8 * fq; const int j = u.aux;
#pragma unroll
        for (int ai = 0; ai < 2; ++ai)
#pragma unroll
            for (int m = 0; m < 4; ++m) { bf16* rowp = Zb + (size_t)(row0 + ai * HALF + m * 16) * ZLD + col0;
#pragma unroll
                for (int bj = 0; bj < 2; ++bj) { const f32x4 v0 = acc[ai][bj][m][0], v1 = acc[ai][bj][m][1];
                    const u32x4 g = *(const u32x4*)(rowp + ZC_G + j * 1024 + bj * HALF);
                    float o[8] = { v0[0] * bflo(g.x), v0[1] * bfhi(g.x), v0[2] * bflo(g.y), v0[3] * bfhi(g.y), v1[0] * bflo(g.z), v1[1] * bfhi(g.z), v1[2] * bflo(g.w), v1[3] * bfhi(g.w) };
                    if (j > 0) { const u32x4 p = *(const u32x4*)(rowp + ZC_QK + bj * HALF);
                        o[0] += bflo(p.x); o[1] += bfhi(p.x); o[2] += bflo(p.y); o[3] += bfhi(p.y); o[4] += bflo(p.z); o[5] += bfhi(p.z); o[6] += bflo(p.w); o[7] += bfhi(p.w); }
                    u32x4 w; w.x = cvt_pk_bf16(o[0], o[1]); w.y = cvt_pk_bf16(o[2], o[3]); w.z = cvt_pk_bf16(o[4], o[5]); w.w = cvt_pk_bf16(o[6], o[7]);
                    *(u32x4*)(rowp + ZC_QK + bj * HALF) = w; } }
    }
};

template <class Epi, class Sched>
__device__ __forceinline__ void gemm_phase(LAS unsigned char* lds, const Gemm g, const Sched& S, const Epi& E, const int tid) {
    const int wid = __builtin_amdgcn_readfirstlane(tid >> 6), lane = tid & 63, wr = wid >> 2, wc = wid & 3, fr = lane & 15, fq = lane >> 4;
    const int nt = g.K / BK;
    unsigned voffA[2], voffB[2];
#pragma unroll
    for (int i = 0; i < 2; ++i) { int R, C; stage_rc(tid * 16 + i * 8192, R, C); const int Rb = Epi::PERM ? ((R & ~31) + perm32(R & 31)) : R;
        voffA[i] = (unsigned)(R * g.lda + C) * 2u; voffB[i] = (unsigned)(Rb * g.ldb + C) * 2u; }
    const size_t kstep = (size_t)(BK * 2);
    const size_t hstepA = (size_t)HALF * g.lda * 2, hstepB = (size_t)HALF * g.ldb * 2;
    const unsigned ldsw = (unsigned)wid * 1024u;
    const int aoff = lds_byte(wr * 64 + fr, fq * 8), boff = lds_byte(wc * 32 + fr, fq * 8);
#define PG8_SA(b, h) (((b) * 2 + (h)) * HTB)
#define PG8_SB(b, h) ((4 + (b) * 2 + (h)) * HTB)
#define PG8_STAGE(bufoff, gbase, voff) do { _Pragma("unroll") for (int _i = 0; _i < 2; ++_i) \
        __builtin_amdgcn_global_load_lds((const unsigned*)((const char*)(gbase) + (voff)[_i]), (LAS unsigned*)(lds + (bufoff) + ldsw + _i * 8192), 16, 0, 0); } while (0)
#define PG8_LDA(dst, b, h) do { _Pragma("unroll") for (int m = 0; m < 4; ++m) _Pragma("unroll") for (int k = 0; k < 2; ++k) dst[m][k] = *(const LAS bf16x8*)(lds + PG8_SA(b, h) + aoff + m * 2048 + k * 1024); } while (0)
#define PG8_LDB(dst, b, h) do { _Pragma("unroll") for (int n = 0; n < 2; ++n) _Pragma("unroll") for (int k = 0; k < 2; ++k) dst[n][k] = *(const LAS bf16x8*)(lds + PG8_SB(b, h) + boff + n * 2048 + k * 1024); } while (0)
#define PG8_MMA(ai, bj, At, Bt) do { __builtin_amdgcn_s_setprio(1); _Pragma("unroll") for (int m = 0; m < 4; ++m) _Pragma("unroll") for (int n = 0; n < 2; ++n) _Pragma("unroll") for (int k = 0; k < 2; ++k) \
        acc[ai][bj][m][n] = __builtin_amdgcn_mfma_f32_16x16x32_bf16(Bt[n][k], At[m][k], acc[ai][bj][m][n], 0, 0, 0); __builtin_amdgcn_s_setprio(0); } while (0)
#define PG8_WAIT_V(n) asm volatile("s_waitcnt vmcnt(" #n ")" ::: "memory")
#define PG8_WAIT_L(n) asm volatile("s_waitcnt lgkmcnt(" #n ")" ::: "memory")
#define PG8_BAR __builtin_amdgcn_s_barrier()
#define PG8_SCHED __builtin_amdgcn_sched_barrier(0)
    Unit cur, nxt; int ui = 0;
    if (!S.next(0, cur)) return;
    f32x4 acc[2][2][4][2];
#pragma unroll
    for (int a = 0; a < 2; ++a)
#pragma unroll
        for (int b = 0; b < 2; ++b)
#pragma unroll
            for (int m = 0; m < 4; ++m)
#pragma unroll
                for (int n = 0; n < 2; ++n) acc[a][b][m][n] = (f32x4){0.f, 0.f, 0.f, 0.f};
    bf16x8 At[4][2], B0[2][2], B1[2][2];
    const char* cA = cur.a; const char* cB = cur.b;
    PG8_STAGE(PG8_SB(0, 0), cB, voffB); PG8_STAGE(PG8_SB(0, 1), cB + hstepB, voffB); PG8_STAGE(PG8_SA(0, 0), cA, voffA); PG8_STAGE(PG8_SA(0, 1), cA + hstepA, voffA);
    if (wr == 1) PG8_BAR;
    PG8_WAIT_V(2); PG8_BAR;
    PG8_STAGE(PG8_SB(1, 0), cB + kstep, voffB); PG8_STAGE(PG8_SA(1, 0), cA + kstep, voffA); PG8_STAGE(PG8_SB(1, 1), cB + hstepB + kstep, voffB);
    PG8_WAIT_V(6); PG8_BAR;
    for (;;) {
        const bool has_next = S.next(ui + 1, nxt);
        const char* nA = has_next ? nxt.a : cA; const char* nB = has_next ? nxt.b : cB;
        for (int t = 0; t < nt; t += 2) {
            const bool last = (t == nt - 2);
            const char* a1 = cA + (size_t)(t + 1) * kstep;
            const char* a2 = last ? nA : cA + (size_t)(t + 2) * kstep; const char* b2 = last ? nB : cB + (size_t)(t + 2) * kstep;
            const char* a3 = a2 + kstep; const char* b3 = b2 + kstep;
            PG8_LDB(B0, 0, 0); PG8_LDB(B1, 0, 1); PG8_SCHED; PG8_LDA(At, 0, 0); PG8_STAGE(PG8_SA(1, 1), a1 + hstepA, voffA);
            PG8_WAIT_V(8); PG8_WAIT_L(0); PG8_BAR; PG8_MMA(0, 0, At, B0); PG8_MMA(0, 1, At, B1); PG8_BAR; PG8_SCHED;
            PG8_LDA(At, 0, 1); PG8_STAGE(PG8_SB(0, 0), b2, voffB); PG8_STAGE(PG8_SB(0, 1), b2 + hstepB, voffB); PG8_STAGE(PG8_SA(0, 0), a2, voffA);
            PG8_WAIT_V(8); PG8_WAIT_L(0); PG8_BAR; PG8_MMA(1, 0, At, B0); PG8_MMA(1, 1, At, B1); PG8_BAR; PG8_SCHED;
            PG8_LDB(B0, 1, 0); PG8_LDB(B1, 1, 1); PG8_SCHED; PG8_LDA(At, 1, 0); PG8_STAGE(PG8_SA(0, 1), a2 + hstepA, voffA);
            PG8_WAIT_V(8); PG8_WAIT_L(0); PG8_BAR; PG8_MMA(0, 0, At, B0); PG8_MMA(0, 1, At, B1); PG8_BAR; PG8_SCHED;
            PG8_LDA(At, 1, 1); PG8_STAGE(PG8_SB(1, 0), b3, voffB); PG8_STAGE(PG8_SB(1, 1), b3 + hstepB, voffB); PG8_STAGE(PG8_SA(1, 0), a3, voffA);
            PG8_WAIT_V(8); PG8_WAIT_L(0); PG8_BAR; PG8_MMA(1, 0, At, B0); PG8_MMA(1, 1, At, B1); PG8_BAR; PG8_SCHED;
        }
        if (wr == 0) PG8_BAR;
        E(acc, cur, wr, wc, fr, fq);
        if (!has_next) break;
#pragma unroll
        for (int a = 0; a < 2; ++a)
#pragma unroll
            for (int b = 0; b < 2; ++b)
#pragma unroll
                for (int m = 0; m < 4; ++m)
#pragma unroll
                    for (int n = 0; n < 2; ++n) acc[a][b][m][n] = (f32x4){0.f, 0.f, 0.f, 0.f};
        cur = nxt; cA = nA; cB = nB; ++ui;
        if (wr == 1) PG8_BAR;
    }
    PG8_WAIT_V(0);
    PG8_BAR;
#undef PG8_SA
#undef PG8_SB
#undef PG8_STAGE
#undef PG8_LDA
#undef PG8_LDB
#undef PG8_MMA
#undef PG8_WAIT_V
#undef PG8_WAIT_L
#undef PG8_BAR
#undef PG8_SCHED
}
}

#define XB_TMO      128
#define XB_XCNT(j)  (256  + 64 * (j))
#define XB_XSUB(j)  (1280 + 64 * (j))
#define XB_XGEN(j)  (2304 + 64 * (j))
#define XB_TOP      3328
#define XB_TOPGEN   3392
#define XCD_BAR_WORDS 3456
#define XB_SPIN_CAP (1u << 18)
__device__ __forceinline__ unsigned xb_ld(unsigned* p)              { return __hip_atomic_load(p, __ATOMIC_RELAXED, __HIP_MEMORY_SCOPE_AGENT); }
__device__ __forceinline__ unsigned xb_add(unsigned* p, unsigned v) { return __hip_atomic_fetch_add(p, v, __ATOMIC_RELAXED, __HIP_MEMORY_SCOPE_AGENT); }
__device__ __forceinline__ unsigned xb_xcc_id() { return (unsigned)__builtin_amdgcn_s_getreg((3 << 11) | 20) & 0xFu; }
#define XB_SPIN(cond, bar) do { unsigned _sp = 0; while (cond) { __builtin_amdgcn_s_sleep(1); \
    if ((++_sp & 255u) == 0u) { if (xb_ld(&(bar)[XB_TMO])) break; if (_sp > XB_SPIN_CAP) { atomicAdd(&(bar)[XB_TMO], 1u); break; } } } } while (0)
struct XcdBarrier { unsigned* bar; unsigned x; volatile LAS unsigned* st; };
__device__ __forceinline__ XcdBarrier xcd_barrier_post(unsigned* bar, volatile LAS unsigned* st) {
    XcdBarrier b; b.bar = bar; b.x = xb_xcc_id(); b.st = st;
    if (threadIdx.x == 0) (void)xb_add(&bar[XB_XCNT(b.x)], 1u);
    return b;
}
__device__ __forceinline__ void xcd_barrier_complete(unsigned* bar, unsigned x, unsigned& nloc, unsigned& nx) {
    const unsigned G = gridDim.x * gridDim.y * gridDim.z;
    unsigned sum, cnt, mine, sp = 0u;
    for (;;) {
        sum = 0u; cnt = 0u; mine = 0u;
#pragma unroll
        for (unsigned j = 0; j < 16; ++j) { const unsigned c = xb_ld(&bar[XB_XCNT(j)]); sum += c; cnt += (c > 0u) ? 1u : 0u; mine = (j == x) ? c : mine; }
        if (sum == G) break;
        __builtin_amdgcn_s_sleep(1);
        if ((++sp & 255u) == 0u) { if (xb_ld(&bar[XB_TMO])) break; if (sp > XB_SPIN_CAP) { atomicAdd(&bar[XB_TMO], 1u); break; } }
    }
    nloc = mine > 0u ? mine : 1u; nx = cnt > 0u ? cnt : 1u;
}
__device__ __forceinline__ void xcd_barrier(const XcdBarrier& b) {
    asm volatile("s_waitcnt vmcnt(0)" ::: "memory");
    __syncthreads();
    if (threadIdx.x == 0) {
        unsigned* bar = b.bar;
        __builtin_amdgcn_s_waitcnt(0);
        unsigned nloc = b.st[0], nx = b.st[1];
        if (nloc == 0u) { xcd_barrier_complete(bar, b.x, nloc, nx); b.st[0] = nloc; b.st[1] = nx; }
        const unsigned old = xb_add(&bar[XB_XSUB(b.x)], 1u);
        const unsigned gen = old / nloc;
        if (old + 1u == (gen + 1u) * nloc) {
            __builtin_amdgcn_fence(__ATOMIC_RELEASE, "agent");
            asm volatile("s_waitcnt vmcnt(0)" ::: "memory");
            const unsigned og = xb_add(&bar[XB_TOP], 1u);
            const unsigned tg = og / nx;
            if (og + 1u == (tg + 1u) * nx) xb_add(&bar[XB_TOPGEN], 1u);
            else XB_SPIN(xb_ld(&bar[XB_TOPGEN]) == tg, bar);
            __builtin_amdgcn_fence(__ATOMIC_ACQUIRE, "agent");
            xb_add(&bar[XB_XGEN(b.x)], 1u);
            asm volatile("s_waitcnt vmcnt(0)" ::: "memory");
        } else {
            XB_SPIN(xb_ld(&bar[XB_XGEN(b.x)]) == gen, bar);
            __builtin_amdgcn_fence(__ATOMIC_ACQUIRE, "agent");
            asm volatile("s_waitcnt vmcnt(0)" ::: "memory");
        }
    }
    __syncthreads();
}

struct Args { const float* in[18]; float* out; unsigned char* ws; int ph_lo, ph_hi; };
enum { I_X = 0, I_MEM, I_NORMG, I_WGU, I_WDOWN, I_WIN, I_CONVW, I_CONVB, I_BI, I_BF, I_MNORM, I_SLNG, I_SLNB, I_SWS, I_SBS, I_WMKV, I_WBR, I_WOUT };

__device__ __forceinline__ void cvt_item(const float* W, int Nsrc, int K, int srccol, bf16* WT, int dstrow, int kb, LAS float* scr, int lane) {
    const int k0 = 64 * kb;
#pragma unroll 8
    for (int i = 0; i < 32; ++i) { const int kk = 2 * i + (lane >> 5); scr[kk * 33 + (lane & 31)] = W[(size_t)(k0 + kk) * Nsrc + srccol + (lane & 31)]; }
    LDS_WAIT(); asm volatile("" ::: "memory");
    const int c = lane & 7;
#pragma unroll
    for (int j = 0; j < 4; ++j) { const int n = (lane >> 3) + 8 * j; const LAS float* s = scr + (8 * c) * 33 + n;
        u32x4 o; o.x = pk2(s[0 * 33], s[1 * 33]); o.y = pk2(s[2 * 33], s[3 * 33]); o.z = pk2(s[4 * 33], s[5 * 33]); o.w = pk2(s[6 * 33], s[7 * 33]);
        *(u32x4*)(WT + (size_t)(dstrow + n) * K + k0 + 8 * c) = o; }
    LDS_WAIT(); asm volatile("" ::: "memory");
}
__device__ __forceinline__ int win_srccol(int r) {
    if (r < 1024) return r;
    if (r < 2048) return 2048 + (r - 1024);
    if (r < 3072) return 3080 + (r - 2048);
    if (r < 4096) return 5128 + (r - 3072);
    if (r < 7168) return 6152 + (r - 4096);
    if (r < 8192) return 1024 + (r - 7168);
    return 4104 + (r - 8192);
}
__device__ __forceinline__ void convert_layer(const Args& a, int l, unsigned char* ws, LAS unsigned char* lds, int gw, int NGW, int wave, int lane, int gtid, int GT) {
    LAS float* scr = (LAS float*)(lds + wave * 16384);
    bf16* Wb = (bf16*)(ws + WS_W);
    constexpr int I_GU = 16 * 176, I_DN = 44 * 32, I_IN = 16 * 288, I_MKV = 16 * 64, I_BR = 16 * 32, I_OUT = 16 * 32;
    constexpr int NITEMS = 2 * I_GU + 2 * I_DN + I_IN + I_MKV + 3 * I_BR + I_OUT;
    for (int it = gw; it < NITEMS; it += NGW) {
        int r = it;
        if (r < 2 * I_GU) { const int j = r / I_GU; r -= j * I_GU; const int kb = r / 176, nb = r % 176; const int p = nb >> 3, q = nb & 7, s = q >> 2, jj = (q & 3) * 32;
            cvt_item(a.in[I_WGU] + (size_t)(l * 2 + j) * D * 2 * DFF, 2 * DFF, D, s * DFF + 128 * p + jj, (bf16*)((char*)Wb + (j ? WO_GU1 : WO_GU0)), nb * 32, kb, scr, lane); continue; }
        r -= 2 * I_GU;
        if (r < 2 * I_DN) { const int j = r / I_DN; r -= j * I_DN; const int kb = r / 32, nb = r % 32;
            cvt_item(a.in[I_WDOWN] + (size_t)(l * 2 + j) * DFF * D, D, DFF, nb * 32, (bf16*)((char*)Wb + (j ? WO_D1 : WO_D0)), nb * 32, kb, scr, lane); continue; }
        r -= 2 * I_DN;
        if (r < I_IN) { const int kb = r / 288, nb = r % 288;
            cvt_item(a.in[I_WIN] + (size_t)l * D * WIN_COLS, WIN_COLS, D, win_srccol(nb * 32), (bf16*)((char*)Wb + WO_IN), nb * 32, kb, scr, lane); continue; }
        r -= I_IN;
        if (r < I_MKV) { const int kb = r / 64, nb = r % 64;
            cvt_item(a.in[I_WMKV] + (size_t)l * D * 2048, 2048, D, nb * 32, (bf16*)((char*)Wb + WO_MKV), nb * 32, kb, scr, lane); continue; }
        r -= I_MKV;
        if (r < 3 * I_BR) { const int j = r / I_BR; r -= j * I_BR; const int kb = r / 32, nb = r % 32;
            cvt_item(a.in[I_WBR] + (size_t)(l * 3 + j) * D * D, D, D, nb * 32, (bf16*)((char*)Wb + WO_BR) + (size_t)j * D * D, nb * 32, kb, scr, lane); continue; }
        r -= 3 * I_BR;
        { const int kb = r / 32, nb = r % 32; cvt_item(a.in[I_WOUT] + (size_t)l * D * D, D, D, nb * 32, (bf16*)((char*)Wb + WO_OUT), nb * 32, kb, scr, lane); }
    }
    bf16* wsg = (bf16*)(ws + WS_WSGU); const float* src = a.in[I_SWS] + (size_t)l * 4 * 128 * 128;
    for (int e = gtid; e < 4 * 128 * 128; e += GT) { const int t = (e >> 7) & 127, s = e & 127; wsg[e] = (bf16)f2bf(s <= t ? src[e] : 0.f); }
    const float* g6 = a.in[I_NORMG] + (size_t)(l * NNORM + 6) * D;
    for (int m = gw; m < MMEM; m += NGW) {
        const f32x4* xr = (const f32x4*)(a.in[I_MEM] + (size_t)m * D) + lane; f32x4 v[4]; float s = 0.f;
#pragma unroll
        for (int j = 0; j < 4; ++j) { v[j] = xr[64 * j]; s += (v[j].x * v[j].x + v[j].y * v[j].y) + (v[j].z * v[j].z + v[j].w * v[j].w); }
        const float rstd = rsqrtf(wave_sum(s) * (1.f / D) + EPS);
        unsigned long long* o8 = (unsigned long long*)((bf16*)(ws + WS_MEMN) + (size_t)m * D) + lane;
#pragma unroll
        for (int j = 0; j < 4; ++j) { const f32x4 gg = ((const f32x4*)g6)[lane + 64 * j];
            o8[64 * j] = (unsigned long long)pk2(v[j].x * rstd * gg.x, v[j].y * rstd * gg.y) | ((unsigned long long)pk2(v[j].z * rstd * gg.z, v[j].w * rstd * gg.w) << 32); }
    }
}

__device__ __forceinline__ void thin_rows(const bf16* fbase, size_t fld, const float* hin, float* hout, const float* ga, float scale, const float* gb, bf16* xn,
                                          int row_lo, int row_hi, int gw, int NGW, int lane, const bool do_gates, const LAS float* wif, const float* bi, const float* bfg, float* gate_i, float* gate_f) {
    for (int m = row_lo + gw; m < row_hi; m += NGW) {
        f32x4 v[4];
        if (fbase) {
            const unsigned long long* fr = (const unsigned long long*)(fbase + (size_t)(m - row_lo) * fld) + lane; float s = 0.f; f32x4 f[4];
#pragma unroll
            for (int j = 0; j < 4; ++j) { const unsigned long long w = fr[64 * j]; const unsigned lo = (unsigned)w, hi = (unsigned)(w >> 32);
                f[j] = (f32x4){bflo(lo), bfhi(lo), bflo(hi), bfhi(hi)}; s += (f[j].x * f[j].x + f[j].y * f[j].y) + (f[j].z * f[j].z + f[j].w * f[j].w); }
            const float rstd = rsqrtf(wave_sum(s) * (1.f / D) + EPS) * scale;
            const f32x4* hr = (const f32x4*)(hin + (size_t)m * D) + lane; f32x4* ho = (f32x4*)(hout + (size_t)m * D) + lane;
#pragma unroll
            for (int j = 0; j < 4; ++j) { const f32x4 gg = ((const f32x4*)ga)[lane + 64 * j]; v[j] = hr[64 * j] + f[j] * rstd * gg; ho[64 * j] = v[j]; }
        } else {
            const f32x4* hr = (const f32x4*)(hin + (size_t)m * D) + lane;
#pragma unroll
            for (int j = 0; j < 4; ++j) v[j] = hr[64 * j];
        }
        if (gb) {
            float s = 0.f;
#pragma unroll
            for (int j = 0; j < 4; ++j) s += (v[j].x * v[j].x + v[j].y * v[j].y) + (v[j].z * v[j].z + v[j].w * v[j].w);
            const float rstd = rsqrtf(wave_sum(s) * (1.f / D) + EPS);
            unsigned long long* o8 = (unsigned long long*)(xn + (size_t)m * D) + lane;
#pragma unroll
            for (int j = 0; j < 4; ++j) { const f32x4 gg = ((const f32x4*)gb)[lane + 64 * j]; v[j] = v[j] * rstd * gg;
                o8[64 * j] = (unsigned long long)pk2(v[j].x, v[j].y) | ((unsigned long long)pk2(v[j].z, v[j].w) << 32); }
            if (do_gates) {
                float acc[8];
#pragma unroll
                for (int e = 0; e < 8; ++e) acc[e] = 0.f;
#pragma unroll
                for (int j = 0; j < 4; ++j)
#pragma unroll
                    for (int q = 0; q < 4; ++q) { const int k = 4 * lane + 256 * j + q; const float xv = v[j][q]; const LAS f32x4* wp = (const LAS f32x4*)(wif + k * 8); const f32x4 w0 = wp[0], w1 = wp[1];
                        acc[0] += xv * w0.x; acc[1] += xv * w0.y; acc[2] += xv * w0.z; acc[3] += xv * w0.w; acc[4] += xv * w1.x; acc[5] += xv * w1.y; acc[6] += xv * w1.z; acc[7] += xv * w1.w; }
#pragma unroll
                for (int e = 0; e < 8; ++e) acc[e] = wave_sum(acc[e]);
                if (lane == 0) {
                    *(f32x4*)(gate_i + (size_t)m * 4) = (f32x4){acc[0] + bi[0], acc[1] + bi[1], acc[2] + bi[2], acc[3] + bi[3]};
                    *(f32x4*)(gate_f + (size_t)m * 4) = (f32x4){logsigmoidf_(acc[4] + bfg[0]), logsigmoidf_(acc[5] + bfg[1]), logsigmoidf_(acc[6] + bfg[2]), logsigmoidf_(acc[7] + bfg[3])};
                }
            }
        }
    }
}

__device__ __forceinline__ void conv8(const bf16* Zb, int bl, int p, int col, const float* cw, const float* cb, float (&o)[8]) {
    const f32x4 b0 = *(const f32x4*)(cb + col), b1 = *(const f32x4*)(cb + col + 4);
    o[0] = b0.x; o[1] = b0.y; o[2] = b0.z; o[3] = b0.w; o[4] = b1.x; o[5] = b1.y; o[6] = b1.z; o[7] = b1.w;
#pragma unroll
    for (int j = 0; j < 4; ++j) { const int pp = p - 3 + j;
        if (pp >= 0) { const u32x4 x = *(const u32x4*)(Zb + (size_t)(bl * SEQ + pp) * ZLD + ZC_QK + col);
            const f32x4 w0 = *(const f32x4*)(cw + j * 1024 + col), w1 = *(const f32x4*)(cw + j * 1024 + col + 4);
            o[0] += w0.x * bflo(x.x); o[1] += w0.y * bfhi(x.x); o[2] += w0.z * bflo(x.y); o[3] += w0.w * bfhi(x.y);
            o[4] += w1.x * bflo(x.z); o[5] += w1.y * bfhi(x.z); o[6] += w1.z * bflo(x.w); o[7] += w1.w * bfhi(x.w); } }
#pragma unroll
    for (int e = 0; e < 8; ++e) o[e] = siluf_(o[e]);
}
__device__ __forceinline__ float wave_incl_scan_add(float v, int lane) {
#pragma unroll
    for (int o = 1; o < 64; o <<= 1) { const float t = __shfl_up(v, o); if (lane >= o) v += t; }
    return v;
}
__device__ __forceinline__ float wave_incl_scan_max(float v, int lane) {
#pragma unroll
    for (int o = 1; o < 64; o <<= 1) { const float t = __shfl_up(v, o); if (lane >= o) v = fmaxf(v, t); }
    return v;
}
__device__ __forceinline__ float wave_max(float v) {
#pragma unroll
    for (int o = 1; o < 64; o <<= 1) v = fmaxf(v, __shfl_xor(v, o));
    return v;
}
constexpr float KSCALE = 0.08838834764831845f;

__device__ __forceinline__ void mlstm_s1(const Args& a, int l, int hf, unsigned char* ws, LAS unsigned char* lds, int G, int cu, int tid, int wave, int lane) {
    const bf16* Zb = (const bf16*)(ws + WS_Z); const bf16* ZT = (const bf16*)(ws + WS_ZT);
    const float* gi = (const float*)(ws + WS_GATE); const float* gf = gi + (size_t)M * 4;
    const float* cw = a.in[I_CONVW] + (size_t)l * 4 * 1024; const float* cb = a.in[I_CONVB] + (size_t)l * 1024;
    LAS bf16* KT = (LAS bf16*)lds;
    LAS float* wv = (LAS float*)(lds + 18432);
    for (int u = cu; u < 16 * NCH; u += G) {
        const int bhl = u >> 6, c = u & 63, bl = bhl >> 2, h = bhl & 3; const int tokg = (hf * 4 + bl) * SEQ + c * LCH;
        if (wave == 0) {
            const float lf = gf[(size_t)(tokg + lane) * 4 + h], ii = gi[(size_t)(tokg + lane) * 4 + h];
            const float bc = wave_incl_scan_add(lf, lane); const float g = __shfl(bc, 63);
            const float av = g - bc + ii; const float ml = wave_max(av);
            wv[lane] = __expf(av - ml);
            if (lane == 0) { float* cs = (float*)(ws + WS_CSC) + (size_t)(bhl * NCH + c) * 4; cs[0] = g; cs[1] = ml; }
        }
        __syncthreads();
#pragma unroll
        for (int rep = 0; rep < 2; ++rep) { const int idx = tid + rep * NTHR, s = idx >> 4, c8 = idx & 15; float o[8];
            conv8(Zb, bl, c * LCH + s, 512 + h * 128 + c8 * 8, cw, cb, o); const float sc = wv[s] * KSCALE;
#pragma unroll
            for (int e = 0; e < 8; ++e) KT[(c8 * 8 + e) * 72 + s] = (bf16)f2bf(o[e] * sc); }
        __syncthreads();
        if (tid < 128) { float s = 0.f;
#pragma unroll 8
            for (int k = 0; k < 64; ++k) s += bf1(KT[tid * 72 + k]);
            ((float*)(ws + WS_NST))[(size_t)(bhl * NCH + c) * 128 + tid] = s; }
        {
            const int r = lane & 31, hh = lane >> 5, v0 = 32 * wave;
            const bf16* vrow = ZT + (size_t)(h * 256 + v0 + r) * ZTLD + bl * SEQ + c * LCH + 8 * hh;
            bf16x8 bfr[4];
#pragma unroll
            for (int ks = 0; ks < 4; ++ks) bfr[ks] = *(const bf16x8*)(vrow + 16 * ks);
            bf16* st = (bf16*)(ws + WS_ST) + (size_t)(bhl * NCH + c) * 32768 + (size_t)(v0 + r) * 128;
#pragma unroll
            for (int db = 0; db < 4; ++db) { f32x16 acc;
#pragma unroll
                for (int e = 0; e < 16; ++e) acc[e] = 0.f;
#pragma unroll
                for (int ks = 0; ks < 4; ++ks) { const bf16x8 af = *(const LAS bf16x8*)(KT + (32 * db + r) * 72 + 16 * ks + 8 * hh); acc = __builtin_amdgcn_mfma_f32_32x32x16_bf16(af, bfr[ks], acc, 0, 0, 0); }
#pragma unroll
                for (int q = 0; q < 4; ++q) { u32x2 w; w.x = pk2(acc[4 * q], acc[4 * q + 1]); w.y = pk2(acc[4 * q + 2], acc[4 * q + 3]); *(u32x2*)(st + 32 * db + 8 * q + 4 * hh) = w; } }
        }
        __syncthreads();
    }
}
__device__ __forceinline__ void mlstm_s2(unsigned char* ws, int G, int cu, int tid) {
    for (int u = cu; u < 128; u += G) {
        const int bhl = u >> 3, part = u & 7; const size_t off = (size_t)(part * NTHR + tid) * 8;
        bf16* st = (bf16*)(ws + WS_ST) + (size_t)bhl * NCH * 32768 + off; float* ns = (float*)(ws + WS_NST) + (size_t)bhl * NCH * 128 + tid; float* cs = (float*)(ws + WS_CSC) + (size_t)bhl * NCH * 4;
        const bool nth = (part == 0 && tid < 128);
        float C[8]; float nv = 0.f, m = -1e30f;
#pragma unroll
        for (int e = 0; e < 8; ++e) C[e] = 0.f;
        for (int c0 = 0; c0 < NCH; c0 += 4) {
            u32x4 cl[4]; float nl[4], gg[4], ml[4];
#pragma unroll
            for (int i = 0; i < 4; ++i) { cl[i] = *(const u32x4*)(st + (size_t)(c0 + i) * 32768); nl[i] = nth ? ns[(c0 + i) * 128] : 0.f; gg[i] = cs[(c0 + i) * 4]; ml[i] = cs[(c0 + i) * 4 + 1]; }
#pragma unroll
            for (int i = 0; i < 4; ++i) {
                u32x4 o; o.x = pk2(C[0], C[1]); o.y = pk2(C[2], C[3]); o.z = pk2(C[4], C[5]); o.w = pk2(C[6], C[7]);
                *(u32x4*)(st + (size_t)(c0 + i) * 32768) = o;
                if (nth) ns[(c0 + i) * 128] = nv;
                if (part == 0 && tid == 0) cs[(c0 + i) * 4 + 2] = m;
                const float mn = fmaxf(gg[i] + m, ml[i]); const float dec = __expf(gg[i] + m - mn), sc = __expf(ml[i] - mn);
                C[0] = dec * C[0] + sc * bflo(cl[i].x); C[1] = dec * C[1] + sc * bfhi(cl[i].x); C[2] = dec * C[2] + sc * bflo(cl[i].y); C[3] = dec * C[3] + sc * bfhi(cl[i].y);
                C[4] = dec * C[4] + sc * bflo(cl[i].z); C[5] = dec * C[5] + sc * bfhi(cl[i].z); C[6] = dec * C[6] + sc * bflo(cl[i].w); C[7] = dec * C[7] + sc * bfhi(cl[i].w);
                nv = dec * nv + sc * nl[i]; m = mn;
            }
        }
    }
}
__device__ __forceinline__ void mlstm_s3(const Args& a, int l, int hf, unsigned char* ws, LAS unsigned char* lds, int G, int cu, int tid, int wave, int lane) {
    bf16* Zb = (bf16*)(ws + WS_Z); const bf16* ZT = (const bf16*)(ws + WS_ZT);
    const float* gi = (const float*)(ws + WS_GATE); const float* gf = gi + (size_t)M * 4;
    const float* cw = a.in[I_CONVW] + (size_t)l * 4 * 1024; const float* cb = a.in[I_CONVB] + (size_t)l * 1024;
    const float* gain = a.in[I_MNORM] + (size_t)l * 1024;
    LAS bf16* QS = (LAS bf16*)lds;
    LAS bf16* KS = (LAS bf16*)(lds + 17408);
    LAS bf16* SD = (LAS bf16*)(lds + 34816);
    LAS float* HB = (LAS float*)(lds + 44032);
    LAS float* SC = (LAS float*)(lds + 110592);
    for (int u = cu; u < 16 * NCH; u += G) {
        const int bhl = u >> 6, c = u & 63, bl = bhl >> 2, h = bhl & 3; const int tokg = (hf * 4 + bl) * SEQ + c * LCH; const int tokl = bl * SEQ + c * LCH;
        if (wave == 0) {
            const float lf = gf[(size_t)(tokg + lane) * 4 + h], ii = gi[(size_t)(tokg + lane) * 4 + h];
            const float bc = wave_incl_scan_add(lf, lane); const float rr = ii - bc; const float cm = wave_incl_scan_max(rr, lane);
            const float mst = ((const float*)(ws + WS_CSC))[(size_t)(bhl * NCH + c) * 4 + 2];
            const float Mt = fmaxf(mst, cm);
            SC[lane] = rr; SC[64 + lane] = Mt; SC[128 + lane] = __expf(mst - Mt); SC[192 + lane] = __expf(-(bc + Mt));
        } else if (wave == 1 || wave == 2) { const int d = (wave - 1) * 64 + lane; SC[320 + d] = ((const float*)(ws + WS_NST))[(size_t)(bhl * NCH + c) * 128 + d]; }
#pragma unroll
        for (int rep = 0; rep < 4; ++rep) { const int idx = tid + (rep & 1) * NTHR, t = idx >> 4, c8 = idx & 15; const bool isk = rep >= 2; float o[8];
            conv8(Zb, bl, c * LCH + t, (isk ? 512 : 0) + h * 128 + c8 * 8, cw, cb, o); const float sc = isk ? KSCALE : 1.f;
            u32x4 w; w.x = pk2(o[0] * sc, o[1] * sc); w.y = pk2(o[2] * sc, o[3] * sc); w.z = pk2(o[4] * sc, o[5] * sc); w.w = pk2(o[6] * sc, o[7] * sc);
            *(LAS u32x4*)((isk ? KS : QS) + t * 136 + c8 * 8) = w; }
        __syncthreads();
        {
            const int tb = wave >> 1, fr = lane & 15, fq = lane >> 4;
#pragma unroll
            for (int i = 0; i < 2; ++i) { const int sblk = (wave & 1) * 2 + i; f32x4 acc = (f32x4){0.f, 0.f, 0.f, 0.f};
                if (sblk <= tb) {
#pragma unroll
                    for (int ks = 0; ks < 4; ++ks) { const bf16x8 af = *(const LAS bf16x8*)(QS + (16 * tb + fr) * 136 + 32 * ks + 8 * fq), bfv = *(const LAS bf16x8*)(KS + (16 * sblk + fr) * 136 + 32 * ks + 8 * fq);
                        acc = __builtin_amdgcn_mfma_f32_16x16x32_bf16(af, bfv, acc, 0, 0, 0); } }
                const int s = 16 * sblk + fr; const float rs_ = SC[s];
#pragma unroll
                for (int e = 0; e < 4; ++e) { const int t = 16 * tb + 4 * fq + e; const float val = (s <= t) ? acc[e] * __expf(rs_ - SC[64 + t]) : 0.f; SD[t * 72 + s] = (bf16)f2bf(val); } }
        }
        __syncthreads();
#pragma unroll
        for (int rep = 0; rep < 2; ++rep) { const int idx = tid + rep * NTHR, t = idx >> 4, c8 = idx & 15; const float it = SC[128 + t];
            u32x4 x = *(const LAS u32x4*)(QS + t * 136 + c8 * 8);
            x.x = pk2(bflo(x.x) * it, bfhi(x.x) * it); x.y = pk2(bflo(x.y) * it, bfhi(x.y) * it); x.z = pk2(bflo(x.z) * it, bfhi(x.z) * it); x.w = pk2(bflo(x.w) * it, bfhi(x.w) * it);
            *(LAS u32x4*)(QS + t * 136 + c8 * 8) = x; }
        __syncthreads();
        if (wave == 0) { const int t = lane; float den = 0.f;
#pragma unroll 8
            for (int s = 0; s < 64; ++s) den += bf1(SD[t * 72 + s]);
#pragma unroll 8
            for (int d = 0; d < 128; ++d) den += bf1(QS[t * 136 + d]) * SC[320 + d];
            SC[256 + t] = 1.f / fmaxf(fabsf(den), SC[192 + t]); }
        f32x16 acc0, acc1;
        const int r = lane & 31, hh = lane >> 5, v0 = 32 * wave;
        {
#pragma unroll
            for (int e = 0; e < 16; ++e) { acc0[e] = 0.f; acc1[e] = 0.f; }
            const bf16* vrow = ZT + (size_t)(h * 256 + v0 + r) * ZTLD + tokl + 8 * hh;
            const bf16* crow = (const bf16*)(ws + WS_ST) + (size_t)(bhl * NCH + c) * 32768 + (size_t)(v0 + r) * 128 + 8 * hh;
#pragma unroll
            for (int ks = 0; ks < 12; ++ks) {
                const bf16x8 bfv = (ks < 4) ? *(const bf16x8*)(vrow + 16 * ks) : *(const bf16x8*)(crow + 16 * (ks - 4));
                const bf16x8 a0 = (ks < 4) ? *(const LAS bf16x8*)(SD + r * 72 + 16 * ks + 8 * hh) : *(const LAS bf16x8*)(QS + r * 136 + 16 * (ks - 4) + 8 * hh);
                const bf16x8 a1 = (ks < 4) ? *(const LAS bf16x8*)(SD + (32 + r) * 72 + 16 * ks + 8 * hh) : *(const LAS bf16x8*)(QS + (32 + r) * 136 + 16 * (ks - 4) + 8 * hh);
                acc0 = __builtin_amdgcn_mfma_f32_32x32x16_bf16(a0, bfv, acc0, 0, 0, 0); acc1 = __builtin_amdgcn_mfma_f32_32x32x16_bf16(a1, bfv, acc1, 0, 0, 0); }
        }
        __syncthreads();
#pragma unroll
        for (int e = 0; e < 16; ++e) { const int t0 = (e & 3) + 8 * (e >> 2) + 4 * hh; HB[t0 * 260 + v0 + r] = acc0[e] * SC[256 + t0]; HB[(32 + t0) * 260 + v0 + r] = acc1[e] * SC[256 + 32 + t0]; }
        __syncthreads();
#pragma unroll
        for (int i = 0; i < 8; ++i) { const int t = 8 * wave + i; const f32x4 x = *(const LAS f32x4*)(HB + t * 260 + 4 * lane);
            const float mean = wave_sum((x.x + x.y) + (x.z + x.w)) * (1.f / 256.f); const f32x4 dx = x - mean;
            const float var = wave_sum((dx.x * dx.x + dx.y * dx.y) + (dx.z * dx.z + dx.w * dx.w)) * (1.f / 256.f); const float rstd = rsqrtf(var + EPS);
            const f32x4 gg = *(const f32x4*)(gain + h * 256 + 4 * lane);
            u32x2* op = (u32x2*)(Zb + (size_t)(tokl + t) * ZLD + ZC_O + h * 256 + 4 * lane); const u32x2 og = *op;
            u32x2 w; w.x = pk2(dx.x * rstd * gg.x * bflo(og.x), dx.y * rstd * gg.y * bfhi(og.x)); w.y = pk2(dx.z * rstd * gg.z * bflo(og.y), dx.w * rstd * gg.w * bfhi(og.y)); *op = w; }
        __syncthreads();
    }
}

__device__ __forceinline__ void sgu_phase(const Args& a, int l, unsigned char* ws, LAS unsigned char* lds, int G, int cu, int tid, int wave, int lane) {
    bf16* Zb = (bf16*)(ws + WS_Z); const bf16* ZT = (const bf16*)(ws + WS_ZT); const bf16* Wc = (const bf16*)(ws + WS_WSGU);
    const float* lng = a.in[I_SLNG] + (size_t)l * 1024; const float* lnb = a.in[I_SLNB] + (size_t)l * 1024; const float* bs = a.in[I_SBS] + (size_t)l * 4 * 128;
    LAS bf16* VT = (LAS bf16*)lds;
    LAS float* PS = (LAS float*)(lds + 69632);
    LAS float* ST = (LAS float*)(lds + 69632 + 4096);
    for (int u = cu; u < 4 * 32 * 4; u += G) {
        const int g = u & 3, cc = (u >> 2) & 31, bl = u >> 7; const int tokl = bl * SEQ + cc * 128;
#pragma unroll
        for (int rep = 0; rep < 8; ++rep) { const int idx = tid + rep * NTHR, d = idx >> 4, c8 = idx & 15;
            *(LAS u32x4*)(VT + d * 136 + c8 * 8) = *(const u32x4*)(ZT + (size_t)(1024 + g * 256 + d) * ZTLD + tokl + c8 * 8); }
        __syncthreads();
        { const int s = tid & 127, part = tid >> 7; float sm = 0.f, sq = 0.f;
#pragma unroll 8
            for (int d = part * 64; d < part * 64 + 64; ++d) { const float x = bf1(VT[d * 136 + s]); sm += x; sq += x * x; }
            PS[(part * 128 + s) * 2] = sm; PS[(part * 128 + s) * 2 + 1] = sq; }
        __syncthreads();
        if (tid < 128) { float sm = 0.f, sq = 0.f;
#pragma unroll
            for (int p = 0; p < 4; ++p) { sm += PS[(p * 128 + tid) * 2]; sq += PS[(p * 128 + tid) * 2 + 1]; }
            const float mean = sm * (1.f / 256.f); const float var = fmaxf(sq * (1.f / 256.f) - mean * mean, 0.f); ST[tid] = mean; ST[128 + tid] = rsqrtf(var + EPS); }
        __syncthreads();
#pragma unroll
        for (int rep = 0; rep < 8; ++rep) { const int idx = tid + rep * NTHR, d = idx >> 4, c8 = idx & 15; const float gg = lng[g * 256 + d], bb = lnb[g * 256 + d];
            u32x4 x = *(const LAS u32x4*)(VT + d * 136 + c8 * 8); const LAS float* mp = ST + c8 * 8; const LAS float* rp = ST + 128 + c8 * 8;
            x.x = pk2((bflo(x.x) - mp[0]) * rp[0] * gg + bb, (bfhi(x.x) - mp[1]) * rp[1] * gg + bb); x.y = pk2((bflo(x.y) - mp[2]) * rp[2] * gg + bb, (bfhi(x.y) - mp[3]) * rp[3] * gg + bb);
            x.z = pk2((bflo(x.z) - mp[4]) * rp[4] * gg + bb, (bfhi(x.z) - mp[5]) * rp[5] * gg + bb); x.w = pk2((bflo(x.w) - mp[6]) * rp[6] * gg + bb, (bfhi(x.w) - mp[7]) * rp[7] * gg + bb);
            *(LAS u32x4*)(VT + d * 136 + c8 * 8) = x; }
        __syncthreads();
        {
            const int r = lane & 31, hh = lane >> 5, d0 = 32 * wave;
            f32x16 acc[4];
#pragma unroll
            for (int tb = 0; tb < 4; ++tb)
#pragma unroll
                for (int e = 0; e < 16; ++e) acc[tb][e] = 0.f;
#pragma unroll
            for (int ks = 0; ks < 8; ++ks) { const bf16x8 af = *(const LAS bf16x8*)(VT + (d0 + r) * 136 + 16 * ks + 8 * hh);
#pragma unroll
                for (int tb = 0; tb < 4; ++tb) if (16 * ks <= 32 * tb + 31) { const bf16x8 bfv = *(const bf16x8*)(Wc + (size_t)(g * 128 + 32 * tb + r) * 128 + 16 * ks + 8 * hh);
                    acc[tb] = __builtin_amdgcn_mfma_f32_32x32x16_bf16(af, bfv, acc[tb], 0, 0, 0); } }
#pragma unroll
            for (int tb = 0; tb < 4; ++tb) { const int t = 32 * tb + r; const float bias = bs[g * 128 + t]; bf16* rowp = Zb + (size_t)(tokl + t) * ZLD + ZC_U + g * 256 + d0 + 4 * hh;
#pragma unroll
                for (int q = 0; q < 4; ++q) { u32x2* op = (u32x2*)(rowp + 8 * q); const u32x2 uu = *op; u32x2 w;
                    w.x = pk2(bflo(uu.x) * (acc[tb][4 * q] + bias), bfhi(uu.x) * (acc[tb][4 * q + 1] + bias)); w.y = pk2(bflo(uu.y) * (acc[tb][4 * q + 2] + bias), bfhi(uu.y) * (acc[tb][4 * q + 3] + bias)); *op = w; } }
        }
        __syncthreads();
    }
}

__device__ __forceinline__ void softmax_rows(unsigned char* ws, int gw, int NGW, int lane) {
    bf16* Zb = (bf16*)(ws + WS_Z);
    for (int m = gw; m < MH; m += NGW) {
        u32x4* p = (u32x4*)(Zb + (size_t)m * ZLD + ZC_XQ + 16 * lane); const u32x4 x0 = p[0], x1 = p[1];
        float v[16] = { bflo(x0.x), bfhi(x0.x), bflo(x0.y), bfhi(x0.y), bflo(x0.z), bfhi(x0.z), bflo(x0.w), bfhi(x0.w), bflo(x1.x), bfhi(x1.x), bflo(x1.y), bfhi(x1.y), bflo(x1.z), bfhi(x1.z), bflo(x1.w), bfhi(x1.w) };
        float mx = v[0];
#pragma unroll
        for (int e = 1; e < 16; ++e) mx = fmaxf(mx, v[e]);
#pragma unroll
        for (int o = 1; o < 16; o <<= 1) mx = fmaxf(mx, __shfl_xor(mx, o));
        float s = 0.f;
#pragma unroll
        for (int e = 0; e < 16; ++e) { v[e] = __expf(v[e] - mx); s += v[e]; }
#pragma unroll
        for (int o = 1; o < 16; o <<= 1) s += __shfl_xor(s, o);
        const float inv = 1.f / s;
        u32x4 y0, y1; y0.x = pk2(v[0] * inv, v[1] * inv); y0.y = pk2(v[2] * inv, v[3] * inv); y0.z = pk2(v[4] * inv, v[5] * inv); y0.w = pk2(v[6] * inv, v[7] * inv);
        y1.x = pk2(v[8] * inv, v[9] * inv); y1.y = pk2(v[10] * inv, v[11] * inv); y1.z = pk2(v[12] * inv, v[13] * inv); y1.w = pk2(v[14] * inv, v[15] * inv);
        p[0] = y0; p[1] = y1;
    }
}

__global__ void __launch_bounds__(NTHR, 2) trunk_fwd(Args args) {
    extern __shared__ __attribute__((aligned(16))) unsigned char lds_raw[];
    LAS unsigned char* lds = (LAS unsigned char*)lds_raw;
    volatile LAS unsigned* MISC = (volatile LAS unsigned*)(lds + MISC_OFF);
    const int G = gridDim.x, cu = blockIdx.x;
    unsigned char* ws = args.ws;
#define PHASE_IDS() int tid = threadIdx.x; asm volatile("" : "+v"(tid)); const int lane = tid & 63, wave = __builtin_amdgcn_readfirstlane(tid >> 6); \
    const int vcu = (G % 8 == 0) ? (cu % 8) * (G / 8) + cu / 8 : cu; const int gw = vcu * NWAVES + wave, NGW = G * NWAVES, gtid = cu * NTHR + tid, GT = G * NTHR; (void)gw; (void)NGW; (void)gtid; (void)GT; (void)lane
    for (int u = threadIdx.x; u < (LDS_BYTES - RING_BYTES) / 4; u += NTHR) ((LAS unsigned*)(lds + RING_BYTES))[u] = 0u;
    __syncthreads();
    XcdBarrier bar = xcd_barrier_post((unsigned*)(ws + WS_CTL) + 4096, MISC + 8);
    const int lo = args.ph_lo, hi = args.ph_hi;
    int ph = 0;
#define IN() (lo <= ph && ph < hi)
#define SEAM() do { if (lo <= ph && ph + 1 < hi) xcd_barrier(bar); ++ph; } while (0)
    bf16* XN = (bf16*)(ws + WS_XN); bf16* Wb = (bf16*)(ws + WS_W);
    float* hbuf = args.out;

    if (IN()) { PHASE_IDS();
        convert_layer(args, 0, ws, lds, gw, NGW, wave, lane, gtid, GT);
        thin_rows(nullptr, 0, args.in[I_X], nullptr, nullptr, 0.f, args.in[I_NORMG], XN, 0, M, gw, NGW, lane, false, nullptr, nullptr, nullptr, nullptr, nullptr);
        __syncthreads();
    }
    SEAM();

    for (int sb = 0; sb < 2 * DEPTH; ++sb) {
        const int l = sb >> 1, j = sb & 1;
        const float* ng = args.in[I_NORMG] + (size_t)l * NNORM * D;
        if (IN()) { PHASE_IDS();
            pg8::Gemm g{D, D, D}; pg8::TileSched S; S.init(M / 256, 2 * DFF / 256, G, cu, XN, D * 2, (char*)Wb + (j ? WO_GU1 : WO_GU0), D * 2);
            pg8::EpiGU E{(bf16*)(ws + WS_HID)};
            pg8::gemm_phase(lds, g, S, E, tid);
        }
        SEAM();
        if (IN()) { PHASE_IDS();
            pg8::Gemm g{DFF, DFF, DFF}; pg8::TileSched S; S.init(M / 256, D / 256, G, cu, ws + WS_HID, DFF * 2, (char*)Wb + (j ? WO_D1 : WO_D0), DFF * 2);
            pg8::EpiAct E{(bf16*)(ws + WS_F), (size_t)D, 0};
            pg8::gemm_phase(lds, g, S, E, tid);
        }
        SEAM();
        if (IN()) { PHASE_IDS();
            const float* hin = (sb == 0) ? args.in[I_X] : hbuf;
            if (j == 0) {
                LAS float* wif = (LAS float*)lds;
                const float* win = args.in[I_WIN] + (size_t)l * D * WIN_COLS;
                for (int e = tid; e < D * 8; e += NTHR) wif[e] = win[(size_t)(e >> 3) * WIN_COLS + 3072 + (e & 7)];
                __syncthreads();
                float* gi = (float*)(ws + WS_GATE);
                thin_rows((const bf16*)(ws + WS_F), D, hin, hbuf, ng + 1 * D, 0.5f, ng + 2 * D, XN, 0, M, gw, NGW, lane, true, wif, args.in[I_BI] + l * 4, args.in[I_BF] + l * 4, gi, gi + (size_t)M * 4);
                __syncthreads();
                {
                    pg8::Gemm g{D, D, D};
                    pg8::TileSched S; S.init(MMEM / 256, D / 256, G, cu, ws + WS_MEMN, D * 2, (char*)Wb + WO_MKV, D * 2);
                    pg8::EpiAct E{(bf16*)(ws + WS_KMEM), (size_t)D, 0};
                    pg8::gemm_phase(lds, g, S, E, tid);
                    pg8::TileSched S2; S2.init(D / 256, MMEM / 256, G, (cu + G / 2) % G, (char*)Wb + WO_MKV + (size_t)D * D * 2, D * 2, ws + WS_MEMN, D * 2);
                    pg8::EpiAct E2{(bf16*)(ws + WS_VTMEM), (size_t)MMEM, 0};
                    pg8::gemm_phase(lds, g, S2, E2, tid);
                }
            } else {
                const float* gnext = (l + 1 < DEPTH) ? args.in[I_NORMG] + (size_t)(l + 1) * NNORM * D : nullptr;
                thin_rows((const bf16*)(ws + WS_F), D, hin, hbuf, ng + 5 * D, 0.5f, gnext, XN, 0, M, gw, NGW, lane, false, nullptr, nullptr, nullptr, nullptr, nullptr);
                if (l + 1 < DEPTH) { __syncthreads(); convert_layer(args, l + 1, ws, lds, gw, NGW, wave, lane, gtid, GT); __syncthreads(); }
            }
        }
        SEAM();
        if (j == 0) {
            for (int hf = 0; hf < 2; ++hf) {
                bf16* Zb = (bf16*)(ws + WS_Z);
                if (IN()) { PHASE_IDS();
                    pg8::Gemm g{D, D, D};
                    pg8::TileSched S; S.init(MH / 256, ZLD / 256, G, cu, XN + (size_t)hf * MH * D, D * 2, (char*)Wb + WO_IN, D * 2);
                    pg8::EpiAct E{Zb, (size_t)ZLD, 1};
                    pg8::gemm_phase(lds, g, S, E, tid);
                    pg8::TileSched S2; S2.init(2048 / 256, MH / 256, G, cu, (char*)Wb + WO_IN + (size_t)ZLD * D * 2, D * 2, XN + (size_t)hf * MH * D, D * 2);
                    pg8::EpiAct E2{(bf16*)(ws + WS_ZT), (size_t)ZTLD, 2};
                    pg8::gemm_phase(lds, g, S2, E2, tid);
                }
                SEAM();
                if (IN()) { PHASE_IDS();
                    mlstm_s1(args, l, hf, ws, lds, G, cu, tid, wave, lane);
                    sgu_phase(args, l, ws, lds, G, cu, tid, wave, lane);
                    pg8::Gemm g{256, ZLD, D};
                    pg8::TileSched S; S.init(MH / 256, 4, G, cu, Zb + ZC_XQ, ZLD * 2, (bf16*)(ws + WS_KMEM) + (size_t)hf * 4 * MEMLEN * D, 0);
                    S.a_pn = 512; S.b_tile = 512; S.pm_per_b = 16; S.b_batch = (size_t)MEMLEN * D * 2;
                    pg8::EpiAct E{Zb + ZC_XQ, (size_t)ZLD, 0};
                    pg8::gemm_phase(lds, g, S, E, tid);
                }
                SEAM();
                if (IN()) { PHASE_IDS();
                    mlstm_s2(ws, G, cu, tid);
                    softmax_rows(ws, gw, NGW, lane);
                }
                SEAM();
                if (IN()) { PHASE_IDS();
                    mlstm_s3(args, l, hf, ws, lds, G, cu, tid, wave, lane);
                    pg8::Gemm g{256, ZLD, MMEM};
                    pg8::TileSched S; S.init(MH / 256, 4, G, cu, Zb + ZC_XQ, ZLD * 2, (bf16*)(ws + WS_VTMEM) + (size_t)hf * 4 * MEMLEN, 0);
                    S.a_pn = 512; S.b_tile = (size_t)256 * MMEM * 2; S.pm_per_b = 16; S.b_batch = (size_t)MEMLEN * 2;
                    pg8::EpiAct E{Zb + ZC_XQ, (size_t)ZLD, 0};
                    pg8::gemm_phase(lds, g, S, E, tid);
                }
                SEAM();
                if (IN()) { PHASE_IDS();
                    pg8::Gemm g{D, ZLD, D};
                    pg8::TileSched S; S.init(MH / 256, D / 256, G, cu, Zb + ZC_O, ZLD * 2, (char*)Wb + WO_BR, D * 2);
                    S.reps = 3; S.a_rep = 1024 * 2; S.b_rep = (size_t)D * D * 2;
                    pg8::EpiBranch E{Zb};
                    pg8::gemm_phase(lds, g, S, E, tid);
                }
                SEAM();
                if (IN()) { PHASE_IDS();
                    pg8::Gemm g{D, ZLD, D};
                    pg8::TileSched S; S.init(MH / 256, D / 256, G, cu, Zb + ZC_QK, ZLD * 2, (char*)Wb + WO_OUT, D * 2);
                    pg8::EpiAct E{Zb + ZC_O, (size_t)ZLD, 0};
                    pg8::gemm_phase(lds, g, S, E, tid);
                }
                SEAM();
                if (IN()) { PHASE_IDS();
                    thin_rows(Zb + ZC_O, ZLD, hbuf, hbuf, ng + 3 * D, 1.0f, ng + 4 * D, XN, hf * MH, (hf + 1) * MH, gw, NGW, lane, false, nullptr, nullptr, nullptr, nullptr, nullptr);
                }
                SEAM();
            }
        }
    }
#undef IN
#undef SEAM
}
constexpr int N_PHASES = 1 + 2 * DEPTH * 3 + DEPTH * 2 * 7;

#ifndef N_LAUNCH_MODE
#define N_LAUNCH_MODE 1
#endif
extern "C" void kernel_launch(void* const* d_in, const int* in_sizes, int n_in, void* d_out, int out_size, void* d_ws, size_t ws_size, hipStream_t stream) {
    static int grid = 0;
    if (grid == 0) {
        if (n_in != 18 || out_size != M * D || ws_size < WS_END) { fprintf(stderr, "kernel_launch: unexpected shapes (n_in %d out %d ws %zu)\n", n_in, out_size, ws_size); grid = -1; return; }
        int dev = 0, cus = 0, per_cu = 0;
        if (hipGetDevice(&dev) != hipSuccess || hipDeviceGetAttribute(&cus, hipDeviceAttributeMultiprocessorCount, dev) != hipSuccess) { grid = -1; return; }
        if (hipFuncSetAttribute((const void*)trunk_fwd, hipFuncAttributeMaxDynamicSharedMemorySize, LDS_BYTES) != hipSuccess) { grid = -1; return; }
        if (hipOccupancyMaxActiveBlocksPerMultiprocessor(&per_cu, (const void*)trunk_fwd, NTHR, LDS_BYTES) != hipSuccess || per_cu < 1) { fprintf(stderr, "kernel_launch: occupancy query says %d\n", per_cu); }
        (void)hipGetLastError();
        grid = cus;
    }
    if (grid < 0) return;
    (void)hipMemsetAsync((char*)d_ws + WS_CTL, 0, CTL_ZERO_BYTES, stream);
    Args a{};
    for (int i = 0; i < 18; ++i) a.in[i] = (const float*)d_in[i];
    a.out = (float*)d_out; a.ws = (unsigned char*)d_ws;
#if N_LAUNCH_MODE == 0
    a.ph_lo = 0; a.ph_hi = N_PHASES;
    hipLaunchKernelGGL(trunk_fwd, dim3(grid), dim3(NTHR), LDS_BYTES, stream, a);
#else
    for (int p = 0; p < N_PHASES; ++p) { a.ph_lo = p; a.ph_hi = p + 1; hipLaunchKernelGGL(trunk_fwd, dim3(grid), dim3(NTHR), LDS_BYTES, stream, a); }
#endif
}
```

```cpp
#include <hip/hip_runtime.h>
#include <cstdio>
#include <cstdint>

#define LAS __attribute__((address_space(3)))
#define GAS __attribute__((address_space(1)))
typedef unsigned short bf16;
typedef short bf16x8 __attribute__((ext_vector_type(8)));
typedef float f32x4 __attribute__((ext_vector_type(4)));
typedef float f32x16 __attribute__((ext_vector_type(16)));
typedef unsigned u32x4 __attribute__((ext_vector_type(4)));
typedef unsigned u32x2 __attribute__((ext_vector_type(2)));

constexpr int D = 1024, BATCH = 8, SEQ = 4096, DEPTH = 2, MEMLEN = 256, DFF = 2816, NNORM = 7;
constexpr int M = BATCH * SEQ, MH = M / 2, MMEM = BATCH * MEMLEN;
constexpr int WIN_COLS = 9224;
constexpr int LCH = 64, NCH = SEQ / LCH;
constexpr int ZLD = 7168;
constexpr int ZC_QK = 0, ZC_O = 1024, ZC_U = 2048, ZC_XQ = 3072, ZC_G = 4096;
constexpr int ZTLD = MH;
constexpr float EPS = 1e-6f;
constexpr int NWAVES = 8, NTHR = 512;

constexpr size_t MiB = 1u << 20;
constexpr size_t WS_CTL = 0, CTL_ZERO_BYTES = 1 * MiB;
constexpr size_t WS_WSGU = 1 * MiB;
constexpr size_t WS_GATE = 2 * MiB;
constexpr size_t WS_NST = 3 * MiB;
constexpr size_t WS_CSC = 4 * MiB;
constexpr size_t WS_MEMN = 5 * MiB;
constexpr size_t WS_KMEM = 9 * MiB;
constexpr size_t WS_VTMEM = 13 * MiB;
constexpr size_t WS_W = 17 * MiB;
constexpr size_t WO_GU0 = 0, WO_GU1 = 11 * MiB, WO_D0 = 22 * MiB, WO_D1 = WO_D0 + 5632 * 1024, WO_IN = 33 * MiB, WO_MKV = 51 * MiB, WO_BR = 55 * MiB, WO_OUT = 61 * MiB;
constexpr size_t WS_XN = 80 * MiB;
constexpr size_t WS_BIG = 144 * MiB;
constexpr size_t WS_HID = WS_BIG, WS_F = WS_BIG + 176 * MiB, WS_Z = WS_BIG, WS_ZT = WS_BIG + 224 * MiB;
constexpr size_t WS_ST = 432 * MiB;
constexpr size_t WS_END = 496 * MiB;

constexpr int LDS_BYTES = 147456;
constexpr int RING_BYTES = 131072;
constexpr int MISC_OFF = RING_BYTES + 320;

__device__ __forceinline__ unsigned f2bf(float f) { unsigned u = __builtin_bit_cast(unsigned, f); return (u + 0x7fffu + ((u >> 16) & 1u)) >> 16; }
__device__ __forceinline__ unsigned pk2(float lo, float hi) { return f2bf(lo) | (f2bf(hi) << 16); }
__device__ __forceinline__ float bflo(unsigned w) { return __uint_as_float(w << 16); }
__device__ __forceinline__ float bfhi(unsigned w) { return __uint_as_float(w & 0xffff0000u); }
__device__ __forceinline__ float bf1(bf16 b) { return __uint_as_float((unsigned)b << 16); }
__device__ __forceinline__ float wave_sum(float v) {
#pragma unroll
    for (int o = 1; o < 64; o <<= 1) v += __shfl_xor(v, o);
    return v;
}
__device__ __forceinline__ float sigmoidf_(float x) { return 1.f / (1.f + __expf(-x)); }
__device__ __forceinline__ float siluf_(float x) { return x / (1.f + __expf(-x)); }
__device__ __forceinline__ float gelu_tanh(float x) { const float u = 1.5957691216f * (x + 0.044715f * x * x * x); return x / (1.f + __expf(-u)); }
__device__ __forceinline__ float logsigmoidf_(float x) { return fminf(x, 0.f) - log1pf(__expf(-fabsf(x))); }
#define LDS_WAIT() asm volatile("s_waitcnt lgkmcnt(0)" ::: "memory")
#define VM_WAIT() asm volatile("s_waitcnt vmcnt(0)" ::: "memory")

namespace pg8 {
constexpr int BM = 256, BK = 64, HALF = 128, HTB = HALF * BK * 2, STAGE_BYTES = 8 * HTB, NXCD = 8, WGM = 8;
__host__ __device__ __forceinline__ int lds_byte(int r, int c) { const int st = (r >> 4) * 2 + (c >> 5), rr = r & 15, cc = c & 31, ob = rr * 64 + cc * 2; return st * 1024 + (ob ^ (((ob >> 9) & 1) << 5)); }
__host__ __device__ __forceinline__ void stage_rc(int b, int& R, int& C) { const int st = b / 1024, sb = b % 1024, swz = sb ^ (((sb >> 9) & 1) << 5); R = (st >> 1) * 16 + swz / 64; C = (st & 1) * 32 + (swz % 64) / 2; }
__host__ __device__ __forceinline__ int perm32(int rho) { const int n = rho >> 4, i = rho & 15; return 8 * (i >> 2) + 4 * n + (i & 3); }

struct Unit { int pm, pn, aux; const char* a; const char* b; };
struct Gemm { int K, lda, ldb; };

struct TileSched {
    int nM, nN, nwg, G, c, reps, pm_per_b;
    const char* A; const char* B;
    size_t a_tile, a_pn, a_rep, b_tile, b_batch, b_rep;
    __device__ __forceinline__ void init(int nM_, int nN_, int G_, int c_, const void* A_, size_t lda_bytes, const void* B_, size_t ldb_bytes) {
        nM = nM_; nN = nN_; nwg = nM * nN; G = G_; c = c_; reps = 1; pm_per_b = 1 << 30; A = (const char*)A_; B = (const char*)B_;
        a_tile = 256 * lda_bytes; a_pn = 0; a_rep = 0; b_tile = 256 * ldb_bytes; b_batch = 0; b_rep = 0;
    }
    __device__ __forceinline__ bool next(int i, Unit& u) const {
        const int ti = i / reps, aux = i - ti * reps;
        const long L = (long)ti * G + c; if (L >= nwg) return false;
        int wgid = (int)L; { const int q = nwg / NXCD, r = nwg % NXCD, xcd = wgid % NXCD, off = wgid / NXCD; wgid = (xcd < r ? xcd * (q + 1) : r * (q + 1) + (xcd - r) * q) + off; }
        const int nig = WGM * nN, gid = wgid / nig, fm = gid * WGM, gsz = (nM - fm) < WGM ? (nM - fm) : WGM;
        u.pm = fm + ((wgid % nig) % gsz); u.pn = (wgid % nig) / gsz; u.aux = aux;
        u.a = A + (size_t)u.pm * a_tile + (size_t)u.pn * a_pn + (size_t)aux * a_rep;
        u.b = B + (size_t)u.pn * b_tile + (size_t)(u.pm / pm_per_b) * b_batch + (size_t)aux * b_rep;
        return true;
    }
};

__device__ __forceinline__ unsigned cvt_pk_bf16(float lo, float hi) { unsigned r; asm volatile("v_cvt_pk_bf16_f32 %0, %1, %2" : "=v"(r) : "v"(lo), "v"(hi)); return r; }

template <int ACT> __device__ __forceinline__ float actf(float x) {
    if (ACT == 1) return sigmoidf_(x);
    if (ACT == 2) return gelu_tanh(x);
    if (ACT == 3) return x * 0.0625f;
    return x;
}
template <int ACT> __device__ __forceinline__ void store_tile_bf16(const f32x4 (&acc)[2][2][4][2], bf16* O, size_t ldc, int row0, int col0) {
#pragma unroll
    for (int ai = 0; ai < 2; ++ai)
#pragma unroll
        for (int m = 0; m < 4; ++m) { bf16* rowp = O + (size_t)(row0 + ai * HALF + m * 16) * ldc + col0;
#pragma unroll
            for (int bj = 0; bj < 2; ++bj) { const f32x4 v0 = acc[ai][bj][m][0], v1 = acc[ai][bj][m][1]; u32x4 w;
                w.x = cvt_pk_bf16(actf<ACT>(v0[0]), actf<ACT>(v0[1])); w.y = cvt_pk_bf16(actf<ACT>(v0[2]), actf<ACT>(v0[3]));
                w.z = cvt_pk_bf16(actf<ACT>(v1[0]), actf<ACT>(v1[1])); w.w = cvt_pk_bf16(actf<ACT>(v1[2]), actf<ACT>(v1[3]));
                *(u32x4*)(rowp + bj * HALF) = w; } }
}
struct EpiAct {
    static constexpr bool PERM = true;
    bf16* O; size_t ldc; int mode;
    __device__ __forceinline__ void operator()(const f32x4 (&acc)[2][2][4][2], const Unit& u, int wr, int wc, int fr, int fq) const {
        const int row0 = u.pm * BM + wr * 64 + fr, col0 = u.pn * BM + wc * 32 + 8 * fq;
        int act = 0;
        if (mode == 1) { const int g = u.pn >> 2; act = (g == 0) ? 0 : (g == 1) ? 1 : (g == 2) ? 2 : (g == 3) ? 3 : 1; }
        else if (mode == 2) act = (u.pm >= 4) ? 2 : 0;
        if (act == 0) store_tile_bf16<0>(acc, O, ldc, row0, col0);
        else if (act == 1) store_tile_bf16<1>(acc, O, ldc, row0, col0);
        else if (act == 2) store_tile_bf16<2>(acc, O, ldc, row0, col0);
        else store_tile_bf16<3>(acc, O, ldc, row0, col0);
    }
};
struct EpiGU {
    static constexpr bool PERM = true;
    bf16* O;
    __device__ __forceinline__ void operator()(const f32x4 (&acc)[2][2][4][2], const Unit& u, int wr, int wc, int fr, int fq) const {
        const int row0 = u.pm * BM + wr * 64 + fr, col0 = u.pn * HALF + wc * 32 + 8 * fq;
#pragma unroll
        for (int ai = 0; ai < 2; ++ai)
#pragma unroll
            for (int m = 0; m < 4; ++m) { bf16* rowp = O + (size_t)(row0 + ai * HALF + m * 16) * DFF + col0;
                const f32x4 g0 = acc[ai][0][m][0], g1 = acc[ai][0][m][1], u0 = acc[ai][1][m][0], u1 = acc[ai][1][m][1]; u32x4 w;
                w.x = cvt_pk_bf16(siluf_(g0[0]) * u0[0], siluf_(g0[1]) * u0[1]); w.y = cvt_pk_bf16(siluf_(g0[2]) * u0[2], siluf_(g0[3]) * u0[3]);
                w.z = cvt_pk_bf16(siluf_(g1[0]) * u1[0], siluf_(g1[1]) * u1[1]); w.w = cvt_pk_bf16(siluf_(g1[2]) * u1[2], siluf_(g1[3]) * u1[3]);
                *(u32x4*)rowp = w; }
    }
};
struct EpiBranch {
    static constexpr bool PERM = true;
    bf16* Zb;
    __device__ __forceinline__ void operator()(const f32x4 (&acc)[2][2][4][2], const Unit& u, int wr, int wc, int fr, int fq) const {
        const int row0 = u.pm * BM + wr * 64 + fr, col0 = u.pn * BM + wc * 32 + 8 * fq; const int j = u.aux;
#pragma unroll
        for (int ai = 0; ai < 2; ++ai)
#pragma unroll
            for (int m = 0; m < 4; ++m) { bf16* rowp = Zb + (size_t)(row0 + ai * HALF + m * 16) * ZLD + col0;
#pragma unroll
                for (int bj = 0; bj < 2; ++bj) { const f32x4 v0 = acc[ai][bj][m][0], v1 = acc[ai][bj][m][1];
                    const u32x4 g = *(const u32x4*)(rowp + ZC_G + j * 1024 + bj * HALF);
                    float o[8] = { v0[0] * bflo(g.x), v0[1] * bfhi(g.x), v0[2] * bflo(g.y), v0[3] * bfhi(g.y), v1[0] * bflo(g.z), v1[1] * bfhi(g.z), v1[2] * bflo(g.w), v1[3] * bfhi(g.w) };
                    if (j > 0) { const u32x4 p = *(const u32x4*)(rowp + ZC_QK + bj * HALF);
                        o[0] += bflo(p.x); o[1] += bfhi(p.x); o[2] += bflo(p.y); o[3] += bfhi(p.y); o[4] += bflo(p.z); o[5] += bfhi(p.z); o[6] += bflo(p.w); o[7] += bfhi(p.w); }
                    u32x4 w; w.x = cvt_pk_bf16(o[0], o[1]); w.y = cvt_pk_bf16(o[2], o[3]); w.z = cvt_pk_bf16(o[4], o[5]); w.w = cvt_pk_bf16(o[6], o[7]);
                    *(u32x4*)(rowp + ZC_QK + bj * HALF) = w; } }
    }
};

template <class Epi, class Sched>
__device__ __forceinline__ void gemm_phase(LAS unsigned char* lds, const Gemm g, const Sched& S, const Epi& E, const int tid) {
    const int wid = __builtin_amdgcn_readfirstlane(tid >> 6), lane = tid & 63, wr = wid >> 2, wc = wid & 3, fr = lane & 15, fq = lane >> 4;
    const int nt = g.K / BK;
    unsigned voffA[2], voffB[2];
#pragma unroll
    for (int i = 0; i < 2; ++i) { int R, C; stage_rc(tid * 16 + i * 8192, R, C); const int Rb = Epi::PERM ? ((R & ~31) + perm32(R & 31)) : R;
        voffA[i] = (unsigned)(R * g.lda + C) * 2u; voffB[i] = (unsigned)(Rb * g.ldb + C) * 2u; }
    const size_t kstep = (size_t)(BK * 2);
    const size_t hstepA = (size_t)HALF * g.lda * 2, hstepB = (size_t)HALF * g.ldb * 2;
    const unsigned ldsw = (unsigned)wid * 1024u;
    const int aoff = lds_byte(wr * 64 + fr, fq * 8), boff = lds_byte(wc * 32 + fr, fq * 8);
#define PG8_SA(b, h) (((b) * 2 + (h)) * HTB)
#define PG8_SB(b, h) ((4 + (b) * 2 + (h)) * HTB)
#define PG8_STAGE(bufoff, gbase, voff) do { _Pragma("unroll") for (int _i = 0; _i < 2; ++_i) \
        __builtin_amdgcn_global_load_lds((const unsigned*)((const char*)(gbase) + (voff)[_i]), (LAS unsigned*)(lds + (bufoff) + ldsw + _i * 8192), 16, 0, 0); } while (0)
#define PG8_LDA(dst, b, h) do { _Pragma("unroll") for (int m = 0; m < 4; ++m) _Pragma("unroll") for (int k = 0; k < 2; ++k) dst[m][k] = *(const LAS bf16x8*)(lds + PG8_SA(b, h) + aoff + m * 2048 + k * 1024); } while (0)
#define PG8_LDB(dst, b, h) do { _Pragma("unroll") for (int n = 0; n < 2; ++n) _Pragma("unroll") for (int k = 0; k < 2; ++k) dst[n][k] = *(const LAS bf16x8*)(lds + PG8_SB(b, h) + boff + n * 2048 + k * 1024); } while (0)
#define PG8_MMA(ai, bj, At, Bt) do { __builtin_amdgcn_s_setprio(1); _Pragma("unroll") for (int m = 0; m < 4; ++m) _Pragma("unroll") for (int n = 0; n < 2; ++n) _Pragma("unroll") for (int k = 0; k < 2; ++k) \
        acc[ai][bj][m][n] = __builtin_amdgcn_mfma_f32_16x16x32_bf16(Bt[n][k], At[m][k], acc[ai][bj][m][n], 0, 0, 0); __builtin_amdgcn_s_setprio(0); } while (0)
#define PG8_WAIT_V(n) asm volatile("s_waitcnt vmcnt(" #n ")" ::: "memory")
#define PG8_WAIT_L(n) asm volatile("s_waitcnt lgkmcnt(" #n ")" ::: "memory")
#define PG8_BAR __builtin_amdgcn_s_barrier()
#define PG8_SCHED __builtin_amdgcn_sched_barrier(0)
    Unit cur, nxt; int ui = 0;
    if (!S.next(0, cur)) return;
    f32x4 acc[2][2][4][2];
#pragma unroll
    for (int a = 0; a < 2; ++a)
#pragma unroll
        for (int b = 0; b < 2; ++b)
#pragma unroll
            for (int m = 0; m < 4; ++m)
#pragma unroll
                for (int n = 0; n < 2; ++n) acc[a][b][m][n] = (f32x4){0.f, 0.f, 0.f, 0.f};
    bf16x8 At[4][2], B0[2][2], B1[2][2];
    const char* cA = cur.a; const char* cB = cur.b;
    PG8_STAGE(PG8_SB(0, 0), cB, voffB); PG8_STAGE(PG8_SB(0, 1), cB + hstepB, voffB); PG8_STAGE(PG8_SA(0, 0), cA, voffA); PG8_STAGE(PG8_SA(0, 1), cA + hstepA, voffA);
    if (wr == 1) PG8_BAR;
    PG8_WAIT_V(2); PG8_BAR;
    PG8_STAGE(PG8_SB(1, 0), cB + kstep, voffB); PG8_STAGE(PG8_SA(1, 0), cA + kstep, voffA); PG8_STAGE(PG8_SB(1, 1), cB + hstepB + kstep, voffB);
    PG8_WAIT_V(6); PG8_BAR;
    for (;;) {
        const bool has_next = S.next(ui + 1, nxt);
        const char* nA = has_next ? nxt.a : cA; const char* nB = has_next ? nxt.b : cB;
        for (int t = 0; t < nt; t += 2) {
            const bool last = (t == nt - 2);
            const char* a1 = cA + (size_t)(t + 1) * kstep;
            const char* a2 = last ? nA : cA + (size_t)(t + 2) * kstep; const char* b2 = last ? nB : cB + (size_t)(t + 2) * kstep;
            const char* a3 = a2 + kstep; const char* b3 = b2 + kstep;
            PG8_LDB(B0, 0, 0); PG8_LDB(B1, 0, 1); PG8_SCHED; PG8_LDA(At, 0, 0); PG8_STAGE(PG8_SA(1, 1), a1 + hstepA, voffA);
            PG8_WAIT_V(8); PG8_WAIT_L(0); PG8_BAR; PG8_MMA(0, 0, At, B0); PG8_MMA(0, 1, At, B1); PG8_BAR; PG8_SCHED;
            PG8_LDA(At, 0, 1); PG8_STAGE(PG8_SB(0, 0), b2, voffB); PG8_STAGE(PG8_SB(0, 1), b2 + hstepB, voffB); PG8_STAGE(PG8_SA(0, 0), a2, voffA);
            PG8_WAIT_V(8); PG8_WAIT_L(0); PG8_BAR; PG8_MMA(1, 0, At, B0); PG8_MMA(1, 1, At, B1); PG8_BAR; PG8_SCHED;
            PG8_LDB(B0, 1, 0); PG8_LDB(B1, 1, 1); PG8_SCHED; PG8_LDA(At, 1, 0); PG8_STAGE(PG8_SA(0, 1), a2 + hstepA, voffA);
            PG8_WAIT_V(8); PG8_WAIT_L(0); PG8_BAR; PG8_MMA(0, 0, At, B0); PG8_MMA(0, 1, At, B1); PG8_BAR; PG8_SCHED;
            PG8_LDA(At, 1, 1); PG8_STAGE(PG8_SB(1, 0), b3, voffB); PG8_STAGE(PG8_SB(1, 1), b3 + hstepB, voffB); PG8_STAGE(PG8_SA(1, 0), a3, voffA);
            PG8_WAIT_V(8); PG8_WAIT_L(0); PG8_BAR; PG8_MMA(1, 0, At, B0); PG8_MMA(1, 1, At, B1); PG8_BAR; PG8_SCHED;
        }
        if (wr == 0) PG8_BAR;
        E(acc, cur, wr, wc, fr, fq);
        if (!has_next) break;
#pragma unroll
        for (int a = 0; a < 2; ++a)
#pragma unroll
            for (int b = 0; b < 2; ++b)
#pragma unroll
                for (int m = 0; m < 4; ++m)
#pragma unroll
                    for (int n = 0; n < 2; ++n) acc[a][b][m][n] = (f32x4){0.f, 0.f, 0.f, 0.f};
        cur = nxt; cA = nA; cB = nB; ++ui;
        if (wr == 1) PG8_BAR;
    }
    PG8_WAIT_V(0);
    PG8_BAR;
#undef PG8_SA
#undef PG8_SB
#undef PG8_STAGE
#undef PG8_LDA
#undef PG8_LDB
#undef PG8_MMA
#undef PG8_WAIT_V
#undef PG8_WAIT_L
#undef PG8_BAR
#undef PG8_SCHED
}
}

#define XB_TMO      128
#define XB_XCNT(j)  (256  + 64 * (j))
#define XB_XSUB(j)  (1280 + 64 * (j))
#define XB_XGEN(j)  (2304 + 64 * (j))
#define XB_TOP      3328
#define XB_TOPGEN   3392
#define XCD_BAR_WORDS 3456
#define XB_SPIN_CAP (1u << 18)
__device__ __forceinline__ unsigned xb_ld(unsigned* p)              { return __hip_atomic_load(p, __ATOMIC_RELAXED, __HIP_MEMORY_SCOPE_AGENT); }
__device__ __forceinline__ unsigned xb_add(unsigned* p, unsigned v) { return __hip_atomic_fetch_add(p, v, __ATOMIC_RELAXED, __HIP_MEMORY_SCOPE_AGENT); }
__device__ __forceinline__ unsigned xb_xcc_id() { return (unsigned)__builtin_amdgcn_s_getreg((3 << 11) | 20) & 0xFu; }
#define XB_SPIN(cond, bar) do { unsigned _sp = 0; while (cond) { __builtin_amdgcn_s_sleep(1); \
    if ((++_sp & 255u) == 0u) { if (xb_ld(&(bar)[XB_TMO])) break; if (_sp > XB_SPIN_CAP) { atomicAdd(&(bar)[XB_TMO], 1u); break; } } } } while (0)
struct XcdBarrier { unsigned* bar; unsigned x; volatile LAS unsigned* st; };
__device__ __forceinline__ XcdBarrier xcd_barrier_post(unsigned* bar, volatile LAS unsigned* st) {
    XcdBarrier b; b.bar = bar; b.x = xb_xcc_id(); b.st = st;
    if (threadIdx.x == 0) (void)xb_add(&bar[XB_XCNT(b.x)], 1u);
    return b;
}
__device__ __forceinline__ void xcd_barrier_complete(unsigned* bar, unsigned x, unsigned& nloc, unsigned& nx) {
    const unsigned G = gridDim.x * gridDim.y * gridDim.z;
    unsigned sum, cnt, mine, sp = 0u;
    for (;;) {
        sum = 0u; cnt = 0u; mine = 0u;
#pragma unroll
        for (unsigned j = 0; j < 16; ++j) { const unsigned c = xb_ld(&bar[XB_XCNT(j)]); sum += c; cnt += (c > 0u) ? 1u : 0u; mine = (j == x) ? c : mine; }
        if (sum == G) break;
        __builtin_amdgcn_s_sleep(1);
        if ((++sp & 255u) == 0u) { if (xb_ld(&bar[XB_TMO])) break; if (sp > XB_SPIN_CAP) { atomicAdd(&bar[XB_TMO], 1u); break; } }
    }
    nloc = mine > 0u ? mine : 1u; nx = cnt > 0u ? cnt : 1u;
}
__device__ __forceinline__ void xcd_barrier(const XcdBarrier& b) {
    asm volatile("s_waitcnt vmcnt(0)" ::: "memory");
    __syncthreads();
    if (threadIdx.x == 0) {
        unsigned* bar = b.bar;
        __builtin_amdgcn_s_waitcnt(0);
        unsigned nloc = b.st[0], nx = b.st[1];
        if (nloc == 0u) { xcd_barrier_complete(bar, b.x, nloc, nx); b.st[0] = nloc; b.st[1] = nx; }
        const unsigned old = xb_add(&bar[XB_XSUB(b.x)], 1u);
        const unsigned gen = old / nloc;
        if (old + 1u == (gen + 1u) * nloc) {
            __builtin_amdgcn_fence(__ATOMIC_RELEASE, "agent");
            asm volatile("s_waitcnt vmcnt(0)" ::: "memory");
            const unsigned og = xb_add(&bar[XB_TOP], 1u);
            const unsigned tg = og / nx;
            if (og + 1u == (tg + 1u) * nx) xb_add(&bar[XB_TOPGEN], 1u);
            else XB_SPIN(xb_ld(&bar[XB_TOPGEN]) == tg, bar);
            __builtin_amdgcn_fence(__ATOMIC_ACQUIRE, "agent");
            xb_add(&bar[XB_XGEN(b.x)], 1u);
            asm volatile("s_waitcnt vmcnt(0)" ::: "memory");
        } else {
            XB_SPIN(xb_ld(&bar[XB_XGEN(b.x)]) == gen, bar);
            __builtin_amdgcn_fence(__ATOMIC_ACQUIRE, "agent");
            asm volatile("s_waitcnt vmcnt(0)" ::: "memory");
        }
    }
    __syncthreads();
}

struct Args { const float* in[18]; float* out; unsigned char* ws; int ph_lo, ph_hi; };
enum { I_X = 0, I_MEM, I_NORMG, I_WGU, I_WDOWN, I_WIN, I_CONVW, I_CONVB, I_BI, I_BF, I_MNORM, I_SLNG, I_SLNB, I_SWS, I_SBS, I_WMKV, I_WBR, I_WOUT };

__device__ __forceinline__ void cvt_item(const float* W, int Nsrc, int K, int srccol, bf16* WT, int dstrow, int kb, LAS float* scr, int lane) {
    const int k0 = 64 * kb;
#pragma unroll 8
    for (int i = 0; i < 32; ++i) { const int kk = 2 * i + (lane >> 5); scr[kk * 33 + (lane & 31)] = W[(size_t)(k0 + kk) * Nsrc + srccol + (lane & 31)]; }
    LDS_WAIT(); asm volatile("" ::: "memory");
    const int c = lane & 7;
#pragma unroll
    for (int j = 0; j < 4; ++j) { const int n = (lane >> 3) + 8 * j; const LAS float* s = scr + (8 * c) * 33 + n;
        u32x4 o; o.x = pk2(s[0 * 33], s[1 * 33]); o.y = pk2(s[2 * 33], s[3 * 33]); o.z = pk2(s[4 * 33], s[5 * 33]); o.w = pk2(s[6 * 33], s[7 * 33]);
        *(u32x4*)(WT + (size_t)(dstrow + n) * K + k0 + 8 * c) = o; }
    LDS_WAIT(); asm volatile("" ::: "memory");
}
__device__ __forceinline__ int win_srccol(int r) {
    if (r < 1024) return r;
    if (r < 2048) return 2048 + (r - 1024);
    if (r < 3072) return 3080 + (r - 2048);
    if (r < 4096) return 5128 + (r - 3072);
    if (r < 7168) return 6152 + (r - 4096);
    if (r < 8192) return 1024 + (r - 7168);
    return 4104 + (r - 8192);
}
__device__ __forceinline__ void convert_layer(const Args& a, int l, unsigned char* ws, LAS unsigned char* lds, int gw, int NGW, int wave, int lane, int gtid, int GT) {
    LAS float* scr = (LAS float*)(lds + wave * 16384);
    bf16* Wb = (bf16*)(ws + WS_W);
    constexpr int I_GU = 16 * 176, I_DN = 44 * 32, I_IN = 16 * 288, I_MKV = 16 * 64, I_BR = 16 * 32, I_OUT = 16 * 32;
    constexpr int NITEMS = 2 * I_GU + 2 * I_DN + I_IN + I_MKV + 3 * I_BR + I_OUT;
    for (int it = gw; it < NITEMS; it += NGW) {
        int r = it;
        if (r < 2 * I_GU) { const int j = r / I_GU; r -= j * I_GU; const int kb = r / 176, nb = r % 176; const int p = nb >> 3, q = nb & 7, s = q >> 2, jj = (q & 3) * 32;
            cvt_item(a.in[I_WGU] + (size_t)(l * 2 + j) * D * 2 * DFF, 2 * DFF, D, s * DFF + 128 * p + jj, (bf16*)((char*)Wb + (j ? WO_GU1 : WO_GU0)), nb * 32, kb, scr, lane); continue; }
        r -= 2 * I_GU;
        if (r < 2 * I_DN) { const int j = r / I_DN; r -= j * I_DN; const int kb = r / 32, nb = r % 32;
            cvt_item(a.in[I_WDOWN] + (size_t)(l * 2 + j) * DFF * D, D, DFF, nb * 32, (bf16*)((char*)Wb + (j ? WO_D1 : WO_D0)), nb * 32, kb, scr, lane); continue; }
        r -= 2 * I_DN;
        if (r < I_IN) { const int kb = r / 288, nb = r % 288;
            cvt_item(a.in[I_WIN] + (size_t)l * D * WIN_COLS, WIN_COLS, D, win_srccol(nb * 32), (bf16*)((char*)Wb + WO_IN), nb * 32, kb, scr, lane); continue; }
        r -= I_IN;
        if (r < I_MKV) { const int kb = r / 64, nb = r % 64;
            cvt_item(a.in[I_WMKV] + (size_t)l * D * 2048, 2048, D, nb * 32, (bf16*)((char*)Wb + WO_MKV), nb * 32, kb, scr, lane); continue; }
        r -= I_MKV;
        if (r < 3 * I_BR) { const int j = r / I_BR; r -= j * I_BR; const int kb = r / 32, nb = r % 32;
            cvt_item(a.in[I_WBR] + (size_t)(l * 3 + j) * D * D, D, D, nb * 32, (bf16*)((char*)Wb + WO_BR) + (size_t)j * D * D, nb * 32, kb, scr, lane); continue; }
        r -= 3 * I_BR;
        { const int kb = r / 32, nb = r % 32; cvt_item(a.in[I_WOUT] + (size_t)l * D * D, D, D, nb * 32, (bf16*)((char*)Wb + WO_OUT), nb * 32, kb, scr, lane); }
    }
    bf16* wsg = (bf16*)(ws + WS_WSGU); const float* src = a.in[I_SWS] + (size_t)l * 4 * 128 * 128;
    for (int e = gtid; e < 4 * 128 * 128; e += GT) { const int t = (e >> 7) & 127, s = e & 127; wsg[e] = (bf16)f2bf(s <= t ? src[e] : 0.f); }
    const float* g6 = a.in[I_NORMG] + (size_t)(l * NNORM + 6) * D;
    for (int m = gw; m < MMEM; m += NGW) {
        const f32x4* xr = (const f32x4*)(a.in[I_MEM] + (size_t)m * D) + lane; f32x4 v[4]; float s = 0.f;
#pragma unroll
        for (int j = 0; j < 4; ++j) { v[j] = xr[64 * j]; s += (v[j].x * v[j].x + v[j].y * v[j].y) + (v[j].z * v[j].z + v[j].w * v[j].w); }
        const float rstd = rsqrtf(wave_sum(s) * (1.f / D) + EPS);
        unsigned long long* o8 = (unsigned long long*)((bf16*)(ws + WS_MEMN) + (size_t)m * D) + lane;
#pragma unroll
        for (int j = 0; j < 4; ++j) { const f32x4 gg = ((const f32x4*)g6)[lane + 64 * j];
            o8[64 * j] = (unsigned long long)pk2(v[j].x * rstd * gg.x, v[j].y * rstd * gg.y) | ((unsigned long long)pk2(v[j].z * rstd * gg.z, v[j].w * rstd * gg.w) << 32); }
    }
}

__device__ __forceinline__ void thin_rows(const bf16* fbase, size_t fld, const float* hin, float* hout, const float* ga, float scale, const float* gb, bf16* xn,
                                          int row_lo, int row_hi, int gw, int NGW, int lane, const bool do_gates, const LAS float* wif, const float* bi, const float* bfg, float* gate_i, float* gate_f) {
    for (int m = row_lo + gw; m < row_hi; m += NGW) {
        f32x4 v[4];
        if (fbase) {
            const unsigned long long* fr = (const unsigned long long*)(fbase + (size_t)(m - row_lo) * fld) + lane; float s = 0.f; f32x4 f[4];
#pragma unroll
            for (int j = 0; j < 4; ++j) { const unsigned long long w = fr[64 * j]; const unsigned lo = (unsigned)w, hi = (unsigned)(w >> 32);
                f[j] = (f32x4){bflo(lo), bfhi(lo), bflo(hi), bfhi(hi)}; s += (f[j].x * f[j].x + f[j].y * f[j].y) + (f[j].z * f[j].z + f[j].w * f[j].w); }
            const float rstd = rsqrtf(wave_sum(s) * (1.f / D) + EPS) * scale;
            const f32x4* hr = (const f32x4*)(hin + (size_t)m * D) + lane; f32x4* ho = (f32x4*)(hout + (size_t)m * D) + lane;
#pragma unroll
            for (int j = 0; j < 4; ++j) { const f32x4 gg = ((const f32x4*)ga)[lane + 64 * j]; v[j] = hr[64 * j] + f[j] * rstd * gg; ho[64 * j] = v[j]; }
        } else {
            const f32x4* hr = (const f32x4*)(hin + (size_t)m * D) + lane;
#pragma unroll
            for (int j = 0; j < 4; ++j) v[j] = hr[64 * j];
        }
        if (gb) {
            float s = 0.f;
#pragma unroll
            for (int j = 0; j < 4; ++j) s += (v[j].x * v[j].x + v[j].y * v[j].y) + (v[j].z * v[j].z + v[j].w * v[j].w);
            const float rstd = rsqrtf(wave_sum(s) * (1.f / D) + EPS);
            unsigned long long* o8 = (unsigned long long*)(xn + (size_t)m * D) + lane;
#pragma unroll
            for (int j = 0; j < 4; ++j) { const f32x4 gg = ((const f32x4*)gb)[lane + 64 * j]; v[j] = v[j] * rstd * gg;
                o8[64 * j] = (unsigned long long)pk2(v[j].x, v[j].y) | ((unsigned long long)pk2(v[j].z, v[j].w) << 32); }
            if (do_gates) {
                float acc[8];
#pragma unroll
                for (int e = 0; e < 8; ++e) acc[e] = 0.f;
#pragma unroll
                for (int j = 0; j < 4; ++j)
#pragma unroll
                    for (int q = 0; q < 4; ++q) { const int k = 4 * lane + 256 * j + q; const float xv = v[j][q]; const LAS f32x4* wp = (const LAS f32x4*)(wif + k * 8); const f32x4 w0 = wp[0], w1 = wp[1];
                        acc[0] += xv * w0.x; acc[1] += xv * w0.y; acc[2] += xv * w0.z; acc[3] += xv * w0.w; acc[4] += xv * w1.x; acc[5] += xv * w1.y; acc[6] += xv * w1.z; acc[7] += xv * w1.w; }
#pragma unroll
                for (int e = 0; e < 8; ++e) acc[e] = wave_sum(acc[e]);
                if (lane == 0) {
                    *(f32x4*)(gate_i + (size_t)m * 4) = (f32x4){acc[0] + bi[0], acc[1] + bi[1], acc[2] + bi[2], acc[3] + bi[3]};
                    *(f32x4*)(gate_f + (size_t)m * 4) = (f32x4){logsigmoidf_(acc[4] + bfg[0]), logsigmoidf_(acc[5] + bfg[1]), logsigmoidf_(acc[6] + bfg[2]), logsigmoidf_(acc[7] + bfg[3])};
                }
            }
        }
    }
}

__device__ __forceinline__ void conv8(const bf16* Zb, int bl, int p, int col, const float* cw, const float* cb, float (&o)[8]) {
    const f32x4 b0 = *(const f32x4*)(cb + col), b1 = *(const f32x4*)(cb + col + 4);
    o[0] = b0.x; o[1] = b0.y; o[2] = b0.z; o[3] = b0.w; o[4] = b1.x; o[5] = b1.y; o[6] = b1.z; o[7] = b1.w;
#pragma unroll
    for (int j = 0; j < 4; ++j) { const int pp = p - 3 + j;
        if (pp >= 0) { const u32x4 x = *(const u32x4*)(Zb + (size_t)(bl * SEQ + pp) * ZLD + ZC_QK + col);
            const f32x4 w0 = *(const f32x4*)(cw + j * 1024 + col), w1 = *(const f32x4*)(cw + j * 1024 + col + 4);
            o[0] += w0.x * bflo(x.x); o[1] += w0.y * bfhi(x.x); o[2] += w0.z * bflo(x.y); o[3] += w0.w * bfhi(x.y);
            o[4] += w1.x * bflo(x.z); o[5] += w1.y * bfhi(x.z); o[6] += w1.z * bflo(x.w); o[7] += w1.w * bfhi(x.w); } }
#pragma unroll
    for (int e = 0; e < 8; ++e) o[e] = siluf_(o[e]);
}
__device__ __forceinline__ float wave_incl_scan_add(float v, int lane) {
#pragma unroll
    for (int o = 1; o < 64; o <<= 1) { const float t = __shfl_up(v, o); if (lane >= o) v += t; }
    return v;
}
__device__ __forceinline__ float wave_incl_scan_max(float v, int lane) {
#pragma unroll
    for (int o = 1; o < 64; o <<= 1) { const float t = __shfl_up(v, o); if (lane >= o) v = fmaxf(v, t); }
    return v;
}
__device__ __forceinline__ float wave_max(float v) {
#pragma unroll
    for (int o = 1; o < 64; o <<= 1) v = fmaxf(v, __shfl_xor(v, o));
    return v;
}
constexpr float KSCALE = 0.08838834764831845f;

__device__ __forceinline__ void mlstm_s1(const Args& a, int l, int hf, unsigned char* ws, LAS unsigned char* lds, int G, int cu, int tid, int wave, int lane) {
    const bf16* Zb = (const bf16*)(ws + WS_Z); const bf16* ZT = (const bf16*)(ws + WS_ZT);
    const float* gi = (const float*)(ws + WS_GATE); const float* gf = gi + (size_t)M * 4;
    const float* cw = a.in[I_CONVW] + (size_t)l * 4 * 1024; const float* cb = a.in[I_CONVB] + (size_t)l * 1024;
    LAS bf16* KT = (LAS bf16*)lds;
    LAS float* wv = (LAS float*)(lds + 18432);
    for (int u = cu; u < 16 * NCH; u += G) {
        const int bhl = u >> 6, c = u & 63, bl = bhl >> 2, h = bhl & 3; const int tokg = (hf * 4 + bl) * SEQ + c * LCH;
        if (wave == 0) {
            const float lf = gf[(size_t)(tokg + lane) * 4 + h], ii = gi[(size_t)(tokg + lane) * 4 + h];
            const float bc = wave_incl_scan_add(lf, lane); const float g = __shfl(bc, 63);
            const float av = g - bc + ii; const float ml = wave_max(av);
            wv[lane] = __expf(av - ml);
            if (lane == 0) { float* cs = (float*)(ws + WS_CSC) + (size_t)(bhl * NCH + c) * 4; cs[0] = g; cs[1] = ml; }
        }
        __syncthreads();
#pragma unroll
        for (int rep = 0; rep < 2; ++rep) { const int idx = tid + rep * NTHR, s = idx >> 4, c8 = idx & 15; float o[8];
            conv8(Zb, bl, c * LCH + s, 512 + h * 128 + c8 * 8, cw, cb, o); const float sc = wv[s] * KSCALE;
#pragma unroll
            for (int e = 0; e < 8; ++e) KT[(c8 * 8 + e) * 72 + s] = (bf16)f2bf(o[e] * sc); }
        __syncthreads();
        if (tid < 128) { float s = 0.f;
#pragma unroll 8
            for (int k = 0; k < 64; ++k) s += bf1(KT[tid * 72 + k]);
            ((float*)(ws + WS_NST))[(size_t)(bhl * NCH + c) * 128 + tid] = s; }
        {
            const int r = lane & 31, hh = lane >> 5, v0 = 32 * wave;
            const bf16* vrow = ZT + (size_t)(h * 256 + v0 + r) * ZTLD + bl * SEQ + c * LCH + 8 * hh;
            bf16x8 bfr[4];
#pragma unroll
            for (int ks = 0; ks < 4; ++ks) bfr[ks] = *(const bf16x8*)(vrow + 16 * ks);
            bf16* st = (bf16*)(ws + WS_ST) + (size_t)(bhl * NCH + c) * 32768 + (size_t)(v0 + r) * 128;
#pragma unroll
            for (int db = 0; db < 4; ++db) { f32x16 acc;
#pragma unroll
                for (int e = 0; e < 16; ++e) acc[e] = 0.f;
#pragma unroll
                for (int ks = 0; ks < 4; ++ks) { const bf16x8 af = *(const LAS bf16x8*)(KT + (32 * db + r) * 72 + 16 * ks + 8 * hh); acc = __builtin_amdgcn_mfma_f32_32x32x16_bf16(af, bfr[ks], acc, 0, 0, 0); }
#pragma unroll
                for (int q = 0; q < 4; ++q) { u32x2 w; w.x = pk2(acc[4 * q], acc[4 * q + 1]); w.y = pk2(acc[4 * q + 2], acc[4 * q + 3]); *(u32x2*)(st + 32 * db + 8 * q + 4 * hh) = w; } }
        }
        __syncthreads();
    }
}
__device__ __forceinline__ void mlstm_s2(unsigned char* ws, int G, int cu, int tid) {
    for (int u = cu; u < 128; u += G) {
        const int bhl = u >> 3, part = u & 7; const size_t off = (size_t)(part * NTHR + tid) * 8;
        bf16* st = (bf16*)(ws + WS_ST) + (size_t)bhl * NCH * 32768 + off; float* ns = (float*)(ws + WS_NST) + (size_t)bhl * NCH * 128 + tid; float* cs = (float*)(ws + WS_CSC) + (size_t)bhl * NCH * 4;
        const bool nth = (part == 0 && tid < 128);
        float C[8]; float nv = 0.f, m = -1e30f;
#pragma unroll
        for (int e = 0; e < 8; ++e) C[e] = 0.f;
        for (int c0 = 0; c0 < NCH; c0 += 4) {
            u32x4 cl[4]; float nl[4], gg[4], ml[4];
#pragma unroll
            for (int i = 0; i < 4; ++i) { cl[i] = *(const u32x4*)(st + (size_t)(c0 + i) * 32768); nl[i] = nth ? ns[(c0 + i) * 128] : 0.f; gg[i] = cs[(c0 + i) * 4]; ml[i] = cs[(c0 + i) * 4 + 1]; }
#pragma unroll
            for (int i = 0; i < 4; ++i) {
                u32x4 o; o.x = pk2(C[0], C[1]); o.y = pk2(C[2], C[3]); o.z = pk2(C[4], C[5]); o.w = pk2(C[6], C[7]);
                *(u32x4*)(st + (size_t)(c0 + i) * 32768) = o;
                if (nth) ns[(c0 + i) * 128] = nv;
                if (part == 0 && tid == 0) cs[(c0 + i) * 4 + 2] = m;
                const float mn = fmaxf(gg[i] + m, ml[i]); const float dec = __expf(gg[i] + m - mn), sc = __expf(ml[i] - mn);
                C[0] = dec * C[0] + sc * bflo(cl[i].x); C[1] = dec * C[1] + sc * bfhi(cl[i].x); C[2] = dec * C[2] + sc * bflo(cl[i].y); C[3] = dec * C[3] + sc * bfhi(cl[i].y);
                C[4] = dec * C[4] + sc * bflo(cl[i].z); C[5] = dec * C[5] + sc * bfhi(cl[i].z); C[6] = dec * C[6] + sc * bflo(cl[i].w); C[7] = dec * C[7] + sc * bfhi(cl[i].w);
                nv = dec * nv + sc * nl[i]; m = mn;
            }
        }
    }
}
__device__ __forceinline__ void mlstm_s3(const Args& a, int l, int hf, unsigned char* ws, LAS unsigned char* lds, int G, int cu, int tid, int wave, int lane) {
    bf16* Zb = (bf16*)(ws + WS_Z); const bf16* ZT = (const bf16*)(ws + WS_ZT);
    const float* gi = (const float*)(ws + WS_GATE); const float* gf = gi + (size_t)M * 4;
    const float* cw = a.in[I_CONVW] + (size_t)l * 4 * 1024; const float* cb = a.in[I_CONVB] + (size_t)l * 1024;
    const float* gain = a.in[I_MNORM] + (size_t)l * 1024;
    LAS bf16* QS = (LAS bf16*)lds;
    LAS bf16* KS = (LAS bf16*)(lds + 17408);
    LAS bf16* SD = (LAS bf16*)(lds + 34816);
    LAS float* HB = (LAS float*)(lds + 44032);
    LAS float* SC = (LAS float*)(lds + 110592);
    for (int u = cu; u < 16 * NCH; u += G) {
        const int bhl = u >> 6, c = u & 63, bl = bhl >> 2, h = bhl & 3; const int tokg = (hf * 4 + bl) * SEQ + c * LCH; const int tokl = bl * SEQ + c * LCH;
        if (wave == 0) {
            const float lf = gf[(size_t)(tokg + lane) * 4 + h], ii = gi[(size_t)(tokg + lane) * 4 + h];
            const float bc = wave_incl_scan_add(lf, lane); const float rr = ii - bc; const float cm = wave_incl_scan_max(rr, lane);
            const float mst = ((const float*)(ws + WS_CSC))[(size_t)(bhl * NCH + c) * 4 + 2];
            const float Mt = fmaxf(mst, cm);
            SC[lane] = rr; SC[64 + lane] = Mt; SC[128 + lane] = __expf(mst - Mt); SC[192 + lane] = __expf(-(bc + Mt));
        } else if (wave == 1 || wave == 2) { const int d = (wave - 1) * 64 + lane; SC[320 + d] = ((const float*)(ws + WS_NST))[(size_t)(bhl * NCH + c) * 128 + d]; }
#pragma unroll
        for (int rep = 0; rep < 4; ++rep) { const int idx = tid + (rep & 1) * NTHR, t = idx >> 4, c8 = idx & 15; const bool isk = rep >= 2; float o[8];
            conv8(Zb, bl, c * LCH + t, (isk ? 512 : 0) + h * 128 + c8 * 8, cw, cb, o); const float sc = isk ? KSCALE : 1.f;
            u32x4 w; w.x = pk2(o[0] * sc, o[1] * sc); w.y = pk2(o[2] * sc, o[3] * sc); w.z = pk2(o[4] * sc, o[5] * sc); w.w = pk2(o[6] * sc, o[7] * sc);
            *(LAS u32x4*)((isk ? KS : QS) + t * 136 + c8 * 8) = w; }
        __syncthreads();
        {
            const int tb = wave >> 1, fr = lane & 15, fq = lane >> 4;
#pragma unroll
            for (int i = 0; i < 2; ++i) { const int sblk = (wave & 1) * 2 + i; f32x4 acc = (f32x4){0.f, 0.f, 0.f, 0.f};
                if (sblk <= tb) {
#pragma unroll
                    for (int ks = 0; ks < 4; ++ks) { const bf16x8 af = *(const LAS bf16x8*)(QS + (16 * tb + fr) * 136 + 32 * ks + 8 * fq), bfv = *(const LAS bf16x8*)(KS + (16 * sblk + fr) * 136 + 32 * ks + 8 * fq);
                        acc = __builtin_amdgcn_mfma_f32_16x16x32_bf16(af, bfv, acc, 0, 0, 0); } }
                const int s = 16 * sblk + fr; const float rs_ = SC[s];
#pragma unroll
                for (int e = 0; e < 4; ++e) { const int t = 16 * tb + 4 * fq + e; const float val = (s <= t) ? acc[e] * __expf(rs_ - SC[64 + t]) : 0.f; SD[t * 72 + s] = (bf16)f2bf(val); } }
        }
        __syncthreads();
#pragma unroll
        for (int rep = 0; rep < 2; ++rep) { const int idx = tid + rep * NTHR, t = idx >> 4, c8 = idx & 15; const float it = SC[128 + t];
            u32x4 x = *(const LAS u32x4*)(QS + t * 136 + c8 * 8);
            x.x = pk2(bflo(x.x) * it, bfhi(x.x) * it); x.y = pk2(bflo(x.y) * it, bfhi(x.y) * it); x.z = pk2(bflo(x.z) * it, bfhi(x.z) * it); x.w = pk2(bflo(x.w) * it, bfhi(x.w) * it);
            *(LAS u32x4*)(QS + t * 136 + c8 * 8) = x; }
        __syncthreads();
        if (wave == 0) { const int t = lane; float den = 0.f;
#pragma unroll 8
            for (int s = 0; s < 64; ++s) den += bf1(SD[t * 72 + s]);
#pragma unroll 8
            for (int d = 0; d < 128; ++d) den += bf1(QS[t * 136 + d]) * SC[320 + d];
            SC[256 + t] = 1.f / fmaxf(fabsf(den), SC[192 + t]); }
        f32x16 acc0, acc1;
        const int r = lane & 31, hh = lane >> 5, v0 = 32 * wave;
        {
#pragma unroll
            for (int e = 0; e < 16; ++e) { acc0[e] = 0.f; acc1[e] = 0.f; }
            const bf16* vrow = ZT + (size_t)(h * 256 + v0 + r) * ZTLD + tokl + 8 * hh;
            const bf16* crow = (const bf16*)(ws + WS_ST) + (size_t)(bhl * NCH + c) * 32768 + (size_t)(v0 + r) * 128 + 8 * hh;
#pragma unroll
            for (int ks = 0; ks < 12; ++ks) {
                const bf16x8 bfv = (ks < 4) ? *(const bf16x8*)(vrow + 16 * ks) : *(const bf16x8*)(crow + 16 * (ks - 4));
                const bf16x8 a0 = (ks < 4) ? *(const LAS bf16x8*)(SD + r * 72 + 16 * ks + 8 * hh) : *(const LAS bf16x8*)(QS + r * 136 + 16 * (ks - 4) + 8 * hh);
                const bf16x8 a1 = (ks < 4) ? *(const LAS bf16x8*)(SD + (32 + r) * 72 + 16 * ks + 8 * hh) : *(const LAS bf16x8*)(QS + (32 + r) * 136 + 16 * (ks - 4) + 8 * hh);
                acc0 = __builtin_amdgcn_mfma_f32_32x32x16_bf16(a0, bfv, acc0, 0, 0, 0); acc1 = __builtin_amdgcn_mfma_f32_32x32x16_bf16(a1, bfv, acc1, 0, 0, 0); }
        }
        __syncthreads();
#pragma unroll
        for (int e = 0; e < 16; ++e) { const int t0 = (e & 3) + 8 * (e >> 2) + 4 * hh; HB[t0 * 260 + v0 + r] = acc0[e] * SC[256 + t0]; HB[(32 + t0) * 260 + v0 + r] = acc1[e] * SC[256 + 32 + t0]; }
        __syncthreads();
#pragma unroll
        for (int i = 0; i < 8; ++i) { const int t = 8 * wave + i; const f32x4 x = *(const LAS f32x4*)(HB + t * 260 + 4 * lane);
            const float mean = wave_sum((x.x + x.y) + (x.z + x.w)) * (1.f / 256.f); const f32x4 dx = x - mean;
            const float var = wave_sum((dx.x * dx.x + dx.y * dx.y) + (dx.z * dx.z + dx.w * dx.w)) * (1.f / 256.f); const float rstd = rsqrtf(var + EPS);
            const f32x4 gg = *(const f32x4*)(gain + h * 256 + 4 * lane);
            u32x2* op = (u32x2*)(Zb + (size_t)(tokl + t) * ZLD + ZC_O + h * 256 + 4 * lane); const u32x2 og = *op;
            u32x2 w; w.x = pk2(dx.x * rstd * gg.x * bflo(og.x), dx.y * rstd * gg.y * bfhi(og.x)); w.y = pk2(dx.z * rstd * gg.z * bflo(og.y), dx.w * rstd * gg.w * bfhi(og.y)); *op = w; }
        __syncthreads();
    }
}

__device__ __forceinline__ void sgu_phase(const Args& a, int l, unsigned char* ws, LAS unsigned char* lds, int G, int cu, int tid, int wave, int lane) {
    bf16* Zb = (bf16*)(ws + WS_Z); const bf16* ZT = (const bf16*)(ws + WS_ZT); const bf16* Wc = (const bf16*)(ws + WS_WSGU);
    const float* lng = a.in[I_SLNG] + (size_t)l * 1024; const float* lnb = a.in[I_SLNB] + (size_t)l * 1024; const float* bs = a.in[I_SBS] + (size_t)l * 4 * 128;
    LAS bf16* VT = (LAS bf16*)lds;
    LAS float* PS = (LAS float*)(lds + 69632);
    LAS float* ST = (LAS float*)(lds + 69632 + 4096);
    for (int u = cu; u < 4 * 32 * 4; u += G) {
        const int g = u & 3, cc = (u >> 2) & 31, bl = u >> 7; const int tokl = bl * SEQ + cc * 128;
#pragma unroll
        for (int rep = 0; rep < 8; ++rep) { const int idx = tid + rep * NTHR, d = idx >> 4, c8 = idx & 15;
            *(LAS u32x4*)(VT + d * 136 + c8 * 8) = *(const u32x4*)(ZT + (size_t)(1024 + g * 256 + d) * ZTLD + tokl + c8 * 8); }
        __syncthreads();
        { const int s = tid & 127, part = tid >> 7; float sm = 0.f, sq = 0.f;
#pragma unroll 8
            for (int d = part * 64; d < part * 64 + 64; ++d) { const float x = bf1(VT[d * 136 + s]); sm += x; sq += x * x; }
            PS[(part * 128 + s) * 2] = sm; PS[(part * 128 + s) * 2 + 1] = sq; }
        __syncthreads();
        if (tid < 128) { float sm = 0.f, sq = 0.f;
#pragma unroll
            for (int p = 0; p < 4; ++p) { sm += PS[(p * 128 + tid) * 2]; sq += PS[(p * 128 + tid) * 2 + 1]; }
            const float mean = sm * (1.f / 256.f); const float var = fmaxf(sq * (1.f / 256.f) - mean * mean, 0.f); ST[tid] = mean; ST[128 + tid] = rsqrtf(var + EPS); }
        __syncthreads();
#pragma unroll
        for (int rep = 0; rep < 8; ++rep) { const int idx = tid + rep * NTHR, d = idx >> 4, c8 = idx & 15; const float gg = lng[g * 256 + d], bb = lnb[g * 256 + d];
            u32x4 x = *(const LAS u32x4*)(VT + d * 136 + c8 * 8); const LAS float* mp = ST + c8 * 8; const LAS float* rp = ST + 128 + c8 * 8;
            x.x = pk2((bflo(x.x) - mp[0]) * rp[0] * gg + bb, (bfhi(x.x) - mp[1]) * rp[1] * gg + bb); x.y = pk2((bflo(x.y) - mp[2]) * rp[2] * gg + bb, (bfhi(x.y) - mp[3]) * rp[3] * gg + bb);
            x.z = pk2((bflo(x.z) - mp[4]) * rp[4] * gg + bb, (bfhi(x.z) - mp[5]) * rp[5] * gg + bb); x.w = pk2((bflo(x.w) - mp[6]) * rp[6] * gg + bb, (bfhi(x.w) - mp[7]) * rp[7] * gg + bb);
            *(LAS u32x4*)(VT + d * 136 + c8 * 8) = x; }
        __syncthreads();
        {
            const int r = lane & 31, hh = lane >> 5, d0 = 32 * wave;
            f32x16 acc[4];
#pragma unroll
            for (int tb = 0; tb < 4; ++tb)
#pragma unroll
                for (int e = 0; e < 16; ++e) acc[tb][e] = 0.f;
#pragma unroll
            for (int ks = 0; ks < 8; ++ks) { const bf16x8 af = *(const LAS bf16x8*)(VT + (d0 + r) * 136 + 16 * ks + 8 * hh);
#pragma unroll
                for (int tb = 0; tb < 4; ++tb) if (16 * ks <= 32 * tb + 31) { const bf16x8 bfv = *(const bf16x8*)(Wc + (size_t)(g * 128 + 32 * tb + r) * 128 + 16 * ks + 8 * hh);
                    acc[tb] = __builtin_amdgcn_mfma_f32_32x32x16_bf16(af, bfv, acc[tb], 0, 0, 0); } }
#pragma unroll
            for (int tb = 0; tb < 4; ++tb) { const int t = 32 * tb + r; const float bias = bs[g * 128 + t]; bf16* rowp = Zb + (size_t)(tokl + t) * ZLD + ZC_U + g * 256 + d0 + 4 * hh;
#pragma unroll
                for (int q = 0; q < 4; ++q) { u32x2* op = (u32x2*)(rowp + 8 * q); const u32x2 uu = *op; u32x2 w;
                    w.x = pk2(bflo(uu.x) * (acc[tb][4 * q] + bias), bfhi(uu.x) * (acc[tb][4 * q + 1] + bias)); w.y = pk2(bflo(uu.y) * (acc[tb][4 * q + 2] + bias), bfhi(uu.y) * (acc[tb][4 * q + 3] + bias)); *op = w; } }
        }
        __syncthreads();
    }
}

__device__ __forceinline__ void softmax_rows(unsigned char* ws, int gw, int NGW, int lane) {
    bf16* Zb = (bf16*)(ws + WS_Z);
    for (int m = gw; m < MH; m += NGW) {
        u32x4* p = (u32x4*)(Zb + (size_t)m * ZLD + ZC_XQ + 16 * lane); const u32x4 x0 = p[0], x1 = p[1];
        float v[16] = { bflo(x0.x), bfhi(x0.x), bflo(x0.y), bfhi(x0.y), bflo(x0.z), bfhi(x0.z), bflo(x0.w), bfhi(x0.w), bflo(x1.x), bfhi(x1.x), bflo(x1.y), bfhi(x1.y), bflo(x1.z), bfhi(x1.z), bflo(x1.w), bfhi(x1.w) };
        float mx = v[0];
#pragma unroll
        for (int e = 1; e < 16; ++e) mx = fmaxf(mx, v[e]);
#pragma unroll
        for (int o = 1; o < 16; o <<= 1) mx = fmaxf(mx, __shfl_xor(mx, o));
        float s = 0.f;
#pragma unroll
        for (int e = 0; e < 16; ++e) { v[e] = __expf(v[e] - mx); s += v[e]; }
#pragma unroll
        for (int o = 1; o < 16; o <<= 1) s += __shfl_xor(s, o);
        const float inv = 1.f / s;
        u32x4 y0, y1; y0.x = pk2(v[0] * inv, v[1] * inv); y0.y = pk2(v[2] * inv, v[3] * inv); y0.z = pk2(v[4] * inv, v[5] * inv); y0.w = pk2(v[6] * inv, v[7] * inv);
        y1.x = pk2(v[8] * inv, v[9] * inv); y1.y = pk2(v[10] * inv, v[11] * inv); y1.z = pk2(v[12] * inv, v[13] * inv); y1.w = pk2(v[14] * inv, v[15] * inv);
        p[0] = y0; p[1] = y1;
    }
}

__global__ void __launch_bounds__(NTHR, 2) trunk_fwd(Args args) {
    extern __shared__ __attribute__((aligned(16))) unsigned char lds_raw[];
    LAS unsigned char* lds = (LAS unsigned char*)lds_raw;
    volatile LAS unsigned* MISC = (volatile LAS unsigned*)(lds + MISC_OFF);
    const int G = gridDim.x, cu = blockIdx.x;
    unsigned char* ws = args.ws;
#define PHASE_IDS() int tid = threadIdx.x; asm volatile("" : "+v"(tid)); const int lane = tid & 63, wave = __builtin_amdgcn_readfirstlane(tid >> 6); \
    const int vcu = (G % 8 == 0) ? (cu % 8) * (G / 8) + cu / 8 : cu; const int gw = vcu * NWAVES + wave, NGW = G * NWAVES, gtid = cu * NTHR + tid, GT = G * NTHR; (void)gw; (void)NGW; (void)gtid; (void)GT; (void)lane
    for (int u = threadIdx.x; u < (LDS_BYTES - RING_BYTES) / 4; u += NTHR) ((LAS unsigned*)(lds + RING_BYTES))[u] = 0u;
    __syncthreads();
    XcdBarrier bar = xcd_barrier_post((unsigned*)(ws + WS_CTL) + 4096, MISC + 8);
    const int lo = args.ph_lo, hi = args.ph_hi;
    int ph = 0;
#define IN() (lo <= ph && ph < hi)
#define SEAM() do { if (lo <= ph && ph + 1 < hi) xcd_barrier(bar); ++ph; } while (0)
    bf16* XN = (bf16*)(ws + WS_XN); bf16* Wb = (bf16*)(ws + WS_W);
    float* hbuf = args.out;

    if (IN()) { PHASE_IDS();
        convert_layer(args, 0, ws, lds, gw, NGW, wave, lane, gtid, GT);
        thin_rows(nullptr, 0, args.in[I_X], nullptr, nullptr, 0.f, args.in[I_NORMG], XN, 0, M, gw, NGW, lane, false, nullptr, nullptr, nullptr, nullptr, nullptr);
        __syncthreads();
    }
    SEAM();

    for (int sb = 0; sb < 2 * DEPTH; ++sb) {
        const int l = sb >> 1, j = sb & 1;
        const float* ng = args.in[I_NORMG] + (size_t)l * NNORM * D;
        if (IN()) { PHASE_IDS();
            pg8::Gemm g{D, D, D}; pg8::TileSched S; S.init(M / 256, 2 * DFF / 256, G, cu, XN, D * 2, (char*)Wb + (j ? WO_GU1 : WO_GU0), D * 2);
            pg8::EpiGU E{(bf16*)(ws + WS_HID)};
            pg8::gemm_phase(lds, g, S, E, tid);
        }
        SEAM();
        if (IN()) { PHASE_IDS();
            pg8::Gemm g{DFF, DFF, DFF}; pg8::TileSched S; S.init(M / 256, D / 256, G, cu, ws + WS_HID, DFF * 2, (char*)Wb + (j ? WO_D1 : WO_D0), DFF * 2);
            pg8::EpiAct E{(bf16*)(ws + WS_F), (size_t)D, 0};
            pg8::gemm_phase(lds, g, S, E, tid);
        }
        SEAM();
        if (IN()) { PHASE_IDS();
            const float* hin = (sb == 0) ? args.in[I_X] : hbuf;
            if (j == 0) {
                LAS float* wif = (LAS float*)lds;
                const float* win = args.in[I_WIN] + (size_t)l * D * WIN_COLS;
                for (int e = tid; e < D * 8; e += NTHR) wif[e] = win[(size_t)(e >> 3) * WIN_COLS + 3072 + (e & 7)];
                __syncthreads();
                float* gi = (float*)(ws + WS_GATE);
                thin_rows((const bf16*)(ws + WS_F), D, hin, hbuf, ng + 1 * D, 0.5f, ng + 2 * D, XN, 0, M, gw, NGW, lane, true, wif, args.in[I_BI] + l * 4, args.in[I_BF] + l * 4, gi, gi + (size_t)M * 4);
                __syncthreads();
                {
                    pg8::Gemm g{D, D, D};
                    pg8::TileSched S; S.init(MMEM / 256, D / 256, G, cu, ws + WS_MEMN, D * 2, (char*)Wb + WO_MKV, D * 2);
                    pg8::EpiAct E{(bf16*)(ws + WS_KMEM), (size_t)D, 0};
                    pg8::gemm_phase(lds, g, S, E, tid);
                    pg8::TileSched S2; S2.init(D / 256, MMEM / 256, G, (cu + G / 2) % G, (char*)Wb + WO_MKV + (size_t)D * D * 2, D * 2, ws + WS_MEMN, D * 2);
                    pg8::EpiAct E2{(bf16*)(ws + WS_VTMEM), (size_t)MMEM, 0};
                    pg8::gemm_phase(lds, g, S2, E2, tid);
                }
            } else {
                const float* gnext = (l + 1 < DEPTH) ? args.in[I_NORMG] + (size_t)(l + 1) * NNORM * D : nullptr;
                thin_rows((const bf16*)(ws + WS_F), D, hin, hbuf, ng + 5 * D, 0.5f, gnext, XN, 0, M, gw, NGW, lane, false, nullptr, nullptr, nullptr, nullptr, nullptr);
                if (l + 1 < DEPTH) { __syncthreads(); convert_layer(args, l + 1, ws, lds, gw, NGW, wave, lane, gtid, GT); __syncthreads(); }
            }
        }
        SEAM();
        if (j == 0) {
            for (int hf = 0; hf < 2; ++hf) {
                bf16* Zb = (bf16*)(ws + WS_Z);
                if (IN()) { PHASE_IDS();
                    pg8::Gemm g{D, D, D};
                    pg8::TileSched S; S.init(MH / 256, ZLD / 256, G, cu, XN + (size_t)hf * MH * D, D * 2, (char*)Wb + WO_IN, D * 2);
                    pg8::EpiAct E{Zb, (size_t)ZLD, 1};
                    pg8::gemm_phase(lds, g, S, E, tid);
                    pg8::TileSched S2; S2.init(2048 / 256, MH / 256, G, cu, (char*)Wb + WO_IN + (size_t)ZLD * D * 2, D * 2, XN + (size_t)hf * MH * D, D * 2);
                    pg8::EpiAct E2{(bf16*)(ws + WS_ZT), (size_t)ZTLD, 2};
                    pg8::gemm_phase(lds, g, S2, E2, tid);
                }
                SEAM();
                if (IN()) { PHASE_IDS();
                    mlstm_s1(args, l, hf, ws, lds, G, cu, tid, wave, lane);
                    sgu_phase(args, l, ws, lds, G, cu, tid, wave, lane);
                    pg8::Gemm g{256, ZLD, D};
                    pg8::TileSched S; S.init(MH / 256, 4, G, cu, Zb + ZC_XQ, ZLD * 2, (bf16*)(ws + WS_KMEM) + (size_t)hf * 4 * MEMLEN * D, 0);
                    S.a_pn = 512; S.b_tile = 512; S.pm_per_b = 16; S.b_batch = (size_t)MEMLEN * D * 2;
                    pg8::EpiAct E{Zb + ZC_XQ, (size_t)ZLD, 0};
                    pg8::gemm_phase(lds, g, S, E, tid);
                }
                SEAM();
                if (IN()) { PHASE_IDS();
                    mlstm_s2(ws, G, cu, tid);
                    softmax_rows(ws, gw, NGW, lane);
                }
                SEAM();
                if (IN()) { PHASE_IDS();
                    mlstm_s3(args, l, hf, ws, lds, G, cu, tid, wave, lane);
                    pg8::Gemm g{256, ZLD, MMEM};
                    pg8::TileSched S; S.init(MH / 256, 4, G, cu, Zb + ZC_XQ, ZLD * 2, (bf16*)(ws + WS_VTMEM) + (size_t)hf * 4 * MEMLEN, 0);
                    S.a_pn = 512; S.b_tile = (size_t)256 * MMEM * 2; S.pm_per_b = 16; S.b_batch = (size_t)MEMLEN * 2;
                    pg8::EpiAct E{Zb + ZC_XQ, (size_t)ZLD, 0};
                    pg8::gemm_phase(lds, g, S, E, tid);
                }
                SEAM();
                if (IN()) { PHASE_IDS();
                    pg8::Gemm g{D, ZLD, D};
                    pg8::TileSched S; S.init(MH / 256, D / 256, G, cu, Zb + ZC_O, ZLD * 2, (char*)Wb + WO_BR, D * 2);
                    S.reps = 3; S.a_rep = 1024 * 2; S.b_rep = (size_t)D * D * 2;
                    pg8::EpiBranch E{Zb};
                    pg8::gemm_phase(lds, g, S, E, tid);
                }
                SEAM();
                if (IN()) { PHASE_IDS();
                    pg8::Gemm g{D, ZLD, D};
                    pg8::TileSched S; S.init(MH / 256, D / 256, G, cu, Zb + ZC_QK, ZLD * 2, (char*)Wb + WO_OUT, D * 2);
                    pg8::EpiAct E{Zb + ZC_O, (size_t)ZLD, 0};
                    pg8::gemm_phase(lds, g, S, E, tid);
                }
                SEAM();
                if (IN()) { PHASE_IDS();
                    thin_rows(Zb + ZC_O, ZLD, hbuf, hbuf, ng + 3 * D, 1.0f, ng + 4 * D, XN, hf * MH, (hf + 1) * MH, gw, NGW, lane, false, nullptr, nullptr, nullptr, nullptr, nullptr);
                }
                SEAM();
            }
        }
    }
#undef IN
#undef SEAM
}
constexpr int N_PHASES = 1 + 2 * DEPTH * 3 + DEPTH * 2 * 7;

#ifndef N_LAUNCH_MODE
#define N_LAUNCH_MODE 0
#endif
extern "C" void kernel_launch(void* const* d_in, const int* in_sizes, int n_in, void* d_out, int out_size, void* d_ws, size_t ws_size, hipStream_t stream) {
    static int grid = 0;
    if (grid == 0) {
        if (n_in != 18 || out_size != M * D || ws_size < WS_END) { fprintf(stderr, "kernel_launch: unexpected shapes (n_in %d out %d ws %zu)\n", n_in, out_size, ws_size); grid = -1; return; }
        int dev = 0, cus = 0, per_cu = 0;
        if (hipGetDevice(&dev) != hipSuccess || hipDeviceGetAttribute(&cus, hipDeviceAttributeMultiprocessorCount, dev) != hipSuccess) { grid = -1; return; }
        if (hipFuncSetAttribute((const void*)trunk_fwd, hipFuncAttributeMaxDynamicSharedMemorySize, LDS_BYTES) != hipSuccess) { grid = -1; return; }
        if (hipOccupancyMaxActiveBlocksPerMultiprocessor(&per_cu, (const void*)trunk_fwd, NTHR, LDS_BYTES) != hipSuccess || per_cu < 1) { fprintf(stderr, "kernel_launch: occupancy query says %d\n", per_cu); }
        (void)hipGetLastError();
        grid = cus;
    }
    if (grid < 0) return;
    (void)hipMemsetAsync((char*)d_ws + WS_CTL, 0, CTL_ZERO_BYTES, stream);
    Args a{};
    for (int i = 0; i < 18; ++i) a.in[i] = (const float*)d_in[i];
    a.out = (float*)d_out; a.ws = (unsigned char*)d_ws;
#if N_LAUNCH_MODE == 0
    a.ph_lo = 0; a.ph_hi = N_PHASES;
    hipLaunchKernelGGL(trunk_fwd, dim3(grid), dim3(NTHR), LDS_BYTES, stream, a);
#else
    for (int p = 0; p < N_PHASES; ++p) { a.ph_lo = p; a.ph_hi = p + 1; hipLaunchKernelGGL(trunk_fwd, dim3(grid), dim3(NTHR), LDS_BYTES, stream, a); }
#endif
}
```

```cpp
#include <hip/hip_runtime.h>
#include <cstdio>
#include <cstdint>

#define LAS __attribute__((address_space(3)))
#define GAS __attribute__((address_space(1)))
typedef unsigned short bf16;
typedef short bf16x8 __attribute__((ext_vector_type(8)));
typedef float f32x4 __attribute__((ext_vector_type(4)));
typedef float f32x16 __attribute__((ext_vector_type(16)));
typedef unsigned u32x4 __attribute__((ext_vector_type(4)));
typedef unsigned u32x2 __attribute__((ext_vector_type(2)));

constexpr int D = 1024, BATCH = 8, SEQ = 4096, DEPTH = 2, MEMLEN = 256, DFF = 2816, NNORM = 7;
constexpr int M = BATCH * SEQ, MH = M / 2, MMEM = BATCH * MEMLEN;
constexpr int WIN_COLS = 9224;
constexpr int LCH = 64, NCH = SEQ / LCH;
constexpr int ZLD = 7168;
constexpr int ZC_QK = 0, ZC_O = 1024, ZC_U = 2048, ZC_XQ = 3072, ZC_G = 4096;
constexpr int ZTLD = MH;
constexpr float EPS = 1e-6f;
constexpr int NWAVES = 8, NTHR = 512;

constexpr size_t MiB = 1u << 20;
constexpr size_t WS_CTL = 0, CTL_ZERO_BYTES = 1 * MiB;
constexpr size_t WS_WSGU = 1 * MiB;
constexpr size_t WS_GATE = 2 * MiB;
constexpr size_t WS_NST = 3 * MiB;
constexpr size_t WS_CSC = 4 * MiB;
constexpr size_t WS_MEMN = 5 * MiB;
constexpr size_t WS_KMEM = 9 * MiB;
constexpr size_t WS_VTMEM = 13 * MiB;
constexpr size_t WS_W = 17 * MiB;
constexpr size_t WO_GU0 = 0, WO_GU1 = 11 * MiB, WO_D0 = 22 * MiB, WO_D1 = WO_D0 + 5632 * 1024, WO_IN = 33 * MiB, WO_MKV = 51 * MiB, WO_BR = 55 * MiB, WO_OUT = 61 * MiB;
constexpr size_t WS_XN = 80 * MiB;
constexpr size_t WS_BIG = 144 * MiB;
constexpr size_t WS_HID = WS_BIG, WS_F = WS_BIG + 176 * MiB, WS_Z = WS_BIG, WS_ZT = WS_BIG + 224 * MiB;
constexpr size_t WS_ST = 432 * MiB;
constexpr size_t WS_END = 496 * MiB;

constexpr int LDS_BYTES = 147456;
constexpr int RING_BYTES = 131072;
constexpr int MISC_OFF = RING_BYTES + 320;

typedef float f32x2_t __attribute__((ext_vector_type(2))); typedef __bf16 bf16x2_t __attribute__((ext_vector_type(2)));
__device__ __forceinline__ unsigned pk2(float lo, float hi) { f32x2_t v = {lo, hi}; bf16x2_t b = __builtin_convertvector(v, bf16x2_t); return __builtin_bit_cast(unsigned, b); }
__device__ __forceinline__ unsigned f2bf(float f) { return pk2(f, 0.f) & 0xffffu; }
__device__ __forceinline__ float bflo(unsigned w) { return __uint_as_float(w << 16); }
__device__ __forceinline__ float bfhi(unsigned w) { return __uint_as_float(w & 0xffff0000u); }
__device__ __forceinline__ float bf1(bf16 b) { return __uint_as_float((unsigned)b << 16); }
__device__ __forceinline__ float wave_sum(float v) {
#pragma unroll
    for (int o = 1; o < 64; o <<= 1) v += __shfl_xor(v, o);
    return v;
}
__device__ __forceinline__ float sigmoidf_(float x) { return __builtin_amdgcn_rcpf(1.f + __expf(-x)); }
__device__ __forceinline__ float siluf_(float x) { return x * __builtin_amdgcn_rcpf(1.f + __expf(-x)); }
__device__ __forceinline__ float gelu_tanh(float x) { const float u = 1.5957691216f * (x + 0.044715f * x * x * x); return x * __builtin_amdgcn_rcpf(1.f + __expf(-u)); }
__device__ __forceinline__ float logsigmoidf_(float x) { return fminf(x, 0.f) - log1pf(__expf(-fabsf(x))); }
#define LDS_WAIT() asm volatile("s_waitcnt lgkmcnt(0)" ::: "memory")
#define VM_WAIT() asm volatile("s_waitcnt vmcnt(0)" ::: "memory")

namespace pg8 {
constexpr int BM = 256, BK = 64, HALF = 128, HTB = HALF * BK * 2, STAGE_BYTES = 8 * HTB, NXCD = 8, WGM = 8;
__host__ __device__ __forceinline__ int lds_byte(int r, int c) { const int st = (r >> 4) * 2 + (c >> 5), rr = r & 15, cc = c & 31, ob = rr * 64 + cc * 2; return st * 1024 + (ob ^ (((ob >> 9) & 1) << 5)); }
__host__ __device__ __forceinline__ void stage_rc(int b, int& R, int& C) { const int st = b / 1024, sb = b % 1024, swz = sb ^ (((sb >> 9) & 1) << 5); R = (st >> 1) * 16 + swz / 64; C = (st & 1) * 32 + (swz % 64) / 2; }
__host__ __device__ __forceinline__ int perm32(int rho) { const int n = rho >> 4, i = rho & 15; return 8 * (i >> 2) + 4 * n + (i & 3); }

struct Unit { int pm, pn, aux; const char* a; const char* b; };
struct Gemm { int K, lda, ldb; };

struct TileSched {
    int nM, nN, nwg, G, c, reps, pm_per_b;
    const char* A; const char* B;
    size_t a_tile, a_pn, a_rep, b_tile, b_batch, b_rep;
    __device__ __forceinline__ void init(int nM_, int nN_, int G_, int c_, const void* A_, size_t lda_bytes, const void* B_, size_t ldb_bytes) {
        nM = nM_; nN = nN_; nwg = nM * nN; G = G_; c = c_; reps = 1; pm_per_b = 1 << 30; A = (const char*)A_; B = (const char*)B_;
        a_tile = 256 * lda_bytes; a_pn = 0; a_rep = 0; b_tile = 256 * ldb_bytes; b_batch = 0; b_rep = 0;
    }
    __device__ __forceinline__ bool next(int i, Unit& u) const {
        const int ti = i / reps, aux = i - ti * reps;
        const long L = (long)ti * G + c; if (L >= nwg) return false;
        int wgid = (int)L; { const int q = nwg / NXCD, r = nwg % NXCD, xcd = wgid % NXCD, off = wgid / NXCD; wgid = (xcd < r ? xcd * (q + 1) : r * (q + 1) + (xcd - r) * q) + off; }
        const int nig = WGM * nN, gid = wgid / nig, fm = gid * WGM, gsz = (nM - fm) < WGM ? (nM - fm) : WGM;
        u.pm = fm + ((wgid % nig) % gsz); u.pn = (wgid % nig) / gsz; u.aux = aux;
        u.a = A + (size_t)u.pm * a_tile + (size_t)u.pn * a_pn + (size_t)aux * a_rep;
        u.b = B + (size_t)u.pn * b_tile + (size_t)(u.pm / pm_per_b) * b_batch + (size_t)aux * b_rep;
        return true;
    }
};

__device__ __forceinline__ unsigned cvt_pk_bf16(float lo, float hi) { return pk2(lo, hi); }

template <int ACT> __device__ __forceinline__ float actf(float x) {
    if (ACT == 1) return sigmoidf_(x);
    if (ACT == 2) return gelu_tanh(x);
    if (ACT == 3) return x * 0.0625f;
    return x;
}
template <int ACT> __device__ __forceinline__ void store_tile_bf16(const f32x4 (&acc)[2][2][4][2], bf16* O, size_t ldc, int row0, int col0) {
#pragma unroll
    for (int ai = 0; ai < 2; ++ai)
#pragma unroll
        for (int m = 0; m < 4; ++m) { bf16* rowp = O + (size_t)(row0 + ai * HALF + m * 16) * ldc + col0;
#pragma unroll
            for (int bj = 0; bj < 2; ++bj) { const f32x4 v0 = acc[ai][bj][m][0], v1 = acc[ai][bj][m][1]; u32x4 w;
                w.x = cvt_pk_bf16(actf<ACT>(v0[0]), actf<ACT>(v0[1])); w.y = cvt_pk_bf16(actf<ACT>(v0[2]), actf<ACT>(v0[3]));
                w.z = cvt_pk_bf16(actf<ACT>(v1[0]), actf<ACT>(v1[1])); w.w = cvt_pk_bf16(actf<ACT>(v1[2]), actf<ACT>(v1[3]));
                *(u32x4*)(rowp + bj * HALF) = w; } }
}
struct EpiAct {
    static constexpr bool PERM = true;
    bf16* O; size_t ldc; int mode;
    __device__ __forceinline__ void operator()(const f32x4 (&acc)[2][2][4][2], const Unit& u, int wr, int wc, int fr, int fq) const {
        const int row0 = u.pm * BM + wr * 64 + fr, col0 = u.pn * BM + wc * 32 + 8 * fq;
        int act = 0;
        if (mode == 1) { const int g = u.pn >> 2; act = (g == 0) ? 0 : (g == 1) ? 1 : (g == 2) ? 2 : (g == 3) ? 3 : 1; }
        else if (mode == 2) act = (u.pm >= 4) ? 2 : 0;
        if (act == 0) store_tile_bf16<0>(acc, O, ldc, row0, col0);
        else if (act == 1) store_tile_bf16<1>(acc, O, ldc, row0, col0);
        else if (act == 2) store_tile_bf16<2>(acc, O, ldc, row0, col0);
        else store_tile_bf16<3>(acc, O, ldc, row0, col0);
    }
};
struct EpiGU {
    static constexpr bool PERM = true;
    bf16* O;
    __device__ __forceinline__ void operator()(const f32x4 (&acc)[2][2][4][2], const Unit& u, int wr, int wc, int fr, int fq) const {
        const int row0 = u.pm * BM + wr * 64 + fr, col0 = u.pn * HALF + wc * 32 + 8 * fq;
#pragma unroll
        for (int ai = 0; ai < 2; ++ai)
#pragma unroll
            for (int m = 0; m < 4; ++m) { bf16* rowp = O + (size_t)(row0 + ai * HALF + m * 16) * DFF + col0;
                const f32x4 g0 = acc[ai][0][m][0], g1 = acc[ai][0][m][1], u0 = acc[ai][1][m][0], u1 = acc[ai][1][m][1]; u32x4 w;
                w.x = cvt_pk_bf16(siluf_(g0[0]) * u0[0], siluf_(g0[1]) * u0[1]); w.y = cvt_pk_bf16(siluf_(g0[2]) * u0[2], siluf_(g0[3]) * u0[3]);
                w.z = cvt_pk_bf16(siluf_(g1[0]) * u1[0], siluf_(g1[1]) * u1[1]); w.w = cvt_pk_bf16(siluf_(g1[2]) * u1[2], siluf_(g1[3]) * u1[3]);
                *(u32x4*)rowp = w; }
    }
};
struct EpiBranch {
    static constexpr bool PERM = true;
    bf16* Zb;
    __device__ __forceinline__ void operator()(const f32x4 (&acc)[2][2][4][2], const Unit& u, int wr, int wc, int fr, int fq) const {
        const int row0 = u.pm * BM + wr * 64 + fr, col0 = u.pn * BM + wc * 32 + 8 * fq; const int j = u.aux;
#pragma unroll
        for (int ai = 0; ai < 2; ++ai)
#pragma unroll
            for (int m = 0; m < 4; ++m) { bf16* rowp = Zb + (size_t)(row0 + ai * HALF + m * 16) * ZLD + col0;
#pragma unroll
                for (int bj = 0; bj < 2; ++bj) { const f32x4 v0 = acc[ai][bj][m][0], v1 = acc[ai][bj][m][1];
                    const u32x4 g = *(const u32x4*)(rowp + ZC_G + j * 1024 + bj * HALF);
                    float o[8] = { v0[0] * bflo(g.x), v0[1] * bfhi(g.x), v0[2] * bflo(g.y), v0[3] * bfhi(g.y), v1[0] * bflo(g.z), v1[1] * bfhi(g.z), v1[2] * bflo(g.w), v1[3] * bfhi(g.w) };
                    if (j > 0) { const u32x4 p = *(const u32x4*)(rowp + ZC_QK + bj * HALF);
                        o[0] += bflo(p.x); o[1] += bfhi(p.x); o[2] += bflo(p.y); o[3] += bfhi(p.y); o[4] += bflo(p.z); o[5] += bfhi(p.z); o[6] += bflo(p.w); o[7] += bfhi(p.w); }
                    u32x4 w; w.x = cvt_pk_bf16(o[0], o[1]); w.y = cvt_pk_bf16(o[2], o[3]); w.z = cvt_pk_bf16(o[4], o[5]); w.w = cvt_pk_bf16(o[6], o[7]);
                    *(u32x4*)(rowp + ZC_QK + bj * HALF) = w; } }
    }
};

template <class Epi, class Sched>
__device__ __forceinline__ void gemm_phase(LAS unsigned char* lds, const Gemm g, const Sched& S, const Epi& E, const int tid) {
    const int wid = __builtin_amdgcn_readfirstlane(tid >> 6), lane = tid & 63, wr = wid >> 2, wc = wid & 3, fr = lane & 15, fq = lane >> 4;
    const int nt = g.K / BK;
    unsigned voffA[2], voffB[2];
#pragma unroll
    for (int i = 0; i < 2; ++i) { int R, C; stage_rc(tid * 16 + i * 8192, R, C); const int Rb = Epi::PERM ? ((R & ~31) + perm32(R & 31)) : R;
        voffA[i] = (unsigned)(R * g.lda + C) * 2u; voffB[i] = (unsigned)(Rb * g.ldb + C) * 2u; }
    const size_t kstep = (size_t)(BK * 2);
    const size_t hstepA = (size_t)HALF * g.lda * 2, hstepB = (size_t)HALF * g.ldb * 2;
    const unsigned ldsw = (unsigned)wid * 1024u;
    const int aoff = lds_byte(wr * 64 + fr, fq * 8), boff = lds_byte(wc * 32 + fr, fq * 8);
#define PG8_SA(b, h) (((b) * 2 + (h)) * HTB)
#define PG8_SB(b, h) ((4 + (b) * 2 + (h)) * HTB)
#define PG8_STAGE(bufoff, gbase, voff) do { _Pragma("unroll") for (int _i = 0; _i < 2; ++_i) \
        __builtin_amdgcn_global_load_lds((const unsigned*)((const char*)(gbase) + (voff)[_i]), (LAS unsigned*)(lds + (bufoff) + ldsw + _i * 8192), 16, 0, 0); } while (0)
#define PG8_LDA(dst, b, h) do { _Pragma("unroll") for (int m = 0; m < 4; ++m) _Pragma("unroll") for (int k = 0; k < 2; ++k) dst[m][k] = *(const LAS bf16x8*)(lds + PG8_SA(b, h) + aoff + m * 2048 + k * 1024); } while (0)
#define PG8_LDB(dst, b, h) do { _Pragma("unroll") for (int n = 0; n < 2; ++n) _Pragma("unroll") for (int k = 0; k < 2; ++k) dst[n][k] = *(const LAS bf16x8*)(lds + PG8_SB(b, h) + boff + n * 2048 + k * 1024); } while (0)
#define PG8_MMA(ai, bj, At, Bt) do { __builtin_amdgcn_s_setprio(1); _Pragma("unroll") for (int m = 0; m < 4; ++m) _Pragma("unroll") for (int n = 0; n < 2; ++n) _Pragma("unroll") for (int k = 0; k < 2; ++k) \
        acc[ai][bj][m][n] = __builtin_amdgcn_mfma_f32_16x16x32_bf16(Bt[n][k], At[m][k], acc[ai][bj][m][n], 0, 0, 0); __builtin_amdgcn_s_setprio(0); } while (0)
#define PG8_WAIT_V(n) asm volatile("s_waitcnt vmcnt(" #n ")" ::: "memory")
#define PG8_WAIT_L(n) asm volatile("s_waitcnt lgkmcnt(" #n ")" ::: "memory")
#define PG8_BAR __builtin_amdgcn_s_barrier()
#define PG8_SCHED __builtin_amdgcn_sched_barrier(0)
    Unit cur, nxt; int ui = 0;
    if (!S.next(0, cur)) return;
    f32x4 acc[2][2][4][2];
#pragma unroll
    for (int a = 0; a < 2; ++a)
#pragma unroll
        for (int b = 0; b < 2; ++b)
#pragma unroll
            for (int m = 0; m < 4; ++m)
#pragma unroll
                for (int n = 0; n < 2; ++n) acc[a][b][m][n] = (f32x4){0.f, 0.f, 0.f, 0.f};
    bf16x8 At[4][2], B0[2][2], B1[2][2];
    const char* cA = cur.a; const char* cB = cur.b;
    PG8_STAGE(PG8_SB(0, 0), cB, voffB); PG8_STAGE(PG8_SB(0, 1), cB + hstepB, voffB); PG8_STAGE(PG8_SA(0, 0), cA, voffA); PG8_STAGE(PG8_SA(0, 1), cA + hstepA, voffA);
    if (wr == 1) PG8_BAR;
    PG8_WAIT_V(2); PG8_BAR;
    PG8_STAGE(PG8_SB(1, 0), cB + kstep, voffB); PG8_STAGE(PG8_SA(1, 0), cA + kstep, voffA); PG8_STAGE(PG8_SB(1, 1), cB + hstepB + kstep, voffB);
    PG8_WAIT_V(6); PG8_BAR;
    for (;;) {
        const bool has_next = S.next(ui + 1, nxt);
        const char* nA = has_next ? nxt.a : cA; const char* nB = has_next ? nxt.b : cB;
        for (int t = 0; t < nt; t += 2) {
            const bool last = (t == nt - 2);
            const char* a1 = cA + (size_t)(t + 1) * kstep;
            const char* a2 = last ? nA : cA + (size_t)(t + 2) * kstep; const char* b2 = last ? nB : cB + (size_t)(t + 2) * kstep;
            const char* a3 = a2 + kstep; const char* b3 = b2 + kstep;
            PG8_LDB(B0, 0, 0); PG8_LDB(B1, 0, 1); PG8_SCHED; PG8_LDA(At, 0, 0); PG8_STAGE(PG8_SA(1, 1), a1 + hstepA, voffA);
            PG8_WAIT_V(8); PG8_WAIT_L(0); PG8_BAR; PG8_MMA(0, 0, At, B0); PG8_MMA(0, 1, At, B1); PG8_BAR; PG8_SCHED;
            PG8_LDA(At, 0, 1); PG8_STAGE(PG8_SB(0, 0), b2, voffB); PG8_STAGE(PG8_SB(0, 1), b2 + hstepB, voffB); PG8_STAGE(PG8_SA(0, 0), a2, voffA);
            PG8_WAIT_V(8); PG8_WAIT_L(0); PG8_BAR; PG8_MMA(1, 0, At, B0); PG8_MMA(1, 1, At, B1); PG8_BAR; PG8_SCHED;
            PG8_LDB(B0, 1, 0); PG8_LDB(B1, 1, 1); PG8_SCHED; PG8_LDA(At, 1, 0); PG8_STAGE(PG8_SA(0, 1), a2 + hstepA, voffA);
            PG8_WAIT_V(8); PG8_WAIT_L(0); PG8_BAR; PG8_MMA(0, 0, At, B0); PG8_MMA(0, 1, At, B1); PG8_BAR; PG8_SCHED;
            PG8_LDA(At, 1, 1); PG8_STAGE(PG8_SB(1, 0), b3, voffB); PG8_STAGE(PG8_SB(1, 1), b3 + hstepB, voffB); PG8_STAGE(PG8_SA(1, 0), a3, voffA);
            PG8_WAIT_V(8); PG8_WAIT_L(0); PG8_BAR; PG8_MMA(1, 0, At, B0); PG8_MMA(1, 1, At, B1); PG8_BAR; PG8_SCHED;
        }
        if (wr == 0) PG8_BAR;
        E(acc, cur, wr, wc, fr, fq);
        if (!has_next) break;
#pragma unroll
        for (int a = 0; a < 2; ++a)
#pragma unroll
            for (int b = 0; b < 2; ++b)
#pragma unroll
                for (int m = 0; m < 4; ++m)
#pragma unroll
                    for (int n = 0; n < 2; ++n) acc[a][b][m][n] = (f32x4){0.f, 0.f, 0.f, 0.f};
        cur = nxt; cA = nA; cB = nB; ++ui;
        if (wr == 1) PG8_BAR;
    }
    PG8_WAIT_V(0);
    PG8_BAR;
#undef PG8_SA
#undef PG8_SB
#undef PG8_STAGE
#undef PG8_LDA
#undef PG8_LDB
#undef PG8_MMA
#undef PG8_WAIT_V
#undef PG8_WAIT_L
#undef PG8_BAR
#undef PG8_SCHED
}
}

#define XB_TMO      128
#define XB_XCNT(j)  (256  + 64 * (j))
#define XB_XSUB(j)  (1280 + 64 * (j))
#define XB_XGEN(j)  (2304 + 64 * (j))
#define XB_TOP      3328
#define XB_TOPGEN   3392
#define XCD_BAR_WORDS 3456
#define XB_SPIN_CAP (1u << 18)
__device__ __forceinline__ unsigned xb_ld(unsigned* p)              { return __hip_atomic_load(p, __ATOMIC_RELAXED, __HIP_MEMORY_SCOPE_AGENT); }
__device__ __forceinline__ unsigned xb_add(unsigned* p, unsigned v) { return __hip_atomic_fetch_add(p, v, __ATOMIC_RELAXED, __HIP_MEMORY_SCOPE_AGENT); }
__device__ __forceinline__ unsigned xb_xcc_id() { return (unsigned)__builtin_amdgcn_s_getreg((3 << 11) | 20) & 0xFu; }
#define XB_SPIN(cond, bar) do { unsigned _sp = 0; while (cond) { __builtin_amdgcn_s_sleep(1); \
    if ((++_sp & 255u) == 0u) { if (xb_ld(&(bar)[XB_TMO])) break; if (_sp > XB_SPIN_CAP) { atomicAdd(&(bar)[XB_TMO], 1u); break; } } } } while (0)
struct XcdBarrier { unsigned* bar; unsigned x; volatile LAS unsigned* st; };
__device__ __forceinline__ XcdBarrier xcd_barrier_post(unsigned* bar, volatile LAS unsigned* st) {
    XcdBarrier b; b.bar = bar; b.x = xb_xcc_id(); b.st = st;
    if (threadIdx.x == 0) (void)xb_add(&bar[XB_XCNT(b.x)], 1u);
    return b;
}
__device__ __forceinline__ void xcd_barrier_complete(unsigned* bar, unsigned x, unsigned& nloc, unsigned& nx) {
    const unsigned G = gridDim.x * gridDim.y * gridDim.z;
    unsigned sum, cnt, mine, sp = 0u;
    for (;;) {
        sum = 0u; cnt = 0u; mine = 0u;
#pragma unroll
        for (unsigned j = 0; j < 16; ++j) { const unsigned c = xb_ld(&bar[XB_XCNT(j)]); sum += c; cnt += (c > 0u) ? 1u : 0u; mine = (j == x) ? c : mine; }
        if (sum == G) break;
        __builtin_amdgcn_s_sleep(1);
        if ((++sp & 255u) == 0u) { if (xb_ld(&bar[XB_TMO])) break; if (sp > XB_SPIN_CAP) { atomicAdd(&bar[XB_TMO], 1u); break; } }
    }
    nloc = mine > 0u ? mine : 1u; nx = cnt > 0u ? cnt : 1u;
}
__device__ __forceinline__ void xcd_barrier(const XcdBarrier& b) {
    asm volatile("s_waitcnt vmcnt(0)" ::: "memory");
    __syncthreads();
    if (threadIdx.x == 0) {
        unsigned* bar = b.bar;
        __builtin_amdgcn_s_waitcnt(0);
        unsigned nloc = b.st[0], nx = b.st[1];
        if (nloc == 0u) { xcd_barrier_complete(bar, b.x, nloc, nx); b.st[0] = nloc; b.st[1] = nx; }
        const unsigned old = xb_add(&bar[XB_XSUB(b.x)], 1u);
        const unsigned gen = old / nloc;
        if (old + 1u == (gen + 1u) * nloc) {
            __builtin_amdgcn_fence(__ATOMIC_RELEASE, "agent");
            asm volatile("s_waitcnt vmcnt(0)" ::: "memory");
            const unsigned og = xb_add(&bar[XB_TOP], 1u);
            const unsigned tg = og / nx;
            if (og + 1u == (tg + 1u) * nx) xb_add(&bar[XB_TOPGEN], 1u);
            else XB_SPIN(xb_ld(&bar[XB_TOPGEN]) == tg, bar);
            __builtin_amdgcn_fence(__ATOMIC_ACQUIRE, "agent");
            xb_add(&bar[XB_XGEN(b.x)], 1u);
            asm volatile("s_waitcnt vmcnt(0)" ::: "memory");
        } else {
            XB_SPIN(xb_ld(&bar[XB_XGEN(b.x)]) == gen, bar);
            __builtin_amdgcn_fence(__ATOMIC_ACQUIRE, "agent");
            asm volatile("s_waitcnt vmcnt(0)" ::: "memory");
        }
    }
    __syncthreads();
}

struct Args { const float* in[18]; float* out; unsigned char* ws; int ph_lo, ph_hi; };
enum { I_X = 0, I_MEM, I_NORMG, I_WGU, I_WDOWN, I_WIN, I_CONVW, I_CONVB, I_BI, I_BF, I_MNORM, I_SLNG, I_SLNB, I_SWS, I_SBS, I_WMKV, I_WBR, I_WOUT };

__device__ __forceinline__ void cvt_item(const float* W, int Nsrc, int K, int srccol, bf16* WT, int dstrow, int kb, LAS float* scr, int lane) {
    const int k0 = 64 * kb;
#pragma unroll 8
    for (int i = 0; i < 32; ++i) { const int kk = 2 * i + (lane >> 5); scr[kk * 33 + (lane & 31)] = W[(size_t)(k0 + kk) * Nsrc + srccol + (lane & 31)]; }
    LDS_WAIT(); asm volatile("" ::: "memory");
    const int c = lane & 7;
#pragma unroll
    for (int j = 0; j < 4; ++j) { const int n = (lane >> 3) + 8 * j; const LAS float* s = scr + (8 * c) * 33 + n;
        u32x4 o; o.x = pk2(s[0 * 33], s[1 * 33]); o.y = pk2(s[2 * 33], s[3 * 33]); o.z = pk2(s[4 * 33], s[5 * 33]); o.w = pk2(s[6 * 33], s[7 * 33]);
        *(u32x4*)(WT + (size_t)(dstrow + n) * K + k0 + 8 * c) = o; }
    LDS_WAIT(); asm volatile("" ::: "memory");
}
__device__ __forceinline__ int win_srccol(int r) {
    if (r < 1024) return r;
    if (r < 2048) return 2048 + (r - 1024);
    if (r < 3072) return 3080 + (r - 2048);
    if (r < 4096) return 5128 + (r - 3072);
    if (r < 7168) return 6152 + (r - 4096);
    if (r < 8192) return 1024 + (r - 7168);
    return 4104 + (r - 8192);
}
__device__ __forceinline__ void convert_layer(const Args& a, int l, unsigned char* ws, LAS unsigned char* lds, int gw, int NGW, int wave, int lane, int gtid, int GT) {
    LAS float* scr = (LAS float*)(lds + wave * 16384);
    bf16* Wb = (bf16*)(ws + WS_W);
    constexpr int I_GU = 16 * 176, I_DN = 44 * 32, I_IN = 16 * 288, I_MKV = 16 * 64, I_BR = 16 * 32, I_OUT = 16 * 32;
    constexpr int NITEMS = 2 * I_GU + 2 * I_DN + I_IN + I_MKV + 3 * I_BR + I_OUT;
    for (int it = gw; it < NITEMS; it += NGW) {
        int r = it;
        if (r < 2 * I_GU) { const int j = r / I_GU; r -= j * I_GU; const int kb = r / 176, nb = r % 176; const int p = nb >> 3, q = nb & 7, s = q >> 2, jj = (q & 3) * 32;
            cvt_item(a.in[I_WGU] + (size_t)(l * 2 + j) * D * 2 * DFF, 2 * DFF, D, s * DFF + 128 * p + jj, (bf16*)((char*)Wb + (j ? WO_GU1 : WO_GU0)), nb * 32, kb, scr, lane); continue; }
        r -= 2 * I_GU;
        if (r < 2 * I_DN) { const int j = r / I_DN; r -= j * I_DN; const int kb = r / 32, nb = r % 32;
            cvt_item(a.in[I_WDOWN] + (size_t)(l * 2 + j) * DFF * D, D, DFF, nb * 32, (bf16*)((char*)Wb + (j ? WO_D1 : WO_D0)), nb * 32, kb, scr, lane); continue; }
        r -= 2 * I_DN;
        if (r < I_IN) { const int kb = r / 288, nb = r % 288;
            cvt_item(a.in[I_WIN] + (size_t)l * D * WIN_COLS, WIN_COLS, D, win_srccol(nb * 32), (bf16*)((char*)Wb + WO_IN), nb * 32, kb, scr, lane); continue; }
        r -= I_IN;
        if (r < I_MKV) { const int kb = r / 64, nb = r % 64;
            cvt_item(a.in[I_WMKV] + (size_t)l * D * 2048, 2048, D, nb * 32, (bf16*)((char*)Wb + WO_MKV), nb * 32, kb, scr, lane); continue; }
        r -= I_MKV;
        if (r < 3 * I_BR) { const int j = r / I_BR; r -= j * I_BR; const int kb = r / 32, nb = r % 32;
            cvt_item(a.in[I_WBR] + (size_t)(l * 3 + j) * D * D, D, D, nb * 32, (bf16*)((char*)Wb + WO_BR) + (size_t)j * D * D, nb * 32, kb, scr, lane); continue; }
        r -= 3 * I_BR;
        { const int kb = r / 32, nb = r % 32; cvt_item(a.in[I_WOUT] + (size_t)l * D * D, D, D, nb * 32, (bf16*)((char*)Wb + WO_OUT), nb * 32, kb, scr, lane); }
    }
    bf16* wsg = (bf16*)(ws + WS_WSGU); const float* src = a.in[I_SWS] + (size_t)l * 4 * 128 * 128;
    for (int e = gtid; e < 4 * 128 * 128; e += GT) { const int t = (e >> 7) & 127, s = e & 127; wsg[e] = (bf16)f2bf(s <= t ? src[e] : 0.f); }
    const float* g6 = a.in[I_NORMG] + (size_t)(l * NNORM + 6) * D;
    for (int m = gw; m < MMEM; m += NGW) {
        const f32x4* xr = (const f32x4*)(a.in[I_MEM] + (size_t)m * D) + lane; f32x4 v[4]; float s = 0.f;
#pragma unroll
        for (int j = 0; j < 4; ++j) { v[j] = xr[64 * j]; s += (v[j].x * v[j].x + v[j].y * v[j].y) + (v[j].z * v[j].z + v[j].w * v[j].w); }
        const float rstd = rsqrtf(wave_sum(s) * (1.f / D) + EPS);
        unsigned long long* o8 = (unsigned long long*)((bf16*)(ws + WS_MEMN) + (size_t)m * D) + lane;
#pragma unroll
        for (int j = 0; j < 4; ++j) { const f32x4 gg = ((const f32x4*)g6)[lane + 64 * j];
            o8[64 * j] = (unsigned long long)pk2(v[j].x * rstd * gg.x, v[j].y * rstd * gg.y) | ((unsigned long long)pk2(v[j].z * rstd * gg.z, v[j].w * rstd * gg.w) << 32); }
    }
}

__device__ __forceinline__ void thin_rows(const bf16* fbase, size_t fld, const float* hin, float* hout, const float* ga, float scale, const float* gb, bf16* xn,
                                          int row_lo, int row_hi, int gw, int NGW, int lane, const bool do_gates, const LAS float* wif, const float* bi, const float* bfg, float* gate_i, float* gate_f) {
    for (int m = row_lo + gw; m < row_hi; m += NGW) {
        f32x4 v[4];
        if (fbase) {
            const unsigned long long* fr = (const unsigned long long*)(fbase + (size_t)(m - row_lo) * fld) + lane; float s = 0.f; f32x4 f[4];
#pragma unroll
            for (int j = 0; j < 4; ++j) { const unsigned long long w = fr[64 * j]; const unsigned lo = (unsigned)w, hi = (unsigned)(w >> 32);
                f[j] = (f32x4){bflo(lo), bfhi(lo), bflo(hi), bfhi(hi)}; s += (f[j].x * f[j].x + f[j].y * f[j].y) + (f[j].z * f[j].z + f[j].w * f[j].w); }
            const float rstd = rsqrtf(wave_sum(s) * (1.f / D) + EPS) * scale;
            const f32x4* hr = (const f32x4*)(hin + (size_t)m * D) + lane; f32x4* ho = (f32x4*)(hout + (size_t)m * D) + lane;
#pragma unroll
            for (int j = 0; j < 4; ++j) { const f32x4 gg = ((const f32x4*)ga)[lane + 64 * j]; v[j] = hr[64 * j] + f[j] * rstd * gg; ho[64 * j] = v[j]; }
        } else {
            const f32x4* hr = (const f32x4*)(hin + (size_t)m * D) + lane;
#pragma unroll
            for (int j = 0; j < 4; ++j) v[j] = hr[64 * j];
        }
        if (gb) {
            float s = 0.f;
#pragma unroll
            for (int j = 0; j < 4; ++j) s += (v[j].x * v[j].x + v[j].y * v[j].y) + (v[j].z * v[j].z + v[j].w * v[j].w);
            const float rstd = rsqrtf(wave_sum(s) * (1.f / D) + EPS);
            unsigned long long* o8 = (unsigned long long*)(xn + (size_t)m * D) + lane;
#pragma unroll
            for (int j = 0; j < 4; ++j) { const f32x4 gg = ((const f32x4*)gb)[lane + 64 * j]; v[j] = v[j] * rstd * gg;
                o8[64 * j] = (unsigned long long)pk2(v[j].x, v[j].y) | ((unsigned long long)pk2(v[j].z, v[j].w) << 32); }
            if (do_gates) {
                float acc[8];
#pragma unroll
                for (int e = 0; e < 8; ++e) acc[e] = 0.f;
#pragma unroll
                for (int j = 0; j < 4; ++j)
#pragma unroll
                    for (int q = 0; q < 4; ++q) { const int k = 4 * lane + 256 * j + q; const float xv = v[j][q]; const LAS f32x4* wp = (const LAS f32x4*)(wif + k * 8); const f32x4 w0 = wp[0], w1 = wp[1];
                        acc[0] += xv * w0.x; acc[1] += xv * w0.y; acc[2] += xv * w0.z; acc[3] += xv * w0.w; acc[4] += xv * w1.x; acc[5] += xv * w1.y; acc[6] += xv * w1.z; acc[7] += xv * w1.w; }
#pragma unroll
                for (int e = 0; e < 8; ++e) acc[e] = wave_sum(acc[e]);
                if (lane == 0) {
                    *(f32x4*)(gate_i + (size_t)m * 4) = (f32x4){acc[0] + bi[0], acc[1] + bi[1], acc[2] + bi[2], acc[3] + bi[3]};
                    *(f32x4*)(gate_f + (size_t)m * 4) = (f32x4){logsigmoidf_(acc[4] + bfg[0]), logsigmoidf_(acc[5] + bfg[1]), logsigmoidf_(acc[6] + bfg[2]), logsigmoidf_(acc[7] + bfg[3])};
                }
            }
        }
    }
}

__device__ __forceinline__ void conv8(const bf16* Zb, int bl, int p, int col, const float* cw, const float* cb, float (&o)[8]) {
    const f32x4 b0 = *(const f32x4*)(cb + col), b1 = *(const f32x4*)(cb + col + 4);
    o[0] = b0.x; o[1] = b0.y; o[2] = b0.z; o[3] = b0.w; o[4] = b1.x; o[5] = b1.y; o[6] = b1.z; o[7] = b1.w;
#pragma unroll
    for (int j = 0; j < 4; ++j) { const int pp = p - 3 + j;
        if (pp >= 0) { const u32x4 x = *(const u32x4*)(Zb + (size_t)(bl * SEQ + pp) * ZLD + ZC_QK + col);
            const f32x4 w0 = *(const f32x4*)(cw + j * 1024 + col), w1 = *(const f32x4*)(cw + j * 1024 + col + 4);
            o[0] += w0.x * bflo(x.x); o[1] += w0.y * bfhi(x.x); o[2] += w0.z * bflo(x.y); o[3] += w0.w * bfhi(x.y);
            o[4] += w1.x * bflo(x.z); o[5] += w1.y * bfhi(x.z); o[6] += w1.z * bflo(x.w); o[7] += w1.w * bfhi(x.w); } }
#pragma unroll
    for (int e = 0; e < 8; ++e) o[e] = siluf_(o[e]);
}
__device__ __forceinline__ float wave_incl_scan_add(float v, int lane) {
#pragma unroll
    for (int o = 1; o < 64; o <<= 1) { const float t = __shfl_up(v, o); if (lane >= o) v += t; }
    return v;
}
__device__ __forceinline__ float wave_incl_scan_max(float v, int lane) {
#pragma unroll
    for (int o = 1; o < 64; o <<= 1) { const float t = __shfl_up(v, o); if (lane >= o) v = fmaxf(v, t); }
    return v;
}
__device__ __forceinline__ float wave_max(float v) {
#pragma unroll
    for (int o = 1; o < 64; o <<= 1) v = fmaxf(v, __shfl_xor(v, o));
    return v;
}
constexpr float KSCALE = 0.08838834764831845f;

__device__ __forceinline__ void mlstm_s1(const Args& a, int l, int hf, unsigned char* ws, LAS unsigned char* lds, int G, int cu, int tid, int wave, int lane) {
    const bf16* Zb = (const bf16*)(ws + WS_Z); const bf16* ZT = (const bf16*)(ws + WS_ZT);
    const float* gi = (const float*)(ws + WS_GATE); const float* gf = gi + (size_t)M * 4;
    const float* cw = a.in[I_CONVW] + (size_t)l * 4 * 1024; const float* cb = a.in[I_CONVB] + (size_t)l * 1024;
    LAS bf16* KT = (LAS bf16*)lds;
    LAS float* wv = (LAS float*)(lds + 18432);
    for (int u = cu; u < 16 * NCH; u += G) {
        const int bhl = u >> 6, c = u & 63, bl = bhl >> 2, h = bhl & 3; const int tokg = (hf * 4 + bl) * SEQ + c * LCH;
        if (wave == 0) {
            const float lf = gf[(size_t)(tokg + lane) * 4 + h], ii = gi[(size_t)(tokg + lane) * 4 + h];
            const float bc = wave_incl_scan_add(lf, lane); const float g = __shfl(bc, 63);
            const float av = g - bc + ii; const float ml = wave_max(av);
            wv[lane] = __expf(av - ml);
            if (lane == 0) { float* cs = (float*)(ws + WS_CSC) + (size_t)(bhl * NCH + c) * 4; cs[0] = g; cs[1] = ml; }
        }
        __syncthreads();
#pragma unroll
        for (int rep = 0; rep < 2; ++rep) { const int idx = tid + rep * NTHR, s = idx >> 4, c8 = idx & 15; float o[8];
            conv8(Zb, bl, c * LCH + s, 512 + h * 128 + c8 * 8, cw, cb, o); const float sc = wv[s] * KSCALE;
#pragma unroll
            for (int e = 0; e < 8; ++e) KT[(c8 * 8 + e) * 72 + s] = (bf16)f2bf(o[e] * sc); }
        __syncthreads();
        if (tid < 128) { float s = 0.f;
#pragma unroll 8
            for (int k = 0; k < 64; ++k) s += bf1(KT[tid * 72 + k]);
            ((float*)(ws + WS_NST))[(size_t)(bhl * NCH + c) * 128 + tid] = s; }
        {
            const int r = lane & 31, hh = lane >> 5, v0 = 32 * wave;
            const bf16* vrow = ZT + (size_t)(h * 256 + v0 + r) * ZTLD + bl * SEQ + c * LCH + 8 * hh;
            bf16x8 bfr[4];
#pragma unroll
            for (int ks = 0; ks < 4; ++ks) bfr[ks] = *(const bf16x8*)(vrow + 16 * ks);
            bf16* st = (bf16*)(ws + WS_ST) + (size_t)(bhl * NCH + c) * 32768 + (size_t)(v0 + r) * 128;
#pragma unroll
            for (int db = 0; db < 4; ++db) { f32x16 acc;
#pragma unroll
                for (int e = 0; e < 16; ++e) acc[e] = 0.f;
#pragma unroll
                for (int ks = 0; ks < 4; ++ks) { const bf16x8 af = *(const LAS bf16x8*)(KT + (32 * db + r) * 72 + 16 * ks + 8 * hh); acc = __builtin_amdgcn_mfma_f32_32x32x16_bf16(af, bfr[ks], acc, 0, 0, 0); }
#pragma unroll
                for (int q = 0; q < 4; ++q) { u32x2 w; w.x = pk2(acc[4 * q], acc[4 * q + 1]); w.y = pk2(acc[4 * q + 2], acc[4 * q + 3]); *(u32x2*)(st + 32 * db + 8 * q + 4 * hh) = w; } }
        }
        __syncthreads();
    }
}
__device__ __forceinline__ void mlstm_s2(unsigned char* ws, int G, int cu, int tid) {
    for (int u = cu; u < 256; u += G) {
        const int bhl = u >> 4, part = u & 15; const size_t off = (size_t)(part * NTHR + tid) * 4;
        bf16* st = (bf16*)(ws + WS_ST) + (size_t)bhl * NCH * 32768 + off; float* ns = (float*)(ws + WS_NST) + (size_t)bhl * NCH * 128 + tid; float* cs = (float*)(ws + WS_CSC) + (size_t)bhl * NCH * 4;
        const bool nth = (part == 0 && tid < 128);
        float C[4]; float nv = 0.f, m = -1e30f;
#pragma unroll
        for (int e = 0; e < 4; ++e) C[e] = 0.f;
        for (int c0 = 0; c0 < NCH; c0 += 8) {
            u32x2 cl[8]; float nl[8], gg[8], ml[8];
#pragma unroll
            for (int i = 0; i < 8; ++i) { cl[i] = *(const u32x2*)(st + (size_t)(c0 + i) * 32768); nl[i] = nth ? ns[(c0 + i) * 128] : 0.f; gg[i] = cs[(c0 + i) * 4]; ml[i] = cs[(c0 + i) * 4 + 1]; }
#pragma unroll
            for (int i = 0; i < 8; ++i) {
                u32x2 o; o.x = pk2(C[0], C[1]); o.y = pk2(C[2], C[3]);
                *(u32x2*)(st + (size_t)(c0 + i) * 32768) = o;
                if (nth) ns[(c0 + i) * 128] = nv;
                if (part == 0 && tid == 0) cs[(c0 + i) * 4 + 2] = m;
                const float mn = fmaxf(gg[i] + m, ml[i]); const float dec = __expf(gg[i] + m - mn), sc = __expf(ml[i] - mn);
                C[0] = dec * C[0] + sc * bflo(cl[i].x); C[1] = dec * C[1] + sc * bfhi(cl[i].x); C[2] = dec * C[2] + sc * bflo(cl[i].y); C[3] = dec * C[3] + sc * bfhi(cl[i].y);
                nv = dec * nv + sc * nl[i]; m = mn;
            }
        }
    }
}
__device__ __forceinline__ void mlstm_s3(const Args& a, int l, int hf, unsigned char* ws, LAS unsigned char* lds, int G, int cu, int tid, int wave, int lane) {
    bf16* Zb = (bf16*)(ws + WS_Z); const bf16* ZT = (const bf16*)(ws + WS_ZT);
    const float* gi = (const float*)(ws + WS_GATE); const float* gf = gi + (size_t)M * 4;
    const float* cw = a.in[I_CONVW] + (size_t)l * 4 * 1024; const float* cb = a.in[I_CONVB] + (size_t)l * 1024;
    const float* gain = a.in[I_MNORM] + (size_t)l * 1024;
    LAS bf16* QS = (LAS bf16*)lds;
    LAS bf16* KS = (LAS bf16*)(lds + 17408);
    LAS bf16* SD = (LAS bf16*)(lds + 34816);
    LAS float* HB = (LAS float*)(lds + 44032);
    LAS float* SC = (LAS float*)(lds + 110592);
    for (int u = cu; u < 16 * NCH; u += G) {
        const int bhl = u >> 6, c = u & 63, bl = bhl >> 2, h = bhl & 3; const int tokg = (hf * 4 + bl) * SEQ + c * LCH; const int tokl = bl * SEQ + c * LCH;
        if (wave == 0) {
            const float lf = gf[(size_t)(tokg + lane) * 4 + h], ii = gi[(size_t)(tokg + lane) * 4 + h];
            const float bc = wave_incl_scan_add(lf, lane); const float rr = ii - bc; const float cm = wave_incl_scan_max(rr, lane);
            const float mst = ((const float*)(ws + WS_CSC))[(size_t)(bhl * NCH + c) * 4 + 2];
            const float Mt = fmaxf(mst, cm);
            SC[lane] = rr; SC[64 + lane] = Mt; SC[128 + lane] = __expf(mst - Mt); SC[192 + lane] = __expf(-(bc + Mt));
        } else if (wave == 1 || wave == 2) { const int d = (wave - 1) * 64 + lane; SC[320 + d] = ((const float*)(ws + WS_NST))[(size_t)(bhl * NCH + c) * 128 + d]; }
#pragma unroll
        for (int rep = 0; rep < 4; ++rep) { const int idx = tid + (rep & 1) * NTHR, t = idx >> 4, c8 = idx & 15; const bool isk = rep >= 2; float o[8];
            conv8(Zb, bl, c * LCH + t, (isk ? 512 : 0) + h * 128 + c8 * 8, cw, cb, o); const float sc = isk ? KSCALE : 1.f;
            u32x4 w; w.x = pk2(o[0] * sc, o[1] * sc); w.y = pk2(o[2] * sc, o[3] * sc); w.z = pk2(o[4] * sc, o[5] * sc); w.w = pk2(o[6] * sc, o[7] * sc);
            *(LAS u32x4*)((isk ? KS : QS) + t * 136 + c8 * 8) = w; }
        __syncthreads();
        {
            const int tb = wave >> 1, fr = lane & 15, fq = lane >> 4;
#pragma unroll
            for (int i = 0; i < 2; ++i) { const int sblk = (wave & 1) * 2 + i; f32x4 acc = (f32x4){0.f, 0.f, 0.f, 0.f};
                if (sblk <= tb) {
#pragma unroll
                    for (int ks = 0; ks < 4; ++ks) { const bf16x8 af = *(const LAS bf16x8*)(QS + (16 * tb + fr) * 136 + 32 * ks + 8 * fq), bfv = *(const LAS bf16x8*)(KS + (16 * sblk + fr) * 136 + 32 * ks + 8 * fq);
                        acc = __builtin_amdgcn_mfma_f32_16x16x32_bf16(af, bfv, acc, 0, 0, 0); } }
                const int s = 16 * sblk + fr; const float rs_ = SC[s];
#pragma unroll
                for (int e = 0; e < 4; ++e) { const int t = 16 * tb + 4 * fq + e; const float val = (s <= t) ? acc[e] * __expf(rs_ - SC[64 + t]) : 0.f; SD[t * 72 + s] = (bf16)f2bf(val); } }
        }
        __syncthreads();
#pragma unroll
        for (int rep = 0; rep < 2; ++rep) { const int idx = tid + rep * NTHR, t = idx >> 4, c8 = idx & 15; const float it = SC[128 + t];
            u32x4 x = *(const LAS u32x4*)(QS + t * 136 + c8 * 8);
            x.x = pk2(bflo(x.x) * it, bfhi(x.x) * it); x.y = pk2(bflo(x.y) * it, bfhi(x.y) * it); x.z = pk2(bflo(x.z) * it, bfhi(x.z) * it); x.w = pk2(bflo(x.w) * it, bfhi(x.w) * it);
            *(LAS u32x4*)(QS + t * 136 + c8 * 8) = x; }
        __syncthreads();
        if (wave == 0) { const int t = lane; float den = 0.f;
#pragma unroll 8
            for (int s = 0; s < 64; ++s) den += bf1(SD[t * 72 + s]);
#pragma unroll 8
            for (int d = 0; d < 128; ++d) den += bf1(QS[t * 136 + d]) * SC[320 + d];
            SC[256 + t] = 1.f / fmaxf(fabsf(den), SC[192 + t]); }
        f32x16 acc0, acc1;
        const int r = lane & 31, hh = lane >> 5, v0 = 32 * wave;
        {
#pragma unroll
            for (int e = 0; e < 16; ++e) { acc0[e] = 0.f; acc1[e] = 0.f; }
            const bf16* vrow = ZT + (size_t)(h * 256 + v0 + r) * ZTLD + tokl + 8 * hh;
            const bf16* crow = (const bf16*)(ws + WS_ST) + (size_t)(bhl * NCH + c) * 32768 + (size_t)(v0 + r) * 128 + 8 * hh;
#pragma unroll
            for (int ks = 0; ks < 12; ++ks) {
                const bf16x8 bfv = (ks < 4) ? *(const bf16x8*)(vrow + 16 * ks) : *(const bf16x8*)(crow + 16 * (ks - 4));
                const bf16x8 a0 = (ks < 4) ? *(const LAS bf16x8*)(SD + r * 72 + 16 * ks + 8 * hh) : *(const LAS bf16x8*)(QS + r * 136 + 16 * (ks - 4) + 8 * hh);
                const bf16x8 a1 = (ks < 4) ? *(const LAS bf16x8*)(SD + (32 + r) * 72 + 16 * ks + 8 * hh) : *(const LAS bf16x8*)(QS + (32 + r) * 136 + 16 * (ks - 4) + 8 * hh);
                acc0 = __builtin_amdgcn_mfma_f32_32x32x16_bf16(a0, bfv, acc0, 0, 0, 0); acc1 = __builtin_amdgcn_mfma_f32_32x32x16_bf16(a1, bfv, acc1, 0, 0, 0); }
        }
        __syncthreads();
#pragma unroll
        for (int e = 0; e < 16; ++e) { const int t0 = (e & 3) + 8 * (e >> 2) + 4 * hh; HB[t0 * 260 + v0 + r] = acc0[e] * SC[256 + t0]; HB[(32 + t0) * 260 + v0 + r] = acc1[e] * SC[256 + 32 + t0]; }
        __syncthreads();
#pragma unroll
        for (int i = 0; i < 8; ++i) { const int t = 8 * wave + i; const f32x4 x = *(const LAS f32x4*)(HB + t * 260 + 4 * lane);
            const float mean = wave_sum((x.x + x.y) + (x.z + x.w)) * (1.f / 256.f); const f32x4 dx = x - mean;
            const float var = wave_sum((dx.x * dx.x + dx.y * dx.y) + (dx.z * dx.z + dx.w * dx.w)) * (1.f / 256.f); const float rstd = rsqrtf(var + EPS);
            const f32x4 gg = *(const f32x4*)(gain + h * 256 + 4 * lane);
            u32x2* op = (u32x2*)(Zb + (size_t)(tokl + t) * ZLD + ZC_O + h * 256 + 4 * lane); const u32x2 og = *op;
            u32x2 w; w.x = pk2(dx.x * rstd * gg.x * bflo(og.x), dx.y * rstd * gg.y * bfhi(og.x)); w.y = pk2(dx.z * rstd * gg.z * bflo(og.y), dx.w * rstd * gg.w * bfhi(og.y)); *op = w; }
        __syncthreads();
    }
}

__device__ __forceinline__ void sgu_phase(const Args& a, int l, unsigned char* ws, LAS unsigned char* lds, int G, int cu, int tid, int wave, int lane) {
    bf16* Zb = (bf16*)(ws + WS_Z); const bf16* ZT = (const bf16*)(ws + WS_ZT); const bf16* Wc = (const bf16*)(ws + WS_WSGU);
    const float* lng = a.in[I_SLNG] + (size_t)l * 1024; const float* lnb = a.in[I_SLNB] + (size_t)l * 1024; const float* bs = a.in[I_SBS] + (size_t)l * 4 * 128;
    LAS bf16* VT = (LAS bf16*)lds;
    LAS float* PS = (LAS float*)(lds + 69632);
    LAS float* ST = (LAS float*)(lds + 69632 + 4096);
    for (int u = cu; u < 4 * 32 * 4; u += G) {
        const int g = u & 3, cc = (u >> 2) & 31, bl = u >> 7; const int tokl = bl * SEQ + cc * 128;
#pragma unroll
        for (int rep = 0; rep < 8; ++rep) { const int idx = tid + rep * NTHR, d = idx >> 4, c8 = idx & 15;
            *(LAS u32x4*)(VT + d * 136 + c8 * 8) = *(const u32x4*)(ZT + (size_t)(1024 + g * 256 + d) * ZTLD + tokl + c8 * 8); }
        __syncthreads();
        { const int s = tid & 127, part = tid >> 7; float sm = 0.f, sq = 0.f;
#pragma unroll 8
            for (int d = part * 64; d < part * 64 + 64; ++d) { const float x = bf1(VT[d * 136 + s]); sm += x; sq += x * x; }
            PS[(part * 128 + s) * 2] = sm; PS[(part * 128 + s) * 2 + 1] = sq; }
        __syncthreads();
        if (tid < 128) { float sm = 0.f, sq = 0.f;
#pragma unroll
            for (int p = 0; p < 4; ++p) { sm += PS[(p * 128 + tid) * 2]; sq += PS[(p * 128 + tid) * 2 + 1]; }
            const float mean = sm * (1.f / 256.f); const float var = fmaxf(sq * (1.f / 256.f) - mean * mean, 0.f); ST[tid] = mean; ST[128 + tid] = rsqrtf(var + EPS); }
        __syncthreads();
#pragma unroll
        for (int rep = 0; rep < 8; ++rep) { const int idx = tid + rep * NTHR, d = idx >> 4, c8 = idx & 15; const float gg = lng[g * 256 + d], bb = lnb[g * 256 + d];
            u32x4 x = *(const LAS u32x4*)(VT + d * 136 + c8 * 8); const LAS float* mp = ST + c8 * 8; const LAS float* rp = ST + 128 + c8 * 8;
            x.x = pk2((bflo(x.x) - mp[0]) * rp[0] * gg + bb, (bfhi(x.x) - mp[1]) * rp[1] * gg + bb); x.y = pk2((bflo(x.y) - mp[2]) * rp[2] * gg + bb, (bfhi(x.y) - mp[3]) * rp[3] * gg + bb);
            x.z = pk2((bflo(x.z) - mp[4]) * rp[4] * gg + bb, (bfhi(x.z) - mp[5]) * rp[5] * gg + bb); x.w = pk2((bflo(x.w) - mp[6]) * rp[6] * gg + bb, (bfhi(x.w) - mp[7]) * rp[7] * gg + bb);
            *(LAS u32x4*)(VT + d * 136 + c8 * 8) = x; }
        __syncthreads();
        {
            const int r = lane & 31, hh = lane >> 5, d0 = 32 * wave;
            f32x16 acc[4];
#pragma unroll
            for (int tb = 0; tb < 4; ++tb)
#pragma unroll
                for (int e = 0; e < 16; ++e) acc[tb][e] = 0.f;
#pragma unroll
            for (int ks = 0; ks < 8; ++ks) { const bf16x8 af = *(const LAS bf16x8*)(VT + (d0 + r) * 136 + 16 * ks + 8 * hh);
#pragma unroll
                for (int tb = 0; tb < 4; ++tb) if (16 * ks <= 32 * tb + 31) { const bf16x8 bfv = *(const bf16x8*)(Wc + (size_t)(g * 128 + 32 * tb + r) * 128 + 16 * ks + 8 * hh);
                    acc[tb] = __builtin_amdgcn_mfma_f32_32x32x16_bf16(af, bfv, acc[tb], 0, 0, 0); } }
#pragma unroll
            for (int tb = 0; tb < 4; ++tb) { const int t = 32 * tb + r; const float bias = bs[g * 128 + t]; bf16* rowp = Zb + (size_t)(tokl + t) * ZLD + ZC_U + g * 256 + d0 + 4 * hh;
#pragma unroll
                for (int q = 0; q < 4; ++q) { u32x2* op = (u32x2*)(rowp + 8 * q); const u32x2 uu = *op; u32x2 w;
                    w.x = pk2(bflo(uu.x) * (acc[tb][4 * q] + bias), bfhi(uu.x) * (acc[tb][4 * q + 1] + bias)); w.y = pk2(bflo(uu.y) * (acc[tb][4 * q + 2] + bias), bfhi(uu.y) * (acc[tb][4 * q + 3] + bias)); *op = w; } }
        }
        __syncthreads();
    }
}

__device__ __forceinline__ void softmax_rows(unsigned char* ws, int gw, int NGW, int lane) {
    bf16* Zb = (bf16*)(ws + WS_Z);
    for (int m = gw; m < MH; m += NGW) {
        u32x4* p = (u32x4*)(Zb + (size_t)m * ZLD + ZC_XQ + 16 * lane); const u32x4 x0 = p[0], x1 = p[1];
        float v[16] = { bflo(x0.x), bfhi(x0.x), bflo(x0.y), bfhi(x0.y), bflo(x0.z), bfhi(x0.z), bflo(x0.w), bfhi(x0.w), bflo(x1.x), bfhi(x1.x), bflo(x1.y), bfhi(x1.y), bflo(x1.z), bfhi(x1.z), bflo(x1.w), bfhi(x1.w) };
        float mx = v[0];
#pragma unroll
        for (int e = 1; e < 16; ++e) mx = fmaxf(mx, v[e]);
#pragma unroll
        for (int o = 1; o < 16; o <<= 1) mx = fmaxf(mx, __shfl_xor(mx, o));
        float s = 0.f;
#pragma unroll
        for (int e = 0; e < 16; ++e) { v[e] = __expf(v[e] - mx); s += v[e]; }
#pragma unroll
        for (int o = 1; o < 16; o <<= 1) s += __shfl_xor(s, o);
        const float inv = 1.f / s;
        u32x4 y0, y1; y0.x = pk2(v[0] * inv, v[1] * inv); y0.y = pk2(v[2] * inv, v[3] * inv); y0.z = pk2(v[4] * inv, v[5] * inv); y0.w = pk2(v[6] * inv, v[7] * inv);
        y1.x = pk2(v[8] * inv, v[9] * inv); y1.y = pk2(v[10] * inv, v[11] * inv); y1.z = pk2(v[12] * inv, v[13] * inv); y1.w = pk2(v[14] * inv, v[15] * inv);
        p[0] = y0; p[1] = y1;
    }
}

__global__ void __launch_bounds__(NTHR, 2) trunk_fwd(Args args) {
    extern __shared__ __attribute__((aligned(16))) unsigned char lds_raw[];
    LAS unsigned char* lds = (LAS unsigned char*)lds_raw;
    volatile LAS unsigned* MISC = (volatile LAS unsigned*)(lds + MISC_OFF);
    const int G = gridDim.x, cu = blockIdx.x;
    unsigned char* ws = args.ws;
#define PHASE_IDS() int tid = threadIdx.x; asm volatile("" : "+v"(tid)); const int lane = tid & 63, wave = __builtin_amdgcn_readfirstlane(tid >> 6); \
    const int vcu = (G % 8 == 0) ? (cu % 8) * (G / 8) + cu / 8 : cu; const int gw = vcu * NWAVES + wave, NGW = G * NWAVES, gtid = cu * NTHR + tid, GT = G * NTHR; (void)gw; (void)NGW; (void)gtid; (void)GT; (void)lane
    for (int u = threadIdx.x; u < (LDS_BYTES - RING_BYTES) / 4; u += NTHR) ((LAS unsigned*)(lds + RING_BYTES))[u] = 0u;
    __syncthreads();
    XcdBarrier bar = xcd_barrier_post((unsigned*)(ws + WS_CTL) + 4096, MISC + 8);
    const int lo = args.ph_lo, hi = args.ph_hi;
    int ph = 0;
#define IN() (lo <= ph && ph < hi)
#define SEAM() do { if (lo <= ph && ph + 1 < hi) xcd_barrier(bar); ++ph; } while (0)
    bf16* XN = (bf16*)(ws + WS_XN); bf16* Wb = (bf16*)(ws + WS_W);
    float* hbuf = args.out;

    if (IN()) { PHASE_IDS();
        convert_layer(args, 0, ws, lds, gw, NGW, wave, lane, gtid, GT);
        thin_rows(nullptr, 0, args.in[I_X], nullptr, nullptr, 0.f, args.in[I_NORMG], XN, 0, M, gw, NGW, lane, false, nullptr, nullptr, nullptr, nullptr, nullptr);
        __syncthreads();
    }
    SEAM();

    for (int sb = 0; sb < 2 * DEPTH; ++sb) {
        const int l = sb >> 1, j = sb & 1;
        const float* ng = args.in[I_NORMG] + (size_t)l * NNORM * D;
        if (IN()) { PHASE_IDS();
            pg8::Gemm g{D, D, D}; pg8::TileSched S; S.init(M / 256, 2 * DFF / 256, G, cu, XN, D * 2, (char*)Wb + (j ? WO_GU1 : WO_GU0), D * 2);
            pg8::EpiGU E{(bf16*)(ws + WS_HID)};
            pg8::gemm_phase(lds, g, S, E, tid);
        }
        SEAM();
        if (IN()) { PHASE_IDS();
            pg8::Gemm g{DFF, DFF, DFF}; pg8::TileSched S; S.init(M / 256, D / 256, G, cu, ws + WS_HID, DFF * 2, (char*)Wb + (j ? WO_D1 : WO_D0), DFF * 2);
            pg8::EpiAct E{(bf16*)(ws + WS_F), (size_t)D, 0};
            pg8::gemm_phase(lds, g, S, E, tid);
        }
        SEAM();
        if (IN()) { PHASE_IDS();
            const float* hin = (sb == 0) ? args.in[I_X] : hbuf;
            if (j == 0) {
                LAS float* wif = (LAS float*)lds;
                const float* win = args.in[I_WIN] + (size_t)l * D * WIN_COLS;
                for (int e = tid; e < D * 8; e += NTHR) wif[e] = win[(size_t)(e >> 3) * WIN_COLS + 3072 + (e & 7)];
                __syncthreads();
                float* gi = (float*)(ws + WS_GATE);
                thin_rows((const bf16*)(ws + WS_F), D, hin, hbuf, ng + 1 * D, 0.5f, ng + 2 * D, XN, 0, M, gw, NGW, lane, true, wif, args.in[I_BI] + l * 4, args.in[I_BF] + l * 4, gi, gi + (size_t)M * 4);
                __syncthreads();
                {
                    pg8::Gemm g{D, D, D};
                    pg8::TileSched S; S.init(MMEM / 256, D / 256, G, cu, ws + WS_MEMN, D * 2, (char*)Wb + WO_MKV, D * 2);
                    pg8::EpiAct E{(bf16*)(ws + WS_KMEM), (size_t)D, 0};
                    pg8::gemm_phase(lds, g, S, E, tid);
                    pg8::TileSched S2; S2.init(D / 256, MMEM / 256, G, (cu + G / 2) % G, (char*)Wb + WO_MKV + (size_t)D * D * 2, D * 2, ws + WS_MEMN, D * 2);
                    pg8::EpiAct E2{(bf16*)(ws + WS_VTMEM), (size_t)MMEM, 0};
                    pg8::gemm_phase(lds, g, S2, E2, tid);
                }
            } else {
                const float* gnext = (l + 1 < DEPTH) ? args.in[I_NORMG] + (size_t)(l + 1) * NNORM * D : nullptr;
                thin_rows((const bf16*)(ws + WS_F), D, hin, hbuf, ng + 5 * D, 0.5f, gnext, XN, 0, M, gw, NGW, lane, false, nullptr, nullptr, nullptr, nullptr, nullptr);
                if (l + 1 < DEPTH) { __syncthreads(); convert_layer(args, l + 1, ws, lds, gw, NGW, wave, lane, gtid, GT); __syncthreads(); }
            }
        }
        SEAM();
        if (j == 0) {
            for (int hf = 0; hf < 2; ++hf) {
                bf16* Zb = (bf16*)(ws + WS_Z);
                if (IN()) { PHASE_IDS();
                    pg8::Gemm g{D, D, D};
                    pg8::TileSched S; S.init(MH / 256, ZLD / 256, G, cu, XN + (size_t)hf * MH * D, D * 2, (char*)Wb + WO_IN, D * 2);
                    pg8::EpiAct E{Zb, (size_t)ZLD, 1};
                    pg8::gemm_phase(lds, g, S, E, tid);
                    pg8::TileSched S2; S2.init(2048 / 256, MH / 256, G, cu, (char*)Wb + WO_IN + (size_t)ZLD * D * 2, D * 2, XN + (size_t)hf * MH * D, D * 2);
                    pg8::EpiAct E2{(bf16*)(ws + WS_ZT), (size_t)ZTLD, 2};
                    pg8::gemm_phase(lds, g, S2, E2, tid);
                }
                SEAM();
                if (IN()) { PHASE_IDS();
                    mlstm_s1(args, l, hf, ws, lds, G, cu, tid, wave, lane);
                    sgu_phase(args, l, ws, lds, G, cu, tid, wave, lane);
                    pg8::Gemm g{256, ZLD, D};
                    pg8::TileSched S; S.init(MH / 256, 4, G, cu, Zb + ZC_XQ, ZLD * 2, (bf16*)(ws + WS_KMEM) + (size_t)hf * 4 * MEMLEN * D, 0);
                    S.a_pn = 512; S.b_tile = 512; S.pm_per_b = 16; S.b_batch = (size_t)MEMLEN * D * 2;
                    pg8::EpiAct E{Zb + ZC_XQ, (size_t)ZLD, 0};
                    pg8::gemm_phase(lds, g, S, E, tid);
                }
                SEAM();
                if (IN()) { PHASE_IDS();
                    mlstm_s2(ws, G, cu, tid);
                    softmax_rows(ws, gw, NGW, lane);
                }
                SEAM();
                if (IN()) { PHASE_IDS();
                    mlstm_s3(args, l, hf, ws, lds, G, cu, tid, wave, lane);
                    pg8::Gemm g{256, ZLD, MMEM};
                    pg8::TileSched S; S.init(MH / 256, 4, G, cu, Zb + ZC_XQ, ZLD * 2, (bf16*)(ws + WS_VTMEM) + (size_t)hf * 4 * MEMLEN, 0);
                    S.a_pn = 512; S.b_tile = (size_t)256 * MMEM * 2; S.pm_per_b = 16; S.b_batch = (size_t)MEMLEN * 2;
                    pg8::EpiAct E{Zb + ZC_XQ, (size_t)ZLD, 0};
                    pg8::gemm_phase(lds, g, S, E, tid);
                }
                SEAM();
                if (IN()) { PHASE_IDS();
                    pg8::Gemm g{D, ZLD, D};
                    pg8::TileSched S; S.init(MH / 256, D / 256, G, cu, Zb + ZC_O, ZLD * 2, (char*)Wb + WO_BR, D * 2);
                    S.reps = 3; S.a_rep = 1024 * 2; S.b_rep = (size_t)D * D * 2;
                    pg8::EpiBranch E{Zb};
                    pg8::gemm_phase(lds, g, S, E, tid);
                }
                SEAM();
                if (IN()) { PHASE_IDS();
                    pg8::Gemm g{D, ZLD, D};
                    pg8::TileSched S; S.init(MH / 256, D / 256, G, cu, Zb + ZC_QK, ZLD * 2, (char*)Wb + WO_OUT, D * 2);
                    pg8::EpiAct E{Zb + ZC_O, (size_t)ZLD, 0};
                    pg8::gemm_phase(lds, g, S, E, tid);
                }
                SEAM();
                if (IN()) { PHASE_IDS();
                    thin_rows(Zb + ZC_O, ZLD, hbuf, hbuf, ng + 3 * D, 1.0f, ng + 4 * D, XN, hf * MH, (hf + 1) * MH, gw, NGW, lane, false, nullptr, nullptr, nullptr, nullptr, nullptr);
                }
                SEAM();
            }
        }
    }
#undef IN
#undef SEAM
}
constexpr int N_PHASES = 1 + 2 * DEPTH * 3 + DEPTH * 2 * 7;

#ifndef N_LAUNCH_MODE
#define N_LAUNCH_MODE 0
#endif
extern "C" void kernel_launch(void* const* d_in, const int* in_sizes, int n_in, void* d_out, int out_size, void* d_ws, size_t ws_size, hipStream_t stream) {
    static int grid = 0;
    if (grid == 0) {
        if (n_in != 18 || out_size != M * D || ws_size < WS_END) { fprintf(stderr, "kernel_launch: unexpected shapes (n_in %d out %d ws %zu)\n", n_in, out_size, ws_size); grid = -1; return; }
        int dev = 0, cus = 0, per_cu = 0;
        if (hipGetDevice(&dev) != hipSuccess || hipDeviceGetAttribute(&cus, hipDeviceAttributeMultiprocessorCount, dev) != hipSuccess) { grid = -1; return; }
        if (hipFuncSetAttribute((const void*)trunk_fwd, hipFuncAttributeMaxDynamicSharedMemorySize, LDS_BYTES) != hipSuccess) { grid = -1; return; }
        if (hipOccupancyMaxActiveBlocksPerMultiprocessor(&per_cu, (const void*)trunk_fwd, NTHR, LDS_BYTES) != hipSuccess || per_cu < 1) { fprintf(stderr, "kernel_launch: occupancy query says %d\n", per_cu); }
        (void)hipGetLastError();
        grid = cus;
    }
    if (grid < 0) return;
    (void)hipMemsetAsync((char*)d_ws + WS_CTL, 0, CTL_ZERO_BYTES, stream);
    Args a{};
    for (int i = 0; i < 18; ++i) a.in[i] = (const float*)d_in[i];
    a.out = (float*)d_out; a.ws = (unsigned char*)d_ws;
#if N_LAUNCH_MODE == 0
    a.ph_lo = 0; a.ph_hi = N_PHASES;
    hipLaunchKernelGGL(trunk_fwd, dim3(grid), dim3(NTHR), LDS_BYTES, stream, a);
#else
    for (int p = 0; p < N_PHASES; ++p) { a.ph_lo = p; a.ph_hi = p + 1; hipLaunchKernelGGL(trunk_fwd, dim3(grid), dim3(NTHR), LDS_BYTES, stream, a); }
#endif
}
```

```cpp
#include <hip/hip_runtime.h>
#include <cstdio>
#include <cstdint>

#define LAS __attribute__((address_space(3)))
#define GAS __attribute__((address_space(1)))
typedef unsigned short bf16;
typedef short bf16x8 __attribute__((ext_vector_type(8)));
typedef float f32x4 __attribute__((ext_vector_type(4)));
typedef float f32x16 __attribute__((ext_vector_type(16)));
typedef unsigned u32x4 __attribute__((ext_vector_type(4)));
typedef unsigned u32x2 __attribute__((ext_vector_type(2)));

constexpr int D = 1024, BATCH = 8, SEQ = 4096, DEPTH = 2, MEMLEN = 256, DFF = 2816, NNORM = 7;
constexpr int M = BATCH * SEQ, MH = M / 2, MMEM = BATCH * MEMLEN;
constexpr int WIN_COLS = 9224;
constexpr int LCH = 64, NCH = SEQ / LCH;
constexpr int ZLD = 7168;
constexpr int ZC_QK = 0, ZC_O = 1024, ZC_U = 2048, ZC_XQ = 3072, ZC_G = 4096;
constexpr int ZTLD = MH;
constexpr float EPS = 1e-6f;
constexpr int NWAVES = 8, NTHR = 512;

constexpr size_t MiB = 1u << 20;
constexpr size_t WS_CTL = 0, CTL_ZERO_BYTES = 1 * MiB;
constexpr size_t WS_WSGU = 1 * MiB;
constexpr size_t WS_GATE = 2 * MiB;
constexpr size_t WS_NST = 3 * MiB;
constexpr size_t WS_CSC = 4 * MiB;
constexpr size_t WS_MEMN = 5 * MiB;
constexpr size_t WS_KMEM = 9 * MiB;
constexpr size_t WS_VTMEM = 13 * MiB;
constexpr size_t WS_W = 17 * MiB;
constexpr size_t WO_GU0 = 0, WO_GU1 = 11 * MiB, WO_D0 = 22 * MiB, WO_D1 = WO_D0 + 5632 * 1024, WO_IN = 33 * MiB, WO_MKV = 51 * MiB, WO_BR = 55 * MiB, WO_OUT = 61 * MiB;
constexpr size_t WS_XN = 80 * MiB;
constexpr size_t WS_RSTD = 4 * MiB + 512 * 1024;
constexpr size_t WS_BIG = 144 * MiB;
constexpr size_t WS_HID = WS_BIG, WS_F = WS_BIG + 176 * MiB, WS_Z = WS_BIG, WS_ZT = WS_BIG + 224 * MiB;
constexpr size_t WS_ST = 432 * MiB;
constexpr size_t WS_END = 496 * MiB;

constexpr int LDS_BYTES = 147456;
constexpr int RING_BYTES = 131072;
constexpr int MISC_OFF = RING_BYTES + 320;

typedef float f32x2_t __attribute__((ext_vector_type(2))); typedef __bf16 bf16x2_t __attribute__((ext_vector_type(2)));
__device__ __forceinline__ unsigned pk2(float lo, float hi) { f32x2_t v = {lo, hi}; bf16x2_t b = __builtin_convertvector(v, bf16x2_t); return __builtin_bit_cast(unsigned, b); }
__device__ __forceinline__ unsigned f2bf(float f) { return pk2(f, 0.f) & 0xffffu; }
__device__ __forceinline__ float bflo(unsigned w) { return __uint_as_float(w << 16); }
__device__ __forceinline__ float bfhi(unsigned w) { return __uint_as_float(w & 0xffff0000u); }
__device__ __forceinline__ float bf1(bf16 b) { return __uint_as_float((unsigned)b << 16); }
__device__ __forceinline__ float wave_sum(float v) {
#pragma unroll
    for (int o = 1; o < 64; o <<= 1) v += __shfl_xor(v, o);
    return v;
}
__device__ __forceinline__ float sigmoidf_(float x) { return __builtin_amdgcn_rcpf(1.f + __expf(-x)); }
__device__ __forceinline__ float siluf_(float x) { return x * __builtin_amdgcn_rcpf(1.f + __expf(-x)); }
__device__ __forceinline__ float gelu_tanh(float x) { const float u = 1.5957691216f * (x + 0.044715f * x * x * x); return x * __builtin_amdgcn_rcpf(1.f + __expf(-u)); }
__device__ __forceinline__ float logsigmoidf_(float x) { return fminf(x, 0.f) - log1pf(__expf(-fabsf(x))); }
#define LDS_WAIT() asm volatile("s_waitcnt lgkmcnt(0)" ::: "memory")
#define VM_WAIT() asm volatile("s_waitcnt vmcnt(0)" ::: "memory")

namespace pg8 {
constexpr int BM = 256, BK = 64, HALF = 128, HTB = HALF * BK * 2, STAGE_BYTES = 8 * HTB, NXCD = 8, WGM = 8;
__host__ __device__ __forceinline__ int lds_byte(int r, int c) { const int st = (r >> 4) * 2 + (c >> 5), rr = r & 15, cc = c & 31, ob = rr * 64 + cc * 2; return st * 1024 + (ob ^ (((ob >> 9) & 1) << 5)); }
__host__ __device__ __forceinline__ void stage_rc(int b, int& R, int& C) { const int st = b / 1024, sb = b % 1024, swz = sb ^ (((sb >> 9) & 1) << 5); R = (st >> 1) * 16 + swz / 64; C = (st & 1) * 32 + (swz % 64) / 2; }
__host__ __device__ __forceinline__ int perm32(int rho) { const int n = rho >> 4, i = rho & 15; return 8 * (i >> 2) + 4 * n + (i & 3); }

struct Unit { int pm, pn, aux; const char* a; const char* b; };
struct Gemm { int K, lda, ldb; };

struct TileSched {
    int nM, nN, nwg, G, c, reps, pm_per_b;
    const char* A; const char* B;
    size_t a_tile, a_pn, a_rep, b_tile, b_batch, b_rep;
    __device__ __forceinline__ void init(int nM_, int nN_, int G_, int c_, const void* A_, size_t lda_bytes, const void* B_, size_t ldb_bytes) {
        nM = nM_; nN = nN_; nwg = nM * nN; G = G_; c = c_; reps = 1; pm_per_b = 1 << 30; A = (const char*)A_; B = (const char*)B_;
        a_tile = 256 * lda_bytes; a_pn = 0; a_rep = 0; b_tile = 256 * ldb_bytes; b_batch = 0; b_rep = 0;
    }
    __device__ __forceinline__ bool next(int i, Unit& u) const {
        const int ti = i / reps, aux = i - ti * reps;
        const long L = (long)ti * G + c; if (L >= nwg) return false;
        int wgid = (int)L; { const int q = nwg / NXCD, r = nwg % NXCD, xcd = wgid % NXCD, off = wgid / NXCD; wgid = (xcd < r ? xcd * (q + 1) : r * (q + 1) + (xcd - r) * q) + off; }
        const int nig = WGM * nN, gid = wgid / nig, fm = gid * WGM, gsz = (nM - fm) < WGM ? (nM - fm) : WGM;
        u.pm = fm + ((wgid % nig) % gsz); u.pn = (wgid % nig) / gsz; u.aux = aux;
        u.a = A + (size_t)u.pm * a_tile + (size_t)u.pn * a_pn + (size_t)aux * a_rep;
        u.b = B + (size_t)u.pn * b_tile + (size_t)(u.pm / pm_per_b) * b_batch + (size_t)aux * b_rep;
        return true;
    }
};

__device__ __forceinline__ unsigned cvt_pk_bf16(float lo, float hi) { return pk2(lo, hi); }

template <int ACT> __device__ __forceinline__ float actf(float x) {
    if (ACT == 1) return sigmoidf_(x);
    if (ACT == 2) return gelu_tanh(x);
    if (ACT == 3) return x * 0.0625f;
    return x;
}
template <int ACT> __device__ __forceinline__ void store_tile_bf16(const f32x4 (&acc)[2][2][4][2], bf16* O, size_t ldc, int row0, int col0, const float* rsrow, const float* rscol) {
    f32x4 cs[2][2];
#pragma unroll
    for (int bj = 0; bj < 2; ++bj)
#pragma unroll
        for (int n = 0; n < 2; ++n) cs[bj][n] = rscol ? *(const f32x4*)(rscol + col0 + bj * HALF + 4 * n) : (f32x4){1.f, 1.f, 1.f, 1.f};
#pragma unroll
    for (int ai = 0; ai < 2; ++ai)
#pragma unroll
        for (int m = 0; m < 4; ++m) { const int row = row0 + ai * HALF + m * 16; bf16* rowp = O + (size_t)row * ldc + col0; const float rr = rsrow ? rsrow[row] : 1.f;
#pragma unroll
            for (int bj = 0; bj < 2; ++bj) { const f32x4 v0 = acc[ai][bj][m][0] * cs[bj][0] * rr, v1 = acc[ai][bj][m][1] * cs[bj][1] * rr; u32x4 w;
                w.x = cvt_pk_bf16(actf<ACT>(v0[0]), actf<ACT>(v0[1])); w.y = cvt_pk_bf16(actf<ACT>(v0[2]), actf<ACT>(v0[3]));
                w.z = cvt_pk_bf16(actf<ACT>(v1[0]), actf<ACT>(v1[1])); w.w = cvt_pk_bf16(actf<ACT>(v1[2]), actf<ACT>(v1[3]));
                *(u32x4*)(rowp + bj * HALF) = w; } }
}
struct EpiAct {
    static constexpr bool PERM = true;
    bf16* O; size_t ldc; int mode; const float* rsrow; const float* rscol;
    __device__ __forceinline__ void operator()(const f32x4 (&acc)[2][2][4][2], const Unit& u, int wr, int wc, int fr, int fq) const {
        const int row0 = u.pm * BM + wr * 64 + fr, col0 = u.pn * BM + wc * 32 + 8 * fq;
        int act = 0;
        if (mode == 1) { const int g = u.pn >> 2; act = (g == 0) ? 0 : (g == 1) ? 1 : (g == 2) ? 2 : (g == 3) ? 3 : 1; }
        else if (mode == 2) act = (u.pm >= 4) ? 2 : 0;
        if (act == 0) store_tile_bf16<0>(acc, O, ldc, row0, col0, rsrow, rscol);
        else if (act == 1) store_tile_bf16<1>(acc, O, ldc, row0, col0, rsrow, rscol);
        else if (act == 2) store_tile_bf16<2>(acc, O, ldc, row0, col0, rsrow, rscol);
        else store_tile_bf16<3>(acc, O, ldc, row0, col0, rsrow, rscol);
    }
};
struct EpiGU {
    static constexpr bool PERM = true;
    bf16* O; const float* rsrow;
    __device__ __forceinline__ void operator()(const f32x4 (&acc)[2][2][4][2], const Unit& u, int wr, int wc, int fr, int fq) const {
        const int row0 = u.pm * BM + wr * 64 + fr, col0 = u.pn * HALF + wc * 32 + 8 * fq;
#pragma unroll
        for (int ai = 0; ai < 2; ++ai)
#pragma unroll
            for (int m = 0; m < 4; ++m) { const int row = row0 + ai * HALF + m * 16; bf16* rowp = O + (size_t)row * DFF + col0; const float rr = rsrow[row];
                const f32x4 g0 = acc[ai][0][m][0] * rr, g1 = acc[ai][0][m][1] * rr, u0 = acc[ai][1][m][0] * rr, u1 = acc[ai][1][m][1] * rr; u32x4 w;
                w.x = cvt_pk_bf16(siluf_(g0[0]) * u0[0], siluf_(g0[1]) * u0[1]); w.y = cvt_pk_bf16(siluf_(g0[2]) * u0[2], siluf_(g0[3]) * u0[3]);
                w.z = cvt_pk_bf16(siluf_(g1[0]) * u1[0], siluf_(g1[1]) * u1[1]); w.w = cvt_pk_bf16(siluf_(g1[2]) * u1[2], siluf_(g1[3]) * u1[3]);
                *(u32x4*)rowp = w; }
    }
};
struct EpiBranch {
    static constexpr bool PERM = true;
    bf16* Zb;
    __device__ __forceinline__ void operator()(const f32x4 (&acc)[2][2][4][2], const Unit& u, int wr, int wc, int fr, int fq) const {
        const int row0 = u.pm * BM + wr * 64 + fr, col0 = u.pn * BM + wc * 32 + 8 * fq; const int j = u.aux;
#pragma unroll
        for (int ai = 0; ai < 2; ++ai)
#pragma unroll
            for (int m = 0; m < 4; ++m) { bf16* rowp = Zb + (size_t)(row0 + ai * HALF + m * 16) * ZLD + col0;
#pragma unroll
                for (int bj = 0; bj < 2; ++bj) { const f32x4 v0 = acc[ai][bj][m][0], v1 = acc[ai][bj][m][1];
                    const u32x4 g = *(const u32x4*)(rowp + ZC_G + j * 1024 + bj * HALF);
                    float o[8] = { v0[0] * bflo(g.x), v0[1] * bfhi(g.x), v0[2] * bflo(g.y), v0[3] * bfhi(g.y), v1[0] * bflo(g.z), v1[1] * bfhi(g.z), v1[2] * bflo(g.w), v1[3] * bfhi(g.w) };
                    if (j > 0) { const u32x4 p = *(const u32x4*)(rowp + ZC_QK + bj * HALF);
                        o[0] += bflo(p.x); o[1] += bfhi(p.x); o[2] += bflo(p.y); o[3] += bfhi(p.y); o[4] += bflo(p.z); o[5] += bfhi(p.z); o[6] += bflo(p.w); o[7] += bfhi(p.w); }
                    u32x4 w; w.x = cvt_pk_bf16(o[0], o[1]); w.y = cvt_pk_bf16(o[2], o[3]); w.z = cvt_pk_bf16(o[4], o[5]); w.w = cvt_pk_bf16(o[6], o[7]);
                    *(u32x4*)(rowp + ZC_QK + bj * HALF) = w; } }
    }
};

template <class Epi, class Sched>
__device__ __forceinline__ void gemm_phase(LAS unsigned char* lds, const Gemm g, const Sched& S, const Epi& E, const int tid) {
    const int wid = __builtin_amdgcn_readfirstlane(tid >> 6), lane = tid & 63, wr = wid >> 2, wc = wid & 3, fr = lane & 15, fq = lane >> 4;
    const int nt = g.K / BK;
    unsigned voffA[2], voffB[2];
#pragma unroll
    for (int i = 0; i < 2; ++i) { int R, C; stage_rc(tid * 16 + i * 8192, R, C); const int Rb = Epi::PERM ? ((R & ~31) + perm32(R & 31)) : R;
        voffA[i] = (unsigned)(R * g.lda + C) * 2u; voffB[i] = (unsigned)(Rb * g.ldb + C) * 2u; }
    const size_t kstep = (size_t)(BK * 2);
    const size_t hstepA = (size_t)HALF * g.lda * 2, hstepB = (size_t)HALF * g.ldb * 2;
    const unsigned ldsw = (unsigned)wid * 1024u;
    const int aoff = lds_byte(wr * 64 + fr, fq * 8), boff = lds_byte(wc * 32 + fr, fq * 8);
#define PG8_SA(b, h) (((b) * 2 + (h)) * HTB)
#define PG8_SB(b, h) ((4 + (b) * 2 + (h)) * HTB)
#define PG8_STAGE(bufoff, gbase, voff) do { _Pragma("unroll") for (int _i = 0; _i < 2; ++_i) \
        __builtin_amdgcn_global_load_lds((const unsigned*)((const char*)(gbase) + (voff)[_i]), (LAS unsigned*)(lds + (bufoff) + ldsw + _i * 8192), 16, 0, 0); } while (0)
#define PG8_LDA(dst, b, h) do { _Pragma("unroll") for (int m = 0; m < 4; ++m) _Pragma("unroll") for (int k = 0; k < 2; ++k) dst[m][k] = *(const LAS bf16x8*)(lds + PG8_SA(b, h) + aoff + m * 2048 + k * 1024); } while (0)
#define PG8_LDB(dst, b, h) do { _Pragma("unroll") for (int n = 0; n < 2; ++n) _Pragma("unroll") for (int k = 0; k < 2; ++k) dst[n][k] = *(const LAS bf16x8*)(lds + PG8_SB(b, h) + boff + n * 2048 + k * 1024); } while (0)
#define PG8_MMA(ai, bj, At, Bt) do { __builtin_amdgcn_s_setprio(1); _Pragma("unroll") for (int m = 0; m < 4; ++m) _Pragma("unroll") for (int n = 0; n < 2; ++n) _Pragma("unroll") for (int k = 0; k < 2; ++k) \
        acc[ai][bj][m][n] = __builtin_amdgcn_mfma_f32_16x16x32_bf16(Bt[n][k], At[m][k], acc[ai][bj][m][n], 0, 0, 0); __builtin_amdgcn_s_setprio(0); } while (0)
#define PG8_WAIT_V(n) asm volatile("s_waitcnt vmcnt(" #n ")" ::: "memory")
#define PG8_WAIT_L(n) asm volatile("s_waitcnt lgkmcnt(" #n ")" ::: "memory")
#define PG8_BAR __builtin_amdgcn_s_barrier()
#define PG8_SCHED __builtin_amdgcn_sched_barrier(0)
    Unit cur, nxt; int ui = 0;
    if (!S.next(0, cur)) return;
    f32x4 acc[2][2][4][2];
#pragma unroll
    for (int a = 0; a < 2; ++a)
#pragma unroll
        for (int b = 0; b < 2; ++b)
#pragma unroll
            for (int m = 0; m < 4; ++m)
#pragma unroll
                for (int n = 0; n < 2; ++n) acc[a][b][m][n] = (f32x4){0.f, 0.f, 0.f, 0.f};
    bf16x8 At[4][2], B0[2][2], B1[2][2];
    const char* cA = cur.a; const char* cB = cur.b;
    PG8_STAGE(PG8_SB(0, 0), cB, voffB); PG8_STAGE(PG8_SB(0, 1), cB + hstepB, voffB); PG8_STAGE(PG8_SA(0, 0), cA, voffA); PG8_STAGE(PG8_SA(0, 1), cA + hstepA, voffA);
    if (wr == 1) PG8_BAR;
    PG8_WAIT_V(2); PG8_BAR;
    PG8_STAGE(PG8_SB(1, 0), cB + kstep, voffB); PG8_STAGE(PG8_SA(1, 0), cA + kstep, voffA); PG8_STAGE(PG8_SB(1, 1), cB + hstepB + kstep, voffB);
    PG8_WAIT_V(6); PG8_BAR;
    for (;;) {
        const bool has_next = S.next(ui + 1, nxt);
        const char* nA = has_next ? nxt.a : cA; const char* nB = has_next ? nxt.b : cB;
        for (int t = 0; t < nt; t += 2) {
            const bool last = (t == nt - 2);
            const char* a1 = cA + (size_t)(t + 1) * kstep;
            const char* a2 = last ? nA : cA + (size_t)(t + 2) * kstep; const char* b2 = last ? nB : cB + (size_t)(t + 2) * kstep;
            const char* a3 = a2 + kstep; const char* b3 = b2 + kstep;
            PG8_LDB(B0, 0, 0); PG8_LDB(B1, 0, 1); PG8_SCHED; PG8_LDA(At, 0, 0); PG8_STAGE(PG8_SA(1, 1), a1 + hstepA, voffA);
            PG8_WAIT_V(8); PG8_WAIT_L(0); PG8_BAR; PG8_MMA(0, 0, At, B0); PG8_MMA(0, 1, At, B1); PG8_BAR; PG8_SCHED;
            PG8_LDA(At, 0, 1); PG8_STAGE(PG8_SB(0, 0), b2, voffB); PG8_STAGE(PG8_SB(0, 1), b2 + hstepB, voffB); PG8_STAGE(PG8_SA(0, 0), a2, voffA);
            PG8_WAIT_V(8); PG8_WAIT_L(0); PG8_BAR; PG8_MMA(1, 0, At, B0); PG8_MMA(1, 1, At, B1); PG8_BAR; PG8_SCHED;
            PG8_LDB(B0, 1, 0); PG8_LDB(B1, 1, 1); PG8_SCHED; PG8_LDA(At, 1, 0); PG8_STAGE(PG8_SA(0, 1), a2 + hstepA, voffA);
            PG8_WAIT_V(8); PG8_WAIT_L(0); PG8_BAR; PG8_MMA(0, 0, At, B0); PG8_MMA(0, 1, At, B1); PG8_BAR; PG8_SCHED;
            PG8_LDA(At, 1, 1); PG8_STAGE(PG8_SB(1, 0), b3, voffB); PG8_STAGE(PG8_SB(1, 1), b3 + hstepB, voffB); PG8_STAGE(PG8_SA(1, 0), a3, voffA);
            PG8_WAIT_V(8); PG8_WAIT_L(0); PG8_BAR; PG8_MMA(1, 0, At, B0); PG8_MMA(1, 1, At, B1); PG8_BAR; PG8_SCHED;
        }
        if (wr == 0) PG8_BAR;
        E(acc, cur, wr, wc, fr, fq);
        if (!has_next) break;
#pragma unroll
        for (int a = 0; a < 2; ++a)
#pragma unroll
            for (int b = 0; b < 2; ++b)
#pragma unroll
                for (int m = 0; m < 4; ++m)
#pragma unroll
                    for (int n = 0; n < 2; ++n) acc[a][b][m][n] = (f32x4){0.f, 0.f, 0.f, 0.f};
        cur = nxt; cA = nA; cB = nB; ++ui;
        if (wr == 1) PG8_BAR;
    }
    PG8_WAIT_V(0);
    PG8_BAR;
#undef PG8_SA
#undef PG8_SB
#undef PG8_STAGE
#undef PG8_LDA
#undef PG8_LDB
#undef PG8_MMA
#undef PG8_WAIT_V
#undef PG8_WAIT_L
#undef PG8_BAR
#undef PG8_SCHED
}
}

#define XB_TMO      128
#define XB_XCNT(j)  (256  + 64 * (j))
#define XB_XSUB(j)  (1280 + 64 * (j))
#define XB_XGEN(j)  (2304 + 64 * (j))
#define XB_TOP      3328
#define XB_TOPGEN   3392
#define XCD_BAR_WORDS 3456
#define XB_SPIN_CAP (1u << 18)
__device__ __forceinline__ unsigned xb_ld(unsigned* p)              { return __hip_atomic_load(p, __ATOMIC_RELAXED, __HIP_MEMORY_SCOPE_AGENT); }
__device__ __forceinline__ unsigned xb_add(unsigned* p, unsigned v) { return __hip_atomic_fetch_add(p, v, __ATOMIC_RELAXED, __HIP_MEMORY_SCOPE_AGENT); }
__device__ __forceinline__ unsigned xb_xcc_id() { return (unsigned)__builtin_amdgcn_s_getreg((3 << 11) | 20) & 0xFu; }
#define XB_SPIN(cond, bar) do { unsigned _sp = 0; while (cond) { __builtin_amdgcn_s_sleep(1); \
    if ((++_sp & 255u) == 0u) { if (xb_ld(&(bar)[XB_TMO])) break; if (_sp > XB_SPIN_CAP) { atomicAdd(&(bar)[XB_TMO], 1u); break; } } } } while (0)
struct XcdBarrier { unsigned* bar; unsigned x; volatile LAS unsigned* st; };
__device__ __forceinline__ XcdBarrier xcd_barrier_post(unsigned* bar, volatile LAS unsigned* st) {
    XcdBarrier b; b.bar = bar; b.x = xb_xcc_id(); b.st = st;
    if (threadIdx.x == 0) (void)xb_add(&bar[XB_XCNT(b.x)], 1u);
    return b;
}
__device__ __forceinline__ void xcd_barrier_complete(unsigned* bar, unsigned x, unsigned& nloc, unsigned& nx) {
    const unsigned G = gridDim.x * gridDim.y * gridDim.z;
    unsigned sum, cnt, mine, sp = 0u;
    for (;;) {
        sum = 0u; cnt = 0u; mine = 0u;
#pragma unroll
        for (unsigned j = 0; j < 16; ++j) { const unsigned c = xb_ld(&bar[XB_XCNT(j)]); sum += c; cnt += (c > 0u) ? 1u : 0u; mine = (j == x) ? c : mine; }
        if (sum == G) break;
        __builtin_amdgcn_s_sleep(1);
        if ((++sp & 255u) == 0u) { if (xb_ld(&bar[XB_TMO])) break; if (sp > XB_SPIN_CAP) { atomicAdd(&bar[XB_TMO], 1u); break; } }
    }
    nloc = mine > 0u ? mine : 1u; nx = cnt > 0u ? cnt : 1u;
}
__device__ __forceinline__ void xcd_barrier(const XcdBarrier& b) {
    asm volatile("s_waitcnt vmcnt(0)" ::: "memory");
    __syncthreads();
    if (threadIdx.x == 0) {
        unsigned* bar = b.bar;
        __builtin_amdgcn_s_waitcnt(0);
        unsigned nloc = b.st[0], nx = b.st[1];
        if (nloc == 0u) { xcd_barrier_complete(bar, b.x, nloc, nx); b.st[0] = nloc; b.st[1] = nx; }
        const unsigned old = xb_add(&bar[XB_XSUB(b.x)], 1u);
        const unsigned gen = old / nloc;
        if (old + 1u == (gen + 1u) * nloc) {
            __builtin_amdgcn_fence(__ATOMIC_RELEASE, "agent");
            asm volatile("s_waitcnt vmcnt(0)" ::: "memory");
            const unsigned og = xb_add(&bar[XB_TOP], 1u);
            const unsigned tg = og / nx;
            if (og + 1u == (tg + 1u) * nx) xb_add(&bar[XB_TOPGEN], 1u);
            else XB_SPIN(xb_ld(&bar[XB_TOPGEN]) == tg, bar);
            __builtin_amdgcn_fence(__ATOMIC_ACQUIRE, "agent");
            xb_add(&bar[XB_XGEN(b.x)], 1u);
            asm volatile("s_waitcnt vmcnt(0)" ::: "memory");
        } else {
            XB_SPIN(xb_ld(&bar[XB_XGEN(b.x)]) == gen, bar);
            __builtin_amdgcn_fence(__ATOMIC_ACQUIRE, "agent");
            asm volatile("s_waitcnt vmcnt(0)" ::: "memory");
        }
    }
    __syncthreads();
}

struct Args { const float* in[18]; float* out; unsigned char* ws; int ph_lo, ph_hi; };
enum { I_X = 0, I_MEM, I_NORMG, I_WGU, I_WDOWN, I_WIN, I_CONVW, I_CONVB, I_BI, I_BF, I_MNORM, I_SLNG, I_SLNB, I_SWS, I_SBS, I_WMKV, I_WBR, I_WOUT };

__device__ __forceinline__ void cvt_item(const float* W, int Nsrc, int K, int srccol, bf16* WT, int dstrow, int kb, LAS float* scr, int lane, const float* gk = nullptr) {
    const int k0 = 64 * kb;
#pragma unroll 8
    for (int i = 0; i < 32; ++i) { const int kk = 2 * i + (lane >> 5); scr[kk * 33 + (lane & 31)] = W[(size_t)(k0 + kk) * Nsrc + srccol + (lane & 31)] * (gk ? gk[k0 + kk] : 1.f); }
    LDS_WAIT(); asm volatile("" ::: "memory");
    const int c = lane & 7;
#pragma unroll
    for (int j = 0; j < 4; ++j) { const int n = (lane >> 3) + 8 * j; const LAS float* s = scr + (8 * c) * 33 + n;
        u32x4 o; o.x = pk2(s[0 * 33], s[1 * 33]); o.y = pk2(s[2 * 33], s[3 * 33]); o.z = pk2(s[4 * 33], s[5 * 33]); o.w = pk2(s[6 * 33], s[7 * 33]);
        *(u32x4*)(WT + (size_t)(dstrow + n) * K + k0 + 8 * c) = o; }
    LDS_WAIT(); asm volatile("" ::: "memory");
}
__device__ __forceinline__ int win_srccol(int r) {
    if (r < 1024) return r;
    if (r < 2048) return 2048 + (r - 1024);
    if (r < 3072) return 3080 + (r - 2048);
    if (r < 4096) return 5128 + (r - 3072);
    if (r < 7168) return 6152 + (r - 4096);
    if (r < 8192) return 1024 + (r - 7168);
    return 4104 + (r - 8192);
}
__device__ __forceinline__ void convert_layer(const Args& a, int l, unsigned char* ws, LAS unsigned char* lds, int gw, int NGW, int wave, int lane, int gtid, int GT) {
    LAS float* scr = (LAS float*)(lds + wave * 16384);
    bf16* Wb = (bf16*)(ws + WS_W);
    constexpr int I_GU = 16 * 176, I_DN = 44 * 32, I_IN = 16 * 288, I_MKV = 16 * 64, I_BR = 16 * 32, I_OUT = 16 * 32;
    constexpr int NITEMS = 2 * I_GU + 2 * I_DN + I_IN + I_MKV + 3 * I_BR + I_OUT;
    for (int it = gw; it < NITEMS; it += NGW) {
        int r = it;
        if (r < 2 * I_GU) { const int j = r / I_GU; r -= j * I_GU; const int kb = r / 176, nb = r % 176; const int p = nb >> 3, q = nb & 7, s = q >> 2, jj = (q & 3) * 32;
            cvt_item(a.in[I_WGU] + (size_t)(l * 2 + j) * D * 2 * DFF, 2 * DFF, D, s * DFF + 128 * p + jj, (bf16*)((char*)Wb + (j ? WO_GU1 : WO_GU0)), nb * 32, kb, scr, lane, a.in[I_NORMG] + (size_t)(l * NNORM + (j ? 4 : 0)) * D); continue; }
        r -= 2 * I_GU;
        if (r < 2 * I_DN) { const int j = r / I_DN; r -= j * I_DN; const int kb = r / 32, nb = r % 32;
            cvt_item(a.in[I_WDOWN] + (size_t)(l * 2 + j) * DFF * D, D, DFF, nb * 32, (bf16*)((char*)Wb + (j ? WO_D1 : WO_D0)), nb * 32, kb, scr, lane); continue; }
        r -= 2 * I_DN;
        if (r < I_IN) { const int kb = r / 288, nb = r % 288;
            cvt_item(a.in[I_WIN] + (size_t)l * D * WIN_COLS, WIN_COLS, D, win_srccol(nb * 32), (bf16*)((char*)Wb + WO_IN), nb * 32, kb, scr, lane, a.in[I_NORMG] + (size_t)(l * NNORM + 2) * D); continue; }
        r -= I_IN;
        if (r < I_MKV) { const int kb = r / 64, nb = r % 64;
            cvt_item(a.in[I_WMKV] + (size_t)l * D * 2048, 2048, D, nb * 32, (bf16*)((char*)Wb + WO_MKV), nb * 32, kb, scr, lane); continue; }
        r -= I_MKV;
        if (r < 3 * I_BR) { const int j = r / I_BR; r -= j * I_BR; const int kb = r / 32, nb = r % 32;
            cvt_item(a.in[I_WBR] + (size_t)(l * 3 + j) * D * D, D, D, nb * 32, (bf16*)((char*)Wb + WO_BR) + (size_t)j * D * D, nb * 32, kb, scr, lane); continue; }
        r -= 3 * I_BR;
        { const int kb = r / 32, nb = r % 32; cvt_item(a.in[I_WOUT] + (size_t)l * D * D, D, D, nb * 32, (bf16*)((char*)Wb + WO_OUT), nb * 32, kb, scr, lane); }
    }
    bf16* wsg = (bf16*)(ws + WS_WSGU); const float* src = a.in[I_SWS] + (size_t)l * 4 * 128 * 128;
    for (int e = gtid; e < 4 * 128 * 128; e += GT) { const int t = (e >> 7) & 127, s = e & 127; wsg[e] = (bf16)f2bf(s <= t ? src[e] : 0.f); }
    const float* g6 = a.in[I_NORMG] + (size_t)(l * NNORM + 6) * D;
    for (int m = gw; m < MMEM; m += NGW) {
        const f32x4* xr = (const f32x4*)(a.in[I_MEM] + (size_t)m * D) + lane; f32x4 v[4]; float s = 0.f;
#pragma unroll
        for (int j = 0; j < 4; ++j) { v[j] = xr[64 * j]; s += (v[j].x * v[j].x + v[j].y * v[j].y) + (v[j].z * v[j].z + v[j].w * v[j].w); }
        const float rstd = rsqrtf(wave_sum(s) * (1.f / D) + EPS);
        unsigned long long* o8 = (unsigned long long*)((bf16*)(ws + WS_MEMN) + (size_t)m * D) + lane;
#pragma unroll
        for (int j = 0; j < 4; ++j) { const f32x4 gg = ((const f32x4*)g6)[lane + 64 * j];
            o8[64 * j] = (unsigned long long)pk2(v[j].x * rstd * gg.x, v[j].y * rstd * gg.y) | ((unsigned long long)pk2(v[j].z * rstd * gg.z, v[j].w * rstd * gg.w) << 32); }
    }
}

__device__ __forceinline__ void thin_rows(const bf16* fbase, size_t fld, const float* ga, float scale, const float* hin32, const bf16* hinb, bf16* hb_out, float* rstd_out, float* out32,
                                          int row_lo, int row_hi, int gw, int NGW, int lane, const bool do_gates, const LAS float* wif, const float* bi, const float* bfg, float* gate_i, float* gate_f) {
    for (int m = row_lo + gw; m < row_hi; m += NGW) {
        f32x4 v[4];
        if (hin32) { const f32x4* hr = (const f32x4*)(hin32 + (size_t)m * D) + lane;
#pragma unroll
            for (int j = 0; j < 4; ++j) v[j] = hr[64 * j]; }
        else { const unsigned long long* hr = (const unsigned long long*)(hinb + (size_t)m * D) + lane;
#pragma unroll
            for (int j = 0; j < 4; ++j) { const unsigned long long w = hr[64 * j]; const unsigned lo = (unsigned)w, hi = (unsigned)(w >> 32); v[j] = (f32x4){bflo(lo), bfhi(lo), bflo(hi), bfhi(hi)}; } }
        if (fbase) {
            const unsigned long long* fr = (const unsigned long long*)(fbase + (size_t)(m - row_lo) * fld) + lane; float s = 0.f; f32x4 f[4];
#pragma unroll
            for (int j = 0; j < 4; ++j) { const unsigned long long w = fr[64 * j]; const unsigned lo = (unsigned)w, hi = (unsigned)(w >> 32);
                f[j] = (f32x4){bflo(lo), bfhi(lo), bflo(hi), bfhi(hi)}; s += (f[j].x * f[j].x + f[j].y * f[j].y) + (f[j].z * f[j].z + f[j].w * f[j].w); }
            const float rstd = rsqrtf(wave_sum(s) * (1.f / D) + EPS) * scale;
#pragma unroll
            for (int j = 0; j < 4; ++j) { const f32x4 gg = ((const f32x4*)ga)[lane + 64 * j]; v[j] = v[j] + f[j] * rstd * gg; }
        }
        if (out32) { f32x4* ho = (f32x4*)(out32 + (size_t)m * D) + lane;
#pragma unroll
            for (int j = 0; j < 4; ++j) ho[64 * j] = v[j]; }
        if (hb_out) {
            float s = 0.f;
#pragma unroll
            for (int j = 0; j < 4; ++j) s += (v[j].x * v[j].x + v[j].y * v[j].y) + (v[j].z * v[j].z + v[j].w * v[j].w);
            const float rstd = rsqrtf(wave_sum(s) * (1.f / D) + EPS);
            unsigned long long* o8 = (unsigned long long*)(hb_out + (size_t)m * D) + lane;
#pragma unroll
            for (int j = 0; j < 4; ++j) o8[64 * j] = (unsigned long long)pk2(v[j].x, v[j].y) | ((unsigned long long)pk2(v[j].z, v[j].w) << 32);
            if (lane == 0) rstd_out[m] = rstd;
            if (do_gates) {
                float acc[8];
#pragma unroll
                for (int e = 0; e < 8; ++e) acc[e] = 0.f;
#pragma unroll
                for (int j = 0; j < 4; ++j)
#pragma unroll
                    for (int q = 0; q < 4; ++q) { const int k = 4 * lane + 256 * j + q; const float xv = v[j][q]; const LAS f32x4* wp = (const LAS f32x4*)(wif + k * 8); const f32x4 w0 = wp[0], w1 = wp[1];
                        acc[0] += xv * w0.x; acc[1] += xv * w0.y; acc[2] += xv * w0.z; acc[3] += xv * w0.w; acc[4] += xv * w1.x; acc[5] += xv * w1.y; acc[6] += xv * w1.z; acc[7] += xv * w1.w; }
#pragma unroll
                for (int e = 0; e < 8; ++e) acc[e] = wave_sum(acc[e]) * rstd;
                if (lane == 0) {
                    *(f32x4*)(gate_i + (size_t)m * 4) = (f32x4){acc[0] + bi[0], acc[1] + bi[1], acc[2] + bi[2], acc[3] + bi[3]};
                    *(f32x4*)(gate_f + (size_t)m * 4) = (f32x4){logsigmoidf_(acc[4] + bfg[0]), logsigmoidf_(acc[5] + bfg[1]), logsigmoidf_(acc[6] + bfg[2]), logsigmoidf_(acc[7] + bfg[3])};
                }
            }
        }
    }
}

__device__ __forceinline__ void conv8(const bf16* Zb, int bl, int p, int col, const float* cw, const float* cb, float (&o)[8]) {
    const f32x4 b0 = *(const f32x4*)(cb + col), b1 = *(const f32x4*)(cb + col + 4);
    o[0] = b0.x; o[1] = b0.y; o[2] = b0.z; o[3] = b0.w; o[4] = b1.x; o[5] = b1.y; o[6] = b1.z; o[7] = b1.w;
#pragma unroll
    for (int j = 0; j < 4; ++j) { const int pp = p - 3 + j;
        if (pp >= 0) { const u32x4 x = *(const u32x4*)(Zb + (size_t)(bl * SEQ + pp) * ZLD + ZC_QK + col);
            const f32x4 w0 = *(const f32x4*)(cw + j * 1024 + col), w1 = *(const f32x4*)(cw + j * 1024 + col + 4);
            o[0] += w0.x * bflo(x.x); o[1] += w0.y * bfhi(x.x); o[2] += w0.z * bflo(x.y); o[3] += w0.w * bfhi(x.y);
            o[4] += w1.x * bflo(x.z); o[5] += w1.y * bfhi(x.z); o[6] += w1.z * bflo(x.w); o[7] += w1.w * bfhi(x.w); } }
#pragma unroll
    for (int e = 0; e < 8; ++e) o[e] = siluf_(o[e]);
}
__device__ __forceinline__ float wave_incl_scan_add(float v, int lane) {
#pragma unroll
    for (int o = 1; o < 64; o <<= 1) { const float t = __shfl_up(v, o); if (lane >= o) v += t; }
    return v;
}
__device__ __forceinline__ float wave_incl_scan_max(float v, int lane) {
#pragma unroll
    for (int o = 1; o < 64; o <<= 1) { const float t = __shfl_up(v, o); if (lane >= o) v = fmaxf(v, t); }
    return v;
}
__device__ __forceinline__ float wave_max(float v) {
#pragma unroll
    for (int o = 1; o < 64; o <<= 1) v = fmaxf(v, __shfl_xor(v, o));
    return v;
}
constexpr float KSCALE = 0.08838834764831845f;

__device__ __forceinline__ void conv8l(const bf16* Zb, int bl, int p, int col, const LAS float* wl, const int wstride, float (&o)[8]) {
    { const f32x4 b0 = *(const LAS f32x4*)(wl + 4 * wstride), b1 = *(const LAS f32x4*)(wl + 4 * wstride + 4);
      o[0] = b0.x; o[1] = b0.y; o[2] = b0.z; o[3] = b0.w; o[4] = b1.x; o[5] = b1.y; o[6] = b1.z; o[7] = b1.w; }
#pragma unroll
    for (int j = 0; j < 4; ++j) { const int pp = p - 3 + j;
        if (pp >= 0) { const u32x4 x = *(const u32x4*)(Zb + (size_t)(bl * SEQ + pp) * ZLD + ZC_QK + col);
            const f32x4 w0 = *(const LAS f32x4*)(wl + j * wstride), w1 = *(const LAS f32x4*)(wl + j * wstride + 4);
            o[0] += w0.x * bflo(x.x); o[1] += w0.y * bfhi(x.x); o[2] += w0.z * bflo(x.y); o[3] += w0.w * bfhi(x.y);
            o[4] += w1.x * bflo(x.z); o[5] += w1.y * bfhi(x.z); o[6] += w1.z * bflo(x.w); o[7] += w1.w * bfhi(x.w); } }
#pragma unroll
    for (int e = 0; e < 8; ++e) o[e] = siluf_(o[e]);
}
__device__ __forceinline__ void stage_convw(LAS float* wl, const float* cw, const float* cb, int col0, int ncol, int dst0, int wstride, int tid) {
    for (int e = tid; e < 5 * ncol; e += NTHR) { const int j = e / ncol, cidx = e - j * ncol; wl[j * wstride + dst0 + cidx] = (j < 4) ? cw[j * 1024 + col0 + cidx] : cb[col0 + cidx]; }
}
__device__ __forceinline__ void mlstm_s1(const Args& a, int l, int hf, unsigned char* ws, LAS unsigned char* lds, int G, int cu, int tid, int wave, int lane) {
    const bf16* Zb = (const bf16*)(ws + WS_Z); const bf16* ZT = (const bf16*)(ws + WS_ZT);
    const float* gi = (const float*)(ws + WS_GATE); const float* gf = gi + (size_t)M * 4;
    const float* cw = a.in[I_CONVW] + (size_t)l * 4 * 1024; const float* cb = a.in[I_CONVB] + (size_t)l * 1024;
    LAS bf16* KT = (LAS bf16*)lds;
    LAS float* wv = (LAS float*)(lds + 18432);
    LAS float* CWL = (LAS float*)(lds + 18688);
    const int c8 = tid & 15; int hcur = -1;
    for (int u = cu; u < 16 * NCH; u += G) {
        const int h = u & 3, c = (u >> 2) & 63, bl = u >> 8, bhl = bl * 4 + h; const int tokg = (hf * 4 + bl) * SEQ + c * LCH;
        if (h != hcur) { __syncthreads(); stage_convw(CWL, cw, cb, 512 + h * 128, 128, 0, 128, tid); hcur = h; }
        const int r = lane & 31, hh = lane >> 5, v0 = 32 * wave;
        bf16x8 bfr[4];
        { const bf16* vrow = ZT + (size_t)(h * 256 + v0 + r) * ZTLD + bl * SEQ + c * LCH + 8 * hh;
#pragma unroll
          for (int ks = 0; ks < 4; ++ks) bfr[ks] = *(const bf16x8*)(vrow + 16 * ks); }
        if (wave == 0) {
            const float lf = gf[(size_t)(tokg + lane) * 4 + h], ii = gi[(size_t)(tokg + lane) * 4 + h];
            const float bc = wave_incl_scan_add(lf, lane); const float g = __shfl(bc, 63);
            const float av = g - bc + ii; const float ml = wave_max(av);
            wv[lane] = __expf(av - ml);
            if (lane == 0) { float* cs = (float*)(ws + WS_CSC) + (size_t)(bhl * NCH + c) * 4; cs[0] = g; cs[1] = ml; }
        }
        __syncthreads();
#pragma unroll
        for (int rep = 0; rep < 2; ++rep) { const int idx = tid + rep * NTHR, s = idx >> 4; float o[8];
            conv8l(Zb, bl, c * LCH + s, 512 + h * 128 + c8 * 8, CWL + c8 * 8, 128, o); const float sc = wv[s] * KSCALE;
#pragma unroll
            for (int e = 0; e < 8; ++e) KT[(c8 * 8 + e) * 72 + s] = (bf16)f2bf(o[e] * sc); }
        __syncthreads();
        if (tid < 128) { float s = 0.f;
#pragma unroll 8
            for (int k = 0; k < 64; ++k) s += bf1(KT[tid * 72 + k]);
            ((float*)(ws + WS_NST))[(size_t)(bhl * NCH + c) * 128 + tid] = s; }
        {
            bf16* st = (bf16*)(ws + WS_ST) + (size_t)(bhl * NCH + c) * 32768 + (size_t)(v0 + r) * 128;
#pragma unroll
            for (int db = 0; db < 4; ++db) { f32x16 acc;
#pragma unroll
                for (int e = 0; e < 16; ++e) acc[e] = 0.f;
#pragma unroll
                for (int ks = 0; ks < 4; ++ks) { const bf16x8 af = *(const LAS bf16x8*)(KT + (32 * db + r) * 72 + 16 * ks + 8 * hh); acc = __builtin_amdgcn_mfma_f32_32x32x16_bf16(af, bfr[ks], acc, 0, 0, 0); }
#pragma unroll
                for (int q = 0; q < 4; ++q) { u32x2 w; w.x = pk2(acc[4 * q], acc[4 * q + 1]); w.y = pk2(acc[4 * q + 2], acc[4 * q + 3]); *(u32x2*)(st + 32 * db + 8 * q + 4 * hh) = w; } }
        }
        __syncthreads();
    }
}
__device__ __forceinline__ void mlstm_s2(unsigned char* ws, int G, int cu, int tid) {
    for (int u = cu; u < 256; u += G) {
        const int bhl = u >> 4, part = u & 15; const size_t off = (size_t)(part * NTHR + tid) * 4;
        bf16* st = (bf16*)(ws + WS_ST) + (size_t)bhl * NCH * 32768 + off; float* ns = (float*)(ws + WS_NST) + (size_t)bhl * NCH * 128 + tid; float* cs = (float*)(ws + WS_CSC) + (size_t)bhl * NCH * 4;
        const bool nth = (part == 0 && tid < 128);
        float C[4]; float nv = 0.f, m = -1e30f;
#pragma unroll
        for (int e = 0; e < 4; ++e) C[e] = 0.f;
        for (int c0 = 0; c0 < NCH; c0 += 8) {
            u32x2 cl[8]; float nl[8], gg[8], ml[8];
#pragma unroll
            for (int i = 0; i < 8; ++i) { cl[i] = *(const u32x2*)(st + (size_t)(c0 + i) * 32768); nl[i] = nth ? ns[(c0 + i) * 128] : 0.f; gg[i] = cs[(c0 + i) * 4]; ml[i] = cs[(c0 + i) * 4 + 1]; }
#pragma unroll
            for (int i = 0; i < 8; ++i) {
                u32x2 o; o.x = pk2(C[0], C[1]); o.y = pk2(C[2], C[3]);
                *(u32x2*)(st + (size_t)(c0 + i) * 32768) = o;
                if (nth) ns[(c0 + i) * 128] = nv;
                if (part == 0 && tid == 0) cs[(c0 + i) * 4 + 2] = m;
                const float mn = fmaxf(gg[i] + m, ml[i]); const float dec = __expf(gg[i] + m - mn), sc = __expf(ml[i] - mn);
                C[0] = dec * C[0] + sc * bflo(cl[i].x); C[1] = dec * C[1] + sc * bfhi(cl[i].x); C[2] = dec * C[2] + sc * bflo(cl[i].y); C[3] = dec * C[3] + sc * bfhi(cl[i].y);
                nv = dec * nv + sc * nl[i]; m = mn;
            }
        }
    }
}
__device__ __forceinline__ void mlstm_s3(const Args& a, int l, int hf, unsigned char* ws, LAS unsigned char* lds, int G, int cu, int tid, int wave, int lane, const int out_col) {
    bf16* Zb = (bf16*)(ws + WS_Z); const bf16* ZT = (const bf16*)(ws + WS_ZT);
    const float* gi = (const float*)(ws + WS_GATE); const float* gf = gi + (size_t)M * 4;
    const float* cw = a.in[I_CONVW] + (size_t)l * 4 * 1024; const float* cb = a.in[I_CONVB] + (size_t)l * 1024;
    const float* gain = a.in[I_MNORM] + (size_t)l * 1024;
    LAS bf16* QS = (LAS bf16*)lds;
    LAS bf16* KS = (LAS bf16*)(lds + 17408);
    LAS bf16* SD = (LAS bf16*)(lds + 34816);
    LAS float* HB = (LAS float*)(lds + 44032);
    LAS float* SC = (LAS float*)(lds + 110592);
    LAS float* CWL = (LAS float*)(lds + 112384);
    const int c8 = tid & 15; int hcur = -1;
    for (int u = cu; u < 16 * NCH; u += G) {
        const int h = u & 3, c = (u >> 2) & 63, bl = u >> 8, bhl = bl * 4 + h; const int tokg = (hf * 4 + bl) * SEQ + c * LCH; const int tokl = bl * SEQ + c * LCH;
        if (h != hcur) { __syncthreads(); stage_convw(CWL, cw, cb, h * 128, 128, 0, 256, tid); stage_convw(CWL, cw, cb, 512 + h * 128, 128, 128, 256, tid); hcur = h; __syncthreads(); }
        const int r = lane & 31, hh = lane >> 5, v0 = 32 * wave;
        bf16x8 bV[4], bC[8];
        { const bf16* vrow = ZT + (size_t)(h * 256 + v0 + r) * ZTLD + tokl + 8 * hh;
          const bf16* crow = (const bf16*)(ws + WS_ST) + (size_t)(bhl * NCH + c) * 32768 + (size_t)(v0 + r) * 128 + 8 * hh;
#pragma unroll
          for (int ks = 0; ks < 4; ++ks) bV[ks] = *(const bf16x8*)(vrow + 16 * ks);
#pragma unroll
          for (int ks = 0; ks < 8; ++ks) bC[ks] = *(const bf16x8*)(crow + 16 * ks); }
        if (wave == 0) {
            const float lf = gf[(size_t)(tokg + lane) * 4 + h], ii = gi[(size_t)(tokg + lane) * 4 + h];
            const float bc = wave_incl_scan_add(lf, lane); const float rr = ii - bc; const float cm = wave_incl_scan_max(rr, lane);
            const float mst = ((const float*)(ws + WS_CSC))[(size_t)(bhl * NCH + c) * 4 + 2];
            const float Mt = fmaxf(mst, cm);
            SC[lane] = rr; SC[64 + lane] = Mt; SC[128 + lane] = __expf(mst - Mt); SC[192 + lane] = __expf(-(bc + Mt));
        } else if (wave == 1 || wave == 2) { const int d = (wave - 1) * 64 + lane; SC[320 + d] = ((const float*)(ws + WS_NST))[(size_t)(bhl * NCH + c) * 128 + d]; }
#pragma unroll
        for (int rep = 0; rep < 2; ++rep) { const int idx = tid + rep * NTHR, t = idx >> 4; float o[8];
            conv8l(Zb, bl, c * LCH + t, h * 128 + c8 * 8, CWL + c8 * 8, 256, o);
            u32x4 w; w.x = pk2(o[0], o[1]); w.y = pk2(o[2], o[3]); w.z = pk2(o[4], o[5]); w.w = pk2(o[6], o[7]);
            *(LAS u32x4*)(QS + t * 136 + c8 * 8) = w;
            conv8l(Zb, bl, c * LCH + t, 512 + h * 128 + c8 * 8, CWL + 128 + c8 * 8, 256, o);
            w.x = pk2(o[0] * KSCALE, o[1] * KSCALE); w.y = pk2(o[2] * KSCALE, o[3] * KSCALE); w.z = pk2(o[4] * KSCALE, o[5] * KSCALE); w.w = pk2(o[6] * KSCALE, o[7] * KSCALE);
            *(LAS u32x4*)(KS + t * 136 + c8 * 8) = w; }
        __syncthreads();
        {
            const int tb = wave >> 1, fr = lane & 15, fq = lane >> 4;
#pragma unroll
            for (int i = 0; i < 2; ++i) { const int sblk = (wave & 1) * 2 + i; f32x4 acc = (f32x4){0.f, 0.f, 0.f, 0.f};
                if (sblk <= tb) {
#pragma unroll
                    for (int ks = 0; ks < 4; ++ks) { const bf16x8 af = *(const LAS bf16x8*)(QS + (16 * tb + fr) * 136 + 32 * ks + 8 * fq), bfv = *(const LAS bf16x8*)(KS + (16 * sblk + fr) * 136 + 32 * ks + 8 * fq);
                        acc = __builtin_amdgcn_mfma_f32_16x16x32_bf16(af, bfv, acc, 0, 0, 0); } }
                const int s = 16 * sblk + fr; const float rs_ = SC[s];
#pragma unroll
                for (int e = 0; e < 4; ++e) { const int t = 16 * tb + 4 * fq + e; const float val = (s <= t) ? acc[e] * __expf(rs_ - SC[64 + t]) : 0.f; SD[t * 72 + s] = (bf16)f2bf(val); } }
        }
        f32x16 aQ0, aQ1, aS0, aS1;
#pragma unroll
        for (int e = 0; e < 16; ++e) { aQ0[e] = 0.f; aQ1[e] = 0.f; aS0[e] = 0.f; aS1[e] = 0.f; }
#pragma unroll
        for (int ks = 0; ks < 8; ++ks) {
            const bf16x8 a0 = *(const LAS bf16x8*)(QS + r * 136 + 16 * ks + 8 * hh), a1 = *(const LAS bf16x8*)(QS + (32 + r) * 136 + 16 * ks + 8 * hh);
            aQ0 = __builtin_amdgcn_mfma_f32_32x32x16_bf16(a0, bC[ks], aQ0, 0, 0, 0); aQ1 = __builtin_amdgcn_mfma_f32_32x32x16_bf16(a1, bC[ks], aQ1, 0, 0, 0); }
        __syncthreads();
        {
            const int t = tid >> 3, p = tid & 7; float ds = 0.f, qn = 0.f;
#pragma unroll
            for (int k = 0; k < 8; ++k) ds += bf1(SD[t * 72 + 8 * p + k]);
#pragma unroll
            for (int k = 0; k < 16; ++k) qn += bf1(QS[t * 136 + 16 * p + k]) * SC[320 + 16 * p + k];
            float den = ds + SC[128 + t] * qn;
            den += __shfl_xor(den, 1); den += __shfl_xor(den, 2); den += __shfl_xor(den, 4);
            if (p == 0) SC[256 + t] = 1.f / fmaxf(fabsf(den), SC[192 + t]);
        }
#pragma unroll
        for (int ks = 0; ks < 4; ++ks) {
            const bf16x8 a0 = *(const LAS bf16x8*)(SD + r * 72 + 16 * ks + 8 * hh), a1 = *(const LAS bf16x8*)(SD + (32 + r) * 72 + 16 * ks + 8 * hh);
            aS0 = __builtin_amdgcn_mfma_f32_32x32x16_bf16(a0, bV[ks], aS0, 0, 0, 0); aS1 = __builtin_amdgcn_mfma_f32_32x32x16_bf16(a1, bV[ks], aS1, 0, 0, 0); }
        __syncthreads();
#pragma unroll
        for (int e = 0; e < 16; ++e) { const int t0 = (e & 3) + 8 * (e >> 2) + 4 * hh;
            HB[t0 * 260 + v0 + r] = (aS0[e] + SC[128 + t0] * aQ0[e]) * SC[256 + t0]; HB[(32 + t0) * 260 + v0 + r] = (aS1[e] + SC[128 + 32 + t0] * aQ1[e]) * SC[256 + 32 + t0]; }
        __syncthreads();
#pragma unroll
        for (int i = 0; i < 8; ++i) { const int t = 8 * wave + i; const f32x4 x = *(const LAS f32x4*)(HB + t * 260 + 4 * lane);
            const float mean = wave_sum((x.x + x.y) + (x.z + x.w)) * (1.f / 256.f); const f32x4 dx = x - mean;
            const float var = wave_sum((dx.x * dx.x + dx.y * dx.y) + (dx.z * dx.z + dx.w * dx.w)) * (1.f / 256.f); const float rstd = rsqrtf(var + EPS);
            const f32x4 gg = *(const f32x4*)(gain + h * 256 + 4 * lane);
            const u32x2 og = *(const u32x2*)(Zb + (size_t)(tokl + t) * ZLD + ZC_O + h * 256 + 4 * lane); u32x2* op = (u32x2*)(Zb + (size_t)(tokl + t) * ZLD + out_col + h * 256 + 4 * lane);
            u32x2 w; w.x = pk2(dx.x * rstd * gg.x * bflo(og.x), dx.y * rstd * gg.y * bfhi(og.x)); w.y = pk2(dx.z * rstd * gg.z * bflo(og.y), dx.w * rstd * gg.w * bfhi(og.y)); *op = w; }
        __syncthreads();
    }
}

__device__ __forceinline__ void sgu_phase(const Args& a, int l, unsigned char* ws, LAS unsigned char* lds, int G, int cu, int tid, int wave, int lane, const int out_col) {
    bf16* Zb = (bf16*)(ws + WS_Z); const bf16* ZT = (const bf16*)(ws + WS_ZT); const bf16* Wc = (const bf16*)(ws + WS_WSGU);
    const float* lng = a.in[I_SLNG] + (size_t)l * 1024; const float* lnb = a.in[I_SLNB] + (size_t)l * 1024; const float* bs = a.in[I_SBS] + (size_t)l * 4 * 128;
    LAS bf16* VT = (LAS bf16*)lds;
    LAS float* PS = (LAS float*)(lds + 69632);
    LAS float* ST = (LAS float*)(lds + 69632 + 4096);
    LAS bf16* WS_ = (LAS bf16*)(lds + 74752);
    int gcur = -1;
    for (int u = cu; u < 4 * 32 * 4; u += G) {
        const int g = u & 3, cc = (u >> 2) & 31, bl = u >> 7; const int tokl = bl * SEQ + cc * 128;
        if (g != gcur) { __syncthreads();
#pragma unroll
            for (int rep = 0; rep < 4; ++rep) { const int idx = tid + rep * NTHR, t = idx >> 4, c8 = idx & 15; *(LAS u32x4*)(WS_ + t * 136 + c8 * 8) = *(const u32x4*)(Wc + (size_t)(g * 128 + t) * 128 + c8 * 8); }
            gcur = g; }
#pragma unroll
        for (int rep = 0; rep < 8; ++rep) { const int idx = tid + rep * NTHR, d = idx >> 4, c8 = idx & 15;
            *(LAS u32x4*)(VT + d * 136 + c8 * 8) = *(const u32x4*)(ZT + (size_t)(1024 + g * 256 + d) * ZTLD + tokl + c8 * 8); }
        __syncthreads();
        { const int s = tid & 127, part = tid >> 7; float sm = 0.f, sq = 0.f;
#pragma unroll 8
            for (int d = part * 64; d < part * 64 + 64; ++d) { const float x = bf1(VT[d * 136 + s]); sm += x; sq += x * x; }
            PS[(part * 128 + s) * 2] = sm; PS[(part * 128 + s) * 2 + 1] = sq; }
        __syncthreads();
        if (tid < 128) { float sm = 0.f, sq = 0.f;
#pragma unroll
            for (int p = 0; p < 4; ++p) { sm += PS[(p * 128 + tid) * 2]; sq += PS[(p * 128 + tid) * 2 + 1]; }
            const float mean = sm * (1.f / 256.f); const float var = fmaxf(sq * (1.f / 256.f) - mean * mean, 0.f); ST[tid] = mean; ST[128 + tid] = rsqrtf(var + EPS); }
        __syncthreads();
#pragma unroll
        for (int rep = 0; rep < 8; ++rep) { const int idx = tid + rep * NTHR, d = idx >> 4, c8 = idx & 15; const float gg = lng[g * 256 + d], bb = lnb[g * 256 + d];
            u32x4 x = *(const LAS u32x4*)(VT + d * 136 + c8 * 8); const LAS float* mp = ST + c8 * 8; const LAS float* rp = ST + 128 + c8 * 8;
            x.x = pk2((bflo(x.x) - mp[0]) * rp[0] * gg + bb, (bfhi(x.x) - mp[1]) * rp[1] * gg + bb); x.y = pk2((bflo(x.y) - mp[2]) * rp[2] * gg + bb, (bfhi(x.y) - mp[3]) * rp[3] * gg + bb);
            x.z = pk2((bflo(x.z) - mp[4]) * rp[4] * gg + bb, (bfhi(x.z) - mp[5]) * rp[5] * gg + bb); x.w = pk2((bflo(x.w) - mp[6]) * rp[6] * gg + bb, (bfhi(x.w) - mp[7]) * rp[7] * gg + bb);
            *(LAS u32x4*)(VT + d * 136 + c8 * 8) = x; }
        __syncthreads();
        {
            const int r = lane & 31, hh = lane >> 5, d0 = 32 * wave;
            f32x16 acc[4];
#pragma unroll
            for (int tb = 0; tb < 4; ++tb)
#pragma unroll
                for (int e = 0; e < 16; ++e) acc[tb][e] = 0.f;
#pragma unroll
            for (int ks = 0; ks < 8; ++ks) { const bf16x8 af = *(const LAS bf16x8*)(VT + (d0 + r) * 136 + 16 * ks + 8 * hh);
#pragma unroll
                for (int tb = 0; tb < 4; ++tb) if (16 * ks <= 32 * tb + 31) { const bf16x8 bfv = *(const LAS bf16x8*)(WS_ + (32 * tb + r) * 136 + 16 * ks + 8 * hh);
                    acc[tb] = __builtin_amdgcn_mfma_f32_32x32x16_bf16(af, bfv, acc[tb], 0, 0, 0); } }
#pragma unroll
            for (int tb = 0; tb < 4; ++tb) { const int t = 32 * tb + r; const float bias = bs[g * 128 + t]; bf16* rowp = Zb + (size_t)(tokl + t) * ZLD + ZC_U + g * 256 + d0 + 4 * hh; const int oshift = out_col - ZC_U;
#pragma unroll
                for (int q = 0; q < 4; ++q) { const u32x2 uu = *(const u32x2*)(rowp + 8 * q); u32x2* op = (u32x2*)(rowp + oshift + 8 * q); u32x2 w;
                    w.x = pk2(bflo(uu.x) * (acc[tb][4 * q] + bias), bfhi(uu.x) * (acc[tb][4 * q + 1] + bias)); w.y = pk2(bflo(uu.y) * (acc[tb][4 * q + 2] + bias), bfhi(uu.y) * (acc[tb][4 * q + 3] + bias)); *op = w; } }
        }
        __syncthreads();
    }
}

__device__ __forceinline__ void softmax_rows(unsigned char* ws, int gw, int NGW, int lane) {
    bf16* Zb = (bf16*)(ws + WS_Z);
    for (int m = gw; m < MH; m += NGW) {
        u32x4* p = (u32x4*)(Zb + (size_t)m * ZLD + ZC_XQ + 16 * lane); const u32x4 x0 = p[0], x1 = p[1];
        float v[16] = { bflo(x0.x), bfhi(x0.x), bflo(x0.y), bfhi(x0.y), bflo(x0.z), bfhi(x0.z), bflo(x0.w), bfhi(x0.w), bflo(x1.x), bfhi(x1.x), bflo(x1.y), bfhi(x1.y), bflo(x1.z), bfhi(x1.z), bflo(x1.w), bfhi(x1.w) };
        float mx = v[0];
#pragma unroll
        for (int e = 1; e < 16; ++e) mx = fmaxf(mx, v[e]);
#pragma unroll
        for (int o = 1; o < 16; o <<= 1) mx = fmaxf(mx, __shfl_xor(mx, o));
        float s = 0.f;
#pragma unroll
        for (int e = 0; e < 16; ++e) { v[e] = __expf(v[e] - mx); s += v[e]; }
#pragma unroll
        for (int o = 1; o < 16; o <<= 1) s += __shfl_xor(s, o);
        const float inv = 1.f / s;
        u32x4 y0, y1; y0.x = pk2(v[0] * inv, v[1] * inv); y0.y = pk2(v[2] * inv, v[3] * inv); y0.z = pk2(v[4] * inv, v[5] * inv); y0.w = pk2(v[6] * inv, v[7] * inv);
        y1.x = pk2(v[8] * inv, v[9] * inv); y1.y = pk2(v[10] * inv, v[11] * inv); y1.z = pk2(v[12] * inv, v[13] * inv); y1.w = pk2(v[14] * inv, v[15] * inv);
        p[0] = y0; p[1] = y1;
    }
}

__global__ void __launch_bounds__(NTHR, 2) trunk_fwd(Args args) {
    extern __shared__ __attribute__((aligned(16))) unsigned char lds_raw[];
    LAS unsigned char* lds = (LAS unsigned char*)lds_raw;
    volatile LAS unsigned* MISC = (volatile LAS unsigned*)(lds + MISC_OFF);
    const int G = gridDim.x, cu = blockIdx.x;
    unsigned char* ws = args.ws;
#define PHASE_IDS() int tid = threadIdx.x; asm volatile("" : "+v"(tid)); const int lane = tid & 63, wave = __builtin_amdgcn_readfirstlane(tid >> 6); \
    const int vcu = (G % 8 == 0) ? (cu % 8) * (G / 8) + cu / 8 : cu; const int gw = vcu * NWAVES + wave, NGW = G * NWAVES, gtid = cu * NTHR + tid, GT = G * NTHR; (void)gw; (void)NGW; (void)gtid; (void)GT; (void)lane
    for (int u = threadIdx.x; u < (LDS_BYTES - RING_BYTES) / 4; u += NTHR) ((LAS unsigned*)(lds + RING_BYTES))[u] = 0u;
    __syncthreads();
    XcdBarrier bar = xcd_barrier_post((unsigned*)(ws + WS_CTL) + 4096, MISC + 8);
    const int lo = args.ph_lo, hi = args.ph_hi;
    int ph = 0;
#define IN() (lo <= ph && ph < hi)
#define SEAM() do { if (lo <= ph && ph + 1 < hi) xcd_barrier(bar); ++ph; } while (0)
    bf16* XN = (bf16*)(ws + WS_XN); bf16* Wb = (bf16*)(ws + WS_W); float* RSTD = (float*)(ws + WS_RSTD);
    float* hbuf = args.out;

    if (IN()) { PHASE_IDS();
        convert_layer(args, 0, ws, lds, gw, NGW, wave, lane, gtid, GT);
        thin_rows(nullptr, 0, nullptr, 0.f, args.in[I_X], nullptr, XN, RSTD, nullptr, 0, M, gw, NGW, lane, false, nullptr, nullptr, nullptr, nullptr, nullptr);
        __syncthreads();
    }
    SEAM();

    for (int sb = 0; sb < 2 * DEPTH; ++sb) {
        const int l = sb >> 1, j = sb & 1;
        const float* ng = args.in[I_NORMG] + (size_t)l * NNORM * D;
        if (IN()) { PHASE_IDS();
            pg8::Gemm g{D, D, D}; pg8::TileSched S; S.init(M / 256, 2 * DFF / 256, G, cu, XN, D * 2, (char*)Wb + (j ? WO_GU1 : WO_GU0), D * 2);
            pg8::EpiGU E{(bf16*)(ws + WS_HID), RSTD};
            pg8::gemm_phase(lds, g, S, E, tid);
        }
        SEAM();
        if (IN()) { PHASE_IDS();
            pg8::Gemm g{DFF, DFF, DFF}; pg8::TileSched S; S.init(M / 256, D / 256, G, cu, ws + WS_HID, DFF * 2, (char*)Wb + (j ? WO_D1 : WO_D0), DFF * 2);
            pg8::EpiAct E{(bf16*)(ws + WS_F), (size_t)D, 0, nullptr, nullptr};
            pg8::gemm_phase(lds, g, S, E, tid);
        }
        SEAM();
        if (IN()) { PHASE_IDS();
            const float* hin = (sb == 0) ? args.in[I_X] : hbuf;
            if (j == 0) {
                LAS float* wif = (LAS float*)lds;
                const float* win = args.in[I_WIN] + (size_t)l * D * WIN_COLS;
                for (int e = tid; e < D * 8; e += NTHR) wif[e] = win[(size_t)(e >> 3) * WIN_COLS + 3072 + (e & 7)] * ng[2 * D + (e >> 3)];
                __syncthreads();
                float* gi = (float*)(ws + WS_GATE);
                thin_rows((const bf16*)(ws + WS_F), D, ng + 1 * D, 0.5f, (sb == 0) ? args.in[I_X] : nullptr, XN, XN, RSTD, nullptr, 0, M, gw, NGW, lane, true, wif, args.in[I_BI] + l * 4, args.in[I_BF] + l * 4, gi, gi + (size_t)M * 4);
                __syncthreads();
                {
                    pg8::Gemm g{D, D, D};
                    pg8::TileSched S; S.init(MMEM / 256, D / 256, G, cu, ws + WS_MEMN, D * 2, (char*)Wb + WO_MKV, D * 2);
                    pg8::EpiAct E{(bf16*)(ws + WS_KMEM), (size_t)D, 0, nullptr, nullptr};
                    pg8::gemm_phase(lds, g, S, E, tid);
                    pg8::TileSched S2; S2.init(D / 256, MMEM / 256, G, (cu + G / 2) % G, (char*)Wb + WO_MKV + (size_t)D * D * 2, D * 2, ws + WS_MEMN, D * 2);
                    pg8::EpiAct E2{(bf16*)(ws + WS_VTMEM), (size_t)MMEM, 0, nullptr, nullptr};
                    pg8::gemm_phase(lds, g, S2, E2, tid);
                }
            } else {
                const bool lastl = (l + 1 == DEPTH);
                thin_rows((const bf16*)(ws + WS_F), D, ng + 5 * D, 0.5f, nullptr, XN, lastl ? nullptr : XN, RSTD, lastl ? hbuf : nullptr, 0, M, gw, NGW, lane, false, nullptr, nullptr, nullptr, nullptr, nullptr);
                if (l + 1 < DEPTH) { __syncthreads(); convert_layer(args, l + 1, ws, lds, gw, NGW, wave, lane, gtid, GT); __syncthreads(); }
            }
        }
        SEAM();
        if (j == 0) {
            for (int hf = 0; hf < 2; ++hf) {
                bf16* Zb = (bf16*)(ws + WS_Z);
                if (IN()) { PHASE_IDS();
                    pg8::Gemm g{D, D, D};
                    pg8::TileSched S; S.init(MH / 256, ZLD / 256, G, cu, XN + (size_t)hf * MH * D, D * 2, (char*)Wb + WO_IN, D * 2);
                    pg8::EpiAct E{Zb, (size_t)ZLD, 1, RSTD + (size_t)hf * MH, nullptr};
                    pg8::gemm_phase(lds, g, S, E, tid);
                    pg8::TileSched S2; S2.init(2048 / 256, MH / 256, G, cu, (char*)Wb + WO_IN + (size_t)ZLD * D * 2, D * 2, XN + (size_t)hf * MH * D, D * 2);
                    pg8::EpiAct E2{(bf16*)(ws + WS_ZT), (size_t)ZTLD, 2, nullptr, RSTD + (size_t)hf * MH};
                    pg8::gemm_phase(lds, g, S2, E2, tid);
                }
                SEAM();
                if (IN()) { PHASE_IDS();
                    mlstm_s1(args, l, hf, ws, lds, G, cu, tid, wave, lane);
                    sgu_phase(args, l, ws, lds, G, cu, tid, wave, lane, ZC_U);
                    pg8::Gemm g{256, ZLD, D};
                    pg8::TileSched S; S.init(MH / 256, 4, G, cu, Zb + ZC_XQ, ZLD * 2, (bf16*)(ws + WS_KMEM) + (size_t)hf * 4 * MEMLEN * D, 0);
                    S.a_pn = 512; S.b_tile = 512; S.pm_per_b = 16; S.b_batch = (size_t)MEMLEN * D * 2;
                    pg8::EpiAct E{Zb + ZC_XQ, (size_t)ZLD, 0, nullptr, nullptr};
                    pg8::gemm_phase(lds, g, S, E, tid);
                }
                SEAM();
                if (IN()) { PHASE_IDS();
                    mlstm_s2(ws, G, cu, tid);
                    softmax_rows(ws, gw, NGW, lane);
                }
                SEAM();
                if (IN()) { PHASE_IDS();
                    mlstm_s3(args, l, hf, ws, lds, G, cu, tid, wave, lane, ZC_O);
#ifdef PROBE_S3
                    for (int rep_ = 0; rep_ < 2; ++rep_) mlstm_s3(args, l, hf, ws, lds, G, cu, tid, wave, lane, ZC_QK);
#endif
#ifdef PROBE_SGU
                    for (int rep_ = 0; rep_ < 2; ++rep_) sgu_phase(args, l, ws, lds, G, cu, tid, wave, lane, ZC_QK);
#endif
                    pg8::Gemm g{256, ZLD, MMEM};
                    pg8::TileSched S; S.init(MH / 256, 4, G, cu, Zb + ZC_XQ, ZLD * 2, (bf16*)(ws + WS_VTMEM) + (size_t)hf * 4 * MEMLEN, 0);
                    S.a_pn = 512; S.b_tile = (size_t)256 * MMEM * 2; S.pm_per_b = 16; S.b_batch = (size_t)MEMLEN * 2;
                    pg8::EpiAct E{Zb + ZC_XQ, (size_t)ZLD, 0, nullptr, nullptr};
                    pg8::gemm_phase(lds, g, S, E, tid);
                }
                SEAM();
                if (IN()) { PHASE_IDS();
                    pg8::Gemm g{D, ZLD, D};
                    pg8::TileSched S; S.init(MH / 256, D / 256, G, cu, Zb + ZC_O, ZLD * 2, (char*)Wb + WO_BR, D * 2);
                    S.reps = 3; S.a_rep = 1024 * 2; S.b_rep = (size_t)D * D * 2;
                    pg8::EpiBranch E{Zb};
                    pg8::gemm_phase(lds, g, S, E, tid);
                }
                SEAM();
                if (IN()) { PHASE_IDS();
                    pg8::Gemm g{D, ZLD, D};
                    pg8::TileSched S; S.init(MH / 256, D / 256, G, cu, Zb + ZC_QK, ZLD * 2, (char*)Wb + WO_OUT, D * 2);
                    pg8::EpiAct E{Zb + ZC_O, (size_t)ZLD, 0, nullptr, nullptr};
                    pg8::gemm_phase(lds, g, S, E, tid);
                }
                SEAM();
                if (IN()) { PHASE_IDS();
                    thin_rows(Zb + ZC_O, ZLD, ng + 3 * D, 1.0f, nullptr, XN, XN, RSTD, nullptr, hf * MH, (hf + 1) * MH, gw, NGW, lane, false, nullptr, nullptr, nullptr, nullptr, nullptr);
                }
                SEAM();
            }
        }
    }
#undef IN
#undef SEAM
}
constexpr int N_PHASES = 1 + 2 * DEPTH * 3 + DEPTH * 2 * 7;

#ifndef N_LAUNCH_MODE
#define N_LAUNCH_MODE 0
#endif
extern "C" void kernel_launch(void* const* d_in, const int* in_sizes, int n_in, void* d_out, int out_size, void* d_ws, size_t ws_size, hipStream_t stream) {
    static int grid = 0;
    if (grid == 0) {
        if (n_in != 18 || out_size != M * D || ws_size < WS_END) { fprintf(stderr, "kernel_launch: unexpected shapes (n_in %d out %d ws %zu)\n", n_in, out_size, ws_size); grid = -1; return; }
        int dev = 0, cus = 0, per_cu = 0;
        if (hipGetDevice(&dev) != hipSuccess || hipDeviceGetAttribute(&cus, hipDeviceAttributeMultiprocessorCount, dev) != hipSuccess) { grid = -1; return; }
        if (hipFuncSetAttribute((const void*)trunk_fwd, hipFuncAttributeMaxDynamicSharedMemorySize, LDS_BYTES) != hipSuccess) { grid = -1; return; }
        if (hipOccupancyMaxActiveBlocksPerMultiprocessor(&per_cu, (const void*)trunk_fwd, NTHR, LDS_BYTES) != hipSuccess || per_cu < 1) { fprintf(stderr, "kernel_launch: occupancy query says %d\n", per_cu); }
        (void)hipGetLastError();
        grid = cus;
    }
    if (grid < 0) return;
    (void)hipMemsetAsync((char*)d_ws + WS_CTL, 0, CTL_ZERO_BYTES, stream);
    Args a{};
    for (int i = 0; i < 18; ++i) a.in[i] = (const float*)d_in[i];
    a.out = (float*)d_out; a.ws = (unsigned char*)d_ws;
#if N_LAUNCH_MODE == 0
    a.ph_lo = 0; a.ph_hi = N_PHASES;
    hipLaunchKernelGGL(trunk_fwd, dim3(grid), dim3(NTHR), LDS_BYTES, stream, a);
#else
    for (int p = 0; p < N_PHASES; ++p) { a.ph_lo = p; a.ph_hi = p + 1; hipLaunchKernelGGL(trunk_fwd, dim3(grid), dim3(NTHR), LDS_BYTES, stream, a); }
#endif
}
```

```cpp
#include <hip/hip_runtime.h>
#include <cstdio>
#include <cstdint>

#define LAS __attribute__((address_space(3)))
#define GAS __attribute__((address_space(1)))
typedef unsigned short bf16;
typedef short bf16x8 __attribute__((ext_vector_type(8)));
typedef float f32x4 __attribute__((ext_vector_type(4)));
typedef float f32x16 __attribute__((ext_vector_type(16)));
typedef unsigned u32x4 __attribute__((ext_vector_type(4)));
typedef unsigned u32x2 __attribute__((ext_vector_type(2)));

constexpr int D = 1024, BATCH = 8, SEQ = 4096, DEPTH = 2, MEMLEN = 256, DFF = 2816, NNORM = 7;
constexpr int M = BATCH * SEQ, MH = M / 2, MMEM = BATCH * MEMLEN;
constexpr int WIN_COLS = 9224;
constexpr int LCH = 64, NCH = SEQ / LCH;
constexpr int ZLD = 7168;
constexpr int ZC_QK = 0, ZC_O = 1024, ZC_U = 2048, ZC_XQ = 3072, ZC_G = 4096;
constexpr int ZTLD = MH;
constexpr float EPS = 1e-6f;
constexpr int NWAVES = 8, NTHR = 512;

constexpr size_t MiB = 1u << 20;
constexpr size_t WS_CTL = 0, CTL_ZERO_BYTES = 1 * MiB;
constexpr size_t WS_WSGU = 1 * MiB;
constexpr size_t WS_GATE = 2 * MiB;
constexpr size_t WS_NST = 3 * MiB;
constexpr size_t WS_CSC = 4 * MiB;
constexpr size_t WS_MEMN = 5 * MiB;
constexpr size_t WS_KMEM = 9 * MiB;
constexpr size_t WS_VTMEM = 13 * MiB;
constexpr size_t WS_W = 17 * MiB;
constexpr size_t WO_GU0 = 0, WO_GU1 = 11 * MiB, WO_D0 = 22 * MiB, WO_D1 = WO_D0 + 5632 * 1024, WO_IN = 33 * MiB, WO_MKV = 51 * MiB, WO_BR = 55 * MiB, WO_OUT = 61 * MiB;
constexpr size_t WS_XN = 80 * MiB;
constexpr size_t WS_RSTD = 4 * MiB + 512 * 1024;
constexpr size_t WS_BIG = 144 * MiB;
constexpr size_t WS_HID = WS_BIG, WS_F = WS_BIG + 176 * MiB, WS_Z = WS_BIG, WS_ZT = WS_BIG + 224 * MiB;
constexpr size_t WS_ST = 432 * MiB;
constexpr size_t WS_END = 496 * MiB;

constexpr int LDS_BYTES = 147456;
constexpr int RING_BYTES = 131072;
constexpr int MISC_OFF = RING_BYTES + 320;

typedef float f32x2_t __attribute__((ext_vector_type(2))); typedef __bf16 bf16x2_t __attribute__((ext_vector_type(2)));
__device__ __forceinline__ unsigned pk2(float lo, float hi) { f32x2_t v = {lo, hi}; bf16x2_t b = __builtin_convertvector(v, bf16x2_t); return __builtin_bit_cast(unsigned, b); }
__device__ __forceinline__ unsigned f2bf(float f) { return pk2(f, 0.f) & 0xffffu; }
__device__ __forceinline__ float bflo(unsigned w) { return __uint_as_float(w << 16); }
__device__ __forceinline__ float bfhi(unsigned w) { return __uint_as_float(w & 0xffff0000u); }
__device__ __forceinline__ float bf1(bf16 b) { return __uint_as_float((unsigned)b << 16); }
__device__ __forceinline__ float wave_sum(float v) {
#pragma unroll
    for (int o = 1; o < 64; o <<= 1) v += __shfl_xor(v, o);
    return v;
}
__device__ __forceinline__ float sigmoidf_(float x) { return __builtin_amdgcn_rcpf(1.f + __expf(-x)); }
__device__ __forceinline__ float siluf_(float x) { return x * __builtin_amdgcn_rcpf(1.f + __expf(-x)); }
__device__ __forceinline__ float gelu_tanh(float x) { const float u = 1.5957691216f * (x + 0.044715f * x * x * x); return x * __builtin_amdgcn_rcpf(1.f + __expf(-u)); }
__device__ __forceinline__ float logsigmoidf_(float x) { return fminf(x, 0.f) - log1pf(__expf(-fabsf(x))); }
#define LDS_WAIT() asm volatile("s_waitcnt lgkmcnt(0)" ::: "memory")
#define VM_WAIT() asm volatile("s_waitcnt vmcnt(0)" ::: "memory")

namespace pg8 {
constexpr int BM = 256, BK = 64, HALF = 128, HTB = HALF * BK * 2, STAGE_BYTES = 8 * HTB, NXCD = 8, WGM = 8;
__host__ __device__ __forceinline__ int lds_byte(int r, int c) { const int st = (r >> 4) * 2 + (c >> 5), rr = r & 15, cc = c & 31, ob = rr * 64 + cc * 2; return st * 1024 + (ob ^ (((ob >> 9) & 1) << 5)); }
__host__ __device__ __forceinline__ void stage_rc(int b, int& R, int& C) { const int st = b / 1024, sb = b % 1024, swz = sb ^ (((sb >> 9) & 1) << 5); R = (st >> 1) * 16 + swz / 64; C = (st & 1) * 32 + (swz % 64) / 2; }
__host__ __device__ __forceinline__ int perm32(int rho) { const int n = rho >> 4, i = rho & 15; return 8 * (i >> 2) + 4 * n + (i & 3); }

struct Unit { int pm, pn, aux; const char* a; const char* b; };
struct Gemm { int K, lda, ldb; };

struct TileSched {
    int nM, nN, nwg, G, c, reps, pm_per_b;
    const char* A; const char* B;
    size_t a_tile, a_pn, a_rep, b_tile, b_batch, b_rep;
    __device__ __forceinline__ void init(int nM_, int nN_, int G_, int c_, const void* A_, size_t lda_bytes, const void* B_, size_t ldb_bytes) {
        nM = nM_; nN = nN_; nwg = nM * nN; G = G_; c = c_; reps = 1; pm_per_b = 1 << 30; A = (const char*)A_; B = (const char*)B_;
        a_tile = 256 * lda_bytes; a_pn = 0; a_rep = 0; b_tile = 256 * ldb_bytes; b_batch = 0; b_rep = 0;
    }
    __device__ __forceinline__ bool next(int i, Unit& u) const {
        const int ti = i / reps, aux = i - ti * reps;
        const long L = (long)ti * G + c; if (L >= nwg) return false;
        int wgid = (int)L; { const int q = nwg / NXCD, r = nwg % NXCD, xcd = wgid % NXCD, off = wgid / NXCD; wgid = (xcd < r ? xcd * (q + 1) : r * (q + 1) + (xcd - r) * q) + off; }
        const int nig = WGM * nN, gid = wgid / nig, fm = gid * WGM, gsz = (nM - fm) < WGM ? (nM - fm) : WGM;
        u.pm = fm + ((wgid % nig) % gsz); u.pn = (wgid % nig) / gsz; u.aux = aux;
        u.a = A + (size_t)u.pm * a_tile + (size_t)u.pn * a_pn + (size_t)aux * a_rep;
        u.b = B + (size_t)u.pn * b_tile + (size_t)(u.pm / pm_per_b) * b_batch + (size_t)aux * b_rep;
        return true;
    }
};

__device__ __forceinline__ unsigned cvt_pk_bf16(float lo, float hi) { return pk2(lo, hi); }

template <int ACT> __device__ __forceinline__ float actf(float x) {
    if (ACT == 1) return sigmoidf_(x);
    if (ACT == 2) return gelu_tanh(x);
    if (ACT == 3) return x * 0.0625f;
    return x;
}
template <int ACT> __device__ __forceinline__ void store_tile_bf16(const f32x4 (&acc)[2][2][4][2], bf16* O, size_t ldc, int row0, int col0, const float* rsrow, const float* rscol) {
    f32x4 cs[2][2];
#pragma unroll
    for (int bj = 0; bj < 2; ++bj)
#pragma unroll
        for (int n = 0; n < 2; ++n) cs[bj][n] = rscol ? *(const f32x4*)(rscol + col0 + bj * HALF + 4 * n) : (f32x4){1.f, 1.f, 1.f, 1.f};
#pragma unroll
    for (int ai = 0; ai < 2; ++ai)
#pragma unroll
        for (int m = 0; m < 4; ++m) { const int row = row0 + ai * HALF + m * 16; bf16* rowp = O + (size_t)row * ldc + col0; const float rr = rsrow ? rsrow[row] : 1.f;
#pragma unroll
            for (int bj = 0; bj < 2; ++bj) { const f32x4 v0 = acc[ai][bj][m][0] * cs[bj][0] * rr, v1 = acc[ai][bj][m][1] * cs[bj][1] * rr; u32x4 w;
                w.x = cvt_pk_bf16(actf<ACT>(v0[0]), actf<ACT>(v0[1])); w.y = cvt_pk_bf16(actf<ACT>(v0[2]), actf<ACT>(v0[3]));
                w.z = cvt_pk_bf16(actf<ACT>(v1[0]), actf<ACT>(v1[1])); w.w = cvt_pk_bf16(actf<ACT>(v1[2]), actf<ACT>(v1[3]));
                *(u32x4*)(rowp + bj * HALF) = w; } }
}
struct EpiAct {
    static constexpr bool PERM = true;
    bf16* O; size_t ldc; int mode; const float* rsrow; const float* rscol;
    __device__ __forceinline__ void operator()(const f32x4 (&acc)[2][2][4][2], const Unit& u, int wr, int wc, int fr, int fq) const {
        const int row0 = u.pm * BM + wr * 64 + fr, col0 = u.pn * BM + wc * 32 + 8 * fq;
        int act = 0;
        if (mode == 1) { const int g = u.pn >> 2; act = (g == 0) ? 0 : (g == 1) ? 1 : (g == 2) ? 2 : (g == 3) ? 3 : 1; }
        else if (mode == 2) act = (u.pm >= 4) ? 2 : 0;
        if (act == 0) store_tile_bf16<0>(acc, O, ldc, row0, col0, rsrow, rscol);
        else if (act == 1) store_tile_bf16<1>(acc, O, ldc, row0, col0, rsrow, rscol);
        else if (act == 2) store_tile_bf16<2>(acc, O, ldc, row0, col0, rsrow, rscol);
        else store_tile_bf16<3>(acc, O, ldc, row0, col0, rsrow, rscol);
    }
};
struct EpiGU {
    static constexpr bool PERM = true;
    bf16* O; const float* rsrow;
    __device__ __forceinline__ void operator()(const f32x4 (&acc)[2][2][4][2], const Unit& u, int wr, int wc, int fr, int fq) const {
        const int row0 = u.pm * BM + wr * 64 + fr, col0 = u.pn * HALF + wc * 32 + 8 * fq;
#pragma unroll
        for (int ai = 0; ai < 2; ++ai)
#pragma unroll
            for (int m = 0; m < 4; ++m) { const int row = row0 + ai * HALF + m * 16; bf16* rowp = O + (size_t)row * DFF + col0; const float rr = rsrow[row];
                const f32x4 g0 = acc[ai][0][m][0] * rr, g1 = acc[ai][0][m][1] * rr, u0 = acc[ai][1][m][0] * rr, u1 = acc[ai][1][m][1] * rr; u32x4 w;
                w.x = cvt_pk_bf16(siluf_(g0[0]) * u0[0], siluf_(g0[1]) * u0[1]); w.y = cvt_pk_bf16(siluf_(g0[2]) * u0[2], siluf_(g0[3]) * u0[3]);
                w.z = cvt_pk_bf16(siluf_(g1[0]) * u1[0], siluf_(g1[1]) * u1[1]); w.w = cvt_pk_bf16(siluf_(g1[2]) * u1[2], siluf_(g1[3]) * u1[3]);
                *(u32x4*)rowp = w; }
    }
};
struct EpiBranch {
    static constexpr bool PERM = true;
    bf16* Zb;
    __device__ __forceinline__ void operator()(const f32x4 (&acc)[2][2][4][2], const Unit& u, int wr, int wc, int fr, int fq) const {
        const int row0 = u.pm * BM + wr * 64 + fr, col0 = u.pn * BM + wc * 32 + 8 * fq; const int j = u.aux;
#pragma unroll
        for (int ai = 0; ai < 2; ++ai)
#pragma unroll
            for (int m = 0; m < 4; ++m) { bf16* rowp = Zb + (size_t)(row0 + ai * HALF + m * 16) * ZLD + col0;
#pragma unroll
                for (int bj = 0; bj < 2; ++bj) { const f32x4 v0 = acc[ai][bj][m][0], v1 = acc[ai][bj][m][1];
                    const u32x4 g = *(const u32x4*)(rowp + ZC_G + j * 1024 + bj * HALF);
                    float o[8] = { v0[0] * bflo(g.x), v0[1] * bfhi(g.x), v0[2] * bflo(g.y), v0[3] * bfhi(g.y), v1[0] * bflo(g.z), v1[1] * bfhi(g.z), v1[2] * bflo(g.w), v1[3] * bfhi(g.w) };
                    if (j > 0) { const u32x4 p = *(const u32x4*)(rowp + ZC_QK + bj * HALF);
                        o[0] += bflo(p.x); o[1] += bfhi(p.x); o[2] += bflo(p.y); o[3] += bfhi(p.y); o[4] += bflo(p.z); o[5] += bfhi(p.z); o[6] += bflo(p.w); o[7] += bfhi(p.w); }
                    u32x4 w; w.x = cvt_pk_bf16(o[0], o[1]); w.y = cvt_pk_bf16(o[2], o[3]); w.z = cvt_pk_bf16(o[4], o[5]); w.w = cvt_pk_bf16(o[6], o[7]);
                    *(u32x4*)(rowp + ZC_QK + bj * HALF) = w; } }
    }
};

template <class Epi, class Sched>
__device__ __forceinline__ void gemm_phase(LAS unsigned char* lds, const Gemm g, const Sched& S, const Epi& E, const int tid) {
    const int wid = __builtin_amdgcn_readfirstlane(tid >> 6), lane = tid & 63, wr = wid >> 2, wc = wid & 3, fr = lane & 15, fq = lane >> 4;
    const int nt = g.K / BK;
    unsigned voffA[2], voffB[2];
#pragma unroll
    for (int i = 0; i < 2; ++i) { int R, C; stage_rc(tid * 16 + i * 8192, R, C); const int Rb = Epi::PERM ? ((R & ~31) + perm32(R & 31)) : R;
        voffA[i] = (unsigned)(R * g.lda + C) * 2u; voffB[i] = (unsigned)(Rb * g.ldb + C) * 2u; }
    const size_t kstep = (size_t)(BK * 2);
    const size_t hstepA = (size_t)HALF * g.lda * 2, hstepB = (size_t)HALF * g.ldb * 2;
    const unsigned ldsw = (unsigned)wid * 1024u;
    const int aoff = lds_byte(wr * 64 + fr, fq * 8), boff = lds_byte(wc * 32 + fr, fq * 8);
#define PG8_SA(b, h) (((b) * 2 + (h)) * HTB)
#define PG8_SB(b, h) ((4 + (b) * 2 + (h)) * HTB)
#define PG8_STAGE(bufoff, gbase, voff) do { _Pragma("unroll") for (int _i = 0; _i < 2; ++_i) \
        __builtin_amdgcn_global_load_lds((const unsigned*)((const char*)(gbase) + (voff)[_i]), (LAS unsigned*)(lds + (bufoff) + ldsw + _i * 8192), 16, 0, 0); } while (0)
#define PG8_LDA(dst, b, h) do { _Pragma("unroll") for (int m = 0; m < 4; ++m) _Pragma("unroll") for (int k = 0; k < 2; ++k) dst[m][k] = *(const LAS bf16x8*)(lds + PG8_SA(b, h) + aoff + m * 2048 + k * 1024); } while (0)
#define PG8_LDB(dst, b, h) do { _Pragma("unroll") for (int n = 0; n < 2; ++n) _Pragma("unroll") for (int k = 0; k < 2; ++k) dst[n][k] = *(const LAS bf16x8*)(lds + PG8_SB(b, h) + boff + n * 2048 + k * 1024); } while (0)
#define PG8_MMA(ai, bj, At, Bt) do { __builtin_amdgcn_s_setprio(1); _Pragma("unroll") for (int m = 0; m < 4; ++m) _Pragma("unroll") for (int n = 0; n < 2; ++n) _Pragma("unroll") for (int k = 0; k < 2; ++k) \
        acc[ai][bj][m][n] = __builtin_amdgcn_mfma_f32_16x16x32_bf16(Bt[n][k], At[m][k], acc[ai][bj][m][n], 0, 0, 0); __builtin_amdgcn_s_setprio(0); } while (0)
#define PG8_WAIT_V(n) asm volatile("s_waitcnt vmcnt(" #n ")" ::: "memory")
#define PG8_WAIT_L(n) asm volatile("s_waitcnt lgkmcnt(" #n ")" ::: "memory")
#define PG8_BAR __builtin_amdgcn_s_barrier()
#define PG8_SCHED __builtin_amdgcn_sched_barrier(0)
    Unit cur, nxt; int ui = 0;
    if (!S.next(0, cur)) return;
    f32x4 acc[2][2][4][2];
#pragma unroll
    for (int a = 0; a < 2; ++a)
#pragma unroll
        for (int b = 0; b < 2; ++b)
#pragma unroll
            for (int m = 0; m < 4; ++m)
#pragma unroll
                for (int n = 0; n < 2; ++n) acc[a][b][m][n] = (f32x4){0.f, 0.f, 0.f, 0.f};
    bf16x8 At[4][2], B0[2][2], B1[2][2];
    const char* cA = cur.a; const char* cB = cur.b;
    PG8_STAGE(PG8_SB(0, 0), cB, voffB); PG8_STAGE(PG8_SB(0, 1), cB + hstepB, voffB); PG8_STAGE(PG8_SA(0, 0), cA, voffA); PG8_STAGE(PG8_SA(0, 1), cA + hstepA, voffA);
    if (wr == 1) PG8_BAR;
    PG8_WAIT_V(2); PG8_BAR;
    PG8_STAGE(PG8_SB(1, 0), cB + kstep, voffB); PG8_STAGE(PG8_SA(1, 0), cA + kstep, voffA); PG8_STAGE(PG8_SB(1, 1), cB + hstepB + kstep, voffB);
    PG8_WAIT_V(6); PG8_BAR;
    for (;;) {
        const bool has_next = S.next(ui + 1, nxt);
        const char* nA = has_next ? nxt.a : cA; const char* nB = has_next ? nxt.b : cB;
        for (int t = 0; t < nt; t += 2) {
            const bool last = (t == nt - 2);
            const char* a1 = cA + (size_t)(t + 1) * kstep;
            const char* a2 = last ? nA : cA + (size_t)(t + 2) * kstep; const char* b2 = last ? nB : cB + (size_t)(t + 2) * kstep;
            const char* a3 = a2 + kstep; const char* b3 = b2 + kstep;
            PG8_LDB(B0, 0, 0); PG8_LDB(B1, 0, 1); PG8_SCHED; PG8_LDA(At, 0, 0); PG8_STAGE(PG8_SA(1, 1), a1 + hstepA, voffA);
            PG8_WAIT_V(8); PG8_WAIT_L(0); PG8_BAR; PG8_MMA(0, 0, At, B0); PG8_MMA(0, 1, At, B1); PG8_BAR; PG8_SCHED;
            PG8_LDA(At, 0, 1); PG8_STAGE(PG8_SB(0, 0), b2, voffB); PG8_STAGE(PG8_SB(0, 1), b2 + hstepB, voffB); PG8_STAGE(PG8_SA(0, 0), a2, voffA);
            PG8_WAIT_V(8); PG8_WAIT_L(0); PG8_BAR; PG8_MMA(1, 0, At, B0); PG8_MMA(1, 1, At, B1); PG8_BAR; PG8_SCHED;
            PG8_LDB(B0, 1, 0); PG8_LDB(B1, 1, 1); PG8_SCHED; PG8_LDA(At, 1, 0); PG8_STAGE(PG8_SA(0, 1), a2 + hstepA, voffA);
            PG8_WAIT_V(8); PG8_WAIT_L(0); PG8_BAR; PG8_MMA(0, 0, At, B0); PG8_MMA(0, 1, At, B1); PG8_BAR; PG8_SCHED;
            PG8_LDA(At, 1, 1); PG8_STAGE(PG8_SB(1, 0), b3, voffB); PG8_STAGE(PG8_SB(1, 1), b3 + hstepB, voffB); PG8_STAGE(PG8_SA(1, 0), a3, voffA);
            PG8_WAIT_V(8); PG8_WAIT_L(0); PG8_BAR; PG8_MMA(1, 0, At, B0); PG8_MMA(1, 1, At, B1); PG8_BAR; PG8_SCHED;
        }
        if (wr == 0) PG8_BAR;
        E(acc, cur, wr, wc, fr, fq);
        if (!has_next) break;
#pragma unroll
        for (int a = 0; a < 2; ++a)
#pragma unroll
            for (int b = 0; b < 2; ++b)
#pragma unroll
                for (int m = 0; m < 4; ++m)
#pragma unroll
                    for (int n = 0; n < 2; ++n) acc[a][b][m][n] = (f32x4){0.f, 0.f, 0.f, 0.f};
        cur = nxt; cA = nA; cB = nB; ++ui;
        if (wr == 1) PG8_BAR;
    }
    PG8_WAIT_V(0);
    PG8_BAR;
#undef PG8_SA
#undef PG8_SB
#undef PG8_STAGE
#undef PG8_LDA
#undef PG8_LDB
#undef PG8_MMA
#undef PG8_WAIT_V
#undef PG8_WAIT_L
#undef PG8_BAR
#undef PG8_SCHED
}
}

#define XB_TMO      128
#define XB_XCNT(j)  (256  + 64 * (j))
#define XB_XSUB(j)  (1280 + 64 * (j))
#define XB_XGEN(j)  (2304 + 64 * (j))
#define XB_TOP      3328
#define XB_TOPGEN   3392
#define XCD_BAR_WORDS 3456
#define XB_SPIN_CAP (1u << 18)
__device__ __forceinline__ unsigned xb_ld(unsigned* p)              { return __hip_atomic_load(p, __ATOMIC_RELAXED, __HIP_MEMORY_SCOPE_AGENT); }
__device__ __forceinline__ unsigned xb_add(unsigned* p, unsigned v) { return __hip_atomic_fetch_add(p, v, __ATOMIC_RELAXED, __HIP_MEMORY_SCOPE_AGENT); }
__device__ __forceinline__ unsigned xb_xcc_id() { return (unsigned)__builtin_amdgcn_s_getreg((3 << 11) | 20) & 0xFu; }
#define XB_SPIN(cond, bar) do { unsigned _sp = 0; while (cond) { __builtin_amdgcn_s_sleep(1); \
    if ((++_sp & 255u) == 0u) { if (xb_ld(&(bar)[XB_TMO])) break; if (_sp > XB_SPIN_CAP) { atomicAdd(&(bar)[XB_TMO], 1u); break; } } } } while (0)
struct XcdBarrier { unsigned* bar; unsigned x; volatile LAS unsigned* st; };
__device__ __forceinline__ XcdBarrier xcd_barrier_post(unsigned* bar, volatile LAS unsigned* st) {
    XcdBarrier b; b.bar = bar; b.x = xb_xcc_id(); b.st = st;
    if (threadIdx.x == 0) (void)xb_add(&bar[XB_XCNT(b.x)], 1u);
    return b;
}
__device__ __forceinline__ void xcd_barrier_complete(unsigned* bar, unsigned x, unsigned& nloc, unsigned& nx) {
    const unsigned G = gridDim.x * gridDim.y * gridDim.z;
    unsigned sum, cnt, mine, sp = 0u;
    for (;;) {
        sum = 0u; cnt = 0u; mine = 0u;
#pragma unroll
        for (unsigned j = 0; j < 16; ++j) { const unsigned c = xb_ld(&bar[XB_XCNT(j)]); sum += c; cnt += (c > 0u) ? 1u : 0u; mine = (j == x) ? c : mine; }
        if (sum == G) break;
        __builtin_amdgcn_s_sleep(1);
        if ((++sp & 255u) == 0u) { if (xb_ld(&bar[XB_TMO])) break; if (sp > XB_SPIN_CAP) { atomicAdd(&bar[XB_TMO], 1u); break; } }
    }
    nloc = mine > 0u ? mine : 1u; nx = cnt > 0u ? cnt : 1u;
}
__device__ __forceinline__ void xcd_barrier(const XcdBarrier& b) {
    asm volatile("s_waitcnt vmcnt(0)" ::: "memory");
    __syncthreads();
    if (threadIdx.x == 0) {
        unsigned* bar = b.bar;
        __builtin_amdgcn_s_waitcnt(0);
        unsigned nloc = b.st[0], nx = b.st[1];
        if (nloc == 0u) { xcd_barrier_complete(bar, b.x, nloc, nx); b.st[0] = nloc; b.st[1] = nx; }
        const unsigned old = xb_add(&bar[XB_XSUB(b.x)], 1u);
        const unsigned gen = old / nloc;
        if (old + 1u == (gen + 1u) * nloc) {
            __builtin_amdgcn_fence(__ATOMIC_RELEASE, "agent");
            asm volatile("s_waitcnt vmcnt(0)" ::: "memory");
            const unsigned og = xb_add(&bar[XB_TOP], 1u);
            const unsigned tg = og / nx;
            if (og + 1u == (tg + 1u) * nx) xb_add(&bar[XB_TOPGEN], 1u);
            else XB_SPIN(xb_ld(&bar[XB_TOPGEN]) == tg, bar);
            __builtin_amdgcn_fence(__ATOMIC_ACQUIRE, "agent");
            xb_add(&bar[XB_XGEN(b.x)], 1u);
            asm volatile("s_waitcnt vmcnt(0)" ::: "memory");
        } else {
            XB_SPIN(xb_ld(&bar[XB_XGEN(b.x)]) == gen, bar);
            __builtin_amdgcn_fence(__ATOMIC_ACQUIRE, "agent");
            asm volatile("s_waitcnt vmcnt(0)" ::: "memory");
        }
    }
    __syncthreads();
}

struct Args { const float* in[18]; float* out; unsigned char* ws; int ph_lo, ph_hi; };
enum { I_X = 0, I_MEM, I_NORMG, I_WGU, I_WDOWN, I_WIN, I_CONVW, I_CONVB, I_BI, I_BF, I_MNORM, I_SLNG, I_SLNB, I_SWS, I_SBS, I_WMKV, I_WBR, I_WOUT };

__device__ __forceinline__ void cvt_item(const float* W, int Nsrc, int K, int srccol, bf16* WT, int dstrow, int kb, LAS float* scr, int lane, const float* gk = nullptr) {
    const int k0 = 64 * kb;
    if ((srccol & 3) == 0) {
        const int c4 = (lane & 7) * 4, rr = lane >> 3;
#pragma unroll
        for (int i = 0; i < 8; ++i) { const int kk = 8 * i + rr; f32x4 x = *(const f32x4*)(W + (size_t)(k0 + kk) * Nsrc + srccol + c4); if (gk) x = x * gk[k0 + kk];
            LAS float* d = scr + kk * 33 + c4; d[0] = x.x; d[1] = x.y; d[2] = x.z; d[3] = x.w; }
    } else {
#pragma unroll 8
        for (int i = 0; i < 32; ++i) { const int kk = 2 * i + (lane >> 5); scr[kk * 33 + (lane & 31)] = W[(size_t)(k0 + kk) * Nsrc + srccol + (lane & 31)] * (gk ? gk[k0 + kk] : 1.f); }
    }
    LDS_WAIT(); asm volatile("" ::: "memory");
    const int c = lane & 7;
#pragma unroll
    for (int j = 0; j < 4; ++j) { const int n = (lane >> 3) + 8 * j; const LAS float* s = scr + (8 * c) * 33 + n;
        u32x4 o; o.x = pk2(s[0 * 33], s[1 * 33]); o.y = pk2(s[2 * 33], s[3 * 33]); o.z = pk2(s[4 * 33], s[5 * 33]); o.w = pk2(s[6 * 33], s[7 * 33]);
        *(u32x4*)(WT + (size_t)(dstrow + n) * K + k0 + 8 * c) = o; }
    LDS_WAIT(); asm volatile("" ::: "memory");
}
__device__ __forceinline__ int win_srccol(int r) {
    if (r < 1024) return r;
    if (r < 2048) return 2048 + (r - 1024);
    if (r < 3072) return 3080 + (r - 2048);
    if (r < 4096) return 5128 + (r - 3072);
    if (r < 7168) return 6152 + (r - 4096);
    if (r < 8192) return 1024 + (r - 7168);
    return 4104 + (r - 8192);
}
__device__ __forceinline__ void convert_layer(const Args& a, int l, unsigned char* ws, LAS unsigned char* lds, int gw, int NGW, int wave, int lane, int gtid, int GT) {
    LAS float* scr = (LAS float*)(lds + wave * 16384);
    bf16* Wb = (bf16*)(ws + WS_W);
    constexpr int I_GU = 16 * 176, I_DN = 44 * 32, I_IN = 16 * 288, I_MKV = 16 * 64, I_BR = 16 * 32, I_OUT = 16 * 32;
    constexpr int NITEMS = 2 * I_GU + 2 * I_DN + I_IN + I_MKV + 3 * I_BR + I_OUT;
    for (int it = gw; it < NITEMS; it += NGW) {
        int r = it;
        if (r < 2 * I_GU) { const int j = r / I_GU; r -= j * I_GU; const int kb = r / 176, nb = r % 176; const int p = nb >> 3, q = nb & 7, s = q >> 2, jj = (q & 3) * 32;
            cvt_item(a.in[I_WGU] + (size_t)(l * 2 + j) * D * 2 * DFF, 2 * DFF, D, s * DFF + 128 * p + jj, (bf16*)((char*)Wb + (j ? WO_GU1 : WO_GU0)), nb * 32, kb, scr, lane, a.in[I_NORMG] + (size_t)(l * NNORM + (j ? 4 : 0)) * D); continue; }
        r -= 2 * I_GU;
        if (r < 2 * I_DN) { const int j = r / I_DN; r -= j * I_DN; const int kb = r / 32, nb = r % 32;
            cvt_item(a.in[I_WDOWN] + (size_t)(l * 2 + j) * DFF * D, D, DFF, nb * 32, (bf16*)((char*)Wb + (j ? WO_D1 : WO_D0)), nb * 32, kb, scr, lane); continue; }
        r -= 2 * I_DN;
        if (r < I_IN) { const int kb = r / 288, nb = r % 288;
            cvt_item(a.in[I_WIN] + (size_t)l * D * WIN_COLS, WIN_COLS, D, win_srccol(nb * 32), (bf16*)((char*)Wb + WO_IN), nb * 32, kb, scr, lane, a.in[I_NORMG] + (size_t)(l * NNORM + 2) * D); continue; }
        r -= I_IN;
        if (r < I_MKV) { const int kb = r / 64, nb = r % 64;
            cvt_item(a.in[I_WMKV] + (size_t)l * D * 2048, 2048, D, nb * 32, (bf16*)((char*)Wb + WO_MKV), nb * 32, kb, scr, lane); continue; }
        r -= I_MKV;
        if (r < 3 * I_BR) { const int j = r / I_BR; r -= j * I_BR; const int kb = r / 32, nb = r % 32;
            cvt_item(a.in[I_WBR] + (size_t)(l * 3 + j) * D * D, D, D, nb * 32, (bf16*)((char*)Wb + WO_BR) + (size_t)j * D * D, nb * 32, kb, scr, lane); continue; }
        r -= 3 * I_BR;
        { const int kb = r / 32, nb = r % 32; cvt_item(a.in[I_WOUT] + (size_t)l * D * D, D, D, nb * 32, (bf16*)((char*)Wb + WO_OUT), nb * 32, kb, scr, lane); }
    }
    bf16* wsg = (bf16*)(ws + WS_WSGU); const float* src = a.in[I_SWS] + (size_t)l * 4 * 128 * 128;
    for (int e = gtid; e < 4 * 128 * 128; e += GT) { const int t = (e >> 7) & 127, s = e & 127; wsg[e] = (bf16)f2bf(s <= t ? src[e] : 0.f); }
    const float* g6 = a.in[I_NORMG] + (size_t)(l * NNORM + 6) * D;
    for (int m = gw; m < MMEM; m += NGW) {
        const f32x4* xr = (const f32x4*)(a.in[I_MEM] + (size_t)m * D) + lane; f32x4 v[4]; float s = 0.f;
#pragma unroll
        for (int j = 0; j < 4; ++j) { v[j] = xr[64 * j]; s += (v[j].x * v[j].x + v[j].y * v[j].y) + (v[j].z * v[j].z + v[j].w * v[j].w); }
        const float rstd = rsqrtf(wave_sum(s) * (1.f / D) + EPS);
        unsigned long long* o8 = (unsigned long long*)((bf16*)(ws + WS_MEMN) + (size_t)m * D) + lane;
#pragma unroll
        for (int j = 0; j < 4; ++j) { const f32x4 gg = ((const f32x4*)g6)[lane + 64 * j];
            o8[64 * j] = (unsigned long long)pk2(v[j].x * rstd * gg.x, v[j].y * rstd * gg.y) | ((unsigned long long)pk2(v[j].z * rstd * gg.z, v[j].w * rstd * gg.w) << 32); }
    }
}

__device__ __forceinline__ void thin_rows(const bf16* fbase, size_t fld, const float* ga, float scale, const float* hin32, const bf16* hinb, bf16* hb_out, float* rstd_out, float* out32,
                                          int row_lo, int row_hi, int gw, int NGW, int lane, const bool do_gates, const LAS float* wif, const float* bi, const float* bfg, float* gate_i, float* gate_f) {
    for (int m = row_lo + gw; m < row_hi; m += NGW) {
        f32x4 v[4];
        if (hin32) { const f32x4* hr = (const f32x4*)(hin32 + (size_t)m * D) + lane;
#pragma unroll
            for (int j = 0; j < 4; ++j) v[j] = hr[64 * j]; }
        else { const unsigned long long* hr = (const unsigned long long*)(hinb + (size_t)m * D) + lane;
#pragma unroll
            for (int j = 0; j < 4; ++j) { const unsigned long long w = hr[64 * j]; const unsigned lo = (unsigned)w, hi = (unsigned)(w >> 32); v[j] = (f32x4){bflo(lo), bfhi(lo), bflo(hi), bfhi(hi)}; } }
        if (fbase) {
            const unsigned long long* fr = (const unsigned long long*)(fbase + (size_t)(m - row_lo) * fld) + lane; float s = 0.f; f32x4 f[4];
#pragma unroll
            for (int j = 0; j < 4; ++j) { const unsigned long long w = fr[64 * j]; const unsigned lo = (unsigned)w, hi = (unsigned)(w >> 32);
                f[j] = (f32x4){bflo(lo), bfhi(lo), bflo(hi), bfhi(hi)}; s += (f[j].x * f[j].x + f[j].y * f[j].y) + (f[j].z * f[j].z + f[j].w * f[j].w); }
            const float rstd = rsqrtf(wave_sum(s) * (1.f / D) + EPS) * scale;
#pragma unroll
            for (int j = 0; j < 4; ++j) { const f32x4 gg = ((const f32x4*)ga)[lane + 64 * j]; v[j] = v[j] + f[j] * rstd * gg; }
        }
        if (out32) { f32x4* ho = (f32x4*)(out32 + (size_t)m * D) + lane;
#pragma unroll
            for (int j = 0; j < 4; ++j) ho[64 * j] = v[j]; }
        if (hb_out) {
            float s = 0.f;
#pragma unroll
            for (int j = 0; j < 4; ++j) s += (v[j].x * v[j].x + v[j].y * v[j].y) + (v[j].z * v[j].z + v[j].w * v[j].w);
            const float rstd = rsqrtf(wave_sum(s) * (1.f / D) + EPS);
            unsigned long long* o8 = (unsigned long long*)(hb_out + (size_t)m * D) + lane;
#pragma unroll
            for (int j = 0; j < 4; ++j) o8[64 * j] = (unsigned long long)pk2(v[j].x, v[j].y) | ((unsigned long long)pk2(v[j].z, v[j].w) << 32);
            if (lane == 0) rstd_out[m] = rstd;
            if (do_gates) {
                float acc[8];
#pragma unroll
                for (int e = 0; e < 8; ++e) acc[e] = 0.f;
#pragma unroll
                for (int j = 0; j < 4; ++j)
#pragma unroll
                    for (int q = 0; q < 4; ++q) { const int k = 4 * lane + 256 * j + q; const float xv = v[j][q]; const LAS f32x4* wp = (const LAS f32x4*)(wif + k * 8); const f32x4 w0 = wp[0], w1 = wp[1];
                        acc[0] += xv * w0.x; acc[1] += xv * w0.y; acc[2] += xv * w0.z; acc[3] += xv * w0.w; acc[4] += xv * w1.x; acc[5] += xv * w1.y; acc[6] += xv * w1.z; acc[7] += xv * w1.w; }
#pragma unroll
                for (int e = 0; e < 8; ++e) acc[e] = wave_sum(acc[e]) * rstd;
                if (lane == 0) {
                    *(f32x4*)(gate_i + (size_t)m * 4) = (f32x4){acc[0] + bi[0], acc[1] + bi[1], acc[2] + bi[2], acc[3] + bi[3]};
                    *(f32x4*)(gate_f + (size_t)m * 4) = (f32x4){logsigmoidf_(acc[4] + bfg[0]), logsigmoidf_(acc[5] + bfg[1]), logsigmoidf_(acc[6] + bfg[2]), logsigmoidf_(acc[7] + bfg[3])};
                }
            }
        }
    }
}

__device__ __forceinline__ void conv8(const bf16* Zb, int bl, int p, int col, const float* cw, const float* cb, float (&o)[8]) {
    const f32x4 b0 = *(const f32x4*)(cb + col), b1 = *(const f32x4*)(cb + col + 4);
    o[0] = b0.x; o[1] = b0.y; o[2] = b0.z; o[3] = b0.w; o[4] = b1.x; o[5] = b1.y; o[6] = b1.z; o[7] = b1.w;
#pragma unroll
    for (int j = 0; j < 4; ++j) { const int pp = p - 3 + j;
        if (pp >= 0) { const u32x4 x = *(const u32x4*)(Zb + (size_t)(bl * SEQ + pp) * ZLD + ZC_QK + col);
            const f32x4 w0 = *(const f32x4*)(cw + j * 1024 + col), w1 = *(const f32x4*)(cw + j * 1024 + col + 4);
            o[0] += w0.x * bflo(x.x); o[1] += w0.y * bfhi(x.x); o[2] += w0.z * bflo(x.y); o[3] += w0.w * bfhi(x.y);
            o[4] += w1.x * bflo(x.z); o[5] += w1.y * bfhi(x.z); o[6] += w1.z * bflo(x.w); o[7] += w1.w * bfhi(x.w); } }
#pragma unroll
    for (int e = 0; e < 8; ++e) o[e] = siluf_(o[e]);
}
__device__ __forceinline__ float wave_incl_scan_add(float v, int lane) {
#pragma unroll
    for (int o = 1; o < 64; o <<= 1) { const float t = __shfl_up(v, o); if (lane >= o) v += t; }
    return v;
}
__device__ __forceinline__ float wave_incl_scan_max(float v, int lane) {
#pragma unroll
    for (int o = 1; o < 64; o <<= 1) { const float t = __shfl_up(v, o); if (lane >= o) v = fmaxf(v, t); }
    return v;
}
__device__ __forceinline__ float wave_max(float v) {
#pragma unroll
    for (int o = 1; o < 64; o <<= 1) v = fmaxf(v, __shfl_xor(v, o));
    return v;
}
constexpr float KSCALE = 0.08838834764831845f;

__device__ __forceinline__ void conv8l(const bf16* Zb, int bl, int p, int col, const LAS float* wl, const int wstride, float (&o)[8]) {
    { const f32x4 b0 = *(const LAS f32x4*)(wl + 4 * wstride), b1 = *(const LAS f32x4*)(wl + 4 * wstride + 4);
      o[0] = b0.x; o[1] = b0.y; o[2] = b0.z; o[3] = b0.w; o[4] = b1.x; o[5] = b1.y; o[6] = b1.z; o[7] = b1.w; }
#pragma unroll
    for (int j = 0; j < 4; ++j) { const int pp = p - 3 + j;
        if (pp >= 0) { const u32x4 x = *(const u32x4*)(Zb + (size_t)(bl * SEQ + pp) * ZLD + ZC_QK + col);
            const f32x4 w0 = *(const LAS f32x4*)(wl + j * wstride), w1 = *(const LAS f32x4*)(wl + j * wstride + 4);
            o[0] += w0.x * bflo(x.x); o[1] += w0.y * bfhi(x.x); o[2] += w0.z * bflo(x.y); o[3] += w0.w * bfhi(x.y);
            o[4] += w1.x * bflo(x.z); o[5] += w1.y * bfhi(x.z); o[6] += w1.z * bflo(x.w); o[7] += w1.w * bfhi(x.w); } }
#pragma unroll
    for (int e = 0; e < 8; ++e) o[e] = siluf_(o[e]);
}
__device__ __forceinline__ void stage_convw(LAS float* wl, const float* cw, const float* cb, int col0, int ncol, int dst0, int wstride, int tid) {
    for (int e = tid; e < 5 * ncol; e += NTHR) { const int j = e / ncol, cidx = e - j * ncol; wl[j * wstride + dst0 + cidx] = (j < 4) ? cw[j * 1024 + col0 + cidx] : cb[col0 + cidx]; }
}
__device__ __forceinline__ void mlstm_s1(const Args& a, int l, int hf, unsigned char* ws, LAS unsigned char* lds, int G, int cu, int tid, int wave, int lane) {
    const bf16* Zb = (const bf16*)(ws + WS_Z); const bf16* ZT = (const bf16*)(ws + WS_ZT);
    const float* gi = (const float*)(ws + WS_GATE); const float* gf = gi + (size_t)M * 4;
    const float* cw = a.in[I_CONVW] + (size_t)l * 4 * 1024; const float* cb = a.in[I_CONVB] + (size_t)l * 1024;
    LAS bf16* KT = (LAS bf16*)lds;
    LAS float* wv = (LAS float*)(lds + 18432);
    LAS float* CWL = (LAS float*)(lds + 18688);
    const int c8 = tid & 15; int hcur = -1;
    for (int u = cu; u < 16 * NCH; u += G) {
        const int h = u & 3, c = (u >> 2) & 63, bl = u >> 8, bhl = bl * 4 + h; const int tokg = (hf * 4 + bl) * SEQ + c * LCH;
        if (h != hcur) { __syncthreads(); stage_convw(CWL, cw, cb, 512 + h * 128, 128, 0, 128, tid); hcur = h; }
        const int r = lane & 31, hh = lane >> 5, v0 = 32 * wave;
        bf16x8 bfr[4];
        { const bf16* vrow = ZT + (size_t)(h * 256 + v0 + r) * ZTLD + bl * SEQ + c * LCH + 8 * hh;
#pragma unroll
          for (int ks = 0; ks < 4; ++ks) bfr[ks] = *(const bf16x8*)(vrow + 16 * ks); }
        if (wave == 0) {
            const float lf = gf[(size_t)(tokg + lane) * 4 + h], ii = gi[(size_t)(tokg + lane) * 4 + h];
            const float bc = wave_incl_scan_add(lf, lane); const float g = __shfl(bc, 63);
            const float av = g - bc + ii; const float ml = wave_max(av);
            wv[lane] = __expf(av - ml);
            if (lane == 0) { float* cs = (float*)(ws + WS_CSC) + (size_t)(bhl * NCH + c) * 4; cs[0] = g; cs[1] = ml; }
        }
        __syncthreads();
#pragma unroll
        for (int rep = 0; rep < 2; ++rep) { const int idx = tid + rep * NTHR, s = idx >> 4; float o[8];
            conv8l(Zb, bl, c * LCH + s, 512 + h * 128 + c8 * 8, CWL + c8 * 8, 128, o); const float sc = wv[s] * KSCALE;
#pragma unroll
            for (int e = 0; e < 8; ++e) KT[(c8 * 8 + e) * 72 + s] = (bf16)f2bf(o[e] * sc); }
        __syncthreads();
        if (tid < 128) { float s = 0.f;
#pragma unroll 8
            for (int k = 0; k < 64; ++k) s += bf1(KT[tid * 72 + k]);
            ((float*)(ws + WS_NST))[(size_t)(bhl * NCH + c) * 128 + tid] = s; }
        {
            bf16* st = (bf16*)(ws + WS_ST) + (size_t)(bhl * NCH + c) * 32768 + (size_t)(v0 + r) * 128;
#pragma unroll
            for (int db = 0; db < 4; ++db) { f32x16 acc;
#pragma unroll
                for (int e = 0; e < 16; ++e) acc[e] = 0.f;
#pragma unroll
                for (int ks = 0; ks < 4; ++ks) { const bf16x8 af = *(const LAS bf16x8*)(KT + (32 * db + r) * 72 + 16 * ks + 8 * hh); acc = __builtin_amdgcn_mfma_f32_32x32x16_bf16(af, bfr[ks], acc, 0, 0, 0); }
#pragma unroll
                for (int q = 0; q < 4; ++q) { u32x2 w; w.x = pk2(acc[4 * q], acc[4 * q + 1]); w.y = pk2(acc[4 * q + 2], acc[4 * q + 3]); *(u32x2*)(st + 32 * db + 8 * q + 4 * hh) = w; } }
        }
        __syncthreads();
    }
}
__device__ __forceinline__ void mlstm_s2(unsigned char* ws, int G, int cu, int tid) {
    for (int u = cu; u < 256; u += G) {
        const int bhl = u >> 4, part = u & 15; const size_t off = (size_t)(part * NTHR + tid) * 4;
        bf16* st = (bf16*)(ws + WS_ST) + (size_t)bhl * NCH * 32768 + off; float* ns = (float*)(ws + WS_NST) + (size_t)bhl * NCH * 128 + tid; float* cs = (float*)(ws + WS_CSC) + (size_t)bhl * NCH * 4;
        const bool nth = (part == 0 && tid < 128);
        float C[4]; float nv = 0.f, m = -1e30f;
#pragma unroll
        for (int e = 0; e < 4; ++e) C[e] = 0.f;
        for (int c0 = 0; c0 < NCH; c0 += 8) {
            u32x2 cl[8]; float nl[8], gg[8], ml[8];
#pragma unroll
            for (int i = 0; i < 8; ++i) { cl[i] = *(const u32x2*)(st + (size_t)(c0 + i) * 32768); nl[i] = nth ? ns[(c0 + i) * 128] : 0.f; gg[i] = cs[(c0 + i) * 4]; ml[i] = cs[(c0 + i) * 4 + 1]; }
#pragma unroll
            for (int i = 0; i < 8; ++i) {
                u32x2 o; o.x = pk2(C[0], C[1]); o.y = pk2(C[2], C[3]);
                *(u32x2*)(st + (size_t)(c0 + i) * 32768) = o;
                if (nth) ns[(c0 + i) * 128] = nv;
                if (part == 0 && tid == 0) cs[(c0 + i) * 4 + 2] = m;
                const float mn = fmaxf(gg[i] + m, ml[i]); const float dec = __expf(gg[i] + m - mn), sc = __expf(ml[i] - mn);
                C[0] = dec * C[0] + sc * bflo(cl[i].x); C[1] = dec * C[1] + sc * bfhi(cl[i].x); C[2] = dec * C[2] + sc * bflo(cl[i].y); C[3] = dec * C[3] + sc * bfhi(cl[i].y);
                nv = dec * nv + sc * nl[i]; m = mn;
            }
        }
    }
}
__device__ __forceinline__ void mlstm_s3(const Args& a, int l, int hf, unsigned char* ws, LAS unsigned char* lds, int G, int cu, int tid, int wave, int lane, const int out_col) {
    bf16* Zb = (bf16*)(ws + WS_Z); const bf16* ZT = (const bf16*)(ws + WS_ZT);
    const float* gi = (const float*)(ws + WS_GATE); const float* gf = gi + (size_t)M * 4;
    const float* cw = a.in[I_CONVW] + (size_t)l * 4 * 1024; const float* cb = a.in[I_CONVB] + (size_t)l * 1024;
    const float* gain = a.in[I_MNORM] + (size_t)l * 1024;
    LAS bf16* QS = (LAS bf16*)lds;
    LAS bf16* KS = (LAS bf16*)(lds + 17408);
    LAS bf16* SD = (LAS bf16*)(lds + 34816);
    LAS float* HB = (LAS float*)(lds + 44032);
    LAS float* SC = (LAS float*)(lds + 110592);
    LAS float* CWL = (LAS float*)(lds + 112384);
    const int c8 = tid & 15; int hcur = -1;
    for (int u = cu; u < 16 * NCH; u += G) {
        const int h = u & 3, c = (u >> 2) & 63, bl = u >> 8, bhl = bl * 4 + h; const int tokg = (hf * 4 + bl) * SEQ + c * LCH; const int tokl = bl * SEQ + c * LCH;
        if (h != hcur) { __syncthreads(); stage_convw(CWL, cw, cb, h * 128, 128, 0, 256, tid); stage_convw(CWL, cw, cb, 512 + h * 128, 128, 128, 256, tid); hcur = h; __syncthreads(); }
        const int r = lane & 31, hh = lane >> 5, v0 = 32 * wave;
        bf16x8 bV[4], bC[8];
        { const bf16* vrow = ZT + (size_t)(h * 256 + v0 + r) * ZTLD + tokl + 8 * hh;
          const bf16* crow = (const bf16*)(ws + WS_ST) + (size_t)(bhl * NCH + c) * 32768 + (size_t)(v0 + r) * 128 + 8 * hh;
#pragma unroll
          for (int ks = 0; ks < 4; ++ks) bV[ks] = *(const bf16x8*)(vrow + 16 * ks);
#pragma unroll
          for (int ks = 0; ks < 8; ++ks) bC[ks] = *(const bf16x8*)(crow + 16 * ks); }
        u32x2 ogr[8];
#pragma unroll
        for (int i = 0; i < 8; ++i) ogr[i] = *(const u32x2*)(Zb + (size_t)(tokl + 8 * wave + i) * ZLD + ZC_O + h * 256 + 4 * lane);
        if (wave == 0) {
            const float lf = gf[(size_t)(tokg + lane) * 4 + h], ii = gi[(size_t)(tokg + lane) * 4 + h];
            const float bc = wave_incl_scan_add(lf, lane); const float rr = ii - bc; const float cm = wave_incl_scan_max(rr, lane);
            const float mst = ((const float*)(ws + WS_CSC))[(size_t)(bhl * NCH + c) * 4 + 2];
            const float Mt = fmaxf(mst, cm);
            SC[lane] = rr; SC[64 + lane] = Mt; SC[128 + lane] = __expf(mst - Mt); SC[192 + lane] = __expf(-(bc + Mt));
        } else if (wave == 1 || wave == 2) { const int d = (wave - 1) * 64 + lane; SC[320 + d] = ((const float*)(ws + WS_NST))[(size_t)(bhl * NCH + c) * 128 + d]; }
#pragma unroll
        for (int rep = 0; rep < 2; ++rep) { const int idx = tid + rep * NTHR, t = idx >> 4; float o[8];
            conv8l(Zb, bl, c * LCH + t, h * 128 + c8 * 8, CWL + c8 * 8, 256, o);
            u32x4 w; w.x = pk2(o[0], o[1]); w.y = pk2(o[2], o[3]); w.z = pk2(o[4], o[5]); w.w = pk2(o[6], o[7]);
            *(LAS u32x4*)(QS + t * 136 + c8 * 8) = w;
            conv8l(Zb, bl, c * LCH + t, 512 + h * 128 + c8 * 8, CWL + 128 + c8 * 8, 256, o);
            w.x = pk2(o[0] * KSCALE, o[1] * KSCALE); w.y = pk2(o[2] * KSCALE, o[3] * KSCALE); w.z = pk2(o[4] * KSCALE, o[5] * KSCALE); w.w = pk2(o[6] * KSCALE, o[7] * KSCALE);
            *(LAS u32x4*)(KS + t * 136 + c8 * 8) = w; }
        __syncthreads();
        {
            const int tb = wave >> 1, fr = lane & 15, fq = lane >> 4;
#pragma unroll
            for (int i = 0; i < 2; ++i) { const int sblk = (wave & 1) * 2 + i; f32x4 acc = (f32x4){0.f, 0.f, 0.f, 0.f};
                if (sblk <= tb) {
#pragma unroll
                    for (int ks = 0; ks < 4; ++ks) { const bf16x8 af = *(const LAS bf16x8*)(QS + (16 * tb + fr) * 136 + 32 * ks + 8 * fq), bfv = *(const LAS bf16x8*)(KS + (16 * sblk + fr) * 136 + 32 * ks + 8 * fq);
                        acc = __builtin_amdgcn_mfma_f32_16x16x32_bf16(af, bfv, acc, 0, 0, 0); } }
                const int s = 16 * sblk + fr; const float rs_ = SC[s];
#pragma unroll
                for (int e = 0; e < 4; ++e) { const int t = 16 * tb + 4 * fq + e; const float val = (s <= t) ? acc[e] * __expf(rs_ - SC[64 + t]) : 0.f; SD[t * 72 + s] = (bf16)f2bf(val); } }
        }
        f32x16 aQ0, aQ1, aS0, aS1;
#pragma unroll
        for (int e = 0; e < 16; ++e) { aQ0[e] = 0.f; aQ1[e] = 0.f; aS0[e] = 0.f; aS1[e] = 0.f; }
#pragma unroll
        for (int ks = 0; ks < 8; ++ks) {
            const bf16x8 a0 = *(const LAS bf16x8*)(QS + r * 136 + 16 * ks + 8 * hh), a1 = *(const LAS bf16x8*)(QS + (32 + r) * 136 + 16 * ks + 8 * hh);
            aQ0 = __builtin_amdgcn_mfma_f32_32x32x16_bf16(a0, bC[ks], aQ0, 0, 0, 0); aQ1 = __builtin_amdgcn_mfma_f32_32x32x16_bf16(a1, bC[ks], aQ1, 0, 0, 0); }
        __syncthreads();
        {
            const int t = tid >> 3, p = tid & 7; float ds = 0.f, qn = 0.f;
#pragma unroll
            for (int k = 0; k < 8; ++k) ds += bf1(SD[t * 72 + 8 * p + k]);
#pragma unroll
            for (int k = 0; k < 16; ++k) qn += bf1(QS[t * 136 + 16 * p + k]) * SC[320 + 16 * p + k];
            float den = ds + SC[128 + t] * qn;
            den += __shfl_xor(den, 1); den += __shfl_xor(den, 2); den += __shfl_xor(den, 4);
            if (p == 0) SC[256 + t] = 1.f / fmaxf(fabsf(den), SC[192 + t]);
        }
#pragma unroll
        for (int ks = 0; ks < 4; ++ks) {
            const bf16x8 a0 = *(const LAS bf16x8*)(SD + r * 72 + 16 * ks + 8 * hh), a1 = *(const LAS bf16x8*)(SD + (32 + r) * 72 + 16 * ks + 8 * hh);
            aS0 = __builtin_amdgcn_mfma_f32_32x32x16_bf16(a0, bV[ks], aS0, 0, 0, 0); aS1 = __builtin_amdgcn_mfma_f32_32x32x16_bf16(a1, bV[ks], aS1, 0, 0, 0); }
        __syncthreads();
#pragma unroll
        for (int e = 0; e < 16; ++e) { const int t0 = (e & 3) + 8 * (e >> 2) + 4 * hh;
            HB[t0 * 260 + v0 + r] = (aS0[e] + SC[128 + t0] * aQ0[e]) * SC[256 + t0]; HB[(32 + t0) * 260 + v0 + r] = (aS1[e] + SC[128 + 32 + t0] * aQ1[e]) * SC[256 + 32 + t0]; }
        __syncthreads();
#pragma unroll
        for (int i = 0; i < 8; ++i) { const int t = 8 * wave + i; const f32x4 x = *(const LAS f32x4*)(HB + t * 260 + 4 * lane);
            const float mean = wave_sum((x.x + x.y) + (x.z + x.w)) * (1.f / 256.f); const f32x4 dx = x - mean;
            const float var = wave_sum((dx.x * dx.x + dx.y * dx.y) + (dx.z * dx.z + dx.w * dx.w)) * (1.f / 256.f); const float rstd = rsqrtf(var + EPS);
            const f32x4 gg = *(const f32x4*)(gain + h * 256 + 4 * lane);
            const u32x2 og = ogr[i]; u32x2* op = (u32x2*)(Zb + (size_t)(tokl + t) * ZLD + out_col + h * 256 + 4 * lane);
            u32x2 w; w.x = pk2(dx.x * rstd * gg.x * bflo(og.x), dx.y * rstd * gg.y * bfhi(og.x)); w.y = pk2(dx.z * rstd * gg.z * bflo(og.y), dx.w * rstd * gg.w * bfhi(og.y)); *op = w; }
        __syncthreads();
    }
}

__device__ __forceinline__ void sgu_phase(const Args& a, int l, unsigned char* ws, LAS unsigned char* lds, int G, int cu, int tid, int wave, int lane, const int out_col) {
    bf16* Zb = (bf16*)(ws + WS_Z); const bf16* ZT = (const bf16*)(ws + WS_ZT); const bf16* Wc = (const bf16*)(ws + WS_WSGU);
    const float* lng = a.in[I_SLNG] + (size_t)l * 1024; const float* lnb = a.in[I_SLNB] + (size_t)l * 1024; const float* bs = a.in[I_SBS] + (size_t)l * 4 * 128;
    LAS bf16* VT = (LAS bf16*)lds;
    LAS float* PS = (LAS float*)(lds + 69632);
    LAS float* ST = (LAS float*)(lds + 69632 + 4096);
    LAS bf16* WS_ = (LAS bf16*)(lds + 74752);
    int gcur = -1;
    for (int u = cu; u < 4 * 32 * 4; u += G) {
        const int g = u & 3, cc = (u >> 2) & 31, bl = u >> 7; const int tokl = bl * SEQ + cc * 128;
        if (g != gcur) { __syncthreads();
#pragma unroll
            for (int rep = 0; rep < 4; ++rep) { const int idx = tid + rep * NTHR, t = idx >> 4, c8 = idx & 15; *(LAS u32x4*)(WS_ + t * 136 + c8 * 8) = *(const u32x4*)(Wc + (size_t)(g * 128 + t) * 128 + c8 * 8); }
            gcur = g; }
#pragma unroll
        for (int rep = 0; rep < 8; ++rep) { const int idx = tid + rep * NTHR, d = idx >> 4, c8 = idx & 15;
            *(LAS u32x4*)(VT + d * 136 + c8 * 8) = *(const u32x4*)(ZT + (size_t)(1024 + g * 256 + d) * ZTLD + tokl + c8 * 8); }
        __syncthreads();
        { const int s = tid & 127, part = tid >> 7; float sm = 0.f, sq = 0.f;
#pragma unroll 8
            for (int d = part * 64; d < part * 64 + 64; ++d) { const float x = bf1(VT[d * 136 + s]); sm += x; sq += x * x; }
            PS[(part * 128 + s) * 2] = sm; PS[(part * 128 + s) * 2 + 1] = sq; }
        __syncthreads();
        if (tid < 128) { float sm = 0.f, sq = 0.f;
#pragma unroll
            for (int p = 0; p < 4; ++p) { sm += PS[(p * 128 + tid) * 2]; sq += PS[(p * 128 + tid) * 2 + 1]; }
            const float mean = sm * (1.f / 256.f); const float var = fmaxf(sq * (1.f / 256.f) - mean * mean, 0.f); ST[tid] = mean; ST[128 + tid] = rsqrtf(var + EPS); }
        __syncthreads();
#pragma unroll
        for (int rep = 0; rep < 8; ++rep) { const int idx = tid + rep * NTHR, d = idx >> 4, c8 = idx & 15; const float gg = lng[g * 256 + d], bb = lnb[g * 256 + d];
            u32x4 x = *(const LAS u32x4*)(VT + d * 136 + c8 * 8); const LAS float* mp = ST + c8 * 8; const LAS float* rp = ST + 128 + c8 * 8;
            x.x = pk2((bflo(x.x) - mp[0]) * rp[0] * gg + bb, (bfhi(x.x) - mp[1]) * rp[1] * gg + bb); x.y = pk2((bflo(x.y) - mp[2]) * rp[2] * gg + bb, (bfhi(x.y) - mp[3]) * rp[3] * gg + bb);
            x.z = pk2((bflo(x.z) - mp[4]) * rp[4] * gg + bb, (bfhi(x.z) - mp[5]) * rp[5] * gg + bb); x.w = pk2((bflo(x.w) - mp[6]) * rp[6] * gg + bb, (bfhi(x.w) - mp[7]) * rp[7] * gg + bb);
            *(LAS u32x4*)(VT + d * 136 + c8 * 8) = x; }
        __syncthreads();
        {
            const int r = lane & 31, hh = lane >> 5, d0 = 32 * wave;
            f32x16 acc[4];
#pragma unroll
            for (int tb = 0; tb < 4; ++tb)
#pragma unroll
                for (int e = 0; e < 16; ++e) acc[tb][e] = 0.f;
#pragma unroll
            for (int ks = 0; ks < 8; ++ks) { const bf16x8 af = *(const LAS bf16x8*)(VT + (d0 + r) * 136 + 16 * ks + 8 * hh);
#pragma unroll
                for (int tb = 0; tb < 4; ++tb) if (16 * ks <= 32 * tb + 31) { const bf16x8 bfv = *(const LAS bf16x8*)(WS_ + (32 * tb + r) * 136 + 16 * ks + 8 * hh);
                    acc[tb] = __builtin_amdgcn_mfma_f32_32x32x16_bf16(af, bfv, acc[tb], 0, 0, 0); } }
#pragma unroll
            for (int tb = 0; tb < 4; ++tb) { const int t = 32 * tb + r; const float bias = bs[g * 128 + t]; bf16* rowp = Zb + (size_t)(tokl + t) * ZLD + ZC_U + g * 256 + d0 + 4 * hh; const int oshift = out_col - ZC_U;
#pragma unroll
                for (int q = 0; q < 4; ++q) { const u32x2 uu = *(const u32x2*)(rowp + 8 * q); u32x2* op = (u32x2*)(rowp + oshift + 8 * q); u32x2 w;
                    w.x = pk2(bflo(uu.x) * (acc[tb][4 * q] + bias), bfhi(uu.x) * (acc[tb][4 * q + 1] + bias)); w.y = pk2(bflo(uu.y) * (acc[tb][4 * q + 2] + bias), bfhi(uu.y) * (acc[tb][4 * q + 3] + bias)); *op = w; } }
        }
        __syncthreads();
    }
}

__device__ __forceinline__ void softmax_rows(unsigned char* ws, int gw, int NGW, int lane) {
    bf16* Zb = (bf16*)(ws + WS_Z);
    for (int m = gw; m < MH; m += NGW) {
        u32x4* p = (u32x4*)(Zb + (size_t)m * ZLD + ZC_XQ + 16 * lane); const u32x4 x0 = p[0], x1 = p[1];
        float v[16] = { bflo(x0.x), bfhi(x0.x), bflo(x0.y), bfhi(x0.y), bflo(x0.z), bfhi(x0.z), bflo(x0.w), bfhi(x0.w), bflo(x1.x), bfhi(x1.x), bflo(x1.y), bfhi(x1.y), bflo(x1.z), bfhi(x1.z), bflo(x1.w), bfhi(x1.w) };
        float mx = v[0];
#pragma unroll
        for (int e = 1; e < 16; ++e) mx = fmaxf(mx, v[e]);
#pragma unroll
        for (int o = 1; o < 16; o <<= 1) mx = fmaxf(mx, __shfl_xor(mx, o));
        float s = 0.f;
#pragma unroll
        for (int e = 0; e < 16; ++e) { v[e] = __expf(v[e] - mx); s += v[e]; }
#pragma unroll
        for (int o = 1; o < 16; o <<= 1) s += __shfl_xor(s, o);
        const float inv = 1.f / s;
        u32x4 y0, y1; y0.x = pk2(v[0] * inv, v[1] * inv); y0.y = pk2(v[2] * inv, v[3] * inv); y0.z = pk2(v[4] * inv, v[5] * inv); y0.w = pk2(v[6] * inv, v[7] * inv);
        y1.x = pk2(v[8] * inv, v[9] * inv); y1.y = pk2(v[10] * inv, v[11] * inv); y1.z = pk2(v[12] * inv, v[13] * inv); y1.w = pk2(v[14] * inv, v[15] * inv);
        p[0] = y0; p[1] = y1;
    }
}

__global__ void __launch_bounds__(NTHR, 2) trunk_fwd(Args args) {
    extern __shared__ __attribute__((aligned(16))) unsigned char lds_raw[];
    LAS unsigned char* lds = (LAS unsigned char*)lds_raw;
    volatile LAS unsigned* MISC = (volatile LAS unsigned*)(lds + MISC_OFF);
    const int G = gridDim.x, cu = blockIdx.x;
    unsigned char* ws = args.ws;
#define PHASE_IDS() int tid = threadIdx.x; asm volatile("" : "+v"(tid)); const int lane = tid & 63, wave = __builtin_amdgcn_readfirstlane(tid >> 6); \
    const int vcu = (G % 8 == 0) ? (cu % 8) * (G / 8) + cu / 8 : cu; const int gw = vcu * NWAVES + wave, NGW = G * NWAVES, gtid = cu * NTHR + tid, GT = G * NTHR; (void)gw; (void)NGW; (void)gtid; (void)GT; (void)lane
    for (int u = threadIdx.x; u < (LDS_BYTES - RING_BYTES) / 4; u += NTHR) ((LAS unsigned*)(lds + RING_BYTES))[u] = 0u;
    __syncthreads();
    XcdBarrier bar = xcd_barrier_post((unsigned*)(ws + WS_CTL) + 4096, MISC + 8);
    const int lo = args.ph_lo, hi = args.ph_hi;
    int ph = 0;
#define IN() (lo <= ph && ph < hi)
#define SEAM() do { if (lo <= ph && ph + 1 < hi) xcd_barrier(bar); ++ph; } while (0)
    bf16* XN = (bf16*)(ws + WS_XN); bf16* Wb = (bf16*)(ws + WS_W); float* RSTD = (float*)(ws + WS_RSTD);
    float* hbuf = args.out;

    if (IN()) { PHASE_IDS();
        convert_layer(args, 0, ws, lds, gw, NGW, wave, lane, gtid, GT);
        thin_rows(nullptr, 0, nullptr, 0.f, args.in[I_X], nullptr, XN, RSTD, nullptr, 0, M, gw, NGW, lane, false, nullptr, nullptr, nullptr, nullptr, nullptr);
        __syncthreads();
    }
    SEAM();

    for (int sb = 0; sb < 2 * DEPTH; ++sb) {
        const int l = sb >> 1, j = sb & 1;
        const float* ng = args.in[I_NORMG] + (size_t)l * NNORM * D;
        if (IN()) { PHASE_IDS();
            pg8::Gemm g{D, D, D}; pg8::TileSched S; S.init(M / 256, 2 * DFF / 256, G, cu, XN, D * 2, (char*)Wb + (j ? WO_GU1 : WO_GU0), D * 2);
            pg8::EpiGU E{(bf16*)(ws + WS_HID), RSTD};
            pg8::gemm_phase(lds, g, S, E, tid);
        }
        SEAM();
        if (IN()) { PHASE_IDS();
            pg8::Gemm g{DFF, DFF, DFF}; pg8::TileSched S; S.init(M / 256, D / 256, G, cu, ws + WS_HID, DFF * 2, (char*)Wb + (j ? WO_D1 : WO_D0), DFF * 2);
            pg8::EpiAct E{(bf16*)(ws + WS_F), (size_t)D, 0, nullptr, nullptr};
            pg8::gemm_phase(lds, g, S, E, tid);
        }
        SEAM();
        if (IN()) { PHASE_IDS();
            const float* hin = (sb == 0) ? args.in[I_X] : hbuf;
            if (j == 0) {
                LAS float* wif = (LAS float*)lds;
                const float* win = args.in[I_WIN] + (size_t)l * D * WIN_COLS;
                for (int e = tid; e < D * 8; e += NTHR) wif[e] = win[(size_t)(e >> 3) * WIN_COLS + 3072 + (e & 7)] * ng[2 * D + (e >> 3)];
                __syncthreads();
                float* gi = (float*)(ws + WS_GATE);
                const float* hx = (sb == 0) ? args.in[I_X] : nullptr;
                if (G == 256) {
                    const bool kvcu = (cu < 32) || (cu >= 128 && cu < 160);
                    if (kvcu) { const int gwk = ((cu < 32) ? cu : cu - 96) * NWAVES + wave;
                        thin_rows((const bf16*)(ws + WS_F), D, ng + 1 * D, 0.5f, hx, XN, XN, RSTD, nullptr, 0, 1024, gwk, 512, lane, true, wif, args.in[I_BI] + l * 4, args.in[I_BF] + l * 4, gi, gi + (size_t)M * 4); }
                    else { const int cun = (cu < 128) ? cu - 32 : cu - 64; const int gwn = cun * NWAVES + wave;
                        thin_rows((const bf16*)(ws + WS_F) + (size_t)1024 * D, D, ng + 1 * D, 0.5f, hx, XN, XN, RSTD, nullptr, 1024, M, gwn, 1536, lane, true, wif, args.in[I_BI] + l * 4, args.in[I_BF] + l * 4, gi, gi + (size_t)M * 4); }
                } else
                thin_rows((const bf16*)(ws + WS_F), D, ng + 1 * D, 0.5f, hx, XN, XN, RSTD, nullptr, 0, M, gw, NGW, lane, true, wif, args.in[I_BI] + l * 4, args.in[I_BF] + l * 4, gi, gi + (size_t)M * 4);
                __syncthreads();
                {
                    pg8::Gemm g{D, D, D};
                    pg8::TileSched S; S.init(MMEM / 256, D / 256, G, cu, ws + WS_MEMN, D * 2, (char*)Wb + WO_MKV, D * 2);
                    pg8::EpiAct E{(bf16*)(ws + WS_KMEM), (size_t)D, 0, nullptr, nullptr};
                    pg8::gemm_phase(lds, g, S, E, tid);
                    pg8::TileSched S2; S2.init(D / 256, MMEM / 256, G, (cu + G / 2) % G, (char*)Wb + WO_MKV + (size_t)D * D * 2, D * 2, ws + WS_MEMN, D * 2);
                    pg8::EpiAct E2{(bf16*)(ws + WS_VTMEM), (size_t)MMEM, 0, nullptr, nullptr};
                    pg8::gemm_phase(lds, g, S2, E2, tid);
                }
            } else {
                const bool lastl = (l + 1 == DEPTH);
                thin_rows((const bf16*)(ws + WS_F), D, ng + 5 * D, 0.5f, nullptr, XN, lastl ? nullptr : XN, RSTD, lastl ? hbuf : nullptr, 0, M, gw, NGW, lane, false, nullptr, nullptr, nullptr, nullptr, nullptr);
                if (l + 1 < DEPTH) { __syncthreads(); convert_layer(args, l + 1, ws, lds, gw, NGW, wave, lane, gtid, GT); __syncthreads(); }
            }
        }
        SEAM();
        if (j == 0) {
            for (int hf = 0; hf < 2; ++hf) {
                bf16* Zb = (bf16*)(ws + WS_Z);
                if (IN()) { PHASE_IDS();
                    pg8::Gemm g{D, D, D};
                    pg8::TileSched S; S.init(MH / 256, ZLD / 256, G, cu, XN + (size_t)hf * MH * D, D * 2, (char*)Wb + WO_IN, D * 2);
                    pg8::EpiAct E{Zb, (size_t)ZLD, 1, RSTD + (size_t)hf * MH, nullptr};
                    pg8::gemm_phase(lds, g, S, E, tid);
                    pg8::TileSched S2; S2.init(2048 / 256, MH / 256, G, cu, (char*)Wb + WO_IN + (size_t)ZLD * D * 2, D * 2, XN + (size_t)hf * MH * D, D * 2);
                    pg8::EpiAct E2{(bf16*)(ws + WS_ZT), (size_t)ZTLD, 2, nullptr, RSTD + (size_t)hf * MH};
                    pg8::gemm_phase(lds, g, S2, E2, tid);
                }
                SEAM();
                if (IN()) { PHASE_IDS();
                    mlstm_s1(args, l, hf, ws, lds, G, cu, tid, wave, lane);
                    sgu_phase(args, l, ws, lds, G, cu, tid, wave, lane, ZC_U);
                    pg8::Gemm g{256, ZLD, D};
                    pg8::TileSched S; S.init(MH / 256, 4, G, cu, Zb + ZC_XQ, ZLD * 2, (bf16*)(ws + WS_KMEM) + (size_t)hf * 4 * MEMLEN * D, 0);
                    S.a_pn = 512; S.b_tile = 512; S.pm_per_b = 16; S.b_batch = (size_t)MEMLEN * D * 2;
                    pg8::EpiAct E{Zb + ZC_XQ, (size_t)ZLD, 0, nullptr, nullptr};
                    pg8::gemm_phase(lds, g, S, E, tid);
                }
                SEAM();
                if (IN()) { PHASE_IDS();
                    mlstm_s2(ws, G, cu, tid);
                    softmax_rows(ws, gw, NGW, lane);
                }
                SEAM();
                if (IN()) { PHASE_IDS();
                    mlstm_s3(args, l, hf, ws, lds, G, cu, tid, wave, lane, ZC_O);
#ifdef PROBE_S3
                    for (int rep_ = 0; rep_ < 2; ++rep_) mlstm_s3(args, l, hf, ws, lds, G, cu, tid, wave, lane, ZC_QK);
#endif
#ifdef PROBE_SGU
                    for (int rep_ = 0; rep_ < 2; ++rep_) sgu_phase(args, l, ws, lds, G, cu, tid, wave, lane, ZC_QK);
#endif
                    pg8::Gemm g{256, ZLD, MMEM};
                    pg8::TileSched S; S.init(MH / 256, 4, G, cu, Zb + ZC_XQ, ZLD * 2, (bf16*)(ws + WS_VTMEM) + (size_t)hf * 4 * MEMLEN, 0);
                    S.a_pn = 512; S.b_tile = (size_t)256 * MMEM * 2; S.pm_per_b = 16; S.b_batch = (size_t)MEMLEN * 2;
                    pg8::EpiAct E{Zb + ZC_XQ, (size_t)ZLD, 0, nullptr, nullptr};
                    pg8::gemm_phase(lds, g, S, E, tid);
                }
                SEAM();
                if (IN()) { PHASE_IDS();
                    pg8::Gemm g{D, ZLD, D};
                    pg8::TileSched S; S.init(MH / 256, D / 256, G, cu, Zb + ZC_O, ZLD * 2, (char*)Wb + WO_BR, D * 2);
                    S.reps = 3; S.a_rep = 1024 * 2; S.b_rep = (size_t)D * D * 2;
                    pg8::EpiBranch E{Zb};
                    pg8::gemm_phase(lds, g, S, E, tid);
                }
                SEAM();
                if (IN()) { PHASE_IDS();
                    pg8::Gemm g{D, ZLD, D};
                    pg8::TileSched S; S.init(MH / 256, D / 256, G, cu, Zb + ZC_QK, ZLD * 2, (char*)Wb + WO_OUT, D * 2);
                    pg8::EpiAct E{Zb + ZC_O, (size_t)ZLD, 0, nullptr, nullptr};
                    pg8::gemm_phase(lds, g, S, E, tid);
                }
                SEAM();
                if (IN()) { PHASE_IDS();
                    thin_rows(Zb + ZC_O, ZLD, ng + 3 * D, 1.0f, nullptr, XN, XN, RSTD, nullptr, hf * MH, (hf + 1) * MH, gw, NGW, lane, false, nullptr, nullptr, nullptr, nullptr, nullptr);
                }
                SEAM();
            }
        }
    }
#undef IN
#undef SEAM
}
constexpr int N_PHASES = 1 + 2 * DEPTH * 3 + DEPTH * 2 * 7;

#ifndef N_LAUNCH_MODE
#define N_LAUNCH_MODE 0
#endif
extern "C" void kernel_launch(void* const* d_in, const int* in_sizes, int n_in, void* d_out, int out_size, void* d_ws, size_t ws_size, hipStream_t stream) {
    static int grid = 0;
    if (grid == 0) {
        if (n_in != 18 || out_size != M * D || ws_size < WS_END) { fprintf(stderr, "kernel_launch: unexpected shapes (n_in %d out %d ws %zu)\n", n_in, out_size, ws_size); grid = -1; return; }
        int dev = 0, cus = 0, per_cu = 0;
        if (hipGetDevice(&dev) != hipSuccess || hipDeviceGetAttribute(&cus, hipDeviceAttributeMultiprocessorCount, dev) != hipSuccess) { grid = -1; return; }
        if (hipFuncSetAttribute((const void*)trunk_fwd, hipFuncAttributeMaxDynamicSharedMemorySize, LDS_BYTES) != hipSuccess) { grid = -1; return; }
        if (hipOccupancyMaxActiveBlocksPerMultiprocessor(&per_cu, (const void*)trunk_fwd, NTHR, LDS_BYTES) != hipSuccess || per_cu < 1) { fprintf(stderr, "kernel_launch: occupancy query says %d\n", per_cu); }
        (void)hipGetLastError();
        grid = cus;
    }
    if (grid < 0) return;
    (void)hipMemsetAsync((char*)d_ws + WS_CTL, 0, CTL_ZERO_BYTES, stream);
    Args a{};
    for (int i = 0; i < 18; ++i) a.in[i] = (const float*)d_in[i];
    a.out = (float*)d_out; a.ws = (unsigned char*)d_ws;
#if N_LAUNCH_MODE == 0
    a.ph_lo = 0; a.ph_hi = N_PHASES;
    hipLaunchKernelGGL(trunk_fwd, dim3(grid), dim3(NTHR), LDS_BYTES, stream, a);
#else
    for (int p = 0; p < N_PHASES; ++p) { a.ph_lo = p; a.ph_hi = p + 1; hipLaunchKernelGGL(trunk_fwd, dim3(grid), dim3(NTHR), LDS_BYTES, stream, a); }
#endif
}
```

```cpp
#include <hip/hip_runtime.h>
#include <cstdio>
#include <cstdint>

#define LAS __attribute__((address_space(3)))
#define GAS __attribute__((address_space(1)))
typedef unsigned short bf16;
typedef short bf16x8 __attribute__((ext_vector_type(8)));
typedef float f32x4 __attribute__((ext_vector_type(4)));
typedef float f32x16 __attribute__((ext_vector_type(16)));
typedef unsigned u32x4 __attribute__((ext_vector_type(4)));
typedef unsigned u32x2 __attribute__((ext_vector_type(2)));

constexpr int D = 1024, BATCH = 8, SEQ = 4096, DEPTH = 2, MEMLEN = 256, DFF = 2816, NNORM = 7;
constexpr int M = BATCH * SEQ, MH = M / 2, MMEM = BATCH * MEMLEN;
constexpr int WIN_COLS = 9224;
constexpr int LCH = 64, NCH = SEQ / LCH;
constexpr int ZLD = 7168;
constexpr int ZC_QK = 0, ZC_O = 1024, ZC_U = 2048, ZC_XQ = 3072, ZC_G = 4096;
constexpr int ZTLD = MH;
constexpr float EPS = 1e-6f;
constexpr int NWAVES = 8, NTHR = 512;

constexpr size_t MiB = 1u << 20;
constexpr size_t WS_CTL = 0, CTL_ZERO_BYTES = 1 * MiB;
constexpr size_t WS_WSGU = 1 * MiB;
constexpr size_t WS_GATE = 2 * MiB;
constexpr size_t WS_NST = 3 * MiB;
constexpr size_t WS_CSC = 4 * MiB;
constexpr size_t WS_MEMN = 5 * MiB;
constexpr size_t WS_KMEM = 9 * MiB;
constexpr size_t WS_VTMEM = 13 * MiB;
constexpr size_t WS_W = 17 * MiB;
constexpr size_t WO_GU0 = 0, WO_GU1 = 11 * MiB, WO_D0 = 22 * MiB, WO_D1 = WO_D0 + 5632 * 1024, WO_IN = 33 * MiB, WO_MKV = 51 * MiB, WO_BR = 55 * MiB, WO_OUT = 61 * MiB;
constexpr size_t WS_XN = 80 * MiB;
constexpr size_t WS_RSTD = 4 * MiB + 512 * 1024;
constexpr size_t WS_BIG = 144 * MiB;
constexpr size_t WS_HID = WS_BIG, WS_F = WS_BIG + 176 * MiB, WS_Z = WS_BIG, WS_ZT = WS_BIG + 224 * MiB;
constexpr size_t WS_ST = 432 * MiB;
constexpr size_t WS_KC = 496 * MiB;
constexpr size_t WS_END = 512 * MiB;

constexpr int LDS_BYTES = 147456;
constexpr int RING_BYTES = 131072;
constexpr int MISC_OFF = RING_BYTES + 320;

typedef float f32x2_t __attribute__((ext_vector_type(2))); typedef __bf16 bf16x2_t __attribute__((ext_vector_type(2)));
__device__ __forceinline__ unsigned pk2(float lo, float hi) { f32x2_t v = {lo, hi}; bf16x2_t b = __builtin_convertvector(v, bf16x2_t); return __builtin_bit_cast(unsigned, b); }
__device__ __forceinline__ unsigned f2bf(float f) { return pk2(f, 0.f) & 0xffffu; }
__device__ __forceinline__ float bflo(unsigned w) { return __uint_as_float(w << 16); }
__device__ __forceinline__ float bfhi(unsigned w) { return __uint_as_float(w & 0xffff0000u); }
__device__ __forceinline__ float bf1(bf16 b) { return __uint_as_float((unsigned)b << 16); }
__device__ __forceinline__ float wave_sum(float v) {
#pragma unroll
    for (int o = 1; o < 64; o <<= 1) v += __shfl_xor(v, o);
    return v;
}
__device__ __forceinline__ float sigmoidf_(float x) { return __builtin_amdgcn_rcpf(1.f + __expf(-x)); }
__device__ __forceinline__ float siluf_(float x) { return x * __builtin_amdgcn_rcpf(1.f + __expf(-x)); }
__device__ __forceinline__ float gelu_tanh(float x) { const float u = 1.5957691216f * (x + 0.044715f * x * x * x); return x * __builtin_amdgcn_rcpf(1.f + __expf(-u)); }
__device__ __forceinline__ float logsigmoidf_(float x) { return fminf(x, 0.f) - log1pf(__expf(-fabsf(x))); }
#define LDS_WAIT() asm volatile("s_waitcnt lgkmcnt(0)" ::: "memory")
#define VM_WAIT() asm volatile("s_waitcnt vmcnt(0)" ::: "memory")

namespace pg8 {
constexpr int BM = 256, BK = 64, HALF = 128, HTB = HALF * BK * 2, STAGE_BYTES = 8 * HTB, NXCD = 8, WGM = 8;
__host__ __device__ __forceinline__ int lds_byte(int r, int c) { const int st = (r >> 4) * 2 + (c >> 5), rr = r & 15, cc = c & 31, ob = rr * 64 + cc * 2; return st * 1024 + (ob ^ (((ob >> 9) & 1) << 5)); }
__host__ __device__ __forceinline__ void stage_rc(int b, int& R, int& C) { const int st = b / 1024, sb = b % 1024, swz = sb ^ (((sb >> 9) & 1) << 5); R = (st >> 1) * 16 + swz / 64; C = (st & 1) * 32 + (swz % 64) / 2; }
__host__ __device__ __forceinline__ int perm32(int rho) { const int n = rho >> 4, i = rho & 15; return 8 * (i >> 2) + 4 * n + (i & 3); }

struct Unit { int pm, pn, aux; const char* a; const char* b; };
struct Gemm { int K, lda, ldb; };

struct TileSched {
    int nM, nN, nwg, G, c, reps, pm_per_b;
    const char* A; const char* B;
    size_t a_tile, a_pn, a_rep, b_tile, b_batch, b_rep;
    __device__ __forceinline__ void init(int nM_, int nN_, int G_, int c_, const void* A_, size_t lda_bytes, const void* B_, size_t ldb_bytes) {
        nM = nM_; nN = nN_; nwg = nM * nN; G = G_; c = c_; reps = 1; pm_per_b = 1 << 30; A = (const char*)A_; B = (const char*)B_;
        a_tile = 256 * lda_bytes; a_pn = 0; a_rep = 0; b_tile = 256 * ldb_bytes; b_batch = 0; b_rep = 0;
    }
    __device__ __forceinline__ bool next(int i, Unit& u) const {
        const int ti = i / reps, aux = i - ti * reps;
        const long L = (long)ti * G + c; if (L >= nwg) return false;
        int wgid = (int)L; { const int q = nwg / NXCD, r = nwg % NXCD, xcd = wgid % NXCD, off = wgid / NXCD; wgid = (xcd < r ? xcd * (q + 1) : r * (q + 1) + (xcd - r) * q) + off; }
        const int nig = WGM * nN, gid = wgid / nig, fm = gid * WGM, gsz = (nM - fm) < WGM ? (nM - fm) : WGM;
        u.pm = fm + ((wgid % nig) % gsz); u.pn = (wgid % nig) / gsz; u.aux = aux;
        u.a = A + (size_t)u.pm * a_tile + (size_t)u.pn * a_pn + (size_t)aux * a_rep;
        u.b = B + (size_t)u.pn * b_tile + (size_t)(u.pm / pm_per_b) * b_batch + (size_t)aux * b_rep;
        return true;
    }
};

__device__ __forceinline__ unsigned cvt_pk_bf16(float lo, float hi) { return pk2(lo, hi); }

template <int ACT> __device__ __forceinline__ float actf(float x) {
    if (ACT == 1) return sigmoidf_(x);
    if (ACT == 2) return gelu_tanh(x);
    if (ACT == 3) return x * 0.0625f;
    return x;
}
template <int ACT> __device__ __forceinline__ void store_tile_bf16(const f32x4 (&acc)[2][2][4][2], bf16* O, size_t ldc, int row0, int col0, const float* rsrow, const float* rscol) {
    f32x4 cs[2][2];
#pragma unroll
    for (int bj = 0; bj < 2; ++bj)
#pragma unroll
        for (int n = 0; n < 2; ++n) cs[bj][n] = rscol ? *(const f32x4*)(rscol + col0 + bj * HALF + 4 * n) : (f32x4){1.f, 1.f, 1.f, 1.f};
#pragma unroll
    for (int ai = 0; ai < 2; ++ai)
#pragma unroll
        for (int m = 0; m < 4; ++m) { const int row = row0 + ai * HALF + m * 16; bf16* rowp = O + (size_t)row * ldc + col0; const float rr = rsrow ? rsrow[row] : 1.f;
#pragma unroll
            for (int bj = 0; bj < 2; ++bj) { const f32x4 v0 = acc[ai][bj][m][0] * cs[bj][0] * rr, v1 = acc[ai][bj][m][1] * cs[bj][1] * rr; u32x4 w;
                w.x = cvt_pk_bf16(actf<ACT>(v0[0]), actf<ACT>(v0[1])); w.y = cvt_pk_bf16(actf<ACT>(v0[2]), actf<ACT>(v0[3]));
                w.z = cvt_pk_bf16(actf<ACT>(v1[0]), actf<ACT>(v1[1])); w.w = cvt_pk_bf16(actf<ACT>(v1[2]), actf<ACT>(v1[3]));
                *(u32x4*)(rowp + bj * HALF) = w; } }
}
struct EpiAct {
    static constexpr bool PERM = true;
    bf16* O; size_t ldc; int mode; const float* rsrow; const float* rscol;
    __device__ __forceinline__ void operator()(const f32x4 (&acc)[2][2][4][2], const Unit& u, int wr, int wc, int fr, int fq) const {
        const int row0 = u.pm * BM + wr * 64 + fr, col0 = u.pn * BM + wc * 32 + 8 * fq;
        int act = 0;
        if (mode == 1) { const int g = u.pn >> 2; act = (g == 0) ? 0 : (g == 1) ? 1 : (g == 2) ? 2 : (g == 3) ? 3 : 1; }
        else if (mode == 2) act = (u.pm >= 4) ? 2 : 0;
        if (act == 0) store_tile_bf16<0>(acc, O, ldc, row0, col0, rsrow, rscol);
        else if (act == 1) store_tile_bf16<1>(acc, O, ldc, row0, col0, rsrow, rscol);
        else if (act == 2) store_tile_bf16<2>(acc, O, ldc, row0, col0, rsrow, rscol);
        else store_tile_bf16<3>(acc, O, ldc, row0, col0, rsrow, rscol);
    }
};
struct EpiGU {
    static constexpr bool PERM = true;
    bf16* O; const float* rsrow;
    __device__ __forceinline__ void operator()(const f32x4 (&acc)[2][2][4][2], const Unit& u, int wr, int wc, int fr, int fq) const {
        const int row0 = u.pm * BM + wr * 64 + fr, col0 = u.pn * HALF + wc * 32 + 8 * fq;
#pragma unroll
        for (int ai = 0; ai < 2; ++ai)
#pragma unroll
            for (int m = 0; m < 4; ++m) { const int row = row0 + ai * HALF + m * 16; bf16* rowp = O + (size_t)row * DFF + col0; const float rr = rsrow[row];
                const f32x4 g0 = acc[ai][0][m][0] * rr, g1 = acc[ai][0][m][1] * rr, u0 = acc[ai][1][m][0] * rr, u1 = acc[ai][1][m][1] * rr; u32x4 w;
                w.x = cvt_pk_bf16(siluf_(g0[0]) * u0[0], siluf_(g0[1]) * u0[1]); w.y = cvt_pk_bf16(siluf_(g0[2]) * u0[2], siluf_(g0[3]) * u0[3]);
                w.z = cvt_pk_bf16(siluf_(g1[0]) * u1[0], siluf_(g1[1]) * u1[1]); w.w = cvt_pk_bf16(siluf_(g1[2]) * u1[2], siluf_(g1[3]) * u1[3]);
                *(u32x4*)rowp = w; }
    }
};
struct EpiBranch {
    static constexpr bool PERM = true;
    bf16* Zb;
    __device__ __forceinline__ void operator()(const f32x4 (&acc)[2][2][4][2], const Unit& u, int wr, int wc, int fr, int fq) const {
        const int row0 = u.pm * BM + wr * 64 + fr, col0 = u.pn * BM + wc * 32 + 8 * fq; const int j = u.aux;
#pragma unroll
        for (int ai = 0; ai < 2; ++ai)
#pragma unroll
            for (int m = 0; m < 4; ++m) { bf16* rowp = Zb + (size_t)(row0 + ai * HALF + m * 16) * ZLD + col0;
#pragma unroll
                for (int bj = 0; bj < 2; ++bj) { const f32x4 v0 = acc[ai][bj][m][0], v1 = acc[ai][bj][m][1];
                    const u32x4 g = *(const u32x4*)(rowp + ZC_G + j * 1024 + bj * HALF);
                    float o[8] = { v0[0] * bflo(g.x), v0[1] * bfhi(g.x), v0[2] * bflo(g.y), v0[3] * bfhi(g.y), v1[0] * bflo(g.z), v1[1] * bfhi(g.z), v1[2] * bflo(g.w), v1[3] * bfhi(g.w) };
                    if (j > 0) { const u32x4 p = *(const u32x4*)(rowp + ZC_QK + bj * HALF);
                        o[0] += bflo(p.x); o[1] += bfhi(p.x); o[2] += bflo(p.y); o[3] += bfhi(p.y); o[4] += bflo(p.z); o[5] += bfhi(p.z); o[6] += bflo(p.w); o[7] += bfhi(p.w); }
                    u32x4 w; w.x = cvt_pk_bf16(o[0], o[1]); w.y = cvt_pk_bf16(o[2], o[3]); w.z = cvt_pk_bf16(o[4], o[5]); w.w = cvt_pk_bf16(o[6], o[7]);
                    *(u32x4*)(rowp + ZC_QK + bj * HALF) = w; } }
    }
};

template <class Epi, class Sched>
__device__ __forceinline__ void gemm_phase(LAS unsigned char* lds, const Gemm g, const Sched& S, const Epi& E, const int tid) {
    const int wid = __builtin_amdgcn_readfirstlane(tid >> 6), lane = tid & 63, wr = wid >> 2, wc = wid & 3, fr = lane & 15, fq = lane >> 4;
    const int nt = g.K / BK;
    unsigned voffA[2], voffB[2];
#pragma unroll
    for (int i = 0; i < 2; ++i) { int R, C; stage_rc(tid * 16 + i * 8192, R, C); const int Rb = Epi::PERM ? ((R & ~31) + perm32(R & 31)) : R;
        voffA[i] = (unsigned)(R * g.lda + C) * 2u; voffB[i] = (unsigned)(Rb * g.ldb + C) * 2u; }
    const size_t kstep = (size_t)(BK * 2);
    const size_t hstepA = (size_t)HALF * g.lda * 2, hstepB = (size_t)HALF * g.ldb * 2;
    const unsigned ldsw = (unsigned)wid * 1024u;
    const int aoff = lds_byte(wr * 64 + fr, fq * 8), boff = lds_byte(wc * 32 + fr, fq * 8);
#define PG8_SA(b, h) (((b) * 2 + (h)) * HTB)
#define PG8_SB(b, h) ((4 + (b) * 2 + (h)) * HTB)
#define PG8_STAGE(bufoff, gbase, voff) do { _Pragma("unroll") for (int _i = 0; _i < 2; ++_i) \
        __builtin_amdgcn_global_load_lds((const unsigned*)((const char*)(gbase) + (voff)[_i]), (LAS unsigned*)(lds + (bufoff) + ldsw + _i * 8192), 16, 0, 0); } while (0)
#define PG8_LDA(dst, b, h) do { _Pragma("unroll") for (int m = 0; m < 4; ++m) _Pragma("unroll") for (int k = 0; k < 2; ++k) dst[m][k] = *(const LAS bf16x8*)(lds + PG8_SA(b, h) + aoff + m * 2048 + k * 1024); } while (0)
#define PG8_LDB(dst, b, h) do { _Pragma("unroll") for (int n = 0; n < 2; ++n) _Pragma("unroll") for (int k = 0; k < 2; ++k) dst[n][k] = *(const LAS bf16x8*)(lds + PG8_SB(b, h) + boff + n * 2048 + k * 1024); } while (0)
#define PG8_MMA(ai, bj, At, Bt) do { __builtin_amdgcn_s_setprio(1); _Pragma("unroll") for (int m = 0; m < 4; ++m) _Pragma("unroll") for (int n = 0; n < 2; ++n) _Pragma("unroll") for (int k = 0; k < 2; ++k) \
        acc[ai][bj][m][n] = __builtin_amdgcn_mfma_f32_16x16x32_bf16(Bt[n][k], At[m][k], acc[ai][bj][m][n], 0, 0, 0); __builtin_amdgcn_s_setprio(0); } while (0)
#define PG8_WAIT_V(n) asm volatile("s_waitcnt vmcnt(" #n ")" ::: "memory")
#define PG8_WAIT_L(n) asm volatile("s_waitcnt lgkmcnt(" #n ")" ::: "memory")
#define PG8_BAR __builtin_amdgcn_s_barrier()
#define PG8_SCHED __builtin_amdgcn_sched_barrier(0)
    Unit cur, nxt; int ui = 0;
    if (!S.next(0, cur)) return;
    f32x4 acc[2][2][4][2];
#pragma unroll
    for (int a = 0; a < 2; ++a)
#pragma unroll
        for (int b = 0; b < 2; ++b)
#pragma unroll
            for (int m = 0; m < 4; ++m)
#pragma unroll
                for (int n = 0; n < 2; ++n) acc[a][b][m][n] = (f32x4){0.f, 0.f, 0.f, 0.f};
    bf16x8 At[4][2], B0[2][2], B1[2][2];
    const char* cA = cur.a; const char* cB = cur.b;
    PG8_STAGE(PG8_SB(0, 0), cB, voffB); PG8_STAGE(PG8_SB(0, 1), cB + hstepB, voffB); PG8_STAGE(PG8_SA(0, 0), cA, voffA); PG8_STAGE(PG8_SA(0, 1), cA + hstepA, voffA);
    if (wr == 1) PG8_BAR;
    PG8_WAIT_V(2); PG8_BAR;
    PG8_STAGE(PG8_SB(1, 0), cB + kstep, voffB); PG8_STAGE(PG8_SA(1, 0), cA + kstep, voffA); PG8_STAGE(PG8_SB(1, 1), cB + hstepB + kstep, voffB);
    PG8_WAIT_V(6); PG8_BAR;
    for (;;) {
        const bool has_next = S.next(ui + 1, nxt);
        const char* nA = has_next ? nxt.a : cA; const char* nB = has_next ? nxt.b : cB;
        for (int t = 0; t < nt; t += 2) {
            const bool last = (t == nt - 2);
            const char* a1 = cA + (size_t)(t + 1) * kstep;
            const char* a2 = last ? nA : cA + (size_t)(t + 2) * kstep; const char* b2 = last ? nB : cB + (size_t)(t + 2) * kstep;
            const char* a3 = a2 + kstep; const char* b3 = b2 + kstep;
            PG8_LDB(B0, 0, 0); PG8_LDB(B1, 0, 1); PG8_SCHED; PG8_LDA(At, 0, 0); PG8_STAGE(PG8_SA(1, 1), a1 + hstepA, voffA);
            PG8_WAIT_V(8); PG8_WAIT_L(0); PG8_BAR; PG8_MMA(0, 0, At, B0); PG8_MMA(0, 1, At, B1); PG8_BAR; PG8_SCHED;
            PG8_LDA(At, 0, 1); PG8_STAGE(PG8_SB(0, 0), b2, voffB); PG8_STAGE(PG8_SB(0, 1), b2 + hstepB, voffB); PG8_STAGE(PG8_SA(0, 0), a2, voffA);
            PG8_WAIT_V(8); PG8_WAIT_L(0); PG8_BAR; PG8_MMA(1, 0, At, B0); PG8_MMA(1, 1, At, B1); PG8_BAR; PG8_SCHED;
            PG8_LDB(B0, 1, 0); PG8_LDB(B1, 1, 1); PG8_SCHED; PG8_LDA(At, 1, 0); PG8_STAGE(PG8_SA(0, 1), a2 + hstepA, voffA);
            PG8_WAIT_V(8); PG8_WAIT_L(0); PG8_BAR; PG8_MMA(0, 0, At, B0); PG8_MMA(0, 1, At, B1); PG8_BAR; PG8_SCHED;
            PG8_LDA(At, 1, 1); PG8_STAGE(PG8_SB(1, 0), b3, voffB); PG8_STAGE(PG8_SB(1, 1), b3 + hstepB, voffB); PG8_STAGE(PG8_SA(1, 0), a3, voffA);
            PG8_WAIT_V(8); PG8_WAIT_L(0); PG8_BAR; PG8_MMA(1, 0, At, B0); PG8_MMA(1, 1, At, B1); PG8_BAR; PG8_SCHED;
        }
        if (wr == 0) PG8_BAR;
        E(acc, cur, wr, wc, fr, fq);
        if (!has_next) break;
#pragma unroll
        for (int a = 0; a < 2; ++a)
#pragma unroll
            for (int b = 0; b < 2; ++b)
#pragma unroll
                for (int m = 0; m < 4; ++m)
#pragma unroll
                    for (int n = 0; n < 2; ++n) acc[a][b][m][n] = (f32x4){0.f, 0.f, 0.f, 0.f};
        cur = nxt; cA = nA; cB = nB; ++ui;
        if (wr == 1) PG8_BAR;
    }
    PG8_WAIT_V(0);
    PG8_BAR;
#undef PG8_SA
#undef PG8_SB
#undef PG8_STAGE
#undef PG8_LDA
#undef PG8_LDB
#undef PG8_MMA
#undef PG8_WAIT_V
#undef PG8_WAIT_L
#undef PG8_BAR
#undef PG8_SCHED
}
}

#define XB_TMO      128
#define XB_XCNT(j)  (256  + 64 * (j))
#define XB_XSUB(j)  (1280 + 64 * (j))
#define XB_XGEN(j)  (2304 + 64 * (j))
#define XB_TOP      3328
#define XB_TOPGEN   3392
#define XCD_BAR_WORDS 3456
#define XB_SPIN_CAP (1u << 18)
__device__ __forceinline__ unsigned xb_ld(unsigned* p)              { return __hip_atomic_load(p, __ATOMIC_RELAXED, __HIP_MEMORY_SCOPE_AGENT); }
__device__ __forceinline__ unsigned xb_add(unsigned* p, unsigned v) { return __hip_atomic_fetch_add(p, v, __ATOMIC_RELAXED, __HIP_MEMORY_SCOPE_AGENT); }
__device__ __forceinline__ unsigned xb_xcc_id() { return (unsigned)__builtin_amdgcn_s_getreg((3 << 11) | 20) & 0xFu; }
#define XB_SPIN(cond, bar) do { unsigned _sp = 0; while (cond) { __builtin_amdgcn_s_sleep(1); \
    if ((++_sp & 255u) == 0u) { if (xb_ld(&(bar)[XB_TMO])) break; if (_sp > XB_SPIN_CAP) { atomicAdd(&(bar)[XB_TMO], 1u); break; } } } } while (0)
struct XcdBarrier { unsigned* bar; unsigned x; volatile LAS unsigned* st; };
__device__ __forceinline__ XcdBarrier xcd_barrier_post(unsigned* bar, volatile LAS unsigned* st) {
    XcdBarrier b; b.bar = bar; b.x = xb_xcc_id(); b.st = st;
    if (threadIdx.x == 0) (void)xb_add(&bar[XB_XCNT(b.x)], 1u);
    return b;
}
__device__ __forceinline__ void xcd_barrier_complete(unsigned* bar, unsigned x, unsigned& nloc, unsigned& nx) {
    const unsigned G = gridDim.x * gridDim.y * gridDim.z;
    unsigned sum, cnt, mine, sp = 0u;
    for (;;) {
        sum = 0u; cnt = 0u; mine = 0u;
#pragma unroll
        for (unsigned j = 0; j < 16; ++j) { const unsigned c = xb_ld(&bar[XB_XCNT(j)]); sum += c; cnt += (c > 0u) ? 1u : 0u; mine = (j == x) ? c : mine; }
        if (sum == G) break;
        __builtin_amdgcn_s_sleep(1);
        if ((++sp & 255u) == 0u) { if (xb_ld(&bar[XB_TMO])) break; if (sp > XB_SPIN_CAP) { atomicAdd(&bar[XB_TMO], 1u); break; } }
    }
    nloc = mine > 0u ? mine : 1u; nx = cnt > 0u ? cnt : 1u;
}
__device__ __forceinline__ void xcd_barrier(const XcdBarrier& b) {
    asm volatile("s_waitcnt vmcnt(0)" ::: "memory");
    __syncthreads();
    if (threadIdx.x == 0) {
        unsigned* bar = b.bar;
        __builtin_amdgcn_s_waitcnt(0);
        unsigned nloc = b.st[0], nx = b.st[1];
        if (nloc == 0u) { xcd_barrier_complete(bar, b.x, nloc, nx); b.st[0] = nloc; b.st[1] = nx; }
        const unsigned old = xb_add(&bar[XB_XSUB(b.x)], 1u);
        const unsigned gen = old / nloc;
        if (old + 1u == (gen + 1u) * nloc) {
            __builtin_amdgcn_fence(__ATOMIC_RELEASE, "agent");
            asm volatile("s_waitcnt vmcnt(0)" ::: "memory");
            const unsigned og = xb_add(&bar[XB_TOP], 1u);
            const unsigned tg = og / nx;
            if (og + 1u == (tg + 1u) * nx) xb_add(&bar[XB_TOPGEN], 1u);
            else XB_SPIN(xb_ld(&bar[XB_TOPGEN]) == tg, bar);
            __builtin_amdgcn_fence(__ATOMIC_ACQUIRE, "agent");
            xb_add(&bar[XB_XGEN(b.x)], 1u);
            asm volatile("s_waitcnt vmcnt(0)" ::: "memory");
        } else {
            XB_SPIN(xb_ld(&bar[XB_XGEN(b.x)]) == gen, bar);
            __builtin_amdgcn_fence(__ATOMIC_ACQUIRE, "agent");
            asm volatile("s_waitcnt vmcnt(0)" ::: "memory");
        }
    }
    __syncthreads();
}

struct Args { const float* in[18]; float* out; unsigned char* ws; int ph_lo, ph_hi; };
enum { I_X = 0, I_MEM, I_NORMG, I_WGU, I_WDOWN, I_WIN, I_CONVW, I_CONVB, I_BI, I_BF, I_MNORM, I_SLNG, I_SLNB, I_SWS, I_SBS, I_WMKV, I_WBR, I_WOUT };

__device__ __forceinline__ void cvt_item(const float* W, int Nsrc, int K, int srccol, bf16* WT, int dstrow, int kb, LAS float* scr, int lane, const float* gk = nullptr) {
    const int k0 = 64 * kb;
    if ((srccol & 3) == 0) {
        const int c4 = (lane & 7) * 4, rr = lane >> 3;
#pragma unroll
        for (int i = 0; i < 8; ++i) { const int kk = 8 * i + rr; f32x4 x = *(const f32x4*)(W + (size_t)(k0 + kk) * Nsrc + srccol + c4); if (gk) x = x * gk[k0 + kk];
            LAS float* d = scr + kk * 33 + c4; d[0] = x.x; d[1] = x.y; d[2] = x.z; d[3] = x.w; }
    } else {
#pragma unroll 8
        for (int i = 0; i < 32; ++i) { const int kk = 2 * i + (lane >> 5); scr[kk * 33 + (lane & 31)] = W[(size_t)(k0 + kk) * Nsrc + srccol + (lane & 31)] * (gk ? gk[k0 + kk] : 1.f); }
    }
    LDS_WAIT(); asm volatile("" ::: "memory");
    const int c = lane & 7;
#pragma unroll
    for (int j = 0; j < 4; ++j) { const int n = (lane >> 3) + 8 * j; const LAS float* s = scr + (8 * c) * 33 + n;
        u32x4 o; o.x = pk2(s[0 * 33], s[1 * 33]); o.y = pk2(s[2 * 33], s[3 * 33]); o.z = pk2(s[4 * 33], s[5 * 33]); o.w = pk2(s[6 * 33], s[7 * 33]);
        *(u32x4*)(WT + (size_t)(dstrow + n) * K + k0 + 8 * c) = o; }
    LDS_WAIT(); asm volatile("" ::: "memory");
}
__device__ __forceinline__ int win_srccol(int r) {
    if (r < 1024) return r;
    if (r < 2048) return 2048 + (r - 1024);
    if (r < 3072) return 3080 + (r - 2048);
    if (r < 4096) return 5128 + (r - 3072);
    if (r < 7168) return 6152 + (r - 4096);
    if (r < 8192) return 1024 + (r - 7168);
    return 4104 + (r - 8192);
}
__device__ __forceinline__ void convert_layer(const Args& a, int l, unsigned char* ws, LAS unsigned char* lds, int gw, int NGW, int wave, int lane, int gtid, int GT) {
    LAS float* scr = (LAS float*)(lds + wave * 16384);
    bf16* Wb = (bf16*)(ws + WS_W);
    constexpr int I_GU = 16 * 176, I_DN = 44 * 32, I_IN = 16 * 288, I_MKV = 16 * 64, I_BR = 16 * 32, I_OUT = 16 * 32;
    constexpr int NITEMS = 2 * I_GU + 2 * I_DN + I_IN + I_MKV + 3 * I_BR + I_OUT;
    for (int it = gw; it < NITEMS; it += NGW) {
        int r = it;
        if (r < 2 * I_GU) { const int j = r / I_GU; r -= j * I_GU; const int kb = r / 176, nb = r % 176; const int p = nb >> 3, q = nb & 7, s = q >> 2, jj = (q & 3) * 32;
            cvt_item(a.in[I_WGU] + (size_t)(l * 2 + j) * D * 2 * DFF, 2 * DFF, D, s * DFF + 128 * p + jj, (bf16*)((char*)Wb + (j ? WO_GU1 : WO_GU0)), nb * 32, kb, scr, lane, a.in[I_NORMG] + (size_t)(l * NNORM + (j ? 4 : 0)) * D); continue; }
        r -= 2 * I_GU;
        if (r < 2 * I_DN) { const int j = r / I_DN; r -= j * I_DN; const int kb = r / 32, nb = r % 32;
            cvt_item(a.in[I_WDOWN] + (size_t)(l * 2 + j) * DFF * D, D, DFF, nb * 32, (bf16*)((char*)Wb + (j ? WO_D1 : WO_D0)), nb * 32, kb, scr, lane); continue; }
        r -= 2 * I_DN;
        if (r < I_IN) { const int kb = r / 288, nb = r % 288;
            cvt_item(a.in[I_WIN] + (size_t)l * D * WIN_COLS, WIN_COLS, D, win_srccol(nb * 32), (bf16*)((char*)Wb + WO_IN), nb * 32, kb, scr, lane, a.in[I_NORMG] + (size_t)(l * NNORM + 2) * D); continue; }
        r -= I_IN;
        if (r < I_MKV) { const int kb = r / 64, nb = r % 64;
            cvt_item(a.in[I_WMKV] + (size_t)l * D * 2048, 2048, D, nb * 32, (bf16*)((char*)Wb + WO_MKV), nb * 32, kb, scr, lane); continue; }
        r -= I_MKV;
        if (r < 3 * I_BR) { const int j = r / I_BR; r -= j * I_BR; const int kb = r / 32, nb = r % 32;
            cvt_item(a.in[I_WBR] + (size_t)(l * 3 + j) * D * D, D, D, nb * 32, (bf16*)((char*)Wb + WO_BR) + (size_t)j * D * D, nb * 32, kb, scr, lane); continue; }
        r -= 3 * I_BR;
        { const int kb = r / 32, nb = r % 32; cvt_item(a.in[I_WOUT] + (size_t)l * D * D, D, D, nb * 32, (bf16*)((char*)Wb + WO_OUT), nb * 32, kb, scr, lane); }
    }
    bf16* wsg = (bf16*)(ws + WS_WSGU); const float* src = a.in[I_SWS] + (size_t)l * 4 * 128 * 128;
    for (int e = gtid; e < 4 * 128 * 128; e += GT) { const int t = (e >> 7) & 127, s = e & 127; wsg[e] = (bf16)f2bf(s <= t ? src[e] : 0.f); }
    const float* g6 = a.in[I_NORMG] + (size_t)(l * NNORM + 6) * D;
    for (int m = gw; m < MMEM; m += NGW) {
        const f32x4* xr = (const f32x4*)(a.in[I_MEM] + (size_t)m * D) + lane; f32x4 v[4]; float s = 0.f;
#pragma unroll
        for (int j = 0; j < 4; ++j) { v[j] = xr[64 * j]; s += (v[j].x * v[j].x + v[j].y * v[j].y) + (v[j].z * v[j].z + v[j].w * v[j].w); }
        const float rstd = rsqrtf(wave_sum(s) * (1.f / D) + EPS);
        unsigned long long* o8 = (unsigned long long*)((bf16*)(ws + WS_MEMN) + (size_t)m * D) + lane;
#pragma unroll
        for (int j = 0; j < 4; ++j) { const f32x4 gg = ((const f32x4*)g6)[lane + 64 * j];
            o8[64 * j] = (unsigned long long)pk2(v[j].x * rstd * gg.x, v[j].y * rstd * gg.y) | ((unsigned long long)pk2(v[j].z * rstd * gg.z, v[j].w * rstd * gg.w) << 32); }
    }
}

__device__ __forceinline__ void thin_rows(const bf16* fbase, size_t fld, const float* ga, float scale, const float* hin32, const bf16* hinb, bf16* hb_out, float* rstd_out, float* out32,
                                          int row_lo, int row_hi, int gw, int NGW, int lane, const bool do_gates, const LAS float* wif, const float* bi, const float* bfg, float* gate_i, float* gate_f) {
    for (int m = row_lo + gw; m < row_hi; m += NGW) {
        f32x4 v[4];
        if (hin32) { const f32x4* hr = (const f32x4*)(hin32 + (size_t)m * D) + lane;
#pragma unroll
            for (int j = 0; j < 4; ++j) v[j] = hr[64 * j]; }
        else { const unsigned long long* hr = (const unsigned long long*)(hinb + (size_t)m * D) + lane;
#pragma unroll
            for (int j = 0; j < 4; ++j) { const unsigned long long w = hr[64 * j]; const unsigned lo = (unsigned)w, hi = (unsigned)(w >> 32); v[j] = (f32x4){bflo(lo), bfhi(lo), bflo(hi), bfhi(hi)}; } }
        if (fbase) {
            const unsigned long long* fr = (const unsigned long long*)(fbase + (size_t)(m - row_lo) * fld) + lane; float s = 0.f; f32x4 f[4];
#pragma unroll
            for (int j = 0; j < 4; ++j) { const unsigned long long w = fr[64 * j]; const unsigned lo = (unsigned)w, hi = (unsigned)(w >> 32);
                f[j] = (f32x4){bflo(lo), bfhi(lo), bflo(hi), bfhi(hi)}; s += (f[j].x * f[j].x + f[j].y * f[j].y) + (f[j].z * f[j].z + f[j].w * f[j].w); }
            const float rstd = rsqrtf(wave_sum(s) * (1.f / D) + EPS) * scale;
#pragma unroll
            for (int j = 0; j < 4; ++j) { const f32x4 gg = ((const f32x4*)ga)[lane + 64 * j]; v[j] = v[j] + f[j] * rstd * gg; }
        }
        if (out32) { f32x4* ho = (f32x4*)(out32 + (size_t)m * D) + lane;
#pragma unroll
            for (int j = 0; j < 4; ++j) ho[64 * j] = v[j]; }
        if (hb_out) {
            float s = 0.f;
#pragma unroll
            for (int j = 0; j < 4; ++j) s += (v[j].x * v[j].x + v[j].y * v[j].y) + (v[j].z * v[j].z + v[j].w * v[j].w);
            const float rstd = rsqrtf(wave_sum(s) * (1.f / D) + EPS);
            unsigned long long* o8 = (unsigned long long*)(hb_out + (size_t)m * D) + lane;
#pragma unroll
            for (int j = 0; j < 4; ++j) o8[64 * j] = (unsigned long long)pk2(v[j].x, v[j].y) | ((unsigned long long)pk2(v[j].z, v[j].w) << 32);
            if (lane == 0) rstd_out[m] = rstd;
            if (do_gates) {
                float acc[8];
#pragma unroll
                for (int e = 0; e < 8; ++e) acc[e] = 0.f;
#pragma unroll
                for (int j = 0; j < 4; ++j)
#pragma unroll
                    for (int q = 0; q < 4; ++q) { const int k = 4 * lane + 256 * j + q; const float xv = v[j][q]; const LAS f32x4* wp = (const LAS f32x4*)(wif + k * 8); const f32x4 w0 = wp[0], w1 = wp[1];
                        acc[0] += xv * w0.x; acc[1] += xv * w0.y; acc[2] += xv * w0.z; acc[3] += xv * w0.w; acc[4] += xv * w1.x; acc[5] += xv * w1.y; acc[6] += xv * w1.z; acc[7] += xv * w1.w; }
#pragma unroll
                for (int e = 0; e < 8; ++e) acc[e] = wave_sum(acc[e]) * rstd;
                if (lane == 0) {
                    *(f32x4*)(gate_i + (size_t)m * 4) = (f32x4){acc[0] + bi[0], acc[1] + bi[1], acc[2] + bi[2], acc[3] + bi[3]};
                    *(f32x4*)(gate_f + (size_t)m * 4) = (f32x4){logsigmoidf_(acc[4] + bfg[0]), logsigmoidf_(acc[5] + bfg[1]), logsigmoidf_(acc[6] + bfg[2]), logsigmoidf_(acc[7] + bfg[3])};
                }
            }
        }
    }
}

__device__ __forceinline__ void conv8(const bf16* Zb, int bl, int p, int col, const float* cw, const float* cb, float (&o)[8]) {
    const f32x4 b0 = *(const f32x4*)(cb + col), b1 = *(const f32x4*)(cb + col + 4);
    o[0] = b0.x; o[1] = b0.y; o[2] = b0.z; o[3] = b0.w; o[4] = b1.x; o[5] = b1.y; o[6] = b1.z; o[7] = b1.w;
#pragma unroll
    for (int j = 0; j < 4; ++j) { const int pp = p - 3 + j;
        if (pp >= 0) { const u32x4 x = *(const u32x4*)(Zb + (size_t)(bl * SEQ + pp) * ZLD + ZC_QK + col);
            const f32x4 w0 = *(const f32x4*)(cw + j * 1024 + col), w1 = *(const f32x4*)(cw + j * 1024 + col + 4);
            o[0] += w0.x * bflo(x.x); o[1] += w0.y * bfhi(x.x); o[2] += w0.z * bflo(x.y); o[3] += w0.w * bfhi(x.y);
            o[4] += w1.x * bflo(x.z); o[5] += w1.y * bfhi(x.z); o[6] += w1.z * bflo(x.w); o[7] += w1.w * bfhi(x.w); } }
#pragma unroll
    for (int e = 0; e < 8; ++e) o[e] = siluf_(o[e]);
}
__device__ __forceinline__ float wave_incl_scan_add(float v, int lane) {
#pragma unroll
    for (int o = 1; o < 64; o <<= 1) { const float t = __shfl_up(v, o); if (lane >= o) v += t; }
    return v;
}
__device__ __forceinline__ float wave_incl_scan_max(float v, int lane) {
#pragma unroll
    for (int o = 1; o < 64; o <<= 1) { const float t = __shfl_up(v, o); if (lane >= o) v = fmaxf(v, t); }
    return v;
}
__device__ __forceinline__ float wave_max(float v) {
#pragma unroll
    for (int o = 1; o < 64; o <<= 1) v = fmaxf(v, __shfl_xor(v, o));
    return v;
}
constexpr float KSCALE = 0.08838834764831845f;

__device__ __forceinline__ void conv8l(const bf16* Zb, int bl, int p, int col, const LAS float* wl, const int wstride, float (&o)[8]) {
    { const f32x4 b0 = *(const LAS f32x4*)(wl + 4 * wstride), b1 = *(const LAS f32x4*)(wl + 4 * wstride + 4);
      o[0] = b0.x; o[1] = b0.y; o[2] = b0.z; o[3] = b0.w; o[4] = b1.x; o[5] = b1.y; o[6] = b1.z; o[7] = b1.w; }
#pragma unroll
    for (int j = 0; j < 4; ++j) { const int pp = p - 3 + j;
        if (pp >= 0) { const u32x4 x = *(const u32x4*)(Zb + (size_t)(bl * SEQ + pp) * ZLD + ZC_QK + col);
            const f32x4 w0 = *(const LAS f32x4*)(wl + j * wstride), w1 = *(const LAS f32x4*)(wl + j * wstride + 4);
            o[0] += w0.x * bflo(x.x); o[1] += w0.y * bfhi(x.x); o[2] += w0.z * bflo(x.y); o[3] += w0.w * bfhi(x.y);
            o[4] += w1.x * bflo(x.z); o[5] += w1.y * bfhi(x.z); o[6] += w1.z * bflo(x.w); o[7] += w1.w * bfhi(x.w); } }
#pragma unroll
    for (int e = 0; e < 8; ++e) o[e] = siluf_(o[e]);
}
__device__ __forceinline__ void stage_convw(LAS float* wl, const float* cw, const float* cb, int col0, int ncol, int dst0, int wstride, int tid) {
    for (int e = tid; e < 5 * ncol; e += NTHR) { const int j = e / ncol, cidx = e - j * ncol; wl[j * wstride + dst0 + cidx] = (j < 4) ? cw[j * 1024 + col0 + cidx] : cb[col0 + cidx]; }
}
__device__ __forceinline__ void mlstm_s1(const Args& a, int l, int hf, unsigned char* ws, LAS unsigned char* lds, int G, int cu, int tid, int wave, int lane) {
    const bf16* Zb = (const bf16*)(ws + WS_Z); const bf16* ZT = (const bf16*)(ws + WS_ZT);
    const float* gi = (const float*)(ws + WS_GATE); const float* gf = gi + (size_t)M * 4;
    const float* cw = a.in[I_CONVW] + (size_t)l * 4 * 1024; const float* cb = a.in[I_CONVB] + (size_t)l * 1024;
    LAS bf16* KT = (LAS bf16*)lds;
    LAS float* wv = (LAS float*)(lds + 18432);
    LAS float* CWL = (LAS float*)(lds + 18688);
    const int c8 = tid & 15; int hcur = -1;
    for (int u = cu; u < 16 * NCH; u += G) {
        const int h = u & 3, c = (u >> 2) & 63, bl = u >> 8, bhl = bl * 4 + h; const int tokg = (hf * 4 + bl) * SEQ + c * LCH;
        if (h != hcur) { __syncthreads(); stage_convw(CWL, cw, cb, 512 + h * 128, 128, 0, 128, tid); hcur = h; }
        const int r = lane & 31, hh = lane >> 5, v0 = 32 * wave;
        bf16x8 bfr[4];
        { const bf16* vrow = ZT + (size_t)(h * 256 + v0 + r) * ZTLD + bl * SEQ + c * LCH + 8 * hh;
#pragma unroll
          for (int ks = 0; ks < 4; ++ks) bfr[ks] = *(const bf16x8*)(vrow + 16 * ks); }
        if (wave == 0) {
            const float lf = gf[(size_t)(tokg + lane) * 4 + h], ii = gi[(size_t)(tokg + lane) * 4 + h];
            const float bc = wave_incl_scan_add(lf, lane); const float g = __shfl(bc, 63);
            const float av = g - bc + ii; const float ml = wave_max(av);
            wv[lane] = __expf(av - ml);
            if (lane == 0) { float* cs = (float*)(ws + WS_CSC) + (size_t)(bhl * NCH + c) * 4; cs[0] = g; cs[1] = ml; }
        }
        __syncthreads();
#pragma unroll
        for (int rep = 0; rep < 2; ++rep) { const int idx = tid + rep * NTHR, s = idx >> 4; float o[8];
            conv8l(Zb, bl, c * LCH + s, 512 + h * 128 + c8 * 8, CWL + c8 * 8, 128, o); const float sc = wv[s] * KSCALE;
            { u32x4 w; w.x = pk2(o[0] * KSCALE, o[1] * KSCALE); w.y = pk2(o[2] * KSCALE, o[3] * KSCALE); w.z = pk2(o[4] * KSCALE, o[5] * KSCALE); w.w = pk2(o[6] * KSCALE, o[7] * KSCALE);
              *(u32x4*)((bf16*)(ws + WS_KC) + (size_t)(bl * SEQ + c * LCH + s) * 512 + h * 128 + c8 * 8) = w; }
#pragma unroll
            for (int e = 0; e < 8; ++e) KT[(c8 * 8 + e) * 72 + s] = (bf16)f2bf(o[e] * sc); }
        __syncthreads();
        if (tid < 128) { float s = 0.f;
#pragma unroll 8
            for (int k = 0; k < 64; ++k) s += bf1(KT[tid * 72 + k]);
            ((float*)(ws + WS_NST))[(size_t)(bhl * NCH + c) * 128 + tid] = s; }
        {
            bf16* st = (bf16*)(ws + WS_ST) + (size_t)(bhl * NCH + c) * 32768 + (size_t)(v0 + r) * 128;
#pragma unroll
            for (int db = 0; db < 4; ++db) { f32x16 acc;
#pragma unroll
                for (int e = 0; e < 16; ++e) acc[e] = 0.f;
#pragma unroll
                for (int ks = 0; ks < 4; ++ks) { const bf16x8 af = *(const LAS bf16x8*)(KT + (32 * db + r) * 72 + 16 * ks + 8 * hh); acc = __builtin_amdgcn_mfma_f32_32x32x16_bf16(af, bfr[ks], acc, 0, 0, 0); }
#pragma unroll
                for (int q = 0; q < 4; ++q) { u32x2 w; w.x = pk2(acc[4 * q], acc[4 * q + 1]); w.y = pk2(acc[4 * q + 2], acc[4 * q + 3]); *(u32x2*)(st + 32 * db + 8 * q + 4 * hh) = w; } }
        }
        __syncthreads();
    }
}
__device__ __forceinline__ void mlstm_s2(unsigned char* ws, int G, int cu, int tid) {
    for (int u = cu; u < 256; u += G) {
        const int bhl = u >> 4, part = u & 15; const size_t off = (size_t)(part * NTHR + tid) * 4;
        bf16* st = (bf16*)(ws + WS_ST) + (size_t)bhl * NCH * 32768 + off; float* ns = (float*)(ws + WS_NST) + (size_t)bhl * NCH * 128 + tid; float* cs = (float*)(ws + WS_CSC) + (size_t)bhl * NCH * 4;
        const bool nth = (part == 0 && tid < 128);
        float C[4]; float nv = 0.f, m = -1e30f;
#pragma unroll
        for (int e = 0; e < 4; ++e) C[e] = 0.f;
        for (int c0 = 0; c0 < NCH; c0 += 8) {
            u32x2 cl[8]; float nl[8], gg[8], ml[8];
#pragma unroll
            for (int i = 0; i < 8; ++i) { cl[i] = *(const u32x2*)(st + (size_t)(c0 + i) * 32768); nl[i] = nth ? ns[(c0 + i) * 128] : 0.f; gg[i] = cs[(c0 + i) * 4]; ml[i] = cs[(c0 + i) * 4 + 1]; }
#pragma unroll
            for (int i = 0; i < 8; ++i) {
                u32x2 o; o.x = pk2(C[0], C[1]); o.y = pk2(C[2], C[3]);
                *(u32x2*)(st + (size_t)(c0 + i) * 32768) = o;
                if (nth) ns[(c0 + i) * 128] = nv;
                if (part == 0 && tid == 0) cs[(c0 + i) * 4 + 2] = m;
                const float mn = fmaxf(gg[i] + m, ml[i]); const float dec = __expf(gg[i] + m - mn), sc = __expf(ml[i] - mn);
                C[0] = dec * C[0] + sc * bflo(cl[i].x); C[1] = dec * C[1] + sc * bfhi(cl[i].x); C[2] = dec * C[2] + sc * bflo(cl[i].y); C[3] = dec * C[3] + sc * bfhi(cl[i].y);
                nv = dec * nv + sc * nl[i]; m = mn;
            }
        }
    }
}
__device__ __forceinline__ void mlstm_s3(const Args& a, int l, int hf, unsigned char* ws, LAS unsigned char* lds, int G, int cu, int tid, int wave, int lane, const int out_col) {
    bf16* Zb = (bf16*)(ws + WS_Z); const bf16* ZT = (const bf16*)(ws + WS_ZT);
    const float* gi = (const float*)(ws + WS_GATE); const float* gf = gi + (size_t)M * 4;
    const float* cw = a.in[I_CONVW] + (size_t)l * 4 * 1024; const float* cb = a.in[I_CONVB] + (size_t)l * 1024;
    const float* gain = a.in[I_MNORM] + (size_t)l * 1024;
    LAS bf16* QS = (LAS bf16*)lds;
    LAS bf16* KS = (LAS bf16*)(lds + 17408);
    LAS bf16* SD = (LAS bf16*)(lds + 34816);
    LAS float* HB = (LAS float*)(lds + 44032);
    LAS float* SC = (LAS float*)(lds + 110592);
    LAS float* CWL = (LAS float*)(lds + 112384);
    const int c8 = tid & 15; int hcur = -1;
    for (int u = cu; u < 16 * NCH; u += G) {
        const int h = u & 3, c = (u >> 2) & 63, bl = u >> 8, bhl = bl * 4 + h; const int tokg = (hf * 4 + bl) * SEQ + c * LCH; const int tokl = bl * SEQ + c * LCH;
        if (h != hcur) { __syncthreads(); stage_convw(CWL, cw, cb, h * 128, 128, 0, 256, tid); hcur = h; __syncthreads(); }
        const int r = lane & 31, hh = lane >> 5, v0 = 32 * wave;
        bf16x8 bV[4], bC[8];
        { const bf16* vrow = ZT + (size_t)(h * 256 + v0 + r) * ZTLD + tokl + 8 * hh;
          const bf16* crow = (const bf16*)(ws + WS_ST) + (size_t)(bhl * NCH + c) * 32768 + (size_t)(v0 + r) * 128 + 8 * hh;
#pragma unroll
          for (int ks = 0; ks < 4; ++ks) bV[ks] = *(const bf16x8*)(vrow + 16 * ks);
#pragma unroll
          for (int ks = 0; ks < 8; ++ks) bC[ks] = *(const bf16x8*)(crow + 16 * ks); }
        u32x4 ogr[4];
#pragma unroll
        for (int i = 0; i < 4; ++i) ogr[i] = *(const u32x4*)(Zb + (size_t)(tokl + (tid >> 3)) * ZLD + ZC_O + h * 256 + 32 * (tid & 7) + 8 * i);
        if (wave == 0) {
            const float lf = gf[(size_t)(tokg + lane) * 4 + h], ii = gi[(size_t)(tokg + lane) * 4 + h];
            const float bc = wave_incl_scan_add(lf, lane); const float rr = ii - bc; const float cm = wave_incl_scan_max(rr, lane);
            const float mst = ((const float*)(ws + WS_CSC))[(size_t)(bhl * NCH + c) * 4 + 2];
            const float Mt = fmaxf(mst, cm);
            SC[lane] = rr; SC[64 + lane] = Mt; SC[128 + lane] = __expf(mst - Mt); SC[192 + lane] = __expf(-(bc + Mt));
        } else if (wave == 1 || wave == 2) { const int d = (wave - 1) * 64 + lane; SC[320 + d] = ((const float*)(ws + WS_NST))[(size_t)(bhl * NCH + c) * 128 + d]; }
#pragma unroll
        for (int rep = 0; rep < 2; ++rep) { const int idx = tid + rep * NTHR, t = idx >> 4; float o[8];
            conv8l(Zb, bl, c * LCH + t, h * 128 + c8 * 8, CWL + c8 * 8, 256, o);
            u32x4 w; w.x = pk2(o[0], o[1]); w.y = pk2(o[2], o[3]); w.z = pk2(o[4], o[5]); w.w = pk2(o[6], o[7]);
            *(LAS u32x4*)(QS + t * 136 + c8 * 8) = w;
            *(LAS u32x4*)(KS + t * 136 + c8 * 8) = *(const u32x4*)((const bf16*)(ws + WS_KC) + (size_t)(tokl + t) * 512 + h * 128 + c8 * 8); }
        __syncthreads();
        {
            const int tb = wave >> 1, fr = lane & 15, fq = lane >> 4;
#pragma unroll
            for (int i = 0; i < 2; ++i) { const int sblk = (wave & 1) * 2 + i; f32x4 acc = (f32x4){0.f, 0.f, 0.f, 0.f};
                if (sblk <= tb) {
#pragma unroll
                    for (int ks = 0; ks < 4; ++ks) { const bf16x8 af = *(const LAS bf16x8*)(QS + (16 * tb + fr) * 136 + 32 * ks + 8 * fq), bfv = *(const LAS bf16x8*)(KS + (16 * sblk + fr) * 136 + 32 * ks + 8 * fq);
                        acc = __builtin_amdgcn_mfma_f32_16x16x32_bf16(af, bfv, acc, 0, 0, 0); } }
                const int s = 16 * sblk + fr; const float rs_ = SC[s];
#pragma unroll
                for (int e = 0; e < 4; ++e) { const int t = 16 * tb + 4 * fq + e; const float val = (s <= t) ? acc[e] * __expf(rs_ - SC[64 + t]) : 0.f; SD[t * 72 + s] = (bf16)f2bf(val); } }
        }
        f32x16 aQ0, aQ1, aS0, aS1;
#pragma unroll
        for (int e = 0; e < 16; ++e) { aQ0[e] = 0.f; aQ1[e] = 0.f; aS0[e] = 0.f; aS1[e] = 0.f; }
#pragma unroll
        for (int ks = 0; ks < 8; ++ks) {
            const bf16x8 a0 = *(const LAS bf16x8*)(QS + r * 136 + 16 * ks + 8 * hh), a1 = *(const LAS bf16x8*)(QS + (32 + r) * 136 + 16 * ks + 8 * hh);
            aQ0 = __builtin_amdgcn_mfma_f32_32x32x16_bf16(a0, bC[ks], aQ0, 0, 0, 0); aQ1 = __builtin_amdgcn_mfma_f32_32x32x16_bf16(a1, bC[ks], aQ1, 0, 0, 0); }
        __syncthreads();
        {
            const int t = tid >> 3, p = tid & 7; float ds = 0.f, qn = 0.f;
#pragma unroll
            for (int k = 0; k < 8; ++k) ds += bf1(SD[t * 72 + 8 * p + k]);
#pragma unroll
            for (int k = 0; k < 16; ++k) qn += bf1(QS[t * 136 + 16 * p + k]) * SC[320 + 16 * p + k];
            float den = ds + SC[128 + t] * qn;
            den += __shfl_xor(den, 1); den += __shfl_xor(den, 2); den += __shfl_xor(den, 4);
            if (p == 0) SC[256 + t] = 1.f / fmaxf(fabsf(den), SC[192 + t]);
        }
#pragma unroll
        for (int ks = 0; ks < 4; ++ks) {
            const bf16x8 a0 = *(const LAS bf16x8*)(SD + r * 72 + 16 * ks + 8 * hh), a1 = *(const LAS bf16x8*)(SD + (32 + r) * 72 + 16 * ks + 8 * hh);
            aS0 = __builtin_amdgcn_mfma_f32_32x32x16_bf16(a0, bV[ks], aS0, 0, 0, 0); aS1 = __builtin_amdgcn_mfma_f32_32x32x16_bf16(a1, bV[ks], aS1, 0, 0, 0); }
        __syncthreads();
#pragma unroll
        for (int e = 0; e < 16; ++e) { const int t0 = (e & 3) + 8 * (e >> 2) + 4 * hh;
            HB[t0 * 260 + v0 + r] = (aS0[e] + SC[128 + t0] * aQ0[e]) * SC[256 + t0]; HB[(32 + t0) * 260 + v0 + r] = (aS1[e] + SC[128 + 32 + t0] * aQ1[e]) * SC[256 + 32 + t0]; }
        __syncthreads();
        {
            const int t = tid >> 3, p = tid & 7; f32x4 x[8]; float sm = 0.f;
#pragma unroll
            for (int k = 0; k < 8; ++k) { x[k] = *(const LAS f32x4*)(HB + t * 260 + 32 * p + 4 * k); sm += (x[k].x + x[k].y) + (x[k].z + x[k].w); }
            sm += __shfl_xor(sm, 1); sm += __shfl_xor(sm, 2); sm += __shfl_xor(sm, 4);
            const float mean = sm * (1.f / 256.f); float sq = 0.f;
#pragma unroll
            for (int k = 0; k < 8; ++k) { x[k] = x[k] - mean; sq += (x[k].x * x[k].x + x[k].y * x[k].y) + (x[k].z * x[k].z + x[k].w * x[k].w); }
            sq += __shfl_xor(sq, 1); sq += __shfl_xor(sq, 2); sq += __shfl_xor(sq, 4);
            const float rstd = rsqrtf(sq * (1.f / 256.f) + EPS);
            const float* gp = gain + h * 256 + 32 * p; bf16* op = Zb + (size_t)(tokl + t) * ZLD + out_col + h * 256 + 32 * p;
#pragma unroll
            for (int i = 0; i < 4; ++i) { const f32x4 g0 = *(const f32x4*)(gp + 8 * i), g1 = *(const f32x4*)(gp + 8 * i + 4); const f32x4 a = x[2 * i] * rstd * g0, b = x[2 * i + 1] * rstd * g1; const u32x4 og = ogr[i]; u32x4 w;
                w.x = pk2(a.x * bflo(og.x), a.y * bfhi(og.x)); w.y = pk2(a.z * bflo(og.y), a.w * bfhi(og.y)); w.z = pk2(b.x * bflo(og.z), b.y * bfhi(og.z)); w.w = pk2(b.z * bflo(og.w), b.w * bfhi(og.w));
                *(u32x4*)(op + 8 * i) = w; }
        }
        __syncthreads();
    }
}

__device__ __forceinline__ void sgu_phase(const Args& a, int l, unsigned char* ws, LAS unsigned char* lds, int G, int cu, int tid, int wave, int lane, const int out_col) {
    bf16* Zb = (bf16*)(ws + WS_Z); const bf16* ZT = (const bf16*)(ws + WS_ZT); const bf16* Wc = (const bf16*)(ws + WS_WSGU);
    const float* lng = a.in[I_SLNG] + (size_t)l * 1024; const float* lnb = a.in[I_SLNB] + (size_t)l * 1024; const float* bs = a.in[I_SBS] + (size_t)l * 4 * 128;
    LAS bf16* VT = (LAS bf16*)lds;
    LAS float* PS = (LAS float*)(lds + 69632);
    LAS float* ST = (LAS float*)(lds + 69632 + 4096);
    LAS bf16* WS_ = (LAS bf16*)(lds + 74752);
    int gcur = -1;
    for (int u = cu; u < 4 * 32 * 4; u += G) {
        const int g = u & 3, cc = (u >> 2) & 31, bl = u >> 7; const int tokl = bl * SEQ + cc * 128;
        if (g != gcur) { __syncthreads();
#pragma unroll
            for (int rep = 0; rep < 4; ++rep) { const int idx = tid + rep * NTHR, t = idx >> 4, c8 = idx & 15; *(LAS u32x4*)(WS_ + t * 136 + c8 * 8) = *(const u32x4*)(Wc + (size_t)(g * 128 + t) * 128 + c8 * 8); }
            gcur = g; }
#pragma unroll
        for (int rep = 0; rep < 8; ++rep) { const int idx = tid + rep * NTHR, d = idx >> 4, c8 = idx & 15;
            *(LAS u32x4*)(VT + d * 136 + c8 * 8) = *(const u32x4*)(ZT + (size_t)(1024 + g * 256 + d) * ZTLD + tokl + c8 * 8); }
        __syncthreads();
        { const int s = tid & 127, part = tid >> 7; float sm = 0.f, sq = 0.f;
#pragma unroll 8
            for (int d = part * 64; d < part * 64 + 64; ++d) { const float x = bf1(VT[d * 136 + s]); sm += x; sq += x * x; }
            PS[(part * 128 + s) * 2] = sm; PS[(part * 128 + s) * 2 + 1] = sq; }
        __syncthreads();
        if (tid < 128) { float sm = 0.f, sq = 0.f;
#pragma unroll
            for (int p = 0; p < 4; ++p) { sm += PS[(p * 128 + tid) * 2]; sq += PS[(p * 128 + tid) * 2 + 1]; }
            const float mean = sm * (1.f / 256.f); const float var = fmaxf(sq * (1.f / 256.f) - mean * mean, 0.f); ST[tid] = mean; ST[128 + tid] = rsqrtf(var + EPS); }
        __syncthreads();
#pragma unroll
        for (int rep = 0; rep < 8; ++rep) { const int idx = tid + rep * NTHR, d = idx >> 4, c8 = idx & 15; const float gg = lng[g * 256 + d], bb = lnb[g * 256 + d];
            u32x4 x = *(const LAS u32x4*)(VT + d * 136 + c8 * 8); const LAS float* mp = ST + c8 * 8; const LAS float* rp = ST + 128 + c8 * 8;
            x.x = pk2((bflo(x.x) - mp[0]) * rp[0] * gg + bb, (bfhi(x.x) - mp[1]) * rp[1] * gg + bb); x.y = pk2((bflo(x.y) - mp[2]) * rp[2] * gg + bb, (bfhi(x.y) - mp[3]) * rp[3] * gg + bb);
            x.z = pk2((bflo(x.z) - mp[4]) * rp[4] * gg + bb, (bfhi(x.z) - mp[5]) * rp[5] * gg + bb); x.w = pk2((bflo(x.w) - mp[6]) * rp[6] * gg + bb, (bfhi(x.w) - mp[7]) * rp[7] * gg + bb);
            *(LAS u32x4*)(VT + d * 136 + c8 * 8) = x; }
        __syncthreads();
        {
            const int r = lane & 31, hh = lane >> 5, d0 = 32 * wave;
            f32x16 acc[4];
#pragma unroll
            for (int tb = 0; tb < 4; ++tb)
#pragma unroll
                for (int e = 0; e < 16; ++e) acc[tb][e] = 0.f;
#pragma unroll
            for (int ks = 0; ks < 8; ++ks) { const bf16x8 af = *(const LAS bf16x8*)(VT + (d0 + r) * 136 + 16 * ks + 8 * hh);
#pragma unroll
                for (int tb = 0; tb < 4; ++tb) if (16 * ks <= 32 * tb + 31) { const bf16x8 bfv = *(const LAS bf16x8*)(WS_ + (32 * tb + r) * 136 + 16 * ks + 8 * hh);
                    acc[tb] = __builtin_amdgcn_mfma_f32_32x32x16_bf16(af, bfv, acc[tb], 0, 0, 0); } }
#pragma unroll
            for (int tb = 0; tb < 4; ++tb) { const int t = 32 * tb + r; const float bias = bs[g * 128 + t]; bf16* rowp = Zb + (size_t)(tokl + t) * ZLD + ZC_U + g * 256 + d0 + 4 * hh; const int oshift = out_col - ZC_U;
#pragma unroll
                for (int q = 0; q < 4; ++q) { const u32x2 uu = *(const u32x2*)(rowp + 8 * q); u32x2* op = (u32x2*)(rowp + oshift + 8 * q); u32x2 w;
                    w.x = pk2(bflo(uu.x) * (acc[tb][4 * q] + bias), bfhi(uu.x) * (acc[tb][4 * q + 1] + bias)); w.y = pk2(bflo(uu.y) * (acc[tb][4 * q + 2] + bias), bfhi(uu.y) * (acc[tb][4 * q + 3] + bias)); *op = w; } }
        }
        __syncthreads();
    }
}

__device__ __forceinline__ void softmax_rows(unsigned char* ws, int gw, int NGW, int lane) {
    bf16* Zb = (bf16*)(ws + WS_Z);
    for (int m = gw; m < MH; m += NGW) {
        u32x4* p = (u32x4*)(Zb + (size_t)m * ZLD + ZC_XQ + 16 * lane); const u32x4 x0 = p[0], x1 = p[1];
        float v[16] = { bflo(x0.x), bfhi(x0.x), bflo(x0.y), bfhi(x0.y), bflo(x0.z), bfhi(x0.z), bflo(x0.w), bfhi(x0.w), bflo(x1.x), bfhi(x1.x), bflo(x1.y), bfhi(x1.y), bflo(x1.z), bfhi(x1.z), bflo(x1.w), bfhi(x1.w) };
        float mx = v[0];
#pragma unroll
        for (int e = 1; e < 16; ++e) mx = fmaxf(mx, v[e]);
#pragma unroll
        for (int o = 1; o < 16; o <<= 1) mx = fmaxf(mx, __shfl_xor(mx, o));
        float s = 0.f;
#pragma unroll
        for (int e = 0; e < 16; ++e) { v[e] = __expf(v[e] - mx); s += v[e]; }
#pragma unroll
        for (int o = 1; o < 16; o <<= 1) s += __shfl_xor(s, o);
        const float inv = 1.f / s;
        u32x4 y0, y1; y0.x = pk2(v[0] * inv, v[1] * inv); y0.y = pk2(v[2] * inv, v[3] * inv); y0.z = pk2(v[4] * inv, v[5] * inv); y0.w = pk2(v[6] * inv, v[7] * inv);
        y1.x = pk2(v[8] * inv, v[9] * inv); y1.y = pk2(v[10] * inv, v[11] * inv); y1.z = pk2(v[12] * inv, v[13] * inv); y1.w = pk2(v[14] * inv, v[15] * inv);
        p[0] = y0; p[1] = y1;
    }
}

__global__ void __launch_bounds__(NTHR, 2) trunk_fwd(Args args) {
    extern __shared__ __attribute__((aligned(16))) unsigned char lds_raw[];
    LAS unsigned char* lds = (LAS unsigned char*)lds_raw;
    volatile LAS unsigned* MISC = (volatile LAS unsigned*)(lds + MISC_OFF);
    const int G = gridDim.x, cu = blockIdx.x;
    unsigned char* ws = args.ws;
#define PHASE_IDS() int tid = threadIdx.x; asm volatile("" : "+v"(tid)); const int lane = tid & 63, wave = __builtin_amdgcn_readfirstlane(tid >> 6); \
    const int vcu = (G % 8 == 0) ? (cu % 8) * (G / 8) + cu / 8 : cu; const int gw = vcu * NWAVES + wave, NGW = G * NWAVES, gtid = cu * NTHR + tid, GT = G * NTHR; (void)gw; (void)NGW; (void)gtid; (void)GT; (void)lane
    for (int u = threadIdx.x; u < (LDS_BYTES - RING_BYTES) / 4; u += NTHR) ((LAS unsigned*)(lds + RING_BYTES))[u] = 0u;
    __syncthreads();
    XcdBarrier bar = xcd_barrier_post((unsigned*)(ws + WS_CTL) + 4096, MISC + 8);
    const int lo = args.ph_lo, hi = args.ph_hi;
    int ph = 0;
#define IN() (lo <= ph && ph < hi)
#define SEAM() do { if (lo <= ph && ph + 1 < hi) xcd_barrier(bar); ++ph; } while (0)
    bf16* XN = (bf16*)(ws + WS_XN); bf16* Wb = (bf16*)(ws + WS_W); float* RSTD = (float*)(ws + WS_RSTD);
    float* hbuf = args.out;

    if (IN()) { PHASE_IDS();
        convert_layer(args, 0, ws, lds, gw, NGW, wave, lane, gtid, GT);
        thin_rows(nullptr, 0, nullptr, 0.f, args.in[I_X], nullptr, XN, RSTD, nullptr, 0, M, gw, NGW, lane, false, nullptr, nullptr, nullptr, nullptr, nullptr);
        __syncthreads();
    }
    SEAM();

    for (int sb = 0; sb < 2 * DEPTH; ++sb) {
        const int l = sb >> 1, j = sb & 1;
        const float* ng = args.in[I_NORMG] + (size_t)l * NNORM * D;
        if (IN()) { PHASE_IDS();
            pg8::Gemm g{D, D, D}; pg8::TileSched S; S.init(M / 256, 2 * DFF / 256, G, cu, XN, D * 2, (char*)Wb + (j ? WO_GU1 : WO_GU0), D * 2);
            pg8::EpiGU E{(bf16*)(ws + WS_HID), RSTD};
            pg8::gemm_phase(lds, g, S, E, tid);
        }
        SEAM();
        if (IN()) { PHASE_IDS();
            pg8::Gemm g{DFF, DFF, DFF}; pg8::TileSched S; S.init(M / 256, D / 256, G, cu, ws + WS_HID, DFF * 2, (char*)Wb + (j ? WO_D1 : WO_D0), DFF * 2);
            pg8::EpiAct E{(bf16*)(ws + WS_F), (size_t)D, 0, nullptr, nullptr};
            pg8::gemm_phase(lds, g, S, E, tid);
        }
        SEAM();
        if (IN()) { PHASE_IDS();
            const float* hin = (sb == 0) ? args.in[I_X] : hbuf;
            if (j == 0) {
                LAS float* wif = (LAS float*)lds;
                const float* win = args.in[I_WIN] + (size_t)l * D * WIN_COLS;
                for (int e = tid; e < D * 8; e += NTHR) wif[e] = win[(size_t)(e >> 3) * WIN_COLS + 3072 + (e & 7)] * ng[2 * D + (e >> 3)];
                __syncthreads();
                float* gi = (float*)(ws + WS_GATE);
                const float* hx = (sb == 0) ? args.in[I_X] : nullptr;
                if (G == 256) {
                    const bool kvcu = (cu < 32) || (cu >= 128 && cu < 160);
                    if (kvcu) { const int gwk = ((cu < 32) ? cu : cu - 96) * NWAVES + wave;
                        thin_rows((const bf16*)(ws + WS_F), D, ng + 1 * D, 0.5f, hx, XN, XN, RSTD, nullptr, 0, 1024, gwk, 512, lane, true, wif, args.in[I_BI] + l * 4, args.in[I_BF] + l * 4, gi, gi + (size_t)M * 4); }
                    else { const int cun = (cu < 128) ? cu - 32 : cu - 64; const int gwn = cun * NWAVES + wave;
                        thin_rows((const bf16*)(ws + WS_F) + (size_t)1024 * D, D, ng + 1 * D, 0.5f, hx, XN, XN, RSTD, nullptr, 1024, M, gwn, 1536, lane, true, wif, args.in[I_BI] + l * 4, args.in[I_BF] + l * 4, gi, gi + (size_t)M * 4); }
                } else
                thin_rows((const bf16*)(ws + WS_F), D, ng + 1 * D, 0.5f, hx, XN, XN, RSTD, nullptr, 0, M, gw, NGW, lane, true, wif, args.in[I_BI] + l * 4, args.in[I_BF] + l * 4, gi, gi + (size_t)M * 4);
                __syncthreads();
                {
                    pg8::Gemm g{D, D, D};
                    pg8::TileSched S; S.init(MMEM / 256, D / 256, G, cu, ws + WS_MEMN, D * 2, (char*)Wb + WO_MKV, D * 2);
                    pg8::EpiAct E{(bf16*)(ws + WS_KMEM), (size_t)D, 0, nullptr, nullptr};
                    pg8::gemm_phase(lds, g, S, E, tid);
                    pg8::TileSched S2; S2.init(D / 256, MMEM / 256, G, (cu + G / 2) % G, (char*)Wb + WO_MKV + (size_t)D * D * 2, D * 2, ws + WS_MEMN, D * 2);
                    pg8::EpiAct E2{(bf16*)(ws + WS_VTMEM), (size_t)MMEM, 0, nullptr, nullptr};
                    pg8::gemm_phase(lds, g, S2, E2, tid);
                }
            } else {
                const bool lastl = (l + 1 == DEPTH);
                thin_rows((const bf16*)(ws + WS_F), D, ng + 5 * D, 0.5f, nullptr, XN, lastl ? nullptr : XN, RSTD, lastl ? hbuf : nullptr, 0, M, gw, NGW, lane, false, nullptr, nullptr, nullptr, nullptr, nullptr);
                if (l + 1 < DEPTH) { __syncthreads(); convert_layer(args, l + 1, ws, lds, gw, NGW, wave, lane, gtid, GT); __syncthreads(); }
            }
        }
        SEAM();
        if (j == 0) {
            for (int hf = 0; hf < 2; ++hf) {
                bf16* Zb = (bf16*)(ws + WS_Z);
                if (IN()) { PHASE_IDS();
                    pg8::Gemm g{D, D, D};
                    pg8::TileSched S; S.init(MH / 256, ZLD / 256, G, cu, XN + (size_t)hf * MH * D, D * 2, (char*)Wb + WO_IN, D * 2);
                    pg8::EpiAct E{Zb, (size_t)ZLD, 1, RSTD + (size_t)hf * MH, nullptr};
                    pg8::gemm_phase(lds, g, S, E, tid);
                    pg8::TileSched S2; S2.init(2048 / 256, MH / 256, G, cu, (char*)Wb + WO_IN + (size_t)ZLD * D * 2, D * 2, XN + (size_t)hf * MH * D, D * 2);
                    pg8::EpiAct E2{(bf16*)(ws + WS_ZT), (size_t)ZTLD, 2, nullptr, RSTD + (size_t)hf * MH};
                    pg8::gemm_phase(lds, g, S2, E2, tid);
                }
                SEAM();
                if (IN()) { PHASE_IDS();
                    mlstm_s1(args, l, hf, ws, lds, G, cu, tid, wave, lane);
                    sgu_phase(args, l, ws, lds, G, cu, tid, wave, lane, ZC_U);
                    pg8::Gemm g{256, ZLD, D};
                    pg8::TileSched S; S.init(MH / 256, 4, G, cu, Zb + ZC_XQ, ZLD * 2, (bf16*)(ws + WS_KMEM) + (size_t)hf * 4 * MEMLEN * D, 0);
                    S.a_pn = 512; S.b_tile = 512; S.pm_per_b = 16; S.b_batch = (size_t)MEMLEN * D * 2;
                    pg8::EpiAct E{Zb + ZC_XQ, (size_t)ZLD, 0, nullptr, nullptr};
                    pg8::gemm_phase(lds, g, S, E, tid);
                }
                SEAM();
                if (IN()) { PHASE_IDS();
                    mlstm_s2(ws, G, cu, tid);
                    softmax_rows(ws, gw, NGW, lane);
                }
                SEAM();
                if (IN()) { PHASE_IDS();
                    mlstm_s3(args, l, hf, ws, lds, G, cu, tid, wave, lane, ZC_O);
#ifdef PROBE_S3
                    for (int rep_ = 0; rep_ < 2; ++rep_) mlstm_s3(args, l, hf, ws, lds, G, cu, tid, wave, lane, ZC_QK);
#endif
#ifdef PROBE_SGU
                    for (int rep_ = 0; rep_ < 2; ++rep_) sgu_phase(args, l, ws, lds, G, cu, tid, wave, lane, ZC_QK);
#endif
                    pg8::Gemm g{256, ZLD, MMEM};
                    pg8::TileSched S; S.init(MH / 256, 4, G, cu, Zb + ZC_XQ, ZLD * 2, (bf16*)(ws + WS_VTMEM) + (size_t)hf * 4 * MEMLEN, 0);
                    S.a_pn = 512; S.b_tile = (size_t)256 * MMEM * 2; S.pm_per_b = 16; S.b_batch = (size_t)MEMLEN * 2;
                    pg8::EpiAct E{Zb + ZC_XQ, (size_t)ZLD, 0, nullptr, nullptr};
                    pg8::gemm_phase(lds, g, S, E, tid);
                }
                SEAM();
                if (IN()) { PHASE_IDS();
                    pg8::Gemm g{D, ZLD, D};
                    pg8::TileSched S; S.init(MH / 256, D / 256, G, cu, Zb + ZC_O, ZLD * 2, (char*)Wb + WO_BR, D * 2);
                    S.reps = 3; S.a_rep = 1024 * 2; S.b_rep = (size_t)D * D * 2;
                    pg8::EpiBranch E{Zb};
                    pg8::gemm_phase(lds, g, S, E, tid);
                }
                SEAM();
                if (IN()) { PHASE_IDS();
                    pg8::Gemm g{D, ZLD, D};
                    pg8::TileSched S; S.init(MH / 256, D / 256, G, cu, Zb + ZC_QK, ZLD * 2, (char*)Wb + WO_OUT, D * 2);
                    pg8::EpiAct E{Zb + ZC_O, (size_t)ZLD, 0, nullptr, nullptr};
                    pg8::gemm_phase(lds, g, S, E, tid);
                }
                SEAM();
                if (IN()) { PHASE_IDS();
                    thin_rows(Zb + ZC_O, ZLD, ng + 3 * D, 1.0f, nullptr, XN, XN, RSTD, nullptr, hf * MH, (hf + 1) * MH, gw, NGW, lane, false, nullptr, nullptr, nullptr, nullptr, nullptr);
                }
                SEAM();
            }
        }
    }
#undef IN
#undef SEAM
}
constexpr int N_PHASES = 1 + 2 * DEPTH * 3 + DEPTH * 2 * 7;

#ifndef N_LAUNCH_MODE
#define N_LAUNCH_MODE 0
#endif
extern "C" void kernel_launch(void* const* d_in, const int* in_sizes, int n_in, void* d_out, int out_size, void* d_ws, size_t ws_size, hipStream_t stream) {
    static int grid = 0;
    if (grid == 0) {
        if (n_in != 18 || out_size != M * D || ws_size < WS_END) { fprintf(stderr, "kernel_launch: unexpected shapes (n_in %d out %d ws %zu)\n", n_in, out_size, ws_size); grid = -1; return; }
        int dev = 0, cus = 0, per_cu = 0;
        if (hipGetDevice(&dev) != hipSuccess || hipDeviceGetAttribute(&cus, hipDeviceAttributeMultiprocessorCount, dev) != hipSuccess) { grid = -1; return; }
        if (hipFuncSetAttribute((const void*)trunk_fwd, hipFuncAttributeMaxDynamicSharedMemorySize, LDS_BYTES) != hipSuccess) { grid = -1; return; }
        if (hipOccupancyMaxActiveBlocksPerMultiprocessor(&per_cu, (const void*)trunk_fwd, NTHR, LDS_BYTES) != hipSuccess || per_cu < 1) { fprintf(stderr, "kernel_launch: occupancy query says %d\n", per_cu); }
        (void)hipGetLastError();
        grid = cus;
    }
    if (grid < 0) return;
    (void)hipMemsetAsync((char*)d_ws + WS_CTL, 0, CTL_ZERO_BYTES, stream);
    Args a{};
    for (int i = 0; i < 18; ++i) a.in[i] = (const float*)d_in[i];
    a.out = (float*)d_out; a.ws = (unsigned char*)d_ws;
#if N_LAUNCH_MODE == 0
    a.ph_lo = 0; a.ph_hi = N_PHASES;
    hipLaunchKernelGGL(trunk_fwd, dim3(grid), dim3(NTHR), LDS_BYTES, stream, a);
#else
    for (int p = 0; p < N_PHASES; ++p) { a.ph_lo = p; a.ph_hi = p + 1; hipLaunchKernelGGL(trunk_fwd, dim3(grid), dim3(NTHR), LDS_BYTES, stream, a); }
#endif
}
```

```cpp
#include <hip/hip_runtime.h>
#include <cstdio>
#include <cstdint>

#define LAS __attribute__((address_space(3)))
#define GAS __attribute__((address_space(1)))
typedef unsigned short bf16;
typedef short bf16x8 __attribute__((ext_vector_type(8)));
typedef float f32x4 __attribute__((ext_vector_type(4)));
typedef float f32x16 __attribute__((ext_vector_type(16)));
typedef unsigned u32x4 __attribute__((ext_vector_type(4)));
typedef unsigned u32x2 __attribute__((ext_vector_type(2)));

constexpr int D = 1024, BATCH = 8, SEQ = 4096, DEPTH = 2, MEMLEN = 256, DFF = 2816, NNORM = 7;
constexpr int M = BATCH * SEQ, MH = M / 2, MMEM = BATCH * MEMLEN;
constexpr int WIN_COLS = 9224;
constexpr int LCH = 64, NCH = SEQ / LCH;
constexpr int ZLD = 7168;
constexpr int ZC_QK = 0, ZC_O = 1024, ZC_U = 2048, ZC_XQ = 3072, ZC_G = 4096;
constexpr int ZTLD = MH;
constexpr float EPS = 1e-6f;
constexpr int NWAVES = 8, NTHR = 512;

constexpr size_t MiB = 1u << 20;
constexpr size_t WS_CTL = 0, CTL_ZERO_BYTES = 1 * MiB;
constexpr size_t WS_WSGU = 1 * MiB;
constexpr size_t WS_GATE = 2 * MiB;
constexpr size_t WS_NST = 3 * MiB;
constexpr size_t WS_CSC = 4 * MiB;
constexpr size_t WS_MEMN = 5 * MiB;
constexpr size_t WS_KMEM = 9 * MiB;
constexpr size_t WS_VTMEM = 13 * MiB;
constexpr size_t WS_W = 17 * MiB;
constexpr size_t WO_GU0 = 0, WO_GU1 = 11 * MiB, WO_D0 = 22 * MiB, WO_D1 = WO_D0 + 5632 * 1024, WO_IN = 33 * MiB, WO_MKV = 51 * MiB, WO_BR = 55 * MiB, WO_OUT = 61 * MiB;
constexpr size_t WS_XN = 80 * MiB;
constexpr size_t WS_RSTD = 4 * MiB + 512 * 1024;
constexpr size_t WS_BIG = 144 * MiB;
constexpr size_t WS_HID = WS_BIG, WS_F = WS_BIG + 176 * MiB, WS_Z = WS_BIG, WS_ZT = WS_BIG + 224 * MiB;
constexpr size_t WS_ST = 432 * MiB;
constexpr size_t WS_KC = 496 * MiB;
constexpr size_t WS_END = 512 * MiB;

constexpr int LDS_BYTES = 147456;
constexpr int RING_BYTES = 131072;
constexpr int MISC_OFF = RING_BYTES + 320;

typedef float f32x2_t __attribute__((ext_vector_type(2))); typedef __bf16 bf16x2_t __attribute__((ext_vector_type(2)));
__device__ __forceinline__ unsigned pk2(float lo, float hi) { f32x2_t v = {lo, hi}; bf16x2_t b = __builtin_convertvector(v, bf16x2_t); return __builtin_bit_cast(unsigned, b); }
__device__ __forceinline__ unsigned f2bf(float f) { return pk2(f, 0.f) & 0xffffu; }
__device__ __forceinline__ float bflo(unsigned w) { return __uint_as_float(w << 16); }
__device__ __forceinline__ float bfhi(unsigned w) { return __uint_as_float(w & 0xffff0000u); }
__device__ __forceinline__ float bf1(bf16 b) { return __uint_as_float((unsigned)b << 16); }
__device__ __forceinline__ float wave_sum(float v) {
#pragma unroll
    for (int o = 1; o < 64; o <<= 1) v += __shfl_xor(v, o);
    return v;
}
__device__ __forceinline__ float sigmoidf_(float x) { return __builtin_amdgcn_rcpf(1.f + __expf(-x)); }
__device__ __forceinline__ float siluf_(float x) { return x * __builtin_amdgcn_rcpf(1.f + __expf(-x)); }
__device__ __forceinline__ float gelu_tanh(float x) { const float u = 1.5957691216f * (x + 0.044715f * x * x * x); return x * __builtin_amdgcn_rcpf(1.f + __expf(-u)); }
__device__ __forceinline__ float logsigmoidf_(float x) { return fminf(x, 0.f) - log1pf(__expf(-fabsf(x))); }
#define LDS_WAIT() asm volatile("s_waitcnt lgkmcnt(0)" ::: "memory")
#define VM_WAIT() asm volatile("s_waitcnt vmcnt(0)" ::: "memory")

namespace pg8 {
constexpr int BM = 256, BK = 64, HALF = 128, HTB = HALF * BK * 2, STAGE_BYTES = 8 * HTB, NXCD = 8, WGM = 8;
__host__ __device__ __forceinline__ int lds_byte(int r, int c) { const int st = (r >> 4) * 2 + (c >> 5), rr = r & 15, cc = c & 31, ob = rr * 64 + cc * 2; return st * 1024 + (ob ^ (((ob >> 9) & 1) << 5)); }
__host__ __device__ __forceinline__ void stage_rc(int b, int& R, int& C) { const int st = b / 1024, sb = b % 1024, swz = sb ^ (((sb >> 9) & 1) << 5); R = (st >> 1) * 16 + swz / 64; C = (st & 1) * 32 + (swz % 64) / 2; }
__host__ __device__ __forceinline__ int perm32(int rho) { const int n = rho >> 4, i = rho & 15; return 8 * (i >> 2) + 4 * n + (i & 3); }

struct Unit { int pm, pn, aux; const char* a; const char* b; };
struct Gemm { int K, lda, ldb; };

struct TileSched {
    int nM, nN, nwg, G, c, reps, pm_per_b;
    const char* A; const char* B;
    size_t a_tile, a_pn, a_rep, b_tile, b_batch, b_rep;
    __device__ __forceinline__ void init(int nM_, int nN_, int G_, int c_, const void* A_, size_t lda_bytes, const void* B_, size_t ldb_bytes) {
        nM = nM_; nN = nN_; nwg = nM * nN; G = G_; c = c_; reps = 1; pm_per_b = 1 << 30; A = (const char*)A_; B = (const char*)B_;
        a_tile = 256 * lda_bytes; a_pn = 0; a_rep = 0; b_tile = 256 * ldb_bytes; b_batch = 0; b_rep = 0;
    }
    __device__ __forceinline__ bool next(int i, Unit& u) const {
        const int ti = i / reps, aux = i - ti * reps;
        const long L = (long)ti * G + c; if (L >= nwg) return false;
        int wgid = (int)L; { const int q = nwg / NXCD, r = nwg % NXCD, xcd = wgid % NXCD, off = wgid / NXCD; wgid = (xcd < r ? xcd * (q + 1) : r * (q + 1) + (xcd - r) * q) + off; }
        const int nig = WGM * nN, gid = wgid / nig, fm = gid * WGM, gsz = (nM - fm) < WGM ? (nM - fm) : WGM;
        u.pm = fm + ((wgid % nig) % gsz); u.pn = (wgid % nig) / gsz; u.aux = aux;
        u.a = A + (size_t)u.pm * a_tile + (size_t)u.pn * a_pn + (size_t)aux * a_rep;
        u.b = B + (size_t)u.pn * b_tile + (size_t)(u.pm / pm_per_b) * b_batch + (size_t)aux * b_rep;
        return true;
    }
};

__device__ __forceinline__ unsigned cvt_pk_bf16(float lo, float hi) { return pk2(lo, hi); }

template <int ACT> __device__ __forceinline__ float actf(float x) {
    if (ACT == 1) return sigmoidf_(x);
    if (ACT == 2) return gelu_tanh(x);
    if (ACT == 3) return x * 0.0625f;
    return x;
}
template <int ACT> __device__ __forceinline__ void store_tile_bf16(const f32x4 (&acc)[2][2][4][2], bf16* O, size_t ldc, int row0, int col0, const float* rsrow, const float* rscol) {
    f32x4 cs[2][2];
#pragma unroll
    for (int bj = 0; bj < 2; ++bj)
#pragma unroll
        for (int n = 0; n < 2; ++n) cs[bj][n] = rscol ? *(const f32x4*)(rscol + col0 + bj * HALF + 4 * n) : (f32x4){1.f, 1.f, 1.f, 1.f};
#pragma unroll
    for (int ai = 0; ai < 2; ++ai)
#pragma unroll
        for (int m = 0; m < 4; ++m) { const int row = row0 + ai * HALF + m * 16; bf16* rowp = O + (size_t)row * ldc + col0; const float rr = rsrow ? rsrow[row] : 1.f;
#pragma unroll
            for (int bj = 0; bj < 2; ++bj) { const f32x4 v0 = acc[ai][bj][m][0] * cs[bj][0] * rr, v1 = acc[ai][bj][m][1] * cs[bj][1] * rr; u32x4 w;
                w.x = cvt_pk_bf16(actf<ACT>(v0[0]), actf<ACT>(v0[1])); w.y = cvt_pk_bf16(actf<ACT>(v0[2]), actf<ACT>(v0[3]));
                w.z = cvt_pk_bf16(actf<ACT>(v1[0]), actf<ACT>(v1[1])); w.w = cvt_pk_bf16(actf<ACT>(v1[2]), actf<ACT>(v1[3]));
                *(u32x4*)(rowp + bj * HALF) = w; } }
}
struct EpiAct {
    static constexpr bool PERM = true;
    bf16* O; size_t ldc; int mode; const float* rsrow; const float* rscol;
    __device__ __forceinline__ void operator()(const f32x4 (&acc)[2][2][4][2], const Unit& u, int wr, int wc, int fr, int fq) const {
        const int row0 = u.pm * BM + wr * 64 + fr, col0 = u.pn * BM + wc * 32 + 8 * fq;
        int act = 0;
        if (mode == 1) { const int g = u.pn >> 2; act = (g == 0) ? 0 : (g == 1) ? 1 : (g == 2) ? 2 : (g == 3) ? 3 : 1; }
        else if (mode == 2) act = (u.pm >= 4) ? 2 : 0;
        if (act == 0) store_tile_bf16<0>(acc, O, ldc, row0, col0, rsrow, rscol);
        else if (act == 1) store_tile_bf16<1>(acc, O, ldc, row0, col0, rsrow, rscol);
        else if (act == 2) store_tile_bf16<2>(acc, O, ldc, row0, col0, rsrow, rscol);
        else store_tile_bf16<3>(acc, O, ldc, row0, col0, rsrow, rscol);
    }
};
struct EpiGU {
    static constexpr bool PERM = true;
    bf16* O; const float* rsrow;
    __device__ __forceinline__ void operator()(const f32x4 (&acc)[2][2][4][2], const Unit& u, int wr, int wc, int fr, int fq) const {
        const int row0 = u.pm * BM + wr * 64 + fr, col0 = u.pn * HALF + wc * 32 + 8 * fq;
#pragma unroll
        for (int ai = 0; ai < 2; ++ai)
#pragma unroll
            for (int m = 0; m < 4; ++m) { const int row = row0 + ai * HALF + m * 16; bf16* rowp = O + (size_t)row * DFF + col0; const float rr = rsrow[row];
                const f32x4 g0 = acc[ai][0][m][0] * rr, g1 = acc[ai][0][m][1] * rr, u0 = acc[ai][1][m][0] * rr, u1 = acc[ai][1][m][1] * rr; u32x4 w;
                w.x = cvt_pk_bf16(siluf_(g0[0]) * u0[0], siluf_(g0[1]) * u0[1]); w.y = cvt_pk_bf16(siluf_(g0[2]) * u0[2], siluf_(g0[3]) * u0[3]);
                w.z = cvt_pk_bf16(siluf_(g1[0]) * u1[0], siluf_(g1[1]) * u1[1]); w.w = cvt_pk_bf16(siluf_(g1[2]) * u1[2], siluf_(g1[3]) * u1[3]);
                *(u32x4*)rowp = w; }
    }
};
struct EpiBranch {
    static constexpr bool PERM = true;
    bf16* Zb;
    __device__ __forceinline__ void operator()(const f32x4 (&acc)[2][2][4][2], const Unit& u, int wr, int wc, int fr, int fq) const {
        const int row0 = u.pm * BM + wr * 64 + fr, col0 = u.pn * BM + wc * 32 + 8 * fq; const int j = u.aux;
#pragma unroll
        for (int ai = 0; ai < 2; ++ai)
#pragma unroll
            for (int m = 0; m < 4; ++m) { bf16* rowp = Zb + (size_t)(row0 + ai * HALF + m * 16) * ZLD + col0;
#pragma unroll
                for (int bj = 0; bj < 2; ++bj) { const f32x4 v0 = acc[ai][bj][m][0], v1 = acc[ai][bj][m][1];
                    const u32x4 g = *(const u32x4*)(rowp + ZC_G + j * 1024 + bj * HALF);
                    float o[8] = { v0[0] * bflo(g.x), v0[1] * bfhi(g.x), v0[2] * bflo(g.y), v0[3] * bfhi(g.y), v1[0] * bflo(g.z), v1[1] * bfhi(g.z), v1[2] * bflo(g.w), v1[3] * bfhi(g.w) };
                    if (j > 0) { const u32x4 p = *(const u32x4*)(rowp + ZC_QK + bj * HALF);
                        o[0] += bflo(p.x); o[1] += bfhi(p.x); o[2] += bflo(p.y); o[3] += bfhi(p.y); o[4] += bflo(p.z); o[5] += bfhi(p.z); o[6] += bflo(p.w); o[7] += bfhi(p.w); }
                    u32x4 w; w.x = cvt_pk_bf16(o[0], o[1]); w.y = cvt_pk_bf16(o[2], o[3]); w.z = cvt_pk_bf16(o[4], o[5]); w.w = cvt_pk_bf16(o[6], o[7]);
                    *(u32x4*)(rowp + ZC_QK + bj * HALF) = w; } }
    }
};

template <class Epi, class Sched>
__device__ __forceinline__ void gemm_phase(LAS unsigned char* lds, const Gemm g, const Sched& S, const Epi& E, const int tid) {
    const int wid = __builtin_amdgcn_readfirstlane(tid >> 6), lane = tid & 63, wr = wid >> 2, wc = wid & 3, fr = lane & 15, fq = lane >> 4;
    const int nt = g.K / BK;
    unsigned voffA[2], voffB[2];
#pragma unroll
    for (int i = 0; i < 2; ++i) { int R, C; stage_rc(tid * 16 + i * 8192, R, C); const int Rb = Epi::PERM ? ((R & ~31) + perm32(R & 31)) : R;
        voffA[i] = (unsigned)(R * g.lda + C) * 2u; voffB[i] = (unsigned)(Rb * g.ldb + C) * 2u; }
    const size_t kstep = (size_t)(BK * 2);
    const size_t hstepA = (size_t)HALF * g.lda * 2, hstepB = (size_t)HALF * g.ldb * 2;
    const unsigned ldsw = (unsigned)wid * 1024u;
    const int aoff = lds_byte(wr * 64 + fr, fq * 8), boff = lds_byte(wc * 32 + fr, fq * 8);
#define PG8_SA(b, h) (((b) * 2 + (h)) * HTB)
#define PG8_SB(b, h) ((4 + (b) * 2 + (h)) * HTB)
#define PG8_STAGE(bufoff, gbase, voff) do { _Pragma("unroll") for (int _i = 0; _i < 2; ++_i) \
        __builtin_amdgcn_global_load_lds((const unsigned*)((const char*)(gbase) + (voff)[_i]), (LAS unsigned*)(lds + (bufoff) + ldsw + _i * 8192), 16, 0, 0); } while (0)
#define PG8_LDA(dst, b, h) do { _Pragma("unroll") for (int m = 0; m < 4; ++m) _Pragma("unroll") for (int k = 0; k < 2; ++k) dst[m][k] = *(const LAS bf16x8*)(lds + PG8_SA(b, h) + aoff + m * 2048 + k * 1024); } while (0)
#define PG8_LDB(dst, b, h) do { _Pragma("unroll") for (int n = 0; n < 2; ++n) _Pragma("unroll") for (int k = 0; k < 2; ++k) dst[n][k] = *(const LAS bf16x8*)(lds + PG8_SB(b, h) + boff + n * 2048 + k * 1024); } while (0)
#define PG8_MMA(ai, bj, At, Bt) do { __builtin_amdgcn_s_setprio(1); _Pragma("unroll") for (int m = 0; m < 4; ++m) _Pragma("unroll") for (int n = 0; n < 2; ++n) _Pragma("unroll") for (int k = 0; k < 2; ++k) \
        acc[ai][bj][m][n] = __builtin_amdgcn_mfma_f32_16x16x32_bf16(Bt[n][k], At[m][k], acc[ai][bj][m][n], 0, 0, 0); __builtin_amdgcn_s_setprio(0); } while (0)
#define PG8_WAIT_V(n) asm volatile("s_waitcnt vmcnt(" #n ")" ::: "memory")
#define PG8_WAIT_L(n) asm volatile("s_waitcnt lgkmcnt(" #n ")" ::: "memory")
#define PG8_BAR __builtin_amdgcn_s_barrier()
#define PG8_SCHED __builtin_amdgcn_sched_barrier(0)
    Unit cur, nxt; int ui = 0;
    if (!S.next(0, cur)) return;
    f32x4 acc[2][2][4][2];
#pragma unroll
    for (int a = 0; a < 2; ++a)
#pragma unroll
        for (int b = 0; b < 2; ++b)
#pragma unroll
            for (int m = 0; m < 4; ++m)
#pragma unroll
                for (int n = 0; n < 2; ++n) acc[a][b][m][n] = (f32x4){0.f, 0.f, 0.f, 0.f};
    bf16x8 At[4][2], B0[2][2], B1[2][2];
    const char* cA = cur.a; const char* cB = cur.b;
    PG8_STAGE(PG8_SB(0, 0), cB, voffB); PG8_STAGE(PG8_SB(0, 1), cB + hstepB, voffB); PG8_STAGE(PG8_SA(0, 0), cA, voffA); PG8_STAGE(PG8_SA(0, 1), cA + hstepA, voffA);
    if (wr == 1) PG8_BAR;
    PG8_WAIT_V(2); PG8_BAR;
    PG8_STAGE(PG8_SB(1, 0), cB + kstep, voffB); PG8_STAGE(PG8_SA(1, 0), cA + kstep, voffA); PG8_STAGE(PG8_SB(1, 1), cB + hstepB + kstep, voffB);
    PG8_WAIT_V(6); PG8_BAR;
    for (;;) {
        const bool has_next = S.next(ui + 1, nxt);
        const char* nA = has_next ? nxt.a : cA; const char* nB = has_next ? nxt.b : cB;
        for (int t = 0; t < nt; t += 2) {
            const bool last = (t == nt - 2);
            const char* a1 = cA + (size_t)(t + 1) * kstep;
            const char* a2 = last ? nA : cA + (size_t)(t + 2) * kstep; const char* b2 = last ? nB : cB + (size_t)(t + 2) * kstep;
            const char* a3 = a2 + kstep; const char* b3 = b2 + kstep;
            PG8_LDB(B0, 0, 0); PG8_LDB(B1, 0, 1); PG8_SCHED; PG8_LDA(At, 0, 0); PG8_STAGE(PG8_SA(1, 1), a1 + hstepA, voffA);
            PG8_WAIT_V(8); PG8_WAIT_L(0); PG8_BAR; PG8_MMA(0, 0, At, B0); PG8_MMA(0, 1, At, B1); PG8_BAR; PG8_SCHED;
            PG8_LDA(At, 0, 1); PG8_STAGE(PG8_SB(0, 0), b2, voffB); PG8_STAGE(PG8_SB(0, 1), b2 + hstepB, voffB); PG8_STAGE(PG8_SA(0, 0), a2, voffA);
            PG8_WAIT_V(8); PG8_WAIT_L(0); PG8_BAR; PG8_MMA(1, 0, At, B0); PG8_MMA(1, 1, At, B1); PG8_BAR; PG8_SCHED;
            PG8_LDB(B0, 1, 0); PG8_LDB(B1, 1, 1); PG8_SCHED; PG8_LDA(At, 1, 0); PG8_STAGE(PG8_SA(0, 1), a2 + hstepA, voffA);
            PG8_WAIT_V(8); PG8_WAIT_L(0); PG8_BAR; PG8_MMA(0, 0, At, B0); PG8_MMA(0, 1, At, B1); PG8_BAR; PG8_SCHED;
            PG8_LDA(At, 1, 1); PG8_STAGE(PG8_SB(1, 0), b3, voffB); PG8_STAGE(PG8_SB(1, 1), b3 + hstepB, voffB); PG8_STAGE(PG8_SA(1, 0), a3, voffA);
            PG8_WAIT_V(8); PG8_WAIT_L(0); PG8_BAR; PG8_MMA(1, 0, At, B0); PG8_MMA(1, 1, At, B1); PG8_BAR; PG8_SCHED;
        }
        if (wr == 0) PG8_BAR;
        E(acc, cur, wr, wc, fr, fq);
        if (!has_next) break;
#pragma unroll
        for (int a = 0; a < 2; ++a)
#pragma unroll
            for (int b = 0; b < 2; ++b)
#pragma unroll
                for (int m = 0; m < 4; ++m)
#pragma unroll
                    for (int n = 0; n < 2; ++n) acc[a][b][m][n] = (f32x4){0.f, 0.f, 0.f, 0.f};
        cur = nxt; cA = nA; cB = nB; ++ui;
        if (wr == 1) PG8_BAR;
    }
    PG8_WAIT_V(0);
    PG8_BAR;
#undef PG8_SA
#undef PG8_SB
#undef PG8_STAGE
#undef PG8_LDA
#undef PG8_LDB
#undef PG8_MMA
#undef PG8_WAIT_V
#undef PG8_WAIT_L
#undef PG8_BAR
#undef PG8_SCHED
}
}

#define XB_TMO      128
#define XB_XCNT(j)  (256  + 64 * (j))
#define XB_XSUB(j)  (1280 + 64 * (j))
#define XB_XGEN(j)  (2304 + 64 * (j))
#define XB_TOP      3328
#define XB_TOPGEN   3392
#define XCD_BAR_WORDS 3456
#define XB_SPIN_CAP (1u << 18)
__device__ __forceinline__ unsigned xb_ld(unsigned* p)              { return __hip_atomic_load(p, __ATOMIC_RELAXED, __HIP_MEMORY_SCOPE_AGENT); }
__device__ __forceinline__ unsigned xb_add(unsigned* p, unsigned v) { return __hip_atomic_fetch_add(p, v, __ATOMIC_RELAXED, __HIP_MEMORY_SCOPE_AGENT); }
__device__ __forceinline__ unsigned xb_xcc_id() { return (unsigned)__builtin_amdgcn_s_getreg((3 << 11) | 20) & 0xFu; }
#define XB_SPIN(cond, bar) do { unsigned _sp = 0; while (cond) { __builtin_amdgcn_s_sleep(1); \
    if ((++_sp & 255u) == 0u) { if (xb_ld(&(bar)[XB_TMO])) break; if (_sp > XB_SPIN_CAP) { atomicAdd(&(bar)[XB_TMO], 1u); break; } } } } while (0)
struct XcdBarrier { unsigned* bar; unsigned x; volatile LAS unsigned* st; };
__device__ __forceinline__ XcdBarrier xcd_barrier_post(unsigned* bar, volatile LAS unsigned* st) {
    XcdBarrier b; b.bar = bar; b.x = xb_xcc_id(); b.st = st;
    if (threadIdx.x == 0) (void)xb_add(&bar[XB_XCNT(b.x)], 1u);
    return b;
}
__device__ __forceinline__ void xcd_barrier_complete(unsigned* bar, unsigned x, unsigned& nloc, unsigned& nx) {
    const unsigned G = gridDim.x * gridDim.y * gridDim.z;
    unsigned sum, cnt, mine, sp = 0u;
    for (;;) {
        sum = 0u; cnt = 0u; mine = 0u;
#pragma unroll
        for (unsigned j = 0; j < 16; ++j) { const unsigned c = xb_ld(&bar[XB_XCNT(j)]); sum += c; cnt += (c > 0u) ? 1u : 0u; mine = (j == x) ? c : mine; }
        if (sum == G) break;
        __builtin_amdgcn_s_sleep(1);
        if ((++sp & 255u) == 0u) { if (xb_ld(&bar[XB_TMO])) break; if (sp > XB_SPIN_CAP) { atomicAdd(&bar[XB_TMO], 1u); break; } }
    }
    nloc = mine > 0u ? mine : 1u; nx = cnt > 0u ? cnt : 1u;
}
__device__ __forceinline__ void xcd_barrier(const XcdBarrier& b) {
    asm volatile("s_waitcnt vmcnt(0)" ::: "memory");
    __syncthreads();
    if (threadIdx.x == 0) {
        unsigned* bar = b.bar;
        __builtin_amdgcn_s_waitcnt(0);
        unsigned nloc = b.st[0], nx = b.st[1];
        if (nloc == 0u) { xcd_barrier_complete(bar, b.x, nloc, nx); b.st[0] = nloc; b.st[1] = nx; }
        const unsigned old = xb_add(&bar[XB_XSUB(b.x)], 1u);
        const unsigned gen = old / nloc;
        if (old + 1u == (gen + 1u) * nloc) {
            __builtin_amdgcn_fence(__ATOMIC_RELEASE, "agent");
            asm volatile("s_waitcnt vmcnt(0)" ::: "memory");
            const unsigned og = xb_add(&bar[XB_TOP], 1u);
            const unsigned tg = og / nx;
            if (og + 1u == (tg + 1u) * nx) xb_add(&bar[XB_TOPGEN], 1u);
            else XB_SPIN(xb_ld(&bar[XB_TOPGEN]) == tg, bar);
            __builtin_amdgcn_fence(__ATOMIC_ACQUIRE, "agent");
            xb_add(&bar[XB_XGEN(b.x)], 1u);
            asm volatile("s_waitcnt vmcnt(0)" ::: "memory");
        } else {
            XB_SPIN(xb_ld(&bar[XB_XGEN(b.x)]) == gen, bar);
            __builtin_amdgcn_fence(__ATOMIC_ACQUIRE, "agent");
            asm volatile("s_waitcnt vmcnt(0)" ::: "memory");
        }
    }
    __syncthreads();
}

struct Args { const float* in[18]; float* out; unsigned char* ws; int ph_lo, ph_hi; };
enum { I_X = 0, I_MEM, I_NORMG, I_WGU, I_WDOWN, I_WIN, I_CONVW, I_CONVB, I_BI, I_BF, I_MNORM, I_SLNG, I_SLNB, I_SWS, I_SBS, I_WMKV, I_WBR, I_WOUT };

__device__ __forceinline__ void cvt_item(const float* W, int Nsrc, int K, int srccol, bf16* WT, int dstrow, int kb, LAS float* scr, int lane, const float* gk = nullptr) {
    const int k0 = 64 * kb;
    if ((srccol & 3) == 0) {
        const int c4 = (lane & 7) * 4, rr = lane >> 3;
#pragma unroll
        for (int i = 0; i < 8; ++i) { const int kk = 8 * i + rr; f32x4 x = *(const f32x4*)(W + (size_t)(k0 + kk) * Nsrc + srccol + c4); if (gk) x = x * gk[k0 + kk];
            LAS float* d = scr + kk * 33 + c4; d[0] = x.x; d[1] = x.y; d[2] = x.z; d[3] = x.w; }
    } else {
#pragma unroll 8
        for (int i = 0; i < 32; ++i) { const int kk = 2 * i + (lane >> 5); scr[kk * 33 + (lane & 31)] = W[(size_t)(k0 + kk) * Nsrc + srccol + (lane & 31)] * (gk ? gk[k0 + kk] : 1.f); }
    }
    LDS_WAIT(); asm volatile("" ::: "memory");
    const int c = lane & 7;
#pragma unroll
    for (int j = 0; j < 4; ++j) { const int n = (lane >> 3) + 8 * j; const LAS float* s = scr + (8 * c) * 33 + n;
        u32x4 o; o.x = pk2(s[0 * 33], s[1 * 33]); o.y = pk2(s[2 * 33], s[3 * 33]); o.z = pk2(s[4 * 33], s[5 * 33]); o.w = pk2(s[6 * 33], s[7 * 33]);
        *(u32x4*)(WT + (size_t)(dstrow + n) * K + k0 + 8 * c) = o; }
    LDS_WAIT(); asm volatile("" ::: "memory");
}
__device__ __forceinline__ int win_srccol(int r) {
    if (r < 1024) return r;
    if (r < 2048) return 2048 + (r - 1024);
    if (r < 3072) return 3080 + (r - 2048);
    if (r < 4096) return 5128 + (r - 3072);
    if (r < 7168) return 6152 + (r - 4096);
    if (r < 8192) return 1024 + (r - 7168);
    return 4104 + (r - 8192);
}
__device__ __forceinline__ void convert_layer(const Args& a, int l, unsigned char* ws, LAS unsigned char* lds, int gw, int NGW, int wave, int lane, int gtid, int GT) {
    LAS float* scr = (LAS float*)(lds + wave * 16384);
    bf16* Wb = (bf16*)(ws + WS_W);
    constexpr int I_GU = 16 * 176, I_DN = 44 * 32, I_IN = 16 * 288, I_MKV = 16 * 64, I_BR = 16 * 32, I_OUT = 16 * 32;
    constexpr int NITEMS = 2 * I_GU + 2 * I_DN + I_IN + I_MKV + 3 * I_BR + I_OUT;
    for (int it = gw; it < NITEMS; it += NGW) {
        int r = it;
        if (r < 2 * I_GU) { const int j = r / I_GU; r -= j * I_GU; const int kb = r / 176, nb = r % 176; const int p = nb >> 3, q = nb & 7, s = q >> 2, jj = (q & 3) * 32;
            cvt_item(a.in[I_WGU] + (size_t)(l * 2 + j) * D * 2 * DFF, 2 * DFF, D, s * DFF + 128 * p + jj, (bf16*)((char*)Wb + (j ? WO_GU1 : WO_GU0)), nb * 32, kb, scr, lane, a.in[I_NORMG] + (size_t)(l * NNORM + (j ? 4 : 0)) * D); continue; }
        r -= 2 * I_GU;
        if (r < 2 * I_DN) { const int j = r / I_DN; r -= j * I_DN; const int kb = r / 32, nb = r % 32;
            cvt_item(a.in[I_WDOWN] + (size_t)(l * 2 + j) * DFF * D, D, DFF, nb * 32, (bf16*)((char*)Wb + (j ? WO_D1 : WO_D0)), nb * 32, kb, scr, lane); continue; }
        r -= 2 * I_DN;
        if (r < I_IN) { const int kb = r / 288, nb = r % 288;
            cvt_item(a.in[I_WIN] + (size_t)l * D * WIN_COLS, WIN_COLS, D, win_srccol(nb * 32), (bf16*)((char*)Wb + WO_IN), nb * 32, kb, scr, lane, a.in[I_NORMG] + (size_t)(l * NNORM + 2) * D); continue; }
        r -= I_IN;
        if (r < I_MKV) { const int kb = r / 64, nb = r % 64;
            cvt_item(a.in[I_WMKV] + (size_t)l * D * 2048, 2048, D, nb * 32, (bf16*)((char*)Wb + WO_MKV), nb * 32, kb, scr, lane); continue; }
        r -= I_MKV;
        if (r < 3 * I_BR) { const int j = r / I_BR; r -= j * I_BR; const int kb = r / 32, nb = r % 32;
            cvt_item(a.in[I_WBR] + (size_t)(l * 3 + j) * D * D, D, D, nb * 32, (bf16*)((char*)Wb + WO_BR) + (size_t)j * D * D, nb * 32, kb, scr, lane); continue; }
        r -= 3 * I_BR;
        { const int kb = r / 32, nb = r % 32; cvt_item(a.in[I_WOUT] + (size_t)l * D * D, D, D, nb * 32, (bf16*)((char*)Wb + WO_OUT), nb * 32, kb, scr, lane); }
    }
    bf16* wsg = (bf16*)(ws + WS_WSGU); const float* src = a.in[I_SWS] + (size_t)l * 4 * 128 * 128;
    for (int e = gtid; e < 4 * 128 * 128; e += GT) { const int t = (e >> 7) & 127, s = e & 127; wsg[e] = (bf16)f2bf(s <= t ? src[e] : 0.f); }
    const float* g6 = a.in[I_NORMG] + (size_t)(l * NNORM + 6) * D;
    for (int m = gw; m < MMEM; m += NGW) {
        const f32x4* xr = (const f32x4*)(a.in[I_MEM] + (size_t)m * D) + lane; f32x4 v[4]; float s = 0.f;
#pragma unroll
        for (int j = 0; j < 4; ++j) { v[j] = xr[64 * j]; s += (v[j].x * v[j].x + v[j].y * v[j].y) + (v[j].z * v[j].z + v[j].w * v[j].w); }
        const float rstd = rsqrtf(wave_sum(s) * (1.f / D) + EPS);
        unsigned long long* o8 = (unsigned long long*)((bf16*)(ws + WS_MEMN) + (size_t)m * D) + lane;
#pragma unroll
        for (int j = 0; j < 4; ++j) { const f32x4 gg = ((const f32x4*)g6)[lane + 64 * j];
            o8[64 * j] = (unsigned long long)pk2(v[j].x * rstd * gg.x, v[j].y * rstd * gg.y) | ((unsigned long long)pk2(v[j].z * rstd * gg.z, v[j].w * rstd * gg.w) << 32); }
    }
}

__device__ __forceinline__ void thin_rows(const bf16* fbase, size_t fld, const float* ga, float scale, const float* hin32, const bf16* hinb, bf16* hb_out, float* rstd_out, float* out32,
                                          int row_lo, int row_hi, int gw, int NGW, int lane, const bool do_gates, const LAS float* wif, const float* bi, const float* bfg, float* gate_i, float* gate_f) {
    for (int m = row_lo + gw; m < row_hi; m += NGW) {
        f32x4 v[4];
        if (hin32) { const f32x4* hr = (const f32x4*)(hin32 + (size_t)m * D) + lane;
#pragma unroll
            for (int j = 0; j < 4; ++j) v[j] = hr[64 * j]; }
        else { const unsigned long long* hr = (const unsigned long long*)(hinb + (size_t)m * D) + lane;
#pragma unroll
            for (int j = 0; j < 4; ++j) { const unsigned long long w = hr[64 * j]; const unsigned lo = (unsigned)w, hi = (unsigned)(w >> 32); v[j] = (f32x4){bflo(lo), bfhi(lo), bflo(hi), bfhi(hi)}; } }
        if (fbase) {
            const unsigned long long* fr = (const unsigned long long*)(fbase + (size_t)(m - row_lo) * fld) + lane; float s = 0.f; f32x4 f[4];
#pragma unroll
            for (int j = 0; j < 4; ++j) { const unsigned long long w = fr[64 * j]; const unsigned lo = (unsigned)w, hi = (unsigned)(w >> 32);
                f[j] = (f32x4){bflo(lo), bfhi(lo), bflo(hi), bfhi(hi)}; s += (f[j].x * f[j].x + f[j].y * f[j].y) + (f[j].z * f[j].z + f[j].w * f[j].w); }
            const float rstd = rsqrtf(wave_sum(s) * (1.f / D) + EPS) * scale;
#pragma unroll
            for (int j = 0; j < 4; ++j) { const f32x4 gg = ((const f32x4*)ga)[lane + 64 * j]; v[j] = v[j] + f[j] * rstd * gg; }
        }
        if (out32) { f32x4* ho = (f32x4*)(out32 + (size_t)m * D) + lane;
#pragma unroll
            for (int j = 0; j < 4; ++j) ho[64 * j] = v[j]; }
        if (hb_out) {
            float s = 0.f;
#pragma unroll
            for (int j = 0; j < 4; ++j) s += (v[j].x * v[j].x + v[j].y * v[j].y) + (v[j].z * v[j].z + v[j].w * v[j].w);
            const float rstd = rsqrtf(wave_sum(s) * (1.f / D) + EPS);
            unsigned long long* o8 = (unsigned long long*)(hb_out + (size_t)m * D) + lane;
#pragma unroll
            for (int j = 0; j < 4; ++j) o8[64 * j] = (unsigned long long)pk2(v[j].x, v[j].y) | ((unsigned long long)pk2(v[j].z, v[j].w) << 32);
            if (lane == 0) rstd_out[m] = rstd;
            if (do_gates) {
                float acc[8];
#pragma unroll
                for (int e = 0; e < 8; ++e) acc[e] = 0.f;
#pragma unroll
                for (int j = 0; j < 4; ++j)
#pragma unroll
                    for (int q = 0; q < 4; ++q) { const int k = 4 * lane + 256 * j + q; const float xv = v[j][q]; const LAS f32x4* wp = (const LAS f32x4*)(wif + k * 8); const f32x4 w0 = wp[0], w1 = wp[1];
                        acc[0] += xv * w0.x; acc[1] += xv * w0.y; acc[2] += xv * w0.z; acc[3] += xv * w0.w; acc[4] += xv * w1.x; acc[5] += xv * w1.y; acc[6] += xv * w1.z; acc[7] += xv * w1.w; }
                {
                    float b4[4], b2[2], b1;
#pragma unroll
                    for (int e = 0; e < 4; ++e) { const float mine = (lane & 4) ? acc[4 + e] : acc[e], send = (lane & 4) ? acc[e] : acc[4 + e]; b4[e] = mine + __shfl_xor(send, 4); }
#pragma unroll
                    for (int e = 0; e < 2; ++e) { const float mine = (lane & 2) ? b4[2 + e] : b4[e], send = (lane & 2) ? b4[e] : b4[2 + e]; b2[e] = mine + __shfl_xor(send, 2); }
                    { const float mine = (lane & 1) ? b2[1] : b2[0], send = (lane & 1) ? b2[0] : b2[1]; b1 = mine + __shfl_xor(send, 1); }
                    b1 += __shfl_xor(b1, 8); b1 += __shfl_xor(b1, 16); b1 += __shfl_xor(b1, 32);
                    const float val = b1 * rstd;
                    if (lane < 4) gate_i[(size_t)m * 4 + lane] = val + bi[lane];
                    else if (lane < 8) gate_f[(size_t)m * 4 + lane - 4] = logsigmoidf_(val + bfg[lane - 4]);
                }
            }
        }
    }
}

__device__ __forceinline__ void conv8(const bf16* Zb, int bl, int p, int col, const float* cw, const float* cb, float (&o)[8]) {
    const f32x4 b0 = *(const f32x4*)(cb + col), b1 = *(const f32x4*)(cb + col + 4);
    o[0] = b0.x; o[1] = b0.y; o[2] = b0.z; o[3] = b0.w; o[4] = b1.x; o[5] = b1.y; o[6] = b1.z; o[7] = b1.w;
#pragma unroll
    for (int j = 0; j < 4; ++j) { const int pp = p - 3 + j;
        if (pp >= 0) { const u32x4 x = *(const u32x4*)(Zb + (size_t)(bl * SEQ + pp) * ZLD + ZC_QK + col);
            const f32x4 w0 = *(const f32x4*)(cw + j * 1024 + col), w1 = *(const f32x4*)(cw + j * 1024 + col + 4);
            o[0] += w0.x * bflo(x.x); o[1] += w0.y * bfhi(x.x); o[2] += w0.z * bflo(x.y); o[3] += w0.w * bfhi(x.y);
            o[4] += w1.x * bflo(x.z); o[5] += w1.y * bfhi(x.z); o[6] += w1.z * bflo(x.w); o[7] += w1.w * bfhi(x.w); } }
#pragma unroll
    for (int e = 0; e < 8; ++e) o[e] = siluf_(o[e]);
}
__device__ __forceinline__ float wave_incl_scan_add(float v, int lane) {
#pragma unroll
    for (int o = 1; o < 64; o <<= 1) { const float t = __shfl_up(v, o); if (lane >= o) v += t; }
    return v;
}
__device__ __forceinline__ float wave_incl_scan_max(float v, int lane) {
#pragma unroll
    for (int o = 1; o < 64; o <<= 1) { const float t = __shfl_up(v, o); if (lane >= o) v = fmaxf(v, t); }
    return v;
}
__device__ __forceinline__ float wave_max(float v) {
#pragma unroll
    for (int o = 1; o < 64; o <<= 1) v = fmaxf(v, __shfl_xor(v, o));
    return v;
}
constexpr float KSCALE = 0.08838834764831845f;

__device__ __forceinline__ void conv8l(const bf16* Zb, int bl, int p, int col, const LAS float* wl, const int wstride, float (&o)[8]) {
    { const f32x4 b0 = *(const LAS f32x4*)(wl + 4 * wstride), b1 = *(const LAS f32x4*)(wl + 4 * wstride + 4);
      o[0] = b0.x; o[1] = b0.y; o[2] = b0.z; o[3] = b0.w; o[4] = b1.x; o[5] = b1.y; o[6] = b1.z; o[7] = b1.w; }
#pragma unroll
    for (int j = 0; j < 4; ++j) { const int pp = p - 3 + j;
        if (pp >= 0) { const u32x4 x = *(const u32x4*)(Zb + (size_t)(bl * SEQ + pp) * ZLD + ZC_QK + col);
            const f32x4 w0 = *(const LAS f32x4*)(wl + j * wstride), w1 = *(const LAS f32x4*)(wl + j * wstride + 4);
            o[0] += w0.x * bflo(x.x); o[1] += w0.y * bfhi(x.x); o[2] += w0.z * bflo(x.y); o[3] += w0.w * bfhi(x.y);
            o[4] += w1.x * bflo(x.z); o[5] += w1.y * bfhi(x.z); o[6] += w1.z * bflo(x.w); o[7] += w1.w * bfhi(x.w); } }
#pragma unroll
    for (int e = 0; e < 8; ++e) o[e] = siluf_(o[e]);
}
__device__ __forceinline__ void stage_convw(LAS float* wl, const float* cw, const float* cb, int col0, int ncol, int dst0, int wstride, int tid) {
    for (int e = tid; e < 5 * ncol; e += NTHR) { const int j = e / ncol, cidx = e - j * ncol; wl[j * wstride + dst0 + cidx] = (j < 4) ? cw[j * 1024 + col0 + cidx] : cb[col0 + cidx]; }
}
__device__ __forceinline__ void mlstm_s1(const Args& a, int l, int hf, unsigned char* ws, LAS unsigned char* lds, int G, int cu, int tid, int wave, int lane) {
    const bf16* Zb = (const bf16*)(ws + WS_Z); const bf16* ZT = (const bf16*)(ws + WS_ZT);
    const float* gi = (const float*)(ws + WS_GATE); const float* gf = gi + (size_t)M * 4;
    const float* cw = a.in[I_CONVW] + (size_t)l * 4 * 1024; const float* cb = a.in[I_CONVB] + (size_t)l * 1024;
    LAS bf16* KT = (LAS bf16*)lds;
    LAS float* wv = (LAS float*)(lds + 18432);
    LAS float* CWL = (LAS float*)(lds + 18688);
    const int c8 = tid & 15; int hcur = -1;
    for (int u = cu; u < 16 * NCH; u += G) {
        const int h = u & 3, c = (u >> 2) & 63, bl = u >> 8, bhl = bl * 4 + h; const int tokg = (hf * 4 + bl) * SEQ + c * LCH;
        if (h != hcur) { __syncthreads(); stage_convw(CWL, cw, cb, 512 + h * 128, 128, 0, 128, tid); hcur = h; }
        const int r = lane & 31, hh = lane >> 5, v0 = 32 * wave;
        bf16x8 bfr[4];
        { const bf16* vrow = ZT + (size_t)(h * 256 + v0 + r) * ZTLD + bl * SEQ + c * LCH + 8 * hh;
#pragma unroll
          for (int ks = 0; ks < 4; ++ks) bfr[ks] = *(const bf16x8*)(vrow + 16 * ks); }
        if (wave == 0) {
            const float lf = gf[(size_t)(tokg + lane) * 4 + h], ii = gi[(size_t)(tokg + lane) * 4 + h];
            const float bc = wave_incl_scan_add(lf, lane); const float g = __shfl(bc, 63);
            const float av = g - bc + ii; const float ml = wave_max(av);
            wv[lane] = __expf(av - ml);
            if (lane == 0) { float* cs = (float*)(ws + WS_CSC) + (size_t)(bhl * NCH + c) * 4; cs[0] = g; cs[1] = ml; }
        }
        __syncthreads();
#pragma unroll
        for (int rep = 0; rep < 2; ++rep) { const int idx = tid + rep * NTHR, s = idx >> 4; float o[8];
            conv8l(Zb, bl, c * LCH + s, 512 + h * 128 + c8 * 8, CWL + c8 * 8, 128, o); const float sc = wv[s] * KSCALE;
            { u32x4 w; w.x = pk2(o[0] * KSCALE, o[1] * KSCALE); w.y = pk2(o[2] * KSCALE, o[3] * KSCALE); w.z = pk2(o[4] * KSCALE, o[5] * KSCALE); w.w = pk2(o[6] * KSCALE, o[7] * KSCALE);
              *(u32x4*)((bf16*)(ws + WS_KC) + (size_t)(bl * SEQ + c * LCH + s) * 512 + h * 128 + c8 * 8) = w; }
#pragma unroll
            for (int e = 0; e < 8; ++e) KT[(c8 * 8 + e) * 72 + s] = (bf16)f2bf(o[e] * sc); }
        __syncthreads();
        if (tid < 128) { float s = 0.f;
#pragma unroll 8
            for (int k = 0; k < 64; ++k) s += bf1(KT[tid * 72 + k]);
            ((float*)(ws + WS_NST))[(size_t)(bhl * NCH + c) * 128 + tid] = s; }
        {
            bf16* st = (bf16*)(ws + WS_ST) + (size_t)(bhl * NCH + c) * 32768 + (size_t)(v0 + r) * 128;
#pragma unroll
            for (int db = 0; db < 4; ++db) { f32x16 acc;
#pragma unroll
                for (int e = 0; e < 16; ++e) acc[e] = 0.f;
#pragma unroll
                for (int ks = 0; ks < 4; ++ks) { const bf16x8 af = *(const LAS bf16x8*)(KT + (32 * db + r) * 72 + 16 * ks + 8 * hh); acc = __builtin_amdgcn_mfma_f32_32x32x16_bf16(af, bfr[ks], acc, 0, 0, 0); }
#pragma unroll
                for (int q = 0; q < 4; ++q) { u32x2 w; w.x = pk2(acc[4 * q], acc[4 * q + 1]); w.y = pk2(acc[4 * q + 2], acc[4 * q + 3]); *(u32x2*)(st + 32 * db + 8 * q + 4 * hh) = w; } }
        }
        __syncthreads();
    }
}
__device__ __forceinline__ void mlstm_s2(unsigned char* ws, int G, int cu, int tid) {
    for (int u = cu; u < 256; u += G) {
        const int bhl = u >> 4, part = u & 15; const size_t off = (size_t)(part * NTHR + tid) * 4;
        bf16* st = (bf16*)(ws + WS_ST) + (size_t)bhl * NCH * 32768 + off; float* ns = (float*)(ws + WS_NST) + (size_t)bhl * NCH * 128 + tid; float* cs = (float*)(ws + WS_CSC) + (size_t)bhl * NCH * 4;
        const bool nth = (part == 0 && tid < 128);
        float C[4]; float nv = 0.f, m = -1e30f;
#pragma unroll
        for (int e = 0; e < 4; ++e) C[e] = 0.f;
        for (int c0 = 0; c0 < NCH; c0 += 8) {
            u32x2 cl[8]; float nl[8], gg[8], ml[8];
#pragma unroll
            for (int i = 0; i < 8; ++i) { cl[i] = *(const u32x2*)(st + (size_t)(c0 + i) * 32768); nl[i] = nth ? ns[(c0 + i) * 128] : 0.f; gg[i] = cs[(c0 + i) * 4]; ml[i] = cs[(c0 + i) * 4 + 1]; }
#pragma unroll
            for (int i = 0; i < 8; ++i) {
                u32x2 o; o.x = pk2(C[0], C[1]); o.y = pk2(C[2], C[3]);
                *(u32x2*)(st + (size_t)(c0 + i) * 32768) = o;
                if (nth) ns[(c0 + i) * 128] = nv;
                if (part == 0 && tid == 0) cs[(c0 + i) * 4 + 2] = m;
                const float mn = fmaxf(gg[i] + m, ml[i]); const float dec = __expf(gg[i] + m - mn), sc = __expf(ml[i] - mn);
                C[0] = dec * C[0] + sc * bflo(cl[i].x); C[1] = dec * C[1] + sc * bfhi(cl[i].x); C[2] = dec * C[2] + sc * bflo(cl[i].y); C[3] = dec * C[3] + sc * bfhi(cl[i].y);
                nv = dec * nv + sc * nl[i]; m = mn;
            }
        }
    }
}
__device__ __forceinline__ void mlstm_s3(const Args& a, int l, int hf, unsigned char* ws, LAS unsigned char* lds, int G, int cu, int tid, int wave, int lane, const int out_col) {
    bf16* Zb = (bf16*)(ws + WS_Z); const bf16* ZT = (const bf16*)(ws + WS_ZT);
    const float* gi = (const float*)(ws + WS_GATE); const float* gf = gi + (size_t)M * 4;
    const float* cw = a.in[I_CONVW] + (size_t)l * 4 * 1024; const float* cb = a.in[I_CONVB] + (size_t)l * 1024;
    const float* gain = a.in[I_MNORM] + (size_t)l * 1024;
    LAS bf16* QS = (LAS bf16*)lds;
    LAS bf16* KS = (LAS bf16*)(lds + 17408);
    LAS bf16* SD = (LAS bf16*)(lds + 34816);
    LAS float* HB = (LAS float*)(lds + 44032);
    LAS float* SC = (LAS float*)(lds + 110592);
    LAS float* CWL = (LAS float*)(lds + 112384);
    const int c8 = tid & 15; int hcur = -1;
    for (int u = cu; u < 16 * NCH; u += G) {
        const int h = u & 3, c = (u >> 2) & 63, bl = u >> 8, bhl = bl * 4 + h; const int tokg = (hf * 4 + bl) * SEQ + c * LCH; const int tokl = bl * SEQ + c * LCH;
        if (h != hcur) { __syncthreads(); stage_convw(CWL, cw, cb, h * 128, 128, 0, 256, tid); hcur = h; __syncthreads(); }
        const int r = lane & 31, hh = lane >> 5, v0 = 32 * wave;
        bf16x8 bV[4], bC[8];
        { const bf16* vrow = ZT + (size_t)(h * 256 + v0 + r) * ZTLD + tokl + 8 * hh;
          const bf16* crow = (const bf16*)(ws + WS_ST) + (size_t)(bhl * NCH + c) * 32768 + (size_t)(v0 + r) * 128 + 8 * hh;
#pragma unroll
          for (int ks = 0; ks < 4; ++ks) bV[ks] = *(const bf16x8*)(vrow + 16 * ks);
#pragma unroll
          for (int ks = 0; ks < 8; ++ks) bC[ks] = *(const bf16x8*)(crow + 16 * ks); }
        u32x4 ogr[4];
#pragma unroll
        for (int i = 0; i < 4; ++i) ogr[i] = *(const u32x4*)(Zb + (size_t)(tokl + (tid >> 3)) * ZLD + ZC_O + h * 256 + 32 * (tid & 7) + 8 * i);
        if (wave == 0) {
            const float lf = gf[(size_t)(tokg + lane) * 4 + h], ii = gi[(size_t)(tokg + lane) * 4 + h];
            const float bc = wave_incl_scan_add(lf, lane); const float rr = ii - bc; const float cm = wave_incl_scan_max(rr, lane);
            const float mst = ((const float*)(ws + WS_CSC))[(size_t)(bhl * NCH + c) * 4 + 2];
            const float Mt = fmaxf(mst, cm);
            SC[lane] = rr; SC[64 + lane] = Mt; SC[128 + lane] = __expf(mst - Mt); SC[192 + lane] = __expf(-(bc + Mt));
        } else if (wave == 1 || wave == 2) { const int d = (wave - 1) * 64 + lane; SC[320 + d] = ((const float*)(ws + WS_NST))[(size_t)(bhl * NCH + c) * 128 + d]; }
#pragma unroll
        for (int rep = 0; rep < 2; ++rep) { const int idx = tid + rep * NTHR, t = idx >> 4; float o[8];
            conv8l(Zb, bl, c * LCH + t, h * 128 + c8 * 8, CWL + c8 * 8, 256, o);
            u32x4 w; w.x = pk2(o[0], o[1]); w.y = pk2(o[2], o[3]); w.z = pk2(o[4], o[5]); w.w = pk2(o[6], o[7]);
            *(LAS u32x4*)(QS + t * 136 + c8 * 8) = w;
            *(LAS u32x4*)(KS + t * 136 + c8 * 8) = *(const u32x4*)((const bf16*)(ws + WS_KC) + (size_t)(tokl + t) * 512 + h * 128 + c8 * 8); }
        __syncthreads();
        {
            const int tb = wave >> 1, fr = lane & 15, fq = lane >> 4;
#pragma unroll
            for (int i = 0; i < 2; ++i) { const int sblk = (wave & 1) * 2 + i; f32x4 acc = (f32x4){0.f, 0.f, 0.f, 0.f};
                if (sblk <= tb) {
#pragma unroll
                    for (int ks = 0; ks < 4; ++ks) { const bf16x8 af = *(const LAS bf16x8*)(QS + (16 * tb + fr) * 136 + 32 * ks + 8 * fq), bfv = *(const LAS bf16x8*)(KS + (16 * sblk + fr) * 136 + 32 * ks + 8 * fq);
                        acc = __builtin_amdgcn_mfma_f32_16x16x32_bf16(af, bfv, acc, 0, 0, 0); } }
                const int s = 16 * sblk + fr; const float rs_ = SC[s];
#pragma unroll
                for (int e = 0; e < 4; ++e) { const int t = 16 * tb + 4 * fq + e; const float val = (s <= t) ? acc[e] * __expf(rs_ - SC[64 + t]) : 0.f; SD[t * 72 + s] = (bf16)f2bf(val); } }
        }
        f32x16 aQ0, aQ1, aS0, aS1;
#pragma unroll
        for (int e = 0; e < 16; ++e) { aQ0[e] = 0.f; aQ1[e] = 0.f; aS0[e] = 0.f; aS1[e] = 0.f; }
#pragma unroll
        for (int ks = 0; ks < 8; ++ks) {
            const bf16x8 a0 = *(const LAS bf16x8*)(QS + r * 136 + 16 * ks + 8 * hh), a1 = *(const LAS bf16x8*)(QS + (32 + r) * 136 + 16 * ks + 8 * hh);
            aQ0 = __builtin_amdgcn_mfma_f32_32x32x16_bf16(a0, bC[ks], aQ0, 0, 0, 0); aQ1 = __builtin_amdgcn_mfma_f32_32x32x16_bf16(a1, bC[ks], aQ1, 0, 0, 0); }
        __syncthreads();
        {
            const int t = tid >> 3, p = tid & 7; float ds = 0.f, qn = 0.f;
#pragma unroll
            for (int k = 0; k < 8; ++k) ds += bf1(SD[t * 72 + 8 * p + k]);
#pragma unroll
            for (int k = 0; k < 16; ++k) qn += bf1(QS[t * 136 + 16 * p + k]) * SC[320 + 16 * p + k];
            float den = ds + SC[128 + t] * qn;
            den += __shfl_xor(den, 1); den += __shfl_xor(den, 2); den += __shfl_xor(den, 4);
            if (p == 0) SC[256 + t] = 1.f / fmaxf(fabsf(den), SC[192 + t]);
        }
#pragma unroll
        for (int ks = 0; ks < 4; ++ks) {
            const bf16x8 a0 = *(const LAS bf16x8*)(SD + r * 72 + 16 * ks + 8 * hh), a1 = *(const LAS bf16x8*)(SD + (32 + r) * 72 + 16 * ks + 8 * hh);
            aS0 = __builtin_amdgcn_mfma_f32_32x32x16_bf16(a0, bV[ks], aS0, 0, 0, 0); aS1 = __builtin_amdgcn_mfma_f32_32x32x16_bf16(a1, bV[ks], aS1, 0, 0, 0); }
        __syncthreads();
#pragma unroll
        for (int e = 0; e < 16; ++e) { const int t0 = (e & 3) + 8 * (e >> 2) + 4 * hh;
            HB[t0 * 260 + v0 + r] = (aS0[e] + SC[128 + t0] * aQ0[e]) * SC[256 + t0]; HB[(32 + t0) * 260 + v0 + r] = (aS1[e] + SC[128 + 32 + t0] * aQ1[e]) * SC[256 + 32 + t0]; }
        __syncthreads();
        {
            const int t = tid >> 3, p = tid & 7; f32x4 x[8]; float sm = 0.f;
#pragma unroll
            for (int k = 0; k < 8; ++k) { x[k] = *(const LAS f32x4*)(HB + t * 260 + 32 * p + 4 * k); sm += (x[k].x + x[k].y) + (x[k].z + x[k].w); }
            sm += __shfl_xor(sm, 1); sm += __shfl_xor(sm, 2); sm += __shfl_xor(sm, 4);
            const float mean = sm * (1.f / 256.f); float sq = 0.f;
#pragma unroll
            for (int k = 0; k < 8; ++k) { x[k] = x[k] - mean; sq += (x[k].x * x[k].x + x[k].y * x[k].y) + (x[k].z * x[k].z + x[k].w * x[k].w); }
            sq += __shfl_xor(sq, 1); sq += __shfl_xor(sq, 2); sq += __shfl_xor(sq, 4);
            const float rstd = rsqrtf(sq * (1.f / 256.f) + EPS);
            const float* gp = gain + h * 256 + 32 * p; bf16* op = Zb + (size_t)(tokl + t) * ZLD + out_col + h * 256 + 32 * p;
#pragma unroll
            for (int i = 0; i < 4; ++i) { const f32x4 g0 = *(const f32x4*)(gp + 8 * i), g1 = *(const f32x4*)(gp + 8 * i + 4); const f32x4 a = x[2 * i] * rstd * g0, b = x[2 * i + 1] * rstd * g1; const u32x4 og = ogr[i]; u32x4 w;
                w.x = pk2(a.x * bflo(og.x), a.y * bfhi(og.x)); w.y = pk2(a.z * bflo(og.y), a.w * bfhi(og.y)); w.z = pk2(b.x * bflo(og.z), b.y * bfhi(og.z)); w.w = pk2(b.z * bflo(og.w), b.w * bfhi(og.w));
                *(u32x4*)(op + 8 * i) = w; }
        }
        __syncthreads();
    }
}

__device__ __forceinline__ void sgu_phase(const Args& a, int l, unsigned char* ws, LAS unsigned char* lds, int G, int cu, int tid, int wave, int lane, const int out_col) {
    bf16* Zb = (bf16*)(ws + WS_Z); const bf16* ZT = (const bf16*)(ws + WS_ZT); const bf16* Wc = (const bf16*)(ws + WS_WSGU);
    const float* lng = a.in[I_SLNG] + (size_t)l * 1024; const float* lnb = a.in[I_SLNB] + (size_t)l * 1024; const float* bs = a.in[I_SBS] + (size_t)l * 4 * 128;
    LAS bf16* VT = (LAS bf16*)lds;
    LAS float* PS = (LAS float*)(lds + 69632);
    LAS float* ST = (LAS float*)(lds + 69632 + 8192);
    LAS bf16* WS_ = (LAS bf16*)(lds + 78848);
    const int c8 = tid & 15, dq = tid >> 4;
    int gcur = -1;
    for (int u = cu; u < 4 * 32 * 4; u += G) {
        const int g = u & 3, cc = (u >> 2) & 31, bl = u >> 7; const int tokl = bl * SEQ + cc * 128;
        u32x4 x[8];
#pragma unroll
        for (int rep = 0; rep < 8; ++rep) x[rep] = *(const u32x4*)(ZT + (size_t)(1024 + g * 256 + dq + 32 * rep) * ZTLD + tokl + c8 * 8);
        if (g != gcur) { __syncthreads();
#pragma unroll
            for (int rep = 0; rep < 4; ++rep) { const int idx = tid + rep * NTHR, t = idx >> 4; *(LAS u32x4*)(WS_ + t * 136 + c8 * 8) = *(const u32x4*)(Wc + (size_t)(g * 128 + t) * 128 + c8 * 8); }
            gcur = g; }
        {
            float sm[8], sq[8];
#pragma unroll
            for (int k = 0; k < 8; ++k) { sm[k] = 0.f; sq[k] = 0.f; }
#pragma unroll
            for (int rep = 0; rep < 8; ++rep) { const u32x4 v = x[rep]; const float f0 = bflo(v.x), f1 = bfhi(v.x), f2 = bflo(v.y), f3 = bfhi(v.y), f4 = bflo(v.z), f5 = bfhi(v.z), f6 = bflo(v.w), f7 = bfhi(v.w);
                sm[0] += f0; sq[0] += f0 * f0; sm[1] += f1; sq[1] += f1 * f1; sm[2] += f2; sq[2] += f2 * f2; sm[3] += f3; sq[3] += f3 * f3;
                sm[4] += f4; sq[4] += f4 * f4; sm[5] += f5; sq[5] += f5 * f5; sm[6] += f6; sq[6] += f6 * f6; sm[7] += f7; sq[7] += f7 * f7; }
#pragma unroll
            for (int k = 0; k < 8; ++k) { sm[k] += __shfl_xor(sm[k], 16); sq[k] += __shfl_xor(sq[k], 16); sm[k] += __shfl_xor(sm[k], 32); sq[k] += __shfl_xor(sq[k], 32); }
            if (lane < 16) {
#pragma unroll
                for (int k = 0; k < 8; ++k) { PS[(wave * 128 + c8 * 8 + k) * 2] = sm[k]; PS[(wave * 128 + c8 * 8 + k) * 2 + 1] = sq[k]; } }
        }
        __syncthreads();
        if (tid < 128) { float sm = 0.f, sq = 0.f;
#pragma unroll
            for (int p = 0; p < 8; ++p) { sm += PS[(p * 128 + tid) * 2]; sq += PS[(p * 128 + tid) * 2 + 1]; }
            const float mean = sm * (1.f / 256.f); const float var = fmaxf(sq * (1.f / 256.f) - mean * mean, 0.f); ST[tid] = mean; ST[128 + tid] = rsqrtf(var + EPS); }
        __syncthreads();
        { const LAS float* mp = ST + c8 * 8; const LAS float* rp = ST + 128 + c8 * 8; float mm[8], rr[8];
#pragma unroll
            for (int k = 0; k < 8; ++k) { mm[k] = mp[k]; rr[k] = rp[k]; }
#pragma unroll
            for (int rep = 0; rep < 8; ++rep) { const int d = dq + 32 * rep; const float gg = lng[g * 256 + d], bb = lnb[g * 256 + d]; u32x4 v = x[rep];
                v.x = pk2((bflo(v.x) - mm[0]) * rr[0] * gg + bb, (bfhi(v.x) - mm[1]) * rr[1] * gg + bb); v.y = pk2((bflo(v.y) - mm[2]) * rr[2] * gg + bb, (bfhi(v.y) - mm[3]) * rr[3] * gg + bb);
                v.z = pk2((bflo(v.z) - mm[4]) * rr[4] * gg + bb, (bfhi(v.z) - mm[5]) * rr[5] * gg + bb); v.w = pk2((bflo(v.w) - mm[6]) * rr[6] * gg + bb, (bfhi(v.w) - mm[7]) * rr[7] * gg + bb);
                *(LAS u32x4*)(VT + d * 136 + c8 * 8) = v; } }
        __syncthreads();
        {
            const int r = lane & 31, hh = lane >> 5, d0 = 32 * wave;
            u32x2 uu[4][4];
#pragma unroll
            for (int tb = 0; tb < 4; ++tb)
#pragma unroll
                for (int q = 0; q < 4; ++q) uu[tb][q] = *(const u32x2*)(Zb + (size_t)(tokl + 32 * tb + r) * ZLD + ZC_U + g * 256 + d0 + 4 * hh + 8 * q);
            f32x16 acc[4];
#pragma unroll
            for (int tb = 0; tb < 4; ++tb)
#pragma unroll
                for (int e = 0; e < 16; ++e) acc[tb][e] = 0.f;
#pragma unroll
            for (int ks = 0; ks < 8; ++ks) { const bf16x8 af = *(const LAS bf16x8*)(VT + (d0 + r) * 136 + 16 * ks + 8 * hh);
#pragma unroll
                for (int tb = 0; tb < 4; ++tb) if (16 * ks <= 32 * tb + 31) { const bf16x8 bfv = *(const LAS bf16x8*)(WS_ + (32 * tb + r) * 136 + 16 * ks + 8 * hh);
                    acc[tb] = __builtin_amdgcn_mfma_f32_32x32x16_bf16(af, bfv, acc[tb], 0, 0, 0); } }
#pragma unroll
            for (int tb = 0; tb < 4; ++tb) { const int t = 32 * tb + r; const float bias = bs[g * 128 + t]; bf16* rowp = Zb + (size_t)(tokl + t) * ZLD + out_col + g * 256 + d0 + 4 * hh;
#pragma unroll
                for (int q = 0; q < 4; ++q) { const u32x2 v = uu[tb][q]; u32x2 w;
                    w.x = pk2(bflo(v.x) * (acc[tb][4 * q] + bias), bfhi(v.x) * (acc[tb][4 * q + 1] + bias)); w.y = pk2(bflo(v.y) * (acc[tb][4 * q + 2] + bias), bfhi(v.y) * (acc[tb][4 * q + 3] + bias)); *(u32x2*)(rowp + 8 * q) = w; } }
        }
        __syncthreads();
    }
}

__device__ __forceinline__ void softmax_rows(unsigned char* ws, int gw, int NGW, int lane) {
    bf16* Zb = (bf16*)(ws + WS_Z);
    for (int m = gw; m < MH; m += NGW) {
        u32x4* p = (u32x4*)(Zb + (size_t)m * ZLD + ZC_XQ + 16 * lane); const u32x4 x0 = p[0], x1 = p[1];
        float v[16] = { bflo(x0.x), bfhi(x0.x), bflo(x0.y), bfhi(x0.y), bflo(x0.z), bfhi(x0.z), bflo(x0.w), bfhi(x0.w), bflo(x1.x), bfhi(x1.x), bflo(x1.y), bfhi(x1.y), bflo(x1.z), bfhi(x1.z), bflo(x1.w), bfhi(x1.w) };
        float mx = v[0];
#pragma unroll
        for (int e = 1; e < 16; ++e) mx = fmaxf(mx, v[e]);
#pragma unroll
        for (int o = 1; o < 16; o <<= 1) mx = fmaxf(mx, __shfl_xor(mx, o));
        float s = 0.f;
#pragma unroll
        for (int e = 0; e < 16; ++e) { v[e] = __expf(v[e] - mx); s += v[e]; }
#pragma unroll
        for (int o = 1; o < 16; o <<= 1) s += __shfl_xor(s, o);
        const float inv = 1.f / s;
        u32x4 y0, y1; y0.x = pk2(v[0] * inv, v[1] * inv); y0.y = pk2(v[2] * inv, v[3] * inv); y0.z = pk2(v[4] * inv, v[5] * inv); y0.w = pk2(v[6] * inv, v[7] * inv);
        y1.x = pk2(v[8] * inv, v[9] * inv); y1.y = pk2(v[10] * inv, v[11] * inv); y1.z = pk2(v[12] * inv, v[13] * inv); y1.w = pk2(v[14] * inv, v[15] * inv);
        p[0] = y0; p[1] = y1;
    }
}

__global__ void __launch_bounds__(NTHR, 2) trunk_fwd(Args args) {
    extern __shared__ __attribute__((aligned(16))) unsigned char lds_raw[];
    LAS unsigned char* lds = (LAS unsigned char*)lds_raw;
    volatile LAS unsigned* MISC = (volatile LAS unsigned*)(lds + MISC_OFF);
    const int G = gridDim.x, cu = blockIdx.x;
    unsigned char* ws = args.ws;
#define PHASE_IDS() int tid = threadIdx.x; asm volatile("" : "+v"(tid)); const int lane = tid & 63, wave = __builtin_amdgcn_readfirstlane(tid >> 6); \
    const int vcu = (G % 8 == 0) ? (cu % 8) * (G / 8) + cu / 8 : cu; const int gw = vcu * NWAVES + wave, NGW = G * NWAVES, gtid = cu * NTHR + tid, GT = G * NTHR; (void)gw; (void)NGW; (void)gtid; (void)GT; (void)lane
    for (int u = threadIdx.x; u < (LDS_BYTES - RING_BYTES) / 4; u += NTHR) ((LAS unsigned*)(lds + RING_BYTES))[u] = 0u;
    __syncthreads();
    XcdBarrier bar = xcd_barrier_post((unsigned*)(ws + WS_CTL) + 4096, MISC + 8);
    const int lo = args.ph_lo, hi = args.ph_hi;
    int ph = 0;
#define IN() (lo <= ph && ph < hi)
#define SEAM() do { if (lo <= ph && ph + 1 < hi) xcd_barrier(bar); ++ph; } while (0)
    bf16* XN = (bf16*)(ws + WS_XN); bf16* Wb = (bf16*)(ws + WS_W); float* RSTD = (float*)(ws + WS_RSTD);
    float* hbuf = args.out;

    if (IN()) { PHASE_IDS();
        convert_layer(args, 0, ws, lds, gw, NGW, wave, lane, gtid, GT);
        thin_rows(nullptr, 0, nullptr, 0.f, args.in[I_X], nullptr, XN, RSTD, nullptr, 0, M, gw, NGW, lane, false, nullptr, nullptr, nullptr, nullptr, nullptr);
        __syncthreads();
    }
    SEAM();

    for (int sb = 0; sb < 2 * DEPTH; ++sb) {
        const int l = sb >> 1, j = sb & 1;
        const float* ng = args.in[I_NORMG] + (size_t)l * NNORM * D;
        if (IN()) { PHASE_IDS();
            pg8::Gemm g{D, D, D}; pg8::TileSched S; S.init(M / 256, 2 * DFF / 256, G, cu, XN, D * 2, (char*)Wb + (j ? WO_GU1 : WO_GU0), D * 2);
            pg8::EpiGU E{(bf16*)(ws + WS_HID), RSTD};
            pg8::gemm_phase(lds, g, S, E, tid);
        }
        SEAM();
        if (IN()) { PHASE_IDS();
            pg8::Gemm g{DFF, DFF, DFF}; pg8::TileSched S; S.init(M / 256, D / 256, G, cu, ws + WS_HID, DFF * 2, (char*)Wb + (j ? WO_D1 : WO_D0), DFF * 2);
            pg8::EpiAct E{(bf16*)(ws + WS_F), (size_t)D, 0, nullptr, nullptr};
            pg8::gemm_phase(lds, g, S, E, tid);
        }
        SEAM();
        if (IN()) { PHASE_IDS();
            const float* hin = (sb == 0) ? args.in[I_X] : hbuf;
            if (j == 0) {
                LAS float* wif = (LAS float*)lds;
                const float* win = args.in[I_WIN] + (size_t)l * D * WIN_COLS;
                for (int e = tid; e < D * 8; e += NTHR) wif[e] = win[(size_t)(e >> 3) * WIN_COLS + 3072 + (e & 7)] * ng[2 * D + (e >> 3)];
                __syncthreads();
                float* gi = (float*)(ws + WS_GATE);
                const float* hx = (sb == 0) ? args.in[I_X] : nullptr;
                if (G == 256) {
                    const bool kvcu = (cu < 32) || (cu >= 128 && cu < 160);
                    if (kvcu) { const int gwk = ((cu < 32) ? cu : cu - 96) * NWAVES + wave;
                        thin_rows((const bf16*)(ws + WS_F), D, ng + 1 * D, 0.5f, hx, XN, XN, RSTD, nullptr, 0, 1024, gwk, 512, lane, true, wif, args.in[I_BI] + l * 4, args.in[I_BF] + l * 4, gi, gi + (size_t)M * 4); }
                    else { const int cun = (cu < 128) ? cu - 32 : cu - 64; const int gwn = cun * NWAVES + wave;
                        thin_rows((const bf16*)(ws + WS_F) + (size_t)1024 * D, D, ng + 1 * D, 0.5f, hx, XN, XN, RSTD, nullptr, 1024, M, gwn, 1536, lane, true, wif, args.in[I_BI] + l * 4, args.in[I_BF] + l * 4, gi, gi + (size_t)M * 4); }
                } else
                thin_rows((const bf16*)(ws + WS_F), D, ng + 1 * D, 0.5f, hx, XN, XN, RSTD, nullptr, 0, M, gw, NGW, lane, true, wif, args.in[I_BI] + l * 4, args.in[I_BF] + l * 4, gi, gi + (size_t)M * 4);
                __syncthreads();
                {
                    pg8::Gemm g{D, D, D};
                    pg8::TileSched S; S.init(MMEM / 256, D / 256, G, cu, ws + WS_MEMN, D * 2, (char*)Wb + WO_MKV, D * 2);
                    pg8::EpiAct E{(bf16*)(ws + WS_KMEM), (size_t)D, 0, nullptr, nullptr};
                    pg8::gemm_phase(lds, g, S, E, tid);
                    pg8::TileSched S2; S2.init(D / 256, MMEM / 256, G, (cu + G / 2) % G, (char*)Wb + WO_MKV + (size_t)D * D * 2, D * 2, ws + WS_MEMN, D * 2);
                    pg8::EpiAct E2{(bf16*)(ws + WS_VTMEM), (size_t)MMEM, 0, nullptr, nullptr};
                    pg8::gemm_phase(lds, g, S2, E2, tid);
                }
            } else {
                const bool lastl = (l + 1 == DEPTH);
                thin_rows((const bf16*)(ws + WS_F), D, ng + 5 * D, 0.5f, nullptr, XN, lastl ? nullptr : XN, RSTD, lastl ? hbuf : nullptr, 0, M, gw, NGW, lane, false, nullptr, nullptr, nullptr, nullptr, nullptr);
                if (l + 1 < DEPTH) { __syncthreads(); convert_layer(args, l + 1, ws, lds, gw, NGW, wave, lane, gtid, GT); __syncthreads(); }
            }
        }
        SEAM();
        if (j == 0) {
            for (int hf = 0; hf < 2; ++hf) {
                bf16* Zb = (bf16*)(ws + WS_Z);
                if (IN()) { PHASE_IDS();
                    pg8::Gemm g{D, D, D};
                    pg8::TileSched S; S.init(MH / 256, ZLD / 256, G, cu, XN + (size_t)hf * MH * D, D * 2, (char*)Wb + WO_IN, D * 2);
                    pg8::EpiAct E{Zb, (size_t)ZLD, 1, RSTD + (size_t)hf * MH, nullptr};
                    pg8::gemm_phase(lds, g, S, E, tid);
                    pg8::TileSched S2; S2.init(2048 / 256, MH / 256, G, cu, (char*)Wb + WO_IN + (size_t)ZLD * D * 2, D * 2, XN + (size_t)hf * MH * D, D * 2);
                    pg8::EpiAct E2{(bf16*)(ws + WS_ZT), (size_t)ZTLD, 2, nullptr, RSTD + (size_t)hf * MH};
                    pg8::gemm_phase(lds, g, S2, E2, tid);
                }
                SEAM();
                if (IN()) { PHASE_IDS();
                    mlstm_s1(args, l, hf, ws, lds, G, cu, tid, wave, lane);
                    sgu_phase(args, l, ws, lds, G, cu, tid, wave, lane, ZC_U);
                    pg8::Gemm g{256, ZLD, D};
                    pg8::TileSched S; S.init(MH / 256, 4, G, cu, Zb + ZC_XQ, ZLD * 2, (bf16*)(ws + WS_KMEM) + (size_t)hf * 4 * MEMLEN * D, 0);
                    S.a_pn = 512; S.b_tile = 512; S.pm_per_b = 16; S.b_batch = (size_t)MEMLEN * D * 2;
                    pg8::EpiAct E{Zb + ZC_XQ, (size_t)ZLD, 0, nullptr, nullptr};
                    pg8::gemm_phase(lds, g, S, E, tid);
                }
                SEAM();
                if (IN()) { PHASE_IDS();
                    mlstm_s2(ws, G, cu, tid);
                    softmax_rows(ws, gw, NGW, lane);
                }
                SEAM();
                if (IN()) { PHASE_IDS();
                    mlstm_s3(args, l, hf, ws, lds, G, cu, tid, wave, lane, ZC_O);
#ifdef PROBE_S3
                    for (int rep_ = 0; rep_ < 2; ++rep_) mlstm_s3(args, l, hf, ws, lds, G, cu, tid, wave, lane, ZC_QK);
#endif
#ifdef PROBE_SGU
                    for (int rep_ = 0; rep_ < 2; ++rep_) sgu_phase(args, l, ws, lds, G, cu, tid, wave, lane, ZC_QK);
#endif
                    pg8::Gemm g{256, ZLD, MMEM};
                    pg8::TileSched S; S.init(MH / 256, 4, G, cu, Zb + ZC_XQ, ZLD * 2, (bf16*)(ws + WS_VTMEM) + (size_t)hf * 4 * MEMLEN, 0);
                    S.a_pn = 512; S.b_tile = (size_t)256 * MMEM * 2; S.pm_per_b = 16; S.b_batch = (size_t)MEMLEN * 2;
                    pg8::EpiAct E{Zb + ZC_XQ, (size_t)ZLD, 0, nullptr, nullptr};
                    pg8::gemm_phase(lds, g, S, E, tid);
                }
                SEAM();
                if (IN()) { PHASE_IDS();
                    pg8::Gemm g{D, ZLD, D};
                    pg8::TileSched S; S.init(MH / 256, D / 256, G, cu, Zb + ZC_O, ZLD * 2, (char*)Wb + WO_BR, D * 2);
                    S.reps = 3; S.a_rep = 1024 * 2; S.b_rep = (size_t)D * D * 2;
                    pg8::EpiBranch E{Zb};
                    pg8::gemm_phase(lds, g, S, E, tid);
                }
                SEAM();
                if (IN()) { PHASE_IDS();
                    pg8::Gemm g{D, ZLD, D};
                    pg8::TileSched S; S.init(MH / 256, D / 256, G, cu, Zb + ZC_QK, ZLD * 2, (char*)Wb + WO_OUT, D * 2);
                    pg8::EpiAct E{Zb + ZC_O, (size_t)ZLD, 0, nullptr, nullptr};
                    pg8::gemm_phase(lds, g, S, E, tid);
                }
                SEAM();
                if (IN()) { PHASE_IDS();
                    thin_rows(Zb + ZC_O, ZLD, ng + 3 * D, 1.0f, nullptr, XN, XN, RSTD, nullptr, hf * MH, (hf + 1) * MH, gw, NGW, lane, false, nullptr, nullptr, nullptr, nullptr, nullptr);
                }
                SEAM();
            }
        }
    }
#undef IN
#undef SEAM
}
constexpr int N_PHASES = 1 + 2 * DEPTH * 3 + DEPTH * 2 * 7;

#ifndef N_LAUNCH_MODE
#define N_LAUNCH_MODE 0
#endif
extern "C" void kernel_launch(void* const* d_in, const int* in_sizes, int n_in, void* d_out, int out_size, void* d_ws, size_t ws_size, hipStream_t stream) {
    static int grid = 0;
    if (grid == 0) {
        if (n_in != 18 || out_size != M * D || ws_size < WS_END) { fprintf(stderr, "kernel_launch: unexpected shapes (n_in %d out %d ws %zu)\n", n_in, out_size, ws_size); grid = -1; return; }
        int dev = 0, cus = 0, per_cu = 0;
        if (hipGetDevice(&dev) != hipSuccess || hipDeviceGetAttribute(&cus, hipDeviceAttributeMultiprocessorCount, dev) != hipSuccess) { grid = -1; return; }
        if (hipFuncSetAttribute((const void*)trunk_fwd, hipFuncAttributeMaxDynamicSharedMemorySize, LDS_BYTES) != hipSuccess) { grid = -1; return; }
        if (hipOccupancyMaxActiveBlocksPerMultiprocessor(&per_cu, (const void*)trunk_fwd, NTHR, LDS_BYTES) != hipSuccess || per_cu < 1) { fprintf(stderr, "kernel_launch: occupancy query says %d\n", per_cu); }
        (void)hipGetLastError();
        grid = cus;
    }
    if (grid < 0) return;
    (void)hipMemsetAsync((char*)d_ws + WS_CTL, 0, CTL_ZERO_BYTES, stream);
    Args a{};
    for (int i = 0; i < 18; ++i) a.in[i] = (const float*)d_in[i];
    a.out = (float*)d_out; a.ws = (unsigned char*)d_ws;
#if N_LAUNCH_MODE == 0
    a.ph_lo = 0; a.ph_hi = N_PHASES;
    hipLaunchKernelGGL(trunk_fwd, dim3(grid), dim3(NTHR), LDS_BYTES, stream, a);
#else
    for (int p = 0; p < N_PHASES; ++p) { a.ph_lo = p; a.ph_hi = p + 1; hipLaunchKernelGGL(trunk_fwd, dim3(grid), dim3(NTHR), LDS_BYTES, stream, a); }
#endif
}
```

```cpp
#include <hip/hip_runtime.h>
#include <cstdio>
#include <cstdint>

#define LAS __attribute__((address_space(3)))
#define GAS __attribute__((address_space(1)))
typedef unsigned short bf16;
typedef short bf16x8 __attribute__((ext_vector_type(8)));
typedef float f32x4 __attribute__((ext_vector_type(4)));
typedef float f32x16 __attribute__((ext_vector_type(16)));
typedef unsigned u32x4 __attribute__((ext_vector_type(4)));
typedef unsigned u32x2 __attribute__((ext_vector_type(2)));

constexpr int D = 1024, BATCH = 8, SEQ = 4096, DEPTH = 2, MEMLEN = 256, DFF = 2816, NNORM = 7;
constexpr int M = BATCH * SEQ, MH = M / 2, MMEM = BATCH * MEMLEN;
constexpr int WIN_COLS = 9224;
constexpr int LCH = 64, NCH = SEQ / LCH;
constexpr int ZLD = 7168;
constexpr int ZC_QK = 0, ZC_O = 1024, ZC_U = 2048, ZC_XQ = 3072, ZC_G = 4096;
constexpr int ZTLD = MH;
constexpr float EPS = 1e-6f;
constexpr int NWAVES = 8, NTHR = 512;

constexpr size_t MiB = 1u << 20;
constexpr size_t WS_CTL = 0, CTL_ZERO_BYTES = 1 * MiB;
constexpr size_t WS_WSGU = 1 * MiB;
constexpr size_t WS_GATE = 2 * MiB;
constexpr size_t WS_NST = 3 * MiB;
constexpr size_t WS_CSC = 4 * MiB;
constexpr size_t WS_MEMN = 5 * MiB;
constexpr size_t WS_KMEM = 9 * MiB;
constexpr size_t WS_VTMEM = 13 * MiB;
constexpr size_t WS_W = 17 * MiB;
constexpr size_t WO_GU0 = 0, WO_GU1 = 11 * MiB, WO_D0 = 22 * MiB, WO_D1 = WO_D0 + 5632 * 1024, WO_IN = 33 * MiB, WO_MKV = 51 * MiB, WO_BR = 55 * MiB, WO_OUT = 61 * MiB;
constexpr size_t WS_XN = 80 * MiB;
constexpr size_t WS_RSTD = 4 * MiB + 512 * 1024;
constexpr size_t WS_BIG = 144 * MiB;
constexpr size_t WS_HID = WS_BIG, WS_F = WS_BIG + 176 * MiB, WS_Z = WS_BIG, WS_ZT = WS_BIG + 224 * MiB;
constexpr size_t WS_ST = 432 * MiB;
constexpr size_t WS_KC = 496 * MiB;
constexpr size_t WS_END = 512 * MiB;

constexpr int LDS_BYTES = 147456;
constexpr int RING_BYTES = 131072;
constexpr int MISC_OFF = RING_BYTES + 320;

typedef float f32x2_t __attribute__((ext_vector_type(2))); typedef __bf16 bf16x2_t __attribute__((ext_vector_type(2)));
__device__ __forceinline__ unsigned pk2(float lo, float hi) { f32x2_t v = {lo, hi}; bf16x2_t b = __builtin_convertvector(v, bf16x2_t); return __builtin_bit_cast(unsigned, b); }
__device__ __forceinline__ unsigned f2bf(float f) { return pk2(f, 0.f) & 0xffffu; }
__device__ __forceinline__ float bflo(unsigned w) { return __uint_as_float(w << 16); }
__device__ __forceinline__ float bfhi(unsigned w) { return __uint_as_float(w & 0xffff0000u); }
__device__ __forceinline__ float bf1(bf16 b) { return __uint_as_float((unsigned)b << 16); }
__device__ __forceinline__ float wave_sum(float v) {
#pragma unroll
    for (int o = 1; o < 64; o <<= 1) v += __shfl_xor(v, o);
    return v;
}
__device__ __forceinline__ float sigmoidf_(float x) { return __builtin_amdgcn_rcpf(1.f + __expf(-x)); }
__device__ __forceinline__ float siluf_(float x) { return x * __builtin_amdgcn_rcpf(1.f + __expf(-x)); }
__device__ __forceinline__ float gelu_tanh(float x) { const float u = 1.5957691216f * (x + 0.044715f * x * x * x); return x * __builtin_amdgcn_rcpf(1.f + __expf(-u)); }
__device__ __forceinline__ float logsigmoidf_(float x) { return fminf(x, 0.f) - log1pf(__expf(-fabsf(x))); }
#define LDS_WAIT() asm volatile("s_waitcnt lgkmcnt(0)" ::: "memory")
#define VM_WAIT() asm volatile("s_waitcnt vmcnt(0)" ::: "memory")

namespace pg8 {
constexpr int BM = 256, BK = 64, HALF = 128, HTB = HALF * BK * 2, STAGE_BYTES = 8 * HTB, NXCD = 8, WGM = 8;
__host__ __device__ __forceinline__ int lds_byte(int r, int c) { const int st = (r >> 4) * 2 + (c >> 5), rr = r & 15, cc = c & 31, ob = rr * 64 + cc * 2; return st * 1024 + (ob ^ (((ob >> 9) & 1) << 5)); }
__host__ __device__ __forceinline__ void stage_rc(int b, int& R, int& C) { const int st = b / 1024, sb = b % 1024, swz = sb ^ (((sb >> 9) & 1) << 5); R = (st >> 1) * 16 + swz / 64; C = (st & 1) * 32 + (swz % 64) / 2; }
__host__ __device__ __forceinline__ int perm32(int rho) { const int n = rho >> 4, i = rho & 15; return 8 * (i >> 2) + 4 * n + (i & 3); }

struct Unit { int pm, pn, aux; const char* a; const char* b; };
struct Gemm { int K, lda, ldb; };

struct TileSched {
    int nM, nN, nwg, G, c, reps, pm_per_b;
    const char* A; const char* B;
    size_t a_tile, a_pn, a_rep, b_tile, b_batch, b_rep;
    __device__ __forceinline__ void init(int nM_, int nN_, int G_, int c_, const void* A_, size_t lda_bytes, const void* B_, size_t ldb_bytes) {
        nM = nM_; nN = nN_; nwg = nM * nN; G = G_; c = c_; reps = 1; pm_per_b = 1 << 30; A = (const char*)A_; B = (const char*)B_;
        a_tile = 256 * lda_bytes; a_pn = 0; a_rep = 0; b_tile = 256 * ldb_bytes; b_batch = 0; b_rep = 0;
    }
    __device__ __forceinline__ bool next(int i, Unit& u) const {
        const int ti = i / reps, aux = i - ti * reps;
        const long L = (long)ti * G + c; if (L >= nwg) return false;
        int wgid = (int)L; { const int q = nwg / NXCD, r = nwg % NXCD, xcd = wgid % NXCD, off = wgid / NXCD; wgid = (xcd < r ? xcd * (q + 1) : r * (q + 1) + (xcd - r) * q) + off; }
        const int nig = WGM * nN, gid = wgid / nig, fm = gid * WGM, gsz = (nM - fm) < WGM ? (nM - fm) : WGM;
        u.pm = fm + ((wgid % nig) % gsz); u.pn = (wgid % nig) / gsz; u.aux = aux;
        u.a = A + (size_t)u.pm * a_tile + (size_t)u.pn * a_pn + (size_t)aux * a_rep;
        u.b = B + (size_t)u.pn * b_tile + (size_t)(u.pm / pm_per_b) * b_batch + (size_t)aux * b_rep;
        return true;
    }
};

__device__ __forceinline__ unsigned cvt_pk_bf16(float lo, float hi) { return pk2(lo, hi); }

template <int ACT> __device__ __forceinline__ float actf(float x) {
    if (ACT == 1) return sigmoidf_(x);
    if (ACT == 2) return gelu_tanh(x);
    if (ACT == 3) return x * 0.0625f;
    return x;
}
template <int ACT> __device__ __forceinline__ void store_tile_bf16(const f32x4 (&acc)[2][2][4][2], bf16* O, size_t ldc, int row0, int col0, const float* rsrow, const float* rscol) {
    f32x4 cs[2][2];
#pragma unroll
    for (int bj = 0; bj < 2; ++bj)
#pragma unroll
        for (int n = 0; n < 2; ++n) cs[bj][n] = rscol ? *(const f32x4*)(rscol + col0 + bj * HALF + 4 * n) : (f32x4){1.f, 1.f, 1.f, 1.f};
#pragma unroll
    for (int ai = 0; ai < 2; ++ai)
#pragma unroll
        for (int m = 0; m < 4; ++m) { const int row = row0 + ai * HALF + m * 16; bf16* rowp = O + (size_t)row * ldc + col0; const float rr = rsrow ? rsrow[row] : 1.f;
#pragma unroll
            for (int bj = 0; bj < 2; ++bj) { const f32x4 v0 = acc[ai][bj][m][0] * cs[bj][0] * rr, v1 = acc[ai][bj][m][1] * cs[bj][1] * rr; u32x4 w;
                w.x = cvt_pk_bf16(actf<ACT>(v0[0]), actf<ACT>(v0[1])); w.y = cvt_pk_bf16(actf<ACT>(v0[2]), actf<ACT>(v0[3]));
                w.z = cvt_pk_bf16(actf<ACT>(v1[0]), actf<ACT>(v1[1])); w.w = cvt_pk_bf16(actf<ACT>(v1[2]), actf<ACT>(v1[3]));
                *(u32x4*)(rowp + bj * HALF) = w; } }
}
struct EpiAct {
    static constexpr bool PERM = true;
    bf16* O; size_t ldc; int mode; const float* rsrow; const float* rscol;
    __device__ __forceinline__ void operator()(const f32x4 (&acc)[2][2][4][2], const Unit& u, int wr, int wc, int fr, int fq) const {
        const int row0 = u.pm * BM + wr * 64 + fr, col0 = u.pn * BM + wc * 32 + 8 * fq;
        int act = 0;
        if (mode == 1) { const int g = u.pn >> 2; act = (g == 0) ? 0 : (g == 1) ? 1 : (g == 2) ? 2 : (g == 3) ? 3 : 1; }
        else if (mode == 2) act = (u.pm >= 4) ? 2 : 0;
        if (act == 0) store_tile_bf16<0>(acc, O, ldc, row0, col0, rsrow, rscol);
        else if (act == 1) store_tile_bf16<1>(acc, O, ldc, row0, col0, rsrow, rscol);
        else if (act == 2) store_tile_bf16<2>(acc, O, ldc, row0, col0, rsrow, rscol);
        else store_tile_bf16<3>(acc, O, ldc, row0, col0, rsrow, rscol);
    }
};
struct EpiGU {
    static constexpr bool PERM = true;
    bf16* O; const float* rsrow;
    __device__ __forceinline__ void operator()(const f32x4 (&acc)[2][2][4][2], const Unit& u, int wr, int wc, int fr, int fq) const {
        const int row0 = u.pm * BM + wr * 64 + fr, col0 = u.pn * HALF + wc * 32 + 8 * fq;
#pragma unroll
        for (int ai = 0; ai < 2; ++ai)
#pragma unroll
            for (int m = 0; m < 4; ++m) { const int row = row0 + ai * HALF + m * 16; bf16* rowp = O + (size_t)row * DFF + col0; const float rr = rsrow[row];
                const f32x4 g0 = acc[ai][0][m][0] * rr, g1 = acc[ai][0][m][1] * rr, u0 = acc[ai][1][m][0] * rr, u1 = acc[ai][1][m][1] * rr; u32x4 w;
                w.x = cvt_pk_bf16(siluf_(g0[0]) * u0[0], siluf_(g0[1]) * u0[1]); w.y = cvt_pk_bf16(siluf_(g0[2]) * u0[2], siluf_(g0[3]) * u0[3]);
                w.z = cvt_pk_bf16(siluf_(g1[0]) * u1[0], siluf_(g1[1]) * u1[1]); w.w = cvt_pk_bf16(siluf_(g1[2]) * u1[2], siluf_(g1[3]) * u1[3]);
                *(u32x4*)rowp = w; }
    }
};
struct EpiBranch {
    static constexpr bool PERM = true;
    bf16* Zb;
    __device__ __forceinline__ void operator()(const f32x4 (&acc)[2][2][4][2], const Unit& u, int wr, int wc, int fr, int fq) const {
        const int row0 = u.pm * BM + wr * 64 + fr, col0 = u.pn * BM + wc * 32 + 8 * fq; const int j = u.aux;
#pragma unroll
        for (int ai = 0; ai < 2; ++ai)
#pragma unroll
            for (int m = 0; m < 4; ++m) { bf16* rowp = Zb + (size_t)(row0 + ai * HALF + m * 16) * ZLD + col0;
#pragma unroll
                for (int bj = 0; bj < 2; ++bj) { const f32x4 v0 = acc[ai][bj][m][0], v1 = acc[ai][bj][m][1];
                    const u32x4 g = *(const u32x4*)(rowp + ZC_G + j * 1024 + bj * HALF);
                    float o[8] = { v0[0] * bflo(g.x), v0[1] * bfhi(g.x), v0[2] * bflo(g.y), v0[3] * bfhi(g.y), v1[0] * bflo(g.z), v1[1] * bfhi(g.z), v1[2] * bflo(g.w), v1[3] * bfhi(g.w) };
                    if (j > 0) { const u32x4 p = *(const u32x4*)(rowp + ZC_QK + bj * HALF);
                        o[0] += bflo(p.x); o[1] += bfhi(p.x); o[2] += bflo(p.y); o[3] += bfhi(p.y); o[4] += bflo(p.z); o[5] += bfhi(p.z); o[6] += bflo(p.w); o[7] += bfhi(p.w); }
                    u32x4 w; w.x = cvt_pk_bf16(o[0], o[1]); w.y = cvt_pk_bf16(o[2], o[3]); w.z = cvt_pk_bf16(o[4], o[5]); w.w = cvt_pk_bf16(o[6], o[7]);
                    *(u32x4*)(rowp + ZC_QK + bj * HALF) = w; } }
    }
};

template <class Epi, class Sched>
__device__ __forceinline__ void gemm_phase(LAS unsigned char* lds, const Gemm g, const Sched& S, const Epi& E, const int tid) {
    const int wid = __builtin_amdgcn_readfirstlane(tid >> 6), lane = tid & 63, wr = wid >> 2, wc = wid & 3, fr = lane & 15, fq = lane >> 4;
    const int nt = g.K / BK;
    unsigned voffA[2], voffB[2];
#pragma unroll
    for (int i = 0; i < 2; ++i) { int R, C; stage_rc(tid * 16 + i * 8192, R, C); const int Rb = Epi::PERM ? ((R & ~31) + perm32(R & 31)) : R;
        voffA[i] = (unsigned)(R * g.lda + C) * 2u; voffB[i] = (unsigned)(Rb * g.ldb + C) * 2u; }
    const size_t kstep = (size_t)(BK * 2);
    const size_t hstepA = (size_t)HALF * g.lda * 2, hstepB = (size_t)HALF * g.ldb * 2;
    const unsigned ldsw = (unsigned)wid * 1024u;
    const int aoff = lds_byte(wr * 64 + fr, fq * 8), boff = lds_byte(wc * 32 + fr, fq * 8);
#define PG8_SA(b, h) (((b) * 2 + (h)) * HTB)
#define PG8_SB(b, h) ((4 + (b) * 2 + (h)) * HTB)
#define PG8_STAGE(bufoff, gbase, voff) do { _Pragma("unroll") for (int _i = 0; _i < 2; ++_i) \
        __builtin_amdgcn_global_load_lds((const unsigned*)((const char*)(gbase) + (voff)[_i]), (LAS unsigned*)(lds + (bufoff) + ldsw + _i * 8192), 16, 0, 0); } while (0)
#define PG8_LDA(dst, b, h) do { _Pragma("unroll") for (int m = 0; m < 4; ++m) _Pragma("unroll") for (int k = 0; k < 2; ++k) dst[m][k] = *(const LAS bf16x8*)(lds + PG8_SA(b, h) + aoff + m * 2048 + k * 1024); } while (0)
#define PG8_LDB(dst, b, h) do { _Pragma("unroll") for (int n = 0; n < 2; ++n) _Pragma("unroll") for (int k = 0; k < 2; ++k) dst[n][k] = *(const LAS bf16x8*)(lds + PG8_SB(b, h) + boff + n * 2048 + k * 1024); } while (0)
#define PG8_MMA(ai, bj, At, Bt) do { __builtin_amdgcn_s_setprio(1); _Pragma("unroll") for (int m = 0; m < 4; ++m) _Pragma("unroll") for (int n = 0; n < 2; ++n) _Pragma("unroll") for (int k = 0; k < 2; ++k) \
        acc[ai][bj][m][n] = __builtin_amdgcn_mfma_f32_16x16x32_bf16(Bt[n][k], At[m][k], acc[ai][bj][m][n], 0, 0, 0); __builtin_amdgcn_s_setprio(0); } while (0)
#define PG8_WAIT_V(n) asm volatile("s_waitcnt vmcnt(" #n ")" ::: "memory")
#define PG8_WAIT_L(n) asm volatile("s_waitcnt lgkmcnt(" #n ")" ::: "memory")
#define PG8_BAR __builtin_amdgcn_s_barrier()
#define PG8_SCHED __builtin_amdgcn_sched_barrier(0)
    Unit cur, nxt; int ui = 0;
    if (!S.next(0, cur)) return;
    f32x4 acc[2][2][4][2];
#pragma unroll
    for (int a = 0; a < 2; ++a)
#pragma unroll
        for (int b = 0; b < 2; ++b)
#pragma unroll
            for (int m = 0; m < 4; ++m)
#pragma unroll
                for (int n = 0; n < 2; ++n) acc[a][b][m][n] = (f32x4){0.f, 0.f, 0.f, 0.f};
    bf16x8 At[4][2], B0[2][2], B1[2][2];
    const char* cA = cur.a; const char* cB = cur.b;
    PG8_STAGE(PG8_SB(0, 0), cB, voffB); PG8_STAGE(PG8_SB(0, 1), cB + hstepB, voffB); PG8_STAGE(PG8_SA(0, 0), cA, voffA); PG8_STAGE(PG8_SA(0, 1), cA + hstepA, voffA);
    if (wr == 1) PG8_BAR;
    PG8_WAIT_V(2); PG8_BAR;
    PG8_STAGE(PG8_SB(1, 0), cB + kstep, voffB); PG8_STAGE(PG8_SA(1, 0), cA + kstep, voffA); PG8_STAGE(PG8_SB(1, 1), cB + hstepB + kstep, voffB);
    PG8_WAIT_V(6); PG8_BAR;
    for (;;) {
        const bool has_next = S.next(ui + 1, nxt);
        const char* nA = has_next ? nxt.a : cA; const char* nB = has_next ? nxt.b : cB;
        for (int t = 0; t < nt; t += 2) {
            const bool last = (t == nt - 2);
            const char* a1 = cA + (size_t)(t + 1) * kstep;
            const char* a2 = last ? nA : cA + (size_t)(t + 2) * kstep; const char* b2 = last ? nB : cB + (size_t)(t + 2) * kstep;
            const char* a3 = a2 + kstep; const char* b3 = b2 + kstep;
            PG8_LDB(B0, 0, 0); PG8_LDB(B1, 0, 1); PG8_SCHED; PG8_LDA(At, 0, 0); PG8_STAGE(PG8_SA(1, 1), a1 + hstepA, voffA);
            PG8_WAIT_V(8); PG8_WAIT_L(0); PG8_BAR; PG8_MMA(0, 0, At, B0); PG8_MMA(0, 1, At, B1); PG8_BAR; PG8_SCHED;
            PG8_LDA(At, 0, 1); PG8_STAGE(PG8_SB(0, 0), b2, voffB); PG8_STAGE(PG8_SB(0, 1), b2 + hstepB, voffB); PG8_STAGE(PG8_SA(0, 0), a2, voffA);
            PG8_WAIT_V(8); PG8_WAIT_L(0); PG8_BAR; PG8_MMA(1, 0, At, B0); PG8_MMA(1, 1, At, B1); PG8_BAR; PG8_SCHED;
            PG8_LDB(B0, 1, 0); PG8_LDB(B1, 1, 1); PG8_SCHED; PG8_LDA(At, 1, 0); PG8_STAGE(PG8_SA(0, 1), a2 + hstepA, voffA);
            PG8_WAIT_V(8); PG8_WAIT_L(0); PG8_BAR; PG8_MMA(0, 0, At, B0); PG8_MMA(0, 1, At, B1); PG8_BAR; PG8_SCHED;
            PG8_LDA(At, 1, 1); PG8_STAGE(PG8_SB(1, 0), b3, voffB); PG8_STAGE(PG8_SB(1, 1), b3 + hstepB, voffB); PG8_STAGE(PG8_SA(1, 0), a3, voffA);
            PG8_WAIT_V(8); PG8_WAIT_L(0); PG8_BAR; PG8_MMA(1, 0, At, B0); PG8_MMA(1, 1, At, B1); PG8_BAR; PG8_SCHED;
        }
        if (wr == 0) PG8_BAR;
        E(acc, cur, wr, wc, fr, fq);
        if (!has_next) break;
#pragma unroll
        for (int a = 0; a < 2; ++a)
#pragma unroll
            for (int b = 0; b < 2; ++b)
#pragma unroll
                for (int m = 0; m < 4; ++m)
#pragma unroll
                    for (int n = 0; n < 2; ++n) acc[a][b][m][n] = (f32x4){0.f, 0.f, 0.f, 0.f};
        cur = nxt; cA = nA; cB = nB; ++ui;
        if (wr == 1) PG8_BAR;
    }
    PG8_WAIT_V(0);
    PG8_BAR;
#undef PG8_SA
#undef PG8_SB
#undef PG8_STAGE
#undef PG8_LDA
#undef PG8_LDB
#undef PG8_MMA
#undef PG8_WAIT_V
#undef PG8_WAIT_L
#undef PG8_BAR
#undef PG8_SCHED
}
}

#define XB_TMO      128
#define XB_XCNT(j)  (256  + 64 * (j))
#define XB_XSUB(j)  (1280 + 64 * (j))
#define XB_XGEN(j)  (2304 + 64 * (j))
#define XB_TOP      3328
#define XB_TOPGEN   3392
#define XCD_BAR_WORDS 3456
#define XB_SPIN_CAP (1u << 18)
__device__ __forceinline__ unsigned xb_ld(unsigned* p)              { return __hip_atomic_load(p, __ATOMIC_RELAXED, __HIP_MEMORY_SCOPE_AGENT); }
__device__ __forceinline__ unsigned xb_add(unsigned* p, unsigned v) { return __hip_atomic_fetch_add(p, v, __ATOMIC_RELAXED, __HIP_MEMORY_SCOPE_AGENT); }
__device__ __forceinline__ unsigned xb_xcc_id() { return (unsigned)__builtin_amdgcn_s_getreg((3 << 11) | 20) & 0xFu; }
#define XB_SPIN(cond, bar) do { unsigned _sp = 0; while (cond) { __builtin_amdgcn_s_sleep(1); \
    if ((++_sp & 255u) == 0u) { if (xb_ld(&(bar)[XB_TMO])) break; if (_sp > XB_SPIN_CAP) { atomicAdd(&(bar)[XB_TMO], 1u); break; } } } } while (0)
struct XcdBarrier { unsigned* bar; unsigned x; volatile LAS unsigned* st; };
__device__ __forceinline__ XcdBarrier xcd_barrier_post(unsigned* bar, volatile LAS unsigned* st) {
    XcdBarrier b; b.bar = bar; b.x = xb_xcc_id(); b.st = st;
    if (threadIdx.x == 0) (void)xb_add(&bar[XB_XCNT(b.x)], 1u);
    return b;
}
__device__ __forceinline__ void xcd_barrier_complete(unsigned* bar, unsigned x, unsigned& nloc, unsigned& nx) {
    const unsigned G = gridDim.x * gridDim.y * gridDim.z;
    unsigned sum, cnt, mine, sp = 0u;
    for (;;) {
        sum = 0u; cnt = 0u; mine = 0u;
#pragma unroll
        for (unsigned j = 0; j < 16; ++j) { const unsigned c = xb_ld(&bar[XB_XCNT(j)]); sum += c; cnt += (c > 0u) ? 1u : 0u; mine = (j == x) ? c : mine; }
        if (sum == G) break;
        __builtin_amdgcn_s_sleep(1);
        if ((++sp & 255u) == 0u) { if (xb_ld(&bar[XB_TMO])) break; if (sp > XB_SPIN_CAP) { atomicAdd(&bar[XB_TMO], 1u); break; } }
    }
    nloc = mine > 0u ? mine : 1u; nx = cnt > 0u ? cnt : 1u;
}
__device__ __forceinline__ void xcd_barrier(const XcdBarrier& b) {
    asm volatile("s_waitcnt vmcnt(0)" ::: "memory");
    __syncthreads();
    if (threadIdx.x == 0) {
        unsigned* bar = b.bar;
        __builtin_amdgcn_s_waitcnt(0);
        unsigned nloc = b.st[0], nx = b.st[1];
        if (nloc == 0u) { xcd_barrier_complete(bar, b.x, nloc, nx); b.st[0] = nloc; b.st[1] = nx; }
        const unsigned old = xb_add(&bar[XB_XSUB(b.x)], 1u);
        const unsigned gen = old / nloc;
        if (old + 1u == (gen + 1u) * nloc) {
            __builtin_amdgcn_fence(__ATOMIC_RELEASE, "agent");
            asm volatile("s_waitcnt vmcnt(0)" ::: "memory");
            const unsigned og = xb_add(&bar[XB_TOP], 1u);
            const unsigned tg = og / nx;
            if (og + 1u == (tg + 1u) * nx) xb_add(&bar[XB_TOPGEN], 1u);
            else XB_SPIN(xb_ld(&bar[XB_TOPGEN]) == tg, bar);
            __builtin_amdgcn_fence(__ATOMIC_ACQUIRE, "agent");
            xb_add(&bar[XB_XGEN(b.x)], 1u);
            asm volatile("s_waitcnt vmcnt(0)" ::: "memory");
        } else {
            XB_SPIN(xb_ld(&bar[XB_XGEN(b.x)]) == gen, bar);
            __builtin_amdgcn_fence(__ATOMIC_ACQUIRE, "agent");
            asm volatile("s_waitcnt vmcnt(0)" ::: "memory");
        }
    }
    __syncthreads();
}

struct Args { const float* in[18]; float* out; unsigned char* ws; int ph_lo, ph_hi; };
enum { I_X = 0, I_MEM, I_NORMG, I_WGU, I_WDOWN, I_WIN, I_CONVW, I_CONVB, I_BI, I_BF, I_MNORM, I_SLNG, I_SLNB, I_SWS, I_SBS, I_WMKV, I_WBR, I_WOUT };

__device__ __forceinline__ void cvt_item(const float* W, int Nsrc, int K, int srccol, bf16* WT, int dstrow, int kb, LAS float* scr, int lane, const float* gk = nullptr) {
    const int k0 = 64 * kb;
    if ((srccol & 3) == 0) {
        const int c4 = (lane & 7) * 4, rr = lane >> 3;
#pragma unroll
        for (int i = 0; i < 8; ++i) { const int kk = 8 * i + rr; f32x4 x = *(const f32x4*)(W + (size_t)(k0 + kk) * Nsrc + srccol + c4); if (gk) x = x * gk[k0 + kk];
            LAS float* d = scr + kk * 33 + c4; d[0] = x.x; d[1] = x.y; d[2] = x.z; d[3] = x.w; }
    } else {
#pragma unroll 8
        for (int i = 0; i < 32; ++i) { const int kk = 2 * i + (lane >> 5); scr[kk * 33 + (lane & 31)] = W[(size_t)(k0 + kk) * Nsrc + srccol + (lane & 31)] * (gk ? gk[k0 + kk] : 1.f); }
    }
    LDS_WAIT(); asm volatile("" ::: "memory");
    const int c = lane & 7;
#pragma unroll
    for (int j = 0; j < 4; ++j) { const int n = (lane >> 3) + 8 * j; const LAS float* s = scr + (8 * c) * 33 + n;
        u32x4 o; o.x = pk2(s[0 * 33], s[1 * 33]); o.y = pk2(s[2 * 33], s[3 * 33]); o.z = pk2(s[4 * 33], s[5 * 33]); o.w = pk2(s[6 * 33], s[7 * 33]);
        *(u32x4*)(WT + (size_t)(dstrow + n) * K + k0 + 8 * c) = o; }
    LDS_WAIT(); asm volatile("" ::: "memory");
}
__device__ __forceinline__ int win_srccol(int r) {
    if (r < 1024) return r;
    if (r < 2048) return 2048 + (r - 1024);
    if (r < 3072) return 3080 + (r - 2048);
    if (r < 4096) return 5128 + (r - 3072);
    if (r < 7168) return 6152 + (r - 4096);
    if (r < 8192) return 1024 + (r - 7168);
    return 4104 + (r - 8192);
}
__device__ __forceinline__ void convert_layer(const Args& a, int l, unsigned char* ws, LAS unsigned char* lds, int gw, int NGW, int wave, int lane, int gtid, int GT) {
    LAS float* scr = (LAS float*)(lds + wave * 16384);
    bf16* Wb = (bf16*)(ws + WS_W);
    constexpr int I_GU = 16 * 176, I_DN = 44 * 32, I_IN = 16 * 288, I_MKV = 16 * 64, I_BR = 16 * 32, I_OUT = 16 * 32;
    constexpr int NITEMS = 2 * I_GU + 2 * I_DN + I_IN + I_MKV + 3 * I_BR + I_OUT;
    for (int it = gw; it < NITEMS; it += NGW) {
        int r = it;
        if (r < 2 * I_GU) { const int j = r / I_GU; r -= j * I_GU; const int kb = r / 176, nb = r % 176; const int p = nb >> 3, q = nb & 7, s = q >> 2, jj = (q & 3) * 32;
            cvt_item(a.in[I_WGU] + (size_t)(l * 2 + j) * D * 2 * DFF, 2 * DFF, D, s * DFF + 128 * p + jj, (bf16*)((char*)Wb + (j ? WO_GU1 : WO_GU0)), nb * 32, kb, scr, lane, a.in[I_NORMG] + (size_t)(l * NNORM + (j ? 4 : 0)) * D); continue; }
        r -= 2 * I_GU;
        if (r < 2 * I_DN) { const int j = r / I_DN; r -= j * I_DN; const int kb = r / 32, nb = r % 32;
            cvt_item(a.in[I_WDOWN] + (size_t)(l * 2 + j) * DFF * D, D, DFF, nb * 32, (bf16*)((char*)Wb + (j ? WO_D1 : WO_D0)), nb * 32, kb, scr, lane); continue; }
        r -= 2 * I_DN;
        if (r < I_IN) { const int kb = r / 288, nb = r % 288;
            cvt_item(a.in[I_WIN] + (size_t)l * D * WIN_COLS, WIN_COLS, D, win_srccol(nb * 32), (bf16*)((char*)Wb + WO_IN), nb * 32, kb, scr, lane, a.in[I_NORMG] + (size_t)(l * NNORM + 2) * D); continue; }
        r -= I_IN;
        if (r < I_MKV) { const int kb = r / 64, nb = r % 64;
            cvt_item(a.in[I_WMKV] + (size_t)l * D * 2048, 2048, D, nb * 32, (bf16*)((char*)Wb + WO_MKV), nb * 32, kb, scr, lane); continue; }
        r -= I_MKV;
        if (r < 3 * I_BR) { const int j = r / I_BR; r -= j * I_BR; const int kb = r / 32, nb = r % 32;
            cvt_item(a.in[I_WBR] + (size_t)(l * 3 + j) * D * D, D, D, nb * 32, (bf16*)((char*)Wb + WO_BR) + (size_t)j * D * D, nb * 32, kb, scr, lane); continue; }
        r -= 3 * I_BR;
        { const int kb = r / 32, nb = r % 32; cvt_item(a.in[I_WOUT] + (size_t)l * D * D, D, D, nb * 32, (bf16*)((char*)Wb + WO_OUT), nb * 32, kb, scr, lane); }
    }
    bf16* wsg = (bf16*)(ws + WS_WSGU); const float* src = a.in[I_SWS] + (size_t)l * 4 * 128 * 128;
    for (int e = gtid; e < 4 * 128 * 128; e += GT) { const int t = (e >> 7) & 127, s = e & 127; wsg[e] = (bf16)f2bf(s <= t ? src[e] : 0.f); }
    const float* g6 = a.in[I_NORMG] + (size_t)(l * NNORM + 6) * D;
    for (int m = gw; m < MMEM; m += NGW) {
        const f32x4* xr = (const f32x4*)(a.in[I_MEM] + (size_t)m * D) + lane; f32x4 v[4]; float s = 0.f;
#pragma unroll
        for (int j = 0; j < 4; ++j) { v[j] = xr[64 * j]; s += (v[j].x * v[j].x + v[j].y * v[j].y) + (v[j].z * v[j].z + v[j].w * v[j].w); }
        const float rstd = rsqrtf(wave_sum(s) * (1.f / D) + EPS);
        unsigned long long* o8 = (unsigned long long*)((bf16*)(ws + WS_MEMN) + (size_t)m * D) + lane;
#pragma unroll
        for (int j = 0; j < 4; ++j) { const f32x4 gg = ((const f32x4*)g6)[lane + 64 * j];
            o8[64 * j] = (unsigned long long)pk2(v[j].x * rstd * gg.x, v[j].y * rstd * gg.y) | ((unsigned long long)pk2(v[j].z * rstd * gg.z, v[j].w * rstd * gg.w) << 32); }
    }
}

__device__ __forceinline__ void thin_rows(const bf16* fbase, size_t fld, const float* ga, float scale, const float* hin32, const bf16* hinb, bf16* hb_out, float* rstd_out, float* out32,
                                          int row_lo, int row_hi, int gw, int NGW, int lane, const bool do_gates, const LAS float* wif, const float* bi, const float* bfg, float* gate_i, float* gate_f) {
    for (int m = row_lo + gw; m < row_hi; m += NGW) {
        f32x4 v[4];
        if (hin32) { const f32x4* hr = (const f32x4*)(hin32 + (size_t)m * D) + lane;
#pragma unroll
            for (int j = 0; j < 4; ++j) v[j] = hr[64 * j]; }
        else { const unsigned long long* hr = (const unsigned long long*)(hinb + (size_t)m * D) + lane;
#pragma unroll
            for (int j = 0; j < 4; ++j) { const unsigned long long w = hr[64 * j]; const unsigned lo = (unsigned)w, hi = (unsigned)(w >> 32); v[j] = (f32x4){bflo(lo), bfhi(lo), bflo(hi), bfhi(hi)}; } }
        if (fbase) {
            const unsigned long long* fr = (const unsigned long long*)(fbase + (size_t)(m - row_lo) * fld) + lane; float s = 0.f; f32x4 f[4];
#pragma unroll
            for (int j = 0; j < 4; ++j) { const unsigned long long w = fr[64 * j]; const unsigned lo = (unsigned)w, hi = (unsigned)(w >> 32);
                f[j] = (f32x4){bflo(lo), bfhi(lo), bflo(hi), bfhi(hi)}; s += (f[j].x * f[j].x + f[j].y * f[j].y) + (f[j].z * f[j].z + f[j].w * f[j].w); }
            const float rstd = rsqrtf(wave_sum(s) * (1.f / D) + EPS) * scale;
#pragma unroll
            for (int j = 0; j < 4; ++j) { const f32x4 gg = ((const f32x4*)ga)[lane + 64 * j]; v[j] = v[j] + f[j] * rstd * gg; }
        }
        if (out32) { f32x4* ho = (f32x4*)(out32 + (size_t)m * D) + lane;
#pragma unroll
            for (int j = 0; j < 4; ++j) ho[64 * j] = v[j]; }
        if (hb_out) {
            float s = 0.f;
#pragma unroll
            for (int j = 0; j < 4; ++j) s += (v[j].x * v[j].x + v[j].y * v[j].y) + (v[j].z * v[j].z + v[j].w * v[j].w);
            const float rstd = rsqrtf(wave_sum(s) * (1.f / D) + EPS);
            unsigned long long* o8 = (unsigned long long*)(hb_out + (size_t)m * D) + lane;
#pragma unroll
            for (int j = 0; j < 4; ++j) o8[64 * j] = (unsigned long long)pk2(v[j].x, v[j].y) | ((unsigned long long)pk2(v[j].z, v[j].w) << 32);
            if (lane == 0) rstd_out[m] = rstd;
            if (do_gates) {
                float acc[8];
#pragma unroll
                for (int e = 0; e < 8; ++e) acc[e] = 0.f;
#pragma unroll
                for (int j = 0; j < 4; ++j)
#pragma unroll
                    for (int q = 0; q < 4; ++q) { const int k = 4 * lane + 256 * j + q; const float xv = v[j][q]; const LAS f32x4* wp = (const LAS f32x4*)(wif + k * 8); const f32x4 w0 = wp[0], w1 = wp[1];
                        acc[0] += xv * w0.x; acc[1] += xv * w0.y; acc[2] += xv * w0.z; acc[3] += xv * w0.w; acc[4] += xv * w1.x; acc[5] += xv * w1.y; acc[6] += xv * w1.z; acc[7] += xv * w1.w; }
                {
                    float b4[4], b2[2], b1;
#pragma unroll
                    for (int e = 0; e < 4; ++e) { const float mine = (lane & 4) ? acc[4 + e] : acc[e], send = (lane & 4) ? acc[e] : acc[4 + e]; b4[e] = mine + __shfl_xor(send, 4); }
#pragma unroll
                    for (int e = 0; e < 2; ++e) { const float mine = (lane & 2) ? b4[2 + e] : b4[e], send = (lane & 2) ? b4[e] : b4[2 + e]; b2[e] = mine + __shfl_xor(send, 2); }
                    { const float mine = (lane & 1) ? b2[1] : b2[0], send = (lane & 1) ? b2[0] : b2[1]; b1 = mine + __shfl_xor(send, 1); }
                    b1 += __shfl_xor(b1, 8); b1 += __shfl_xor(b1, 16); b1 += __shfl_xor(b1, 32);
                    const float val = b1 * rstd;
                    if (lane < 4) gate_i[(size_t)m * 4 + lane] = val + bi[lane];
                    else if (lane < 8) gate_f[(size_t)m * 4 + lane - 4] = logsigmoidf_(val + bfg[lane - 4]);
                }
            }
        }
    }
}

__device__ __forceinline__ void conv8(const bf16* Zb, int bl, int p, int col, const float* cw, const float* cb, float (&o)[8]) {
    const f32x4 b0 = *(const f32x4*)(cb + col), b1 = *(const f32x4*)(cb + col + 4);
    o[0] = b0.x; o[1] = b0.y; o[2] = b0.z; o[3] = b0.w; o[4] = b1.x; o[5] = b1.y; o[6] = b1.z; o[7] = b1.w;
#pragma unroll
    for (int j = 0; j < 4; ++j) { const int pp = p - 3 + j;
        if (pp >= 0) { const u32x4 x = *(const u32x4*)(Zb + (size_t)(bl * SEQ + pp) * ZLD + ZC_QK + col);
            const f32x4 w0 = *(const f32x4*)(cw + j * 1024 + col), w1 = *(const f32x4*)(cw + j * 1024 + col + 4);
            o[0] += w0.x * bflo(x.x); o[1] += w0.y * bfhi(x.x); o[2] += w0.z * bflo(x.y); o[3] += w0.w * bfhi(x.y);
            o[4] += w1.x * bflo(x.z); o[5] += w1.y * bfhi(x.z); o[6] += w1.z * bflo(x.w); o[7] += w1.w * bfhi(x.w); } }
#pragma unroll
    for (int e = 0; e < 8; ++e) o[e] = siluf_(o[e]);
}
__device__ __forceinline__ float wave_incl_scan_add(float v, int lane) {
#pragma unroll
    for (int o = 1; o < 64; o <<= 1) { const float t = __shfl_up(v, o); if (lane >= o) v += t; }
    return v;
}
__device__ __forceinline__ float wave_incl_scan_max(float v, int lane) {
#pragma unroll
    for (int o = 1; o < 64; o <<= 1) { const float t = __shfl_up(v, o); if (lane >= o) v = fmaxf(v, t); }
    return v;
}
__device__ __forceinline__ float wave_max(float v) {
#pragma unroll
    for (int o = 1; o < 64; o <<= 1) v = fmaxf(v, __shfl_xor(v, o));
    return v;
}
constexpr float KSCALE = 0.08838834764831845f;

__device__ __forceinline__ void conv_load(const bf16* Zb, int bl, int p, int col, u32x4 (&raw)[4]) {
#pragma unroll
    for (int j = 0; j < 4; ++j) { const int pp = p - 3 + j; raw[j] = (u32x4){0u, 0u, 0u, 0u};
        if (pp >= 0) raw[j] = *(const u32x4*)(Zb + (size_t)(bl * SEQ + pp) * ZLD + ZC_QK + col); }
}
__device__ __forceinline__ void conv_apply(const u32x4 (&raw)[4], const LAS float* wl, const int wstride, float (&o)[8]) {
    { const f32x4 b0 = *(const LAS f32x4*)(wl + 4 * wstride), b1 = *(const LAS f32x4*)(wl + 4 * wstride + 4);
      o[0] = b0.x; o[1] = b0.y; o[2] = b0.z; o[3] = b0.w; o[4] = b1.x; o[5] = b1.y; o[6] = b1.z; o[7] = b1.w; }
#pragma unroll
    for (int j = 0; j < 4; ++j) { const u32x4 x = raw[j];
        const f32x4 w0 = *(const LAS f32x4*)(wl + j * wstride), w1 = *(const LAS f32x4*)(wl + j * wstride + 4);
        o[0] += w0.x * bflo(x.x); o[1] += w0.y * bfhi(x.x); o[2] += w0.z * bflo(x.y); o[3] += w0.w * bfhi(x.y);
        o[4] += w1.x * bflo(x.z); o[5] += w1.y * bfhi(x.z); o[6] += w1.z * bflo(x.w); o[7] += w1.w * bfhi(x.w); }
#pragma unroll
    for (int e = 0; e < 8; ++e) o[e] = siluf_(o[e]);
}
__device__ __forceinline__ void stage_convw(LAS float* wl, const float* cw, const float* cb, int col0, int ncol, int dst0, int wstride, int tid) {
    for (int e = tid; e < 5 * ncol; e += NTHR) { const int j = e / ncol, cidx = e - j * ncol; wl[j * wstride + dst0 + cidx] = (j < 4) ? cw[j * 1024 + col0 + cidx] : cb[col0 + cidx]; }
}
__device__ __forceinline__ void mlstm_s1(const Args& a, int l, int hf, unsigned char* ws, LAS unsigned char* lds, int G, int cu, int tid, int wave, int lane) {
    const bf16* Zb = (const bf16*)(ws + WS_Z); const bf16* ZT = (const bf16*)(ws + WS_ZT);
    const float* gi = (const float*)(ws + WS_GATE); const float* gf = gi + (size_t)M * 4;
    const float* cw = a.in[I_CONVW] + (size_t)l * 4 * 1024; const float* cb = a.in[I_CONVB] + (size_t)l * 1024;
    LAS bf16* KT = (LAS bf16*)lds;
    LAS float* wv = (LAS float*)(lds + 18432);
    LAS float* CWL = (LAS float*)(lds + 18688);
    const int c8 = tid & 15; int hcur = -1;
    for (int u = cu; u < 16 * NCH; u += G) {
        const int h = u & 3, c = (u >> 2) & 63, bl = u >> 8, bhl = bl * 4 + h; const int tokg = (hf * 4 + bl) * SEQ + c * LCH;
        if (h != hcur) { __syncthreads(); stage_convw(CWL, cw, cb, 512 + h * 128, 128, 0, 128, tid); hcur = h; }
        const int r = lane & 31, hh = lane >> 5, v0 = 32 * wave;
        bf16x8 bfr[4];
        { const bf16* vrow = ZT + (size_t)(h * 256 + v0 + r) * ZTLD + bl * SEQ + c * LCH + 8 * hh;
#pragma unroll
          for (int ks = 0; ks < 4; ++ks) bfr[ks] = *(const bf16x8*)(vrow + 16 * ks); }
        u32x4 raw[2][4];
#pragma unroll
        for (int rep = 0; rep < 2; ++rep) conv_load(Zb, bl, c * LCH + ((tid + rep * NTHR) >> 4), 512 + h * 128 + c8 * 8, raw[rep]);
        if (wave == 0) {
            const float lf = gf[(size_t)(tokg + lane) * 4 + h], ii = gi[(size_t)(tokg + lane) * 4 + h];
            const float bc = wave_incl_scan_add(lf, lane); const float g = __shfl(bc, 63);
            const float av = g - bc + ii; const float ml = wave_max(av);
            wv[lane] = __expf(av - ml);
            if (lane == 0) { float* cs = (float*)(ws + WS_CSC) + (size_t)(bhl * NCH + c) * 4; cs[0] = g; cs[1] = ml; }
        }
        __syncthreads();
#pragma unroll
        for (int rep = 0; rep < 2; ++rep) { const int idx = tid + rep * NTHR, s = idx >> 4; float o[8];
            conv_apply(raw[rep], CWL + c8 * 8, 128, o); const float sc = wv[s] * KSCALE;
            { u32x4 w; w.x = pk2(o[0] * KSCALE, o[1] * KSCALE); w.y = pk2(o[2] * KSCALE, o[3] * KSCALE); w.z = pk2(o[4] * KSCALE, o[5] * KSCALE); w.w = pk2(o[6] * KSCALE, o[7] * KSCALE);
              *(u32x4*)((bf16*)(ws + WS_KC) + (size_t)(bl * SEQ + c * LCH + s) * 512 + h * 128 + c8 * 8) = w; }
#pragma unroll
            for (int e = 0; e < 8; ++e) KT[(c8 * 8 + e) * 72 + s] = (bf16)f2bf(o[e] * sc); }
        __syncthreads();
        if (tid < 128) { float s = 0.f;
#pragma unroll 8
            for (int k = 0; k < 64; ++k) s += bf1(KT[tid * 72 + k]);
            ((float*)(ws + WS_NST))[(size_t)(bhl * NCH + c) * 128 + tid] = s; }
        {
            bf16* st = (bf16*)(ws + WS_ST) + (size_t)(bhl * NCH + c) * 32768 + (size_t)(v0 + r) * 128;
#pragma unroll
            for (int db = 0; db < 4; ++db) { f32x16 acc;
#pragma unroll
                for (int e = 0; e < 16; ++e) acc[e] = 0.f;
#pragma unroll
                for (int ks = 0; ks < 4; ++ks) { const bf16x8 af = *(const LAS bf16x8*)(KT + (32 * db + r) * 72 + 16 * ks + 8 * hh); acc = __builtin_amdgcn_mfma_f32_32x32x16_bf16(af, bfr[ks], acc, 0, 0, 0); }
#pragma unroll
                for (int q = 0; q < 4; ++q) { u32x2 w; w.x = pk2(acc[4 * q], acc[4 * q + 1]); w.y = pk2(acc[4 * q + 2], acc[4 * q + 3]); *(u32x2*)(st + 32 * db + 8 * q + 4 * hh) = w; } }
        }
        __syncthreads();
    }
}
__device__ __forceinline__ void mlstm_s2(unsigned char* ws, int G, int cu, int tid) {
    for (int u = cu; u < 256; u += G) {
        const int bhl = u >> 4, part = u & 15; const size_t off = (size_t)(part * NTHR + tid) * 4;
        bf16* st = (bf16*)(ws + WS_ST) + (size_t)bhl * NCH * 32768 + off; float* ns = (float*)(ws + WS_NST) + (size_t)bhl * NCH * 128 + tid; float* cs = (float*)(ws + WS_CSC) + (size_t)bhl * NCH * 4;
        const bool nth = (part == 0 && tid < 128);
        float C[4]; float nv = 0.f, m = -1e30f;
#pragma unroll
        for (int e = 0; e < 4; ++e) C[e] = 0.f;
        for (int c0 = 0; c0 < NCH; c0 += 8) {
            u32x2 cl[8]; float nl[8], gg[8], ml[8];
#pragma unroll
            for (int i = 0; i < 8; ++i) { cl[i] = *(const u32x2*)(st + (size_t)(c0 + i) * 32768); nl[i] = nth ? ns[(c0 + i) * 128] : 0.f; gg[i] = cs[(c0 + i) * 4]; ml[i] = cs[(c0 + i) * 4 + 1]; }
#pragma unroll
            for (int i = 0; i < 8; ++i) {
                u32x2 o; o.x = pk2(C[0], C[1]); o.y = pk2(C[2], C[3]);
                *(u32x2*)(st + (size_t)(c0 + i) * 32768) = o;
                if (nth) ns[(c0 + i) * 128] = nv;
                if (part == 0 && tid == 0) cs[(c0 + i) * 4 + 2] = m;
                const float mn = fmaxf(gg[i] + m, ml[i]); const float dec = __expf(gg[i] + m - mn), sc = __expf(ml[i] - mn);
                C[0] = dec * C[0] + sc * bflo(cl[i].x); C[1] = dec * C[1] + sc * bfhi(cl[i].x); C[2] = dec * C[2] + sc * bflo(cl[i].y); C[3] = dec * C[3] + sc * bfhi(cl[i].y);
                nv = dec * nv + sc * nl[i]; m = mn;
            }
        }
    }
}
__device__ __forceinline__ void mlstm_s3(const Args& a, int l, int hf, unsigned char* ws, LAS unsigned char* lds, int G, int cu, int tid, int wave, int lane, const int out_col) {
    bf16* Zb = (bf16*)(ws + WS_Z); const bf16* ZT = (const bf16*)(ws + WS_ZT);
    const float* gi = (const float*)(ws + WS_GATE); const float* gf = gi + (size_t)M * 4;
    const float* cw = a.in[I_CONVW] + (size_t)l * 4 * 1024; const float* cb = a.in[I_CONVB] + (size_t)l * 1024;
    const float* gain = a.in[I_MNORM] + (size_t)l * 1024;
    LAS bf16* QS = (LAS bf16*)lds;
    LAS bf16* KS = (LAS bf16*)(lds + 17408);
    LAS bf16* SD = (LAS bf16*)(lds + 34816);
    LAS float* HB = (LAS float*)(lds + 44032);
    LAS float* SC = (LAS float*)(lds + 110592);
    LAS float* CWL = (LAS float*)(lds + 112384);
    const int c8 = tid & 15; int hcur = -1;
    for (int u = cu; u < 16 * NCH; u += G) {
        const int h = u & 3, c = (u >> 2) & 63, bl = u >> 8, bhl = bl * 4 + h; const int tokg = (hf * 4 + bl) * SEQ + c * LCH; const int tokl = bl * SEQ + c * LCH;
        if (h != hcur) { __syncthreads(); stage_convw(CWL, cw, cb, h * 128, 128, 0, 256, tid); hcur = h; __syncthreads(); }
        const int r = lane & 31, hh = lane >> 5, v0 = 32 * wave;
        bf16x8 bV[4], bC[8];
        { const bf16* vrow = ZT + (size_t)(h * 256 + v0 + r) * ZTLD + tokl + 8 * hh;
          const bf16* crow = (const bf16*)(ws + WS_ST) + (size_t)(bhl * NCH + c) * 32768 + (size_t)(v0 + r) * 128 + 8 * hh;
#pragma unroll
          for (int ks = 0; ks < 4; ++ks) bV[ks] = *(const bf16x8*)(vrow + 16 * ks);
#pragma unroll
          for (int ks = 0; ks < 8; ++ks) bC[ks] = *(const bf16x8*)(crow + 16 * ks); }
        u32x4 ogr[4];
#pragma unroll
        for (int i = 0; i < 4; ++i) ogr[i] = *(const u32x4*)(Zb + (size_t)(tokl + (tid >> 3)) * ZLD + ZC_O + h * 256 + 32 * (tid & 7) + 8 * i);
        u32x4 rawq[2][4], kt[2];
#pragma unroll
        for (int rep = 0; rep < 2; ++rep) { const int t = (tid + rep * NTHR) >> 4; conv_load(Zb, bl, c * LCH + t, h * 128 + c8 * 8, rawq[rep]);
            kt[rep] = *(const u32x4*)((const bf16*)(ws + WS_KC) + (size_t)(tokl + t) * 512 + h * 128 + c8 * 8); }
        if (wave == 0) {
            const float lf = gf[(size_t)(tokg + lane) * 4 + h], ii = gi[(size_t)(tokg + lane) * 4 + h];
            const float bc = wave_incl_scan_add(lf, lane); const float rr = ii - bc; const float cm = wave_incl_scan_max(rr, lane);
            const float mst = ((const float*)(ws + WS_CSC))[(size_t)(bhl * NCH + c) * 4 + 2];
            const float Mt = fmaxf(mst, cm);
            SC[lane] = rr; SC[64 + lane] = Mt; SC[128 + lane] = __expf(mst - Mt); SC[192 + lane] = __expf(-(bc + Mt));
        } else if (wave == 1 || wave == 2) { const int d = (wave - 1) * 64 + lane; SC[320 + d] = ((const float*)(ws + WS_NST))[(size_t)(bhl * NCH + c) * 128 + d]; }
#pragma unroll
        for (int rep = 0; rep < 2; ++rep) { const int idx = tid + rep * NTHR, t = idx >> 4; float o[8];
            conv_apply(rawq[rep], CWL + c8 * 8, 256, o);
            u32x4 w; w.x = pk2(o[0], o[1]); w.y = pk2(o[2], o[3]); w.z = pk2(o[4], o[5]); w.w = pk2(o[6], o[7]);
            *(LAS u32x4*)(QS + t * 136 + c8 * 8) = w;
            *(LAS u32x4*)(KS + t * 136 + c8 * 8) = kt[rep]; }
        __syncthreads();
        {
            const int tb = wave >> 1, fr = lane & 15, fq = lane >> 4;
#pragma unroll
            for (int i = 0; i < 2; ++i) { const int sblk = (wave & 1) * 2 + i; f32x4 acc = (f32x4){0.f, 0.f, 0.f, 0.f};
                if (sblk <= tb) {
#pragma unroll
                    for (int ks = 0; ks < 4; ++ks) { const bf16x8 af = *(const LAS bf16x8*)(QS + (16 * tb + fr) * 136 + 32 * ks + 8 * fq), bfv = *(const LAS bf16x8*)(KS + (16 * sblk + fr) * 136 + 32 * ks + 8 * fq);
                        acc = __builtin_amdgcn_mfma_f32_16x16x32_bf16(af, bfv, acc, 0, 0, 0); } }
                const int s = 16 * sblk + fr; const float rs_ = SC[s];
#pragma unroll
                for (int e = 0; e < 4; ++e) { const int t = 16 * tb + 4 * fq + e; const float val = (s <= t) ? acc[e] * __expf(rs_ - SC[64 + t]) : 0.f; SD[t * 72 + s] = (bf16)f2bf(val); } }
        }
        f32x16 aQ0, aQ1, aS0, aS1;
#pragma unroll
        for (int e = 0; e < 16; ++e) { aQ0[e] = 0.f; aQ1[e] = 0.f; aS0[e] = 0.f; aS1[e] = 0.f; }
#pragma unroll
        for (int ks = 0; ks < 8; ++ks) {
            const bf16x8 a0 = *(const LAS bf16x8*)(QS + r * 136 + 16 * ks + 8 * hh), a1 = *(const LAS bf16x8*)(QS + (32 + r) * 136 + 16 * ks + 8 * hh);
            aQ0 = __builtin_amdgcn_mfma_f32_32x32x16_bf16(a0, bC[ks], aQ0, 0, 0, 0); aQ1 = __builtin_amdgcn_mfma_f32_32x32x16_bf16(a1, bC[ks], aQ1, 0, 0, 0); }
        __syncthreads();
        {
            const int t = tid >> 3, p = tid & 7; float ds = 0.f, qn = 0.f;
#pragma unroll
            for (int k = 0; k < 8; ++k) ds += bf1(SD[t * 72 + 8 * p + k]);
#pragma unroll
            for (int k = 0; k < 16; ++k) qn += bf1(QS[t * 136 + 16 * p + k]) * SC[320 + 16 * p + k];
            float den = ds + SC[128 + t] * qn;
            den += __shfl_xor(den, 1); den += __shfl_xor(den, 2); den += __shfl_xor(den, 4);
            if (p == 0) SC[256 + t] = 1.f / fmaxf(fabsf(den), SC[192 + t]);
        }
#pragma unroll
        for (int ks = 0; ks < 4; ++ks) {
            const bf16x8 a0 = *(const LAS bf16x8*)(SD + r * 72 + 16 * ks + 8 * hh), a1 = *(const LAS bf16x8*)(SD + (32 + r) * 72 + 16 * ks + 8 * hh);
            aS0 = __builtin_amdgcn_mfma_f32_32x32x16_bf16(a0, bV[ks], aS0, 0, 0, 0); aS1 = __builtin_amdgcn_mfma_f32_32x32x16_bf16(a1, bV[ks], aS1, 0, 0, 0); }
        __syncthreads();
#pragma unroll
        for (int e = 0; e < 16; ++e) { const int t0 = (e & 3) + 8 * (e >> 2) + 4 * hh;
            HB[t0 * 260 + v0 + r] = (aS0[e] + SC[128 + t0] * aQ0[e]) * SC[256 + t0]; HB[(32 + t0) * 260 + v0 + r] = (aS1[e] + SC[128 + 32 + t0] * aQ1[e]) * SC[256 + 32 + t0]; }
        __syncthreads();
        {
            const int t = tid >> 3, p = tid & 7; f32x4 x[8]; float sm = 0.f;
#pragma unroll
            for (int k = 0; k < 8; ++k) { x[k] = *(const LAS f32x4*)(HB + t * 260 + 32 * p + 4 * k); sm += (x[k].x + x[k].y) + (x[k].z + x[k].w); }
            sm += __shfl_xor(sm, 1); sm += __shfl_xor(sm, 2); sm += __shfl_xor(sm, 4);
            const float mean = sm * (1.f / 256.f); float sq = 0.f;
#pragma unroll
            for (int k = 0; k < 8; ++k) { x[k] = x[k] - mean; sq += (x[k].x * x[k].x + x[k].y * x[k].y) + (x[k].z * x[k].z + x[k].w * x[k].w); }
            sq += __shfl_xor(sq, 1); sq += __shfl_xor(sq, 2); sq += __shfl_xor(sq, 4);
            const float rstd = rsqrtf(sq * (1.f / 256.f) + EPS);
            const float* gp = gain + h * 256 + 32 * p; bf16* op = Zb + (size_t)(tokl + t) * ZLD + out_col + h * 256 + 32 * p;
#pragma unroll
            for (int i = 0; i < 4; ++i) { const f32x4 g0 = *(const f32x4*)(gp + 8 * i), g1 = *(const f32x4*)(gp + 8 * i + 4); const f32x4 a = x[2 * i] * rstd * g0, b = x[2 * i + 1] * rstd * g1; const u32x4 og = ogr[i]; u32x4 w;
                w.x = pk2(a.x * bflo(og.x), a.y * bfhi(og.x)); w.y = pk2(a.z * bflo(og.y), a.w * bfhi(og.y)); w.z = pk2(b.x * bflo(og.z), b.y * bfhi(og.z)); w.w = pk2(b.z * bflo(og.w), b.w * bfhi(og.w));
                *(u32x4*)(op + 8 * i) = w; }
        }
        __syncthreads();
    }
}

__device__ __forceinline__ void sgu_phase(const Args& a, int l, unsigned char* ws, LAS unsigned char* lds, int G, int cu, int tid, int wave, int lane, const int out_col) {
    bf16* Zb = (bf16*)(ws + WS_Z); const bf16* ZT = (const bf16*)(ws + WS_ZT); const bf16* Wc = (const bf16*)(ws + WS_WSGU);
    const float* lng = a.in[I_SLNG] + (size_t)l * 1024; const float* lnb = a.in[I_SLNB] + (size_t)l * 1024; const float* bs = a.in[I_SBS] + (size_t)l * 4 * 128;
    LAS bf16* VT = (LAS bf16*)lds;
    LAS float* PS = (LAS float*)(lds + 69632);
    LAS float* ST = (LAS float*)(lds + 69632 + 8192);
    LAS bf16* WS_ = (LAS bf16*)(lds + 78848);
    const int c8 = tid & 15, dq = tid >> 4;
    int gcur = -1;
    for (int u = cu; u < 4 * 32 * 4; u += G) {
        const int g = u & 3, cc = (u >> 2) & 31, bl = u >> 7; const int tokl = bl * SEQ + cc * 128;
        u32x4 x[8];
#pragma unroll
        for (int rep = 0; rep < 8; ++rep) x[rep] = *(const u32x4*)(ZT + (size_t)(1024 + g * 256 + dq + 32 * rep) * ZTLD + tokl + c8 * 8);
        if (g != gcur) { __syncthreads();
#pragma unroll
            for (int rep = 0; rep < 4; ++rep) { const int idx = tid + rep * NTHR, t = idx >> 4; *(LAS u32x4*)(WS_ + t * 136 + c8 * 8) = *(const u32x4*)(Wc + (size_t)(g * 128 + t) * 128 + c8 * 8); }
            gcur = g; }
        {
            float sm[8], sq[8];
#pragma unroll
            for (int k = 0; k < 8; ++k) { sm[k] = 0.f; sq[k] = 0.f; }
#pragma unroll
            for (int rep = 0; rep < 8; ++rep) { const u32x4 v = x[rep]; const float f0 = bflo(v.x), f1 = bfhi(v.x), f2 = bflo(v.y), f3 = bfhi(v.y), f4 = bflo(v.z), f5 = bfhi(v.z), f6 = bflo(v.w), f7 = bfhi(v.w);
                sm[0] += f0; sq[0] += f0 * f0; sm[1] += f1; sq[1] += f1 * f1; sm[2] += f2; sq[2] += f2 * f2; sm[3] += f3; sq[3] += f3 * f3;
                sm[4] += f4; sq[4] += f4 * f4; sm[5] += f5; sq[5] += f5 * f5; sm[6] += f6; sq[6] += f6 * f6; sm[7] += f7; sq[7] += f7 * f7; }
#pragma unroll
            for (int k = 0; k < 8; ++k) { sm[k] += __shfl_xor(sm[k], 16); sq[k] += __shfl_xor(sq[k], 16); sm[k] += __shfl_xor(sm[k], 32); sq[k] += __shfl_xor(sq[k], 32); }
            if (lane < 16) {
#pragma unroll
                for (int k = 0; k < 8; ++k) { PS[(wave * 128 + c8 * 8 + k) * 2] = sm[k]; PS[(wave * 128 + c8 * 8 + k) * 2 + 1] = sq[k]; } }
        }
        __syncthreads();
        if (tid < 128) { float sm = 0.f, sq = 0.f;
#pragma unroll
            for (int p = 0; p < 8; ++p) { sm += PS[(p * 128 + tid) * 2]; sq += PS[(p * 128 + tid) * 2 + 1]; }
            const float mean = sm * (1.f / 256.f); const float var = fmaxf(sq * (1.f / 256.f) - mean * mean, 0.f); ST[tid] = mean; ST[128 + tid] = rsqrtf(var + EPS); }
        __syncthreads();
        { const LAS float* mp = ST + c8 * 8; const LAS float* rp = ST + 128 + c8 * 8; float mm[8], rr[8];
#pragma unroll
            for (int k = 0; k < 8; ++k) { mm[k] = mp[k]; rr[k] = rp[k]; }
#pragma unroll
            for (int rep = 0; rep < 8; ++rep) { const int d = dq + 32 * rep; const float gg = lng[g * 256 + d], bb = lnb[g * 256 + d]; u32x4 v = x[rep];
                v.x = pk2((bflo(v.x) - mm[0]) * rr[0] * gg + bb, (bfhi(v.x) - mm[1]) * rr[1] * gg + bb); v.y = pk2((bflo(v.y) - mm[2]) * rr[2] * gg + bb, (bfhi(v.y) - mm[3]) * rr[3] * gg + bb);
                v.z = pk2((bflo(v.z) - mm[4]) * rr[4] * gg + bb, (bfhi(v.z) - mm[5]) * rr[5] * gg + bb); v.w = pk2((bflo(v.w) - mm[6]) * rr[6] * gg + bb, (bfhi(v.w) - mm[7]) * rr[7] * gg + bb);
                *(LAS u32x4*)(VT + d * 136 + c8 * 8) = v; } }
        __syncthreads();
        {
            const int r = lane & 31, hh = lane >> 5, d0 = 32 * wave;
            u32x2 uu[4][4];
#pragma unroll
            for (int tb = 0; tb < 4; ++tb)
#pragma unroll
                for (int q = 0; q < 4; ++q) uu[tb][q] = *(const u32x2*)(Zb + (size_t)(tokl + 32 * tb + r) * ZLD + ZC_U + g * 256 + d0 + 4 * hh + 8 * q);
            f32x16 acc[4];
#pragma unroll
            for (int tb = 0; tb < 4; ++tb)
#pragma unroll
                for (int e = 0; e < 16; ++e) acc[tb][e] = 0.f;
#pragma unroll
            for (int ks = 0; ks < 8; ++ks) { const bf16x8 af = *(const LAS bf16x8*)(VT + (d0 + r) * 136 + 16 * ks + 8 * hh);
#pragma unroll
                for (int tb = 0; tb < 4; ++tb) if (16 * ks <= 32 * tb + 31) { const bf16x8 bfv = *(const LAS bf16x8*)(WS_ + (32 * tb + r) * 136 + 16 * ks + 8 * hh);
                    acc[tb] = __builtin_amdgcn_mfma_f32_32x32x16_bf16(af, bfv, acc[tb], 0, 0, 0); } }
#pragma unroll
            for (int tb = 0; tb < 4; ++tb) { const int t = 32 * tb + r; const float bias = bs[g * 128 + t]; bf16* rowp = Zb + (size_t)(tokl + t) * ZLD + out_col + g * 256 + d0 + 4 * hh;
#pragma unroll
                for (int q = 0; q < 4; ++q) { const u32x2 v = uu[tb][q]; u32x2 w;
                    w.x = pk2(bflo(v.x) * (acc[tb][4 * q] + bias), bfhi(v.x) * (acc[tb][4 * q + 1] + bias)); w.y = pk2(bflo(v.y) * (acc[tb][4 * q + 2] + bias), bfhi(v.y) * (acc[tb][4 * q + 3] + bias)); *(u32x2*)(rowp + 8 * q) = w; } }
        }
        __syncthreads();
    }
}

__device__ __forceinline__ void softmax_rows(unsigned char* ws, int gw, int NGW, int lane) {
    bf16* Zb = (bf16*)(ws + WS_Z);
    for (int m = gw; m < MH; m += NGW) {
        u32x4* p = (u32x4*)(Zb + (size_t)m * ZLD + ZC_XQ + 16 * lane); const u32x4 x0 = p[0], x1 = p[1];
        float v[16] = { bflo(x0.x), bfhi(x0.x), bflo(x0.y), bfhi(x0.y), bflo(x0.z), bfhi(x0.z), bflo(x0.w), bfhi(x0.w), bflo(x1.x), bfhi(x1.x), bflo(x1.y), bfhi(x1.y), bflo(x1.z), bfhi(x1.z), bflo(x1.w), bfhi(x1.w) };
        float mx = v[0];
#pragma unroll
        for (int e = 1; e < 16; ++e) mx = fmaxf(mx, v[e]);
#pragma unroll
        for (int o = 1; o < 16; o <<= 1) mx = fmaxf(mx, __shfl_xor(mx, o));
        float s = 0.f;
#pragma unroll
        for (int e = 0; e < 16; ++e) { v[e] = __expf(v[e] - mx); s += v[e]; }
#pragma unroll
        for (int o = 1; o < 16; o <<= 1) s += __shfl_xor(s, o);
        const float inv = 1.f / s;
        u32x4 y0, y1; y0.x = pk2(v[0] * inv, v[1] * inv); y0.y = pk2(v[2] * inv, v[3] * inv); y0.z = pk2(v[4] * inv, v[5] * inv); y0.w = pk2(v[6] * inv, v[7] * inv);
        y1.x = pk2(v[8] * inv, v[9] * inv); y1.y = pk2(v[10] * inv, v[11] * inv); y1.z = pk2(v[12] * inv, v[13] * inv); y1.w = pk2(v[14] * inv, v[15] * inv);
        p[0] = y0; p[1] = y1;
    }
}

__global__ void __launch_bounds__(NTHR, 2) trunk_fwd(Args args) {
    extern __shared__ __attribute__((aligned(16))) unsigned char lds_raw[];
    LAS unsigned char* lds = (LAS unsigned char*)lds_raw;
    volatile LAS unsigned* MISC = (volatile LAS unsigned*)(lds + MISC_OFF);
    const int G = gridDim.x, cu = blockIdx.x;
    unsigned char* ws = args.ws;
#define PHASE_IDS() int tid = threadIdx.x; asm volatile("" : "+v"(tid)); const int lane = tid & 63, wave = __builtin_amdgcn_readfirstlane(tid >> 6); \
    const int vcu = (G % 8 == 0) ? (cu % 8) * (G / 8) + cu / 8 : cu; const int gw = vcu * NWAVES + wave, NGW = G * NWAVES, gtid = cu * NTHR + tid, GT = G * NTHR; (void)gw; (void)NGW; (void)gtid; (void)GT; (void)lane
    for (int u = threadIdx.x; u < (LDS_BYTES - RING_BYTES) / 4; u += NTHR) ((LAS unsigned*)(lds + RING_BYTES))[u] = 0u;
    __syncthreads();
    XcdBarrier bar = xcd_barrier_post((unsigned*)(ws + WS_CTL) + 4096, MISC + 8);
    const int lo = args.ph_lo, hi = args.ph_hi;
    int ph = 0;
#define IN() (lo <= ph && ph < hi)
#define SEAM() do { if (lo <= ph && ph + 1 < hi) xcd_barrier(bar); ++ph; } while (0)
    bf16* XN = (bf16*)(ws + WS_XN); bf16* Wb = (bf16*)(ws + WS_W); float* RSTD = (float*)(ws + WS_RSTD);
    float* hbuf = args.out;

    if (IN()) { PHASE_IDS();
        convert_layer(args, 0, ws, lds, gw, NGW, wave, lane, gtid, GT);
        thin_rows(nullptr, 0, nullptr, 0.f, args.in[I_X], nullptr, XN, RSTD, nullptr, 0, M, gw, NGW, lane, false, nullptr, nullptr, nullptr, nullptr, nullptr);
        __syncthreads();
    }
    SEAM();

    for (int sb = 0; sb < 2 * DEPTH; ++sb) {
        const int l = sb >> 1, j = sb & 1;
        const float* ng = args.in[I_NORMG] + (size_t)l * NNORM * D;
        if (IN()) { PHASE_IDS();
            pg8::Gemm g{D, D, D}; pg8::TileSched S; S.init(M / 256, 2 * DFF / 256, G, cu, XN, D * 2, (char*)Wb + (j ? WO_GU1 : WO_GU0), D * 2);
            pg8::EpiGU E{(bf16*)(ws + WS_HID), RSTD};
            pg8::gemm_phase(lds, g, S, E, tid);
        }
        SEAM();
        if (IN()) { PHASE_IDS();
            pg8::Gemm g{DFF, DFF, DFF}; pg8::TileSched S; S.init(M / 256, D / 256, G, cu, ws + WS_HID, DFF * 2, (char*)Wb + (j ? WO_D1 : WO_D0), DFF * 2);
            pg8::EpiAct E{(bf16*)(ws + WS_F), (size_t)D, 0, nullptr, nullptr};
            pg8::gemm_phase(lds, g, S, E, tid);
        }
        SEAM();
        if (IN()) { PHASE_IDS();
            const float* hin = (sb == 0) ? args.in[I_X] : hbuf;
            if (j == 0) {
                LAS float* wif = (LAS float*)lds;
                const float* win = args.in[I_WIN] + (size_t)l * D * WIN_COLS;
                for (int e = tid; e < D * 8; e += NTHR) wif[e] = win[(size_t)(e >> 3) * WIN_COLS + 3072 + (e & 7)] * ng[2 * D + (e >> 3)];
                __syncthreads();
                float* gi = (float*)(ws + WS_GATE);
                const float* hx = (sb == 0) ? args.in[I_X] : nullptr;
                if (G == 256) {
                    const bool kvcu = (cu < 32) || (cu >= 128 && cu < 160);
                    if (kvcu) { const int gwk = ((cu < 32) ? cu : cu - 96) * NWAVES + wave;
                        thin_rows((const bf16*)(ws + WS_F), D, ng + 1 * D, 0.5f, hx, XN, XN, RSTD, nullptr, 0, 1024, gwk, 512, lane, true, wif, args.in[I_BI] + l * 4, args.in[I_BF] + l * 4, gi, gi + (size_t)M * 4); }
                    else { const int cun = (cu < 128) ? cu - 32 : cu - 64; const int gwn = cun * NWAVES + wave;
                        thin_rows((const bf16*)(ws + WS_F) + (size_t)1024 * D, D, ng + 1 * D, 0.5f, hx, XN, XN, RSTD, nullptr, 1024, M, gwn, 1536, lane, true, wif, args.in[I_BI] + l * 4, args.in[I_BF] + l * 4, gi, gi + (size_t)M * 4); }
                } else
                thin_rows((const bf16*)(ws + WS_F), D, ng + 1 * D, 0.5f, hx, XN, XN, RSTD, nullptr, 0, M, gw, NGW, lane, true, wif, args.in[I_BI] + l * 4, args.in[I_BF] + l * 4, gi, gi + (size_t)M * 4);
                __syncthreads();
                {
                    pg8::Gemm g{D, D, D};
                    pg8::TileSched S; S.init(MMEM / 256, D / 256, G, cu, ws + WS_MEMN, D * 2, (char*)Wb + WO_MKV, D * 2);
                    pg8::EpiAct E{(bf16*)(ws + WS_KMEM), (size_t)D, 0, nullptr, nullptr};
                    pg8::gemm_phase(lds, g, S, E, tid);
                    pg8::TileSched S2; S2.init(D / 256, MMEM / 256, G, (cu + G / 2) % G, (char*)Wb + WO_MKV + (size_t)D * D * 2, D * 2, ws + WS_MEMN, D * 2);
                    pg8::EpiAct E2{(bf16*)(ws + WS_VTMEM), (size_t)MMEM, 0, nullptr, nullptr};
                    pg8::gemm_phase(lds, g, S2, E2, tid);
                }
            } else {
                const bool lastl = (l + 1 == DEPTH);
                thin_rows((const bf16*)(ws + WS_F), D, ng + 5 * D, 0.5f, nullptr, XN, lastl ? nullptr : XN, RSTD, lastl ? hbuf : nullptr, 0, M, gw, NGW, lane, false, nullptr, nullptr, nullptr, nullptr, nullptr);
                if (l + 1 < DEPTH) { __syncthreads(); convert_layer(args, l + 1, ws, lds, gw, NGW, wave, lane, gtid, GT); __syncthreads(); }
            }
        }
        SEAM();
        if (j == 0) {
            for (int hf = 0; hf < 2; ++hf) {
                bf16* Zb = (bf16*)(ws + WS_Z);
                if (IN()) { PHASE_IDS();
                    pg8::Gemm g{D, D, D};
                    pg8::TileSched S; S.init(MH / 256, ZLD / 256, G, cu, XN + (size_t)hf * MH * D, D * 2, (char*)Wb + WO_IN, D * 2);
                    pg8::EpiAct E{Zb, (size_t)ZLD, 1, RSTD + (size_t)hf * MH, nullptr};
                    pg8::gemm_phase(lds, g, S, E, tid);
                    pg8::TileSched S2; S2.init(2048 / 256, MH / 256, G, cu, (char*)Wb + WO_IN + (size_t)ZLD * D * 2, D * 2, XN + (size_t)hf * MH * D, D * 2);
                    pg8::EpiAct E2{(bf16*)(ws + WS_ZT), (size_t)ZTLD, 2, nullptr, RSTD + (size_t)hf * MH};
                    pg8::gemm_phase(lds, g, S2, E2, tid);
                }
                SEAM();
                if (IN()) { PHASE_IDS();
                    mlstm_s1(args, l, hf, ws, lds, G, cu, tid, wave, lane);
                    sgu_phase(args, l, ws, lds, G, cu, tid, wave, lane, ZC_U);
                    pg8::Gemm g{256, ZLD, D};
                    pg8::TileSched S; S.init(MH / 256, 4, G, cu, Zb + ZC_XQ, ZLD * 2, (bf16*)(ws + WS_KMEM) + (size_t)hf * 4 * MEMLEN * D, 0);
                    S.a_pn = 512; S.b_tile = 512; S.pm_per_b = 16; S.b_batch = (size_t)MEMLEN * D * 2;
                    pg8::EpiAct E{Zb + ZC_XQ, (size_t)ZLD, 0, nullptr, nullptr};
                    pg8::gemm_phase(lds, g, S, E, tid);
                    for (int i = 0; ; ++i) { pg8::Unit uu; if (!S.next(i, uu)) break;
                        for (int rr = 0; rr < 32; ++rr) { unsigned long long* p = (unsigned long long*)(Zb + (size_t)(uu.pm * 256 + wave * 32 + rr) * ZLD + ZC_XQ + uu.pn * 256) + lane;
                            const unsigned long long w = __hip_atomic_load(p, __ATOMIC_RELAXED, __HIP_MEMORY_SCOPE_AGENT); const unsigned lo_ = (unsigned)w, hi_ = (unsigned)(w >> 32);
                            float v0 = bflo(lo_), v1 = bfhi(lo_), v2 = bflo(hi_), v3 = bfhi(hi_);
                            const float mx = wave_max(fmaxf(fmaxf(v0, v1), fmaxf(v2, v3)));
                            v0 = __expf(v0 - mx); v1 = __expf(v1 - mx); v2 = __expf(v2 - mx); v3 = __expf(v3 - mx);
                            const float inv = __builtin_amdgcn_rcpf(wave_sum((v0 + v1) + (v2 + v3)));
                            *p = (unsigned long long)pk2(v0 * inv, v1 * inv) | ((unsigned long long)pk2(v2 * inv, v3 * inv) << 32); } }
                }
                SEAM();
                if (IN()) { PHASE_IDS();
                    mlstm_s2(ws, G, cu, tid);
                }
                SEAM();
                if (IN()) { PHASE_IDS();
                    mlstm_s3(args, l, hf, ws, lds, G, cu, tid, wave, lane, ZC_O);
#ifdef PROBE_S3
                    for (int rep_ = 0; rep_ < 2; ++rep_) mlstm_s3(args, l, hf, ws, lds, G, cu, tid, wave, lane, ZC_QK);
#endif
#ifdef PROBE_SGU
                    for (int rep_ = 0; rep_ < 2; ++rep_) sgu_phase(args, l, ws, lds, G, cu, tid, wave, lane, ZC_QK);
#endif
                    pg8::Gemm g{256, ZLD, MMEM};
                    pg8::TileSched S; S.init(MH / 256, 4, G, cu, Zb + ZC_XQ, ZLD * 2, (bf16*)(ws + WS_VTMEM) + (size_t)hf * 4 * MEMLEN, 0);
                    S.a_pn = 512; S.b_tile = (size_t)256 * MMEM * 2; S.pm_per_b = 16; S.b_batch = (size_t)MEMLEN * 2;
                    pg8::EpiAct E{Zb + ZC_XQ, (size_t)ZLD, 0, nullptr, nullptr};
                    pg8::gemm_phase(lds, g, S, E, tid);
                }
                SEAM();
                if (IN()) { PHASE_IDS();
                    pg8::Gemm g{D, ZLD, D};
                    pg8::TileSched S; S.init(MH / 256, D / 256, G, cu, Zb + ZC_O, ZLD * 2, (char*)Wb + WO_BR, D * 2);
                    S.reps = 3; S.a_rep = 1024 * 2; S.b_rep = (size_t)D * D * 2;
                    pg8::EpiBranch E{Zb};
                    pg8::gemm_phase(lds, g, S, E, tid);
                }
                SEAM();
                if (IN()) { PHASE_IDS();
                    pg8::Gemm g{D, ZLD, D};
                    pg8::TileSched S; S.init(MH / 256, D / 256, G, cu, Zb + ZC_QK, ZLD * 2, (char*)Wb + WO_OUT, D * 2);
                    pg8::EpiAct E{Zb + ZC_O, (size_t)ZLD, 0, nullptr, nullptr};
                    pg8::gemm_phase(lds, g, S, E, tid);
                }
                SEAM();
                if (IN()) { PHASE_IDS();
                    thin_rows(Zb + ZC_O, ZLD, ng + 3 * D, 1.0f, nullptr, XN, XN, RSTD, nullptr, hf * MH, (hf + 1) * MH, gw, NGW, lane, false, nullptr, nullptr, nullptr, nullptr, nullptr);
                }
                SEAM();
            }
        }
    }
#undef IN
#undef SEAM
}
constexpr int N_PHASES = 1 + 2 * DEPTH * 3 + DEPTH * 2 * 7;

#ifndef N_LAUNCH_MODE
#define N_LAUNCH_MODE 0
#endif
extern "C" void kernel_launch(void* const* d_in, const int* in_sizes, int n_in, void* d_out, int out_size, void* d_ws, size_t ws_size, hipStream_t stream) {
    static int grid = 0;
    if (grid == 0) {
        if (n_in != 18 || out_size != M * D || ws_size < WS_END) { fprintf(stderr, "kernel_launch: unexpected shapes (n_in %d out %d ws %zu)\n", n_in, out_size, ws_size); grid = -1; return; }
        int dev = 0, cus = 0, per_cu = 0;
        if (hipGetDevice(&dev) != hipSuccess || hipDeviceGetAttribute(&cus, hipDeviceAttributeMultiprocessorCount, dev) != hipSuccess) { grid = -1; return; }
        if (hipFuncSetAttribute((const void*)trunk_fwd, hipFuncAttributeMaxDynamicSharedMemorySize, LDS_BYTES) != hipSuccess) { grid = -1; return; }
        if (hipOccupancyMaxActiveBlocksPerMultiprocessor(&per_cu, (const void*)trunk_fwd, NTHR, LDS_BYTES) != hipSuccess || per_cu < 1) { fprintf(stderr, "kernel_launch: occupancy query says %d\n", per_cu); }
        (void)hipGetLastError();
        grid = cus;
    }
    if (grid < 0) return;
    (void)hipMemsetAsync((char*)d_ws + WS_CTL, 0, CTL_ZERO_BYTES, stream);
    Args a{};
    for (int i = 0; i < 18; ++i) a.in[i] = (const float*)d_in[i];
    a.out = (float*)d_out; a.ws = (unsigned char*)d_ws;
#if N_LAUNCH_MODE == 0
    a.ph_lo = 0; a.ph_hi = N_PHASES;
    hipLaunchKernelGGL(trunk_fwd, dim3(grid), dim3(NTHR), LDS_BYTES, stream, a);
#else
    for (int p = 0; p < N_PHASES; ++p) { a.ph_lo = p; a.ph_hi = p + 1; hipLaunchKernelGGL(trunk_fwd, dim3(grid), dim3(NTHR), LDS_BYTES, stream, a); }
#endif
}
```

```cpp
#include <hip/hip_runtime.h>
#include <cstdio>
#include <cstdint>

#define LAS __attribute__((address_space(3)))
#define GAS __attribute__((address_space(1)))
typedef unsigned short bf16;
typedef short bf16x8 __attribute__((ext_vector_type(8)));
typedef float f32x4 __attribute__((ext_vector_type(4)));
typedef float f32x16 __attribute__((ext_vector_type(16)));
typedef unsigned u32x4 __attribute__((ext_vector_type(4)));
typedef unsigned u32x2 __attribute__((ext_vector_type(2)));

constexpr int D = 1024, BATCH = 8, SEQ = 4096, DEPTH = 2, MEMLEN = 256, DFF = 2816, NNORM = 7;
constexpr int M = BATCH * SEQ, MH = M / 2, MMEM = BATCH * MEMLEN;
constexpr int WIN_COLS = 9224;
constexpr int LCH = 64, NCH = SEQ / LCH;
constexpr int ZLD = 7168;
constexpr int ZC_QK = 0, ZC_O = 1024, ZC_U = 2048, ZC_XQ = 3072, ZC_G = 4096;
constexpr int ZTLD = MH;
constexpr float EPS = 1e-6f;
constexpr int NWAVES = 8, NTHR = 512;

constexpr size_t MiB = 1u << 20;
constexpr size_t WS_CTL = 0, CTL_ZERO_BYTES = 1 * MiB;
constexpr size_t WS_WSGU = 1 * MiB;
constexpr size_t WS_GATE = 2 * MiB;
constexpr size_t WS_NST = 3 * MiB;
constexpr size_t WS_CSC = 4 * MiB;
constexpr size_t WS_MEMN = 5 * MiB;
constexpr size_t WS_KMEM = 9 * MiB;
constexpr size_t WS_VTMEM = 13 * MiB;
constexpr size_t WS_W = 17 * MiB;
constexpr size_t WO_GU0 = 0, WO_GU1 = 11 * MiB, WO_D0 = 22 * MiB, WO_D1 = WO_D0 + 5632 * 1024, WO_IN = 33 * MiB, WO_MKV = 51 * MiB, WO_BR = 55 * MiB, WO_OUT = 61 * MiB;
constexpr size_t WS_XN = 80 * MiB;
constexpr size_t WS_WIF = 4 * MiB + 256 * 1024;
constexpr size_t WS_RSTD = 4 * MiB + 512 * 1024;
constexpr size_t WS_BIG = 144 * MiB;
constexpr size_t WS_HID = WS_BIG, WS_F = WS_BIG + 176 * MiB, WS_Z = WS_BIG, WS_ZT = WS_BIG + 224 * MiB;
constexpr size_t WS_ST = 432 * MiB;
constexpr size_t WS_KC = 496 * MiB;
constexpr size_t WS_END = 512 * MiB;

constexpr int LDS_BYTES = 147456;
constexpr int RING_BYTES = 131072;
constexpr int MISC_OFF = RING_BYTES + 320;

typedef float f32x2_t __attribute__((ext_vector_type(2))); typedef __bf16 bf16x2_t __attribute__((ext_vector_type(2)));
__device__ __forceinline__ unsigned pk2(float lo, float hi) { f32x2_t v = {lo, hi}; bf16x2_t b = __builtin_convertvector(v, bf16x2_t); return __builtin_bit_cast(unsigned, b); }
__device__ __forceinline__ unsigned f2bf(float f) { return pk2(f, 0.f) & 0xffffu; }
__device__ __forceinline__ float bflo(unsigned w) { return __uint_as_float(w << 16); }
__device__ __forceinline__ float bfhi(unsigned w) { return __uint_as_float(w & 0xffff0000u); }
__device__ __forceinline__ float bf1(bf16 b) { return __uint_as_float((unsigned)b << 16); }
__device__ __forceinline__ float wave_sum(float v) {
#pragma unroll
    for (int o = 1; o < 64; o <<= 1) v += __shfl_xor(v, o);
    return v;
}
__device__ __forceinline__ float sigmoidf_(float x) { return __builtin_amdgcn_rcpf(1.f + __expf(-x)); }
__device__ __forceinline__ float siluf_(float x) { return x * __builtin_amdgcn_rcpf(1.f + __expf(-x)); }
__device__ __forceinline__ float gelu_tanh(float x) { const float u = 1.5957691216f * (x + 0.044715f * x * x * x); return x * __builtin_amdgcn_rcpf(1.f + __expf(-u)); }
__device__ __forceinline__ float logsigmoidf_(float x) { return fminf(x, 0.f) - log1pf(__expf(-fabsf(x))); }
#define LDS_WAIT() asm volatile("s_waitcnt lgkmcnt(0)" ::: "memory")
#define VM_WAIT() asm volatile("s_waitcnt vmcnt(0)" ::: "memory")

namespace pg8 {
constexpr int BM = 256, BK = 64, HALF = 128, HTB = HALF * BK * 2, STAGE_BYTES = 8 * HTB, NXCD = 8, WGM = 8;
__host__ __device__ __forceinline__ int lds_byte(int r, int c) { const int st = (r >> 4) * 2 + (c >> 5), rr = r & 15, cc = c & 31, ob = rr * 64 + cc * 2; return st * 1024 + (ob ^ (((ob >> 9) & 1) << 5)); }
__host__ __device__ __forceinline__ void stage_rc(int b, int& R, int& C) { const int st = b / 1024, sb = b % 1024, swz = sb ^ (((sb >> 9) & 1) << 5); R = (st >> 1) * 16 + swz / 64; C = (st & 1) * 32 + (swz % 64) / 2; }
__host__ __device__ __forceinline__ int perm32(int rho) { const int n = rho >> 4, i = rho & 15; return 8 * (i >> 2) + 4 * n + (i & 3); }

struct Unit { int pm, pn, aux; const char* a; const char* b; };
struct Gemm { int K, lda, ldb; };

struct TileSched {
    int nM, nN, nwg, G, c, reps, pm_per_b;
    const char* A; const char* B;
    size_t a_tile, a_pn, a_rep, b_tile, b_batch, b_rep;
    __device__ __forceinline__ void init(int nM_, int nN_, int G_, int c_, const void* A_, size_t lda_bytes, const void* B_, size_t ldb_bytes) {
        nM = nM_; nN = nN_; nwg = nM * nN; G = G_; c = c_; reps = 1; pm_per_b = 1 << 30; A = (const char*)A_; B = (const char*)B_;
        a_tile = 256 * lda_bytes; a_pn = 0; a_rep = 0; b_tile = 256 * ldb_bytes; b_batch = 0; b_rep = 0;
    }
    __device__ __forceinline__ bool next(int i, Unit& u) const {
        const int ti = i / reps, aux = i - ti * reps;
        const long L = (long)ti * G + c; if (L >= nwg) return false;
        int wgid = (int)L; { const int q = nwg / NXCD, r = nwg % NXCD, xcd = wgid % NXCD, off = wgid / NXCD; wgid = (xcd < r ? xcd * (q + 1) : r * (q + 1) + (xcd - r) * q) + off; }
        const int nig = WGM * nN, gid = wgid / nig, fm = gid * WGM, gsz = (nM - fm) < WGM ? (nM - fm) : WGM;
        u.pm = fm + ((wgid % nig) % gsz); u.pn = (wgid % nig) / gsz; u.aux = aux;
        u.a = A + (size_t)u.pm * a_tile + (size_t)u.pn * a_pn + (size_t)aux * a_rep;
        u.b = B + (size_t)u.pn * b_tile + (size_t)(u.pm / pm_per_b) * b_batch + (size_t)aux * b_rep;
        return true;
    }
};

__device__ __forceinline__ unsigned cvt_pk_bf16(float lo, float hi) { return pk2(lo, hi); }

template <int ACT> __device__ __forceinline__ float actf(float x) {
    if (ACT == 1) return sigmoidf_(x);
    if (ACT == 2) return gelu_tanh(x);
    if (ACT == 3) return x * 0.0625f;
    return x;
}
template <int ACT> __device__ __forceinline__ void store_tile_bf16(const f32x4 (&acc)[2][2][4][2], bf16* O, size_t ldc, int row0, int col0, const float* rsrow, const float* rscol) {
    f32x4 cs[2][2];
#pragma unroll
    for (int bj = 0; bj < 2; ++bj)
#pragma unroll
        for (int n = 0; n < 2; ++n) cs[bj][n] = rscol ? *(const f32x4*)(rscol + col0 + bj * HALF + 4 * n) : (f32x4){1.f, 1.f, 1.f, 1.f};
#pragma unroll
    for (int ai = 0; ai < 2; ++ai)
#pragma unroll
        for (int m = 0; m < 4; ++m) { const int row = row0 + ai * HALF + m * 16; bf16* rowp = O + (size_t)row * ldc + col0; const float rr = rsrow ? rsrow[row] : 1.f;
#pragma unroll
            for (int bj = 0; bj < 2; ++bj) { const f32x4 v0 = acc[ai][bj][m][0] * cs[bj][0] * rr, v1 = acc[ai][bj][m][1] * cs[bj][1] * rr; u32x4 w;
                w.x = cvt_pk_bf16(actf<ACT>(v0[0]), actf<ACT>(v0[1])); w.y = cvt_pk_bf16(actf<ACT>(v0[2]), actf<ACT>(v0[3]));
                w.z = cvt_pk_bf16(actf<ACT>(v1[0]), actf<ACT>(v1[1])); w.w = cvt_pk_bf16(actf<ACT>(v1[2]), actf<ACT>(v1[3]));
                *(u32x4*)(rowp + bj * HALF) = w; } }
}
struct EpiAct {
    static constexpr bool PERM = true;
    bf16* O; size_t ldc; int mode; const float* rsrow; const float* rscol;
    __device__ __forceinline__ void operator()(const f32x4 (&acc)[2][2][4][2], const Unit& u, int wr, int wc, int fr, int fq) const {
        const int row0 = u.pm * BM + wr * 64 + fr, col0 = u.pn * BM + wc * 32 + 8 * fq;
        int act = 0;
        if (mode == 1) { const int g = u.pn >> 2; act = (g == 0) ? 0 : (g == 1) ? 1 : (g == 2) ? 2 : (g == 3) ? 3 : 1; }
        else if (mode == 2) act = (u.pm >= 4) ? 2 : 0;
        if (act == 0) store_tile_bf16<0>(acc, O, ldc, row0, col0, rsrow, rscol);
        else if (act == 1) store_tile_bf16<1>(acc, O, ldc, row0, col0, rsrow, rscol);
        else if (act == 2) store_tile_bf16<2>(acc, O, ldc, row0, col0, rsrow, rscol);
        else store_tile_bf16<3>(acc, O, ldc, row0, col0, rsrow, rscol);
    }
};
struct EpiGU {
    static constexpr bool PERM = true;
    bf16* O; const float* rsrow;
    __device__ __forceinline__ void operator()(const f32x4 (&acc)[2][2][4][2], const Unit& u, int wr, int wc, int fr, int fq) const {
        const int row0 = u.pm * BM + wr * 64 + fr, col0 = u.pn * HALF + wc * 32 + 8 * fq;
#pragma unroll
        for (int ai = 0; ai < 2; ++ai)
#pragma unroll
            for (int m = 0; m < 4; ++m) { const int row = row0 + ai * HALF + m * 16; bf16* rowp = O + (size_t)row * DFF + col0; const float rr = rsrow[row];
                const f32x4 g0 = acc[ai][0][m][0] * rr, g1 = acc[ai][0][m][1] * rr, u0 = acc[ai][1][m][0] * rr, u1 = acc[ai][1][m][1] * rr; u32x4 w;
                w.x = cvt_pk_bf16(siluf_(g0[0]) * u0[0], siluf_(g0[1]) * u0[1]); w.y = cvt_pk_bf16(siluf_(g0[2]) * u0[2], siluf_(g0[3]) * u0[3]);
                w.z = cvt_pk_bf16(siluf_(g1[0]) * u1[0], siluf_(g1[1]) * u1[1]); w.w = cvt_pk_bf16(siluf_(g1[2]) * u1[2], siluf_(g1[3]) * u1[3]);
                *(u32x4*)rowp = w; }
    }
};
struct EpiBranch {
    static constexpr bool PERM = true;
    bf16* Zb;
    __device__ __forceinline__ void operator()(const f32x4 (&acc)[2][2][4][2], const Unit& u, int wr, int wc, int fr, int fq) const {
        const int row0 = u.pm * BM + wr * 64 + fr, col0 = u.pn * BM + wc * 32 + 8 * fq; const int j = u.aux;
#pragma unroll
        for (int ai = 0; ai < 2; ++ai)
#pragma unroll
            for (int m = 0; m < 4; ++m) { bf16* rowp = Zb + (size_t)(row0 + ai * HALF + m * 16) * ZLD + col0;
#pragma unroll
                for (int bj = 0; bj < 2; ++bj) { const f32x4 v0 = acc[ai][bj][m][0], v1 = acc[ai][bj][m][1];
                    const u32x4 g = *(const u32x4*)(rowp + ZC_G + j * 1024 + bj * HALF);
                    float o[8] = { v0[0] * bflo(g.x), v0[1] * bfhi(g.x), v0[2] * bflo(g.y), v0[3] * bfhi(g.y), v1[0] * bflo(g.z), v1[1] * bfhi(g.z), v1[2] * bflo(g.w), v1[3] * bfhi(g.w) };
                    if (j > 0) { const u32x4 p = *(const u32x4*)(rowp + ZC_QK + bj * HALF);
                        o[0] += bflo(p.x); o[1] += bfhi(p.x); o[2] += bflo(p.y); o[3] += bfhi(p.y); o[4] += bflo(p.z); o[5] += bfhi(p.z); o[6] += bflo(p.w); o[7] += bfhi(p.w); }
                    u32x4 w; w.x = cvt_pk_bf16(o[0], o[1]); w.y = cvt_pk_bf16(o[2], o[3]); w.z = cvt_pk_bf16(o[4], o[5]); w.w = cvt_pk_bf16(o[6], o[7]);
                    *(u32x4*)(rowp + ZC_QK + bj * HALF) = w; } }
    }
};

template <class Epi, class Sched>
__device__ __forceinline__ void gemm_phase(LAS unsigned char* lds, const Gemm g, const Sched& S, const Epi& E, const int tid) {
    const int wid = __builtin_amdgcn_readfirstlane(tid >> 6), lane = tid & 63, wr = wid >> 2, wc = wid & 3, fr = lane & 15, fq = lane >> 4;
    const int nt = g.K / BK;
    unsigned voffA[2], voffB[2];
#pragma unroll
    for (int i = 0; i < 2; ++i) { int R, C; stage_rc(tid * 16 + i * 8192, R, C); const int Rb = Epi::PERM ? ((R & ~31) + perm32(R & 31)) : R;
        voffA[i] = (unsigned)(R * g.lda + C) * 2u; voffB[i] = (unsigned)(Rb * g.ldb + C) * 2u; }
    const size_t kstep = (size_t)(BK * 2);
    const size_t hstepA = (size_t)HALF * g.lda * 2, hstepB = (size_t)HALF * g.ldb * 2;
    const unsigned ldsw = (unsigned)wid * 1024u;
    const int aoff = lds_byte(wr * 64 + fr, fq * 8), boff = lds_byte(wc * 32 + fr, fq * 8);
#define PG8_SA(b, h) (((b) * 2 + (h)) * HTB)
#define PG8_SB(b, h) ((4 + (b) * 2 + (h)) * HTB)
#define PG8_STAGE(bufoff, gbase, voff) do { _Pragma("unroll") for (int _i = 0; _i < 2; ++_i) \
        __builtin_amdgcn_global_load_lds((const unsigned*)((const char*)(gbase) + (voff)[_i]), (LAS unsigned*)(lds + (bufoff) + ldsw + _i * 8192), 16, 0, 0); } while (0)
#define PG8_LDA(dst, b, h) do { _Pragma("unroll") for (int m = 0; m < 4; ++m) _Pragma("unroll") for (int k = 0; k < 2; ++k) dst[m][k] = *(const LAS bf16x8*)(lds + PG8_SA(b, h) + aoff + m * 2048 + k * 1024); } while (0)
#define PG8_LDB(dst, b, h) do { _Pragma("unroll") for (int n = 0; n < 2; ++n) _Pragma("unroll") for (int k = 0; k < 2; ++k) dst[n][k] = *(const LAS bf16x8*)(lds + PG8_SB(b, h) + boff + n * 2048 + k * 1024); } while (0)
#define PG8_MMA(ai, bj, At, Bt) do { __builtin_amdgcn_s_setprio(1); _Pragma("unroll") for (int m = 0; m < 4; ++m) _Pragma("unroll") for (int n = 0; n < 2; ++n) _Pragma("unroll") for (int k = 0; k < 2; ++k) \
        acc[ai][bj][m][n] = __builtin_amdgcn_mfma_f32_16x16x32_bf16(Bt[n][k], At[m][k], acc[ai][bj][m][n], 0, 0, 0); __builtin_amdgcn_s_setprio(0); } while (0)
#define PG8_WAIT_V(n) asm volatile("s_waitcnt vmcnt(" #n ")" ::: "memory")
#define PG8_WAIT_L(n) asm volatile("s_waitcnt lgkmcnt(" #n ")" ::: "memory")
#define PG8_BAR __builtin_amdgcn_s_barrier()
#define PG8_SCHED __builtin_amdgcn_sched_barrier(0)
    Unit cur, nxt; int ui = 0;
    if (!S.next(0, cur)) return;
    f32x4 acc[2][2][4][2];
#pragma unroll
    for (int a = 0; a < 2; ++a)
#pragma unroll
        for (int b = 0; b < 2; ++b)
#pragma unroll
            for (int m = 0; m < 4; ++m)
#pragma unroll
                for (int n = 0; n < 2; ++n) acc[a][b][m][n] = (f32x4){0.f, 0.f, 0.f, 0.f};
    bf16x8 At[4][2], B0[2][2], B1[2][2];
    const char* cA = cur.a; const char* cB = cur.b;
    PG8_STAGE(PG8_SB(0, 0), cB, voffB); PG8_STAGE(PG8_SB(0, 1), cB + hstepB, voffB); PG8_STAGE(PG8_SA(0, 0), cA, voffA); PG8_STAGE(PG8_SA(0, 1), cA + hstepA, voffA);
    if (wr == 1) PG8_BAR;
    PG8_WAIT_V(2); PG8_BAR;
    PG8_STAGE(PG8_SB(1, 0), cB + kstep, voffB); PG8_STAGE(PG8_SA(1, 0), cA + kstep, voffA); PG8_STAGE(PG8_SB(1, 1), cB + hstepB + kstep, voffB);
    PG8_WAIT_V(6); PG8_BAR;
    for (;;) {
        const bool has_next = S.next(ui + 1, nxt);
        const char* nA = has_next ? nxt.a : cA; const char* nB = has_next ? nxt.b : cB;
        for (int t = 0; t < nt; t += 2) {
            const bool last = (t == nt - 2);
            const char* a1 = cA + (size_t)(t + 1) * kstep;
            const char* a2 = last ? nA : cA + (size_t)(t + 2) * kstep; const char* b2 = last ? nB : cB + (size_t)(t + 2) * kstep;
            const char* a3 = a2 + kstep; const char* b3 = b2 + kstep;
            PG8_LDB(B0, 0, 0); PG8_LDB(B1, 0, 1); PG8_SCHED; PG8_LDA(At, 0, 0); PG8_STAGE(PG8_SA(1, 1), a1 + hstepA, voffA);
            PG8_WAIT_V(8); PG8_WAIT_L(0); PG8_BAR; PG8_MMA(0, 0, At, B0); PG8_MMA(0, 1, At, B1); PG8_BAR; PG8_SCHED;
            PG8_LDA(At, 0, 1); PG8_STAGE(PG8_SB(0, 0), b2, voffB); PG8_STAGE(PG8_SB(0, 1), b2 + hstepB, voffB); PG8_STAGE(PG8_SA(0, 0), a2, voffA);
            PG8_WAIT_V(8); PG8_WAIT_L(0); PG8_BAR; PG8_MMA(1, 0, At, B0); PG8_MMA(1, 1, At, B1); PG8_BAR; PG8_SCHED;
            PG8_LDB(B0, 1, 0); PG8_LDB(B1, 1, 1); PG8_SCHED; PG8_LDA(At, 1, 0); PG8_STAGE(PG8_SA(0, 1), a2 + hstepA, voffA);
            PG8_WAIT_V(8); PG8_WAIT_L(0); PG8_BAR; PG8_MMA(0, 0, At, B0); PG8_MMA(0, 1, At, B1); PG8_BAR; PG8_SCHED;
            PG8_LDA(At, 1, 1); PG8_STAGE(PG8_SB(1, 0), b3, voffB); PG8_STAGE(PG8_SB(1, 1), b3 + hstepB, voffB); PG8_STAGE(PG8_SA(1, 0), a3, voffA);
            PG8_WAIT_V(8); PG8_WAIT_L(0); PG8_BAR; PG8_MMA(1, 0, At, B0); PG8_MMA(1, 1, At, B1); PG8_BAR; PG8_SCHED;
        }
        if (wr == 0) PG8_BAR;
        E(acc, cur, wr, wc, fr, fq);
        if (!has_next) break;
#pragma unroll
        for (int a = 0; a < 2; ++a)
#pragma unroll
            for (int b = 0; b < 2; ++b)
#pragma unroll
                for (int m = 0; m < 4; ++m)
#pragma unroll
                    for (int n = 0; n < 2; ++n) acc[a][b][m][n] = (f32x4){0.f, 0.f, 0.f, 0.f};
        cur = nxt; cA = nA; cB = nB; ++ui;
        if (wr == 1) PG8_BAR;
    }
    PG8_WAIT_V(0);
    PG8_BAR;
#undef PG8_SA
#undef PG8_SB
#undef PG8_STAGE
#undef PG8_LDA
#undef PG8_LDB
#undef PG8_MMA
#undef PG8_WAIT_V
#undef PG8_WAIT_L
#undef PG8_BAR
#undef PG8_SCHED
}
}

#define XB_TMO      128
#define XB_XCNT(j)  (256  + 64 * (j))
#define XB_XSUB(j)  (1280 + 64 * (j))
#define XB_XGEN(j)  (2304 + 64 * (j))
#define XB_TOP      3328
#define XB_TOPGEN   3392
#define XCD_BAR_WORDS 3456
#define XB_SPIN_CAP (1u << 18)
__device__ __forceinline__ unsigned xb_ld(unsigned* p)              { return __hip_atomic_load(p, __ATOMIC_RELAXED, __HIP_MEMORY_SCOPE_AGENT); }
__device__ __forceinline__ unsigned xb_add(unsigned* p, unsigned v) { return __hip_atomic_fetch_add(p, v, __ATOMIC_RELAXED, __HIP_MEMORY_SCOPE_AGENT); }
__device__ __forceinline__ unsigned xb_xcc_id() { return (unsigned)__builtin_amdgcn_s_getreg((3 << 11) | 20) & 0xFu; }
#define XB_SPIN(cond, bar) do { unsigned _sp = 0; while (cond) { __builtin_amdgcn_s_sleep(1); \
    if ((++_sp & 255u) == 0u) { if (xb_ld(&(bar)[XB_TMO])) break; if (_sp > XB_SPIN_CAP) { atomicAdd(&(bar)[XB_TMO], 1u); break; } } } } while (0)
struct XcdBarrier { unsigned* bar; unsigned x; volatile LAS unsigned* st; };
__device__ __forceinline__ XcdBarrier xcd_barrier_post(unsigned* bar, volatile LAS unsigned* st) {
    XcdBarrier b; b.bar = bar; b.x = xb_xcc_id(); b.st = st;
    if (threadIdx.x == 0) (void)xb_add(&bar[XB_XCNT(b.x)], 1u);
    return b;
}
__device__ __forceinline__ void xcd_barrier_complete(unsigned* bar, unsigned x, unsigned& nloc, unsigned& nx) {
    const unsigned G = gridDim.x * gridDim.y * gridDim.z;
    unsigned sum, cnt, mine, sp = 0u;
    for (;;) {
        sum = 0u; cnt = 0u; mine = 0u;
#pragma unroll
        for (unsigned j = 0; j < 16; ++j) { const unsigned c = xb_ld(&bar[XB_XCNT(j)]); sum += c; cnt += (c > 0u) ? 1u : 0u; mine = (j == x) ? c : mine; }
        if (sum == G) break;
        __builtin_amdgcn_s_sleep(1);
        if ((++sp & 255u) == 0u) { if (xb_ld(&bar[XB_TMO])) break; if (sp > XB_SPIN_CAP) { atomicAdd(&bar[XB_TMO], 1u); break; } }
    }
    nloc = mine > 0u ? mine : 1u; nx = cnt > 0u ? cnt : 1u;
}
__device__ __forceinline__ void xcd_barrier(const XcdBarrier& b) {
    asm volatile("s_waitcnt vmcnt(0)" ::: "memory");
    __syncthreads();
    if (threadIdx.x == 0) {
        unsigned* bar = b.bar;
        __builtin_amdgcn_s_waitcnt(0);
        unsigned nloc = b.st[0], nx = b.st[1];
        if (nloc == 0u) { xcd_barrier_complete(bar, b.x, nloc, nx); b.st[0] = nloc; b.st[1] = nx; }
        const unsigned old = xb_add(&bar[XB_XSUB(b.x)], 1u);
        const unsigned gen = old / nloc;
        if (old + 1u == (gen + 1u) * nloc) {
            __builtin_amdgcn_fence(__ATOMIC_RELEASE, "agent");
            asm volatile("s_waitcnt vmcnt(0)" ::: "memory");
            const unsigned og = xb_add(&bar[XB_TOP], 1u);
            const unsigned tg = og / nx;
            if (og + 1u == (tg + 1u) * nx) xb_add(&bar[XB_TOPGEN], 1u);
            else XB_SPIN(xb_ld(&bar[XB_TOPGEN]) == tg, bar);
            __builtin_amdgcn_fence(__ATOMIC_ACQUIRE, "agent");
            xb_add(&bar[XB_XGEN(b.x)], 1u);
            asm volatile("s_waitcnt vmcnt(0)" ::: "memory");
        } else {
            XB_SPIN(xb_ld(&bar[XB_XGEN(b.x)]) == gen, bar);
            __builtin_amdgcn_fence(__ATOMIC_ACQUIRE, "agent");
            asm volatile("s_waitcnt vmcnt(0)" ::: "memory");
        }
    }
    __syncthreads();
}

struct Args { const float* in[18]; float* out; unsigned char* ws; int ph_lo, ph_hi; };
enum { I_X = 0, I_MEM, I_NORMG, I_WGU, I_WDOWN, I_WIN, I_CONVW, I_CONVB, I_BI, I_BF, I_MNORM, I_SLNG, I_SLNB, I_SWS, I_SBS, I_WMKV, I_WBR, I_WOUT };

__device__ __forceinline__ void cvt_item(const float* W, int Nsrc, int K, int srccol, bf16* WT, int dstrow, int kb, LAS float* scr, int lane, const float* gk = nullptr) {
    const int k0 = 64 * kb;
    if ((srccol & 3) == 0) {
        const int c4 = (lane & 7) * 4, rr = lane >> 3;
#pragma unroll
        for (int i = 0; i < 8; ++i) { const int kk = 8 * i + rr; f32x4 x = *(const f32x4*)(W + (size_t)(k0 + kk) * Nsrc + srccol + c4); if (gk) x = x * gk[k0 + kk];
            LAS float* d = scr + kk * 33 + c4; d[0] = x.x; d[1] = x.y; d[2] = x.z; d[3] = x.w; }
    } else {
#pragma unroll 8
        for (int i = 0; i < 32; ++i) { const int kk = 2 * i + (lane >> 5); scr[kk * 33 + (lane & 31)] = W[(size_t)(k0 + kk) * Nsrc + srccol + (lane & 31)] * (gk ? gk[k0 + kk] : 1.f); }
    }
    LDS_WAIT(); asm volatile("" ::: "memory");
    const int c = lane & 7;
#pragma unroll
    for (int j = 0; j < 4; ++j) { const int n = (lane >> 3) + 8 * j; const LAS float* s = scr + (8 * c) * 33 + n;
        u32x4 o; o.x = pk2(s[0 * 33], s[1 * 33]); o.y = pk2(s[2 * 33], s[3 * 33]); o.z = pk2(s[4 * 33], s[5 * 33]); o.w = pk2(s[6 * 33], s[7 * 33]);
        *(u32x4*)(WT + (size_t)(dstrow + n) * K + k0 + 8 * c) = o; }
    LDS_WAIT(); asm volatile("" ::: "memory");
}
__device__ __forceinline__ int win_srccol(int r) {
    if (r < 1024) return r;
    if (r < 2048) return 2048 + (r - 1024);
    if (r < 3072) return 3080 + (r - 2048);
    if (r < 4096) return 5128 + (r - 3072);
    if (r < 7168) return 6152 + (r - 4096);
    if (r < 8192) return 1024 + (r - 7168);
    return 4104 + (r - 8192);
}
__device__ __forceinline__ void convert_layer(const Args& a, int l, unsigned char* ws, LAS unsigned char* lds, int gw, int NGW, int wave, int lane, int gtid, int GT) {
    LAS float* scr = (LAS float*)(lds + wave * 16384);
    bf16* Wb = (bf16*)(ws + WS_W);
    constexpr int I_GU = 16 * 176, I_DN = 44 * 32, I_IN = 16 * 288, I_MKV = 16 * 64, I_BR = 16 * 32, I_OUT = 16 * 32;
    constexpr int NITEMS = 2 * I_GU + 2 * I_DN + I_IN + I_MKV + 3 * I_BR + I_OUT;
    for (int it = gw; it < NITEMS; it += NGW) {
        int r = it;
        if (r < 2 * I_GU) { const int j = r / I_GU; r -= j * I_GU; const int kb = r / 176, nb = r % 176; const int p = nb >> 3, q = nb & 7, s = q >> 2, jj = (q & 3) * 32;
            cvt_item(a.in[I_WGU] + (size_t)(l * 2 + j) * D * 2 * DFF, 2 * DFF, D, s * DFF + 128 * p + jj, (bf16*)((char*)Wb + (j ? WO_GU1 : WO_GU0)), nb * 32, kb, scr, lane, a.in[I_NORMG] + (size_t)(l * NNORM + (j ? 4 : 0)) * D); continue; }
        r -= 2 * I_GU;
        if (r < 2 * I_DN) { const int j = r / I_DN; r -= j * I_DN; const int kb = r / 32, nb = r % 32;
            cvt_item(a.in[I_WDOWN] + (size_t)(l * 2 + j) * DFF * D, D, DFF, nb * 32, (bf16*)((char*)Wb + (j ? WO_D1 : WO_D0)), nb * 32, kb, scr, lane); continue; }
        r -= 2 * I_DN;
        if (r < I_IN) { const int kb = r / 288, nb = r % 288;
            cvt_item(a.in[I_WIN] + (size_t)l * D * WIN_COLS, WIN_COLS, D, win_srccol(nb * 32), (bf16*)((char*)Wb + WO_IN), nb * 32, kb, scr, lane, a.in[I_NORMG] + (size_t)(l * NNORM + 2) * D); continue; }
        r -= I_IN;
        if (r < I_MKV) { const int kb = r / 64, nb = r % 64;
            cvt_item(a.in[I_WMKV] + (size_t)l * D * 2048, 2048, D, nb * 32, (bf16*)((char*)Wb + WO_MKV), nb * 32, kb, scr, lane); continue; }
        r -= I_MKV;
        if (r < 3 * I_BR) { const int j = r / I_BR; r -= j * I_BR; const int kb = r / 32, nb = r % 32;
            cvt_item(a.in[I_WBR] + (size_t)(l * 3 + j) * D * D, D, D, nb * 32, (bf16*)((char*)Wb + WO_BR) + (size_t)j * D * D, nb * 32, kb, scr, lane); continue; }
        r -= 3 * I_BR;
        { const int kb = r / 32, nb = r % 32; cvt_item(a.in[I_WOUT] + (size_t)l * D * D, D, D, nb * 32, (bf16*)((char*)Wb + WO_OUT), nb * 32, kb, scr, lane); }
    }
    { const float* win = a.in[I_WIN] + (size_t)l * D * WIN_COLS; const float* g2 = a.in[I_NORMG] + (size_t)(l * NNORM + 2) * D; float* wt = (float*)(ws + WS_WIF);
      for (int e = gtid; e < 8 * D; e += GT) { const int k = e >> 3, c = e & 7; wt[c * D + k] = win[(size_t)k * WIN_COLS + 3072 + c] * g2[k]; } }
    bf16* wsg = (bf16*)(ws + WS_WSGU); const float* src = a.in[I_SWS] + (size_t)l * 4 * 128 * 128;
    for (int e = gtid; e < 4 * 128 * 128; e += GT) { const int t = (e >> 7) & 127, s = e & 127; wsg[e] = (bf16)f2bf(s <= t ? src[e] : 0.f); }
    const float* g6 = a.in[I_NORMG] + (size_t)(l * NNORM + 6) * D;
    for (int m = gw; m < MMEM; m += NGW) {
        const f32x4* xr = (const f32x4*)(a.in[I_MEM] + (size_t)m * D) + lane; f32x4 v[4]; float s = 0.f;
#pragma unroll
        for (int j = 0; j < 4; ++j) { v[j] = xr[64 * j]; s += (v[j].x * v[j].x + v[j].y * v[j].y) + (v[j].z * v[j].z + v[j].w * v[j].w); }
        const float rstd = rsqrtf(wave_sum(s) * (1.f / D) + EPS);
        unsigned long long* o8 = (unsigned long long*)((bf16*)(ws + WS_MEMN) + (size_t)m * D) + lane;
#pragma unroll
        for (int j = 0; j < 4; ++j) { const f32x4 gg = ((const f32x4*)g6)[lane + 64 * j];
            o8[64 * j] = (unsigned long long)pk2(v[j].x * rstd * gg.x, v[j].y * rstd * gg.y) | ((unsigned long long)pk2(v[j].z * rstd * gg.z, v[j].w * rstd * gg.w) << 32); }
    }
}

__device__ __forceinline__ void thin_rows(const bf16* fbase, size_t fld, const float* ga, float scale, const float* hin32, const bf16* hinb, bf16* hb_out, float* rstd_out, float* out32,
                                          int row_lo, int row_hi, int gw, int NGW, int lane, const bool do_gates, const LAS float* wif, const float* bi, const float* bfg, float* gate_i, float* gate_f) {
    for (int m = row_lo + gw; m < row_hi; m += NGW) {
        f32x4 v[4];
        if (hin32) { const f32x4* hr = (const f32x4*)(hin32 + (size_t)m * D) + lane;
#pragma unroll
            for (int j = 0; j < 4; ++j) v[j] = hr[64 * j]; }
        else { const unsigned long long* hr = (const unsigned long long*)(hinb + (size_t)m * D) + lane;
#pragma unroll
            for (int j = 0; j < 4; ++j) { const unsigned long long w = hr[64 * j]; const unsigned lo = (unsigned)w, hi = (unsigned)(w >> 32); v[j] = (f32x4){bflo(lo), bfhi(lo), bflo(hi), bfhi(hi)}; } }
        if (fbase) {
            const unsigned long long* fr = (const unsigned long long*)(fbase + (size_t)(m - row_lo) * fld) + lane; float s = 0.f; f32x4 f[4];
#pragma unroll
            for (int j = 0; j < 4; ++j) { const unsigned long long w = fr[64 * j]; const unsigned lo = (unsigned)w, hi = (unsigned)(w >> 32);
                f[j] = (f32x4){bflo(lo), bfhi(lo), bflo(hi), bfhi(hi)}; s += (f[j].x * f[j].x + f[j].y * f[j].y) + (f[j].z * f[j].z + f[j].w * f[j].w); }
            const float rstd = rsqrtf(wave_sum(s) * (1.f / D) + EPS) * scale;
#pragma unroll
            for (int j = 0; j < 4; ++j) { const f32x4 gg = ((const f32x4*)ga)[lane + 64 * j]; v[j] = v[j] + f[j] * rstd * gg; }
        }
        if (out32) { f32x4* ho = (f32x4*)(out32 + (size_t)m * D) + lane;
#pragma unroll
            for (int j = 0; j < 4; ++j) ho[64 * j] = v[j]; }
        if (hb_out) {
            float s = 0.f;
#pragma unroll
            for (int j = 0; j < 4; ++j) s += (v[j].x * v[j].x + v[j].y * v[j].y) + (v[j].z * v[j].z + v[j].w * v[j].w);
            const float rstd = rsqrtf(wave_sum(s) * (1.f / D) + EPS);
            unsigned long long* o8 = (unsigned long long*)(hb_out + (size_t)m * D) + lane;
#pragma unroll
            for (int j = 0; j < 4; ++j) o8[64 * j] = (unsigned long long)pk2(v[j].x, v[j].y) | ((unsigned long long)pk2(v[j].z, v[j].w) << 32);
            if (lane == 0) rstd_out[m] = rstd;
            if (do_gates) {
                float acc[8];
#pragma unroll
                for (int e = 0; e < 8; ++e) acc[e] = 0.f;
#pragma unroll
                for (int j = 0; j < 4; ++j)
#pragma unroll
                    for (int e = 0; e < 8; ++e) { const f32x4 w4 = *(const LAS f32x4*)(wif + e * D + 4 * lane + 256 * j); acc[e] += (v[j].x * w4.x + v[j].y * w4.y) + (v[j].z * w4.z + v[j].w * w4.w); }
                {
                    float b4[4], b2[2], b1;
#pragma unroll
                    for (int e = 0; e < 4; ++e) { const float mine = (lane & 4) ? acc[4 + e] : acc[e], send = (lane & 4) ? acc[e] : acc[4 + e]; b4[e] = mine + __shfl_xor(send, 4); }
#pragma unroll
                    for (int e = 0; e < 2; ++e) { const float mine = (lane & 2) ? b4[2 + e] : b4[e], send = (lane & 2) ? b4[e] : b4[2 + e]; b2[e] = mine + __shfl_xor(send, 2); }
                    { const float mine = (lane & 1) ? b2[1] : b2[0], send = (lane & 1) ? b2[0] : b2[1]; b1 = mine + __shfl_xor(send, 1); }
                    b1 += __shfl_xor(b1, 8); b1 += __shfl_xor(b1, 16); b1 += __shfl_xor(b1, 32);
                    const float val = b1 * rstd;
                    if (lane < 4) gate_i[(size_t)m * 4 + lane] = val + bi[lane];
                    else if (lane < 8) gate_f[(size_t)m * 4 + lane - 4] = logsigmoidf_(val + bfg[lane - 4]);
                }
            }
        }
    }
}

__device__ __forceinline__ void conv8(const bf16* Zb, int bl, int p, int col, const float* cw, const float* cb, float (&o)[8]) {
    const f32x4 b0 = *(const f32x4*)(cb + col), b1 = *(const f32x4*)(cb + col + 4);
    o[0] = b0.x; o[1] = b0.y; o[2] = b0.z; o[3] = b0.w; o[4] = b1.x; o[5] = b1.y; o[6] = b1.z; o[7] = b1.w;
#pragma unroll
    for (int j = 0; j < 4; ++j) { const int pp = p - 3 + j;
        if (pp >= 0) { const u32x4 x = *(const u32x4*)(Zb + (size_t)(bl * SEQ + pp) * ZLD + ZC_QK + col);
            const f32x4 w0 = *(const f32x4*)(cw + j * 1024 + col), w1 = *(const f32x4*)(cw + j * 1024 + col + 4);
            o[0] += w0.x * bflo(x.x); o[1] += w0.y * bfhi(x.x); o[2] += w0.z * bflo(x.y); o[3] += w0.w * bfhi(x.y);
            o[4] += w1.x * bflo(x.z); o[5] += w1.y * bfhi(x.z); o[6] += w1.z * bflo(x.w); o[7] += w1.w * bfhi(x.w); } }
#pragma unroll
    for (int e = 0; e < 8; ++e) o[e] = siluf_(o[e]);
}
__device__ __forceinline__ float wave_incl_scan_add(float v, int lane) {
#pragma unroll
    for (int o = 1; o < 64; o <<= 1) { const float t = __shfl_up(v, o); if (lane >= o) v += t; }
    return v;
}
__device__ __forceinline__ float wave_incl_scan_max(float v, int lane) {
#pragma unroll
    for (int o = 1; o < 64; o <<= 1) { const float t = __shfl_up(v, o); if (lane >= o) v = fmaxf(v, t); }
    return v;
}
__device__ __forceinline__ float wave_max(float v) {
#pragma unroll
    for (int o = 1; o < 64; o <<= 1) v = fmaxf(v, __shfl_xor(v, o));
    return v;
}
constexpr float KSCALE = 0.08838834764831845f;

__device__ __forceinline__ void conv_load(const bf16* Zb, int bl, int p, int col, u32x4 (&raw)[4]) {
#pragma unroll
    for (int j = 0; j < 4; ++j) { const int pp = p - 3 + j; raw[j] = (u32x4){0u, 0u, 0u, 0u};
        if (pp >= 0) raw[j] = *(const u32x4*)(Zb + (size_t)(bl * SEQ + pp) * ZLD + ZC_QK + col); }
}
__device__ __forceinline__ void conv_apply(const u32x4 (&raw)[4], const LAS float* wl, const int wstride, float (&o)[8]) {
    { const f32x4 b0 = *(const LAS f32x4*)(wl + 4 * wstride), b1 = *(const LAS f32x4*)(wl + 4 * wstride + 4);
      o[0] = b0.x; o[1] = b0.y; o[2] = b0.z; o[3] = b0.w; o[4] = b1.x; o[5] = b1.y; o[6] = b1.z; o[7] = b1.w; }
#pragma unroll
    for (int j = 0; j < 4; ++j) { const u32x4 x = raw[j];
        const f32x4 w0 = *(const LAS f32x4*)(wl + j * wstride), w1 = *(const LAS f32x4*)(wl + j * wstride + 4);
        o[0] += w0.x * bflo(x.x); o[1] += w0.y * bfhi(x.x); o[2] += w0.z * bflo(x.y); o[3] += w0.w * bfhi(x.y);
        o[4] += w1.x * bflo(x.z); o[5] += w1.y * bfhi(x.z); o[6] += w1.z * bflo(x.w); o[7] += w1.w * bfhi(x.w); }
#pragma unroll
    for (int e = 0; e < 8; ++e) o[e] = siluf_(o[e]);
}
__device__ __forceinline__ void stage_convw(LAS float* wl, const float* cw, const float* cb, int col0, int ncol, int dst0, int wstride, int tid) {
    for (int e = tid; e < 5 * ncol; e += NTHR) { const int j = e / ncol, cidx = e - j * ncol; wl[j * wstride + dst0 + cidx] = (j < 4) ? cw[j * 1024 + col0 + cidx] : cb[col0 + cidx]; }
}
__device__ __forceinline__ void mlstm_s1(const Args& a, int l, int hf, unsigned char* ws, LAS unsigned char* lds, int G, int cu, int tid, int wave, int lane) {
    const bf16* Zb = (const bf16*)(ws + WS_Z); const bf16* ZT = (const bf16*)(ws + WS_ZT);
    const float* gi = (const float*)(ws + WS_GATE); const float* gf = gi + (size_t)M * 4;
    const float* cw = a.in[I_CONVW] + (size_t)l * 4 * 1024; const float* cb = a.in[I_CONVB] + (size_t)l * 1024;
    LAS bf16* KT = (LAS bf16*)lds;
    LAS float* wv = (LAS float*)(lds + 18432);
    LAS float* CWL = (LAS float*)(lds + 18688);
    const int c8 = tid & 15; int hcur = -1;
    for (int u = cu; u < 16 * NCH; u += G) {
        const int h = u & 3, c = (u >> 2) & 63, bl = u >> 8, bhl = bl * 4 + h; const int tokg = (hf * 4 + bl) * SEQ + c * LCH;
        if (h != hcur) { __syncthreads(); stage_convw(CWL, cw, cb, 512 + h * 128, 128, 0, 128, tid); hcur = h; }
        const int r = lane & 31, hh = lane >> 5, v0 = 32 * wave;
        bf16x8 bfr[4];
        { const bf16* vrow = ZT + (size_t)(h * 256 + v0 + r) * ZTLD + bl * SEQ + c * LCH + 8 * hh;
#pragma unroll
          for (int ks = 0; ks < 4; ++ks) bfr[ks] = *(const bf16x8*)(vrow + 16 * ks); }
        u32x4 raw[2][4];
#pragma unroll
        for (int rep = 0; rep < 2; ++rep) conv_load(Zb, bl, c * LCH + ((tid + rep * NTHR) >> 4), 512 + h * 128 + c8 * 8, raw[rep]);
        if (wave == 0) {
            const float lf = gf[(size_t)(tokg + lane) * 4 + h], ii = gi[(size_t)(tokg + lane) * 4 + h];
            const float bc = wave_incl_scan_add(lf, lane); const float g = __shfl(bc, 63);
            const float av = g - bc + ii; const float ml = wave_max(av);
            wv[lane] = __expf(av - ml);
            if (lane == 0) { float* cs = (float*)(ws + WS_CSC) + (size_t)(bhl * NCH + c) * 4; cs[0] = g; cs[1] = ml; }
        }
        __syncthreads();
#pragma unroll
        for (int rep = 0; rep < 2; ++rep) { const int idx = tid + rep * NTHR, s = idx >> 4; float o[8];
            conv_apply(raw[rep], CWL + c8 * 8, 128, o); const float sc = wv[s] * KSCALE;
            { u32x4 w; w.x = pk2(o[0] * KSCALE, o[1] * KSCALE); w.y = pk2(o[2] * KSCALE, o[3] * KSCALE); w.z = pk2(o[4] * KSCALE, o[5] * KSCALE); w.w = pk2(o[6] * KSCALE, o[7] * KSCALE);
              *(u32x4*)((bf16*)(ws + WS_KC) + (size_t)(bl * SEQ + c * LCH + s) * 512 + h * 128 + c8 * 8) = w; }
#pragma unroll
            for (int e = 0; e < 8; ++e) KT[(c8 * 8 + e) * 72 + s] = (bf16)f2bf(o[e] * sc); }
        __syncthreads();
        if (tid < 128) { float s = 0.f;
#pragma unroll 8
            for (int k = 0; k < 64; ++k) s += bf1(KT[tid * 72 + k]);
            ((float*)(ws + WS_NST))[(size_t)(bhl * NCH + c) * 128 + tid] = s; }
        {
            bf16* st = (bf16*)(ws + WS_ST) + (size_t)(bhl * NCH + c) * 32768 + (size_t)(v0 + r) * 128;
#pragma unroll
            for (int db = 0; db < 4; ++db) { f32x16 acc;
#pragma unroll
                for (int e = 0; e < 16; ++e) acc[e] = 0.f;
#pragma unroll
                for (int ks = 0; ks < 4; ++ks) { const bf16x8 af = *(const LAS bf16x8*)(KT + (32 * db + r) * 72 + 16 * ks + 8 * hh); acc = __builtin_amdgcn_mfma_f32_32x32x16_bf16(af, bfr[ks], acc, 0, 0, 0); }
#pragma unroll
                for (int q = 0; q < 4; ++q) { u32x2 w; w.x = pk2(acc[4 * q], acc[4 * q + 1]); w.y = pk2(acc[4 * q + 2], acc[4 * q + 3]); *(u32x2*)(st + 32 * db + 8 * q + 4 * hh) = w; } }
        }
        __syncthreads();
    }
}
__device__ __forceinline__ void mlstm_s2(unsigned char* ws, int G, int cu, int tid) {
    for (int u = cu; u < 256; u += G) {
        const int bhl = u >> 4, part = u & 15; const size_t off = (size_t)(part * NTHR + tid) * 4;
        bf16* st = (bf16*)(ws + WS_ST) + (size_t)bhl * NCH * 32768 + off; float* ns = (float*)(ws + WS_NST) + (size_t)bhl * NCH * 128 + tid; float* cs = (float*)(ws + WS_CSC) + (size_t)bhl * NCH * 4;
        const bool nth = (part == 0 && tid < 128);
        float C[4]; float nv = 0.f, m = -1e30f;
#pragma unroll
        for (int e = 0; e < 4; ++e) C[e] = 0.f;
        for (int c0 = 0; c0 < NCH; c0 += 8) {
            u32x2 cl[8]; float nl[8], gg[8], ml[8];
#pragma unroll
            for (int i = 0; i < 8; ++i) { cl[i] = *(const u32x2*)(st + (size_t)(c0 + i) * 32768); nl[i] = nth ? ns[(c0 + i) * 128] : 0.f; gg[i] = cs[(c0 + i) * 4]; ml[i] = cs[(c0 + i) * 4 + 1]; }
#pragma unroll
            for (int i = 0; i < 8; ++i) {
                u32x2 o; o.x = pk2(C[0], C[1]); o.y = pk2(C[2], C[3]);
                *(u32x2*)(st + (size_t)(c0 + i) * 32768) = o;
                if (nth) ns[(c0 + i) * 128] = nv;
                if (part == 0 && tid == 0) cs[(c0 + i) * 4 + 2] = m;
                const float mn = fmaxf(gg[i] + m, ml[i]); const float dec = __expf(gg[i] + m - mn), sc = __expf(ml[i] - mn);
                C[0] = dec * C[0] + sc * bflo(cl[i].x); C[1] = dec * C[1] + sc * bfhi(cl[i].x); C[2] = dec * C[2] + sc * bflo(cl[i].y); C[3] = dec * C[3] + sc * bfhi(cl[i].y);
                nv = dec * nv + sc * nl[i]; m = mn;
            }
        }
    }
}
__device__ __forceinline__ void mlstm_s3(const Args& a, int l, int hf, unsigned char* ws, LAS unsigned char* lds, int G, int cu, int tid, int wave, int lane, const int out_col) {
    bf16* Zb = (bf16*)(ws + WS_Z); const bf16* ZT = (const bf16*)(ws + WS_ZT);
    const float* gi = (const float*)(ws + WS_GATE); const float* gf = gi + (size_t)M * 4;
    const float* cw = a.in[I_CONVW] + (size_t)l * 4 * 1024; const float* cb = a.in[I_CONVB] + (size_t)l * 1024;
    const float* gain = a.in[I_MNORM] + (size_t)l * 1024;
    LAS bf16* QS = (LAS bf16*)lds;
    LAS bf16* KS = (LAS bf16*)(lds + 17408);
    LAS bf16* SD = (LAS bf16*)(lds + 34816);
    LAS float* HB = (LAS float*)(lds + 44032);
    LAS float* SC = (LAS float*)(lds + 110592);
    LAS float* CWL = (LAS float*)(lds + 112384);
    const int c8 = tid & 15; int hcur = -1;
    for (int u = cu; u < 16 * NCH; u += G) {
        const int h = u & 3, c = (u >> 2) & 63, bl = u >> 8, bhl = bl * 4 + h; const int tokg = (hf * 4 + bl) * SEQ + c * LCH; const int tokl = bl * SEQ + c * LCH;
        if (h != hcur) { __syncthreads(); stage_convw(CWL, cw, cb, h * 128, 128, 0, 256, tid); hcur = h; __syncthreads(); }
        const int r = lane & 31, hh = lane >> 5, v0 = 32 * wave;
        bf16x8 bV[4], bC[8];
        { const bf16* vrow = ZT + (size_t)(h * 256 + v0 + r) * ZTLD + tokl + 8 * hh;
          const bf16* crow = (const bf16*)(ws + WS_ST) + (size_t)(bhl * NCH + c) * 32768 + (size_t)(v0 + r) * 128 + 8 * hh;
#pragma unroll
          for (int ks = 0; ks < 4; ++ks) bV[ks] = *(const bf16x8*)(vrow + 16 * ks);
#pragma unroll
          for (int ks = 0; ks < 8; ++ks) bC[ks] = *(const bf16x8*)(crow + 16 * ks); }
        u32x4 ogr[4];
#pragma unroll
        for (int i = 0; i < 4; ++i) ogr[i] = *(const u32x4*)(Zb + (size_t)(tokl + (tid >> 3)) * ZLD + ZC_O + h * 256 + 32 * (tid & 7) + 8 * i);
        u32x4 rawq[2][4], kt[2];
#pragma unroll
        for (int rep = 0; rep < 2; ++rep) { const int t = (tid + rep * NTHR) >> 4; conv_load(Zb, bl, c * LCH + t, h * 128 + c8 * 8, rawq[rep]);
            kt[rep] = *(const u32x4*)((const bf16*)(ws + WS_KC) + (size_t)(tokl + t) * 512 + h * 128 + c8 * 8); }
        if (wave == 0) {
            const float lf = gf[(size_t)(tokg + lane) * 4 + h], ii = gi[(size_t)(tokg + lane) * 4 + h];
            const float bc = wave_incl_scan_add(lf, lane); const float rr = ii - bc; const float cm = wave_incl_scan_max(rr, lane);
            const float mst = ((const float*)(ws + WS_CSC))[(size_t)(bhl * NCH + c) * 4 + 2];
            const float Mt = fmaxf(mst, cm);
            SC[lane] = rr; SC[64 + lane] = Mt; SC[128 + lane] = __expf(mst - Mt); SC[192 + lane] = __expf(-(bc + Mt));
        } else if (wave == 1 || wave == 2) { const int d = (wave - 1) * 64 + lane; SC[320 + d] = ((const float*)(ws + WS_NST))[(size_t)(bhl * NCH + c) * 128 + d]; }
#pragma unroll
        for (int rep = 0; rep < 2; ++rep) { const int idx = tid + rep * NTHR, t = idx >> 4; float o[8];
            conv_apply(rawq[rep], CWL + c8 * 8, 256, o);
            u32x4 w; w.x = pk2(o[0], o[1]); w.y = pk2(o[2], o[3]); w.z = pk2(o[4], o[5]); w.w = pk2(o[6], o[7]);
            *(LAS u32x4*)(QS + t * 136 + c8 * 8) = w;
            *(LAS u32x4*)(KS + t * 136 + c8 * 8) = kt[rep]; }
        __syncthreads();
        {
            const int tb = wave >> 1, fr = lane & 15, fq = lane >> 4;
#pragma unroll
            for (int i = 0; i < 2; ++i) { const int sblk = (wave & 1) * 2 + i; f32x4 acc = (f32x4){0.f, 0.f, 0.f, 0.f};
                if (sblk <= tb) {
#pragma unroll
                    for (int ks = 0; ks < 4; ++ks) { const bf16x8 af = *(const LAS bf16x8*)(QS + (16 * tb + fr) * 136 + 32 * ks + 8 * fq), bfv = *(const LAS bf16x8*)(KS + (16 * sblk + fr) * 136 + 32 * ks + 8 * fq);
                        acc = __builtin_amdgcn_mfma_f32_16x16x32_bf16(af, bfv, acc, 0, 0, 0); } }
                const int s = 16 * sblk + fr; const float rs_ = SC[s];
#pragma unroll
                for (int e = 0; e < 4; ++e) { const int t = 16 * tb + 4 * fq + e; const float val = (s <= t) ? acc[e] * __expf(rs_ - SC[64 + t]) : 0.f; SD[t * 72 + s] = (bf16)f2bf(val); } }
        }
        f32x16 aQ0, aQ1, aS0, aS1;
#pragma unroll
        for (int e = 0; e < 16; ++e) { aQ0[e] = 0.f; aQ1[e] = 0.f; aS0[e] = 0.f; aS1[e] = 0.f; }
#pragma unroll
        for (int ks = 0; ks < 8; ++ks) {
            const bf16x8 a0 = *(const LAS bf16x8*)(QS + r * 136 + 16 * ks + 8 * hh), a1 = *(const LAS bf16x8*)(QS + (32 + r) * 136 + 16 * ks + 8 * hh);
            aQ0 = __builtin_amdgcn_mfma_f32_32x32x16_bf16(a0, bC[ks], aQ0, 0, 0, 0); aQ1 = __builtin_amdgcn_mfma_f32_32x32x16_bf16(a1, bC[ks], aQ1, 0, 0, 0); }
        __syncthreads();
        {
            const int t = tid >> 3, p = tid & 7; float ds = 0.f, qn = 0.f;
#pragma unroll
            for (int k = 0; k < 8; ++k) ds += bf1(SD[t * 72 + 8 * p + k]);
#pragma unroll
            for (int k = 0; k < 16; ++k) qn += bf1(QS[t * 136 + 16 * p + k]) * SC[320 + 16 * p + k];
            float den = ds + SC[128 + t] * qn;
            den += __shfl_xor(den, 1); den += __shfl_xor(den, 2); den += __shfl_xor(den, 4);
            if (p == 0) SC[256 + t] = 1.f / fmaxf(fabsf(den), SC[192 + t]);
        }
#pragma unroll
        for (int ks = 0; ks < 4; ++ks) {
            const bf16x8 a0 = *(const LAS bf16x8*)(SD + r * 72 + 16 * ks + 8 * hh), a1 = *(const LAS bf16x8*)(SD + (32 + r) * 72 + 16 * ks + 8 * hh);
            aS0 = __builtin_amdgcn_mfma_f32_32x32x16_bf16(a0, bV[ks], aS0, 0, 0, 0); aS1 = __builtin_amdgcn_mfma_f32_32x32x16_bf16(a1, bV[ks], aS1, 0, 0, 0); }
        __syncthreads();
#pragma unroll
        for (int e = 0; e < 16; ++e) { const int t0 = (e & 3) + 8 * (e >> 2) + 4 * hh;
            HB[t0 * 260 + v0 + r] = (aS0[e] + SC[128 + t0] * aQ0[e]) * SC[256 + t0]; HB[(32 + t0) * 260 + v0 + r] = (aS1[e] + SC[128 + 32 + t0] * aQ1[e]) * SC[256 + 32 + t0]; }
        __syncthreads();
        {
            const int t = tid >> 3, p = tid & 7; f32x4 x[8]; float sm = 0.f;
#pragma unroll
            for (int k = 0; k < 8; ++k) { x[k] = *(const LAS f32x4*)(HB + t * 260 + 32 * p + 4 * k); sm += (x[k].x + x[k].y) + (x[k].z + x[k].w); }
            sm += __shfl_xor(sm, 1); sm += __shfl_xor(sm, 2); sm += __shfl_xor(sm, 4);
            const float mean = sm * (1.f / 256.f); float sq = 0.f;
#pragma unroll
            for (int k = 0; k < 8; ++k) { x[k] = x[k] - mean; sq += (x[k].x * x[k].x + x[k].y * x[k].y) + (x[k].z * x[k].z + x[k].w * x[k].w); }
            sq += __shfl_xor(sq, 1); sq += __shfl_xor(sq, 2); sq += __shfl_xor(sq, 4);
            const float rstd = rsqrtf(sq * (1.f / 256.f) + EPS);
            const float* gp = gain + h * 256 + 32 * p; bf16* op = Zb + (size_t)(tokl + t) * ZLD + out_col + h * 256 + 32 * p;
#pragma unroll
            for (int i = 0; i < 4; ++i) { const f32x4 g0 = *(const f32x4*)(gp + 8 * i), g1 = *(const f32x4*)(gp + 8 * i + 4); const f32x4 a = x[2 * i] * rstd * g0, b = x[2 * i + 1] * rstd * g1; const u32x4 og = ogr[i]; u32x4 w;
                w.x = pk2(a.x * bflo(og.x), a.y * bfhi(og.x)); w.y = pk2(a.z * bflo(og.y), a.w * bfhi(og.y)); w.z = pk2(b.x * bflo(og.z), b.y * bfhi(og.z)); w.w = pk2(b.z * bflo(og.w), b.w * bfhi(og.w));
                *(u32x4*)(op + 8 * i) = w; }
        }
        __syncthreads();
    }
}

__device__ __forceinline__ void sgu_phase(const Args& a, int l, unsigned char* ws, LAS unsigned char* lds, int G, int cu, int tid, int wave, int lane, const int out_col) {
    bf16* Zb = (bf16*)(ws + WS_Z); const bf16* ZT = (const bf16*)(ws + WS_ZT); const bf16* Wc = (const bf16*)(ws + WS_WSGU);
    const float* lng = a.in[I_SLNG] + (size_t)l * 1024; const float* lnb = a.in[I_SLNB] + (size_t)l * 1024; const float* bs = a.in[I_SBS] + (size_t)l * 4 * 128;
    LAS bf16* VT = (LAS bf16*)lds;
    LAS float* PS = (LAS float*)(lds + 69632);
    LAS float* ST = (LAS float*)(lds + 69632 + 8192);
    LAS bf16* WS_ = (LAS bf16*)(lds + 78848);
    const int c8 = tid & 15, dq = tid >> 4;
    int gcur = -1;
    u32x4 x[8];
    if (cu < 4 * 32 * 4) { const int g = cu & 3, cc = (cu >> 2) & 31, bl = cu >> 7;
#pragma unroll
        for (int rep = 0; rep < 8; ++rep) x[rep] = *(const u32x4*)(ZT + (size_t)(1024 + g * 256 + dq + 32 * rep) * ZTLD + bl * SEQ + cc * 128 + c8 * 8); }
    for (int u = cu; u < 4 * 32 * 4; u += G) {
        const int g = u & 3, cc = (u >> 2) & 31, bl = u >> 7; const int tokl = bl * SEQ + cc * 128;
        if (g != gcur) { __syncthreads();
#pragma unroll
            for (int rep = 0; rep < 4; ++rep) { const int idx = tid + rep * NTHR, t = idx >> 4; *(LAS u32x4*)(WS_ + t * 136 + c8 * 8) = *(const u32x4*)(Wc + (size_t)(g * 128 + t) * 128 + c8 * 8); }
            gcur = g; }
        {
            float sm[8], sq[8];
#pragma unroll
            for (int k = 0; k < 8; ++k) { sm[k] = 0.f; sq[k] = 0.f; }
#pragma unroll
            for (int rep = 0; rep < 8; ++rep) { const u32x4 v = x[rep]; const float f0 = bflo(v.x), f1 = bfhi(v.x), f2 = bflo(v.y), f3 = bfhi(v.y), f4 = bflo(v.z), f5 = bfhi(v.z), f6 = bflo(v.w), f7 = bfhi(v.w);
                sm[0] += f0; sq[0] += f0 * f0; sm[1] += f1; sq[1] += f1 * f1; sm[2] += f2; sq[2] += f2 * f2; sm[3] += f3; sq[3] += f3 * f3;
                sm[4] += f4; sq[4] += f4 * f4; sm[5] += f5; sq[5] += f5 * f5; sm[6] += f6; sq[6] += f6 * f6; sm[7] += f7; sq[7] += f7 * f7; }
#pragma unroll
            for (int k = 0; k < 8; ++k) { sm[k] += __shfl_xor(sm[k], 16); sq[k] += __shfl_xor(sq[k], 16); sm[k] += __shfl_xor(sm[k], 32); sq[k] += __shfl_xor(sq[k], 32); }
            if (lane < 16) {
#pragma unroll
                for (int k = 0; k < 8; ++k) { PS[(wave * 128 + c8 * 8 + k) * 2] = sm[k]; PS[(wave * 128 + c8 * 8 + k) * 2 + 1] = sq[k]; } }
        }
        __syncthreads();
        if (tid < 128) { float sm = 0.f, sq = 0.f;
#pragma unroll
            for (int p = 0; p < 8; ++p) { sm += PS[(p * 128 + tid) * 2]; sq += PS[(p * 128 + tid) * 2 + 1]; }
            const float mean = sm * (1.f / 256.f); const float var = fmaxf(sq * (1.f / 256.f) - mean * mean, 0.f); ST[tid] = mean; ST[128 + tid] = rsqrtf(var + EPS); }
        __syncthreads();
        { const LAS float* mp = ST + c8 * 8; const LAS float* rp = ST + 128 + c8 * 8; float mm[8], rr[8];
#pragma unroll
            for (int k = 0; k < 8; ++k) { mm[k] = mp[k]; rr[k] = rp[k]; }
#pragma unroll
            for (int rep = 0; rep < 8; ++rep) { const int d = dq + 32 * rep; const float gg = lng[g * 256 + d], bb = lnb[g * 256 + d]; u32x4 v = x[rep];
                v.x = pk2((bflo(v.x) - mm[0]) * rr[0] * gg + bb, (bfhi(v.x) - mm[1]) * rr[1] * gg + bb); v.y = pk2((bflo(v.y) - mm[2]) * rr[2] * gg + bb, (bfhi(v.y) - mm[3]) * rr[3] * gg + bb);
                v.z = pk2((bflo(v.z) - mm[4]) * rr[4] * gg + bb, (bfhi(v.z) - mm[5]) * rr[5] * gg + bb); v.w = pk2((bflo(v.w) - mm[6]) * rr[6] * gg + bb, (bfhi(v.w) - mm[7]) * rr[7] * gg + bb);
                *(LAS u32x4*)(VT + d * 136 + c8 * 8) = v; } }
        if (u + G < 4 * 32 * 4) { const int un = u + G, gn = un & 3, ccn = (un >> 2) & 31, bln = un >> 7;
#pragma unroll
            for (int rep = 0; rep < 8; ++rep) x[rep] = *(const u32x4*)(ZT + (size_t)(1024 + gn * 256 + dq + 32 * rep) * ZTLD + bln * SEQ + ccn * 128 + c8 * 8); }
        __syncthreads();
        {
            const int r = lane & 31, hh = lane >> 5, d0 = 32 * wave;
            u32x2 uu[4][4];
#pragma unroll
            for (int tb = 0; tb < 4; ++tb)
#pragma unroll
                for (int q = 0; q < 4; ++q) uu[tb][q] = *(const u32x2*)(Zb + (size_t)(tokl + 32 * tb + r) * ZLD + ZC_U + g * 256 + d0 + 4 * hh + 8 * q);
            f32x16 acc[4];
#pragma unroll
            for (int tb = 0; tb < 4; ++tb)
#pragma unroll
                for (int e = 0; e < 16; ++e) acc[tb][e] = 0.f;
#pragma unroll
            for (int ks = 0; ks < 8; ++ks) { const bf16x8 af = *(const LAS bf16x8*)(VT + (d0 + r) * 136 + 16 * ks + 8 * hh);
#pragma unroll
                for (int tb = 0; tb < 4; ++tb) if (16 * ks <= 32 * tb + 31) { const bf16x8 bfv = *(const LAS bf16x8*)(WS_ + (32 * tb + r) * 136 + 16 * ks + 8 * hh);
                    acc[tb] = __builtin_amdgcn_mfma_f32_32x32x16_bf16(af, bfv, acc[tb], 0, 0, 0); } }
#pragma unroll
            for (int tb = 0; tb < 4; ++tb) { const int t = 32 * tb + r; const float bias = bs[g * 128 + t]; bf16* rowp = Zb + (size_t)(tokl + t) * ZLD + out_col + g * 256 + d0 + 4 * hh;
#pragma unroll
                for (int q = 0; q < 4; ++q) { const u32x2 v = uu[tb][q]; u32x2 w;
                    w.x = pk2(bflo(v.x) * (acc[tb][4 * q] + bias), bfhi(v.x) * (acc[tb][4 * q + 1] + bias)); w.y = pk2(bflo(v.y) * (acc[tb][4 * q + 2] + bias), bfhi(v.y) * (acc[tb][4 * q + 3] + bias)); *(u32x2*)(rowp + 8 * q) = w; } }
        }
        __syncthreads();
    }
}

__device__ __forceinline__ void softmax_rows(unsigned char* ws, int gw, int NGW, int lane) {
    bf16* Zb = (bf16*)(ws + WS_Z);
    for (int m = gw; m < MH; m += NGW) {
        u32x4* p = (u32x4*)(Zb + (size_t)m * ZLD + ZC_XQ + 16 * lane); const u32x4 x0 = p[0], x1 = p[1];
        float v[16] = { bflo(x0.x), bfhi(x0.x), bflo(x0.y), bfhi(x0.y), bflo(x0.z), bfhi(x0.z), bflo(x0.w), bfhi(x0.w), bflo(x1.x), bfhi(x1.x), bflo(x1.y), bfhi(x1.y), bflo(x1.z), bfhi(x1.z), bflo(x1.w), bfhi(x1.w) };
        float mx = v[0];
#pragma unroll
        for (int e = 1; e < 16; ++e) mx = fmaxf(mx, v[e]);
#pragma unroll
        for (int o = 1; o < 16; o <<= 1) mx = fmaxf(mx, __shfl_xor(mx, o));
        float s = 0.f;
#pragma unroll
        for (int e = 0; e < 16; ++e) { v[e] = __expf(v[e] - mx); s += v[e]; }
#pragma unroll
        for (int o = 1; o < 16; o <<= 1) s += __shfl_xor(s, o);
        const float inv = 1.f / s;
        u32x4 y0, y1; y0.x = pk2(v[0] * inv, v[1] * inv); y0.y = pk2(v[2] * inv, v[3] * inv); y0.z = pk2(v[4] * inv, v[5] * inv); y0.w = pk2(v[6] * inv, v[7] * inv);
        y1.x = pk2(v[8] * inv, v[9] * inv); y1.y = pk2(v[10] * inv, v[11] * inv); y1.z = pk2(v[12] * inv, v[13] * inv); y1.w = pk2(v[14] * inv, v[15] * inv);
        p[0] = y0; p[1] = y1;
    }
}

__global__ void __launch_bounds__(NTHR, 2) trunk_fwd(Args args) {
    extern __shared__ __attribute__((aligned(16))) unsigned char lds_raw[];
    LAS unsigned char* lds = (LAS unsigned char*)lds_raw;
    volatile LAS unsigned* MISC = (volatile LAS unsigned*)(lds + MISC_OFF);
    const int G = gridDim.x, cu = blockIdx.x;
    unsigned char* ws = args.ws;
#define PHASE_IDS() int tid = threadIdx.x; asm volatile("" : "+v"(tid)); const int lane = tid & 63, wave = __builtin_amdgcn_readfirstlane(tid >> 6); \
    const int vcu = (G % 8 == 0) ? (cu % 8) * (G / 8) + cu / 8 : cu; const int gw = vcu * NWAVES + wave, NGW = G * NWAVES, gtid = cu * NTHR + tid, GT = G * NTHR; (void)gw; (void)NGW; (void)gtid; (void)GT; (void)lane
    for (int u = threadIdx.x; u < (LDS_BYTES - RING_BYTES) / 4; u += NTHR) ((LAS unsigned*)(lds + RING_BYTES))[u] = 0u;
    __syncthreads();
    XcdBarrier bar = xcd_barrier_post((unsigned*)(ws + WS_CTL) + 4096, MISC + 8);
    const int lo = args.ph_lo, hi = args.ph_hi;
    int ph = 0;
#define IN() (lo <= ph && ph < hi)
#define SEAM() do { if (lo <= ph && ph + 1 < hi) xcd_barrier(bar); ++ph; } while (0)
    bf16* XN = (bf16*)(ws + WS_XN); bf16* Wb = (bf16*)(ws + WS_W); float* RSTD = (float*)(ws + WS_RSTD);
    float* hbuf = args.out;

    if (IN()) { PHASE_IDS();
        convert_layer(args, 0, ws, lds, gw, NGW, wave, lane, gtid, GT);
        thin_rows(nullptr, 0, nullptr, 0.f, args.in[I_X], nullptr, XN, RSTD, nullptr, 0, M, gw, NGW, lane, false, nullptr, nullptr, nullptr, nullptr, nullptr);
        __syncthreads();
    }
    SEAM();

    for (int sb = 0; sb < 2 * DEPTH; ++sb) {
        const int l = sb >> 1, j = sb & 1;
        const float* ng = args.in[I_NORMG] + (size_t)l * NNORM * D;
        if (IN()) { PHASE_IDS();
            pg8::Gemm g{D, D, D}; pg8::TileSched S; S.init(M / 256, 2 * DFF / 256, G, cu, XN, D * 2, (char*)Wb + (j ? WO_GU1 : WO_GU0), D * 2);
            pg8::EpiGU E{(bf16*)(ws + WS_HID), RSTD};
            pg8::gemm_phase(lds, g, S, E, tid);
        }
        SEAM();
        if (IN()) { PHASE_IDS();
            pg8::Gemm g{DFF, DFF, DFF}; pg8::TileSched S; S.init(M / 256, D / 256, G, cu, ws + WS_HID, DFF * 2, (char*)Wb + (j ? WO_D1 : WO_D0), DFF * 2);
            pg8::EpiAct E{(bf16*)(ws + WS_F), (size_t)D, 0, nullptr, nullptr};
            pg8::gemm_phase(lds, g, S, E, tid);
        }
        SEAM();
        if (IN()) { PHASE_IDS();
            const float* hin = (sb == 0) ? args.in[I_X] : hbuf;
            if (j == 0) {
                LAS float* wif = (LAS float*)lds;
                for (int e = tid; e < D * 8 / 4; e += NTHR) ((LAS f32x4*)wif)[e] = ((const f32x4*)(ws + WS_WIF))[e];
                __syncthreads();
                float* gi = (float*)(ws + WS_GATE);
                const float* hx = (sb == 0) ? args.in[I_X] : nullptr;
                if (G == 256) {
                    const bool kvcu = (cu < 32) || (cu >= 128 && cu < 160);
                    if (kvcu) { const int gwk = ((cu < 32) ? cu : cu - 96) * NWAVES + wave;
                        thin_rows((const bf16*)(ws + WS_F), D, ng + 1 * D, 0.5f, hx, XN, XN, RSTD, nullptr, 0, 1024, gwk, 512, lane, true, wif, args.in[I_BI] + l * 4, args.in[I_BF] + l * 4, gi, gi + (size_t)M * 4); }
                    else { const int cun = (cu < 128) ? cu - 32 : cu - 64; const int gwn = cun * NWAVES + wave;
                        thin_rows((const bf16*)(ws + WS_F) + (size_t)1024 * D, D, ng + 1 * D, 0.5f, hx, XN, XN, RSTD, nullptr, 1024, M, gwn, 1536, lane, true, wif, args.in[I_BI] + l * 4, args.in[I_BF] + l * 4, gi, gi + (size_t)M * 4); }
                } else
                thin_rows((const bf16*)(ws + WS_F), D, ng + 1 * D, 0.5f, hx, XN, XN, RSTD, nullptr, 0, M, gw, NGW, lane, true, wif, args.in[I_BI] + l * 4, args.in[I_BF] + l * 4, gi, gi + (size_t)M * 4);
                __syncthreads();
                {
                    pg8::Gemm g{D, D, D};
                    pg8::TileSched S; S.init(MMEM / 256, D / 256, G, cu, ws + WS_MEMN, D * 2, (char*)Wb + WO_MKV, D * 2);
                    pg8::EpiAct E{(bf16*)(ws + WS_KMEM), (size_t)D, 0, nullptr, nullptr};
                    pg8::gemm_phase(lds, g, S, E, tid);
                    pg8::TileSched S2; S2.init(D / 256, MMEM / 256, G, (cu + G / 2) % G, (char*)Wb + WO_MKV + (size_t)D * D * 2, D * 2, ws + WS_MEMN, D * 2);
                    pg8::EpiAct E2{(bf16*)(ws + WS_VTMEM), (size_t)MMEM, 0, nullptr, nullptr};
                    pg8::gemm_phase(lds, g, S2, E2, tid);
                }
            } else {
                const bool lastl = (l + 1 == DEPTH);
                thin_rows((const bf16*)(ws + WS_F), D, ng + 5 * D, 0.5f, nullptr, XN, lastl ? nullptr : XN, RSTD, lastl ? hbuf : nullptr, 0, M, gw, NGW, lane, false, nullptr, nullptr, nullptr, nullptr, nullptr);
                if (l + 1 < DEPTH) { __syncthreads(); convert_layer(args, l + 1, ws, lds, gw, NGW, wave, lane, gtid, GT); __syncthreads(); }
            }
        }
        SEAM();
        if (j == 0) {
            for (int hf = 0; hf < 2; ++hf) {
                bf16* Zb = (bf16*)(ws + WS_Z);
                if (IN()) { PHASE_IDS();
                    pg8::Gemm g{D, D, D};
                    pg8::TileSched S; S.init(MH / 256, ZLD / 256, G, cu, XN + (size_t)hf * MH * D, D * 2, (char*)Wb + WO_IN, D * 2);
                    pg8::EpiAct E{Zb, (size_t)ZLD, 1, RSTD + (size_t)hf * MH, nullptr};
                    pg8::gemm_phase(lds, g, S, E, tid);
                    pg8::TileSched S2; S2.init(2048 / 256, MH / 256, G, cu, (char*)Wb + WO_IN + (size_t)ZLD * D * 2, D * 2, XN + (size_t)hf * MH * D, D * 2);
                    pg8::EpiAct E2{(bf16*)(ws + WS_ZT), (size_t)ZTLD, 2, nullptr, RSTD + (size_t)hf * MH};
                    pg8::gemm_phase(lds, g, S2, E2, tid);
                }
                SEAM();
                if (IN()) { PHASE_IDS();
                    mlstm_s1(args, l, hf, ws, lds, G, cu, tid, wave, lane);
                    sgu_phase(args, l, ws, lds, G, cu, tid, wave, lane, ZC_U);
                    pg8::Gemm g{256, ZLD, D};
                    pg8::TileSched S; S.init(MH / 256, 4, G, cu, Zb + ZC_XQ, ZLD * 2, (bf16*)(ws + WS_KMEM) + (size_t)hf * 4 * MEMLEN * D, 0);
                    S.a_pn = 512; S.b_tile = 512; S.pm_per_b = 16; S.b_batch = (size_t)MEMLEN * D * 2;
                    pg8::EpiAct E{Zb + ZC_XQ, (size_t)ZLD, 0, nullptr, nullptr};
                    pg8::gemm_phase(lds, g, S, E, tid);
                    for (int i = 0; ; ++i) { pg8::Unit uu; if (!S.next(i, uu)) break;
                        bf16* tb_ = Zb + (size_t)(uu.pm * 256 + wave * 32 + (lane >> 4)) * ZLD + ZC_XQ + uu.pn * 256 + 16 * (lane & 15);
                        for (int r0 = 0; r0 < 32; r0 += 16) {
                            unsigned long long w[4][4];
#pragma unroll
                            for (int q = 0; q < 4; ++q) { unsigned long long* p = (unsigned long long*)(tb_ + (size_t)(r0 + 4 * q) * ZLD);
#pragma unroll
                                for (int e = 0; e < 4; ++e) w[q][e] = __hip_atomic_load(p + e, __ATOMIC_RELAXED, __HIP_MEMORY_SCOPE_AGENT); }
#pragma unroll
                            for (int q = 0; q < 4; ++q) { float v[16];
#pragma unroll
                                for (int e = 0; e < 4; ++e) { const unsigned lo_ = (unsigned)w[q][e], hi_ = (unsigned)(w[q][e] >> 32); v[4 * e] = bflo(lo_); v[4 * e + 1] = bfhi(lo_); v[4 * e + 2] = bflo(hi_); v[4 * e + 3] = bfhi(hi_); }
                                float mx = v[0];
#pragma unroll
                                for (int e = 1; e < 16; ++e) mx = fmaxf(mx, v[e]);
#pragma unroll
                                for (int o = 1; o < 16; o <<= 1) mx = fmaxf(mx, __shfl_xor(mx, o));
                                float sm = 0.f;
#pragma unroll
                                for (int e = 0; e < 16; ++e) { v[e] = __expf(v[e] - mx); sm += v[e]; }
#pragma unroll
                                for (int o = 1; o < 16; o <<= 1) sm += __shfl_xor(sm, o);
                                const float inv = __builtin_amdgcn_rcpf(sm);
                                u32x4* po = (u32x4*)(tb_ + (size_t)(r0 + 4 * q) * ZLD); u32x4 y0, y1;
                                y0.x = pk2(v[0] * inv, v[1] * inv); y0.y = pk2(v[2] * inv, v[3] * inv); y0.z = pk2(v[4] * inv, v[5] * inv); y0.w = pk2(v[6] * inv, v[7] * inv);
                                y1.x = pk2(v[8] * inv, v[9] * inv); y1.y = pk2(v[10] * inv, v[11] * inv); y1.z = pk2(v[12] * inv, v[13] * inv); y1.w = pk2(v[14] * inv, v[15] * inv);
                                po[0] = y0; po[1] = y1; } } }
                }
                SEAM();
                if (IN()) { PHASE_IDS();
                    mlstm_s2(ws, G, cu, tid);
                }
                SEAM();
                if (IN()) { PHASE_IDS();
                    mlstm_s3(args, l, hf, ws, lds, G, cu, tid, wave, lane, ZC_O);
#ifdef PROBE_S3
                    for (int rep_ = 0; rep_ < 2; ++rep_) mlstm_s3(args, l, hf, ws, lds, G, cu, tid, wave, lane, ZC_QK);
#endif
#ifdef PROBE_SGU
                    for (int rep_ = 0; rep_ < 2; ++rep_) sgu_phase(args, l, ws, lds, G, cu, tid, wave, lane, ZC_QK);
#endif
                    pg8::Gemm g{256, ZLD, MMEM};
                    pg8::TileSched S; S.init(MH / 256, 4, G, cu, Zb + ZC_XQ, ZLD * 2, (bf16*)(ws + WS_VTMEM) + (size_t)hf * 4 * MEMLEN, 0);
                    S.a_pn = 512; S.b_tile = (size_t)256 * MMEM * 2; S.pm_per_b = 16; S.b_batch = (size_t)MEMLEN * 2;
                    pg8::EpiAct E{Zb + ZC_XQ, (size_t)ZLD, 0, nullptr, nullptr};
                    pg8::gemm_phase(lds, g, S, E, tid);
                }
                SEAM();
                if (IN()) { PHASE_IDS();
                    pg8::Gemm g{D, ZLD, D};
                    pg8::TileSched S; S.init(MH / 256, D / 256, G, cu, Zb + ZC_O, ZLD * 2, (char*)Wb + WO_BR, D * 2);
                    S.reps = 3; S.a_rep = 1024 * 2; S.b_rep = (size_t)D * D * 2;
                    pg8::EpiBranch E{Zb};
                    pg8::gemm_phase(lds, g, S, E, tid);
                }
                SEAM();
                if (IN()) { PHASE_IDS();
                    pg8::Gemm g{D, ZLD, D};
                    pg8::TileSched S; S.init(MH / 256, D / 256, G, cu, Zb + ZC_QK, ZLD * 2, (char*)Wb + WO_OUT, D * 2);
                    pg8::EpiAct E{Zb + ZC_O, (size_t)ZLD, 0, nullptr, nullptr};
                    pg8::gemm_phase(lds, g, S, E, tid);
                }
                SEAM();
                if (IN()) { PHASE_IDS();
                    thin_rows(Zb + ZC_O, ZLD, ng + 3 * D, 1.0f, nullptr, XN, XN, RSTD, nullptr, hf * MH, (hf + 1) * MH, gw, NGW, lane, false, nullptr, nullptr, nullptr, nullptr, nullptr);
                }
                SEAM();
            }
        }
    }
#undef IN
#undef SEAM
}
constexpr int N_PHASES = 1 + 2 * DEPTH * 3 + DEPTH * 2 * 7;

#ifndef N_LAUNCH_MODE
#define N_LAUNCH_MODE 0
#endif
extern "C" void kernel_launch(void* const* d_in, const int* in_sizes, int n_in, void* d_out, int out_size, void* d_ws, size_t ws_size, hipStream_t stream) {
    static int grid = 0;
    if (grid == 0) {
        if (n_in != 18 || out_size != M * D || ws_size < WS_END) { fprintf(stderr, "kernel_launch: unexpected shapes (n_in %d out %d ws %zu)\n", n_in, out_size, ws_size); grid = -1; return; }
        int dev = 0, cus = 0, per_cu = 0;
        if (hipGetDevice(&dev) != hipSuccess || hipDeviceGetAttribute(&cus, hipDeviceAttributeMultiprocessorCount, dev) != hipSuccess) { grid = -1; return; }
        if (hipFuncSetAttribute((const void*)trunk_fwd, hipFuncAttributeMaxDynamicSharedMemorySize, LDS_BYTES) != hipSuccess) { grid = -1; return; }
        if (hipOccupancyMaxActiveBlocksPerMultiprocessor(&per_cu, (const void*)trunk_fwd, NTHR, LDS_BYTES) != hipSuccess || per_cu < 1) { fprintf(stderr, "kernel_launch: occupancy query says %d\n", per_cu); }
        (void)hipGetLastError();
        grid = cus;
    }
    if (grid < 0) return;
    (void)hipMemsetAsync((char*)d_ws + WS_CTL, 0, CTL_ZERO_BYTES, stream);
    Args a{};
    for (int i = 0; i < 18; ++i) a.in[i] = (const float*)d_in[i];
    a.out = (float*)d_out; a.ws = (unsigned char*)d_ws;
#if N_LAUNCH_MODE == 0
    a.ph_lo = 0; a.ph_hi = N_PHASES;
    hipLaunchKernelGGL(trunk_fwd, dim3(grid), dim3(NTHR), LDS_BYTES, stream, a);
#else
    for (int p = 0; p < N_PHASES; ++p) { a.ph_lo = p; a.ph_hi = p + 1; hipLaunchKernelGGL(trunk_fwd, dim3(grid), dim3(NTHR), LDS_BYTES, stream, a); }
#endif
}
```

```cpp
#include <hip/hip_runtime.h>
#include <cstdio>
#include <cstdint>

#define LAS __attribute__((address_space(3)))
#define GAS __attribute__((address_space(1)))
typedef unsigned short bf16;
typedef short bf16x8 __attribute__((ext_vector_type(8)));
typedef float f32x4 __attribute__((ext_vector_type(4)));
typedef float f32x16 __attribute__((ext_vector_type(16)));
typedef unsigned u32x4 __attribute__((ext_vector_type(4)));
typedef unsigned u32x2 __attribute__((ext_vector_type(2)));

constexpr int D = 1024, BATCH = 8, SEQ = 4096, DEPTH = 2, MEMLEN = 256, DFF = 2816, NNORM = 7;
constexpr int M = BATCH * SEQ, MH = M / 2, MMEM = BATCH * MEMLEN;
constexpr int WIN_COLS = 9224;
constexpr int LCH = 64, NCH = SEQ / LCH;
constexpr int ZLD = 7168;
constexpr int ZC_QK = 0, ZC_O = 1024, ZC_U = 2048, ZC_XQ = 3072, ZC_G = 4096;
constexpr int ZTLD = MH;
constexpr float EPS = 1e-6f;
constexpr int NWAVES = 8, NTHR = 512;

constexpr size_t MiB = 1u << 20;
constexpr size_t WS_CTL = 0, CTL_ZERO_BYTES = 1 * MiB;
constexpr size_t WS_WSGU = 1 * MiB;
constexpr size_t WS_GATE = 2 * MiB;
constexpr size_t WS_NST = 3 * MiB;
constexpr size_t WS_CSC = 4 * MiB;
constexpr size_t WS_MEMN = 5 * MiB;
constexpr size_t WS_KMEM = 9 * MiB;
constexpr size_t WS_VTMEM = 13 * MiB;
constexpr size_t WS_W = 17 * MiB;
constexpr size_t WO_GU0 = 0, WO_GU1 = 11 * MiB, WO_D0 = 22 * MiB, WO_D1 = WO_D0 + 5632 * 1024, WO_IN = 33 * MiB, WO_MKV = 51 * MiB, WO_BR = 55 * MiB, WO_OUT = 61 * MiB;
constexpr size_t WS_XN = 80 * MiB;
constexpr size_t WS_WIF = 4 * MiB + 256 * 1024;
constexpr size_t WS_RSTD = 4 * MiB + 512 * 1024;
constexpr size_t WS_BIG = 144 * MiB;
constexpr size_t WS_HID = WS_BIG, WS_F = WS_BIG + 176 * MiB, WS_Z = WS_BIG, WS_ZT = WS_BIG + 224 * MiB;
constexpr size_t WS_ST = 432 * MiB;
constexpr size_t WS_KC = 496 * MiB;
constexpr size_t WS_END = 512 * MiB;

constexpr int LDS_BYTES = 147456;
constexpr int RING_BYTES = 131072;
constexpr int MISC_OFF = RING_BYTES + 320;

typedef float f32x2_t __attribute__((ext_vector_type(2))); typedef __bf16 bf16x2_t __attribute__((ext_vector_type(2)));
__device__ __forceinline__ unsigned pk2(float lo, float hi) { f32x2_t v = {lo, hi}; bf16x2_t b = __builtin_convertvector(v, bf16x2_t); return __builtin_bit_cast(unsigned, b); }
__device__ __forceinline__ unsigned f2bf(float f) { return pk2(f, 0.f) & 0xffffu; }
__device__ __forceinline__ float bflo(unsigned w) { return __uint_as_float(w << 16); }
__device__ __forceinline__ float bfhi(unsigned w) { return __uint_as_float(w & 0xffff0000u); }
__device__ __forceinline__ float bf1(bf16 b) { return __uint_as_float((unsigned)b << 16); }
__device__ __forceinline__ float shx(float v, int mask, int lane) { return __builtin_bit_cast(float, __builtin_amdgcn_ds_bpermute((lane ^ mask) << 2, __builtin_bit_cast(int, v))); }
__device__ __forceinline__ float shidx(float v, int src) { return __builtin_bit_cast(float, __builtin_amdgcn_ds_bpermute(src << 2, __builtin_bit_cast(int, v))); }
__device__ __forceinline__ float wave_sum(float v, int lane) {
#pragma unroll
    for (int o = 1; o < 64; o <<= 1) v += shx(v, o, lane);
    return v;
}
__device__ __forceinline__ float sigmoidf_(float x) { return __builtin_amdgcn_rcpf(1.f + __expf(-x)); }
__device__ __forceinline__ float siluf_(float x) { return x * __builtin_amdgcn_rcpf(1.f + __expf(-x)); }
__device__ __forceinline__ float gelu_tanh(float x) { const float u = 1.5957691216f * (x + 0.044715f * x * x * x); return x * __builtin_amdgcn_rcpf(1.f + __expf(-u)); }
__device__ __forceinline__ float logsigmoidf_(float x) { return fminf(x, 0.f) - __logf(1.f + __expf(-fabsf(x))); }
#define LDS_WAIT() asm volatile("s_waitcnt lgkmcnt(0)" ::: "memory")
#define VM_WAIT() asm volatile("s_waitcnt vmcnt(0)" ::: "memory")

namespace pg8 {
constexpr int BM = 256, BK = 64, HALF = 128, HTB = HALF * BK * 2, STAGE_BYTES = 8 * HTB, NXCD = 8, WGM = 8;
__host__ __device__ __forceinline__ int lds_byte(int r, int c) { const int st = (r >> 4) * 2 + (c >> 5), rr = r & 15, cc = c & 31, ob = rr * 64 + cc * 2; return st * 1024 + (ob ^ (((ob >> 9) & 1) << 5)); }
__host__ __device__ __forceinline__ void stage_rc(int b, int& R, int& C) { const int st = b / 1024, sb = b % 1024, swz = sb ^ (((sb >> 9) & 1) << 5); R = (st >> 1) * 16 + swz / 64; C = (st & 1) * 32 + (swz % 64) / 2; }
__host__ __device__ __forceinline__ int perm32(int rho) { const int n = rho >> 4, i = rho & 15; return 8 * (i >> 2) + 4 * n + (i & 3); }

struct Unit { int pm, pn, aux; const char* a; const char* b; };
struct Gemm { int K, lda, ldb; };

struct TileSched {
    int nM, nN, nwg, G, c, reps, pm_per_b;
    const char* A; const char* B;
    size_t a_tile, a_pn, a_rep, b_tile, b_batch, b_rep;
    __device__ __forceinline__ void init(int nM_, int nN_, int G_, int c_, const void* A_, size_t lda_bytes, const void* B_, size_t ldb_bytes) {
        nM = nM_; nN = nN_; nwg = nM * nN; G = G_; c = c_; reps = 1; pm_per_b = 1 << 30; A = (const char*)A_; B = (const char*)B_;
        a_tile = 256 * lda_bytes; a_pn = 0; a_rep = 0; b_tile = 256 * ldb_bytes; b_batch = 0; b_rep = 0;
    }
    __device__ __forceinline__ bool next(int i, Unit& u) const {
        const int ti = i / reps, aux = i - ti * reps;
        const long L = (long)ti * G + c; if (L >= nwg) return false;
        int wgid = (int)L; { const int q = nwg / NXCD, r = nwg % NXCD, xcd = wgid % NXCD, off = wgid / NXCD; wgid = (xcd < r ? xcd * (q + 1) : r * (q + 1) + (xcd - r) * q) + off; }
        const int nig = WGM * nN, gid = wgid / nig, fm = gid * WGM, gsz = (nM - fm) < WGM ? (nM - fm) : WGM;
        u.pm = fm + ((wgid % nig) % gsz); u.pn = (wgid % nig) / gsz; u.aux = aux;
        u.a = A + (size_t)u.pm * a_tile + (size_t)u.pn * a_pn + (size_t)aux * a_rep;
        u.b = B + (size_t)u.pn * b_tile + (size_t)(u.pm / pm_per_b) * b_batch + (size_t)aux * b_rep;
        return true;
    }
};

__device__ __forceinline__ unsigned cvt_pk_bf16(float lo, float hi) { return pk2(lo, hi); }

template <int ACT> __device__ __forceinline__ float actf(float x) {
    if (ACT == 1) return sigmoidf_(x);
    if (ACT == 2) return gelu_tanh(x);
    if (ACT == 3) return x * 0.0625f;
    return x;
}
template <int ACT> __device__ __forceinline__ void store_tile_bf16(const f32x4 (&acc)[2][2][4][2], bf16* O, size_t ldc, int row0, int col0, const float* rsrow, const float* rscol) {
    f32x4 cs[2][2];
#pragma unroll
    for (int bj = 0; bj < 2; ++bj)
#pragma unroll
        for (int n = 0; n < 2; ++n) cs[bj][n] = rscol ? *(const f32x4*)(rscol + col0 + bj * HALF + 4 * n) : (f32x4){1.f, 1.f, 1.f, 1.f};
#pragma unroll
    for (int ai = 0; ai < 2; ++ai)
#pragma unroll
        for (int m = 0; m < 4; ++m) { const int row = row0 + ai * HALF + m * 16; bf16* rowp = O + (size_t)row * ldc + col0; const float rr = rsrow ? rsrow[row] : 1.f;
#pragma unroll
            for (int bj = 0; bj < 2; ++bj) { const f32x4 v0 = acc[ai][bj][m][0] * cs[bj][0] * rr, v1 = acc[ai][bj][m][1] * cs[bj][1] * rr; u32x4 w;
                w.x = cvt_pk_bf16(actf<ACT>(v0[0]), actf<ACT>(v0[1])); w.y = cvt_pk_bf16(actf<ACT>(v0[2]), actf<ACT>(v0[3]));
                w.z = cvt_pk_bf16(actf<ACT>(v1[0]), actf<ACT>(v1[1])); w.w = cvt_pk_bf16(actf<ACT>(v1[2]), actf<ACT>(v1[3]));
                *(u32x4*)(rowp + bj * HALF) = w; } }
}
struct EpiAct {
    static constexpr bool PERM = true;
    bf16* O; size_t ldc; int mode; const float* rsrow; const float* rscol;
    __device__ __forceinline__ void operator()(const f32x4 (&acc)[2][2][4][2], const Unit& u, int wr, int wc, int fr, int fq) const {
        const int row0 = u.pm * BM + wr * 64 + fr, col0 = u.pn * BM + wc * 32 + 8 * fq;
        int act = 0;
        if (mode == 1) { const int g = u.pn >> 2; act = (g == 0) ? 0 : (g == 1) ? 1 : (g == 2) ? 2 : (g == 3) ? 3 : 1; }
        else if (mode == 2) act = (u.pm >= 4) ? 2 : 0;
        if (act == 0) store_tile_bf16<0>(acc, O, ldc, row0, col0, rsrow, rscol);
        else if (act == 1) store_tile_bf16<1>(acc, O, ldc, row0, col0, rsrow, rscol);
        else if (act == 2) store_tile_bf16<2>(acc, O, ldc, row0, col0, rsrow, rscol);
        else store_tile_bf16<3>(acc, O, ldc, row0, col0, rsrow, rscol);
    }
};
struct EpiGU {
    static constexpr bool PERM = true;
    bf16* O; const float* rsrow;
    __device__ __forceinline__ void operator()(const f32x4 (&acc)[2][2][4][2], const Unit& u, int wr, int wc, int fr, int fq) const {
        const int row0 = u.pm * BM + wr * 64 + fr, col0 = u.pn * HALF + wc * 32 + 8 * fq;
#pragma unroll
        for (int ai = 0; ai < 2; ++ai)
#pragma unroll
            for (int m = 0; m < 4; ++m) { const int row = row0 + ai * HALF + m * 16; bf16* rowp = O + (size_t)row * DFF + col0; const float rr = rsrow[row];
                const f32x4 g0 = acc[ai][0][m][0] * rr, g1 = acc[ai][0][m][1] * rr, u0 = acc[ai][1][m][0] * rr, u1 = acc[ai][1][m][1] * rr; u32x4 w;
                w.x = cvt_pk_bf16(siluf_(g0[0]) * u0[0], siluf_(g0[1]) * u0[1]); w.y = cvt_pk_bf16(siluf_(g0[2]) * u0[2], siluf_(g0[3]) * u0[3]);
                w.z = cvt_pk_bf16(siluf_(g1[0]) * u1[0], siluf_(g1[1]) * u1[1]); w.w = cvt_pk_bf16(siluf_(g1[2]) * u1[2], siluf_(g1[3]) * u1[3]);
                *(u32x4*)rowp = w; }
    }
};
struct EpiBranch {
    static constexpr bool PERM = true;
    bf16* Zb;
    __device__ __forceinline__ void operator()(const f32x4 (&acc)[2][2][4][2], const Unit& u, int wr, int wc, int fr, int fq) const {
        const int row0 = u.pm * BM + wr * 64 + fr, col0 = u.pn * BM + wc * 32 + 8 * fq; const int j = u.aux;
#pragma unroll
        for (int ai = 0; ai < 2; ++ai)
#pragma unroll
            for (int m = 0; m < 4; ++m) { bf16* rowp = Zb + (size_t)(row0 + ai * HALF + m * 16) * ZLD + col0;
#pragma unroll
                for (int bj = 0; bj < 2; ++bj) { const f32x4 v0 = acc[ai][bj][m][0], v1 = acc[ai][bj][m][1];
                    const u32x4 g = *(const u32x4*)(rowp + ZC_G + j * 1024 + bj * HALF);
                    float o[8] = { v0[0] * bflo(g.x), v0[1] * bfhi(g.x), v0[2] * bflo(g.y), v0[3] * bfhi(g.y), v1[0] * bflo(g.z), v1[1] * bfhi(g.z), v1[2] * bflo(g.w), v1[3] * bfhi(g.w) };
                    if (j > 0) { const u32x4 p = *(const u32x4*)(rowp + ZC_QK + bj * HALF);
                        o[0] += bflo(p.x); o[1] += bfhi(p.x); o[2] += bflo(p.y); o[3] += bfhi(p.y); o[4] += bflo(p.z); o[5] += bfhi(p.z); o[6] += bflo(p.w); o[7] += bfhi(p.w); }
                    u32x4 w; w.x = cvt_pk_bf16(o[0], o[1]); w.y = cvt_pk_bf16(o[2], o[3]); w.z = cvt_pk_bf16(o[4], o[5]); w.w = cvt_pk_bf16(o[6], o[7]);
                    *(u32x4*)(rowp + ZC_QK + bj * HALF) = w; } }
    }
};

template <class Epi, class Sched>
__device__ __forceinline__ void gemm_phase(LAS unsigned char* lds, const Gemm g, const Sched& S, const Epi& E, const int tid) {
    const int wid = __builtin_amdgcn_readfirstlane(tid >> 6), lane = tid & 63, wr = wid >> 2, wc = wid & 3, fr = lane & 15, fq = lane >> 4;
    const int nt = g.K / BK;
    unsigned voffA[2], voffB[2];
#pragma unroll
    for (int i = 0; i < 2; ++i) { int R, C; stage_rc(tid * 16 + i * 8192, R, C); const int Rb = Epi::PERM ? ((R & ~31) + perm32(R & 31)) : R;
        voffA[i] = (unsigned)(R * g.lda + C) * 2u; voffB[i] = (unsigned)(Rb * g.ldb + C) * 2u; }
    const size_t kstep = (size_t)(BK * 2);
    const size_t hstepA = (size_t)HALF * g.lda * 2, hstepB = (size_t)HALF * g.ldb * 2;
    const unsigned ldsw = (unsigned)wid * 1024u;
    const int aoff = lds_byte(wr * 64 + fr, fq * 8), boff = lds_byte(wc * 32 + fr, fq * 8);
#define PG8_SA(b, h) (((b) * 2 + (h)) * HTB)
#define PG8_SB(b, h) ((4 + (b) * 2 + (h)) * HTB)
#define PG8_STAGE(bufoff, gbase, voff) do { _Pragma("unroll") for (int _i = 0; _i < 2; ++_i) \
        __builtin_amdgcn_global_load_lds((const unsigned*)((const char*)(gbase) + (voff)[_i]), (LAS unsigned*)(lds + (bufoff) + ldsw + _i * 8192), 16, 0, 0); } while (0)
#define PG8_LDA(dst, b, h) do { _Pragma("unroll") for (int m = 0; m < 4; ++m) _Pragma("unroll") for (int k = 0; k < 2; ++k) dst[m][k] = *(const LAS bf16x8*)(lds + PG8_SA(b, h) + aoff + m * 2048 + k * 1024); } while (0)
#define PG8_LDB(dst, b, h) do { _Pragma("unroll") for (int n = 0; n < 2; ++n) _Pragma("unroll") for (int k = 0; k < 2; ++k) dst[n][k] = *(const LAS bf16x8*)(lds + PG8_SB(b, h) + boff + n * 2048 + k * 1024); } while (0)
#define PG8_MMA(ai, bj, At, Bt) do { __builtin_amdgcn_s_setprio(1); _Pragma("unroll") for (int m = 0; m < 4; ++m) _Pragma("unroll") for (int n = 0; n < 2; ++n) _Pragma("unroll") for (int k = 0; k < 2; ++k) \
        acc[ai][bj][m][n] = __builtin_amdgcn_mfma_f32_16x16x32_bf16(Bt[n][k], At[m][k], acc[ai][bj][m][n], 0, 0, 0); __builtin_amdgcn_s_setprio(0); } while (0)
#define PG8_WAIT_V(n) asm volatile("s_waitcnt vmcnt(" #n ")" ::: "memory")
#define PG8_WAIT_L(n) asm volatile("s_waitcnt lgkmcnt(" #n ")" ::: "memory")
#define PG8_BAR __builtin_amdgcn_s_barrier()
#define PG8_SCHED __builtin_amdgcn_sched_barrier(0)
    Unit cur, nxt; int ui = 0;
    if (!S.next(0, cur)) return;
    f32x4 acc[2][2][4][2];
#pragma unroll
    for (int a = 0; a < 2; ++a)
#pragma unroll
        for (int b = 0; b < 2; ++b)
#pragma unroll
            for (int m = 0; m < 4; ++m)
#pragma unroll
                for (int n = 0; n < 2; ++n) acc[a][b][m][n] = (f32x4){0.f, 0.f, 0.f, 0.f};
    bf16x8 At[4][2], B0[2][2], B1[2][2];
    const char* cA = cur.a; const char* cB = cur.b;
    PG8_STAGE(PG8_SB(0, 0), cB, voffB); PG8_STAGE(PG8_SB(0, 1), cB + hstepB, voffB); PG8_STAGE(PG8_SA(0, 0), cA, voffA); PG8_STAGE(PG8_SA(0, 1), cA + hstepA, voffA);
    if (wr == 1) PG8_BAR;
    PG8_WAIT_V(2); PG8_BAR;
    PG8_STAGE(PG8_SB(1, 0), cB + kstep, voffB); PG8_STAGE(PG8_SA(1, 0), cA + kstep, voffA); PG8_STAGE(PG8_SB(1, 1), cB + hstepB + kstep, voffB);
    PG8_WAIT_V(6); PG8_BAR;
    for (;;) {
        const bool has_next = S.next(ui + 1, nxt);
        const char* nA = has_next ? nxt.a : cA; const char* nB = has_next ? nxt.b : cB;
        for (int t = 0; t < nt; t += 2) {
            const bool last = (t == nt - 2);
            const char* a1 = cA + (size_t)(t + 1) * kstep;
            const char* a2 = last ? nA : cA + (size_t)(t + 2) * kstep; const char* b2 = last ? nB : cB + (size_t)(t + 2) * kstep;
            const char* a3 = a2 + kstep; const char* b3 = b2 + kstep;
            PG8_LDB(B0, 0, 0); PG8_LDB(B1, 0, 1); PG8_SCHED; PG8_LDA(At, 0, 0); PG8_STAGE(PG8_SA(1, 1), a1 + hstepA, voffA);
            PG8_WAIT_V(8); PG8_WAIT_L(0); PG8_BAR; PG8_MMA(0, 0, At, B0); PG8_MMA(0, 1, At, B1); PG8_BAR; PG8_SCHED;
            PG8_LDA(At, 0, 1); PG8_STAGE(PG8_SB(0, 0), b2, voffB); PG8_STAGE(PG8_SB(0, 1), b2 + hstepB, voffB); PG8_STAGE(PG8_SA(0, 0), a2, voffA);
            PG8_WAIT_V(8); PG8_WAIT_L(0); PG8_BAR; PG8_MMA(1, 0, At, B0); PG8_MMA(1, 1, At, B1); PG8_BAR; PG8_SCHED;
            PG8_LDB(B0, 1, 0); PG8_LDB(B1, 1, 1); PG8_SCHED; PG8_LDA(At, 1, 0); PG8_STAGE(PG8_SA(0, 1), a2 + hstepA, voffA);
            PG8_WAIT_V(8); PG8_WAIT_L(0); PG8_BAR; PG8_MMA(0, 0, At, B0); PG8_MMA(0, 1, At, B1); PG8_BAR; PG8_SCHED;
            PG8_LDA(At, 1, 1); PG8_STAGE(PG8_SB(1, 0), b3, voffB); PG8_STAGE(PG8_SB(1, 1), b3 + hstepB, voffB); PG8_STAGE(PG8_SA(1, 0), a3, voffA);
            PG8_WAIT_V(8); PG8_WAIT_L(0); PG8_BAR; PG8_MMA(1, 0, At, B0); PG8_MMA(1, 1, At, B1); PG8_BAR; PG8_SCHED;
        }
        if (wr == 0) PG8_BAR;
        E(acc, cur, wr, wc, fr, fq);
        if (!has_next) break;
#pragma unroll
        for (int a = 0; a < 2; ++a)
#pragma unroll
            for (int b = 0; b < 2; ++b)
#pragma unroll
                for (int m = 0; m < 4; ++m)
#pragma unroll
                    for (int n = 0; n < 2; ++n) acc[a][b][m][n] = (f32x4){0.f, 0.f, 0.f, 0.f};
        cur = nxt; cA = nA; cB = nB; ++ui;
        if (wr == 1) PG8_BAR;
    }
    PG8_WAIT_V(0);
    PG8_BAR;
#undef PG8_SA
#undef PG8_SB
#undef PG8_STAGE
#undef PG8_LDA
#undef PG8_LDB
#undef PG8_MMA
#undef PG8_WAIT_V
#undef PG8_WAIT_L
#undef PG8_BAR
#undef PG8_SCHED
}
}

#define XB_TMO      128
#define XB_XCNT(j)  (256  + 64 * (j))
#define XB_XSUB(j)  (1280 + 64 * (j))
#define XB_XGEN(j)  (2304 + 64 * (j))
#define XB_TOP      3328
#define XB_TOPGEN   3392
#define XCD_BAR_WORDS 3456
#define XB_SPIN_CAP (1u << 18)
__device__ __forceinline__ unsigned xb_ld(unsigned* p)              { return __hip_atomic_load(p, __ATOMIC_RELAXED, __HIP_MEMORY_SCOPE_AGENT); }
__device__ __forceinline__ unsigned xb_add(unsigned* p, unsigned v) { return __hip_atomic_fetch_add(p, v, __ATOMIC_RELAXED, __HIP_MEMORY_SCOPE_AGENT); }
__device__ __forceinline__ unsigned xb_xcc_id() { return (unsigned)__builtin_amdgcn_s_getreg((3 << 11) | 20) & 0xFu; }
#define XB_SPIN(cond, bar) do { unsigned _sp = 0; while (cond) { __builtin_amdgcn_s_sleep(1); \
    if ((++_sp & 255u) == 0u) { if (xb_ld(&(bar)[XB_TMO])) break; if (_sp > XB_SPIN_CAP) { atomicAdd(&(bar)[XB_TMO], 1u); break; } } } } while (0)
struct XcdBarrier { unsigned* bar; unsigned x; volatile LAS unsigned* st; };
__device__ __forceinline__ XcdBarrier xcd_barrier_post(unsigned* bar, volatile LAS unsigned* st) {
    XcdBarrier b; b.bar = bar; b.x = xb_xcc_id(); b.st = st;
    if (threadIdx.x == 0) (void)xb_add(&bar[XB_XCNT(b.x)], 1u);
    return b;
}
__device__ __forceinline__ void xcd_barrier_complete(unsigned* bar, unsigned x, unsigned& nloc, unsigned& nx) {
    const unsigned G = gridDim.x * gridDim.y * gridDim.z;
    unsigned sum, cnt, mine, sp = 0u;
    for (;;) {
        sum = 0u; cnt = 0u; mine = 0u;
#pragma unroll
        for (unsigned j = 0; j < 16; ++j) { const unsigned c = xb_ld(&bar[XB_XCNT(j)]); sum += c; cnt += (c > 0u) ? 1u : 0u; mine = (j == x) ? c : mine; }
        if (sum == G) break;
        __builtin_amdgcn_s_sleep(1);
        if ((++sp & 255u) == 0u) { if (xb_ld(&bar[XB_TMO])) break; if (sp > XB_SPIN_CAP) { atomicAdd(&bar[XB_TMO], 1u); break; } }
    }
    nloc = mine > 0u ? mine : 1u; nx = cnt > 0u ? cnt : 1u;
}
__device__ __forceinline__ void xcd_barrier(const XcdBarrier& b) {
    asm volatile("s_waitcnt vmcnt(0)" ::: "memory");
    __syncthreads();
    if (threadIdx.x == 0) {
        unsigned* bar = b.bar;
        __builtin_amdgcn_s_waitcnt(0);
        unsigned nloc = b.st[0], nx = b.st[1];
        if (nloc == 0u) { xcd_barrier_complete(bar, b.x, nloc, nx); b.st[0] = nloc; b.st[1] = nx; }
        const unsigned old = xb_add(&bar[XB_XSUB(b.x)], 1u);
        const unsigned gen = old / nloc;
        if (old + 1u == (gen + 1u) * nloc) {
            __builtin_amdgcn_fence(__ATOMIC_RELEASE, "agent");
            asm volatile("s_waitcnt vmcnt(0)" ::: "memory");
            const unsigned og = xb_add(&bar[XB_TOP], 1u);
            const unsigned tg = og / nx;
            if (og + 1u == (tg + 1u) * nx) xb_add(&bar[XB_TOPGEN], 1u);
            else XB_SPIN(xb_ld(&bar[XB_TOPGEN]) == tg, bar);
            __builtin_amdgcn_fence(__ATOMIC_ACQUIRE, "agent");
            xb_add(&bar[XB_XGEN(b.x)], 1u);
            asm volatile("s_waitcnt vmcnt(0)" ::: "memory");
        } else {
            XB_SPIN(xb_ld(&bar[XB_XGEN(b.x)]) == gen, bar);
            __builtin_amdgcn_fence(__ATOMIC_ACQUIRE, "agent");
            asm volatile("s_waitcnt vmcnt(0)" ::: "memory");
        }
    }
    __syncthreads();
}

struct Args { const float* in[18]; float* out; unsigned char* ws; int ph_lo, ph_hi; };
enum { I_X = 0, I_MEM, I_NORMG, I_WGU, I_WDOWN, I_WIN, I_CONVW, I_CONVB, I_BI, I_BF, I_MNORM, I_SLNG, I_SLNB, I_SWS, I_SBS, I_WMKV, I_WBR, I_WOUT };

__device__ __forceinline__ void cvt_item(const float* W, int Nsrc, int K, int srccol, bf16* WT, int dstrow, int kb, LAS float* scr, int lane, const float* gk = nullptr) {
    const int k0 = 64 * kb;
    if ((srccol & 3) == 0) {
        const int c4 = (lane & 7) * 4, rr = lane >> 3;
#pragma unroll
        for (int i = 0; i < 8; ++i) { const int kk = 8 * i + rr; f32x4 x = *(const f32x4*)(W + (size_t)(k0 + kk) * Nsrc + srccol + c4); if (gk) x = x * gk[k0 + kk];
            LAS float* d = scr + kk * 33 + c4; d[0] = x.x; d[1] = x.y; d[2] = x.z; d[3] = x.w; }
    } else {
#pragma unroll 8
        for (int i = 0; i < 32; ++i) { const int kk = 2 * i + (lane >> 5); scr[kk * 33 + (lane & 31)] = W[(size_t)(k0 + kk) * Nsrc + srccol + (lane & 31)] * (gk ? gk[k0 + kk] : 1.f); }
    }
    LDS_WAIT(); asm volatile("" ::: "memory");
    const int c = lane & 7;
#pragma unroll
    for (int j = 0; j < 4; ++j) { const int n = (lane >> 3) + 8 * j; const LAS float* s = scr + (8 * c) * 33 + n;
        u32x4 o; o.x = pk2(s[0 * 33], s[1 * 33]); o.y = pk2(s[2 * 33], s[3 * 33]); o.z = pk2(s[4 * 33], s[5 * 33]); o.w = pk2(s[6 * 33], s[7 * 33]);
        *(u32x4*)(WT + (size_t)(dstrow + n) * K + k0 + 8 * c) = o; }
    LDS_WAIT(); asm volatile("" ::: "memory");
}
__device__ __forceinline__ int win_srccol(int r) {
    if (r < 1024) return r;
    if (r < 2048) return 2048 + (r - 1024);
    if (r < 3072) return 3080 + (r - 2048);
    if (r < 4096) return 5128 + (r - 3072);
    if (r < 7168) return 6152 + (r - 4096);
    if (r < 8192) return 1024 + (r - 7168);
    return 4104 + (r - 8192);
}
__device__ __forceinline__ void convert_layer(const Args& a, int l, unsigned char* ws, LAS unsigned char* lds, int gw, int NGW, int wave, int lane, int gtid, int GT) {
    LAS float* scr = (LAS float*)(lds + wave * 16384);
    bf16* Wb = (bf16*)(ws + WS_W);
    constexpr int I_GU = 16 * 176, I_DN = 44 * 32, I_IN = 16 * 288, I_MKV = 16 * 64, I_BR = 16 * 32, I_OUT = 16 * 32;
    constexpr int NITEMS = 2 * I_GU + 2 * I_DN + I_IN + I_MKV + 3 * I_BR + I_OUT;
    for (int it = gw; it < NITEMS; it += NGW) {
        int r = it;
        if (r < 2 * I_GU) { const int j = r / I_GU; r -= j * I_GU; const int kb = r / 176, nb = r % 176; const int p = nb >> 3, q = nb & 7, s = q >> 2, jj = (q & 3) * 32;
            cvt_item(a.in[I_WGU] + (size_t)(l * 2 + j) * D * 2 * DFF, 2 * DFF, D, s * DFF + 128 * p + jj, (bf16*)((char*)Wb + (j ? WO_GU1 : WO_GU0)), nb * 32, kb, scr, lane, a.in[I_NORMG] + (size_t)(l * NNORM + (j ? 4 : 0)) * D); continue; }
        r -= 2 * I_GU;
        if (r < 2 * I_DN) { const int j = r / I_DN; r -= j * I_DN; const int kb = r / 32, nb = r % 32;
            cvt_item(a.in[I_WDOWN] + (size_t)(l * 2 + j) * DFF * D, D, DFF, nb * 32, (bf16*)((char*)Wb + (j ? WO_D1 : WO_D0)), nb * 32, kb, scr, lane); continue; }
        r -= 2 * I_DN;
        if (r < I_IN) { const int kb = r / 288, nb = r % 288;
            cvt_item(a.in[I_WIN] + (size_t)l * D * WIN_COLS, WIN_COLS, D, win_srccol(nb * 32), (bf16*)((char*)Wb + WO_IN), nb * 32, kb, scr, lane, a.in[I_NORMG] + (size_t)(l * NNORM + 2) * D); continue; }
        r -= I_IN;
        if (r < I_MKV) { const int kb = r / 64, nb = r % 64;
            cvt_item(a.in[I_WMKV] + (size_t)l * D * 2048, 2048, D, nb * 32, (bf16*)((char*)Wb + WO_MKV), nb * 32, kb, scr, lane); continue; }
        r -= I_MKV;
        if (r < 3 * I_BR) { const int j = r / I_BR; r -= j * I_BR; const int kb = r / 32, nb = r % 32;
            cvt_item(a.in[I_WBR] + (size_t)(l * 3 + j) * D * D, D, D, nb * 32, (bf16*)((char*)Wb + WO_BR) + (size_t)j * D * D, nb * 32, kb, scr, lane); continue; }
        r -= 3 * I_BR;
        { const int kb = r / 32, nb = r % 32; cvt_item(a.in[I_WOUT] + (size_t)l * D * D, D, D, nb * 32, (bf16*)((char*)Wb + WO_OUT), nb * 32, kb, scr, lane); }
    }
    { const float* win = a.in[I_WIN] + (size_t)l * D * WIN_COLS; const float* g2 = a.in[I_NORMG] + (size_t)(l * NNORM + 2) * D; float* wt = (float*)(ws + WS_WIF);
      for (int e = gtid; e < 8 * D; e += GT) { const int k = e >> 3, c = e & 7; wt[c * D + k] = win[(size_t)k * WIN_COLS + 3072 + c] * g2[k]; } }
    bf16* wsg = (bf16*)(ws + WS_WSGU); const float* src = a.in[I_SWS] + (size_t)l * 4 * 128 * 128;
    for (int e = gtid; e < 4 * 128 * 128; e += GT) { const int t = (e >> 7) & 127, s = e & 127; wsg[e] = (bf16)f2bf(s <= t ? src[e] : 0.f); }
    const float* g6 = a.in[I_NORMG] + (size_t)(l * NNORM + 6) * D;
    for (int m = gw; m < MMEM; m += NGW) {
        const f32x4* xr = (const f32x4*)(a.in[I_MEM] + (size_t)m * D) + lane; f32x4 v[4]; float s = 0.f;
#pragma unroll
        for (int j = 0; j < 4; ++j) { v[j] = xr[64 * j]; s += (v[j].x * v[j].x + v[j].y * v[j].y) + (v[j].z * v[j].z + v[j].w * v[j].w); }
        const float rstd = rsqrtf(wave_sum(s, lane) * (1.f / D) + EPS);
        unsigned long long* o8 = (unsigned long long*)((bf16*)(ws + WS_MEMN) + (size_t)m * D) + lane;
#pragma unroll
        for (int j = 0; j < 4; ++j) { const f32x4 gg = ((const f32x4*)g6)[lane + 64 * j];
            o8[64 * j] = (unsigned long long)pk2(v[j].x * rstd * gg.x, v[j].y * rstd * gg.y) | ((unsigned long long)pk2(v[j].z * rstd * gg.z, v[j].w * rstd * gg.w) << 32); }
    }
}

__device__ __forceinline__ void thin_rows(const bf16* fbase, size_t fld, const float* ga, float scale, const float* hin32, const bf16* hinb, bf16* hb_out, float* rstd_out, float* out32,
                                          int row_lo, int row_hi, int gw, int NGW, int lane, const bool do_gates, const LAS float* wif, const float* bi, const float* bfg, float* gate_i, float* gate_f) {
    f32x4 hn32[4]; unsigned long long hnb[4], fn[4];
    int m = row_lo + gw;
    if (m < row_hi) {
        if (hin32) { const f32x4* hr = (const f32x4*)(hin32 + (size_t)m * D) + lane;
#pragma unroll
            for (int j = 0; j < 4; ++j) hn32[j] = hr[64 * j]; }
        else { const unsigned long long* hr = (const unsigned long long*)(hinb + (size_t)m * D) + lane;
#pragma unroll
            for (int j = 0; j < 4; ++j) hnb[j] = hr[64 * j]; }
        if (fbase) { const unsigned long long* fr = (const unsigned long long*)(fbase + (size_t)(m - row_lo) * fld) + lane;
#pragma unroll
            for (int j = 0; j < 4; ++j) fn[j] = fr[64 * j]; }
    }
    for (; m < row_hi; m += NGW) {
        f32x4 v[4]; unsigned long long fc[4];
        if (hin32) {
#pragma unroll
            for (int j = 0; j < 4; ++j) v[j] = hn32[j]; }
        else {
#pragma unroll
            for (int j = 0; j < 4; ++j) { const unsigned long long w = hnb[j]; const unsigned lo = (unsigned)w, hi = (unsigned)(w >> 32); v[j] = (f32x4){bflo(lo), bfhi(lo), bflo(hi), bfhi(hi)}; } }
#pragma unroll
        for (int j = 0; j < 4; ++j) fc[j] = fn[j];
        const int mn = m + NGW;
        if (mn < row_hi) {
            if (hin32) { const f32x4* hr = (const f32x4*)(hin32 + (size_t)mn * D) + lane;
#pragma unroll
                for (int j = 0; j < 4; ++j) hn32[j] = hr[64 * j]; }
            else { const unsigned long long* hr = (const unsigned long long*)(hinb + (size_t)mn * D) + lane;
#pragma unroll
                for (int j = 0; j < 4; ++j) hnb[j] = hr[64 * j]; }
            if (fbase) { const unsigned long long* fr = (const unsigned long long*)(fbase + (size_t)(mn - row_lo) * fld) + lane;
#pragma unroll
                for (int j = 0; j < 4; ++j) fn[j] = fr[64 * j]; }
        }
        if (fbase) {
            float s = 0.f; f32x4 f[4];
#pragma unroll
            for (int j = 0; j < 4; ++j) { const unsigned long long w = fc[j]; const unsigned lo = (unsigned)w, hi = (unsigned)(w >> 32);
                f[j] = (f32x4){bflo(lo), bfhi(lo), bflo(hi), bfhi(hi)}; s += (f[j].x * f[j].x + f[j].y * f[j].y) + (f[j].z * f[j].z + f[j].w * f[j].w); }
            const float rstd = rsqrtf(wave_sum(s, lane) * (1.f / D) + EPS) * scale;
#pragma unroll
            for (int j = 0; j < 4; ++j) { const f32x4 gg = ((const f32x4*)ga)[lane + 64 * j]; v[j] = v[j] + f[j] * rstd * gg; }
        }
        if (out32) { f32x4* ho = (f32x4*)(out32 + (size_t)m * D) + lane;
#pragma unroll
            for (int j = 0; j < 4; ++j) ho[64 * j] = v[j]; }
        if (hb_out) {
            float s = 0.f;
#pragma unroll
            for (int j = 0; j < 4; ++j) s += (v[j].x * v[j].x + v[j].y * v[j].y) + (v[j].z * v[j].z + v[j].w * v[j].w);
            const float rstd = rsqrtf(wave_sum(s, lane) * (1.f / D) + EPS);
            unsigned long long* o8 = (unsigned long long*)(hb_out + (size_t)m * D) + lane;
#pragma unroll
            for (int j = 0; j < 4; ++j) o8[64 * j] = (unsigned long long)pk2(v[j].x, v[j].y) | ((unsigned long long)pk2(v[j].z, v[j].w) << 32);
            if (lane == 0) rstd_out[m] = rstd;
            if (do_gates) {
                float acc[8];
#pragma unroll
                for (int e = 0; e < 8; ++e) acc[e] = 0.f;
#pragma unroll
                for (int j = 0; j < 4; ++j)
#pragma unroll
                    for (int e = 0; e < 8; ++e) { const f32x4 w4 = *(const LAS f32x4*)(wif + e * D + 4 * lane + 256 * j); acc[e] += (v[j].x * w4.x + v[j].y * w4.y) + (v[j].z * w4.z + v[j].w * w4.w); }
                {
                    float b4[4], b2[2], b1;
#pragma unroll
                    for (int e = 0; e < 4; ++e) { const float mine = (lane & 4) ? acc[4 + e] : acc[e], send = (lane & 4) ? acc[e] : acc[4 + e]; b4[e] = mine + shx(send, 4, lane); }
#pragma unroll
                    for (int e = 0; e < 2; ++e) { const float mine = (lane & 2) ? b4[2 + e] : b4[e], send = (lane & 2) ? b4[e] : b4[2 + e]; b2[e] = mine + shx(send, 2, lane); }
                    { const float mine = (lane & 1) ? b2[1] : b2[0], send = (lane & 1) ? b2[0] : b2[1]; b1 = mine + shx(send, 1, lane); }
                    b1 += shx(b1, 8, lane); b1 += shx(b1, 16, lane); b1 += shx(b1, 32, lane);
                    const float val = b1 * rstd;
                    if (lane < 4) gate_i[(size_t)m * 4 + lane] = val + bi[lane];
                    else if (lane < 8) gate_f[(size_t)m * 4 + lane - 4] = logsigmoidf_(val + bfg[lane - 4]);
                }
            }
        }
    }
}

__device__ __forceinline__ void conv8(const bf16* Zb, int bl, int p, int col, const float* cw, const float* cb, float (&o)[8]) {
    const f32x4 b0 = *(const f32x4*)(cb + col), b1 = *(const f32x4*)(cb + col + 4);
    o[0] = b0.x; o[1] = b0.y; o[2] = b0.z; o[3] = b0.w; o[4] = b1.x; o[5] = b1.y; o[6] = b1.z; o[7] = b1.w;
#pragma unroll
    for (int j = 0; j < 4; ++j) { const int pp = p - 3 + j;
        if (pp >= 0) { const u32x4 x = *(const u32x4*)(Zb + (size_t)(bl * SEQ + pp) * ZLD + ZC_QK + col);
            const f32x4 w0 = *(const f32x4*)(cw + j * 1024 + col), w1 = *(const f32x4*)(cw + j * 1024 + col + 4);
            o[0] += w0.x * bflo(x.x); o[1] += w0.y * bfhi(x.x); o[2] += w0.z * bflo(x.y); o[3] += w0.w * bfhi(x.y);
            o[4] += w1.x * bflo(x.z); o[5] += w1.y * bfhi(x.z); o[6] += w1.z * bflo(x.w); o[7] += w1.w * bfhi(x.w); } }
#pragma unroll
    for (int e = 0; e < 8; ++e) o[e] = siluf_(o[e]);
}
__device__ __forceinline__ float wave_incl_scan_add(float v, int lane) {
#pragma unroll
    for (int o = 1; o < 64; o <<= 1) { const float t = shidx(v, lane >= o ? lane - o : lane); if (lane >= o) v += t; }
    return v;
}
__device__ __forceinline__ float wave_incl_scan_max(float v, int lane) {
#pragma unroll
    for (int o = 1; o < 64; o <<= 1) { const float t = shidx(v, lane >= o ? lane - o : lane); if (lane >= o) v = fmaxf(v, t); }
    return v;
}
__device__ __forceinline__ float wave_max(float v, int lane) {
#pragma unroll
    for (int o = 1; o < 64; o <<= 1) v = fmaxf(v, shx(v, o, lane));
    return v;
}
constexpr float KSCALE = 0.08838834764831845f;

__device__ __forceinline__ void conv_load(const bf16* Zb, int bl, int p, int col, u32x4 (&raw)[4]) {
#pragma unroll
    for (int j = 0; j < 4; ++j) { const int pp = p - 3 + j; raw[j] = (u32x4){0u, 0u, 0u, 0u};
        if (pp >= 0) raw[j] = *(const u32x4*)(Zb + (size_t)(bl * SEQ + pp) * ZLD + ZC_QK + col); }
}
__device__ __forceinline__ void conv_apply(const u32x4 (&raw)[4], const LAS float* wl, const int wstride, float (&o)[8]) {
    { const f32x4 b0 = *(const LAS f32x4*)(wl + 4 * wstride), b1 = *(const LAS f32x4*)(wl + 4 * wstride + 4);
      o[0] = b0.x; o[1] = b0.y; o[2] = b0.z; o[3] = b0.w; o[4] = b1.x; o[5] = b1.y; o[6] = b1.z; o[7] = b1.w; }
#pragma unroll
    for (int j = 0; j < 4; ++j) { const u32x4 x = raw[j];
        const f32x4 w0 = *(const LAS f32x4*)(wl + j * wstride), w1 = *(const LAS f32x4*)(wl + j * wstride + 4);
        o[0] += w0.x * bflo(x.x); o[1] += w0.y * bfhi(x.x); o[2] += w0.z * bflo(x.y); o[3] += w0.w * bfhi(x.y);
        o[4] += w1.x * bflo(x.z); o[5] += w1.y * bfhi(x.z); o[6] += w1.z * bflo(x.w); o[7] += w1.w * bfhi(x.w); }
#pragma unroll
    for (int e = 0; e < 8; ++e) o[e] = siluf_(o[e]);
}
__device__ __forceinline__ void stage_convw(LAS float* wl, const float* cw, const float* cb, int col0, int ncol, int dst0, int wstride, int tid) {
    for (int e = tid; e < 5 * ncol; e += NTHR) { const int j = e / ncol, cidx = e - j * ncol; wl[j * wstride + dst0 + cidx] = (j < 4) ? cw[j * 1024 + col0 + cidx] : cb[col0 + cidx]; }
}
__device__ __forceinline__ void mlstm_s1(const Args& a, int l, int hf, unsigned char* ws, LAS unsigned char* lds, int G, int cu, int tid, int wave, int lane) {
    const bf16* Zb = (const bf16*)(ws + WS_Z); const bf16* ZT = (const bf16*)(ws + WS_ZT);
    const float* gi = (const float*)(ws + WS_GATE); const float* gf = gi + (size_t)M * 4;
    const float* cw = a.in[I_CONVW] + (size_t)l * 4 * 1024; const float* cb = a.in[I_CONVB] + (size_t)l * 1024;
    LAS bf16* KT = (LAS bf16*)lds;
    LAS float* wv = (LAS float*)(lds + 18432);
    LAS float* CWL = (LAS float*)(lds + 18688);
    const int c8 = tid & 15; int hcur = -1;
    for (int u = cu; u < 16 * NCH; u += G) {
        const int h = u & 3, c = (u >> 2) & 63, bl = u >> 8, bhl = bl * 4 + h; const int tokg = (hf * 4 + bl) * SEQ + c * LCH;
        if (h != hcur) { __syncthreads(); stage_convw(CWL, cw, cb, 512 + h * 128, 128, 0, 128, tid); hcur = h; }
        const int r = lane & 31, hh = lane >> 5, v0 = 32 * wave;
        bf16x8 bfr[4];
        { const bf16* vrow = ZT + (size_t)(h * 256 + v0 + r) * ZTLD + bl * SEQ + c * LCH + 8 * hh;
#pragma unroll
          for (int ks = 0; ks < 4; ++ks) bfr[ks] = *(const bf16x8*)(vrow + 16 * ks); }
        u32x4 raw[2][4];
#pragma unroll
        for (int rep = 0; rep < 2; ++rep) conv_load(Zb, bl, c * LCH + ((tid + rep * NTHR) >> 4), 512 + h * 128 + c8 * 8, raw[rep]);
        if (wave == 0) {
            const float lf = gf[(size_t)(tokg + lane) * 4 + h], ii = gi[(size_t)(tokg + lane) * 4 + h];
            const float bc = wave_incl_scan_add(lf, lane); const float g = shidx(bc, 63);
            const float av = g - bc + ii; const float ml = wave_max(av, lane);
            wv[lane] = __expf(av - ml);
            if (lane == 0) { float* cs = (float*)(ws + WS_CSC) + (size_t)(bhl * NCH + c) * 4; cs[0] = g; cs[1] = ml; }
        }
        __syncthreads();
#pragma unroll
        for (int rep = 0; rep < 2; ++rep) { const int idx = tid + rep * NTHR, s = idx >> 4; float o[8];
            conv_apply(raw[rep], CWL + c8 * 8, 128, o); const float sc = wv[s] * KSCALE;
            { u32x4 w; w.x = pk2(o[0] * KSCALE, o[1] * KSCALE); w.y = pk2(o[2] * KSCALE, o[3] * KSCALE); w.z = pk2(o[4] * KSCALE, o[5] * KSCALE); w.w = pk2(o[6] * KSCALE, o[7] * KSCALE);
              *(u32x4*)((bf16*)(ws + WS_KC) + (size_t)(bl * SEQ + c * LCH + s) * 512 + h * 128 + c8 * 8) = w; }
#pragma unroll
            for (int e = 0; e < 8; ++e) KT[(c8 * 8 + e) * 72 + s] = (bf16)f2bf(o[e] * sc); }
        __syncthreads();
        if (tid < 128) { float s = 0.f;
#pragma unroll 8
            for (int k = 0; k < 64; ++k) s += bf1(KT[tid * 72 + k]);
            ((float*)(ws + WS_NST))[(size_t)(bhl * NCH + c) * 128 + tid] = s; }
        {
            bf16* st = (bf16*)(ws + WS_ST) + (size_t)(bhl * NCH + c) * 32768 + (size_t)(v0 + r) * 128;
#pragma unroll
            for (int db = 0; db < 4; ++db) { f32x16 acc;
#pragma unroll
                for (int e = 0; e < 16; ++e) acc[e] = 0.f;
#pragma unroll
                for (int ks = 0; ks < 4; ++ks) { const bf16x8 af = *(const LAS bf16x8*)(KT + (32 * db + r) * 72 + 16 * ks + 8 * hh); acc = __builtin_amdgcn_mfma_f32_32x32x16_bf16(af, bfr[ks], acc, 0, 0, 0); }
#pragma unroll
                for (int q = 0; q < 4; ++q) { u32x2 w; w.x = pk2(acc[4 * q], acc[4 * q + 1]); w.y = pk2(acc[4 * q + 2], acc[4 * q + 3]); *(u32x2*)(st + 32 * db + 8 * q + 4 * hh) = w; } }
        }
        __syncthreads();
    }
}
__device__ __forceinline__ void mlstm_s2(unsigned char* ws, int G, int cu, int tid) {
    for (int u = cu; u < 256; u += G) {
        const int bhl = u >> 4, part = u & 15; const size_t off = (size_t)(part * NTHR + tid) * 4;
        bf16* st = (bf16*)(ws + WS_ST) + (size_t)bhl * NCH * 32768 + off; float* ns = (float*)(ws + WS_NST) + (size_t)bhl * NCH * 128 + tid; float* cs = (float*)(ws + WS_CSC) + (size_t)bhl * NCH * 4;
        const bool nth = (part == 0 && tid < 128);
        float C[4]; float nv = 0.f, m = -1e30f;
#pragma unroll
        for (int e = 0; e < 4; ++e) C[e] = 0.f;
        for (int c0 = 0; c0 < NCH; c0 += 8) {
            u32x2 cl[8]; float nl[8], gg[8], ml[8];
#pragma unroll
            for (int i = 0; i < 8; ++i) { cl[i] = *(const u32x2*)(st + (size_t)(c0 + i) * 32768); nl[i] = nth ? ns[(c0 + i) * 128] : 0.f; gg[i] = cs[(c0 + i) * 4]; ml[i] = cs[(c0 + i) * 4 + 1]; }
#pragma unroll
            for (int i = 0; i < 8; ++i) {
                u32x2 o; o.x = pk2(C[0], C[1]); o.y = pk2(C[2], C[3]);
                *(u32x2*)(st + (size_t)(c0 + i) * 32768) = o;
                if (nth) ns[(c0 + i) * 128] = nv;
                if (part == 0 && tid == 0) cs[(c0 + i) * 4 + 2] = m;
                const float mn = fmaxf(gg[i] + m, ml[i]); const float dec = __expf(gg[i] + m - mn), sc = __expf(ml[i] - mn);
                C[0] = dec * C[0] + sc * bflo(cl[i].x); C[1] = dec * C[1] + sc * bfhi(cl[i].x); C[2] = dec * C[2] + sc * bflo(cl[i].y); C[3] = dec * C[3] + sc * bfhi(cl[i].y);
                nv = dec * nv + sc * nl[i]; m = mn;
            }
        }
    }
}
__device__ __forceinline__ void mlstm_s3(const Args& a, int l, int hf, unsigned char* ws, LAS unsigned char* lds, int G, int cu, int tid, int wave, int lane, const int out_col) {
    bf16* Zb = (bf16*)(ws + WS_Z); const bf16* ZT = (const bf16*)(ws + WS_ZT);
    const float* gi = (const float*)(ws + WS_GATE); const float* gf = gi + (size_t)M * 4;
    const float* cw = a.in[I_CONVW] + (size_t)l * 4 * 1024; const float* cb = a.in[I_CONVB] + (size_t)l * 1024;
    const float* gain = a.in[I_MNORM] + (size_t)l * 1024;
    LAS bf16* QS = (LAS bf16*)lds;
    LAS bf16* KS = (LAS bf16*)(lds + 17408);
    LAS bf16* SD = (LAS bf16*)(lds + 34816);
    LAS float* HB = (LAS float*)(lds + 44032);
    LAS float* SC = (LAS float*)(lds + 110592);
    LAS float* CWL = (LAS float*)(lds + 112384);
    const int c8 = tid & 15; int hcur = -1;
    for (int u = cu; u < 16 * NCH; u += G) {
        const int h = u & 3, c = (u >> 2) & 63, bl = u >> 8, bhl = bl * 4 + h; const int tokg = (hf * 4 + bl) * SEQ + c * LCH; const int tokl = bl * SEQ + c * LCH;
        if (h != hcur) { __syncthreads(); stage_convw(CWL, cw, cb, h * 128, 128, 0, 256, tid); hcur = h; __syncthreads(); }
        const int r = lane & 31, hh = lane >> 5, v0 = 32 * wave;
        bf16x8 bV[4], bC[8];
        { const bf16* vrow = ZT + (size_t)(h * 256 + v0 + r) * ZTLD + tokl + 8 * hh;
          const bf16* crow = (const bf16*)(ws + WS_ST) + (size_t)(bhl * NCH + c) * 32768 + (size_t)(v0 + r) * 128 + 8 * hh;
#pragma unroll
          for (int ks = 0; ks < 4; ++ks) bV[ks] = *(const bf16x8*)(vrow + 16 * ks);
#pragma unroll
          for (int ks = 0; ks < 8; ++ks) bC[ks] = *(const bf16x8*)(crow + 16 * ks); }
        u32x4 ogr[4];
#pragma unroll
        for (int i = 0; i < 4; ++i) ogr[i] = *(const u32x4*)(Zb + (size_t)(tokl + (tid >> 3)) * ZLD + ZC_O + h * 256 + 32 * (tid & 7) + 8 * i);
        u32x4 kt[2];
#pragma unroll
        for (int rep = 0; rep < 2; ++rep) { const int t = (tid + rep * NTHR) >> 4; kt[rep] = *(const u32x4*)((const bf16*)(ws + WS_KC) + (size_t)(tokl + t) * 512 + h * 128 + c8 * 8); }
        if (wave == 0) {
            const float lf = gf[(size_t)(tokg + lane) * 4 + h], ii = gi[(size_t)(tokg + lane) * 4 + h];
            const float bc = wave_incl_scan_add(lf, lane); const float rr = ii - bc; const float cm = wave_incl_scan_max(rr, lane);
            const float mst = ((const float*)(ws + WS_CSC))[(size_t)(bhl * NCH + c) * 4 + 2];
            const float Mt = fmaxf(mst, cm);
            SC[lane] = rr; SC[64 + lane] = Mt; SC[128 + lane] = __expf(mst - Mt); SC[192 + lane] = __expf(-(bc + Mt));
        } else if (wave == 1 || wave == 2) { const int d = (wave - 1) * 64 + lane; SC[320 + d] = ((const float*)(ws + WS_NST))[(size_t)(bhl * NCH + c) * 128 + d]; }
#pragma unroll
        for (int rep = 0; rep < 2; ++rep) { const int idx = tid + rep * NTHR, t = idx >> 4; float o[8];
            { u32x4 rawq[4]; conv_load(Zb, bl, c * LCH + t, h * 128 + c8 * 8, rawq); conv_apply(rawq, CWL + c8 * 8, 256, o); }
            u32x4 w; w.x = pk2(o[0], o[1]); w.y = pk2(o[2], o[3]); w.z = pk2(o[4], o[5]); w.w = pk2(o[6], o[7]);
            *(LAS u32x4*)(QS + t * 136 + c8 * 8) = w;
            *(LAS u32x4*)(KS + t * 136 + c8 * 8) = kt[rep]; }
        __syncthreads();
        {
            const int tb = wave >> 1, fr = lane & 15, fq = lane >> 4;
#pragma unroll
            for (int i = 0; i < 2; ++i) { const int sblk = (wave & 1) * 2 + i; f32x4 acc = (f32x4){0.f, 0.f, 0.f, 0.f};
                if (sblk <= tb) {
#pragma unroll
                    for (int ks = 0; ks < 4; ++ks) { const bf16x8 af = *(const LAS bf16x8*)(QS + (16 * tb + fr) * 136 + 32 * ks + 8 * fq), bfv = *(const LAS bf16x8*)(KS + (16 * sblk + fr) * 136 + 32 * ks + 8 * fq);
                        acc = __builtin_amdgcn_mfma_f32_16x16x32_bf16(af, bfv, acc, 0, 0, 0); } }
                const int s = 16 * sblk + fr; const float rs_ = SC[s];
#pragma unroll
                for (int e = 0; e < 4; ++e) { const int t = 16 * tb + 4 * fq + e; const float val = (s <= t) ? acc[e] * __expf(rs_ - SC[64 + t]) : 0.f; SD[t * 72 + s] = (bf16)f2bf(val); } }
        }
        f32x16 aQ0, aQ1, aS0, aS1;
#pragma unroll
        for (int e = 0; e < 16; ++e) { aQ0[e] = 0.f; aQ1[e] = 0.f; aS0[e] = 0.f; aS1[e] = 0.f; }
#pragma unroll
        for (int ks = 0; ks < 8; ++ks) {
            const bf16x8 a0 = *(const LAS bf16x8*)(QS + r * 136 + 16 * ks + 8 * hh), a1 = *(const LAS bf16x8*)(QS + (32 + r) * 136 + 16 * ks + 8 * hh);
            aQ0 = __builtin_amdgcn_mfma_f32_32x32x16_bf16(a0, bC[ks], aQ0, 0, 0, 0); aQ1 = __builtin_amdgcn_mfma_f32_32x32x16_bf16(a1, bC[ks], aQ1, 0, 0, 0); }
        __syncthreads();
        {
            const int t = tid >> 3, p = tid & 7; float ds = 0.f, qn = 0.f;
#pragma unroll
            for (int k = 0; k < 8; ++k) ds += bf1(SD[t * 72 + 8 * p + k]);
#pragma unroll
            for (int k = 0; k < 16; ++k) qn += bf1(QS[t * 136 + 16 * p + k]) * SC[320 + 16 * p + k];
            float den = ds + SC[128 + t] * qn;
            den += shx(den, 1, lane); den += shx(den, 2, lane); den += shx(den, 4, lane);
            if (p == 0) SC[256 + t] = 1.f / fmaxf(fabsf(den), SC[192 + t]);
        }
#pragma unroll
        for (int ks = 0; ks < 4; ++ks) {
            const bf16x8 a0 = *(const LAS bf16x8*)(SD + r * 72 + 16 * ks + 8 * hh), a1 = *(const LAS bf16x8*)(SD + (32 + r) * 72 + 16 * ks + 8 * hh);
            aS0 = __builtin_amdgcn_mfma_f32_32x32x16_bf16(a0, bV[ks], aS0, 0, 0, 0); aS1 = __builtin_amdgcn_mfma_f32_32x32x16_bf16(a1, bV[ks], aS1, 0, 0, 0); }
        __syncthreads();
#pragma unroll
        for (int e = 0; e < 16; ++e) { const int t0 = (e & 3) + 8 * (e >> 2) + 4 * hh;
            HB[t0 * 260 + v0 + r] = (aS0[e] + SC[128 + t0] * aQ0[e]) * SC[256 + t0]; HB[(32 + t0) * 260 + v0 + r] = (aS1[e] + SC[128 + 32 + t0] * aQ1[e]) * SC[256 + 32 + t0]; }
        __syncthreads();
        {
            const int t = tid >> 3, p = tid & 7; f32x4 x[8]; float sm = 0.f;
#pragma unroll
            for (int k = 0; k < 8; ++k) { x[k] = *(const LAS f32x4*)(HB + t * 260 + 32 * p + 4 * k); sm += (x[k].x + x[k].y) + (x[k].z + x[k].w); }
            sm += shx(sm, 1, lane); sm += shx(sm, 2, lane); sm += shx(sm, 4, lane);
            const float mean = sm * (1.f / 256.f); float sq = 0.f;
#pragma unroll
            for (int k = 0; k < 8; ++k) { x[k] = x[k] - mean; sq += (x[k].x * x[k].x + x[k].y * x[k].y) + (x[k].z * x[k].z + x[k].w * x[k].w); }
            sq += shx(sq, 1, lane); sq += shx(sq, 2, lane); sq += shx(sq, 4, lane);
            const float rstd = rsqrtf(sq * (1.f / 256.f) + EPS);
            const float* gp = gain + h * 256 + 32 * p; bf16* op = Zb + (size_t)(tokl + t) * ZLD + out_col + h * 256 + 32 * p;
#pragma unroll
            for (int i = 0; i < 4; ++i) { const f32x4 g0 = *(const f32x4*)(gp + 8 * i), g1 = *(const f32x4*)(gp + 8 * i + 4); const f32x4 a = x[2 * i] * rstd * g0, b = x[2 * i + 1] * rstd * g1; const u32x4 og = ogr[i]; u32x4 w;
                w.x = pk2(a.x * bflo(og.x), a.y * bfhi(og.x)); w.y = pk2(a.z * bflo(og.y), a.w * bfhi(og.y)); w.z = pk2(b.x * bflo(og.z), b.y * bfhi(og.z)); w.w = pk2(b.z * bflo(og.w), b.w * bfhi(og.w));
                *(u32x4*)(op + 8 * i) = w; }
        }
        __syncthreads();
    }
}

__device__ __forceinline__ void sgu_phase(const Args& a, int l, unsigned char* ws, LAS unsigned char* lds, int G, int cu, int tid, int wave, int lane, const int out_col) {
    bf16* Zb = (bf16*)(ws + WS_Z); const bf16* ZT = (const bf16*)(ws + WS_ZT); const bf16* Wc = (const bf16*)(ws + WS_WSGU);
    const float* lng = a.in[I_SLNG] + (size_t)l * 1024; const float* lnb = a.in[I_SLNB] + (size_t)l * 1024; const float* bs = a.in[I_SBS] + (size_t)l * 4 * 128;
    LAS bf16* VT = (LAS bf16*)lds;
    LAS float* PS = (LAS float*)(lds + 69632);
    LAS float* ST = (LAS float*)(lds + 69632 + 8192);
    LAS bf16* WS_ = (LAS bf16*)(lds + 78848);
    const int c8 = tid & 15, dq = tid >> 4;
    int gcur = -1;
    u32x4 x[8];
    if (cu < 4 * 32 * 4) { const int g = cu & 3, cc = (cu >> 2) & 31, bl = cu >> 7;
#pragma unroll
        for (int rep = 0; rep < 8; ++rep) x[rep] = *(const u32x4*)(ZT + (size_t)(1024 + g * 256 + dq + 32 * rep) * ZTLD + bl * SEQ + cc * 128 + c8 * 8); }
    for (int u = cu; u < 4 * 32 * 4; u += G) {
        const int g = u & 3, cc = (u >> 2) & 31, bl = u >> 7; const int tokl = bl * SEQ + cc * 128;
        if (g != gcur) { __syncthreads();
#pragma unroll
            for (int rep = 0; rep < 4; ++rep) { const int idx = tid + rep * NTHR, t = idx >> 4; *(LAS u32x4*)(WS_ + t * 136 + c8 * 8) = *(const u32x4*)(Wc + (size_t)(g * 128 + t) * 128 + c8 * 8); }
            gcur = g; }
        {
            float sm[8], sq[8];
#pragma unroll
            for (int k = 0; k < 8; ++k) { sm[k] = 0.f; sq[k] = 0.f; }
#pragma unroll
            for (int rep = 0; rep < 8; ++rep) { const u32x4 v = x[rep]; const float f0 = bflo(v.x), f1 = bfhi(v.x), f2 = bflo(v.y), f3 = bfhi(v.y), f4 = bflo(v.z), f5 = bfhi(v.z), f6 = bflo(v.w), f7 = bfhi(v.w);
                sm[0] += f0; sq[0] += f0 * f0; sm[1] += f1; sq[1] += f1 * f1; sm[2] += f2; sq[2] += f2 * f2; sm[3] += f3; sq[3] += f3 * f3;
                sm[4] += f4; sq[4] += f4 * f4; sm[5] += f5; sq[5] += f5 * f5; sm[6] += f6; sq[6] += f6 * f6; sm[7] += f7; sq[7] += f7 * f7; }
#pragma unroll
            for (int k = 0; k < 8; ++k) { sm[k] += shx(sm[k], 16, lane); sq[k] += shx(sq[k], 16, lane); sm[k] += shx(sm[k], 32, lane); sq[k] += shx(sq[k], 32, lane); }
            if (lane < 16) {
#pragma unroll
                for (int k = 0; k < 8; ++k) { PS[(wave * 128 + c8 * 8 + k) * 2] = sm[k]; PS[(wave * 128 + c8 * 8 + k) * 2 + 1] = sq[k]; } }
        }
        __syncthreads();
        if (tid < 128) { float sm = 0.f, sq = 0.f;
#pragma unroll
            for (int p = 0; p < 8; ++p) { sm += PS[(p * 128 + tid) * 2]; sq += PS[(p * 128 + tid) * 2 + 1]; }
            const float mean = sm * (1.f / 256.f); const float var = fmaxf(sq * (1.f / 256.f) - mean * mean, 0.f); ST[tid] = mean; ST[128 + tid] = rsqrtf(var + EPS); }
        __syncthreads();
        { const LAS float* mp = ST + c8 * 8; const LAS float* rp = ST + 128 + c8 * 8; float mm[8], rr[8];
#pragma unroll
            for (int k = 0; k < 8; ++k) { mm[k] = mp[k]; rr[k] = rp[k]; }
#pragma unroll
            for (int rep = 0; rep < 8; ++rep) { const int d = dq + 32 * rep; const float gg = lng[g * 256 + d], bb = lnb[g * 256 + d]; u32x4 v = x[rep];
                v.x = pk2((bflo(v.x) - mm[0]) * rr[0] * gg + bb, (bfhi(v.x) - mm[1]) * rr[1] * gg + bb); v.y = pk2((bflo(v.y) - mm[2]) * rr[2] * gg + bb, (bfhi(v.y) - mm[3]) * rr[3] * gg + bb);
                v.z = pk2((bflo(v.z) - mm[4]) * rr[4] * gg + bb, (bfhi(v.z) - mm[5]) * rr[5] * gg + bb); v.w = pk2((bflo(v.w) - mm[6]) * rr[6] * gg + bb, (bfhi(v.w) - mm[7]) * rr[7] * gg + bb);
                *(LAS u32x4*)(VT + d * 136 + c8 * 8) = v; } }
        if (u + G < 4 * 32 * 4) { const int un = u + G, gn = un & 3, ccn = (un >> 2) & 31, bln = un >> 7;
#pragma unroll
            for (int rep = 0; rep < 8; ++rep) x[rep] = *(const u32x4*)(ZT + (size_t)(1024 + gn * 256 + dq + 32 * rep) * ZTLD + bln * SEQ + ccn * 128 + c8 * 8); }
        __syncthreads();
        {
            const int r = lane & 31, hh = lane >> 5, d0 = 32 * wave;
            u32x2 uu[4][4];
#pragma unroll
            for (int tb = 0; tb < 4; ++tb)
#pragma unroll
                for (int q = 0; q < 4; ++q) uu[tb][q] = *(const u32x2*)(Zb + (size_t)(tokl + 32 * tb + r) * ZLD + ZC_U + g * 256 + d0 + 4 * hh + 8 * q);
            f32x16 acc[4];
#pragma unroll
            for (int tb = 0; tb < 4; ++tb)
#pragma unroll
                for (int e = 0; e < 16; ++e) acc[tb][e] = 0.f;
#pragma unroll
            for (int ks = 0; ks < 8; ++ks) { const bf16x8 af = *(const LAS bf16x8*)(VT + (d0 + r) * 136 + 16 * ks + 8 * hh);
#pragma unroll
                for (int tb = 0; tb < 4; ++tb) if (16 * ks <= 32 * tb + 31) { const bf16x8 bfv = *(const LAS bf16x8*)(WS_ + (32 * tb + r) * 136 + 16 * ks + 8 * hh);
                    acc[tb] = __builtin_amdgcn_mfma_f32_32x32x16_bf16(af, bfv, acc[tb], 0, 0, 0); } }
#pragma unroll
            for (int tb = 0; tb < 4; ++tb) { const int t = 32 * tb + r; const float bias = bs[g * 128 + t]; bf16* rowp = Zb + (size_t)(tokl + t) * ZLD + out_col + g * 256 + d0 + 4 * hh;
#pragma unroll
                for (int q = 0; q < 4; ++q) { const u32x2 v = uu[tb][q]; u32x2 w;
                    w.x = pk2(bflo(v.x) * (acc[tb][4 * q] + bias), bfhi(v.x) * (acc[tb][4 * q + 1] + bias)); w.y = pk2(bflo(v.y) * (acc[tb][4 * q + 2] + bias), bfhi(v.y) * (acc[tb][4 * q + 3] + bias)); *(u32x2*)(rowp + 8 * q) = w; } }
        }
        __syncthreads();
    }
}

__device__ __forceinline__ void softmax_rows(unsigned char* ws, int gw, int NGW, int lane) {
    bf16* Zb = (bf16*)(ws + WS_Z);
    for (int m = gw; m < MH; m += NGW) {
        u32x4* p = (u32x4*)(Zb + (size_t)m * ZLD + ZC_XQ + 16 * lane); const u32x4 x0 = p[0], x1 = p[1];
        float v[16] = { bflo(x0.x), bfhi(x0.x), bflo(x0.y), bfhi(x0.y), bflo(x0.z), bfhi(x0.z), bflo(x0.w), bfhi(x0.w), bflo(x1.x), bfhi(x1.x), bflo(x1.y), bfhi(x1.y), bflo(x1.z), bfhi(x1.z), bflo(x1.w), bfhi(x1.w) };
        float mx = v[0];
#pragma unroll
        for (int e = 1; e < 16; ++e) mx = fmaxf(mx, v[e]);
#pragma unroll
        for (int o = 1; o < 16; o <<= 1) mx = fmaxf(mx, shx(mx, o, lane));
        float s = 0.f;
#pragma unroll
        for (int e = 0; e < 16; ++e) { v[e] = __expf(v[e] - mx); s += v[e]; }
#pragma unroll
        for (int o = 1; o < 16; o <<= 1) s += shx(s, o, lane);
        const float inv = 1.f / s;
        u32x4 y0, y1; y0.x = pk2(v[0] * inv, v[1] * inv); y0.y = pk2(v[2] * inv, v[3] * inv); y0.z = pk2(v[4] * inv, v[5] * inv); y0.w = pk2(v[6] * inv, v[7] * inv);
        y1.x = pk2(v[8] * inv, v[9] * inv); y1.y = pk2(v[10] * inv, v[11] * inv); y1.z = pk2(v[12] * inv, v[13] * inv); y1.w = pk2(v[14] * inv, v[15] * inv);
        p[0] = y0; p[1] = y1;
    }
}

__global__ void __launch_bounds__(NTHR, 2) trunk_fwd(Args args) {
    extern __shared__ __attribute__((aligned(16))) unsigned char lds_raw[];
    LAS unsigned char* lds = (LAS unsigned char*)lds_raw;
    volatile LAS unsigned* MISC = (volatile LAS unsigned*)(lds + MISC_OFF);
    const int G = gridDim.x, cu = blockIdx.x;
    unsigned char* ws = args.ws;
#define PHASE_IDS() int tid = threadIdx.x; asm volatile("" : "+v"(tid)); const int lane = tid & 63, wave = __builtin_amdgcn_readfirstlane(tid >> 6); \
    const int vcu = (G % 8 == 0) ? (cu % 8) * (G / 8) + cu / 8 : cu; const int gw = vcu * NWAVES + wave, NGW = G * NWAVES, gtid = cu * NTHR + tid, GT = G * NTHR; (void)gw; (void)NGW; (void)gtid; (void)GT; (void)lane
    for (int u = threadIdx.x; u < (LDS_BYTES - RING_BYTES) / 4; u += NTHR) ((LAS unsigned*)(lds + RING_BYTES))[u] = 0u;
    __syncthreads();
    XcdBarrier bar = xcd_barrier_post((unsigned*)(ws + WS_CTL) + 4096, MISC + 8);
    const int lo = args.ph_lo, hi = args.ph_hi;
    int ph = 0;
#define IN() (lo <= ph && ph < hi)
#define SEAM() do { if (lo <= ph && ph + 1 < hi) xcd_barrier(bar); ++ph; } while (0)
    bf16* XN = (bf16*)(ws + WS_XN); bf16* Wb = (bf16*)(ws + WS_W); float* RSTD = (float*)(ws + WS_RSTD);
    float* hbuf = args.out;

    if (IN()) { PHASE_IDS();
        convert_layer(args, 0, ws, lds, gw, NGW, wave, lane, gtid, GT);
        thin_rows(nullptr, 0, nullptr, 0.f, args.in[I_X], nullptr, XN, RSTD, nullptr, 0, M, gw, NGW, lane, false, nullptr, nullptr, nullptr, nullptr, nullptr);
        __syncthreads();
    }
    SEAM();

    for (int sb = 0; sb < 2 * DEPTH; ++sb) {
        const int l = sb >> 1, j = sb & 1;
        const float* ng = args.in[I_NORMG] + (size_t)l * NNORM * D;
        if (IN()) { PHASE_IDS();
            pg8::Gemm g{D, D, D}; pg8::TileSched S; S.init(M / 256, 2 * DFF / 256, G, cu, XN, D * 2, (char*)Wb + (j ? WO_GU1 : WO_GU0), D * 2);
            pg8::EpiGU E{(bf16*)(ws + WS_HID), RSTD};
            pg8::gemm_phase(lds, g, S, E, tid);
        }
        SEAM();
        if (IN()) { PHASE_IDS();
            pg8::Gemm g{DFF, DFF, DFF}; pg8::TileSched S; S.init(M / 256, D / 256, G, cu, ws + WS_HID, DFF * 2, (char*)Wb + (j ? WO_D1 : WO_D0), DFF * 2);
            pg8::EpiAct E{(bf16*)(ws + WS_F), (size_t)D, 0, nullptr, nullptr};
            pg8::gemm_phase(lds, g, S, E, tid);
        }
        SEAM();
        if (IN()) { PHASE_IDS();
            const float* hin = (sb == 0) ? args.in[I_X] : hbuf;
            if (j == 0) {
                LAS float* wif = (LAS float*)lds;
                for (int e = tid; e < D * 8 / 4; e += NTHR) ((LAS f32x4*)wif)[e] = ((const f32x4*)(ws + WS_WIF))[e];
                __syncthreads();
                float* gi = (float*)(ws + WS_GATE);
                const float* hx = (sb == 0) ? args.in[I_X] : nullptr;
                if (G == 256) {
                    const bool kvcu = (cu < 32) || (cu >= 128 && cu < 160);
                    if (kvcu) { const int gwk = ((cu < 32) ? cu : cu - 96) * NWAVES + wave;
                        thin_rows((const bf16*)(ws + WS_F), D, ng + 1 * D, 0.5f, hx, XN, XN, RSTD, nullptr, 0, 3072, gwk, 512, lane, true, wif, args.in[I_BI] + l * 4, args.in[I_BF] + l * 4, gi, gi + (size_t)M * 4); }
                    else { const int cun = (cu < 128) ? cu - 32 : cu - 64; const int gwn = cun * NWAVES + wave;
                        thin_rows((const bf16*)(ws + WS_F) + (size_t)3072 * D, D, ng + 1 * D, 0.5f, hx, XN, XN, RSTD, nullptr, 3072, M, gwn, 1536, lane, true, wif, args.in[I_BI] + l * 4, args.in[I_BF] + l * 4, gi, gi + (size_t)M * 4); }
                } else
                thin_rows((const bf16*)(ws + WS_F), D, ng + 1 * D, 0.5f, hx, XN, XN, RSTD, nullptr, 0, M, gw, NGW, lane, true, wif, args.in[I_BI] + l * 4, args.in[I_BF] + l * 4, gi, gi + (size_t)M * 4);
                __syncthreads();
                {
                    pg8::Gemm g{D, D, D};
                    pg8::TileSched S; S.init(MMEM / 256, D / 256, G, cu, ws + WS_MEMN, D * 2, (char*)Wb + WO_MKV, D * 2);
                    pg8::EpiAct E{(bf16*)(ws + WS_KMEM), (size_t)D, 0, nullptr, nullptr};
                    pg8::gemm_phase(lds, g, S, E, tid);
                    pg8::TileSched S2; S2.init(D / 256, MMEM / 256, G, (cu + G / 2) % G, (char*)Wb + WO_MKV + (size_t)D * D * 2, D * 2, ws + WS_MEMN, D * 2);
                    pg8::EpiAct E2{(bf16*)(ws + WS_VTMEM), (size_t)MMEM, 0, nullptr, nullptr};
                    pg8::gemm_phase(lds, g, S2, E2, tid);
                }
            } else {
                const bool lastl = (l + 1 == DEPTH);
                thin_rows((const bf16*)(ws + WS_F), D, ng + 5 * D, 0.5f, nullptr, XN, lastl ? nullptr : XN, RSTD, lastl ? hbuf : nullptr, 0, M, gw, NGW, lane, false, nullptr, nullptr, nullptr, nullptr, nullptr);
                if (l + 1 < DEPTH) { __syncthreads(); convert_layer(args, l + 1, ws, lds, gw, NGW, wave, lane, gtid, GT); __syncthreads(); }
            }
        }
        SEAM();
        if (j == 0) {
            for (int hf = 0; hf < 2; ++hf) {
                bf16* Zb = (bf16*)(ws + WS_Z);
                if (IN()) { PHASE_IDS();
                    pg8::Gemm g{D, D, D};
                    pg8::TileSched S; S.init(MH / 256, ZLD / 256, G, cu, XN + (size_t)hf * MH * D, D * 2, (char*)Wb + WO_IN, D * 2);
                    pg8::EpiAct E{Zb, (size_t)ZLD, 1, RSTD + (size_t)hf * MH, nullptr};
                    pg8::gemm_phase(lds, g, S, E, tid);
                    pg8::TileSched S2; S2.init(2048 / 256, MH / 256, G, cu, (char*)Wb + WO_IN + (size_t)ZLD * D * 2, D * 2, XN + (size_t)hf * MH * D, D * 2);
                    pg8::EpiAct E2{(bf16*)(ws + WS_ZT), (size_t)ZTLD, 2, nullptr, RSTD + (size_t)hf * MH};
                    pg8::gemm_phase(lds, g, S2, E2, tid);
                }
                SEAM();
                if (IN()) { PHASE_IDS();
                    mlstm_s1(args, l, hf, ws, lds, G, cu, tid, wave, lane);
                    sgu_phase(args, l, ws, lds, G, cu, tid, wave, lane, ZC_U);
                    pg8::Gemm g{256, ZLD, D};
                    pg8::TileSched S; S.init(MH / 256, 4, G, cu, Zb + ZC_XQ, ZLD * 2, (bf16*)(ws + WS_KMEM) + (size_t)hf * 4 * MEMLEN * D, 0);
                    S.a_pn = 512; S.b_tile = 512; S.pm_per_b = 16; S.b_batch = (size_t)MEMLEN * D * 2;
                    pg8::EpiAct E{Zb + ZC_XQ, (size_t)ZLD, 0, nullptr, nullptr};
                    pg8::gemm_phase(lds, g, S, E, tid);
                    for (int i = 0; ; ++i) { pg8::Unit uu; if (!S.next(i, uu)) break;
                        bf16* tb_ = Zb + (size_t)(uu.pm * 256 + wave * 32 + (lane >> 4)) * ZLD + ZC_XQ + uu.pn * 256 + 16 * (lane & 15);
                        for (int r0 = 0; r0 < 32; r0 += 16) {
                            unsigned long long w[4][4];
#pragma unroll
                            for (int q = 0; q < 4; ++q) { unsigned long long* p = (unsigned long long*)(tb_ + (size_t)(r0 + 4 * q) * ZLD);
#pragma unroll
                                for (int e = 0; e < 4; ++e) w[q][e] = __hip_atomic_load(p + e, __ATOMIC_RELAXED, __HIP_MEMORY_SCOPE_AGENT); }
#pragma unroll
                            for (int q = 0; q < 4; ++q) { float v[16];
#pragma unroll
                                for (int e = 0; e < 4; ++e) { const unsigned lo_ = (unsigned)w[q][e], hi_ = (unsigned)(w[q][e] >> 32); v[4 * e] = bflo(lo_); v[4 * e + 1] = bfhi(lo_); v[4 * e + 2] = bflo(hi_); v[4 * e + 3] = bfhi(hi_); }
                                float mx = v[0];
#pragma unroll
                                for (int e = 1; e < 16; ++e) mx = fmaxf(mx, v[e]);
#pragma unroll
                                for (int o = 1; o < 16; o <<= 1) mx = fmaxf(mx, shx(mx, o, lane));
                                float sm = 0.f;
#pragma unroll
                                for (int e = 0; e < 16; ++e) { v[e] = __expf(v[e] - mx); sm += v[e]; }
#pragma unroll
                                for (int o = 1; o < 16; o <<= 1) sm += shx(sm, o, lane);
                                const float inv = __builtin_amdgcn_rcpf(sm);
                                u32x4* po = (u32x4*)(tb_ + (size_t)(r0 + 4 * q) * ZLD); u32x4 y0, y1;
                                y0.x = pk2(v[0] * inv, v[1] * inv); y0.y = pk2(v[2] * inv, v[3] * inv); y0.z = pk2(v[4] * inv, v[5] * inv); y0.w = pk2(v[6] * inv, v[7] * inv);
                                y1.x = pk2(v[8] * inv, v[9] * inv); y1.y = pk2(v[10] * inv, v[11] * inv); y1.z = pk2(v[12] * inv, v[13] * inv); y1.w = pk2(v[14] * inv, v[15] * inv);
                                po[0] = y0; po[1] = y1; } } }
                }
                SEAM();
                if (IN()) { PHASE_IDS();
                    mlstm_s2(ws, G, cu, tid);
                }
                SEAM();
                if (IN()) { PHASE_IDS();
                    mlstm_s3(args, l, hf, ws, lds, G, cu, tid, wave, lane, ZC_O);
#ifdef PROBE_S3
                    for (int rep_ = 0; rep_ < 2; ++rep_) mlstm_s3(args, l, hf, ws, lds, G, cu, tid, wave, lane, ZC_QK);
#endif
#ifdef PROBE_SGU
                    for (int rep_ = 0; rep_ < 2; ++rep_) sgu_phase(args, l, ws, lds, G, cu, tid, wave, lane, ZC_QK);
#endif
                    pg8::Gemm g{256, ZLD, MMEM};
                    pg8::TileSched S; S.init(MH / 256, 4, G, cu, Zb + ZC_XQ, ZLD * 2, (bf16*)(ws + WS_VTMEM) + (size_t)hf * 4 * MEMLEN, 0);
                    S.a_pn = 512; S.b_tile = (size_t)256 * MMEM * 2; S.pm_per_b = 16; S.b_batch = (size_t)MEMLEN * 2;
                    pg8::EpiAct E{Zb + ZC_XQ, (size_t)ZLD, 0, nullptr, nullptr};
                    pg8::gemm_phase(lds, g, S, E, tid);
                }
                SEAM();
                if (IN()) { PHASE_IDS();
                    pg8::Gemm g{D, ZLD, D};
                    pg8::TileSched S; S.init(MH / 256, D / 256, G, cu, Zb + ZC_O, ZLD * 2, (char*)Wb + WO_BR, D * 2);
                    S.reps = 3; S.a_rep = 1024 * 2; S.b_rep = (size_t)D * D * 2;
                    pg8::EpiBranch E{Zb};
                    pg8::gemm_phase(lds, g, S, E, tid);
                }
                SEAM();
                if (IN()) { PHASE_IDS();
                    pg8::Gemm g{D, ZLD, D};
                    pg8::TileSched S; S.init(MH / 256, D / 256, G, cu, Zb + ZC_QK, ZLD * 2, (char*)Wb + WO_OUT, D * 2);
                    pg8::EpiAct E{Zb + ZC_O, (size_t)ZLD, 0, nullptr, nullptr};
                    pg8::gemm_phase(lds, g, S, E, tid);
                }
                SEAM();
                if (IN()) { PHASE_IDS();
                    thin_rows(Zb + ZC_O, ZLD, ng + 3 * D, 1.0f, nullptr, XN, XN, RSTD, nullptr, hf * MH, (hf + 1) * MH, gw, NGW, lane, false, nullptr, nullptr, nullptr, nullptr, nullptr);
                }
                SEAM();
            }
        }
    }
#undef IN
#undef SEAM
}
constexpr int N_PHASES = 1 + 2 * DEPTH * 3 + DEPTH * 2 * 7;

#ifndef N_LAUNCH_MODE
#define N_LAUNCH_MODE 0
#endif
extern "C" void kernel_launch(void* const* d_in, const int* in_sizes, int n_in, void* d_out, int out_size, void* d_ws, size_t ws_size, hipStream_t stream) {
    static int grid = 0;
    if (grid == 0) {
        if (n_in != 18 || out_size != M * D || ws_size < WS_END) { fprintf(stderr, "kernel_launch: unexpected shapes (n_in %d out %d ws %zu)\n", n_in, out_size, ws_size); grid = -1; return; }
        int dev = 0, cus = 0, per_cu = 0;
        if (hipGetDevice(&dev) != hipSuccess || hipDeviceGetAttribute(&cus, hipDeviceAttributeMultiprocessorCount, dev) != hipSuccess) { grid = -1; return; }
        if (hipFuncSetAttribute((const void*)trunk_fwd, hipFuncAttributeMaxDynamicSharedMemorySize, LDS_BYTES) != hipSuccess) { grid = -1; return; }
        if (hipOccupancyMaxActiveBlocksPerMultiprocessor(&per_cu, (const void*)trunk_fwd, NTHR, LDS_BYTES) != hipSuccess || per_cu < 1) { fprintf(stderr, "kernel_launch: occupancy query says %d\n", per_cu); }
        (void)hipGetLastError();
        grid = cus;
    }
    if (grid < 0) return;
    (void)hipMemsetAsync((char*)d_ws + WS_CTL, 0, CTL_ZERO_BYTES, stream);
    Args a{};
    for (int i = 0; i < 18; ++i) a.in[i] = (const float*)d_in[i];
    a.out = (float*)d_out; a.ws = (unsigned char*)d_ws;
#if N_LAUNCH_MODE == 0
    a.ph_lo = 0; a.ph_hi = N_PHASES;
    hipLaunchKernelGGL(trunk_fwd, dim3(grid), dim3(NTHR), LDS_BYTES, stream, a);
#else
    for (int p = 0; p < N_PHASES; ++p) { a.ph_lo = p; a.ph_hi = p + 1; hipLaunchKernelGGL(trunk_fwd, dim3(grid), dim3(NTHR), LDS_BYTES, stream, a); }
#endif
}
```

```cpp
#include <hip/hip_runtime.h>
#include <cstdio>
#include <cstdint>

#define LAS __attribute__((address_space(3)))
#define GAS __attribute__((address_space(1)))
typedef unsigned short bf16;
typedef short bf16x8 __attribute__((ext_vector_type(8)));
typedef float f32x4 __attribute__((ext_vector_type(4)));
typedef float f32x16 __attribute__((ext_vector_type(16)));
typedef unsigned u32x4 __attribute__((ext_vector_type(4)));
typedef unsigned u32x2 __attribute__((ext_vector_type(2)));

constexpr int D = 1024, BATCH = 8, SEQ = 4096, DEPTH = 2, MEMLEN = 256, DFF = 2816, NNORM = 7;
constexpr int M = BATCH * SEQ, MH = M / 2, MMEM = BATCH * MEMLEN;
constexpr int WIN_COLS = 9224;
constexpr int LCH = 64, NCH = SEQ / LCH;
constexpr int ZLD = 7168;
constexpr int ZC_QK = 0, ZC_O = 1024, ZC_U = 2048, ZC_XQ = 3072, ZC_G = 4096;
constexpr int ZTLD = MH;
constexpr float EPS = 1e-6f;
constexpr int NWAVES = 8, NTHR = 512;

constexpr size_t MiB = 1u << 20;
constexpr size_t WS_CTL = 0, CTL_ZERO_BYTES = 1 * MiB;
constexpr size_t WS_WSGU = 1 * MiB;
constexpr size_t WS_GATE = 2 * MiB;
constexpr size_t WS_NST = 3 * MiB;
constexpr size_t WS_CSC = 4 * MiB;
constexpr size_t WS_MEMN = 5 * MiB;
constexpr size_t WS_KMEM = 9 * MiB;
constexpr size_t WS_VTMEM = 13 * MiB;
constexpr size_t WS_W = 17 * MiB;
constexpr size_t WO_GU0 = 0, WO_GU1 = 11 * MiB, WO_D0 = 22 * MiB, WO_D1 = WO_D0 + 5632 * 1024, WO_IN = 33 * MiB, WO_MKV = 51 * MiB, WO_BR = 55 * MiB, WO_OUT = 61 * MiB;
constexpr size_t WS_XN = 80 * MiB;
constexpr size_t WS_WIF = 4 * MiB + 256 * 1024;
constexpr size_t WS_RSTD = 4 * MiB + 512 * 1024;
constexpr size_t WS_BIG = 144 * MiB;
constexpr size_t WS_HID = WS_BIG, WS_F = WS_BIG + 176 * MiB, WS_Z = WS_BIG, WS_ZT = WS_BIG + 224 * MiB;
constexpr size_t WS_ST = 432 * MiB;
constexpr size_t WS_KC = 496 * MiB;
constexpr size_t WS_END = 512 * MiB;

constexpr int LDS_BYTES = 147456;
constexpr int RING_BYTES = 131072;
constexpr int MISC_OFF = RING_BYTES + 320;

typedef float f32x2_t __attribute__((ext_vector_type(2))); typedef __bf16 bf16x2_t __attribute__((ext_vector_type(2)));
__device__ __forceinline__ unsigned pk2(float lo, float hi) { f32x2_t v = {lo, hi}; bf16x2_t b = __builtin_convertvector(v, bf16x2_t); return __builtin_bit_cast(unsigned, b); }
__device__ __forceinline__ unsigned f2bf(float f) { return pk2(f, 0.f) & 0xffffu; }
__device__ __forceinline__ float bflo(unsigned w) { return __uint_as_float(w << 16); }
__device__ __forceinline__ float bfhi(unsigned w) { return __uint_as_float(w & 0xffff0000u); }
__device__ __forceinline__ float bf1(bf16 b) { return __uint_as_float((unsigned)b << 16); }
__device__ __forceinline__ float shx(float v, int mask, int lane) { return __builtin_bit_cast(float, __builtin_amdgcn_ds_bpermute((lane ^ mask) << 2, __builtin_bit_cast(int, v))); }
__device__ __forceinline__ float shidx(float v, int src) { return __builtin_bit_cast(float, __builtin_amdgcn_ds_bpermute(src << 2, __builtin_bit_cast(int, v))); }
#define DPP_XOR1 0xB1
#define DPP_XOR2 0x4E
#define DPP_HMIR 0x141
#define DPP_MIR  0x140
template <int CTRL> __device__ __forceinline__ float dppf(float v) { return __builtin_bit_cast(float, __builtin_amdgcn_mov_dpp(__builtin_bit_cast(int, v), CTRL, 0xF, 0xF, true)); }
__device__ __forceinline__ float row16_sum(float v) { v += dppf<DPP_XOR1>(v); v += dppf<DPP_XOR2>(v); v += dppf<DPP_HMIR>(v); v += dppf<DPP_MIR>(v); return v; }
__device__ __forceinline__ float row16_max(float v) { v = fmaxf(v, dppf<DPP_XOR1>(v)); v = fmaxf(v, dppf<DPP_XOR2>(v)); v = fmaxf(v, dppf<DPP_HMIR>(v)); v = fmaxf(v, dppf<DPP_MIR>(v)); return v; }
__device__ __forceinline__ float grp8_sum(float v) { v += dppf<DPP_XOR1>(v); v += dppf<DPP_XOR2>(v); v += dppf<DPP_HMIR>(v); return v; }
__device__ __forceinline__ float wave_sum(float v, int lane) { v = row16_sum(v); v += shx(v, 16, lane); v += shx(v, 32, lane); return v; }
__device__ __forceinline__ float sigmoidf_(float x) { return __builtin_amdgcn_rcpf(1.f + __expf(-x)); }
__device__ __forceinline__ float siluf_(float x) { return x * __builtin_amdgcn_rcpf(1.f + __expf(-x)); }
__device__ __forceinline__ float gelu_tanh(float x) { const float u = 1.5957691216f * (x + 0.044715f * x * x * x); return x * __builtin_amdgcn_rcpf(1.f + __expf(-u)); }
__device__ __forceinline__ float logsigmoidf_(float x) { return fminf(x, 0.f) - __logf(1.f + __expf(-fabsf(x))); }
#define LDS_WAIT() asm volatile("s_waitcnt lgkmcnt(0)" ::: "memory")
#define VM_WAIT() asm volatile("s_waitcnt vmcnt(0)" ::: "memory")

namespace pg8 {
constexpr int BM = 256, BK = 64, HALF = 128, HTB = HALF * BK * 2, STAGE_BYTES = 8 * HTB, NXCD = 8, WGM = 8;
__host__ __device__ __forceinline__ int lds_byte(int r, int c) { const int st = (r >> 4) * 2 + (c >> 5), rr = r & 15, cc = c & 31, ob = rr * 64 + cc * 2; return st * 1024 + (ob ^ (((ob >> 9) & 1) << 5)); }
__host__ __device__ __forceinline__ void stage_rc(int b, int& R, int& C) { const int st = b / 1024, sb = b % 1024, swz = sb ^ (((sb >> 9) & 1) << 5); R = (st >> 1) * 16 + swz / 64; C = (st & 1) * 32 + (swz % 64) / 2; }
__host__ __device__ __forceinline__ int perm32(int rho) { const int n = rho >> 4, i = rho & 15; return 8 * (i >> 2) + 4 * n + (i & 3); }

struct Unit { int pm, pn, aux; const char* a; const char* b; };
struct Gemm { int K, lda, ldb; };

struct TileSched {
    int nM, nN, nwg, G, c, reps, pm_per_b;
    const char* A; const char* B;
    size_t a_tile, a_pn, a_rep, b_tile, b_batch, b_rep;
    __device__ __forceinline__ void init(int nM_, int nN_, int G_, int c_, const void* A_, size_t lda_bytes, const void* B_, size_t ldb_bytes) {
        nM = nM_; nN = nN_; nwg = nM * nN; G = G_; c = c_; reps = 1; pm_per_b = 1 << 30; A = (const char*)A_; B = (const char*)B_;
        a_tile = 256 * lda_bytes; a_pn = 0; a_rep = 0; b_tile = 256 * ldb_bytes; b_batch = 0; b_rep = 0;
    }
    __device__ __forceinline__ bool next(int i, Unit& u) const {
        const int ti = i / reps, aux = i - ti * reps;
        const long L = (long)ti * G + c; if (L >= nwg) return false;
        int wgid = (int)L; { const int q = nwg / NXCD, r = nwg % NXCD, xcd = wgid % NXCD, off = wgid / NXCD; wgid = (xcd < r ? xcd * (q + 1) : r * (q + 1) + (xcd - r) * q) + off; }
        const int nig = WGM * nN, gid = wgid / nig, fm = gid * WGM, gsz = (nM - fm) < WGM ? (nM - fm) : WGM;
        u.pm = fm + ((wgid % nig) % gsz); u.pn = (wgid % nig) / gsz; u.aux = aux;
        u.a = A + (size_t)u.pm * a_tile + (size_t)u.pn * a_pn + (size_t)aux * a_rep;
        u.b = B + (size_t)u.pn * b_tile + (size_t)(u.pm / pm_per_b) * b_batch + (size_t)aux * b_rep;
        return true;
    }
};

__device__ __forceinline__ unsigned cvt_pk_bf16(float lo, float hi) { return pk2(lo, hi); }

template <int ACT> __device__ __forceinline__ float actf(float x) {
    if (ACT == 1) return sigmoidf_(x);
    if (ACT == 2) return gelu_tanh(x);
    if (ACT == 3) return x * 0.0625f;
    return x;
}
template <int ACT> __device__ __forceinline__ void store_tile_bf16(const f32x4 (&acc)[2][2][4][2], bf16* O, size_t ldc, int row0, int col0, const float* rsrow, const float* rscol) {
    f32x4 cs[2][2];
#pragma unroll
    for (int bj = 0; bj < 2; ++bj)
#pragma unroll
        for (int n = 0; n < 2; ++n) cs[bj][n] = rscol ? *(const f32x4*)(rscol + col0 + bj * HALF + 4 * n) : (f32x4){1.f, 1.f, 1.f, 1.f};
#pragma unroll
    for (int ai = 0; ai < 2; ++ai)
#pragma unroll
        for (int m = 0; m < 4; ++m) { const int row = row0 + ai * HALF + m * 16; bf16* rowp = O + (size_t)row * ldc + col0; const float rr = rsrow ? rsrow[row] : 1.f;
#pragma unroll
            for (int bj = 0; bj < 2; ++bj) { const f32x4 v0 = acc[ai][bj][m][0] * cs[bj][0] * rr, v1 = acc[ai][bj][m][1] * cs[bj][1] * rr; u32x4 w;
                w.x = cvt_pk_bf16(actf<ACT>(v0[0]), actf<ACT>(v0[1])); w.y = cvt_pk_bf16(actf<ACT>(v0[2]), actf<ACT>(v0[3]));
                w.z = cvt_pk_bf16(actf<ACT>(v1[0]), actf<ACT>(v1[1])); w.w = cvt_pk_bf16(actf<ACT>(v1[2]), actf<ACT>(v1[3]));
                *(u32x4*)(rowp + bj * HALF) = w; } }
}
struct EpiAct {
    static constexpr bool PERM = true;
    bf16* O; size_t ldc; int mode; const float* rsrow; const float* rscol;
    __device__ __forceinline__ void operator()(const f32x4 (&acc)[2][2][4][2], const Unit& u, int wr, int wc, int fr, int fq) const {
        const int row0 = u.pm * BM + wr * 64 + fr, col0 = u.pn * BM + wc * 32 + 8 * fq;
        int act = 0;
        if (mode == 1) { const int g = u.pn >> 2; act = (g == 0) ? 0 : (g == 1) ? 1 : (g == 2) ? 2 : (g == 3) ? 3 : 1; }
        else if (mode == 2) act = (u.pm >= 4) ? 2 : 0;
        if (act == 0) store_tile_bf16<0>(acc, O, ldc, row0, col0, rsrow, rscol);
        else if (act == 1) store_tile_bf16<1>(acc, O, ldc, row0, col0, rsrow, rscol);
        else if (act == 2) store_tile_bf16<2>(acc, O, ldc, row0, col0, rsrow, rscol);
        else store_tile_bf16<3>(acc, O, ldc, row0, col0, rsrow, rscol);
    }
};
struct EpiGU {
    static constexpr bool PERM = true;
    bf16* O; const float* rsrow;
    __device__ __forceinline__ void operator()(const f32x4 (&acc)[2][2][4][2], const Unit& u, int wr, int wc, int fr, int fq) const {
        const int row0 = u.pm * BM + wr * 64 + fr, col0 = u.pn * HALF + wc * 32 + 8 * fq;
#pragma unroll
        for (int ai = 0; ai < 2; ++ai)
#pragma unroll
            for (int m = 0; m < 4; ++m) { const int row = row0 + ai * HALF + m * 16; bf16* rowp = O + (size_t)row * DFF + col0; const float rr = rsrow[row];
                const f32x4 g0 = acc[ai][0][m][0] * rr, g1 = acc[ai][0][m][1] * rr, u0 = acc[ai][1][m][0] * rr, u1 = acc[ai][1][m][1] * rr; u32x4 w;
                w.x = cvt_pk_bf16(siluf_(g0[0]) * u0[0], siluf_(g0[1]) * u0[1]); w.y = cvt_pk_bf16(siluf_(g0[2]) * u0[2], siluf_(g0[3]) * u0[3]);
                w.z = cvt_pk_bf16(siluf_(g1[0]) * u1[0], siluf_(g1[1]) * u1[1]); w.w = cvt_pk_bf16(siluf_(g1[2]) * u1[2], siluf_(g1[3]) * u1[3]);
                *(u32x4*)rowp = w; }
    }
};
struct EpiBranch {
    static constexpr bool PERM = true;
    bf16* Zb;
    __device__ __forceinline__ void operator()(const f32x4 (&acc)[2][2][4][2], const Unit& u, int wr, int wc, int fr, int fq) const {
        const int row0 = u.pm * BM + wr * 64 + fr, col0 = u.pn * BM + wc * 32 + 8 * fq; const int j = u.aux;
#pragma unroll
        for (int ai = 0; ai < 2; ++ai)
#pragma unroll
            for (int m = 0; m < 4; ++m) { bf16* rowp = Zb + (size_t)(row0 + ai * HALF + m * 16) * ZLD + col0;
#pragma unroll
                for (int bj = 0; bj < 2; ++bj) { const f32x4 v0 = acc[ai][bj][m][0], v1 = acc[ai][bj][m][1];
                    const u32x4 g = *(const u32x4*)(rowp + ZC_G + j * 1024 + bj * HALF);
                    float o[8] = { v0[0] * bflo(g.x), v0[1] * bfhi(g.x), v0[2] * bflo(g.y), v0[3] * bfhi(g.y), v1[0] * bflo(g.z), v1[1] * bfhi(g.z), v1[2] * bflo(g.w), v1[3] * bfhi(g.w) };
                    if (j > 0) { const u32x4 p = *(const u32x4*)(rowp + ZC_QK + bj * HALF);
                        o[0] += bflo(p.x); o[1] += bfhi(p.x); o[2] += bflo(p.y); o[3] += bfhi(p.y); o[4] += bflo(p.z); o[5] += bfhi(p.z); o[6] += bflo(p.w); o[7] += bfhi(p.w); }
                    u32x4 w; w.x = cvt_pk_bf16(o[0], o[1]); w.y = cvt_pk_bf16(o[2], o[3]); w.z = cvt_pk_bf16(o[4], o[5]); w.w = cvt_pk_bf16(o[6], o[7]);
                    *(u32x4*)(rowp + ZC_QK + bj * HALF) = w; } }
    }
};

template <class Epi, class Sched>
__device__ __forceinline__ void gemm_phase(LAS unsigned char* lds, const Gemm g, const Sched& S, const Epi& E, const int tid) {
    const int wid = __builtin_amdgcn_readfirstlane(tid >> 6), lane = tid & 63, wr = wid >> 2, wc = wid & 3, fr = lane & 15, fq = lane >> 4;
    const int nt = g.K / BK;
    unsigned voffA[2], voffB[2];
#pragma unroll
    for (int i = 0; i < 2; ++i) { int R, C; stage_rc(tid * 16 + i * 8192, R, C); const int Rb = Epi::PERM ? ((R & ~31) + perm32(R & 31)) : R;
        voffA[i] = (unsigned)(R * g.lda + C) * 2u; voffB[i] = (unsigned)(Rb * g.ldb + C) * 2u; }
    const size_t kstep = (size_t)(BK * 2);
    const size_t hstepA = (size_t)HALF * g.lda * 2, hstepB = (size_t)HALF * g.ldb * 2;
    const unsigned ldsw = (unsigned)wid * 1024u;
    const int aoff = lds_byte(wr * 64 + fr, fq * 8), boff = lds_byte(wc * 32 + fr, fq * 8);
#define PG8_SA(b, h) (((b) * 2 + (h)) * HTB)
#define PG8_SB(b, h) ((4 + (b) * 2 + (h)) * HTB)
#define PG8_STAGE(bufoff, gbase, voff) do { _Pragma("unroll") for (int _i = 0; _i < 2; ++_i) \
        __builtin_amdgcn_global_load_lds((const unsigned*)((const char*)(gbase) + (voff)[_i]), (LAS unsigned*)(lds + (bufoff) + ldsw + _i * 8192), 16, 0, 0); } while (0)
#define PG8_LDA(dst, b, h) do { _Pragma("unroll") for (int m = 0; m < 4; ++m) _Pragma("unroll") for (int k = 0; k < 2; ++k) dst[m][k] = *(const LAS bf16x8*)(lds + PG8_SA(b, h) + aoff + m * 2048 + k * 1024); } while (0)
#define PG8_LDB(dst, b, h) do { _Pragma("unroll") for (int n = 0; n < 2; ++n) _Pragma("unroll") for (int k = 0; k < 2; ++k) dst[n][k] = *(const LAS bf16x8*)(lds + PG8_SB(b, h) + boff + n * 2048 + k * 1024); } while (0)
#define PG8_MMA(ai, bj, At, Bt) do { __builtin_amdgcn_s_setprio(1); _Pragma("unroll") for (int m = 0; m < 4; ++m) _Pragma("unroll") for (int n = 0; n < 2; ++n) _Pragma("unroll") for (int k = 0; k < 2; ++k) \
        acc[ai][bj][m][n] = __builtin_amdgcn_mfma_f32_16x16x32_bf16(Bt[n][k], At[m][k], acc[ai][bj][m][n], 0, 0, 0); __builtin_amdgcn_s_setprio(0); } while (0)
#define PG8_WAIT_V(n) asm volatile("s_waitcnt vmcnt(" #n ")" ::: "memory")
#define PG8_WAIT_L(n) asm volatile("s_waitcnt lgkmcnt(" #n ")" ::: "memory")
#define PG8_BAR __builtin_amdgcn_s_barrier()
#define PG8_SCHED __builtin_amdgcn_sched_barrier(0)
    Unit cur, nxt; int ui = 0;
    if (!S.next(0, cur)) return;
    f32x4 acc[2][2][4][2];
#pragma unroll
    for (int a = 0; a < 2; ++a)
#pragma unroll
        for (int b = 0; b < 2; ++b)
#pragma unroll
            for (int m = 0; m < 4; ++m)
#pragma unroll
                for (int n = 0; n < 2; ++n) acc[a][b][m][n] = (f32x4){0.f, 0.f, 0.f, 0.f};
    bf16x8 At[4][2], B0[2][2], B1[2][2];
    const char* cA = cur.a; const char* cB = cur.b;
    PG8_STAGE(PG8_SB(0, 0), cB, voffB); PG8_STAGE(PG8_SB(0, 1), cB + hstepB, voffB); PG8_STAGE(PG8_SA(0, 0), cA, voffA); PG8_STAGE(PG8_SA(0, 1), cA + hstepA, voffA);
    if (wr == 1) PG8_BAR;
    PG8_WAIT_V(2); PG8_BAR;
    PG8_STAGE(PG8_SB(1, 0), cB + kstep, voffB); PG8_STAGE(PG8_SA(1, 0), cA + kstep, voffA); PG8_STAGE(PG8_SB(1, 1), cB + hstepB + kstep, voffB);
    PG8_WAIT_V(6); PG8_BAR;
    for (;;) {
        const bool has_next = S.next(ui + 1, nxt);
        const char* nA = has_next ? nxt.a : cA; const char* nB = has_next ? nxt.b : cB;
        for (int t = 0; t < nt; t += 2) {
            const bool last = (t == nt - 2);
            const char* a1 = cA + (size_t)(t + 1) * kstep;
            const char* a2 = last ? nA : cA + (size_t)(t + 2) * kstep; const char* b2 = last ? nB : cB + (size_t)(t + 2) * kstep;
            const char* a3 = a2 + kstep; const char* b3 = b2 + kstep;
            PG8_LDB(B0, 0, 0); PG8_LDB(B1, 0, 1); PG8_SCHED; PG8_LDA(At, 0, 0); PG8_STAGE(PG8_SA(1, 1), a1 + hstepA, voffA);
            PG8_WAIT_V(8); PG8_WAIT_L(0); PG8_BAR; PG8_MMA(0, 0, At, B0); PG8_MMA(0, 1, At, B1); PG8_BAR; PG8_SCHED;
            PG8_LDA(At, 0, 1); PG8_STAGE(PG8_SB(0, 0), b2, voffB); PG8_STAGE(PG8_SB(0, 1), b2 + hstepB, voffB); PG8_STAGE(PG8_SA(0, 0), a2, voffA);
            PG8_WAIT_V(8); PG8_WAIT_L(0); PG8_BAR; PG8_MMA(1, 0, At, B0); PG8_MMA(1, 1, At, B1); PG8_BAR; PG8_SCHED;
            PG8_LDB(B0, 1, 0); PG8_LDB(B1, 1, 1); PG8_SCHED; PG8_LDA(At, 1, 0); PG8_STAGE(PG8_SA(0, 1), a2 + hstepA, voffA);
            PG8_WAIT_V(8); PG8_WAIT_L(0); PG8_BAR; PG8_MMA(0, 0, At, B0); PG8_MMA(0, 1, At, B1); PG8_BAR; PG8_SCHED;
            PG8_LDA(At, 1, 1); PG8_STAGE(PG8_SB(1, 0), b3, voffB); PG8_STAGE(PG8_SB(1, 1), b3 + hstepB, voffB); PG8_STAGE(PG8_SA(1, 0), a3, voffA);
            PG8_WAIT_V(8); PG8_WAIT_L(0); PG8_BAR; PG8_MMA(1, 0, At, B0); PG8_MMA(1, 1, At, B1); PG8_BAR; PG8_SCHED;
        }
        if (wr == 0) PG8_BAR;
        E(acc, cur, wr, wc, fr, fq);
        if (!has_next) break;
#pragma unroll
        for (int a = 0; a < 2; ++a)
#pragma unroll
            for (int b = 0; b < 2; ++b)
#pragma unroll
                for (int m = 0; m < 4; ++m)
#pragma unroll
                    for (int n = 0; n < 2; ++n) acc[a][b][m][n] = (f32x4){0.f, 0.f, 0.f, 0.f};
        cur = nxt; cA = nA; cB = nB; ++ui;
        if (wr == 1) PG8_BAR;
    }
    PG8_WAIT_V(0);
    PG8_BAR;
#undef PG8_SA
#undef PG8_SB
#undef PG8_STAGE
#undef PG8_LDA
#undef PG8_LDB
#undef PG8_MMA
#undef PG8_WAIT_V
#undef PG8_WAIT_L
#undef PG8_BAR
#undef PG8_SCHED
}
}

#define XB_TMO      128
#define XB_XCNT(j)  (256  + 64 * (j))
#define XB_XSUB(j)  (1280 + 64 * (j))
#define XB_XGEN(j)  (2304 + 64 * (j))
#define XB_TOP      3328
#define XB_TOPGEN   3392
#define XCD_BAR_WORDS 3456
#define XB_SPIN_CAP (1u << 18)
__device__ __forceinline__ unsigned xb_ld(unsigned* p)              { return __hip_atomic_load(p, __ATOMIC_RELAXED, __HIP_MEMORY_SCOPE_AGENT); }
__device__ __forceinline__ unsigned xb_add(unsigned* p, unsigned v) { return __hip_atomic_fetch_add(p, v, __ATOMIC_RELAXED, __HIP_MEMORY_SCOPE_AGENT); }
__device__ __forceinline__ unsigned xb_xcc_id() { return (unsigned)__builtin_amdgcn_s_getreg((3 << 11) | 20) & 0xFu; }
#define XB_SPIN(cond, bar) do { unsigned _sp = 0; while (cond) { __builtin_amdgcn_s_sleep(1); \
    if ((++_sp & 255u) == 0u) { if (xb_ld(&(bar)[XB_TMO])) break; if (_sp > XB_SPIN_CAP) { atomicAdd(&(bar)[XB_TMO], 1u); break; } } } } while (0)
struct XcdBarrier { unsigned* bar; unsigned x; volatile LAS unsigned* st; };
__device__ __forceinline__ XcdBarrier xcd_barrier_post(unsigned* bar, volatile LAS unsigned* st) {
    XcdBarrier b; b.bar = bar; b.x = xb_xcc_id(); b.st = st;
    if (threadIdx.x == 0) (void)xb_add(&bar[XB_XCNT(b.x)], 1u);
    return b;
}
__device__ __forceinline__ void xcd_barrier_complete(unsigned* bar, unsigned x, unsigned& nloc, unsigned& nx) {
    const unsigned G = gridDim.x * gridDim.y * gridDim.z;
    unsigned sum, cnt, mine, sp = 0u;
    for (;;) {
        sum = 0u; cnt = 0u; mine = 0u;
#pragma unroll
        for (unsigned j = 0; j < 16; ++j) { const unsigned c = xb_ld(&bar[XB_XCNT(j)]); sum += c; cnt += (c > 0u) ? 1u : 0u; mine = (j == x) ? c : mine; }
        if (sum == G) break;
        __builtin_amdgcn_s_sleep(1);
        if ((++sp & 255u) == 0u) { if (xb_ld(&bar[XB_TMO])) break; if (sp > XB_SPIN_CAP) { atomicAdd(&bar[XB_TMO], 1u); break; } }
    }
    nloc = mine > 0u ? mine : 1u; nx = cnt > 0u ? cnt : 1u;
}
__device__ __forceinline__ void xcd_barrier(const XcdBarrier& b) {
    asm volatile("s_waitcnt vmcnt(0)" ::: "memory");
    __syncthreads();
    if (threadIdx.x == 0) {
        unsigned* bar = b.bar;
        __builtin_amdgcn_s_waitcnt(0);
        unsigned nloc = b.st[0], nx = b.st[1];
        if (nloc == 0u) { xcd_barrier_complete(bar, b.x, nloc, nx); b.st[0] = nloc; b.st[1] = nx; }
        const unsigned old = xb_add(&bar[XB_XSUB(b.x)], 1u);
        const unsigned gen = old / nloc;
        if (old + 1u == (gen + 1u) * nloc) {
            __builtin_amdgcn_fence(__ATOMIC_RELEASE, "agent");
            asm volatile("s_waitcnt vmcnt(0)" ::: "memory");
            const unsigned og = xb_add(&bar[XB_TOP], 1u);
            const unsigned tg = og / nx;
            if (og + 1u == (tg + 1u) * nx) xb_add(&bar[XB_TOPGEN], 1u);
            else XB_SPIN(xb_ld(&bar[XB_TOPGEN]) == tg, bar);
            __builtin_amdgcn_fence(__ATOMIC_ACQUIRE, "agent");
            xb_add(&bar[XB_XGEN(b.x)], 1u);
            asm volatile("s_waitcnt vmcnt(0)" ::: "memory");
        } else {
            XB_SPIN(xb_ld(&bar[XB_XGEN(b.x)]) == gen, bar);
            __builtin_amdgcn_fence(__ATOMIC_ACQUIRE, "agent");
            asm volatile("s_waitcnt vmcnt(0)" ::: "memory");
        }
    }
    __syncthreads();
}

struct Args { const float* in[18]; float* out; unsigned char* ws; int ph_lo, ph_hi; };
enum { I_X = 0, I_MEM, I_NORMG, I_WGU, I_WDOWN, I_WIN, I_CONVW, I_CONVB, I_BI, I_BF, I_MNORM, I_SLNG, I_SLNB, I_SWS, I_SBS, I_WMKV, I_WBR, I_WOUT };

__device__ __forceinline__ void cvt_item(const float* W, int Nsrc, int K, int srccol, bf16* WT, int dstrow, int kb, LAS float* scr, int lane, const float* gk = nullptr) {
    const int k0 = 64 * kb;
    if ((srccol & 3) == 0) {
        const int c4 = (lane & 7) * 4, rr = lane >> 3;
#pragma unroll
        for (int i = 0; i < 8; ++i) { const int kk = 8 * i + rr; f32x4 x = *(const f32x4*)(W + (size_t)(k0 + kk) * Nsrc + srccol + c4); if (gk) x = x * gk[k0 + kk];
            LAS float* d = scr + kk * 33 + c4; d[0] = x.x; d[1] = x.y; d[2] = x.z; d[3] = x.w; }
    } else {
#pragma unroll 8
        for (int i = 0; i < 32; ++i) { const int kk = 2 * i + (lane >> 5); scr[kk * 33 + (lane & 31)] = W[(size_t)(k0 + kk) * Nsrc + srccol + (lane & 31)] * (gk ? gk[k0 + kk] : 1.f); }
    }
    LDS_WAIT(); asm volatile("" ::: "memory");
    const int c = lane & 7;
#pragma unroll
    for (int j = 0; j < 4; ++j) { const int n = (lane >> 3) + 8 * j; const LAS float* s = scr + (8 * c) * 33 + n;
        u32x4 o; o.x = pk2(s[0 * 33], s[1 * 33]); o.y = pk2(s[2 * 33], s[3 * 33]); o.z = pk2(s[4 * 33], s[5 * 33]); o.w = pk2(s[6 * 33], s[7 * 33]);
        *(u32x4*)(WT + (size_t)(dstrow + n) * K + k0 + 8 * c) = o; }
    LDS_WAIT(); asm volatile("" ::: "memory");
}
__device__ __forceinline__ int win_srccol(int r) {
    if (r < 1024) return r;
    if (r < 2048) return 2048 + (r - 1024);
    if (r < 3072) return 3080 + (r - 2048);
    if (r < 4096) return 5128 + (r - 3072);
    if (r < 7168) return 6152 + (r - 4096);
    if (r < 8192) return 1024 + (r - 7168);
    return 4104 + (r - 8192);
}
__device__ __forceinline__ void convert_layer(const Args& a, int l, unsigned char* ws, LAS unsigned char* lds, int gw, int NGW, int wave, int lane, int gtid, int GT) {
    LAS float* scr = (LAS float*)(lds + wave * 16384);
    bf16* Wb = (bf16*)(ws + WS_W);
    constexpr int I_GU = 16 * 176, I_DN = 44 * 32, I_IN = 16 * 288, I_MKV = 16 * 64, I_BR = 16 * 32, I_OUT = 16 * 32;
    constexpr int NITEMS = 2 * I_GU + 2 * I_DN + I_IN + I_MKV + 3 * I_BR + I_OUT;
    for (int it = gw; it < NITEMS; it += NGW) {
        int r = it;
        if (r < 2 * I_GU) { const int j = r / I_GU; r -= j * I_GU; const int kb = r / 176, nb = r % 176; const int p = nb >> 3, q = nb & 7, s = q >> 2, jj = (q & 3) * 32;
            cvt_item(a.in[I_WGU] + (size_t)(l * 2 + j) * D * 2 * DFF, 2 * DFF, D, s * DFF + 128 * p + jj, (bf16*)((char*)Wb + (j ? WO_GU1 : WO_GU0)), nb * 32, kb, scr, lane, a.in[I_NORMG] + (size_t)(l * NNORM + (j ? 4 : 0)) * D); continue; }
        r -= 2 * I_GU;
        if (r < 2 * I_DN) { const int j = r / I_DN; r -= j * I_DN; const int kb = r / 32, nb = r % 32;
            cvt_item(a.in[I_WDOWN] + (size_t)(l * 2 + j) * DFF * D, D, DFF, nb * 32, (bf16*)((char*)Wb + (j ? WO_D1 : WO_D0)), nb * 32, kb, scr, lane); continue; }
        r -= 2 * I_DN;
        if (r < I_IN) { const int kb = r / 288, nb = r % 288;
            cvt_item(a.in[I_WIN] + (size_t)l * D * WIN_COLS, WIN_COLS, D, win_srccol(nb * 32), (bf16*)((char*)Wb + WO_IN), nb * 32, kb, scr, lane, a.in[I_NORMG] + (size_t)(l * NNORM + 2) * D); continue; }
        r -= I_IN;
        if (r < I_MKV) { const int kb = r / 64, nb = r % 64;
            cvt_item(a.in[I_WMKV] + (size_t)l * D * 2048, 2048, D, nb * 32, (bf16*)((char*)Wb + WO_MKV), nb * 32, kb, scr, lane); continue; }
        r -= I_MKV;
        if (r < 3 * I_BR) { const int j = r / I_BR; r -= j * I_BR; const int kb = r / 32, nb = r % 32;
            cvt_item(a.in[I_WBR] + (size_t)(l * 3 + j) * D * D, D, D, nb * 32, (bf16*)((char*)Wb + WO_BR) + (size_t)j * D * D, nb * 32, kb, scr, lane); continue; }
        r -= 3 * I_BR;
        { const int kb = r / 32, nb = r % 32; cvt_item(a.in[I_WOUT] + (size_t)l * D * D, D, D, nb * 32, (bf16*)((char*)Wb + WO_OUT), nb * 32, kb, scr, lane); }
    }
    { const float* win = a.in[I_WIN] + (size_t)l * D * WIN_COLS; const float* g2 = a.in[I_NORMG] + (size_t)(l * NNORM + 2) * D; float* wt = (float*)(ws + WS_WIF);
      for (int e = gtid; e < 8 * D; e += GT) { const int k = e >> 3, c = e & 7; wt[c * D + k] = win[(size_t)k * WIN_COLS + 3072 + c] * g2[k]; } }
    bf16* wsg = (bf16*)(ws + WS_WSGU); const float* src = a.in[I_SWS] + (size_t)l * 4 * 128 * 128;
    for (int e = gtid; e < 4 * 128 * 128; e += GT) { const int t = (e >> 7) & 127, s = e & 127; wsg[e] = (bf16)f2bf(s <= t ? src[e] : 0.f); }
    const float* g6 = a.in[I_NORMG] + (size_t)(l * NNORM + 6) * D;
    for (int m = gw; m < MMEM; m += NGW) {
        const f32x4* xr = (const f32x4*)(a.in[I_MEM] + (size_t)m * D) + lane; f32x4 v[4]; float s = 0.f;
#pragma unroll
        for (int j = 0; j < 4; ++j) { v[j] = xr[64 * j]; s += (v[j].x * v[j].x + v[j].y * v[j].y) + (v[j].z * v[j].z + v[j].w * v[j].w); }
        const float rstd = rsqrtf(wave_sum(s, lane) * (1.f / D) + EPS);
        unsigned long long* o8 = (unsigned long long*)((bf16*)(ws + WS_MEMN) + (size_t)m * D) + lane;
#pragma unroll
        for (int j = 0; j < 4; ++j) { const f32x4 gg = ((const f32x4*)g6)[lane + 64 * j];
            o8[64 * j] = (unsigned long long)pk2(v[j].x * rstd * gg.x, v[j].y * rstd * gg.y) | ((unsigned long long)pk2(v[j].z * rstd * gg.z, v[j].w * rstd * gg.w) << 32); }
    }
}

__device__ __forceinline__ void thin_rows(const bf16* fbase, size_t fld, const float* ga, float scale, const float* hin32, const bf16* hinb, bf16* hb_out, float* rstd_out, float* out32,
                                          int row_lo, int row_hi, int gw, int NGW, int lane, const bool do_gates, const LAS float* wif, const float* bi, const float* bfg, float* gate_i, float* gate_f) {
    f32x4 hn32[4]; unsigned long long hnb[4], fn[4];
    int m = row_lo + gw;
    if (m < row_hi) {
        if (hin32) { const f32x4* hr = (const f32x4*)(hin32 + (size_t)m * D) + lane;
#pragma unroll
            for (int j = 0; j < 4; ++j) hn32[j] = hr[64 * j]; }
        else { const unsigned long long* hr = (const unsigned long long*)(hinb + (size_t)m * D) + lane;
#pragma unroll
            for (int j = 0; j < 4; ++j) hnb[j] = hr[64 * j]; }
        if (fbase) { const unsigned long long* fr = (const unsigned long long*)(fbase + (size_t)(m - row_lo) * fld) + lane;
#pragma unroll
            for (int j = 0; j < 4; ++j) fn[j] = fr[64 * j]; }
    }
    for (; m < row_hi; m += NGW) {
        f32x4 v[4]; unsigned long long fc[4];
        if (hin32) {
#pragma unroll
            for (int j = 0; j < 4; ++j) v[j] = hn32[j]; }
        else {
#pragma unroll
            for (int j = 0; j < 4; ++j) { const unsigned long long w = hnb[j]; const unsigned lo = (unsigned)w, hi = (unsigned)(w >> 32); v[j] = (f32x4){bflo(lo), bfhi(lo), bflo(hi), bfhi(hi)}; } }
#pragma unroll
        for (int j = 0; j < 4; ++j) fc[j] = fn[j];
        const int mn = m + NGW;
        if (mn < row_hi) {
            if (hin32) { const f32x4* hr = (const f32x4*)(hin32 + (size_t)mn * D) + lane;
#pragma unroll
                for (int j = 0; j < 4; ++j) hn32[j] = hr[64 * j]; }
            else { const unsigned long long* hr = (const unsigned long long*)(hinb + (size_t)mn * D) + lane;
#pragma unroll
                for (int j = 0; j < 4; ++j) hnb[j] = hr[64 * j]; }
            if (fbase) { const unsigned long long* fr = (const unsigned long long*)(fbase + (size_t)(mn - row_lo) * fld) + lane;
#pragma unroll
                for (int j = 0; j < 4; ++j) fn[j] = fr[64 * j]; }
        }
        if (fbase) {
            float s = 0.f; f32x4 f[4];
#pragma unroll
            for (int j = 0; j < 4; ++j) { const unsigned long long w = fc[j]; const unsigned lo = (unsigned)w, hi = (unsigned)(w >> 32);
                f[j] = (f32x4){bflo(lo), bfhi(lo), bflo(hi), bfhi(hi)}; s += (f[j].x * f[j].x + f[j].y * f[j].y) + (f[j].z * f[j].z + f[j].w * f[j].w); }
            const float rstd = rsqrtf(wave_sum(s, lane) * (1.f / D) + EPS) * scale;
#pragma unroll
            for (int j = 0; j < 4; ++j) { const f32x4 gg = ((const f32x4*)ga)[lane + 64 * j]; v[j] = v[j] + f[j] * rstd * gg; }
        }
        if (out32) { f32x4* ho = (f32x4*)(out32 + (size_t)m * D) + lane;
#pragma unroll
            for (int j = 0; j < 4; ++j) ho[64 * j] = v[j]; }
        if (hb_out) {
            float s = 0.f;
#pragma unroll
            for (int j = 0; j < 4; ++j) s += (v[j].x * v[j].x + v[j].y * v[j].y) + (v[j].z * v[j].z + v[j].w * v[j].w);
            const float rstd = rsqrtf(wave_sum(s, lane) * (1.f / D) + EPS);
            unsigned long long* o8 = (unsigned long long*)(hb_out + (size_t)m * D) + lane;
#pragma unroll
            for (int j = 0; j < 4; ++j) o8[64 * j] = (unsigned long long)pk2(v[j].x, v[j].y) | ((unsigned long long)pk2(v[j].z, v[j].w) << 32);
            if (lane == 0) rstd_out[m] = rstd;
            if (do_gates) {
                float acc[8];
#pragma unroll
                for (int e = 0; e < 8; ++e) acc[e] = 0.f;
#pragma unroll
                for (int j = 0; j < 4; ++j)
#pragma unroll
                    for (int e = 0; e < 8; ++e) { const f32x4 w4 = *(const LAS f32x4*)(wif + e * D + 4 * lane + 256 * j); acc[e] += (v[j].x * w4.x + v[j].y * w4.y) + (v[j].z * w4.z + v[j].w * w4.w); }
                {
                    float b4[4], b2[2], b1;
#pragma unroll
                    for (int e = 0; e < 4; ++e) { const float mine = (lane & 4) ? acc[4 + e] : acc[e], send = (lane & 4) ? acc[e] : acc[4 + e]; b4[e] = mine + dppf<DPP_HMIR>(send); }
#pragma unroll
                    for (int e = 0; e < 2; ++e) { const float mine = (lane & 2) ? b4[2 + e] : b4[e], send = (lane & 2) ? b4[e] : b4[2 + e]; b2[e] = mine + dppf<DPP_XOR2>(send); }
                    { const float mine = (lane & 1) ? b2[1] : b2[0], send = (lane & 1) ? b2[0] : b2[1]; b1 = mine + dppf<DPP_XOR1>(send); }
                    b1 += shx(b1, 8, lane); b1 += shx(b1, 16, lane); b1 += shx(b1, 32, lane);
                    const float val = b1 * rstd;
                    if (lane < 4) gate_i[(size_t)m * 4 + lane] = val + bi[lane];
                    else if (lane < 8) gate_f[(size_t)m * 4 + lane - 4] = logsigmoidf_(val + bfg[lane - 4]);
                }
            }
        }
    }
}

__device__ __forceinline__ void conv8(const bf16* Zb, int bl, int p, int col, const float* cw, const float* cb, float (&o)[8]) {
    const f32x4 b0 = *(const f32x4*)(cb + col), b1 = *(const f32x4*)(cb + col + 4);
    o[0] = b0.x; o[1] = b0.y; o[2] = b0.z; o[3] = b0.w; o[4] = b1.x; o[5] = b1.y; o[6] = b1.z; o[7] = b1.w;
#pragma unroll
    for (int j = 0; j < 4; ++j) { const int pp = p - 3 + j;
        if (pp >= 0) { const u32x4 x = *(const u32x4*)(Zb + (size_t)(bl * SEQ + pp) * ZLD + ZC_QK + col);
            const f32x4 w0 = *(const f32x4*)(cw + j * 1024 + col), w1 = *(const f32x4*)(cw + j * 1024 + col + 4);
            o[0] += w0.x * bflo(x.x); o[1] += w0.y * bfhi(x.x); o[2] += w0.z * bflo(x.y); o[3] += w0.w * bfhi(x.y);
            o[4] += w1.x * bflo(x.z); o[5] += w1.y * bfhi(x.z); o[6] += w1.z * bflo(x.w); o[7] += w1.w * bfhi(x.w); } }
#pragma unroll
    for (int e = 0; e < 8; ++e) o[e] = siluf_(o[e]);
}
__device__ __forceinline__ float wave_incl_scan_add(float v, int lane) {
#pragma unroll
    for (int o = 1; o < 64; o <<= 1) { const float t = shidx(v, lane >= o ? lane - o : lane); if (lane >= o) v += t; }
    return v;
}
__device__ __forceinline__ float wave_incl_scan_max(float v, int lane) {
#pragma unroll
    for (int o = 1; o < 64; o <<= 1) { const float t = shidx(v, lane >= o ? lane - o : lane); if (lane >= o) v = fmaxf(v, t); }
    return v;
}
__device__ __forceinline__ float wave_max(float v, int lane) { v = row16_max(v); v = fmaxf(v, shx(v, 16, lane)); v = fmaxf(v, shx(v, 32, lane)); return v; }
constexpr float KSCALE = 0.08838834764831845f;

__device__ __forceinline__ void conv_load(const bf16* Zb, int bl, int p, int col, u32x4 (&raw)[4]) {
#pragma unroll
    for (int j = 0; j < 4; ++j) { const int pp = p - 3 + j; raw[j] = (u32x4){0u, 0u, 0u, 0u};
        if (pp >= 0) raw[j] = *(const u32x4*)(Zb + (size_t)(bl * SEQ + pp) * ZLD + ZC_QK + col); }
}
__device__ __forceinline__ void conv_apply(const u32x4 (&raw)[4], const LAS float* wl, const int wstride, float (&o)[8]) {
    { const f32x4 b0 = *(const LAS f32x4*)(wl + 4 * wstride), b1 = *(const LAS f32x4*)(wl + 4 * wstride + 4);
      o[0] = b0.x; o[1] = b0.y; o[2] = b0.z; o[3] = b0.w; o[4] = b1.x; o[5] = b1.y; o[6] = b1.z; o[7] = b1.w; }
#pragma unroll
    for (int j = 0; j < 4; ++j) { const u32x4 x = raw[j];
        const f32x4 w0 = *(const LAS f32x4*)(wl + j * wstride), w1 = *(const LAS f32x4*)(wl + j * wstride + 4);
        o[0] += w0.x * bflo(x.x); o[1] += w0.y * bfhi(x.x); o[2] += w0.z * bflo(x.y); o[3] += w0.w * bfhi(x.y);
        o[4] += w1.x * bflo(x.z); o[5] += w1.y * bfhi(x.z); o[6] += w1.z * bflo(x.w); o[7] += w1.w * bfhi(x.w); }
#pragma unroll
    for (int e = 0; e < 8; ++e) o[e] = siluf_(o[e]);
}
__device__ __forceinline__ void stage_convw(LAS float* wl, const float* cw, const float* cb, int col0, int ncol, int dst0, int wstride, int tid) {
    for (int e = tid; e < 5 * ncol; e += NTHR) { const int j = e / ncol, cidx = e - j * ncol; wl[j * wstride + dst0 + cidx] = (j < 4) ? cw[j * 1024 + col0 + cidx] : cb[col0 + cidx]; }
}
__device__ __forceinline__ void mlstm_s1(const Args& a, int l, int hf, unsigned char* ws, LAS unsigned char* lds, int G, int cu, int tid, int wave, int lane) {
    const bf16* Zb = (const bf16*)(ws + WS_Z); const bf16* ZT = (const bf16*)(ws + WS_ZT);
    const float* gi = (const float*)(ws + WS_GATE); const float* gf = gi + (size_t)M * 4;
    const float* cw = a.in[I_CONVW] + (size_t)l * 4 * 1024; const float* cb = a.in[I_CONVB] + (size_t)l * 1024;
    LAS bf16* KT = (LAS bf16*)lds;
    LAS float* wv = (LAS float*)(lds + 18432);
    LAS float* CWL = (LAS float*)(lds + 18688);
    const int c8 = tid & 15; int hcur = -1;
    for (int u = cu; u < 16 * NCH; u += G) {
        const int h = u & 3, c = (u >> 2) & 63, bl = u >> 8, bhl = bl * 4 + h; const int tokg = (hf * 4 + bl) * SEQ + c * LCH;
        if (h != hcur) { __syncthreads(); stage_convw(CWL, cw, cb, 512 + h * 128, 128, 0, 128, tid); hcur = h; }
        const int r = lane & 31, hh = lane >> 5, v0 = 32 * wave;
        bf16x8 bfr[4];
        { const bf16* vrow = ZT + (size_t)(h * 256 + v0 + r) * ZTLD + bl * SEQ + c * LCH + 8 * hh;
#pragma unroll
          for (int ks = 0; ks < 4; ++ks) bfr[ks] = *(const bf16x8*)(vrow + 16 * ks); }
        u32x4 raw[2][4];
#pragma unroll
        for (int rep = 0; rep < 2; ++rep) conv_load(Zb, bl, c * LCH + ((tid + rep * NTHR) >> 4), 512 + h * 128 + c8 * 8, raw[rep]);
        if (wave == 0) {
            const float lf = gf[(size_t)(tokg + lane) * 4 + h], ii = gi[(size_t)(tokg + lane) * 4 + h];
            const float bc = wave_incl_scan_add(lf, lane); const float g = shidx(bc, 63);
            const float av = g - bc + ii; const float ml = wave_max(av, lane);
            wv[lane] = __expf(av - ml);
            if (lane == 0) { float* cs = (float*)(ws + WS_CSC) + (size_t)(bhl * NCH + c) * 4; cs[0] = g; cs[1] = ml; }
        }
        __syncthreads();
#pragma unroll
        for (int rep = 0; rep < 2; ++rep) { const int idx = tid + rep * NTHR, s = idx >> 4; float o[8];
            conv_apply(raw[rep], CWL + c8 * 8, 128, o); const float sc = wv[s] * KSCALE;
            { u32x4 w; w.x = pk2(o[0] * KSCALE, o[1] * KSCALE); w.y = pk2(o[2] * KSCALE, o[3] * KSCALE); w.z = pk2(o[4] * KSCALE, o[5] * KSCALE); w.w = pk2(o[6] * KSCALE, o[7] * KSCALE);
              *(u32x4*)((bf16*)(ws + WS_KC) + (size_t)(bl * SEQ + c * LCH + s) * 512 + h * 128 + c8 * 8) = w; }
#pragma unroll
            for (int e = 0; e < 8; ++e) KT[(c8 * 8 + e) * 72 + s] = (bf16)f2bf(o[e] * sc); }
        __syncthreads();
        if (tid < 128) { float s = 0.f;
#pragma unroll 8
            for (int k = 0; k < 64; ++k) s += bf1(KT[tid * 72 + k]);
            ((float*)(ws + WS_NST))[(size_t)(bhl * NCH + c) * 128 + tid] = s; }
        {
            bf16* st = (bf16*)(ws + WS_ST) + (size_t)(bhl * NCH + c) * 32768 + (size_t)(v0 + r) * 128;
#pragma unroll
            for (int db = 0; db < 4; ++db) { f32x16 acc;
#pragma unroll
                for (int e = 0; e < 16; ++e) acc[e] = 0.f;
#pragma unroll
                for (int ks = 0; ks < 4; ++ks) { const bf16x8 af = *(const LAS bf16x8*)(KT + (32 * db + r) * 72 + 16 * ks + 8 * hh); acc = __builtin_amdgcn_mfma_f32_32x32x16_bf16(af, bfr[ks], acc, 0, 0, 0); }
#pragma unroll
                for (int q = 0; q < 4; ++q) { u32x2 w; w.x = pk2(acc[4 * q], acc[4 * q + 1]); w.y = pk2(acc[4 * q + 2], acc[4 * q + 3]); *(u32x2*)(st + 32 * db + 8 * q + 4 * hh) = w; } }
        }
        __syncthreads();
    }
}
__device__ __forceinline__ void mlstm_s2(unsigned char* ws, int G, int cu, int tid) {
    for (int u = cu; u < 256; u += G) {
        const int bhl = u >> 4, part = u & 15; const size_t off = (size_t)(part * NTHR + tid) * 4;
        bf16* st = (bf16*)(ws + WS_ST) + (size_t)bhl * NCH * 32768 + off; float* ns = (float*)(ws + WS_NST) + (size_t)bhl * NCH * 128 + tid; float* cs = (float*)(ws + WS_CSC) + (size_t)bhl * NCH * 4;
        const bool nth = (part == 0 && tid < 128);
        float C[4]; float nv = 0.f, m = -1e30f;
#pragma unroll
        for (int e = 0; e < 4; ++e) C[e] = 0.f;
        for (int c0 = 0; c0 < NCH; c0 += 8) {
            u32x2 cl[8]; float nl[8], gg[8], ml[8];
#pragma unroll
            for (int i = 0; i < 8; ++i) { cl[i] = *(const u32x2*)(st + (size_t)(c0 + i) * 32768); nl[i] = nth ? ns[(c0 + i) * 128] : 0.f; gg[i] = cs[(c0 + i) * 4]; ml[i] = cs[(c0 + i) * 4 + 1]; }
#pragma unroll
            for (int i = 0; i < 8; ++i) {
                u32x2 o; o.x = pk2(C[0], C[1]); o.y = pk2(C[2], C[3]);
                *(u32x2*)(st + (size_t)(c0 + i) * 32768) = o;
                if (nth) ns[(c0 + i) * 128] = nv;
                if (part == 0 && tid == 0) cs[(c0 + i) * 4 + 2] = m;
                const float mn = fmaxf(gg[i] + m, ml[i]); const float dec = __expf(gg[i] + m - mn), sc = __expf(ml[i] - mn);
                C[0] = dec * C[0] + sc * bflo(cl[i].x); C[1] = dec * C[1] + sc * bfhi(cl[i].x); C[2] = dec * C[2] + sc * bflo(cl[i].y); C[3] = dec * C[3] + sc * bfhi(cl[i].y);
                nv = dec * nv + sc * nl[i]; m = mn;
            }
        }
    }
}
__device__ __forceinline__ void mlstm_s3(const Args& a, int l, int hf, unsigned char* ws, LAS unsigned char* lds, int G, int cu, int tid, int wave, int lane, const int out_col) {
    bf16* Zb = (bf16*)(ws + WS_Z); const bf16* ZT = (const bf16*)(ws + WS_ZT);
    const float* gi = (const float*)(ws + WS_GATE); const float* gf = gi + (size_t)M * 4;
    const float* cw = a.in[I_CONVW] + (size_t)l * 4 * 1024; const float* cb = a.in[I_CONVB] + (size_t)l * 1024;
    const float* gain = a.in[I_MNORM] + (size_t)l * 1024;
    LAS bf16* QS = (LAS bf16*)lds;
    LAS bf16* KS = (LAS bf16*)(lds + 17408);
    LAS bf16* SD = (LAS bf16*)(lds + 34816);
    LAS float* HB = (LAS float*)(lds + 44032);
    LAS float* SC = (LAS float*)(lds + 110592);
    LAS float* CWL = (LAS float*)(lds + 112384);
    const int c8 = tid & 15; int hcur = -1;
    for (int u = cu; u < 16 * NCH; u += G) {
        const int h = u & 3, c = (u >> 2) & 63, bl = u >> 8, bhl = bl * 4 + h; const int tokg = (hf * 4 + bl) * SEQ + c * LCH; const int tokl = bl * SEQ + c * LCH;
        if (h != hcur) { __syncthreads(); stage_convw(CWL, cw, cb, h * 128, 128, 0, 256, tid); hcur = h; __syncthreads(); }
        const int r = lane & 31, hh = lane >> 5, v0 = 32 * wave;
        bf16x8 bV[4], bC[8];
        { const bf16* vrow = ZT + (size_t)(h * 256 + v0 + r) * ZTLD + tokl + 8 * hh;
          const bf16* crow = (const bf16*)(ws + WS_ST) + (size_t)(bhl * NCH + c) * 32768 + (size_t)(v0 + r) * 128 + 8 * hh;
#pragma unroll
          for (int ks = 0; ks < 4; ++ks) bV[ks] = *(const bf16x8*)(vrow + 16 * ks);
#pragma unroll
          for (int ks = 0; ks < 8; ++ks) bC[ks] = *(const bf16x8*)(crow + 16 * ks); }
        u32x4 ogr[4];
#pragma unroll
        for (int i = 0; i < 4; ++i) ogr[i] = *(const u32x4*)(Zb + (size_t)(tokl + (tid >> 3)) * ZLD + ZC_O + h * 256 + 32 * (tid & 7) + 8 * i);
        u32x4 kt[2];
#pragma unroll
        for (int rep = 0; rep < 2; ++rep) { const int t = (tid + rep * NTHR) >> 4; kt[rep] = *(const u32x4*)((const bf16*)(ws + WS_KC) + (size_t)(tokl + t) * 512 + h * 128 + c8 * 8); }
        if (wave == 0) {
            const float lf = gf[(size_t)(tokg + lane) * 4 + h], ii = gi[(size_t)(tokg + lane) * 4 + h];
            const float bc = wave_incl_scan_add(lf, lane); const float rr = ii - bc; const float cm = wave_incl_scan_max(rr, lane);
            const float mst = ((const float*)(ws + WS_CSC))[(size_t)(bhl * NCH + c) * 4 + 2];
            const float Mt = fmaxf(mst, cm);
            SC[lane] = rr; SC[64 + lane] = Mt; SC[128 + lane] = __expf(mst - Mt); SC[192 + lane] = __expf(-(bc + Mt));
        } else if (wave == 1 || wave == 2) { const int d = (wave - 1) * 64 + lane; SC[320 + d] = ((const float*)(ws + WS_NST))[(size_t)(bhl * NCH + c) * 128 + d]; }
#pragma unroll
        for (int rep = 0; rep < 2; ++rep) { const int idx = tid + rep * NTHR, t = idx >> 4; float o[8];
            { u32x4 rawq[4]; conv_load(Zb, bl, c * LCH + t, h * 128 + c8 * 8, rawq); conv_apply(rawq, CWL + c8 * 8, 256, o); }
            u32x4 w; w.x = pk2(o[0], o[1]); w.y = pk2(o[2], o[3]); w.z = pk2(o[4], o[5]); w.w = pk2(o[6], o[7]);
            *(LAS u32x4*)(QS + t * 136 + c8 * 8) = w;
            *(LAS u32x4*)(KS + t * 136 + c8 * 8) = kt[rep]; }
        __syncthreads();
        {
            const int tb = wave >> 1, fr = lane & 15, fq = lane >> 4;
#pragma unroll
            for (int i = 0; i < 2; ++i) { const int sblk = (wave & 1) * 2 + i; f32x4 acc = (f32x4){0.f, 0.f, 0.f, 0.f};
                if (sblk <= tb) {
#pragma unroll
                    for (int ks = 0; ks < 4; ++ks) { const bf16x8 af = *(const LAS bf16x8*)(QS + (16 * tb + fr) * 136 + 32 * ks + 8 * fq), bfv = *(const LAS bf16x8*)(KS + (16 * sblk + fr) * 136 + 32 * ks + 8 * fq);
                        acc = __builtin_amdgcn_mfma_f32_16x16x32_bf16(af, bfv, acc, 0, 0, 0); } }
                const int s = 16 * sblk + fr; const float rs_ = SC[s];
#pragma unroll
                for (int e = 0; e < 4; ++e) { const int t = 16 * tb + 4 * fq + e; const float val = (s <= t) ? acc[e] * __expf(rs_ - SC[64 + t]) : 0.f; SD[t * 72 + s] = (bf16)f2bf(val); } }
        }
        f32x16 aQ0, aQ1, aS0, aS1;
#pragma unroll
        for (int e = 0; e < 16; ++e) { aQ0[e] = 0.f; aQ1[e] = 0.f; aS0[e] = 0.f; aS1[e] = 0.f; }
#pragma unroll
        for (int ks = 0; ks < 8; ++ks) {
            const bf16x8 a0 = *(const LAS bf16x8*)(QS + r * 136 + 16 * ks + 8 * hh), a1 = *(const LAS bf16x8*)(QS + (32 + r) * 136 + 16 * ks + 8 * hh);
            aQ0 = __builtin_amdgcn_mfma_f32_32x32x16_bf16(a0, bC[ks], aQ0, 0, 0, 0); aQ1 = __builtin_amdgcn_mfma_f32_32x32x16_bf16(a1, bC[ks], aQ1, 0, 0, 0); }
        __syncthreads();
        {
            const int t = tid >> 3, p = tid & 7; float ds = 0.f, qn = 0.f;
#pragma unroll
            for (int k = 0; k < 8; ++k) ds += bf1(SD[t * 72 + 8 * p + k]);
#pragma unroll
            for (int k = 0; k < 16; ++k) qn += bf1(QS[t * 136 + 16 * p + k]) * SC[320 + 16 * p + k];
            float den = ds + SC[128 + t] * qn;
            den = grp8_sum(den);
            if (p == 0) SC[256 + t] = 1.f / fmaxf(fabsf(den), SC[192 + t]);
        }
#pragma unroll
        for (int ks = 0; ks < 4; ++ks) {
            const bf16x8 a0 = *(const LAS bf16x8*)(SD + r * 72 + 16 * ks + 8 * hh), a1 = *(const LAS bf16x8*)(SD + (32 + r) * 72 + 16 * ks + 8 * hh);
            aS0 = __builtin_amdgcn_mfma_f32_32x32x16_bf16(a0, bV[ks], aS0, 0, 0, 0); aS1 = __builtin_amdgcn_mfma_f32_32x32x16_bf16(a1, bV[ks], aS1, 0, 0, 0); }
        __syncthreads();
#pragma unroll
        for (int e = 0; e < 16; ++e) { const int t0 = (e & 3) + 8 * (e >> 2) + 4 * hh;
            HB[t0 * 260 + v0 + r] = (aS0[e] + SC[128 + t0] * aQ0[e]) * SC[256 + t0]; HB[(32 + t0) * 260 + v0 + r] = (aS1[e] + SC[128 + 32 + t0] * aQ1[e]) * SC[256 + 32 + t0]; }
        __syncthreads();
        {
            const int t = tid >> 3, p = tid & 7; f32x4 x[8]; float sm = 0.f;
#pragma unroll
            for (int k = 0; k < 8; ++k) { x[k] = *(const LAS f32x4*)(HB + t * 260 + 32 * p + 4 * k); sm += (x[k].x + x[k].y) + (x[k].z + x[k].w); }
            sm = grp8_sum(sm);
            const float mean = sm * (1.f / 256.f); float sq = 0.f;
#pragma unroll
            for (int k = 0; k < 8; ++k) { x[k] = x[k] - mean; sq += (x[k].x * x[k].x + x[k].y * x[k].y) + (x[k].z * x[k].z + x[k].w * x[k].w); }
            sq = grp8_sum(sq);
            const float rstd = rsqrtf(sq * (1.f / 256.f) + EPS);
            const float* gp = gain + h * 256 + 32 * p; bf16* op = Zb + (size_t)(tokl + t) * ZLD + out_col + h * 256 + 32 * p;
#pragma unroll
            for (int i = 0; i < 4; ++i) { const f32x4 g0 = *(const f32x4*)(gp + 8 * i), g1 = *(const f32x4*)(gp + 8 * i + 4); const f32x4 a = x[2 * i] * rstd * g0, b = x[2 * i + 1] * rstd * g1; const u32x4 og = ogr[i]; u32x4 w;
                w.x = pk2(a.x * bflo(og.x), a.y * bfhi(og.x)); w.y = pk2(a.z * bflo(og.y), a.w * bfhi(og.y)); w.z = pk2(b.x * bflo(og.z), b.y * bfhi(og.z)); w.w = pk2(b.z * bflo(og.w), b.w * bfhi(og.w));
                *(u32x4*)(op + 8 * i) = w; }
        }
        __syncthreads();
    }
}

__device__ __forceinline__ void sgu_phase(const Args& a, int l, unsigned char* ws, LAS unsigned char* lds, int G, int cu, int tid, int wave, int lane, const int out_col) {
    bf16* Zb = (bf16*)(ws + WS_Z); const bf16* ZT = (const bf16*)(ws + WS_ZT); const bf16* Wc = (const bf16*)(ws + WS_WSGU);
    const float* lng = a.in[I_SLNG] + (size_t)l * 1024; const float* lnb = a.in[I_SLNB] + (size_t)l * 1024; const float* bs = a.in[I_SBS] + (size_t)l * 4 * 128;
    LAS bf16* VT = (LAS bf16*)lds;
    LAS float* PS = (LAS float*)(lds + 69632);
    LAS float* ST = (LAS float*)(lds + 69632 + 8192);
    LAS bf16* WS_ = (LAS bf16*)(lds + 78848);
    const int c8 = tid & 15, dq = tid >> 4;
    int gcur = -1;
    u32x4 x[8];
    if (cu < 4 * 32 * 4) { const int g = cu & 3, cc = (cu >> 2) & 31, bl = cu >> 7;
#pragma unroll
        for (int rep = 0; rep < 8; ++rep) x[rep] = *(const u32x4*)(ZT + (size_t)(1024 + g * 256 + dq + 32 * rep) * ZTLD + bl * SEQ + cc * 128 + c8 * 8); }
    for (int u = cu; u < 4 * 32 * 4; u += G) {
        const int g = u & 3, cc = (u >> 2) & 31, bl = u >> 7; const int tokl = bl * SEQ + cc * 128;
        if (g != gcur) { __syncthreads();
#pragma unroll
            for (int rep = 0; rep < 4; ++rep) { const int idx = tid + rep * NTHR, t = idx >> 4; *(LAS u32x4*)(WS_ + t * 136 + c8 * 8) = *(const u32x4*)(Wc + (size_t)(g * 128 + t) * 128 + c8 * 8); }
            gcur = g; }
        {
            float sm[8], sq[8];
#pragma unroll
            for (int k = 0; k < 8; ++k) { sm[k] = 0.f; sq[k] = 0.f; }
#pragma unroll
            for (int rep = 0; rep < 8; ++rep) { const u32x4 v = x[rep]; const float f0 = bflo(v.x), f1 = bfhi(v.x), f2 = bflo(v.y), f3 = bfhi(v.y), f4 = bflo(v.z), f5 = bfhi(v.z), f6 = bflo(v.w), f7 = bfhi(v.w);
                sm[0] += f0; sq[0] += f0 * f0; sm[1] += f1; sq[1] += f1 * f1; sm[2] += f2; sq[2] += f2 * f2; sm[3] += f3; sq[3] += f3 * f3;
                sm[4] += f4; sq[4] += f4 * f4; sm[5] += f5; sq[5] += f5 * f5; sm[6] += f6; sq[6] += f6 * f6; sm[7] += f7; sq[7] += f7 * f7; }
#pragma unroll
            for (int k = 0; k < 8; ++k) { sm[k] += shx(sm[k], 16, lane); sq[k] += shx(sq[k], 16, lane); sm[k] += shx(sm[k], 32, lane); sq[k] += shx(sq[k], 32, lane); }
            if (lane < 16) {
#pragma unroll
                for (int k = 0; k < 8; ++k) { PS[(wave * 128 + c8 * 8 + k) * 2] = sm[k]; PS[(wave * 128 + c8 * 8 + k) * 2 + 1] = sq[k]; } }
        }
        __syncthreads();
        if (tid < 128) { float sm = 0.f, sq = 0.f;
#pragma unroll
            for (int p = 0; p < 8; ++p) { sm += PS[(p * 128 + tid) * 2]; sq += PS[(p * 128 + tid) * 2 + 1]; }
            const float mean = sm * (1.f / 256.f); const float var = fmaxf(sq * (1.f / 256.f) - mean * mean, 0.f); ST[tid] = mean; ST[128 + tid] = rsqrtf(var + EPS); }
        __syncthreads();
        { const LAS float* mp = ST + c8 * 8; const LAS float* rp = ST + 128 + c8 * 8; float mm[8], rr[8];
#pragma unroll
            for (int k = 0; k < 8; ++k) { mm[k] = mp[k]; rr[k] = rp[k]; }
#pragma unroll
            for (int rep = 0; rep < 8; ++rep) { const int d = dq + 32 * rep; const float gg = lng[g * 256 + d], bb = lnb[g * 256 + d]; u32x4 v = x[rep];
                v.x = pk2((bflo(v.x) - mm[0]) * rr[0] * gg + bb, (bfhi(v.x) - mm[1]) * rr[1] * gg + bb); v.y = pk2((bflo(v.y) - mm[2]) * rr[2] * gg + bb, (bfhi(v.y) - mm[3]) * rr[3] * gg + bb);
                v.z = pk2((bflo(v.z) - mm[4]) * rr[4] * gg + bb, (bfhi(v.z) - mm[5]) * rr[5] * gg + bb); v.w = pk2((bflo(v.w) - mm[6]) * rr[6] * gg + bb, (bfhi(v.w) - mm[7]) * rr[7] * gg + bb);
                *(LAS u32x4*)(VT + d * 136 + c8 * 8) = v; } }
        if (u + G < 4 * 32 * 4) { const int un = u + G, gn = un & 3, ccn = (un >> 2) & 31, bln = un >> 7;
#pragma unroll
            for (int rep = 0; rep < 8; ++rep) x[rep] = *(const u32x4*)(ZT + (size_t)(1024 + gn * 256 + dq + 32 * rep) * ZTLD + bln * SEQ + ccn * 128 + c8 * 8); }
        __syncthreads();
        {
            const int r = lane & 31, hh = lane >> 5, d0 = 32 * wave;
            u32x2 uu[4][4];
#pragma unroll
            for (int tb = 0; tb < 4; ++tb)
#pragma unroll
                for (int q = 0; q < 4; ++q) uu[tb][q] = *(const u32x2*)(Zb + (size_t)(tokl + 32 * tb + r) * ZLD + ZC_U + g * 256 + d0 + 4 * hh + 8 * q);
            f32x16 acc[4];
#pragma unroll
            for (int tb = 0; tb < 4; ++tb)
#pragma unroll
                for (int e = 0; e < 16; ++e) acc[tb][e] = 0.f;
#pragma unroll
            for (int ks = 0; ks < 8; ++ks) { const bf16x8 af = *(const LAS bf16x8*)(VT + (d0 + r) * 136 + 16 * ks + 8 * hh);
#pragma unroll
                for (int tb = 0; tb < 4; ++tb) if (16 * ks <= 32 * tb + 31) { const bf16x8 bfv = *(const LAS bf16x8*)(WS_ + (32 * tb + r) * 136 + 16 * ks + 8 * hh);
                    acc[tb] = __builtin_amdgcn_mfma_f32_32x32x16_bf16(af, bfv, acc[tb], 0, 0, 0); } }
#pragma unroll
            for (int tb = 0; tb < 4; ++tb) { const int t = 32 * tb + r; const float bias = bs[g * 128 + t]; bf16* rowp = Zb + (size_t)(tokl + t) * ZLD + out_col + g * 256 + d0 + 4 * hh;
#pragma unroll
                for (int q = 0; q < 4; ++q) { const u32x2 v = uu[tb][q]; u32x2 w;
                    w.x = pk2(bflo(v.x) * (acc[tb][4 * q] + bias), bfhi(v.x) * (acc[tb][4 * q + 1] + bias)); w.y = pk2(bflo(v.y) * (acc[tb][4 * q + 2] + bias), bfhi(v.y) * (acc[tb][4 * q + 3] + bias)); *(u32x2*)(rowp + 8 * q) = w; } }
        }
        __syncthreads();
    }
}

__device__ __forceinline__ void softmax_rows(unsigned char* ws, int gw, int NGW, int lane) {
    bf16* Zb = (bf16*)(ws + WS_Z);
    for (int m = gw; m < MH; m += NGW) {
        u32x4* p = (u32x4*)(Zb + (size_t)m * ZLD + ZC_XQ + 16 * lane); const u32x4 x0 = p[0], x1 = p[1];
        float v[16] = { bflo(x0.x), bfhi(x0.x), bflo(x0.y), bfhi(x0.y), bflo(x0.z), bfhi(x0.z), bflo(x0.w), bfhi(x0.w), bflo(x1.x), bfhi(x1.x), bflo(x1.y), bfhi(x1.y), bflo(x1.z), bfhi(x1.z), bflo(x1.w), bfhi(x1.w) };
        float mx = v[0];
#pragma unroll
        for (int e = 1; e < 16; ++e) mx = fmaxf(mx, v[e]);
#pragma unroll
        for (int o = 1; o < 16; o <<= 1) mx = fmaxf(mx, shx(mx, o, lane));
        float s = 0.f;
#pragma unroll
        for (int e = 0; e < 16; ++e) { v[e] = __expf(v[e] - mx); s += v[e]; }
#pragma unroll
        for (int o = 1; o < 16; o <<= 1) s += shx(s, o, lane);
        const float inv = 1.f / s;
        u32x4 y0, y1; y0.x = pk2(v[0] * inv, v[1] * inv); y0.y = pk2(v[2] * inv, v[3] * inv); y0.z = pk2(v[4] * inv, v[5] * inv); y0.w = pk2(v[6] * inv, v[7] * inv);
        y1.x = pk2(v[8] * inv, v[9] * inv); y1.y = pk2(v[10] * inv, v[11] * inv); y1.z = pk2(v[12] * inv, v[13] * inv); y1.w = pk2(v[14] * inv, v[15] * inv);
        p[0] = y0; p[1] = y1;
    }
}

__global__ void __launch_bounds__(NTHR, 2) trunk_fwd(Args args) {
    extern __shared__ __attribute__((aligned(16))) unsigned char lds_raw[];
    LAS unsigned char* lds = (LAS unsigned char*)lds_raw;
    volatile LAS unsigned* MISC = (volatile LAS unsigned*)(lds + MISC_OFF);
    const int G = gridDim.x, cu = blockIdx.x;
    unsigned char* ws = args.ws;
#define PHASE_IDS() int tid = threadIdx.x; asm volatile("" : "+v"(tid)); const int lane = tid & 63, wave = __builtin_amdgcn_readfirstlane(tid >> 6); \
    const int vcu = (G % 8 == 0) ? (cu % 8) * (G / 8) + cu / 8 : cu; const int gw = vcu * NWAVES + wave, NGW = G * NWAVES, gtid = cu * NTHR + tid, GT = G * NTHR; (void)gw; (void)NGW; (void)gtid; (void)GT; (void)lane
    for (int u = threadIdx.x; u < (LDS_BYTES - RING_BYTES) / 4; u += NTHR) ((LAS unsigned*)(lds + RING_BYTES))[u] = 0u;
    __syncthreads();
    XcdBarrier bar = xcd_barrier_post((unsigned*)(ws + WS_CTL) + 4096, MISC + 8);
    const int lo = args.ph_lo, hi = args.ph_hi;
    int ph = 0;
#define IN() (lo <= ph && ph < hi)
#define SEAM() do { if (lo <= ph && ph + 1 < hi) xcd_barrier(bar); ++ph; } while (0)
    bf16* XN = (bf16*)(ws + WS_XN); bf16* Wb = (bf16*)(ws + WS_W); float* RSTD = (float*)(ws + WS_RSTD);
    float* hbuf = args.out;

    if (IN()) { PHASE_IDS();
        convert_layer(args, 0, ws, lds, gw, NGW, wave, lane, gtid, GT);
        thin_rows(nullptr, 0, nullptr, 0.f, args.in[I_X], nullptr, XN, RSTD, nullptr, 0, M, gw, NGW, lane, false, nullptr, nullptr, nullptr, nullptr, nullptr);
        __syncthreads();
    }
    SEAM();

    for (int sb = 0; sb < 2 * DEPTH; ++sb) {
        const int l = sb >> 1, j = sb & 1;
        const float* ng = args.in[I_NORMG] + (size_t)l * NNORM * D;
        if (IN()) { PHASE_IDS();
            pg8::Gemm g{D, D, D}; pg8::TileSched S; S.init(M / 256, 2 * DFF / 256, G, cu, XN, D * 2, (char*)Wb + (j ? WO_GU1 : WO_GU0), D * 2);
            pg8::EpiGU E{(bf16*)(ws + WS_HID), RSTD};
            pg8::gemm_phase(lds, g, S, E, tid);
        }
        SEAM();
        if (IN()) { PHASE_IDS();
            pg8::Gemm g{DFF, DFF, DFF}; pg8::TileSched S; S.init(M / 256, D / 256, G, cu, ws + WS_HID, DFF * 2, (char*)Wb + (j ? WO_D1 : WO_D0), DFF * 2);
            pg8::EpiAct E{(bf16*)(ws + WS_F), (size_t)D, 0, nullptr, nullptr};
            pg8::gemm_phase(lds, g, S, E, tid);
        }
        SEAM();
        if (IN()) { PHASE_IDS();
            const float* hin = (sb == 0) ? args.in[I_X] : hbuf;
            if (j == 0) {
                LAS float* wif = (LAS float*)lds;
                for (int e = tid; e < D * 8 / 4; e += NTHR) ((LAS f32x4*)wif)[e] = ((const f32x4*)(ws + WS_WIF))[e];
                __syncthreads();
                float* gi = (float*)(ws + WS_GATE);
                const float* hx = (sb == 0) ? args.in[I_X] : nullptr;
                if (G == 256) {
                    const bool kvcu = (cu < 32) || (cu >= 128 && cu < 160);
                    if (kvcu) { const int gwk = ((cu < 32) ? cu : cu - 96) * NWAVES + wave;
                        thin_rows((const bf16*)(ws + WS_F), D, ng + 1 * D, 0.5f, hx, XN, XN, RSTD, nullptr, 0, 3072, gwk, 512, lane, true, wif, args.in[I_BI] + l * 4, args.in[I_BF] + l * 4, gi, gi + (size_t)M * 4); }
                    else { const int cun = (cu < 128) ? cu - 32 : cu - 64; const int gwn = cun * NWAVES + wave;
                        thin_rows((const bf16*)(ws + WS_F) + (size_t)3072 * D, D, ng + 1 * D, 0.5f, hx, XN, XN, RSTD, nullptr, 3072, M, gwn, 1536, lane, true, wif, args.in[I_BI] + l * 4, args.in[I_BF] + l * 4, gi, gi + (size_t)M * 4); }
                } else
                thin_rows((const bf16*)(ws + WS_F), D, ng + 1 * D, 0.5f, hx, XN, XN, RSTD, nullptr, 0, M, gw, NGW, lane, true, wif, args.in[I_BI] + l * 4, args.in[I_BF] + l * 4, gi, gi + (size_t)M * 4);
                __syncthreads();
                {
                    pg8::Gemm g{D, D, D};
                    pg8::TileSched S; S.init(MMEM / 256, D / 256, G, cu, ws + WS_MEMN, D * 2, (char*)Wb + WO_MKV, D * 2);
                    pg8::EpiAct E{(bf16*)(ws + WS_KMEM), (size_t)D, 0, nullptr, nullptr};
                    pg8::gemm_phase(lds, g, S, E, tid);
                    pg8::TileSched S2; S2.init(D / 256, MMEM / 256, G, (cu + G / 2) % G, (char*)Wb + WO_MKV + (size_t)D * D * 2, D * 2, ws + WS_MEMN, D * 2);
                    pg8::EpiAct E2{(bf16*)(ws + WS_VTMEM), (size_t)MMEM, 0, nullptr, nullptr};
                    pg8::gemm_phase(lds, g, S2, E2, tid);
                }
            } else {
                const bool lastl = (l + 1 == DEPTH);
                thin_rows((const bf16*)(ws + WS_F), D, ng + 5 * D, 0.5f, nullptr, XN, lastl ? nullptr : XN, RSTD, lastl ? hbuf : nullptr, 0, M, gw, NGW, lane, false, nullptr, nullptr, nullptr, nullptr, nullptr);
                if (l + 1 < DEPTH) { __syncthreads(); convert_layer(args, l + 1, ws, lds, gw, NGW, wave, lane, gtid, GT); __syncthreads(); }
            }
        }
        SEAM();
        if (j == 0) {
            for (int hf = 0; hf < 2; ++hf) {
                bf16* Zb = (bf16*)(ws + WS_Z);
                if (IN()) { PHASE_IDS();
                    pg8::Gemm g{D, D, D};
                    pg8::TileSched S; S.init(MH / 256, ZLD / 256, G, cu, XN + (size_t)hf * MH * D, D * 2, (char*)Wb + WO_IN, D * 2);
                    pg8::EpiAct E{Zb, (size_t)ZLD, 1, RSTD + (size_t)hf * MH, nullptr};
                    pg8::gemm_phase(lds, g, S, E, tid);
                    pg8::TileSched S2; S2.init(2048 / 256, MH / 256, G, cu, (char*)Wb + WO_IN + (size_t)ZLD * D * 2, D * 2, XN + (size_t)hf * MH * D, D * 2);
                    pg8::EpiAct E2{(bf16*)(ws + WS_ZT), (size_t)ZTLD, 2, nullptr, RSTD + (size_t)hf * MH};
                    pg8::gemm_phase(lds, g, S2, E2, tid);
                }
                SEAM();
                if (IN()) { PHASE_IDS();
                    mlstm_s1(args, l, hf, ws, lds, G, cu, tid, wave, lane);
                    sgu_phase(args, l, ws, lds, G, cu, tid, wave, lane, ZC_U);
                    pg8::Gemm g{256, ZLD, D};
                    pg8::TileSched S; S.init(MH / 256, 4, G, cu, Zb + ZC_XQ, ZLD * 2, (bf16*)(ws + WS_KMEM) + (size_t)hf * 4 * MEMLEN * D, 0);
                    S.a_pn = 512; S.b_tile = 512; S.pm_per_b = 16; S.b_batch = (size_t)MEMLEN * D * 2;
                    pg8::EpiAct E{Zb + ZC_XQ, (size_t)ZLD, 0, nullptr, nullptr};
                    pg8::gemm_phase(lds, g, S, E, tid);
                    for (int i = 0; ; ++i) { pg8::Unit uu; if (!S.next(i, uu)) break;
                        bf16* tb_ = Zb + (size_t)(uu.pm * 256 + wave * 32 + (lane >> 4)) * ZLD + ZC_XQ + uu.pn * 256 + 16 * (lane & 15);
                        for (int r0 = 0; r0 < 32; r0 += 16) {
                            unsigned long long w[4][4];
#pragma unroll
                            for (int q = 0; q < 4; ++q) { unsigned long long* p = (unsigned long long*)(tb_ + (size_t)(r0 + 4 * q) * ZLD);
#pragma unroll
                                for (int e = 0; e < 4; ++e) w[q][e] = __hip_atomic_load(p + e, __ATOMIC_RELAXED, __HIP_MEMORY_SCOPE_AGENT); }
#pragma unroll
                            for (int q = 0; q < 4; ++q) { float v[16];
#pragma unroll
                                for (int e = 0; e < 4; ++e) { const unsigned lo_ = (unsigned)w[q][e], hi_ = (unsigned)(w[q][e] >> 32); v[4 * e] = bflo(lo_); v[4 * e + 1] = bfhi(lo_); v[4 * e + 2] = bflo(hi_); v[4 * e + 3] = bfhi(hi_); }
                                float mx = v[0];
#pragma unroll
                                for (int e = 1; e < 16; ++e) mx = fmaxf(mx, v[e]);
                                mx = row16_max(mx);
                                float sm = 0.f;
#pragma unroll
                                for (int e = 0; e < 16; ++e) { v[e] = __expf(v[e] - mx); sm += v[e]; }
                                sm = row16_sum(sm);
                                const float inv = __builtin_amdgcn_rcpf(sm);
                                u32x4* po = (u32x4*)(tb_ + (size_t)(r0 + 4 * q) * ZLD); u32x4 y0, y1;
                                y0.x = pk2(v[0] * inv, v[1] * inv); y0.y = pk2(v[2] * inv, v[3] * inv); y0.z = pk2(v[4] * inv, v[5] * inv); y0.w = pk2(v[6] * inv, v[7] * inv);
                                y1.x = pk2(v[8] * inv, v[9] * inv); y1.y = pk2(v[10] * inv, v[11] * inv); y1.z = pk2(v[12] * inv, v[13] * inv); y1.w = pk2(v[14] * inv, v[15] * inv);
                                po[0] = y0; po[1] = y1; } } }
                }
                SEAM();
                if (IN()) { PHASE_IDS();
                    mlstm_s2(ws, G, cu, tid);
                }
                SEAM();
                if (IN()) { PHASE_IDS();
                    mlstm_s3(args, l, hf, ws, lds, G, cu, tid, wave, lane, ZC_O);
#ifdef PROBE_S3
                    for (int rep_ = 0; rep_ < 2; ++rep_) mlstm_s3(args, l, hf, ws, lds, G, cu, tid, wave, lane, ZC_QK);
#endif
#ifdef PROBE_SGU
                    for (int rep_ = 0; rep_ < 2; ++rep_) sgu_phase(args, l, ws, lds, G, cu, tid, wave, lane, ZC_QK);
#endif
                    pg8::Gemm g{256, ZLD, MMEM};
                    pg8::TileSched S; S.init(MH / 256, 4, G, cu, Zb + ZC_XQ, ZLD * 2, (bf16*)(ws + WS_VTMEM) + (size_t)hf * 4 * MEMLEN, 0);
                    S.a_pn = 512; S.b_tile = (size_t)256 * MMEM * 2; S.pm_per_b = 16; S.b_batch = (size_t)MEMLEN * 2;
                    pg8::EpiAct E{Zb + ZC_XQ, (size_t)ZLD, 0, nullptr, nullptr};
                    pg8::gemm_phase(lds, g, S, E, tid);
                }
                SEAM();
                if (IN()) { PHASE_IDS();
                    pg8::Gemm g{D, ZLD, D};
                    pg8::TileSched S; S.init(MH / 256, D / 256, G, cu, Zb + ZC_O, ZLD * 2, (char*)Wb + WO_BR, D * 2);
                    S.reps = 3; S.a_rep = 1024 * 2; S.b_rep = (size_t)D * D * 2;
                    pg8::EpiBranch E{Zb};
                    pg8::gemm_phase(lds, g, S, E, tid);
                }
                SEAM();
                if (IN()) { PHASE_IDS();
                    pg8::Gemm g{D, ZLD, D};
                    pg8::TileSched S; S.init(MH / 256, D / 256, G, cu, Zb + ZC_QK, ZLD * 2, (char*)Wb + WO_OUT, D * 2);
                    pg8::EpiAct E{Zb + ZC_O, (size_t)ZLD, 0, nullptr, nullptr};
                    pg8::gemm_phase(lds, g, S, E, tid);
                }
                SEAM();
                if (IN()) { PHASE_IDS();
                    thin_rows(Zb + ZC_O, ZLD, ng + 3 * D, 1.0f, nullptr, XN, XN, RSTD, nullptr, hf * MH, (hf + 1) * MH, gw, NGW, lane, false, nullptr, nullptr, nullptr, nullptr, nullptr);
                }
                SEAM();
            }
        }
    }
#undef IN
#undef SEAM
}
constexpr int N_PHASES = 1 + 2 * DEPTH * 3 + DEPTH * 2 * 7;

#ifndef N_LAUNCH_MODE
#define N_LAUNCH_MODE 0
#endif
extern "C" void kernel_launch(void* const* d_in, const int* in_sizes, int n_in, void* d_out, int out_size, void* d_ws, size_t ws_size, hipStream_t stream) {
    static int grid = 0;
    if (grid == 0) {
        if (n_in != 18 || out_size != M * D || ws_size < WS_END) { fprintf(stderr, "kernel_launch: unexpected shapes (n_in %d out %d ws %zu)\n", n_in, out_size, ws_size); grid = -1; return; }
        int dev = 0, cus = 0, per_cu = 0;
        if (hipGetDevice(&dev) != hipSuccess || hipDeviceGetAttribute(&cus, hipDeviceAttributeMultiprocessorCount, dev) != hipSuccess) { grid = -1; return; }
        if (hipFuncSetAttribute((const void*)trunk_fwd, hipFuncAttributeMaxDynamicSharedMemorySize, LDS_BYTES) != hipSuccess) { grid = -1; return; }
        if (hipOccupancyMaxActiveBlocksPerMultiprocessor(&per_cu, (const void*)trunk_fwd, NTHR, LDS_BYTES) != hipSuccess || per_cu < 1) { fprintf(stderr, "kernel_launch: occupancy query says %d\n", per_cu); }
        (void)hipGetLastError();
        grid = cus;
    }
    if (grid < 0) return;
    (void)hipMemsetAsync((char*)d_ws + WS_CTL, 0, CTL_ZERO_BYTES, stream);
    Args a{};
    for (int i = 0; i < 18; ++i) a.in[i] = (const float*)d_in[i];
    a.out = (float*)d_out; a.ws = (unsigned char*)d_ws;
#if N_LAUNCH_MODE == 0
    a.ph_lo = 0; a.ph_hi = N_PHASES;
    hipLaunchKernelGGL(trunk_fwd, dim3(grid), dim3(NTHR), LDS_BYTES, stream, a);
#else
    for (int p = 0; p < N_PHASES; ++p) { a.ph_lo = p; a.ph_hi = p + 1; hipLaunchKernelGGL(trunk_fwd, dim3(grid), dim3(NTHR), LDS_BYTES, stream, a); }
#endif
}
```

```cpp
#include <hip/hip_runtime.h>
#include <cstdio>
#include <cstdint>

#define LAS __attribute__((address_space(3)))
#define GAS __attribute__((address_space(1)))
typedef unsigned short bf16;
typedef short bf16x8 __attribute__((ext_vector_type(8)));
typedef float f32x4 __attribute__((ext_vector_type(4)));
typedef float f32x16 __attribute__((ext_vector_type(16)));
typedef unsigned u32x4 __attribute__((ext_vector_type(4)));
typedef unsigned u32x2 __attribute__((ext_vector_type(2)));

constexpr int D = 1024, BATCH = 8, SEQ = 4096, DEPTH = 2, MEMLEN = 256, DFF = 2816, NNORM = 7;
constexpr int M = BATCH * SEQ, MH = M / 2, MMEM = BATCH * MEMLEN;
constexpr int WIN_COLS = 9224;
constexpr int LCH = 64, NCH = SEQ / LCH;
constexpr int ZLD = 7168;
constexpr int ZC_QK = 0, ZC_O = 1024, ZC_U = 2048, ZC_XQ = 3072, ZC_G = 4096;
constexpr int ZTLD = MH;
constexpr float EPS = 1e-6f;
constexpr int NWAVES = 8, NTHR = 512;

constexpr size_t MiB = 1u << 20;
constexpr size_t WS_CTL = 0, CTL_ZERO_BYTES = 1 * MiB;
constexpr size_t WS_WSGU = 1 * MiB;
constexpr size_t WS_GATE = 2 * MiB;
constexpr size_t WS_NST = 3 * MiB;
constexpr size_t WS_CSC = 4 * MiB;
constexpr size_t WS_MEMN = 5 * MiB;
constexpr size_t WS_KMEM = 9 * MiB;
constexpr size_t WS_VTMEM = 13 * MiB;
constexpr size_t WS_W = 17 * MiB;
constexpr size_t WO_GU0 = 0, WO_GU1 = 11 * MiB, WO_D0 = 22 * MiB, WO_D1 = WO_D0 + 5632 * 1024, WO_IN = 33 * MiB, WO_MKV = 51 * MiB, WO_BR = 55 * MiB, WO_OUT = 61 * MiB;
constexpr size_t WS_XN = 80 * MiB;
constexpr size_t WS_WIF = 4 * MiB + 256 * 1024;
constexpr size_t WS_RSTD = 4 * MiB + 512 * 1024;
constexpr size_t WS_BIG = 144 * MiB;
constexpr size_t WS_HID = WS_BIG, WS_F = WS_BIG + 176 * MiB, WS_Z = WS_BIG, WS_ZT = WS_BIG + 224 * MiB;
constexpr size_t WS_ST = 432 * MiB;
constexpr size_t WS_KC = 496 * MiB;
constexpr size_t WS_END = 512 * MiB;

constexpr int LDS_BYTES = 147456;
constexpr int RING_BYTES = 131072;
constexpr int MISC_OFF = RING_BYTES + 320;

typedef float f32x2_t __attribute__((ext_vector_type(2))); typedef __bf16 bf16x2_t __attribute__((ext_vector_type(2)));
__device__ __forceinline__ unsigned pk2(float lo, float hi) { f32x2_t v = {lo, hi}; bf16x2_t b = __builtin_convertvector(v, bf16x2_t); return __builtin_bit_cast(unsigned, b); }
__device__ __forceinline__ unsigned f2bf(float f) { return pk2(f, 0.f) & 0xffffu; }
__device__ __forceinline__ float bflo(unsigned w) { return __uint_as_float(w << 16); }
__device__ __forceinline__ float bfhi(unsigned w) { return __uint_as_float(w & 0xffff0000u); }
__device__ __forceinline__ float bf1(bf16 b) { return __uint_as_float((unsigned)b << 16); }
__device__ __forceinline__ float shx(float v, int mask, int lane) { return __builtin_bit_cast(float, __builtin_amdgcn_ds_bpermute((lane ^ mask) << 2, __builtin_bit_cast(int, v))); }
__device__ __forceinline__ float shidx(float v, int src) { return __builtin_bit_cast(float, __builtin_amdgcn_ds_bpermute(src << 2, __builtin_bit_cast(int, v))); }
#define DPP_XOR1 0xB1
#define DPP_XOR2 0x4E
#define DPP_HMIR 0x141
#define DPP_MIR  0x140
template <int CTRL> __device__ __forceinline__ float dppf(float v) { return __builtin_bit_cast(float, __builtin_amdgcn_mov_dpp(__builtin_bit_cast(int, v), CTRL, 0xF, 0xF, true)); }
__device__ __forceinline__ float row16_sum(float v) { v += dppf<DPP_XOR1>(v); v += dppf<DPP_XOR2>(v); v += dppf<DPP_HMIR>(v); v += dppf<DPP_MIR>(v); return v; }
__device__ __forceinline__ float row16_max(float v) { v = fmaxf(v, dppf<DPP_XOR1>(v)); v = fmaxf(v, dppf<DPP_XOR2>(v)); v = fmaxf(v, dppf<DPP_HMIR>(v)); v = fmaxf(v, dppf<DPP_MIR>(v)); return v; }
__device__ __forceinline__ float grp8_sum(float v) { v += dppf<DPP_XOR1>(v); v += dppf<DPP_XOR2>(v); v += dppf<DPP_HMIR>(v); return v; }
__device__ __forceinline__ float wave_sum(float v, int lane) { v = row16_sum(v); v += shx(v, 16, lane); v += shx(v, 32, lane); return v; }
__device__ __forceinline__ float sigmoidf_(float x) { return __builtin_amdgcn_rcpf(1.f + __expf(-x)); }
__device__ __forceinline__ float siluf_(float x) { return x * __builtin_amdgcn_rcpf(1.f + __expf(-x)); }
__device__ __forceinline__ float gelu_tanh(float x) { const float u = 1.5957691216f * (x + 0.044715f * x * x * x); return x * __builtin_amdgcn_rcpf(1.f + __expf(-u)); }
__device__ __forceinline__ float logsigmoidf_(float x) { return fminf(x, 0.f) - __logf(1.f + __expf(-fabsf(x))); }
#define LDS_WAIT() asm volatile("s_waitcnt lgkmcnt(0)" ::: "memory")
#define VM_WAIT() asm volatile("s_waitcnt vmcnt(0)" ::: "memory")

namespace pg8 {
constexpr int BM = 256, BK = 64, HALF = 128, HTB = HALF * BK * 2, STAGE_BYTES = 8 * HTB, NXCD = 8, WGM = 8;
__host__ __device__ __forceinline__ int lds_byte(int r, int c) { const int st = (r >> 4) * 2 + (c >> 5), rr = r & 15, cc = c & 31, ob = rr * 64 + cc * 2; return st * 1024 + (ob ^ (((ob >> 9) & 1) << 5)); }
__host__ __device__ __forceinline__ void stage_rc(int b, int& R, int& C) { const int st = b / 1024, sb = b % 1024, swz = sb ^ (((sb >> 9) & 1) << 5); R = (st >> 1) * 16 + swz / 64; C = (st & 1) * 32 + (swz % 64) / 2; }
__host__ __device__ __forceinline__ int perm32(int rho) { const int n = rho >> 4, i = rho & 15; return 8 * (i >> 2) + 4 * n + (i & 3); }

struct Unit { int pm, pn, aux; const char* a; const char* b; };
struct Gemm { int K, lda, ldb; };

struct TileSched {
    int nM, nN, nwg, G, c, reps, pm_per_b;
    const char* A; const char* B;
    size_t a_tile, a_pn, a_rep, b_tile, b_batch, b_rep;
    __device__ __forceinline__ void init(int nM_, int nN_, int G_, int c_, const void* A_, size_t lda_bytes, const void* B_, size_t ldb_bytes) {
        nM = nM_; nN = nN_; nwg = nM * nN; G = G_; c = c_; reps = 1; pm_per_b = 1 << 30; A = (const char*)A_; B = (const char*)B_;
        a_tile = 256 * lda_bytes; a_pn = 0; a_rep = 0; b_tile = 256 * ldb_bytes; b_batch = 0; b_rep = 0;
    }
    __device__ __forceinline__ bool next(int i, Unit& u) const {
        const int ti = i / reps, aux = i - ti * reps;
        const long L = (long)ti * G + c; if (L >= nwg) return false;
        int wgid = (int)L; { const int q = nwg / NXCD, r = nwg % NXCD, xcd = wgid % NXCD, off = wgid / NXCD; wgid = (xcd < r ? xcd * (q + 1) : r * (q + 1) + (xcd - r) * q) + off; }
        const int nig = WGM * nN, gid = wgid / nig, fm = gid * WGM, gsz = (nM - fm) < WGM ? (nM - fm) : WGM;
        u.pm = fm + ((wgid % nig) % gsz); u.pn = (wgid % nig) / gsz; u.aux = aux;
        u.a = A + (size_t)u.pm * a_tile + (size_t)u.pn * a_pn + (size_t)aux * a_rep;
        u.b = B + (size_t)u.pn * b_tile + (size_t)(u.pm / pm_per_b) * b_batch + (size_t)aux * b_rep;
        return true;
    }
};

__device__ __forceinline__ unsigned cvt_pk_bf16(float lo, float hi) { return pk2(lo, hi); }

template <int ACT> __device__ __forceinline__ float actf(float x) {
    if (ACT == 1) return sigmoidf_(x);
    if (ACT == 2) return gelu_tanh(x);
    if (ACT == 3) return x * 0.0625f;
    return x;
}
template <int ACT> __device__ __forceinline__ void store_tile_bf16(const f32x4 (&acc)[2][2][4][2], bf16* O, size_t ldc, int row0, int col0, const float* rsrow, const float* rscol) {
    f32x4 cs[2][2];
#pragma unroll
    for (int bj = 0; bj < 2; ++bj)
#pragma unroll
        for (int n = 0; n < 2; ++n) cs[bj][n] = rscol ? *(const f32x4*)(rscol + col0 + bj * HALF + 4 * n) : (f32x4){1.f, 1.f, 1.f, 1.f};
#pragma unroll
    for (int ai = 0; ai < 2; ++ai)
#pragma unroll
        for (int m = 0; m < 4; ++m) { const int row = row0 + ai * HALF + m * 16; bf16* rowp = O + (size_t)row * ldc + col0; const float rr = rsrow ? rsrow[row] : 1.f;
#pragma unroll
            for (int bj = 0; bj < 2; ++bj) { const f32x4 v0 = acc[ai][bj][m][0] * cs[bj][0] * rr, v1 = acc[ai][bj][m][1] * cs[bj][1] * rr; u32x4 w;
                w.x = cvt_pk_bf16(actf<ACT>(v0[0]), actf<ACT>(v0[1])); w.y = cvt_pk_bf16(actf<ACT>(v0[2]), actf<ACT>(v0[3]));
                w.z = cvt_pk_bf16(actf<ACT>(v1[0]), actf<ACT>(v1[1])); w.w = cvt_pk_bf16(actf<ACT>(v1[2]), actf<ACT>(v1[3]));
                *(u32x4*)(rowp + bj * HALF) = w; } }
}
struct EpiAct {
    static constexpr bool PERM = true;
    bf16* O; size_t ldc; int mode; const float* rsrow; const float* rscol;
    __device__ __forceinline__ void operator()(const f32x4 (&acc)[2][2][4][2], const Unit& u, int wr, int wc, int fr, int fq) const {
        const int row0 = u.pm * BM + wr * 64 + fr, col0 = u.pn * BM + wc * 32 + 8 * fq;
        int act = 0;
        if (mode == 1) { const int g = u.pn >> 2; act = (g == 0) ? 0 : (g == 1) ? 1 : (g == 2) ? 2 : (g == 3) ? 3 : 1; }
        else if (mode == 2) act = (u.pm >= 4) ? 2 : 0;
        if (act == 0) store_tile_bf16<0>(acc, O, ldc, row0, col0, rsrow, rscol);
        else if (act == 1) store_tile_bf16<1>(acc, O, ldc, row0, col0, rsrow, rscol);
        else if (act == 2) store_tile_bf16<2>(acc, O, ldc, row0, col0, rsrow, rscol);
        else store_tile_bf16<3>(acc, O, ldc, row0, col0, rsrow, rscol);
    }
};
struct EpiGU {
    static constexpr bool PERM = true;
    bf16* O; const float* rsrow;
    __device__ __forceinline__ void operator()(const f32x4 (&acc)[2][2][4][2], const Unit& u, int wr, int wc, int fr, int fq) const {
        const int row0 = u.pm * BM + wr * 64 + fr, col0 = u.pn * HALF + wc * 32 + 8 * fq;
#pragma unroll
        for (int ai = 0; ai < 2; ++ai)
#pragma unroll
            for (int m = 0; m < 4; ++m) { const int row = row0 + ai * HALF + m * 16; bf16* rowp = O + (size_t)row * DFF + col0; const float rr = rsrow[row];
                const f32x4 g0 = acc[ai][0][m][0] * rr, g1 = acc[ai][0][m][1] * rr, u0 = acc[ai][1][m][0] * rr, u1 = acc[ai][1][m][1] * rr; u32x4 w;
                w.x = cvt_pk_bf16(siluf_(g0[0]) * u0[0], siluf_(g0[1]) * u0[1]); w.y = cvt_pk_bf16(siluf_(g0[2]) * u0[2], siluf_(g0[3]) * u0[3]);
                w.z = cvt_pk_bf16(siluf_(g1[0]) * u1[0], siluf_(g1[1]) * u1[1]); w.w = cvt_pk_bf16(siluf_(g1[2]) * u1[2], siluf_(g1[3]) * u1[3]);
                *(u32x4*)rowp = w; }
    }
};
struct EpiBranch {
    static constexpr bool PERM = true;
    bf16* Zb;
    __device__ __forceinline__ void operator()(f32x4 (&acc)[2][2][4][2], const Unit& u, int wr, int wc, int fr, int fq) const {
        const int row0 = u.pm * BM + wr * 64 + fr, col0 = u.pn * BM + wc * 32 + 8 * fq; const int j = u.aux;
        bf16* base = Zb + (size_t)row0 * ZLD + col0;
        {
            u32x4 g[2][4][2];
#pragma unroll
            for (int ai = 0; ai < 2; ++ai)
#pragma unroll
                for (int m = 0; m < 4; ++m)
#pragma unroll
                    for (int bj = 0; bj < 2; ++bj) g[ai][m][bj] = *(const u32x4*)(base + (size_t)(ai * HALF + m * 16) * ZLD + ZC_G + j * 1024 + bj * HALF);
#pragma unroll
            for (int ai = 0; ai < 2; ++ai)
#pragma unroll
                for (int m = 0; m < 4; ++m)
#pragma unroll
                    for (int bj = 0; bj < 2; ++bj) { const u32x4 gg = g[ai][m][bj];
                        acc[ai][bj][m][0] = acc[ai][bj][m][0] * (f32x4){bflo(gg.x), bfhi(gg.x), bflo(gg.y), bfhi(gg.y)};
                        acc[ai][bj][m][1] = acc[ai][bj][m][1] * (f32x4){bflo(gg.z), bfhi(gg.z), bflo(gg.w), bfhi(gg.w)}; }
        }
        if (j > 0) {
            u32x4 p[2][4][2];
#pragma unroll
            for (int ai = 0; ai < 2; ++ai)
#pragma unroll
                for (int m = 0; m < 4; ++m)
#pragma unroll
                    for (int bj = 0; bj < 2; ++bj) p[ai][m][bj] = *(const u32x4*)(base + (size_t)(ai * HALF + m * 16) * ZLD + ZC_QK + bj * HALF);
#pragma unroll
            for (int ai = 0; ai < 2; ++ai)
#pragma unroll
                for (int m = 0; m < 4; ++m)
#pragma unroll
                    for (int bj = 0; bj < 2; ++bj) { const u32x4 pp = p[ai][m][bj];
                        acc[ai][bj][m][0] = acc[ai][bj][m][0] + (f32x4){bflo(pp.x), bfhi(pp.x), bflo(pp.y), bfhi(pp.y)};
                        acc[ai][bj][m][1] = acc[ai][bj][m][1] + (f32x4){bflo(pp.z), bfhi(pp.z), bflo(pp.w), bfhi(pp.w)}; }
        }
#pragma unroll
        for (int ai = 0; ai < 2; ++ai)
#pragma unroll
            for (int m = 0; m < 4; ++m)
#pragma unroll
                for (int bj = 0; bj < 2; ++bj) { const f32x4 v0 = acc[ai][bj][m][0], v1 = acc[ai][bj][m][1]; u32x4 w;
                    w.x = cvt_pk_bf16(v0[0], v0[1]); w.y = cvt_pk_bf16(v0[2], v0[3]); w.z = cvt_pk_bf16(v1[0], v1[1]); w.w = cvt_pk_bf16(v1[2], v1[3]);
                    *(u32x4*)(base + (size_t)(ai * HALF + m * 16) * ZLD + ZC_QK + bj * HALF) = w; }
    }
};

template <class Epi, class Sched>
__device__ __forceinline__ void gemm_phase(LAS unsigned char* lds, const Gemm g, const Sched& S, const Epi& E, const int tid) {
    const int wid = __builtin_amdgcn_readfirstlane(tid >> 6), lane = tid & 63, wr = wid >> 2, wc = wid & 3, fr = lane & 15, fq = lane >> 4;
    const int nt = g.K / BK;
    unsigned voffA[2], voffB[2];
#pragma unroll
    for (int i = 0; i < 2; ++i) { int R, C; stage_rc(tid * 16 + i * 8192, R, C); const int Rb = Epi::PERM ? ((R & ~31) + perm32(R & 31)) : R;
        voffA[i] = (unsigned)(R * g.lda + C) * 2u; voffB[i] = (unsigned)(Rb * g.ldb + C) * 2u; }
    const size_t kstep = (size_t)(BK * 2);
    const size_t hstepA = (size_t)HALF * g.lda * 2, hstepB = (size_t)HALF * g.ldb * 2;
    const unsigned ldsw = (unsigned)wid * 1024u;
    const int aoff = lds_byte(wr * 64 + fr, fq * 8), boff = lds_byte(wc * 32 + fr, fq * 8);
#define PG8_SA(b, h) (((b) * 2 + (h)) * HTB)
#define PG8_SB(b, h) ((4 + (b) * 2 + (h)) * HTB)
#define PG8_STAGE(bufoff, gbase, voff) do { _Pragma("unroll") for (int _i = 0; _i < 2; ++_i) \
        __builtin_amdgcn_global_load_lds((const unsigned*)((const char*)(gbase) + (voff)[_i]), (LAS unsigned*)(lds + (bufoff) + ldsw + _i * 8192), 16, 0, 0); } while (0)
#define PG8_LDA(dst, b, h) do { _Pragma("unroll") for (int m = 0; m < 4; ++m) _Pragma("unroll") for (int k = 0; k < 2; ++k) dst[m][k] = *(const LAS bf16x8*)(lds + PG8_SA(b, h) + aoff + m * 2048 + k * 1024); } while (0)
#define PG8_LDB(dst, b, h) do { _Pragma("unroll") for (int n = 0; n < 2; ++n) _Pragma("unroll") for (int k = 0; k < 2; ++k) dst[n][k] = *(const LAS bf16x8*)(lds + PG8_SB(b, h) + boff + n * 2048 + k * 1024); } while (0)
#define PG8_MMA(ai, bj, At, Bt) do { __builtin_amdgcn_s_setprio(1); _Pragma("unroll") for (int m = 0; m < 4; ++m) _Pragma("unroll") for (int n = 0; n < 2; ++n) _Pragma("unroll") for (int k = 0; k < 2; ++k) \
        acc[ai][bj][m][n] = __builtin_amdgcn_mfma_f32_16x16x32_bf16(Bt[n][k], At[m][k], acc[ai][bj][m][n], 0, 0, 0); __builtin_amdgcn_s_setprio(0); } while (0)
#define PG8_WAIT_V(n) asm volatile("s_waitcnt vmcnt(" #n ")" ::: "memory")
#define PG8_WAIT_L(n) asm volatile("s_waitcnt lgkmcnt(" #n ")" ::: "memory")
#define PG8_BAR __builtin_amdgcn_s_barrier()
#define PG8_SCHED __builtin_amdgcn_sched_barrier(0)
    Unit cur, nxt; int ui = 0;
    if (!S.next(0, cur)) return;
    f32x4 acc[2][2][4][2];
#pragma unroll
    for (int a = 0; a < 2; ++a)
#pragma unroll
        for (int b = 0; b < 2; ++b)
#pragma unroll
            for (int m = 0; m < 4; ++m)
#pragma unroll
                for (int n = 0; n < 2; ++n) acc[a][b][m][n] = (f32x4){0.f, 0.f, 0.f, 0.f};
    bf16x8 At[4][2], B0[2][2], B1[2][2];
    const char* cA = cur.a; const char* cB = cur.b;
    PG8_STAGE(PG8_SB(0, 0), cB, voffB); PG8_STAGE(PG8_SB(0, 1), cB + hstepB, voffB); PG8_STAGE(PG8_SA(0, 0), cA, voffA); PG8_STAGE(PG8_SA(0, 1), cA + hstepA, voffA);
    if (wr == 1) PG8_BAR;
    PG8_WAIT_V(2); PG8_BAR;
    PG8_STAGE(PG8_SB(1, 0), cB + kstep, voffB); PG8_STAGE(PG8_SA(1, 0), cA + kstep, voffA); PG8_STAGE(PG8_SB(1, 1), cB + hstepB + kstep, voffB);
    PG8_WAIT_V(6); PG8_BAR;
    for (;;) {
        const bool has_next = S.next(ui + 1, nxt);
        const char* nA = has_next ? nxt.a : cA; const char* nB = has_next ? nxt.b : cB;
        for (int t = 0; t < nt; t += 2) {
            const bool last = (t == nt - 2);
            const char* a1 = cA + (size_t)(t + 1) * kstep;
            const char* a2 = last ? nA : cA + (size_t)(t + 2) * kstep; const char* b2 = last ? nB : cB + (size_t)(t + 2) * kstep;
            const char* a3 = a2 + kstep; const char* b3 = b2 + kstep;
            PG8_LDB(B0, 0, 0); PG8_LDB(B1, 0, 1); PG8_SCHED; PG8_LDA(At, 0, 0); PG8_STAGE(PG8_SA(1, 1), a1 + hstepA, voffA);
            PG8_WAIT_V(8); PG8_WAIT_L(0); PG8_BAR; PG8_MMA(0, 0, At, B0); PG8_MMA(0, 1, At, B1); PG8_BAR; PG8_SCHED;
            PG8_LDA(At, 0, 1); PG8_STAGE(PG8_SB(0, 0), b2, voffB); PG8_STAGE(PG8_SB(0, 1), b2 + hstepB, voffB); PG8_STAGE(PG8_SA(0, 0), a2, voffA);
            PG8_WAIT_V(8); PG8_WAIT_L(0); PG8_BAR; PG8_MMA(1, 0, At, B0); PG8_MMA(1, 1, At, B1); PG8_BAR; PG8_SCHED;
            PG8_LDB(B0, 1, 0); PG8_LDB(B1, 1, 1); PG8_SCHED; PG8_LDA(At, 1, 0); PG8_STAGE(PG8_SA(0, 1), a2 + hstepA, voffA);
            PG8_WAIT_V(8); PG8_WAIT_L(0); PG8_BAR; PG8_MMA(0, 0, At, B0); PG8_MMA(0, 1, At, B1); PG8_BAR; PG8_SCHED;
            PG8_LDA(At, 1, 1); PG8_STAGE(PG8_SB(1, 0), b3, voffB); PG8_STAGE(PG8_SB(1, 1), b3 + hstepB, voffB); PG8_STAGE(PG8_SA(1, 0), a3, voffA);
            PG8_WAIT_V(8); PG8_WAIT_L(0); PG8_BAR; PG8_MMA(1, 0, At, B0); PG8_MMA(1, 1, At, B1); PG8_BAR; PG8_SCHED;
        }
        if (wr == 0) PG8_BAR;
        E(acc, cur, wr, wc, fr, fq);
        if (!has_next) break;
#pragma unroll
        for (int a = 0; a < 2; ++a)
#pragma unroll
            for (int b = 0; b < 2; ++b)
#pragma unroll
                for (int m = 0; m < 4; ++m)
#pragma unroll
                    for (int n = 0; n < 2; ++n) acc[a][b][m][n] = (f32x4){0.f, 0.f, 0.f, 0.f};
        cur = nxt; cA = nA; cB = nB; ++ui;
        if (wr == 1) PG8_BAR;
    }
    PG8_WAIT_V(0);
    PG8_BAR;
#undef PG8_SA
#undef PG8_SB
#undef PG8_STAGE
#undef PG8_LDA
#undef PG8_LDB
#undef PG8_MMA
#undef PG8_WAIT_V
#undef PG8_WAIT_L
#undef PG8_BAR
#undef PG8_SCHED
}
}

#define XB_TMO      128
#define XB_XCNT(j)  (256  + 64 * (j))
#define XB_XSUB(j)  (1280 + 64 * (j))
#define XB_XGEN(j)  (2304 + 64 * (j))
#define XB_TOP      3328
#define XB_TOPGEN   3392
#define XCD_BAR_WORDS 3456
#define XB_SPIN_CAP (1u << 18)
__device__ __forceinline__ unsigned xb_ld(unsigned* p)              { return __hip_atomic_load(p, __ATOMIC_RELAXED, __HIP_MEMORY_SCOPE_AGENT); }
__device__ __forceinline__ unsigned xb_add(unsigned* p, unsigned v) { return __hip_atomic_fetch_add(p, v, __ATOMIC_RELAXED, __HIP_MEMORY_SCOPE_AGENT); }
__device__ __forceinline__ unsigned xb_xcc_id() { return (unsigned)__builtin_amdgcn_s_getreg((3 << 11) | 20) & 0xFu; }
#define XB_SPIN(cond, bar) do { unsigned _sp = 0; while (cond) { __builtin_amdgcn_s_sleep(1); \
    if ((++_sp & 255u) == 0u) { if (xb_ld(&(bar)[XB_TMO])) break; if (_sp > XB_SPIN_CAP) { atomicAdd(&(bar)[XB_TMO], 1u); break; } } } } while (0)
struct XcdBarrier { unsigned* bar; unsigned x; volatile LAS unsigned* st; };
__device__ __forceinline__ XcdBarrier xcd_barrier_post(unsigned* bar, volatile LAS unsigned* st) {
    XcdBarrier b; b.bar = bar; b.x = xb_xcc_id(); b.st = st;
    if (threadIdx.x == 0) (void)xb_add(&bar[XB_XCNT(b.x)], 1u);
    return b;
}
__device__ __forceinline__ void xcd_barrier_complete(unsigned* bar, unsigned x, unsigned& nloc, unsigned& nx) {
    const unsigned G = gridDim.x * gridDim.y * gridDim.z;
    unsigned sum, cnt, mine, sp = 0u;
    for (;;) {
        sum = 0u; cnt = 0u; mine = 0u;
#pragma unroll
        for (unsigned j = 0; j < 16; ++j) { const unsigned c = xb_ld(&bar[XB_XCNT(j)]); sum += c; cnt += (c > 0u) ? 1u : 0u; mine = (j == x) ? c : mine; }
        if (sum == G) break;
        __builtin_amdgcn_s_sleep(1);
        if ((++sp & 255u) == 0u) { if (xb_ld(&bar[XB_TMO])) break; if (sp > XB_SPIN_CAP) { atomicAdd(&bar[XB_TMO], 1u); break; } }
    }
    nloc = mine > 0u ? mine : 1u; nx = cnt > 0u ? cnt : 1u;
}
__device__ __forceinline__ void xcd_barrier(const XcdBarrier& b) {
    asm volatile("s_waitcnt vmcnt(0)" ::: "memory");
    __syncthreads();
    if (threadIdx.x == 0) {
        unsigned* bar = b.bar;
        __builtin_amdgcn_s_waitcnt(0);
        unsigned nloc = b.st[0], nx = b.st[1];
        if (nloc == 0u) { xcd_barrier_complete(bar, b.x, nloc, nx); b.st[0] = nloc; b.st[1] = nx; }
        const unsigned old = xb_add(&bar[XB_XSUB(b.x)], 1u);
        const unsigned gen = old / nloc;
        if (old + 1u == (gen + 1u) * nloc) {
            __builtin_amdgcn_fence(__ATOMIC_RELEASE, "agent");
            asm volatile("s_waitcnt vmcnt(0)" ::: "memory");
            const unsigned og = xb_add(&bar[XB_TOP], 1u);
            const unsigned tg = og / nx;
            if (og + 1u == (tg + 1u) * nx) xb_add(&bar[XB_TOPGEN], 1u);
            else XB_SPIN(xb_ld(&bar[XB_TOPGEN]) == tg, bar);
            __builtin_amdgcn_fence(__ATOMIC_ACQUIRE, "agent");
            xb_add(&bar[XB_XGEN(b.x)], 1u);
            asm volatile("s_waitcnt vmcnt(0)" ::: "memory");
        } else {
            XB_SPIN(xb_ld(&bar[XB_XGEN(b.x)]) == gen, bar);
            __builtin_amdgcn_fence(__ATOMIC_ACQUIRE, "agent");
            asm volatile("s_waitcnt vmcnt(0)" ::: "memory");
        }
    }
    __syncthreads();
}

struct Args { const float* in[18]; float* out; unsigned char* ws; int ph_lo, ph_hi; };
enum { I_X = 0, I_MEM, I_NORMG, I_WGU, I_WDOWN, I_WIN, I_CONVW, I_CONVB, I_BI, I_BF, I_MNORM, I_SLNG, I_SLNB, I_SWS, I_SBS, I_WMKV, I_WBR, I_WOUT };

__device__ __forceinline__ void cvt_item(const float* W, int Nsrc, int K, int srccol, bf16* WT, int dstrow, int kb, LAS float* scr, int lane, const float* gk = nullptr) {
    const int k0 = 64 * kb;
    if ((srccol & 3) == 0) {
        const int c4 = (lane & 7) * 4, rr = lane >> 3;
#pragma unroll
        for (int i = 0; i < 8; ++i) { const int kk = 8 * i + rr; f32x4 x = *(const f32x4*)(W + (size_t)(k0 + kk) * Nsrc + srccol + c4); if (gk) x = x * gk[k0 + kk];
            LAS float* d = scr + kk * 33 + c4; d[0] = x.x; d[1] = x.y; d[2] = x.z; d[3] = x.w; }
    } else {
#pragma unroll 8
        for (int i = 0; i < 32; ++i) { const int kk = 2 * i + (lane >> 5); scr[kk * 33 + (lane & 31)] = W[(size_t)(k0 + kk) * Nsrc + srccol + (lane & 31)] * (gk ? gk[k0 + kk] : 1.f); }
    }
    LDS_WAIT(); asm volatile("" ::: "memory");
    const int c = lane & 7;
#pragma unroll
    for (int j = 0; j < 4; ++j) { const int n = (lane >> 3) + 8 * j; const LAS float* s = scr + (8 * c) * 33 + n;
        u32x4 o; o.x = pk2(s[0 * 33], s[1 * 33]); o.y = pk2(s[2 * 33], s[3 * 33]); o.z = pk2(s[4 * 33], s[5 * 33]); o.w = pk2(s[6 * 33], s[7 * 33]);
        *(u32x4*)(WT + (size_t)(dstrow + n) * K + k0 + 8 * c) = o; }
    LDS_WAIT(); asm volatile("" ::: "memory");
}
__device__ __forceinline__ int win_srccol(int r) {
    if (r < 1024) return r;
    if (r < 2048) return 2048 + (r - 1024);
    if (r < 3072) return 3080 + (r - 2048);
    if (r < 4096) return 5128 + (r - 3072);
    if (r < 7168) return 6152 + (r - 4096);
    if (r < 8192) return 1024 + (r - 7168);
    return 4104 + (r - 8192);
}
__device__ __forceinline__ void convert_layer(const Args& a, int l, unsigned char* ws, LAS unsigned char* lds, int gw, int NGW, int wave, int lane, int gtid, int GT) {
    LAS float* scr = (LAS float*)(lds + wave * 16384);
    bf16* Wb = (bf16*)(ws + WS_W);
    constexpr int I_GU = 16 * 176, I_DN = 44 * 32, I_IN = 16 * 288, I_MKV = 16 * 64, I_BR = 16 * 32, I_OUT = 16 * 32;
    constexpr int NITEMS = 2 * I_GU + 2 * I_DN + I_IN + I_MKV + 3 * I_BR + I_OUT;
    for (int it = gw; it < NITEMS; it += NGW) {
        int r = it;
        if (r < 2 * I_GU) { const int j = r / I_GU; r -= j * I_GU; const int kb = r / 176, nb = r % 176; const int p = nb >> 3, q = nb & 7, s = q >> 2, jj = (q & 3) * 32;
            cvt_item(a.in[I_WGU] + (size_t)(l * 2 + j) * D * 2 * DFF, 2 * DFF, D, s * DFF + 128 * p + jj, (bf16*)((char*)Wb + (j ? WO_GU1 : WO_GU0)), nb * 32, kb, scr, lane, a.in[I_NORMG] + (size_t)(l * NNORM + (j ? 4 : 0)) * D); continue; }
        r -= 2 * I_GU;
        if (r < 2 * I_DN) { const int j = r / I_DN; r -= j * I_DN; const int kb = r / 32, nb = r % 32;
            cvt_item(a.in[I_WDOWN] + (size_t)(l * 2 + j) * DFF * D, D, DFF, nb * 32, (bf16*)((char*)Wb + (j ? WO_D1 : WO_D0)), nb * 32, kb, scr, lane); continue; }
        r -= 2 * I_DN;
        if (r < I_IN) { const int kb = r / 288, nb = r % 288;
            cvt_item(a.in[I_WIN] + (size_t)l * D * WIN_COLS, WIN_COLS, D, win_srccol(nb * 32), (bf16*)((char*)Wb + WO_IN), nb * 32, kb, scr, lane, a.in[I_NORMG] + (size_t)(l * NNORM + 2) * D); continue; }
        r -= I_IN;
        if (r < I_MKV) { const int kb = r / 64, nb = r % 64;
            cvt_item(a.in[I_WMKV] + (size_t)l * D * 2048, 2048, D, nb * 32, (bf16*)((char*)Wb + WO_MKV), nb * 32, kb, scr, lane); continue; }
        r -= I_MKV;
        if (r < 3 * I_BR) { const int j = r / I_BR; r -= j * I_BR; const int kb = r / 32, nb = r % 32;
            cvt_item(a.in[I_WBR] + (size_t)(l * 3 + j) * D * D, D, D, nb * 32, (bf16*)((char*)Wb + WO_BR) + (size_t)j * D * D, nb * 32, kb, scr, lane); continue; }
        r -= 3 * I_BR;
        { const int kb = r / 32, nb = r % 32; cvt_item(a.in[I_WOUT] + (size_t)l * D * D, D, D, nb * 32, (bf16*)((char*)Wb + WO_OUT), nb * 32, kb, scr, lane); }
    }
    { const float* win = a.in[I_WIN] + (size_t)l * D * WIN_COLS; const float* g2 = a.in[I_NORMG] + (size_t)(l * NNORM + 2) * D; float* wt = (float*)(ws + WS_WIF);
      for (int e = gtid; e < 8 * D; e += GT) { const int k = e >> 3, c = e & 7; wt[c * D + k] = win[(size_t)k * WIN_COLS + 3072 + c] * g2[k]; } }
    bf16* wsg = (bf16*)(ws + WS_WSGU); const float* src = a.in[I_SWS] + (size_t)l * 4 * 128 * 128;
    for (int e = gtid; e < 4 * 128 * 128; e += GT) { const int t = (e >> 7) & 127, s = e & 127; wsg[e] = (bf16)f2bf(s <= t ? src[e] : 0.f); }
    const float* g6 = a.in[I_NORMG] + (size_t)(l * NNORM + 6) * D;
    for (int m = gw; m < MMEM; m += NGW) {
        const f32x4* xr = (const f32x4*)(a.in[I_MEM] + (size_t)m * D) + lane; f32x4 v[4]; float s = 0.f;
#pragma unroll
        for (int j = 0; j < 4; ++j) { v[j] = xr[64 * j]; s += (v[j].x * v[j].x + v[j].y * v[j].y) + (v[j].z * v[j].z + v[j].w * v[j].w); }
        const float rstd = rsqrtf(wave_sum(s, lane) * (1.f / D) + EPS);
        unsigned long long* o8 = (unsigned long long*)((bf16*)(ws + WS_MEMN) + (size_t)m * D) + lane;
#pragma unroll
        for (int j = 0; j < 4; ++j) { const f32x4 gg = ((const f32x4*)g6)[lane + 64 * j];
            o8[64 * j] = (unsigned long long)pk2(v[j].x * rstd * gg.x, v[j].y * rstd * gg.y) | ((unsigned long long)pk2(v[j].z * rstd * gg.z, v[j].w * rstd * gg.w) << 32); }
    }
}

__device__ __forceinline__ void thin_rows(const bf16* fbase, size_t fld, const float* ga, float scale, const float* hin32, const bf16* hinb, bf16* hb_out, float* rstd_out, float* out32,
                                          int row_lo, int row_hi, int gw, int NGW, int lane, const bool do_gates, const LAS float* wif, const float* bi, const float* bfg, float* gate_i, float* gate_f) {
    f32x4 hn32[4]; unsigned long long hnb[4], fn[4];
    int m = row_lo + gw;
    if (m < row_hi) {
        if (hin32) { const f32x4* hr = (const f32x4*)(hin32 + (size_t)m * D) + lane;
#pragma unroll
            for (int j = 0; j < 4; ++j) hn32[j] = hr[64 * j]; }
        else { const unsigned long long* hr = (const unsigned long long*)(hinb + (size_t)m * D) + lane;
#pragma unroll
            for (int j = 0; j < 4; ++j) hnb[j] = hr[64 * j]; }
        if (fbase) { const unsigned long long* fr = (const unsigned long long*)(fbase + (size_t)(m - row_lo) * fld) + lane;
#pragma unroll
            for (int j = 0; j < 4; ++j) fn[j] = fr[64 * j]; }
    }
    for (; m < row_hi; m += NGW) {
        f32x4 v[4]; unsigned long long fc[4];
        if (hin32) {
#pragma unroll
            for (int j = 0; j < 4; ++j) v[j] = hn32[j]; }
        else {
#pragma unroll
            for (int j = 0; j < 4; ++j) { const unsigned long long w = hnb[j]; const unsigned lo = (unsigned)w, hi = (unsigned)(w >> 32); v[j] = (f32x4){bflo(lo), bfhi(lo), bflo(hi), bfhi(hi)}; } }
#pragma unroll
        for (int j = 0; j < 4; ++j) fc[j] = fn[j];
        const int mn = m + NGW;
        if (mn < row_hi) {
            if (hin32) { const f32x4* hr = (const f32x4*)(hin32 + (size_t)mn * D) + lane;
#pragma unroll
                for (int j = 0; j < 4; ++j) hn32[j] = hr[64 * j]; }
            else { const unsigned long long* hr = (const unsigned long long*)(hinb + (size_t)mn * D) + lane;
#pragma unroll
                for (int j = 0; j < 4; ++j) hnb[j] = hr[64 * j]; }
            if (fbase) { const unsigned long long* fr = (const unsigned long long*)(fbase + (size_t)(mn - row_lo) * fld) + lane;
#pragma unroll
                for (int j = 0; j < 4; ++j) fn[j] = fr[64 * j]; }
        }
        if (fbase) {
            float s = 0.f; f32x4 f[4];
#pragma unroll
            for (int j = 0; j < 4; ++j) { const unsigned long long w = fc[j]; const unsigned lo = (unsigned)w, hi = (unsigned)(w >> 32);
                f[j] = (f32x4){bflo(lo), bfhi(lo), bflo(hi), bfhi(hi)}; s += (f[j].x * f[j].x + f[j].y * f[j].y) + (f[j].z * f[j].z + f[j].w * f[j].w); }
            const float rstd = rsqrtf(wave_sum(s, lane) * (1.f / D) + EPS) * scale;
#pragma unroll
            for (int j = 0; j < 4; ++j) { const f32x4 gg = ((const f32x4*)ga)[lane + 64 * j]; v[j] = v[j] + f[j] * rstd * gg; }
        }
        if (out32) { f32x4* ho = (f32x4*)(out32 + (size_t)m * D) + lane;
#pragma unroll
            for (int j = 0; j < 4; ++j) ho[64 * j] = v[j]; }
        if (hb_out) {
            float s = 0.f;
#pragma unroll
            for (int j = 0; j < 4; ++j) s += (v[j].x * v[j].x + v[j].y * v[j].y) + (v[j].z * v[j].z + v[j].w * v[j].w);
            const float rstd = rsqrtf(wave_sum(s, lane) * (1.f / D) + EPS);
            unsigned long long* o8 = (unsigned long long*)(hb_out + (size_t)m * D) + lane;
#pragma unroll
            for (int j = 0; j < 4; ++j) o8[64 * j] = (unsigned long long)pk2(v[j].x, v[j].y) | ((unsigned long long)pk2(v[j].z, v[j].w) << 32);
            if (lane == 0) rstd_out[m] = rstd;
            if (do_gates) {
                float acc[8];
#pragma unroll
                for (int e = 0; e < 8; ++e) acc[e] = 0.f;
#pragma unroll
                for (int j = 0; j < 4; ++j)
#pragma unroll
                    for (int e = 0; e < 8; ++e) { const f32x4 w4 = *(const LAS f32x4*)(wif + e * D + 4 * lane + 256 * j); acc[e] += (v[j].x * w4.x + v[j].y * w4.y) + (v[j].z * w4.z + v[j].w * w4.w); }
                {
                    float b4[4], b2[2], b1;
#pragma unroll
                    for (int e = 0; e < 4; ++e) { const float mine = (lane & 4) ? acc[4 + e] : acc[e], send = (lane & 4) ? acc[e] : acc[4 + e]; b4[e] = mine + dppf<DPP_HMIR>(send); }
#pragma unroll
                    for (int e = 0; e < 2; ++e) { const float mine = (lane & 2) ? b4[2 + e] : b4[e], send = (lane & 2) ? b4[e] : b4[2 + e]; b2[e] = mine + dppf<DPP_XOR2>(send); }
                    { const float mine = (lane & 1) ? b2[1] : b2[0], send = (lane & 1) ? b2[0] : b2[1]; b1 = mine + dppf<DPP_XOR1>(send); }
                    b1 += shx(b1, 8, lane); b1 += shx(b1, 16, lane); b1 += shx(b1, 32, lane);
                    const float val = b1 * rstd;
                    if (lane < 4) gate_i[(size_t)m * 4 + lane] = val + bi[lane];
                    else if (lane < 8) gate_f[(size_t)m * 4 + lane - 4] = logsigmoidf_(val + bfg[lane - 4]);
                }
            }
        }
    }
}

__device__ __forceinline__ void conv8(const bf16* Zb, int bl, int p, int col, const float* cw, const float* cb, float (&o)[8]) {
    const f32x4 b0 = *(const f32x4*)(cb + col), b1 = *(const f32x4*)(cb + col + 4);
    o[0] = b0.x; o[1] = b0.y; o[2] = b0.z; o[3] = b0.w; o[4] = b1.x; o[5] = b1.y; o[6] = b1.z; o[7] = b1.w;
#pragma unroll
    for (int j = 0; j < 4; ++j) { const int pp = p - 3 + j;
        if (pp >= 0) { const u32x4 x = *(const u32x4*)(Zb + (size_t)(bl * SEQ + pp) * ZLD + ZC_QK + col);
            const f32x4 w0 = *(const f32x4*)(cw + j * 1024 + col), w1 = *(const f32x4*)(cw + j * 1024 + col + 4);
            o[0] += w0.x * bflo(x.x); o[1] += w0.y * bfhi(x.x); o[2] += w0.z * bflo(x.y); o[3] += w0.w * bfhi(x.y);
            o[4] += w1.x * bflo(x.z); o[5] += w1.y * bfhi(x.z); o[6] += w1.z * bflo(x.w); o[7] += w1.w * bfhi(x.w); } }
#pragma unroll
    for (int e = 0; e < 8; ++e) o[e] = siluf_(o[e]);
}
__device__ __forceinline__ float wave_incl_scan_add(float v, int lane) {
#pragma unroll
    for (int o = 1; o < 64; o <<= 1) { const float t = shidx(v, lane >= o ? lane - o : lane); if (lane >= o) v += t; }
    return v;
}
__device__ __forceinline__ float wave_incl_scan_max(float v, int lane) {
#pragma unroll
    for (int o = 1; o < 64; o <<= 1) { const float t = shidx(v, lane >= o ? lane - o : lane); if (lane >= o) v = fmaxf(v, t); }
    return v;
}
__device__ __forceinline__ float wave_max(float v, int lane) { v = row16_max(v); v = fmaxf(v, shx(v, 16, lane)); v = fmaxf(v, shx(v, 32, lane)); return v; }
constexpr float KSCALE = 0.08838834764831845f;

__device__ __forceinline__ void conv_load(const bf16* Zb, int bl, int p, int col, u32x4 (&raw)[4]) {
#pragma unroll
    for (int j = 0; j < 4; ++j) { const int pp = p - 3 + j; raw[j] = (u32x4){0u, 0u, 0u, 0u};
        if (pp >= 0) raw[j] = *(const u32x4*)(Zb + (size_t)(bl * SEQ + pp) * ZLD + ZC_QK + col); }
}
__device__ __forceinline__ void conv_apply(const u32x4 (&raw)[4], const LAS float* wl, const int wstride, float (&o)[8]) {
    { const f32x4 b0 = *(const LAS f32x4*)(wl + 4 * wstride), b1 = *(const LAS f32x4*)(wl + 4 * wstride + 4);
      o[0] = b0.x; o[1] = b0.y; o[2] = b0.z; o[3] = b0.w; o[4] = b1.x; o[5] = b1.y; o[6] = b1.z; o[7] = b1.w; }
#pragma unroll
    for (int j = 0; j < 4; ++j) { const u32x4 x = raw[j];
        const f32x4 w0 = *(const LAS f32x4*)(wl + j * wstride), w1 = *(const LAS f32x4*)(wl + j * wstride + 4);
        o[0] += w0.x * bflo(x.x); o[1] += w0.y * bfhi(x.x); o[2] += w0.z * bflo(x.y); o[3] += w0.w * bfhi(x.y);
        o[4] += w1.x * bflo(x.z); o[5] += w1.y * bfhi(x.z); o[6] += w1.z * bflo(x.w); o[7] += w1.w * bfhi(x.w); }
#pragma unroll
    for (int e = 0; e < 8; ++e) o[e] = siluf_(o[e]);
}
__device__ __forceinline__ void stage_convw(LAS float* wl, const float* cw, const float* cb, int col0, int ncol, int dst0, int wstride, int tid) {
    for (int e = tid; e < 5 * ncol; e += NTHR) { const int j = e / ncol, cidx = e - j * ncol; wl[j * wstride + dst0 + cidx] = (j < 4) ? cw[j * 1024 + col0 + cidx] : cb[col0 + cidx]; }
}
__device__ __forceinline__ void mlstm_s1(const Args& a, int l, int hf, unsigned char* ws, LAS unsigned char* lds, int G, int cu, int tid, int wave, int lane) {
    const bf16* Zb = (const bf16*)(ws + WS_Z); const bf16* ZT = (const bf16*)(ws + WS_ZT);
    const float* gi = (const float*)(ws + WS_GATE); const float* gf = gi + (size_t)M * 4;
    const float* cw = a.in[I_CONVW] + (size_t)l * 4 * 1024; const float* cb = a.in[I_CONVB] + (size_t)l * 1024;
    LAS bf16* KT = (LAS bf16*)lds;
    LAS float* wv = (LAS float*)(lds + 18432);
    LAS float* CWL = (LAS float*)(lds + 18688);
    const int c8 = tid & 15; int hcur = -1;
    for (int u = cu; u < 16 * NCH; u += G) {
        const int h = u & 3, c = (u >> 2) & 63, bl = u >> 8, bhl = bl * 4 + h; const int tokg = (hf * 4 + bl) * SEQ + c * LCH;
        if (h != hcur) { __syncthreads(); stage_convw(CWL, cw, cb, 512 + h * 128, 128, 0, 128, tid); hcur = h; }
        const int r = lane & 31, hh = lane >> 5, v0 = 32 * wave;
        bf16x8 bfr[4];
        { const bf16* vrow = ZT + (size_t)(h * 256 + v0 + r) * ZTLD + bl * SEQ + c * LCH + 8 * hh;
#pragma unroll
          for (int ks = 0; ks < 4; ++ks) bfr[ks] = *(const bf16x8*)(vrow + 16 * ks); }
        u32x4 raw[2][4];
#pragma unroll
        for (int rep = 0; rep < 2; ++rep) conv_load(Zb, bl, c * LCH + ((tid + rep * NTHR) >> 4), 512 + h * 128 + c8 * 8, raw[rep]);
        if (wave == 0) {
            const float lf = gf[(size_t)(tokg + lane) * 4 + h], ii = gi[(size_t)(tokg + lane) * 4 + h];
            const float bc = wave_incl_scan_add(lf, lane); const float g = shidx(bc, 63);
            const float av = g - bc + ii; const float ml = wave_max(av, lane);
            wv[lane] = __expf(av - ml);
            if (lane == 0) { float* cs = (float*)(ws + WS_CSC) + (size_t)(bhl * NCH + c) * 4; cs[0] = g; cs[1] = ml; }
        }
        __syncthreads();
#pragma unroll
        for (int rep = 0; rep < 2; ++rep) { const int idx = tid + rep * NTHR, s = idx >> 4; float o[8];
            conv_apply(raw[rep], CWL + c8 * 8, 128, o); const float sc = wv[s] * KSCALE;
            { u32x4 w; w.x = pk2(o[0] * KSCALE, o[1] * KSCALE); w.y = pk2(o[2] * KSCALE, o[3] * KSCALE); w.z = pk2(o[4] * KSCALE, o[5] * KSCALE); w.w = pk2(o[6] * KSCALE, o[7] * KSCALE);
              *(u32x4*)((bf16*)(ws + WS_KC) + (size_t)(bl * SEQ + c * LCH + s) * 512 + h * 128 + c8 * 8) = w; }
#pragma unroll
            for (int e = 0; e < 8; ++e) KT[(c8 * 8 + e) * 72 + s] = (bf16)f2bf(o[e] * sc); }
        __syncthreads();
        if (tid < 128) { float s = 0.f;
#pragma unroll 8
            for (int k = 0; k < 64; ++k) s += bf1(KT[tid * 72 + k]);
            ((float*)(ws + WS_NST))[(size_t)(bhl * NCH + c) * 128 + tid] = s; }
        {
            LAS bf16* SL = (LAS bf16*)(lds + 21248);
#pragma unroll
            for (int db = 0; db < 4; ++db) { f32x16 acc;
#pragma unroll
                for (int e = 0; e < 16; ++e) acc[e] = 0.f;
#pragma unroll
                for (int ks = 0; ks < 4; ++ks) { const bf16x8 af = *(const LAS bf16x8*)(KT + (32 * db + r) * 72 + 16 * ks + 8 * hh); acc = __builtin_amdgcn_mfma_f32_32x32x16_bf16(af, bfr[ks], acc, 0, 0, 0); }
#pragma unroll
                for (int q = 0; q < 4; ++q) { u32x2 w; w.x = pk2(acc[4 * q], acc[4 * q + 1]); w.y = pk2(acc[4 * q + 2], acc[4 * q + 3]); *(LAS u32x2*)(SL + (v0 + r) * 136 + 32 * db + 8 * q + 4 * hh) = w; } }
            __syncthreads();
            bf16* st = (bf16*)(ws + WS_ST) + (size_t)(bhl * NCH + c) * 32768;
#pragma unroll
            for (int rep = 0; rep < 8; ++rep) { const int idx = tid + rep * NTHR, row = idx >> 4, c16 = idx & 15; *(u32x4*)(st + row * 128 + c16 * 8) = *(const LAS u32x4*)(SL + row * 136 + c16 * 8); }
        }
    }
    __syncthreads();
}
__device__ __forceinline__ void mlstm_s2(unsigned char* ws, int G, int cu, int tid) {
    for (int u = cu; u < 256; u += G) {
        const int bhl = u >> 4, part = u & 15; const size_t off = (size_t)(part * NTHR + tid) * 4;
        bf16* st = (bf16*)(ws + WS_ST) + (size_t)bhl * NCH * 32768 + off; float* ns = (float*)(ws + WS_NST) + (size_t)bhl * NCH * 128 + tid; float* cs = (float*)(ws + WS_CSC) + (size_t)bhl * NCH * 4;
        const bool nth = (part == 0 && tid < 128);
        float C[4]; float nv = 0.f, m = -1e30f;
#pragma unroll
        for (int e = 0; e < 4; ++e) C[e] = 0.f;
        for (int c0 = 0; c0 < NCH; c0 += 8) {
            u32x2 cl[8]; float nl[8], gg[8], ml[8];
#pragma unroll
            for (int i = 0; i < 8; ++i) { cl[i] = *(const u32x2*)(st + (size_t)(c0 + i) * 32768); nl[i] = nth ? ns[(c0 + i) * 128] : 0.f; gg[i] = cs[(c0 + i) * 4]; ml[i] = cs[(c0 + i) * 4 + 1]; }
#pragma unroll
            for (int i = 0; i < 8; ++i) {
                u32x2 o; o.x = pk2(C[0], C[1]); o.y = pk2(C[2], C[3]);
                *(u32x2*)(st + (size_t)(c0 + i) * 32768) = o;
                if (nth) ns[(c0 + i) * 128] = nv;
                if (part == 0 && tid == 0) cs[(c0 + i) * 4 + 2] = m;
                const float mn = fmaxf(gg[i] + m, ml[i]); const float dec = __expf(gg[i] + m - mn), sc = __expf(ml[i] - mn);
                C[0] = dec * C[0] + sc * bflo(cl[i].x); C[1] = dec * C[1] + sc * bfhi(cl[i].x); C[2] = dec * C[2] + sc * bflo(cl[i].y); C[3] = dec * C[3] + sc * bfhi(cl[i].y);
                nv = dec * nv + sc * nl[i]; m = mn;
            }
        }
    }
}
__device__ __forceinline__ void mlstm_s3(const Args& a, int l, int hf, unsigned char* ws, LAS unsigned char* lds, int G, int cu, int tid, int wave, int lane, const int out_col) {
    bf16* Zb = (bf16*)(ws + WS_Z); const bf16* ZT = (const bf16*)(ws + WS_ZT);
    const float* gi = (const float*)(ws + WS_GATE); const float* gf = gi + (size_t)M * 4;
    const float* cw = a.in[I_CONVW] + (size_t)l * 4 * 1024; const float* cb = a.in[I_CONVB] + (size_t)l * 1024;
    const float* gain = a.in[I_MNORM] + (size_t)l * 1024;
    LAS bf16* QS = (LAS bf16*)lds;
    LAS bf16* KS = (LAS bf16*)(lds + 17408);
    LAS bf16* SD = (LAS bf16*)(lds + 34816);
    LAS float* HB = (LAS float*)(lds + 44032);
    LAS float* SC = (LAS float*)(lds + 110592);
    LAS float* CWL = (LAS float*)(lds + 112384);
    const int c8 = tid & 15; int hcur = -1;
    for (int u = cu; u < 16 * NCH; u += G) {
        const int h = u & 3, c = (u >> 2) & 63, bl = u >> 8, bhl = bl * 4 + h; const int tokg = (hf * 4 + bl) * SEQ + c * LCH; const int tokl = bl * SEQ + c * LCH;
        if (h != hcur) { __syncthreads(); stage_convw(CWL, cw, cb, h * 128, 128, 0, 256, tid); hcur = h; __syncthreads(); }
        const int r = lane & 31, hh = lane >> 5, v0 = 32 * wave;
        bf16x8 bV[4], bC[8];
        { const bf16* vrow = ZT + (size_t)(h * 256 + v0 + r) * ZTLD + tokl + 8 * hh;
          const bf16* crow = (const bf16*)(ws + WS_ST) + (size_t)(bhl * NCH + c) * 32768 + (size_t)(v0 + r) * 128 + 8 * hh;
#pragma unroll
          for (int ks = 0; ks < 4; ++ks) bV[ks] = *(const bf16x8*)(vrow + 16 * ks);
#pragma unroll
          for (int ks = 0; ks < 8; ++ks) bC[ks] = *(const bf16x8*)(crow + 16 * ks); }
        u32x4 ogr[4];
#pragma unroll
        for (int i = 0; i < 4; ++i) ogr[i] = *(const u32x4*)(Zb + (size_t)(tokl + (tid >> 3)) * ZLD + ZC_O + h * 256 + 32 * (tid & 7) + 8 * i);
        u32x4 kt[2];
#pragma unroll
        for (int rep = 0; rep < 2; ++rep) { const int t = (tid + rep * NTHR) >> 4; kt[rep] = *(const u32x4*)((const bf16*)(ws + WS_KC) + (size_t)(tokl + t) * 512 + h * 128 + c8 * 8); }
        if (wave == 0) {
            const float lf = gf[(size_t)(tokg + lane) * 4 + h], ii = gi[(size_t)(tokg + lane) * 4 + h];
            const float bc = wave_incl_scan_add(lf, lane); const float rr = ii - bc; const float cm = wave_incl_scan_max(rr, lane);
            const float mst = ((const float*)(ws + WS_CSC))[(size_t)(bhl * NCH + c) * 4 + 2];
            const float Mt = fmaxf(mst, cm);
            SC[lane] = rr; SC[64 + lane] = Mt; SC[128 + lane] = __expf(mst - Mt); SC[192 + lane] = __expf(-(bc + Mt));
        } else if (wave == 1 || wave == 2) { const int d = (wave - 1) * 64 + lane; SC[320 + d] = ((const float*)(ws + WS_NST))[(size_t)(bhl * NCH + c) * 128 + d]; }
#pragma unroll
        for (int rep = 0; rep < 2; ++rep) { const int idx = tid + rep * NTHR, t = idx >> 4; float o[8];
            { u32x4 rawq[4]; conv_load(Zb, bl, c * LCH + t, h * 128 + c8 * 8, rawq); conv_apply(rawq, CWL + c8 * 8, 256, o); }
            u32x4 w; w.x = pk2(o[0], o[1]); w.y = pk2(o[2], o[3]); w.z = pk2(o[4], o[5]); w.w = pk2(o[6], o[7]);
            *(LAS u32x4*)(QS + t * 136 + c8 * 8) = w;
            *(LAS u32x4*)(KS + t * 136 + c8 * 8) = kt[rep]; }
        __syncthreads();
        {
            const int tb = wave >> 1, fr = lane & 15, fq = lane >> 4;
#pragma unroll
            for (int i = 0; i < 2; ++i) { const int sblk = (wave & 1) * 2 + i; f32x4 acc = (f32x4){0.f, 0.f, 0.f, 0.f};
                if (sblk <= tb) {
#pragma unroll
                    for (int ks = 0; ks < 4; ++ks) { const bf16x8 af = *(const LAS bf16x8*)(QS + (16 * tb + fr) * 136 + 32 * ks + 8 * fq), bfv = *(const LAS bf16x8*)(KS + (16 * sblk + fr) * 136 + 32 * ks + 8 * fq);
                        acc = __builtin_amdgcn_mfma_f32_16x16x32_bf16(af, bfv, acc, 0, 0, 0); } }
                const int s = 16 * sblk + fr; const float rs_ = SC[s];
#pragma unroll
                for (int e = 0; e < 4; ++e) { const int t = 16 * tb + 4 * fq + e; const float val = (s <= t) ? acc[e] * __expf(rs_ - SC[64 + t]) : 0.f; SD[t * 72 + s] = (bf16)f2bf(val); } }
        }
        f32x16 aQ0, aQ1, aS0, aS1;
#pragma unroll
        for (int e = 0; e < 16; ++e) { aQ0[e] = 0.f; aQ1[e] = 0.f; aS0[e] = 0.f; aS1[e] = 0.f; }
#pragma unroll
        for (int ks = 0; ks < 8; ++ks) {
            const bf16x8 a0 = *(const LAS bf16x8*)(QS + r * 136 + 16 * ks + 8 * hh), a1 = *(const LAS bf16x8*)(QS + (32 + r) * 136 + 16 * ks + 8 * hh);
            aQ0 = __builtin_amdgcn_mfma_f32_32x32x16_bf16(a0, bC[ks], aQ0, 0, 0, 0); aQ1 = __builtin_amdgcn_mfma_f32_32x32x16_bf16(a1, bC[ks], aQ1, 0, 0, 0); }
        __syncthreads();
        {
            const int t = tid >> 3, p = tid & 7; float ds = 0.f, qn = 0.f;
#pragma unroll
            for (int k = 0; k < 8; ++k) ds += bf1(SD[t * 72 + 8 * p + k]);
#pragma unroll
            for (int k = 0; k < 16; ++k) qn += bf1(QS[t * 136 + 16 * p + k]) * SC[320 + 16 * p + k];
            float den = ds + SC[128 + t] * qn;
            den = grp8_sum(den);
            if (p == 0) SC[256 + t] = 1.f / fmaxf(fabsf(den), SC[192 + t]);
        }
#pragma unroll
        for (int ks = 0; ks < 4; ++ks) {
            const bf16x8 a0 = *(const LAS bf16x8*)(SD + r * 72 + 16 * ks + 8 * hh), a1 = *(const LAS bf16x8*)(SD + (32 + r) * 72 + 16 * ks + 8 * hh);
            aS0 = __builtin_amdgcn_mfma_f32_32x32x16_bf16(a0, bV[ks], aS0, 0, 0, 0); aS1 = __builtin_amdgcn_mfma_f32_32x32x16_bf16(a1, bV[ks], aS1, 0, 0, 0); }
        __syncthreads();
#pragma unroll
        for (int e = 0; e < 16; ++e) { const int t0 = (e & 3) + 8 * (e >> 2) + 4 * hh;
            HB[t0 * 260 + v0 + r] = (aS0[e] + SC[128 + t0] * aQ0[e]) * SC[256 + t0]; HB[(32 + t0) * 260 + v0 + r] = (aS1[e] + SC[128 + 32 + t0] * aQ1[e]) * SC[256 + 32 + t0]; }
        __syncthreads();
        {
            const int t = tid >> 3, p = tid & 7; f32x4 x[8]; float sm = 0.f;
#pragma unroll
            for (int k = 0; k < 8; ++k) { x[k] = *(const LAS f32x4*)(HB + t * 260 + 32 * p + 4 * k); sm += (x[k].x + x[k].y) + (x[k].z + x[k].w); }
            sm = grp8_sum(sm);
            const float mean = sm * (1.f / 256.f); float sq = 0.f;
#pragma unroll
            for (int k = 0; k < 8; ++k) { x[k] = x[k] - mean; sq += (x[k].x * x[k].x + x[k].y * x[k].y) + (x[k].z * x[k].z + x[k].w * x[k].w); }
            sq = grp8_sum(sq);
            const float rstd = rsqrtf(sq * (1.f / 256.f) + EPS);
            const float* gp = gain + h * 256 + 32 * p; bf16* op = Zb + (size_t)(tokl + t) * ZLD + out_col + h * 256 + 32 * p;
#pragma unroll
            for (int i = 0; i < 4; ++i) { const f32x4 g0 = *(const f32x4*)(gp + 8 * i), g1 = *(const f32x4*)(gp + 8 * i + 4); const f32x4 a = x[2 * i] * rstd * g0, b = x[2 * i + 1] * rstd * g1; const u32x4 og = ogr[i]; u32x4 w;
                w.x = pk2(a.x * bflo(og.x), a.y * bfhi(og.x)); w.y = pk2(a.z * bflo(og.y), a.w * bfhi(og.y)); w.z = pk2(b.x * bflo(og.z), b.y * bfhi(og.z)); w.w = pk2(b.z * bflo(og.w), b.w * bfhi(og.w));
                *(u32x4*)(op + 8 * i) = w; }
        }
        __syncthreads();
    }
}

__device__ __forceinline__ void sgu_phase(const Args& a, int l, unsigned char* ws, LAS unsigned char* lds, int G, int cu, int tid, int wave, int lane, const int out_col) {
    bf16* Zb = (bf16*)(ws + WS_Z); const bf16* ZT = (const bf16*)(ws + WS_ZT); const bf16* Wc = (const bf16*)(ws + WS_WSGU);
    const float* lng = a.in[I_SLNG] + (size_t)l * 1024; const float* lnb = a.in[I_SLNB] + (size_t)l * 1024; const float* bs = a.in[I_SBS] + (size_t)l * 4 * 128;
    LAS bf16* VT = (LAS bf16*)lds;
    LAS float* PS = (LAS float*)(lds + 69632);
    LAS float* ST = (LAS float*)(lds + 69632 + 8192);
    LAS bf16* WS_ = (LAS bf16*)(lds + 78848);
    const int c8 = tid & 15, dq = tid >> 4;
    int gcur = -1;
    u32x4 x[8];
    if (cu < 4 * 32 * 4) { const int g = cu & 3, cc = (cu >> 2) & 31, bl = cu >> 7;
#pragma unroll
        for (int rep = 0; rep < 8; ++rep) x[rep] = *(const u32x4*)(ZT + (size_t)(1024 + g * 256 + dq + 32 * rep) * ZTLD + bl * SEQ + cc * 128 + c8 * 8); }
    for (int u = cu; u < 4 * 32 * 4; u += G) {
        const int g = u & 3, cc = (u >> 2) & 31, bl = u >> 7; const int tokl = bl * SEQ + cc * 128;
        if (g != gcur) { __syncthreads();
#pragma unroll
            for (int rep = 0; rep < 4; ++rep) { const int idx = tid + rep * NTHR, t = idx >> 4; *(LAS u32x4*)(WS_ + t * 136 + c8 * 8) = *(const u32x4*)(Wc + (size_t)(g * 128 + t) * 128 + c8 * 8); }
            gcur = g; }
        {
            float sm[8], sq[8];
#pragma unroll
            for (int k = 0; k < 8; ++k) { sm[k] = 0.f; sq[k] = 0.f; }
#pragma unroll
            for (int rep = 0; rep < 8; ++rep) { const u32x4 v = x[rep]; const float f0 = bflo(v.x), f1 = bfhi(v.x), f2 = bflo(v.y), f3 = bfhi(v.y), f4 = bflo(v.z), f5 = bfhi(v.z), f6 = bflo(v.w), f7 = bfhi(v.w);
                sm[0] += f0; sq[0] += f0 * f0; sm[1] += f1; sq[1] += f1 * f1; sm[2] += f2; sq[2] += f2 * f2; sm[3] += f3; sq[3] += f3 * f3;
                sm[4] += f4; sq[4] += f4 * f4; sm[5] += f5; sq[5] += f5 * f5; sm[6] += f6; sq[6] += f6 * f6; sm[7] += f7; sq[7] += f7 * f7; }
#pragma unroll
            for (int k = 0; k < 8; ++k) { sm[k] += shx(sm[k], 16, lane); sq[k] += shx(sq[k], 16, lane); sm[k] += shx(sm[k], 32, lane); sq[k] += shx(sq[k], 32, lane); }
            if (lane < 16) {
#pragma unroll
                for (int k = 0; k < 8; ++k) { PS[(wave * 128 + c8 * 8 + k) * 2] = sm[k]; PS[(wave * 128 + c8 * 8 + k) * 2 + 1] = sq[k]; } }
        }
        __syncthreads();
        if (tid < 128) { float sm = 0.f, sq = 0.f;
#pragma unroll
            for (int p = 0; p < 8; ++p) { sm += PS[(p * 128 + tid) * 2]; sq += PS[(p * 128 + tid) * 2 + 1]; }
            const float mean = sm * (1.f / 256.f); const float var = fmaxf(sq * (1.f / 256.f) - mean * mean, 0.f); ST[tid] = mean; ST[128 + tid] = rsqrtf(var + EPS); }
        __syncthreads();
        { const LAS float* mp = ST + c8 * 8; const LAS float* rp = ST + 128 + c8 * 8; float mm[8], rr[8];
#pragma unroll
            for (int k = 0; k < 8; ++k) { mm[k] = mp[k]; rr[k] = rp[k]; }
#pragma unroll
            for (int rep = 0; rep < 8; ++rep) { const int d = dq + 32 * rep; const float gg = lng[g * 256 + d], bb = lnb[g * 256 + d]; u32x4 v = x[rep];
                v.x = pk2((bflo(v.x) - mm[0]) * rr[0] * gg + bb, (bfhi(v.x) - mm[1]) * rr[1] * gg + bb); v.y = pk2((bflo(v.y) - mm[2]) * rr[2] * gg + bb, (bfhi(v.y) - mm[3]) * rr[3] * gg + bb);
                v.z = pk2((bflo(v.z) - mm[4]) * rr[4] * gg + bb, (bfhi(v.z) - mm[5]) * rr[5] * gg + bb); v.w = pk2((bflo(v.w) - mm[6]) * rr[6] * gg + bb, (bfhi(v.w) - mm[7]) * rr[7] * gg + bb);
                *(LAS u32x4*)(VT + d * 136 + c8 * 8) = v; } }
        if (u + G < 4 * 32 * 4) { const int un = u + G, gn = un & 3, ccn = (un >> 2) & 31, bln = un >> 7;
#pragma unroll
            for (int rep = 0; rep < 8; ++rep) x[rep] = *(const u32x4*)(ZT + (size_t)(1024 + gn * 256 + dq + 32 * rep) * ZTLD + bln * SEQ + ccn * 128 + c8 * 8); }
        __syncthreads();
        {
            const int r = lane & 31, hh = lane >> 5, d0 = 32 * wave;
            u32x2 uu[4][4];
#pragma unroll
            for (int tb = 0; tb < 4; ++tb)
#pragma unroll
                for (int q = 0; q < 4; ++q) uu[tb][q] = *(const u32x2*)(Zb + (size_t)(tokl + 32 * tb + r) * ZLD + ZC_U + g * 256 + d0 + 4 * hh + 8 * q);
            f32x16 acc[4];
#pragma unroll
            for (int tb = 0; tb < 4; ++tb)
#pragma unroll
                for (int e = 0; e < 16; ++e) acc[tb][e] = 0.f;
#pragma unroll
            for (int ks = 0; ks < 8; ++ks) { const bf16x8 af = *(const LAS bf16x8*)(VT + (d0 + r) * 136 + 16 * ks + 8 * hh);
#pragma unroll
                for (int tb = 0; tb < 4; ++tb) if (16 * ks <= 32 * tb + 31) { const bf16x8 bfv = *(const LAS bf16x8*)(WS_ + (32 * tb + r) * 136 + 16 * ks + 8 * hh);
                    acc[tb] = __builtin_amdgcn_mfma_f32_32x32x16_bf16(af, bfv, acc[tb], 0, 0, 0); } }
#pragma unroll
            for (int tb = 0; tb < 4; ++tb) { const int t = 32 * tb + r; const float bias = bs[g * 128 + t]; bf16* rowp = Zb + (size_t)(tokl + t) * ZLD + out_col + g * 256 + d0 + 4 * hh;
#pragma unroll
                for (int q = 0; q < 4; ++q) { const u32x2 v = uu[tb][q]; u32x2 w;
                    w.x = pk2(bflo(v.x) * (acc[tb][4 * q] + bias), bfhi(v.x) * (acc[tb][4 * q + 1] + bias)); w.y = pk2(bflo(v.y) * (acc[tb][4 * q + 2] + bias), bfhi(v.y) * (acc[tb][4 * q + 3] + bias)); *(u32x2*)(rowp + 8 * q) = w; } }
        }
        __syncthreads();
    }
}

__device__ __forceinline__ void softmax_rows(unsigned char* ws, int gw, int NGW, int lane) {
    bf16* Zb = (bf16*)(ws + WS_Z);
    for (int m = gw; m < MH; m += NGW) {
        u32x4* p = (u32x4*)(Zb + (size_t)m * ZLD + ZC_XQ + 16 * lane); const u32x4 x0 = p[0], x1 = p[1];
        float v[16] = { bflo(x0.x), bfhi(x0.x), bflo(x0.y), bfhi(x0.y), bflo(x0.z), bfhi(x0.z), bflo(x0.w), bfhi(x0.w), bflo(x1.x), bfhi(x1.x), bflo(x1.y), bfhi(x1.y), bflo(x1.z), bfhi(x1.z), bflo(x1.w), bfhi(x1.w) };
        float mx = v[0];
#pragma unroll
        for (int e = 1; e < 16; ++e) mx = fmaxf(mx, v[e]);
#pragma unroll
        for (int o = 1; o < 16; o <<= 1) mx = fmaxf(mx, shx(mx, o, lane));
        float s = 0.f;
#pragma unroll
        for (int e = 0; e < 16; ++e) { v[e] = __expf(v[e] - mx); s += v[e]; }
#pragma unroll
        for (int o = 1; o < 16; o <<= 1) s += shx(s, o, lane);
        const float inv = 1.f / s;
        u32x4 y0, y1; y0.x = pk2(v[0] * inv, v[1] * inv); y0.y = pk2(v[2] * inv, v[3] * inv); y0.z = pk2(v[4] * inv, v[5] * inv); y0.w = pk2(v[6] * inv, v[7] * inv);
        y1.x = pk2(v[8] * inv, v[9] * inv); y1.y = pk2(v[10] * inv, v[11] * inv); y1.z = pk2(v[12] * inv, v[13] * inv); y1.w = pk2(v[14] * inv, v[15] * inv);
        p[0] = y0; p[1] = y1;
    }
}

__global__ void __launch_bounds__(NTHR, 2) trunk_fwd(Args args) {
    extern __shared__ __attribute__((aligned(16))) unsigned char lds_raw[];
    LAS unsigned char* lds = (LAS unsigned char*)lds_raw;
    volatile LAS unsigned* MISC = (volatile LAS unsigned*)(lds + MISC_OFF);
    const int G = gridDim.x, cu = blockIdx.x;
    unsigned char* ws = args.ws;
#define PHASE_IDS() int tid = threadIdx.x; asm volatile("" : "+v"(tid)); const int lane = tid & 63, wave = __builtin_amdgcn_readfirstlane(tid >> 6); \
    const int vcu = (G % 8 == 0) ? (cu % 8) * (G / 8) + cu / 8 : cu; const int gw = vcu * NWAVES + wave, NGW = G * NWAVES, gtid = cu * NTHR + tid, GT = G * NTHR; (void)gw; (void)NGW; (void)gtid; (void)GT; (void)lane
    for (int u = threadIdx.x; u < (LDS_BYTES - RING_BYTES) / 4; u += NTHR) ((LAS unsigned*)(lds + RING_BYTES))[u] = 0u;
    __syncthreads();
    XcdBarrier bar = xcd_barrier_post((unsigned*)(ws + WS_CTL) + 4096, MISC + 8);
    const int lo = args.ph_lo, hi = args.ph_hi;
    int ph = 0;
#define IN() (lo <= ph && ph < hi)
#define SEAM() do { if (lo <= ph && ph + 1 < hi) xcd_barrier(bar); ++ph; } while (0)
    bf16* XN = (bf16*)(ws + WS_XN); bf16* Wb = (bf16*)(ws + WS_W); float* RSTD = (float*)(ws + WS_RSTD);
    float* hbuf = args.out;

    if (IN()) { PHASE_IDS();
        convert_layer(args, 0, ws, lds, gw, NGW, wave, lane, gtid, GT);
        thin_rows(nullptr, 0, nullptr, 0.f, args.in[I_X], nullptr, XN, RSTD, nullptr, 0, M, gw, NGW, lane, false, nullptr, nullptr, nullptr, nullptr, nullptr);
        __syncthreads();
    }
    SEAM();

    for (int sb = 0; sb < 2 * DEPTH; ++sb) {
        const int l = sb >> 1, j = sb & 1;
        const float* ng = args.in[I_NORMG] + (size_t)l * NNORM * D;
        if (IN()) { PHASE_IDS();
            pg8::Gemm g{D, D, D}; pg8::TileSched S; S.init(M / 256, 2 * DFF / 256, G, cu, XN, D * 2, (char*)Wb + (j ? WO_GU1 : WO_GU0), D * 2);
            pg8::EpiGU E{(bf16*)(ws + WS_HID), RSTD};
            pg8::gemm_phase(lds, g, S, E, tid);
        }
        SEAM();
        if (IN()) { PHASE_IDS();
            pg8::Gemm g{DFF, DFF, DFF}; pg8::TileSched S; S.init(M / 256, D / 256, G, cu, ws + WS_HID, DFF * 2, (char*)Wb + (j ? WO_D1 : WO_D0), DFF * 2);
            pg8::EpiAct E{(bf16*)(ws + WS_F), (size_t)D, 0, nullptr, nullptr};
            pg8::gemm_phase(lds, g, S, E, tid);
        }
        SEAM();
        if (IN()) { PHASE_IDS();
            const float* hin = (sb == 0) ? args.in[I_X] : hbuf;
            if (j == 0) {
                LAS float* wif = (LAS float*)lds;
                for (int e = tid; e < D * 8 / 4; e += NTHR) ((LAS f32x4*)wif)[e] = ((const f32x4*)(ws + WS_WIF))[e];
                __syncthreads();
                float* gi = (float*)(ws + WS_GATE);
                const float* hx = (sb == 0) ? args.in[I_X] : nullptr;
                if (G == 256) {
                    const bool kvcu = (cu < 32) || (cu >= 128 && cu < 160);
                    if (kvcu) { const int gwk = ((cu < 32) ? cu : cu - 96) * NWAVES + wave;
                        thin_rows((const bf16*)(ws + WS_F), D, ng + 1 * D, 0.5f, hx, XN, XN, RSTD, nullptr, 0, 3072, gwk, 512, lane, true, wif, args.in[I_BI] + l * 4, args.in[I_BF] + l * 4, gi, gi + (size_t)M * 4); }
                    else { const int cun = (cu < 128) ? cu - 32 : cu - 64; const int gwn = cun * NWAVES + wave;
                        thin_rows((const bf16*)(ws + WS_F) + (size_t)3072 * D, D, ng + 1 * D, 0.5f, hx, XN, XN, RSTD, nullptr, 3072, M, gwn, 1536, lane, true, wif, args.in[I_BI] + l * 4, args.in[I_BF] + l * 4, gi, gi + (size_t)M * 4); }
                } else
                thin_rows((const bf16*)(ws + WS_F), D, ng + 1 * D, 0.5f, hx, XN, XN, RSTD, nullptr, 0, M, gw, NGW, lane, true, wif, args.in[I_BI] + l * 4, args.in[I_BF] + l * 4, gi, gi + (size_t)M * 4);
                __syncthreads();
                {
                    pg8::Gemm g{D, D, D};
                    pg8::TileSched S; S.init(MMEM / 256, D / 256, G, cu, ws + WS_MEMN, D * 2, (char*)Wb + WO_MKV, D * 2);
                    pg8::EpiAct E{(bf16*)(ws + WS_KMEM), (size_t)D, 0, nullptr, nullptr};
                    pg8::gemm_phase(lds, g, S, E, tid);
                    pg8::TileSched S2; S2.init(D / 256, MMEM / 256, G, (cu + G / 2) % G, (char*)Wb + WO_MKV + (size_t)D * D * 2, D * 2, ws + WS_MEMN, D * 2);
                    pg8::EpiAct E2{(bf16*)(ws + WS_VTMEM), (size_t)MMEM, 0, nullptr, nullptr};
                    pg8::gemm_phase(lds, g, S2, E2, tid);
                }
            } else {
                const bool lastl = (l + 1 == DEPTH);
                thin_rows((const bf16*)(ws + WS_F), D, ng + 5 * D, 0.5f, nullptr, XN, lastl ? nullptr : XN, RSTD, lastl ? hbuf : nullptr, 0, M, gw, NGW, lane, false, nullptr, nullptr, nullptr, nullptr, nullptr);
                if (l + 1 < DEPTH) { __syncthreads(); convert_layer(args, l + 1, ws, lds, gw, NGW, wave, lane, gtid, GT); __syncthreads(); }
            }
        }
        SEAM();
        if (j == 0) {
            for (int hf = 0; hf < 2; ++hf) {
                bf16* Zb = (bf16*)(ws + WS_Z);
                if (IN()) { PHASE_IDS();
                    if (hf == 1) { thin_rows((const bf16*)(ws + WS_ST), D, ng + 3 * D, 1.0f, nullptr, XN, XN, RSTD, nullptr, 0, MH, gw, NGW, lane, false, nullptr, nullptr, nullptr, nullptr, nullptr); __syncthreads(); }
                    pg8::Gemm g{D, D, D};
                    pg8::TileSched S; S.init(MH / 256, ZLD / 256, G, cu, XN + (size_t)hf * MH * D, D * 2, (char*)Wb + WO_IN, D * 2);
                    pg8::EpiAct E{Zb, (size_t)ZLD, 1, RSTD + (size_t)hf * MH, nullptr};
                    pg8::gemm_phase(lds, g, S, E, tid);
                    pg8::TileSched S2; S2.init(2048 / 256, MH / 256, G, cu, (char*)Wb + WO_IN + (size_t)ZLD * D * 2, D * 2, XN + (size_t)hf * MH * D, D * 2);
                    pg8::EpiAct E2{(bf16*)(ws + WS_ZT), (size_t)ZTLD, 2, nullptr, RSTD + (size_t)hf * MH};
                    pg8::gemm_phase(lds, g, S2, E2, tid);
                }
                SEAM();
                if (IN()) { PHASE_IDS();
                    mlstm_s1(args, l, hf, ws, lds, G, cu, tid, wave, lane);
                    sgu_phase(args, l, ws, lds, G, cu, tid, wave, lane, ZC_U);
                    pg8::Gemm g{256, ZLD, D};
                    pg8::TileSched S; S.init(MH / 256, 4, G, cu, Zb + ZC_XQ, ZLD * 2, (bf16*)(ws + WS_KMEM) + (size_t)hf * 4 * MEMLEN * D, 0);
                    S.a_pn = 512; S.b_tile = 512; S.pm_per_b = 16; S.b_batch = (size_t)MEMLEN * D * 2;
                    pg8::EpiAct E{Zb + ZC_XQ, (size_t)ZLD, 0, nullptr, nullptr};
                    pg8::gemm_phase(lds, g, S, E, tid);
                    for (int i = 0; ; ++i) { pg8::Unit uu; if (!S.next(i, uu)) break;
                        bf16* tb_ = Zb + (size_t)(uu.pm * 256 + wave * 32 + (lane >> 4)) * ZLD + ZC_XQ + uu.pn * 256 + 16 * (lane & 15);
                        for (int r0 = 0; r0 < 32; r0 += 16) {
                            unsigned long long w[4][4];
#pragma unroll
                            for (int q = 0; q < 4; ++q) { unsigned long long* p = (unsigned long long*)(tb_ + (size_t)(r0 + 4 * q) * ZLD);
#pragma unroll
                                for (int e = 0; e < 4; ++e) w[q][e] = __hip_atomic_load(p + e, __ATOMIC_RELAXED, __HIP_MEMORY_SCOPE_AGENT); }
#pragma unroll
                            for (int q = 0; q < 4; ++q) { float v[16];
#pragma unroll
                                for (int e = 0; e < 4; ++e) { const unsigned lo_ = (unsigned)w[q][e], hi_ = (unsigned)(w[q][e] >> 32); v[4 * e] = bflo(lo_); v[4 * e + 1] = bfhi(lo_); v[4 * e + 2] = bflo(hi_); v[4 * e + 3] = bfhi(hi_); }
                                float mx = v[0];
#pragma unroll
                                for (int e = 1; e < 16; ++e) mx = fmaxf(mx, v[e]);
                                mx = row16_max(mx);
                                float sm = 0.f;
#pragma unroll
                                for (int e = 0; e < 16; ++e) { v[e] = __expf(v[e] - mx); sm += v[e]; }
                                sm = row16_sum(sm);
                                const float inv = __builtin_amdgcn_rcpf(sm);
                                u32x4* po = (u32x4*)(tb_ + (size_t)(r0 + 4 * q) * ZLD); u32x4 y0, y1;
                                y0.x = pk2(v[0] * inv, v[1] * inv); y0.y = pk2(v[2] * inv, v[3] * inv); y0.z = pk2(v[4] * inv, v[5] * inv); y0.w = pk2(v[6] * inv, v[7] * inv);
                                y1.x = pk2(v[8] * inv, v[9] * inv); y1.y = pk2(v[10] * inv, v[11] * inv); y1.z = pk2(v[12] * inv, v[13] * inv); y1.w = pk2(v[14] * inv, v[15] * inv);
                                po[0] = y0; po[1] = y1; } } }
                }
                SEAM();
                if (IN()) { PHASE_IDS();
                    mlstm_s2(ws, G, cu, tid);
                }
                SEAM();
                if (IN()) { PHASE_IDS();
                    mlstm_s3(args, l, hf, ws, lds, G, cu, tid, wave, lane, ZC_O);
#ifdef PROBE_S3
                    for (int rep_ = 0; rep_ < 2; ++rep_) mlstm_s3(args, l, hf, ws, lds, G, cu, tid, wave, lane, ZC_QK);
#endif
#ifdef PROBE_SGU
                    for (int rep_ = 0; rep_ < 2; ++rep_) sgu_phase(args, l, ws, lds, G, cu, tid, wave, lane, ZC_QK);
#endif
                    pg8::Gemm g{256, ZLD, MMEM};
                    pg8::TileSched S; S.init(MH / 256, 4, G, cu, Zb + ZC_XQ, ZLD * 2, (bf16*)(ws + WS_VTMEM) + (size_t)hf * 4 * MEMLEN, 0);
                    S.a_pn = 512; S.b_tile = (size_t)256 * MMEM * 2; S.pm_per_b = 16; S.b_batch = (size_t)MEMLEN * 2;
                    pg8::EpiAct E{Zb + ZC_XQ, (size_t)ZLD, 0, nullptr, nullptr};
                    pg8::gemm_phase(lds, g, S, E, tid);
                }
                SEAM();
                if (IN()) { PHASE_IDS();
                    pg8::Gemm g{D, ZLD, D};
                    pg8::TileSched S; S.init(MH / 256, D / 256, G, cu, Zb + ZC_O, ZLD * 2, (char*)Wb + WO_BR, D * 2);
                    S.reps = 3; S.a_rep = 1024 * 2; S.b_rep = (size_t)D * D * 2;
                    pg8::EpiBranch E{Zb};
                    pg8::gemm_phase(lds, g, S, E, tid);
                }
                SEAM();
                if (IN()) { PHASE_IDS();
                    pg8::Gemm g{D, ZLD, D};
                    pg8::TileSched S; S.init(MH / 256, D / 256, G, cu, Zb + ZC_QK, ZLD * 2, (char*)Wb + WO_OUT, D * 2);
                    pg8::EpiAct E{(hf == 0) ? (bf16*)(ws + WS_ST) : Zb + ZC_O, (hf == 0) ? (size_t)D : (size_t)ZLD, 0, nullptr, nullptr};
                    pg8::gemm_phase(lds, g, S, E, tid);
                }
                SEAM();
                if (hf == 1) {
                if (IN()) { PHASE_IDS();
                    thin_rows(Zb + ZC_O, ZLD, ng + 3 * D, 1.0f, nullptr, XN, XN, RSTD, nullptr, hf * MH, (hf + 1) * MH, gw, NGW, lane, false, nullptr, nullptr, nullptr, nullptr, nullptr);
                }
                SEAM();
                }
            }
        }
    }
#undef IN
#undef SEAM
}
constexpr int N_PHASES = 1 + 2 * DEPTH * 3 + DEPTH * (2 * 7 - 1);

#ifndef N_LAUNCH_MODE
#define N_LAUNCH_MODE 0
#endif
extern "C" void kernel_launch(void* const* d_in, const int* in_sizes, int n_in, void* d_out, int out_size, void* d_ws, size_t ws_size, hipStream_t stream) {
    static int grid = 0;
    if (grid == 0) {
        if (n_in != 18 || out_size != M * D || ws_size < WS_END) { fprintf(stderr, "kernel_launch: unexpected shapes (n_in %d out %d ws %zu)\n", n_in, out_size, ws_size); grid = -1; return; }
        int dev = 0, cus = 0, per_cu = 0;
        if (hipGetDevice(&dev) != hipSuccess || hipDeviceGetAttribute(&cus, hipDeviceAttributeMultiprocessorCount, dev) != hipSuccess) { grid = -1; return; }
        if (hipFuncSetAttribute((const void*)trunk_fwd, hipFuncAttributeMaxDynamicSharedMemorySize, LDS_BYTES) != hipSuccess) { grid = -1; return; }
        if (hipOccupancyMaxActiveBlocksPerMultiprocessor(&per_cu, (const void*)trunk_fwd, NTHR, LDS_BYTES) != hipSuccess || per_cu < 1) { fprintf(stderr, "kernel_launch: occupancy query says %d\n", per_cu); }
        (void)hipGetLastError();
        grid = cus;
    }
    if (grid < 0) return;
    (void)hipMemsetAsync((char*)d_ws + WS_CTL, 0, CTL_ZERO_BYTES, stream);
    Args a{};
    for (int i = 0; i < 18; ++i) a.in[i] = (const float*)d_in[i];
    a.out = (float*)d_out; a.ws = (unsigned char*)d_ws;
#if N_LAUNCH_MODE == 0
    a.ph_lo = 0; a.ph_hi = N_PHASES;
    hipLaunchKernelGGL(trunk_fwd, dim3(grid), dim3(NTHR), LDS_BYTES, stream, a);
#else
    for (int p = 0; p < N_PHASES; ++p) { a.ph_lo = p; a.ph_hi = p + 1; hipLaunchKernelGGL(trunk_fwd, dim3(grid), dim3(NTHR), LDS_BYTES, stream, a); }
#endif
}
```

```cpp
#include <hip/hip_runtime.h>
#include <cstdio>
#include <cstdint>

#define LAS __attribute__((address_space(3)))
#define GAS __attribute__((address_space(1)))
typedef unsigned short bf16;
typedef short bf16x8 __attribute__((ext_vector_type(8)));
typedef float f32x4 __attribute__((ext_vector_type(4)));
typedef float f32x16 __attribute__((ext_vector_type(16)));
typedef unsigned u32x4 __attribute__((ext_vector_type(4)));
typedef unsigned u32x2 __attribute__((ext_vector_type(2)));

constexpr int D = 1024, BATCH = 8, SEQ = 4096, DEPTH = 2, MEMLEN = 256, DFF = 2816, NNORM = 7;
constexpr int M = BATCH * SEQ, MH = M / 2, MMEM = BATCH * MEMLEN;
constexpr int WIN_COLS = 9224;
constexpr int LCH = 64, NCH = SEQ / LCH;
constexpr int ZLD = 7168;
constexpr int ZC_QK = 0, ZC_O = 1024, ZC_U = 2048, ZC_XQ = 3072, ZC_G = 4096;
constexpr int ZTLD = MH;
constexpr float EPS = 1e-6f;
constexpr int NWAVES = 8, NTHR = 512;

constexpr size_t MiB = 1u << 20;
constexpr size_t WS_CTL = 0, CTL_ZERO_BYTES = 32 * 1024;
constexpr size_t WS_WSGU = 1 * MiB;
constexpr size_t WS_GATE = 2 * MiB;
constexpr size_t WS_NST = 3 * MiB;
constexpr size_t WS_CSC = 4 * MiB;
constexpr size_t WS_MEMN = 5 * MiB;
constexpr size_t WS_KMEM = 9 * MiB;
constexpr size_t WS_VTMEM = 13 * MiB;
constexpr size_t WS_W = 17 * MiB;
constexpr size_t WO_GU0 = 0, WO_GU1 = 11 * MiB, WO_D0 = 22 * MiB, WO_D1 = WO_D0 + 5632 * 1024, WO_IN = 33 * MiB, WO_MKV = 51 * MiB, WO_BR = 55 * MiB, WO_OUT = 61 * MiB;
constexpr size_t WS_XN = 80 * MiB;
constexpr size_t WS_WIF = 4 * MiB + 256 * 1024;
constexpr size_t WS_RSTD = 4 * MiB + 512 * 1024;
constexpr size_t WS_BIG = 144 * MiB;
constexpr size_t WS_HID = WS_BIG, WS_F = WS_BIG + 176 * MiB, WS_Z = WS_BIG, WS_ZT = WS_BIG + 224 * MiB;
constexpr size_t WS_ST = 432 * MiB;
constexpr size_t WS_KC = 496 * MiB;
constexpr size_t WS_END = 512 * MiB;

constexpr int LDS_BYTES = 147456;
constexpr int RING_BYTES = 131072;
constexpr int MISC_OFF = RING_BYTES + 320;

typedef float f32x2_t __attribute__((ext_vector_type(2))); typedef __bf16 bf16x2_t __attribute__((ext_vector_type(2)));
__device__ __forceinline__ unsigned pk2(float lo, float hi) { f32x2_t v = {lo, hi}; bf16x2_t b = __builtin_convertvector(v, bf16x2_t); return __builtin_bit_cast(unsigned, b); }
__device__ __forceinline__ unsigned f2bf(float f) { return pk2(f, 0.f) & 0xffffu; }
__device__ __forceinline__ float bflo(unsigned w) { return __uint_as_float(w << 16); }
__device__ __forceinline__ float bfhi(unsigned w) { return __uint_as_float(w & 0xffff0000u); }
__device__ __forceinline__ float bf1(bf16 b) { return __uint_as_float((unsigned)b << 16); }
__device__ __forceinline__ float shx(float v, int mask, int lane) { return __builtin_bit_cast(float, __builtin_amdgcn_ds_bpermute((lane ^ mask) << 2, __builtin_bit_cast(int, v))); }
__device__ __forceinline__ float shidx(float v, int src) { return __builtin_bit_cast(float, __builtin_amdgcn_ds_bpermute(src << 2, __builtin_bit_cast(int, v))); }
#define DPP_XOR1 0xB1
#define DPP_XOR2 0x4E
#define DPP_HMIR 0x141
#define DPP_MIR  0x140
template <int CTRL> __device__ __forceinline__ float dppf(float v) { return __builtin_bit_cast(float, __builtin_amdgcn_mov_dpp(__builtin_bit_cast(int, v), CTRL, 0xF, 0xF, true)); }
__device__ __forceinline__ float row16_sum(float v) { v += dppf<DPP_XOR1>(v); v += dppf<DPP_XOR2>(v); v += dppf<DPP_HMIR>(v); v += dppf<DPP_MIR>(v); return v; }
__device__ __forceinline__ float row16_max(float v) { v = fmaxf(v, dppf<DPP_XOR1>(v)); v = fmaxf(v, dppf<DPP_XOR2>(v)); v = fmaxf(v, dppf<DPP_HMIR>(v)); v = fmaxf(v, dppf<DPP_MIR>(v)); return v; }
__device__ __forceinline__ float grp8_sum(float v) { v += dppf<DPP_XOR1>(v); v += dppf<DPP_XOR2>(v); v += dppf<DPP_HMIR>(v); return v; }
__device__ __forceinline__ float wave_sum(float v, int lane) { v = row16_sum(v); v += shx(v, 16, lane); v += shx(v, 32, lane); return v; }
__device__ __forceinline__ float sigmoidf_(float x) { return __builtin_amdgcn_rcpf(1.f + __expf(-x)); }
__device__ __forceinline__ float siluf_(float x) { return x * __builtin_amdgcn_rcpf(1.f + __expf(-x)); }
__device__ __forceinline__ float gelu_tanh(float x) { const float u = 1.5957691216f * (x + 0.044715f * x * x * x); return x * __builtin_amdgcn_rcpf(1.f + __expf(-u)); }
__device__ __forceinline__ float logsigmoidf_(float x) { return fminf(x, 0.f) - __logf(1.f + __expf(-fabsf(x))); }
#define LDS_WAIT() asm volatile("s_waitcnt lgkmcnt(0)" ::: "memory")
#define VM_WAIT() asm volatile("s_waitcnt vmcnt(0)" ::: "memory")

namespace pg8 {
constexpr int BM = 256, BK = 64, HALF = 128, HTB = HALF * BK * 2, STAGE_BYTES = 8 * HTB, NXCD = 8, WGM = 8;
__host__ __device__ __forceinline__ int lds_byte(int r, int c) { const int st = (r >> 4) * 2 + (c >> 5), rr = r & 15, cc = c & 31, ob = rr * 64 + cc * 2; return st * 1024 + (ob ^ (((ob >> 9) & 1) << 5)); }
__host__ __device__ __forceinline__ void stage_rc(int b, int& R, int& C) { const int st = b / 1024, sb = b % 1024, swz = sb ^ (((sb >> 9) & 1) << 5); R = (st >> 1) * 16 + swz / 64; C = (st & 1) * 32 + (swz % 64) / 2; }
__host__ __device__ __forceinline__ int perm32(int rho) { const int n = rho >> 4, i = rho & 15; return 8 * (i >> 2) + 4 * n + (i & 3); }

struct Unit { int pm, pn, aux; const char* a; const char* b; };
struct Gemm { int K, lda, ldb; };

struct TileSched {
    int nM, nN, nwg, G, c, reps, pm_per_b;
    const char* A; const char* B;
    size_t a_tile, a_pn, a_rep, b_tile, b_batch, b_rep;
    __device__ __forceinline__ void init(int nM_, int nN_, int G_, int c_, const void* A_, size_t lda_bytes, const void* B_, size_t ldb_bytes) {
        nM = nM_; nN = nN_; nwg = nM * nN; G = G_; c = c_; reps = 1; pm_per_b = 1 << 30; A = (const char*)A_; B = (const char*)B_;
        a_tile = 256 * lda_bytes; a_pn = 0; a_rep = 0; b_tile = 256 * ldb_bytes; b_batch = 0; b_rep = 0;
    }
    __device__ __forceinline__ bool next(int i, Unit& u) const {
        const int ti = i / reps, aux = i - ti * reps;
        const long L = (long)ti * G + c; if (L >= nwg) return false;
        int wgid = (int)L; { const int q = nwg / NXCD, r = nwg % NXCD, xcd = wgid % NXCD, off = wgid / NXCD; wgid = (xcd < r ? xcd * (q + 1) : r * (q + 1) + (xcd - r) * q) + off; }
        const int nig = WGM * nN, gid = wgid / nig, fm = gid * WGM, gsz = (nM - fm) < WGM ? (nM - fm) : WGM;
        u.pm = fm + ((wgid % nig) % gsz); u.pn = (wgid % nig) / gsz; u.aux = aux;
        u.a = A + (size_t)u.pm * a_tile + (size_t)u.pn * a_pn + (size_t)aux * a_rep;
        u.b = B + (size_t)u.pn * b_tile + (size_t)(u.pm / pm_per_b) * b_batch + (size_t)aux * b_rep;
        return true;
    }
};

__device__ __forceinline__ unsigned cvt_pk_bf16(float lo, float hi) { return pk2(lo, hi); }

__device__ __forceinline__ float gate_ratio(float zd, float zn, float nf) {
    const float ed = __expf(-fminf(fmaxf(zd, -60.f), 60.f)), en = __expf(-fminf(fmaxf(zn, -60.f), 60.f));
    return fmaf(en, nf, 1.f) * __builtin_amdgcn_rcpf(1.f + ed);
}
template <int ACT> __device__ __forceinline__ float actf(float x) {
    if (ACT == 1) return sigmoidf_(x);
    if (ACT == 2) return gelu_tanh(x);
    if (ACT == 3) return x * 0.0625f;
    return x;
}
template <int ACT> __device__ __forceinline__ void store_tile_bf16(const f32x4 (&acc)[2][2][4][2], bf16* O, size_t ldc, int row0, int col0, const float* rsrow, const float* rscol) {
    f32x4 cs[2][2];
#pragma unroll
    for (int bj = 0; bj < 2; ++bj)
#pragma unroll
        for (int n = 0; n < 2; ++n) cs[bj][n] = rscol ? *(const f32x4*)(rscol + col0 + bj * HALF + 4 * n) : (f32x4){1.f, 1.f, 1.f, 1.f};
#pragma unroll
    for (int ai = 0; ai < 2; ++ai)
#pragma unroll
        for (int m = 0; m < 4; ++m) { const int row = row0 + ai * HALF + m * 16; bf16* rowp = O + (size_t)row * ldc + col0; const float rr = rsrow ? rsrow[row] : 1.f;
#pragma unroll
            for (int bj = 0; bj < 2; ++bj) { const f32x4 v0 = acc[ai][bj][m][0] * cs[bj][0] * rr, v1 = acc[ai][bj][m][1] * cs[bj][1] * rr; u32x4 w;
                w.x = cvt_pk_bf16(actf<ACT>(v0[0]), actf<ACT>(v0[1])); w.y = cvt_pk_bf16(actf<ACT>(v0[2]), actf<ACT>(v0[3]));
                w.z = cvt_pk_bf16(actf<ACT>(v1[0]), actf<ACT>(v1[1])); w.w = cvt_pk_bf16(actf<ACT>(v1[2]), actf<ACT>(v1[3]));
                *(u32x4*)(rowp + bj * HALF) = w; } }
}
struct EpiAct {
    static constexpr bool PERM = true; static constexpr bool CHAIN = false;
    bf16* O; size_t ldc; int mode; const float* rsrow; const float* rscol;
    __device__ __forceinline__ void operator()(const f32x4 (&acc)[2][2][4][2], const Unit& u, int wr, int wc, int fr, int fq) const {
        const int row0 = u.pm * BM + wr * 64 + fr, col0 = u.pn * BM + wc * 32 + 8 * fq;
        int act = 0;
        if (mode == 1) { const int g = u.pn >> 2; act = (g == 0) ? 0 : (g == 1) ? 1 : (g == 2) ? 2 : (g == 3) ? 3 : 0; }
        else if (mode == 2) act = (u.pm >= 4) ? 2 : 0;
        if (act == 0) store_tile_bf16<0>(acc, O, ldc, row0, col0, rsrow, rscol);
        else if (act == 1) store_tile_bf16<1>(acc, O, ldc, row0, col0, rsrow, rscol);
        else if (act == 2) store_tile_bf16<2>(acc, O, ldc, row0, col0, rsrow, rscol);
        else store_tile_bf16<3>(acc, O, ldc, row0, col0, rsrow, rscol);
    }
};
struct EpiGU {
    static constexpr bool PERM = true; static constexpr bool CHAIN = false;
    bf16* O; const float* rsrow;
    __device__ __forceinline__ void operator()(const f32x4 (&acc)[2][2][4][2], const Unit& u, int wr, int wc, int fr, int fq) const {
        const int row0 = u.pm * BM + wr * 64 + fr, col0 = u.pn * HALF + wc * 32 + 8 * fq;
#pragma unroll
        for (int ai = 0; ai < 2; ++ai)
#pragma unroll
            for (int m = 0; m < 4; ++m) { const int row = row0 + ai * HALF + m * 16; bf16* rowp = O + (size_t)row * DFF + col0; const float rr = rsrow[row];
                const f32x4 g0 = acc[ai][0][m][0] * rr, g1 = acc[ai][0][m][1] * rr, u0 = acc[ai][1][m][0] * rr, u1 = acc[ai][1][m][1] * rr; u32x4 w;
                w.x = cvt_pk_bf16(siluf_(g0[0]) * u0[0], siluf_(g0[1]) * u0[1]); w.y = cvt_pk_bf16(siluf_(g0[2]) * u0[2], siluf_(g0[3]) * u0[3]);
                w.z = cvt_pk_bf16(siluf_(g1[0]) * u1[0], siluf_(g1[1]) * u1[1]); w.w = cvt_pk_bf16(siluf_(g1[2]) * u1[2], siluf_(g1[3]) * u1[3]);
                *(u32x4*)rowp = w; }
    }
};
struct EpiBranch {
    static constexpr bool PERM = true; static constexpr bool CHAIN = true;
    bf16* Zb;
    __device__ __forceinline__ void operator()(f32x4 (&acc)[2][2][4][2], const Unit& u, int wr, int wc, int fr, int fq) const {
        const int row0 = u.pm * BM + wr * 64 + fr, col0 = u.pn * BM + wc * 32 + 8 * fq; const int j = u.aux;
        bf16* base = Zb + (size_t)row0 * ZLD + col0;
        const bf16* gz = base + ZC_G + j * 1024; const bf16* gzn = gz + (j < 2 ? 1024 : 0); const float nf = (j < 2) ? 1.f : 0.f;
#pragma unroll
        for (int q = 0; q < 4; ++q) { const int ai = q >> 1, m0 = (q & 1) * 2;
            asm volatile("" ::: "memory");
            u32x4 za[2][2], zb[2][2];
#pragma unroll
            for (int m = 0; m < 2; ++m)
#pragma unroll
                for (int bj = 0; bj < 2; ++bj) za[m][bj] = *(const u32x4*)(gz + (size_t)(ai * HALF + (m0 + m) * 16) * ZLD + bj * HALF);
#pragma unroll
            for (int m = 0; m < 2; ++m)
#pragma unroll
                for (int bj = 0; bj < 2; ++bj) zb[m][bj] = *(const u32x4*)(gzn + (size_t)(ai * HALF + (m0 + m) * 16) * ZLD + bj * HALF);
#pragma unroll
            for (int m = 0; m < 2; ++m)
#pragma unroll
                for (int bj = 0; bj < 2; ++bj) { const u32x4 a = za[m][bj], b = zb[m][bj];
                    acc[ai][bj][m0 + m][0] = acc[ai][bj][m0 + m][0] * (f32x4){gate_ratio(bflo(a.x), bflo(b.x), nf), gate_ratio(bfhi(a.x), bfhi(b.x), nf), gate_ratio(bflo(a.y), bflo(b.y), nf), gate_ratio(bfhi(a.y), bfhi(b.y), nf)};
                    acc[ai][bj][m0 + m][1] = acc[ai][bj][m0 + m][1] * (f32x4){gate_ratio(bflo(a.z), bflo(b.z), nf), gate_ratio(bfhi(a.z), bfhi(b.z), nf), gate_ratio(bflo(a.w), bflo(b.w), nf), gate_ratio(bfhi(a.w), bfhi(b.w), nf)}; }
        }
        if (j == 2) {
#pragma unroll
            for (int ai = 0; ai < 2; ++ai)
#pragma unroll
                for (int m = 0; m < 4; ++m)
#pragma unroll
                    for (int bj = 0; bj < 2; ++bj) { const f32x4 v0 = acc[ai][bj][m][0], v1 = acc[ai][bj][m][1]; u32x4 w;
                        w.x = cvt_pk_bf16(v0[0], v0[1]); w.y = cvt_pk_bf16(v0[2], v0[3]); w.z = cvt_pk_bf16(v1[0], v1[1]); w.w = cvt_pk_bf16(v1[2], v1[3]);
                        *(u32x4*)(base + (size_t)(ai * HALF + m * 16) * ZLD + ZC_QK + bj * HALF) = w; }
        }
    }
};

template <class Epi, class Sched>
__device__ __forceinline__ void gemm_phase(LAS unsigned char* lds, const Gemm g, const Sched& S, const Epi& E, const int tid) {
    const int wid = __builtin_amdgcn_readfirstlane(tid >> 6), lane = tid & 63, wr = wid >> 2, wc = wid & 3, fr = lane & 15, fq = lane >> 4;
    const int nt = g.K / BK;
    unsigned voffA[2], voffB[2];
#pragma unroll
    for (int i = 0; i < 2; ++i) { int R, C; stage_rc(tid * 16 + i * 8192, R, C); const int Rb = Epi::PERM ? ((R & ~31) + perm32(R & 31)) : R;
        voffA[i] = (unsigned)(R * g.lda + C) * 2u; voffB[i] = (unsigned)(Rb * g.ldb + C) * 2u; }
    const size_t kstep = (size_t)(BK * 2);
    const size_t hstepA = (size_t)HALF * g.lda * 2, hstepB = (size_t)HALF * g.ldb * 2;
    const unsigned ldsw = (unsigned)wid * 1024u;
    const int aoff = lds_byte(wr * 64 + fr, fq * 8), boff = lds_byte(wc * 32 + fr, fq * 8);
#define PG8_SA(b, h) (((b) * 2 + (h)) * HTB)
#define PG8_SB(b, h) ((4 + (b) * 2 + (h)) * HTB)
#define PG8_STAGE(bufoff, gbase, voff) do { _Pragma("unroll") for (int _i = 0; _i < 2; ++_i) \
        __builtin_amdgcn_global_load_lds((const unsigned*)((const char*)(gbase) + (voff)[_i]), (LAS unsigned*)(lds + (bufoff) + ldsw + _i * 8192), 16, 0, 0); } while (0)
#define PG8_LDA(dst, b, h) do { _Pragma("unroll") for (int m = 0; m < 4; ++m) _Pragma("unroll") for (int k = 0; k < 2; ++k) dst[m][k] = *(const LAS bf16x8*)(lds + PG8_SA(b, h) + aoff + m * 2048 + k * 1024); } while (0)
#define PG8_LDB(dst, b, h) do { _Pragma("unroll") for (int n = 0; n < 2; ++n) _Pragma("unroll") for (int k = 0; k < 2; ++k) dst[n][k] = *(const LAS bf16x8*)(lds + PG8_SB(b, h) + boff + n * 2048 + k * 1024); } while (0)
#define PG8_MMA(ai, bj, At, Bt) do { __builtin_amdgcn_s_setprio(1); _Pragma("unroll") for (int m = 0; m < 4; ++m) _Pragma("unroll") for (int n = 0; n < 2; ++n) _Pragma("unroll") for (int k = 0; k < 2; ++k) \
        acc[ai][bj][m][n] = __builtin_amdgcn_mfma_f32_16x16x32_bf16(Bt[n][k], At[m][k], acc[ai][bj][m][n], 0, 0, 0); __builtin_amdgcn_s_setprio(0); } while (0)
#define PG8_WAIT_V(n) asm volatile("s_waitcnt vmcnt(" #n ")" ::: "memory")
#define PG8_WAIT_L(n) asm volatile("s_waitcnt lgkmcnt(" #n ")" ::: "memory")
#define PG8_BAR __builtin_amdgcn_s_barrier()
#define PG8_SCHED __builtin_amdgcn_sched_barrier(0)
    Unit cur, nxt; int ui = 0;
    if (!S.next(0, cur)) return;
    f32x4 acc[2][2][4][2];
#pragma unroll
    for (int a = 0; a < 2; ++a)
#pragma unroll
        for (int b = 0; b < 2; ++b)
#pragma unroll
            for (int m = 0; m < 4; ++m)
#pragma unroll
                for (int n = 0; n < 2; ++n) acc[a][b][m][n] = (f32x4){0.f, 0.f, 0.f, 0.f};
    bf16x8 At[4][2], B0[2][2], B1[2][2];
    const char* cA = cur.a; const char* cB = cur.b;
    PG8_STAGE(PG8_SB(0, 0), cB, voffB); PG8_STAGE(PG8_SB(0, 1), cB + hstepB, voffB); PG8_STAGE(PG8_SA(0, 0), cA, voffA); PG8_STAGE(PG8_SA(0, 1), cA + hstepA, voffA);
    if (wr == 1) PG8_BAR;
    PG8_WAIT_V(2); PG8_BAR;
    PG8_STAGE(PG8_SB(1, 0), cB + kstep, voffB); PG8_STAGE(PG8_SA(1, 0), cA + kstep, voffA); PG8_STAGE(PG8_SB(1, 1), cB + hstepB + kstep, voffB);
    PG8_WAIT_V(6); PG8_BAR;
    for (;;) {
        const bool has_next = S.next(ui + 1, nxt);
        const char* nA = has_next ? nxt.a : cA; const char* nB = has_next ? nxt.b : cB;
        for (int t = 0; t < nt; t += 2) {
            const bool last = (t == nt - 2);
            const char* a1 = cA + (size_t)(t + 1) * kstep;
            const char* a2 = last ? nA : cA + (size_t)(t + 2) * kstep; const char* b2 = last ? nB : cB + (size_t)(t + 2) * kstep;
            const char* a3 = a2 + kstep; const char* b3 = b2 + kstep;
            PG8_LDB(B0, 0, 0); PG8_LDB(B1, 0, 1); PG8_SCHED; PG8_LDA(At, 0, 0); PG8_STAGE(PG8_SA(1, 1), a1 + hstepA, voffA);
            PG8_WAIT_V(8); PG8_WAIT_L(0); PG8_BAR; PG8_MMA(0, 0, At, B0); PG8_MMA(0, 1, At, B1); PG8_BAR; PG8_SCHED;
            PG8_LDA(At, 0, 1); PG8_STAGE(PG8_SB(0, 0), b2, voffB); PG8_STAGE(PG8_SB(0, 1), b2 + hstepB, voffB); PG8_STAGE(PG8_SA(0, 0), a2, voffA);
            PG8_WAIT_V(8); PG8_WAIT_L(0); PG8_BAR; PG8_MMA(1, 0, At, B0); PG8_MMA(1, 1, At, B1); PG8_BAR; PG8_SCHED;
            PG8_LDB(B0, 1, 0); PG8_LDB(B1, 1, 1); PG8_SCHED; PG8_LDA(At, 1, 0); PG8_STAGE(PG8_SA(0, 1), a2 + hstepA, voffA);
            PG8_WAIT_V(8); PG8_WAIT_L(0); PG8_BAR; PG8_MMA(0, 0, At, B0); PG8_MMA(0, 1, At, B1); PG8_BAR; PG8_SCHED;
            PG8_LDA(At, 1, 1); PG8_STAGE(PG8_SB(1, 0), b3, voffB); PG8_STAGE(PG8_SB(1, 1), b3 + hstepB, voffB); PG8_STAGE(PG8_SA(1, 0), a3, voffA);
            PG8_WAIT_V(8); PG8_WAIT_L(0); PG8_BAR; PG8_MMA(1, 0, At, B0); PG8_MMA(1, 1, At, B1); PG8_BAR; PG8_SCHED;
        }
        if (wr == 0) PG8_BAR;
        E(acc, cur, wr, wc, fr, fq);
        if (!has_next) break;
        if (!Epi::CHAIN || nxt.aux == 0)
#pragma unroll
        for (int a = 0; a < 2; ++a)
#pragma unroll
            for (int b = 0; b < 2; ++b)
#pragma unroll
                for (int m = 0; m < 4; ++m)
#pragma unroll
                    for (int n = 0; n < 2; ++n) acc[a][b][m][n] = (f32x4){0.f, 0.f, 0.f, 0.f};
        cur = nxt; cA = nA; cB = nB; ++ui;
        if (wr == 1) PG8_BAR;
    }
    PG8_WAIT_V(0);
    PG8_BAR;
#undef PG8_SA
#undef PG8_SB
#undef PG8_STAGE
#undef PG8_LDA
#undef PG8_LDB
#undef PG8_MMA
#undef PG8_WAIT_V
#undef PG8_WAIT_L
#undef PG8_BAR
#undef PG8_SCHED
}
}

#define XB_TMO      128
#define XB_XCNT(j)  (256  + 64 * (j))
#define XB_XSUB(j)  (1280 + 64 * (j))
#define XB_XGEN(j)  (2304 + 64 * (j))
#define XB_TOP      3328
#define XB_TOPGEN   3392
#define XCD_BAR_WORDS 3456
#define XB_SPIN_CAP (1u << 18)
__device__ __forceinline__ unsigned xb_ld(unsigned* p)              { return __hip_atomic_load(p, __ATOMIC_RELAXED, __HIP_MEMORY_SCOPE_AGENT); }
__device__ __forceinline__ unsigned xb_add(unsigned* p, unsigned v) { return __hip_atomic_fetch_add(p, v, __ATOMIC_RELAXED, __HIP_MEMORY_SCOPE_AGENT); }
__device__ __forceinline__ unsigned xb_xcc_id() { return (unsigned)__builtin_amdgcn_s_getreg((3 << 11) | 20) & 0xFu; }
#define XB_SPIN(cond, bar) do { unsigned _sp = 0; while (cond) { __builtin_amdgcn_s_sleep(1); \
    if ((++_sp & 255u) == 0u) { if (xb_ld(&(bar)[XB_TMO])) break; if (_sp > XB_SPIN_CAP) { atomicAdd(&(bar)[XB_TMO], 1u); break; } } } } while (0)
struct XcdBarrier { unsigned* bar; unsigned x; volatile LAS unsigned* st; };
__device__ __forceinline__ XcdBarrier xcd_barrier_post(unsigned* bar, volatile LAS unsigned* st) {
    XcdBarrier b; b.bar = bar; b.x = xb_xcc_id(); b.st = st;
    if (threadIdx.x == 0) (void)xb_add(&bar[XB_XCNT(b.x)], 1u);
    return b;
}
__device__ __forceinline__ void xcd_barrier_complete(unsigned* bar, unsigned x, unsigned& nloc, unsigned& nx) {
    const unsigned G = gridDim.x * gridDim.y * gridDim.z;
    unsigned sum, cnt, mine, sp = 0u;
    for (;;) {
        sum = 0u; cnt = 0u; mine = 0u;
#pragma unroll
        for (unsigned j = 0; j < 16; ++j) { const unsigned c = xb_ld(&bar[XB_XCNT(j)]); sum += c; cnt += (c > 0u) ? 1u : 0u; mine = (j == x) ? c : mine; }
        if (sum == G) break;
        __builtin_amdgcn_s_sleep(1);
        if ((++sp & 255u) == 0u) { if (xb_ld(&bar[XB_TMO])) break; if (sp > XB_SPIN_CAP) { atomicAdd(&bar[XB_TMO], 1u); break; } }
    }
    nloc = mine > 0u ? mine : 1u; nx = cnt > 0u ? cnt : 1u;
}
__device__ __forceinline__ void xcd_barrier(const XcdBarrier& b) {
    asm volatile("s_waitcnt vmcnt(0)" ::: "memory");
    __syncthreads();
    if (threadIdx.x == 0) {
        unsigned* bar = b.bar;
        __builtin_amdgcn_s_waitcnt(0);
        unsigned nloc = b.st[0], nx = b.st[1];
        if (nloc == 0u) { xcd_barrier_complete(bar, b.x, nloc, nx); b.st[0] = nloc; b.st[1] = nx; }
        const unsigned old = xb_add(&bar[XB_XSUB(b.x)], 1u);
        const unsigned gen = old / nloc;
        if (old + 1u == (gen + 1u) * nloc) {
            __builtin_amdgcn_fence(__ATOMIC_RELEASE, "agent");
            asm volatile("s_waitcnt vmcnt(0)" ::: "memory");
            const unsigned og = xb_add(&bar[XB_TOP], 1u);
            const unsigned tg = og / nx;
            if (og + 1u == (tg + 1u) * nx) xb_add(&bar[XB_TOPGEN], 1u);
            else XB_SPIN(xb_ld(&bar[XB_TOPGEN]) == tg, bar);
            __builtin_amdgcn_fence(__ATOMIC_ACQUIRE, "agent");
            xb_add(&bar[XB_XGEN(b.x)], 1u);
            asm volatile("s_waitcnt vmcnt(0)" ::: "memory");
        } else {
            XB_SPIN(xb_ld(&bar[XB_XGEN(b.x)]) == gen, bar);
            __builtin_amdgcn_fence(__ATOMIC_ACQUIRE, "agent");
            asm volatile("s_waitcnt vmcnt(0)" ::: "memory");
        }
    }
    __syncthreads();
}

struct Args { const float* in[18]; float* out; unsigned char* ws; int ph_lo, ph_hi; };
enum { I_X = 0, I_MEM, I_NORMG, I_WGU, I_WDOWN, I_WIN, I_CONVW, I_CONVB, I_BI, I_BF, I_MNORM, I_SLNG, I_SLNB, I_SWS, I_SBS, I_WMKV, I_WBR, I_WOUT };

struct CvtItem { const float* W; bf16* WT; int gsel, Nsrc, K, srccol, dstrow, kb; };
__device__ __forceinline__ void cvt_load(const CvtItem& d, int lane, f32x4 (&x)[8]) {
    const int c4 = (lane & 7) * 4, rr = lane >> 3, k0 = 64 * d.kb;
#pragma unroll
    for (int i = 0; i < 8; ++i) { const int kk = 8 * i + rr; x[i] = *(const f32x4*)(d.W + (size_t)(k0 + kk) * d.Nsrc + d.srccol + c4); }
}
__device__ __forceinline__ void cvt_finish(const CvtItem& d, int lane, const f32x4 (&x)[8], LAS float* scr, LAS unsigned char* lds) {
    const int c4 = (lane & 7) * 4, rr = lane >> 3, k0 = 64 * d.kb;
    const LAS float* gl = (const LAS float*)(lds + (d.gsel < 0 ? 0 : d.gsel) * 16384 + 8448);
#pragma unroll
    for (int i = 0; i < 8; ++i) { const int kk = 8 * i + rr; const float g = d.gsel < 0 ? 1.f : gl[k0 + kk]; const f32x4 v = x[i] * g; LAS float* p = scr + kk * 33 + c4; p[0] = v.x; p[1] = v.y; p[2] = v.z; p[3] = v.w; }
    LDS_WAIT(); asm volatile("" ::: "memory");
    const int c = lane & 7;
#pragma unroll
    for (int j = 0; j < 4; ++j) { const int n = (lane >> 3) + 8 * j; const LAS float* s = scr + (8 * c) * 33 + n;
        u32x4 o; o.x = pk2(s[0 * 33], s[1 * 33]); o.y = pk2(s[2 * 33], s[3 * 33]); o.z = pk2(s[4 * 33], s[5 * 33]); o.w = pk2(s[6 * 33], s[7 * 33]);
        *(u32x4*)(d.WT + (size_t)(d.dstrow + n) * d.K + k0 + 8 * c) = o; }
    LDS_WAIT(); asm volatile("" ::: "memory");
}
__device__ __forceinline__ int win_srccol(int r) {
    if (r < 1024) return r;
    if (r < 2048) return 2048 + (r - 1024);
    if (r < 3072) return 3080 + (r - 2048);
    if (r < 4096) return 5128 + (r - 3072);
    if (r < 7168) return 6152 + (r - 4096);
    if (r < 8192) return 1024 + (r - 7168);
    return 4104 + (r - 8192);
}
__device__ __forceinline__ void cvt_item_of(const Args& a, const int l, bf16* Wb, const int it, CvtItem& d) {
    constexpr int I_GU = 16 * 176, I_DN = 44 * 32, I_IN = 16 * 288, I_MKV = 16 * 64, I_BR = 16 * 32;
    int r = it; d.gsel = -1;
    if (r < 2 * I_GU) { const int j = r / I_GU; r -= j * I_GU; const int kb = r / 176, nb = r % 176; const int p = nb >> 3, q = nb & 7, s_ = q >> 2, jj = (q & 3) * 32;
        d.W = a.in[I_WGU] + (size_t)(l * 2 + j) * D * 2 * DFF; d.Nsrc = 2 * DFF; d.K = D; d.srccol = s_ * DFF + 128 * p + jj; d.WT = (bf16*)((char*)Wb + (j ? WO_GU1 : WO_GU0)); d.dstrow = nb * 32; d.kb = kb;
        d.gsel = j; return; }
    r -= 2 * I_GU;
    if (r < 2 * I_DN) { const int j = r / I_DN; r -= j * I_DN; d.W = a.in[I_WDOWN] + (size_t)(l * 2 + j) * DFF * D; d.Nsrc = D; d.K = DFF; d.srccol = (r % 32) * 32; d.WT = (bf16*)((char*)Wb + (j ? WO_D1 : WO_D0)); d.dstrow = (r % 32) * 32; d.kb = r / 32; return; }
    r -= 2 * I_DN;
    if (r < I_IN) { const int kb = r / 288, nb = r % 288; d.W = a.in[I_WIN] + (size_t)l * D * WIN_COLS; d.Nsrc = WIN_COLS; d.K = D; d.srccol = win_srccol(nb * 32); d.WT = (bf16*)((char*)Wb + WO_IN); d.dstrow = nb * 32; d.kb = kb;
        d.gsel = 2; return; }
    r -= I_IN;
    if (r < I_MKV) { d.W = a.in[I_WMKV] + (size_t)l * D * 2048; d.Nsrc = 2048; d.K = D; d.srccol = (r % 64) * 32; d.WT = (bf16*)((char*)Wb + WO_MKV); d.dstrow = (r % 64) * 32; d.kb = r / 64; return; }
    r -= I_MKV;
    if (r < 3 * I_BR) { const int j = r / I_BR; r -= j * I_BR; d.W = a.in[I_WBR] + (size_t)(l * 3 + j) * D * D; d.Nsrc = D; d.K = D; d.srccol = (r % 32) * 32; d.WT = (bf16*)((char*)Wb + WO_BR) + (size_t)j * D * D; d.dstrow = (r % 32) * 32; d.kb = r / 32; return; }
    r -= 3 * I_BR;
    d.W = a.in[I_WOUT] + (size_t)l * D * D; d.Nsrc = D; d.K = D; d.srccol = (r % 32) * 32; d.WT = (bf16*)((char*)Wb + WO_OUT); d.dstrow = (r % 32) * 32; d.kb = r / 32;
}
__device__ __forceinline__ void convert_layer(const Args& a, int l, unsigned char* ws, LAS unsigned char* lds, int gw, int NGW, int wave, int lane, int gtid, int GT) {
    LAS float* scr = (LAS float*)(lds + wave * 16384);
    bf16* Wb = (bf16*)(ws + WS_W);
    constexpr int I_GU = 16 * 176, I_DN = 44 * 32, I_IN = 16 * 288, I_MKV = 16 * 64, I_BR = 16 * 32, I_OUT = 16 * 32;
    constexpr int NITEMS = 2 * I_GU + 2 * I_DN + I_IN + I_MKV + 3 * I_BR + I_OUT;
    {
        const int tid_ = wave * 64 + lane;
        for (int e = tid_; e < 3 * D; e += NTHR) { const int j = e >> 10, k = e & 1023; ((LAS float*)(lds + j * 16384 + 8448))[k] = a.in[I_NORMG][(size_t)(l * NNORM + (j == 0 ? 0 : j == 1 ? 4 : 2)) * D + k]; }
        __syncthreads();
    }
    {
        int it = gw; f32x4 xc[8]; CvtItem dc;
        if (it < NITEMS) { cvt_item_of(a, l, Wb, it, dc); cvt_load(dc, lane, xc); }
        for (; it < NITEMS; it += NGW) {
            f32x4 xn[8]; CvtItem dn = dc; const bool more = it + NGW < NITEMS;
            if (more) { cvt_item_of(a, l, Wb, it + NGW, dn); cvt_load(dn, lane, xn); }
            cvt_finish(dc, lane, xc, scr, lds);
            if (more) { dc = dn;
#pragma unroll
                for (int i = 0; i < 8; ++i) xc[i] = xn[i]; }
        }
    }
    { const float* win = a.in[I_WIN] + (size_t)l * D * WIN_COLS; const float* g2 = a.in[I_NORMG] + (size_t)(l * NNORM + 2) * D; float* wt = (float*)(ws + WS_WIF);
      for (int e = gtid; e < 8 * D; e += GT) { const int k = e >> 3, c = e & 7; wt[c * D + k] = win[(size_t)k * WIN_COLS + 3072 + c] * g2[k]; } }
    bf16* wsg = (bf16*)(ws + WS_WSGU); const float* src = a.in[I_SWS] + (size_t)l * 4 * 128 * 128;
    for (int e = gtid; e < 4 * 128 * 128; e += GT) { const int t = (e >> 7) & 127, s = e & 127; wsg[e] = (bf16)f2bf(s <= t ? src[e] : 0.f); }
    const float* g6 = a.in[I_NORMG] + (size_t)(l * NNORM + 6) * D;
    for (int m = gw; m < MMEM; m += NGW) {
        const f32x4* xr = (const f32x4*)(a.in[I_MEM] + (size_t)m * D) + lane; f32x4 v[4]; float s = 0.f;
#pragma unroll
        for (int j = 0; j < 4; ++j) { v[j] = xr[64 * j]; s += (v[j].x * v[j].x + v[j].y * v[j].y) + (v[j].z * v[j].z + v[j].w * v[j].w); }
        const float rstd = rsqrtf(wave_sum(s, lane) * (1.f / D) + EPS);
        unsigned long long* o8 = (unsigned long long*)((bf16*)(ws + WS_MEMN) + (size_t)m * D) + lane;
#pragma unroll
        for (int j = 0; j < 4; ++j) { const f32x4 gg = ((const f32x4*)g6)[lane + 64 * j];
            o8[64 * j] = (unsigned long long)pk2(v[j].x * rstd * gg.x, v[j].y * rstd * gg.y) | ((unsigned long long)pk2(v[j].z * rstd * gg.z, v[j].w * rstd * gg.w) << 32); }
    }
}

__device__ __forceinline__ void thin_rows(const bf16* fbase, size_t fld, const float* ga, float scale, const float* hin32, const bf16* hinb, bf16* hb_out, float* rstd_out, float* out32,
                                          int row_lo, int row_hi, int gw, int NGW, int lane, const bool do_gates, const LAS float* wif, const float* bi, const float* bfg, float* gate_i, float* gate_f) {
    f32x4 hn32[4]; unsigned long long hnb[4], fn[4];
    int m = row_lo + gw;
    if (m < row_hi) {
        if (hin32) { const f32x4* hr = (const f32x4*)(hin32 + (size_t)m * D) + lane;
#pragma unroll
            for (int j = 0; j < 4; ++j) hn32[j] = hr[64 * j]; }
        else { const unsigned long long* hr = (const unsigned long long*)(hinb + (size_t)m * D) + lane;
#pragma unroll
            for (int j = 0; j < 4; ++j) hnb[j] = hr[64 * j]; }
        if (fbase) { const unsigned long long* fr = (const unsigned long long*)(fbase + (size_t)(m - row_lo) * fld) + lane;
#pragma unroll
            for (int j = 0; j < 4; ++j) fn[j] = fr[64 * j]; }
    }
    for (; m < row_hi; m += NGW) {
        f32x4 v[4]; unsigned long long fc[4];
        if (hin32) {
#pragma unroll
            for (int j = 0; j < 4; ++j) v[j] = hn32[j]; }
        else {
#pragma unroll
            for (int j = 0; j < 4; ++j) { const unsigned long long w = hnb[j]; const unsigned lo = (unsigned)w, hi = (unsigned)(w >> 32); v[j] = (f32x4){bflo(lo), bfhi(lo), bflo(hi), bfhi(hi)}; } }
#pragma unroll
        for (int j = 0; j < 4; ++j) fc[j] = fn[j];
        const int mn = m + NGW;
        if (mn < row_hi) {
            if (hin32) { const f32x4* hr = (const f32x4*)(hin32 + (size_t)mn * D) + lane;
#pragma unroll
                for (int j = 0; j < 4; ++j) hn32[j] = hr[64 * j]; }
            else { const unsigned long long* hr = (const unsigned long long*)(hinb + (size_t)mn * D) + lane;
#pragma unroll
                for (int j = 0; j < 4; ++j) hnb[j] = hr[64 * j]; }
            if (fbase) { const unsigned long long* fr = (const unsigned long long*)(fbase + (size_t)(mn - row_lo) * fld) + lane;
#pragma unroll
                for (int j = 0; j < 4; ++j) fn[j] = fr[64 * j]; }
        }
        if (fbase) {
            float s = 0.f; f32x4 f[4];
#pragma unroll
            for (int j = 0; j < 4; ++j) { const unsigned long long w = fc[j]; const unsigned lo = (unsigned)w, hi = (unsigned)(w >> 32);
                f[j] = (f32x4){bflo(lo), bfhi(lo), bflo(hi), bfhi(hi)}; s += (f[j].x * f[j].x + f[j].y * f[j].y) + (f[j].z * f[j].z + f[j].w * f[j].w); }
            const float rstd = rsqrtf(wave_sum(s, lane) * (1.f / D) + EPS) * scale;
#pragma unroll
            for (int j = 0; j < 4; ++j) { const f32x4 gg = ((const f32x4*)ga)[lane + 64 * j]; v[j] = v[j] + f[j] * rstd * gg; }
        }
        if (out32) { f32x4* ho = (f32x4*)(out32 + (size_t)m * D) + lane;
#pragma unroll
            for (int j = 0; j < 4; ++j) ho[64 * j] = v[j]; }
        if (hb_out) {
            float s = 0.f;
#pragma unroll
            for (int j = 0; j < 4; ++j) s += (v[j].x * v[j].x + v[j].y * v[j].y) + (v[j].z * v[j].z + v[j].w * v[j].w);
            const float rstd = rsqrtf(wave_sum(s, lane) * (1.f / D) + EPS);
            unsigned long long* o8 = (unsigned long long*)(hb_out + (size_t)m * D) + lane;
#pragma unroll
            for (int j = 0; j < 4; ++j) o8[64 * j] = (unsigned long long)pk2(v[j].x, v[j].y) | ((unsigned long long)pk2(v[j].z, v[j].w) << 32);
            if (lane == 0) rstd_out[m] = rstd;
            if (do_gates) {
                float acc[8];
#pragma unroll
                for (int e = 0; e < 8; ++e) acc[e] = 0.f;
#pragma unroll
                for (int j = 0; j < 4; ++j)
#pragma unroll
                    for (int e = 0; e < 8; ++e) { const u32x2 w2 = *(const LAS u32x2*)((const LAS bf16*)wif + e * D + 4 * lane + 256 * j); acc[e] += (v[j].x * bflo(w2.x) + v[j].y * bfhi(w2.x)) + (v[j].z * bflo(w2.y) + v[j].w * bfhi(w2.y)); }
                {
                    float b4[4], b2[2], b1;
#pragma unroll
                    for (int e = 0; e < 4; ++e) { const float mine = (lane & 4) ? acc[4 + e] : acc[e], send = (lane & 4) ? acc[e] : acc[4 + e]; b4[e] = mine + dppf<DPP_HMIR>(send); }
#pragma unroll
                    for (int e = 0; e < 2; ++e) { const float mine = (lane & 2) ? b4[2 + e] : b4[e], send = (lane & 2) ? b4[e] : b4[2 + e]; b2[e] = mine + dppf<DPP_XOR2>(send); }
                    { const float mine = (lane & 1) ? b2[1] : b2[0], send = (lane & 1) ? b2[0] : b2[1]; b1 = mine + dppf<DPP_XOR1>(send); }
                    b1 += shx(b1, 8, lane); b1 += shx(b1, 16, lane); b1 += shx(b1, 32, lane);
                    const float val = b1 * rstd;
                    if (lane < 4) gate_i[(size_t)m * 4 + lane] = val + bi[lane];
                    else if (lane < 8) gate_f[(size_t)m * 4 + lane - 4] = logsigmoidf_(val + bfg[lane - 4]);
                }
            }
        }
    }
}

__device__ __forceinline__ void conv8(const bf16* Zb, int bl, int p, int col, const float* cw, const float* cb, float (&o)[8]) {
    const f32x4 b0 = *(const f32x4*)(cb + col), b1 = *(const f32x4*)(cb + col + 4);
    o[0] = b0.x; o[1] = b0.y; o[2] = b0.z; o[3] = b0.w; o[4] = b1.x; o[5] = b1.y; o[6] = b1.z; o[7] = b1.w;
#pragma unroll
    for (int j = 0; j < 4; ++j) { const int pp = p - 3 + j;
        if (pp >= 0) { const u32x4 x = *(const u32x4*)(Zb + (size_t)(bl * SEQ + pp) * ZLD + ZC_QK + col);
            const f32x4 w0 = *(const f32x4*)(cw + j * 1024 + col), w1 = *(const f32x4*)(cw + j * 1024 + col + 4);
            o[0] += w0.x * bflo(x.x); o[1] += w0.y * bfhi(x.x); o[2] += w0.z * bflo(x.y); o[3] += w0.w * bfhi(x.y);
            o[4] += w1.x * bflo(x.z); o[5] += w1.y * bfhi(x.z); o[6] += w1.z * bflo(x.w); o[7] += w1.w * bfhi(x.w); } }
#pragma unroll
    for (int e = 0; e < 8; ++e) o[e] = siluf_(o[e]);
}
__device__ __forceinline__ float wave_incl_scan_add(float v, int lane) {
#pragma unroll
    for (int o = 1; o < 64; o <<= 1) { const float t = shidx(v, lane >= o ? lane - o : lane); if (lane >= o) v += t; }
    return v;
}
__device__ __forceinline__ float wave_incl_scan_max(float v, int lane) {
#pragma unroll
    for (int o = 1; o < 64; o <<= 1) { const float t = shidx(v, lane >= o ? lane - o : lane); if (lane >= o) v = fmaxf(v, t); }
    return v;
}
__device__ __forceinline__ float wave_max(float v, int lane) { v = row16_max(v); v = fmaxf(v, shx(v, 16, lane)); v = fmaxf(v, shx(v, 32, lane)); return v; }
constexpr float KSCALE = 0.08838834764831845f;

__device__ __forceinline__ void conv_load(const bf16* Zb, int bl, int p, int col, u32x4 (&raw)[4]) {
#pragma unroll
    for (int j = 0; j < 4; ++j) { const int pp = p - 3 + j; raw[j] = (u32x4){0u, 0u, 0u, 0u};
        if (pp >= 0) raw[j] = *(const u32x4*)(Zb + (size_t)(bl * SEQ + pp) * ZLD + ZC_QK + col); }
}
__device__ __forceinline__ void conv_apply(const u32x4 (&raw)[4], const LAS float* wl, const int wstride, float (&o)[8]) {
    { const f32x4 b0 = *(const LAS f32x4*)(wl + 4 * wstride), b1 = *(const LAS f32x4*)(wl + 4 * wstride + 4);
      o[0] = b0.x; o[1] = b0.y; o[2] = b0.z; o[3] = b0.w; o[4] = b1.x; o[5] = b1.y; o[6] = b1.z; o[7] = b1.w; }
#pragma unroll
    for (int j = 0; j < 4; ++j) { const u32x4 x = raw[j];
        const f32x4 w0 = *(const LAS f32x4*)(wl + j * wstride), w1 = *(const LAS f32x4*)(wl + j * wstride + 4);
        o[0] += w0.x * bflo(x.x); o[1] += w0.y * bfhi(x.x); o[2] += w0.z * bflo(x.y); o[3] += w0.w * bfhi(x.y);
        o[4] += w1.x * bflo(x.z); o[5] += w1.y * bfhi(x.z); o[6] += w1.z * bflo(x.w); o[7] += w1.w * bfhi(x.w); }
#pragma unroll
    for (int e = 0; e < 8; ++e) o[e] = siluf_(o[e]);
}
__device__ __forceinline__ void stage_convw(LAS float* wl, const float* cw, const float* cb, int col0, int ncol, int dst0, int wstride, int tid) {
    for (int e = tid; e < 5 * ncol; e += NTHR) { const int j = e / ncol, cidx = e - j * ncol; wl[j * wstride + dst0 + cidx] = (j < 4) ? cw[j * 1024 + col0 + cidx] : cb[col0 + cidx]; }
}
__device__ __forceinline__ void mlstm_s1(const Args& a, int l, int hf, unsigned char* ws, LAS unsigned char* lds, int G, int cu, int tid, int wave, int lane) {
    const bf16* Zb = (const bf16*)(ws + WS_Z); const bf16* ZT = (const bf16*)(ws + WS_ZT);
    const float* gi = (const float*)(ws + WS_GATE); const float* gf = gi + (size_t)M * 4;
    const float* cw = a.in[I_CONVW] + (size_t)l * 4 * 1024; const float* cb = a.in[I_CONVB] + (size_t)l * 1024;
    LAS bf16* KT = (LAS bf16*)lds;
    LAS float* wv = (LAS float*)(lds + 18432);
    LAS float* CWL = (LAS float*)(lds + 18944);
    LAS bf16* SL = (LAS bf16*)(lds + 21504);
    const int c8 = tid & 15, r = lane & 31, hh = lane >> 5, v0 = 32 * wave; int hcur = -1;
    bf16x8 bfr[4]; u32x4 raw[2][4];
#define S1_LOAD(UU, BF, RW) do { const int h_ = (UU) & 3, c_ = ((UU) >> 2) & 63, bl_ = (UU) >> 8; \
        const bf16* vrow_ = ZT + (size_t)(h_ * 256 + v0 + r) * ZTLD + bl_ * SEQ + c_ * LCH + 8 * hh; \
        _Pragma("unroll") for (int ks = 0; ks < 4; ++ks) BF[ks] = *(const bf16x8*)(vrow_ + 16 * ks); \
        _Pragma("unroll") for (int rep = 0; rep < 2; ++rep) conv_load(Zb, bl_, c_ * LCH + ((tid + rep * NTHR) >> 4), 512 + h_ * 128 + c8 * 8, RW[rep]); } while (0)
#define S1_GATES(UU, BUF) do { const int h_ = (UU) & 3, c_ = ((UU) >> 2) & 63, bl_ = (UU) >> 8, bhl_ = bl_ * 4 + h_; const int tokg_ = (hf * 4 + bl_) * SEQ + c_ * LCH; \
        const float lf = gf[(size_t)(tokg_ + lane) * 4 + h_], ii = gi[(size_t)(tokg_ + lane) * 4 + h_]; \
        const float bc = wave_incl_scan_add(lf, lane); const float g = shidx(bc, 63); const float av = g - bc + ii; const float ml = wave_max(av, lane); \
        wv[(BUF) * 64 + lane] = __expf(av - ml); \
        if (lane == 0) { float* cs = (float*)(ws + WS_CSC) + (size_t)(bhl_ * NCH + c_) * 4; cs[0] = g; cs[1] = ml; } } while (0)
    int u = cu, cur = 0;
    if (u < 16 * NCH) { S1_LOAD(u, bfr, raw); if (wave == 7) S1_GATES(u, 0); }
    for (; u < 16 * NCH; u += G) {
        const int h = u & 3, c = (u >> 2) & 63, bl = u >> 8, bhl = bl * 4 + h;
        if (h != hcur) { __syncthreads(); stage_convw(CWL, cw, cb, 512 + h * 128, 128, 0, 128, tid); hcur = h; }
        __syncthreads();
#pragma unroll
        for (int rep = 0; rep < 2; ++rep) { const int idx = tid + rep * NTHR, s = idx >> 4; float o[8];
            conv_apply(raw[rep], CWL + c8 * 8, 128, o); const float sc = wv[cur * 64 + s] * KSCALE;
            { u32x4 w; w.x = pk2(o[0] * KSCALE, o[1] * KSCALE); w.y = pk2(o[2] * KSCALE, o[3] * KSCALE); w.z = pk2(o[4] * KSCALE, o[5] * KSCALE); w.w = pk2(o[6] * KSCALE, o[7] * KSCALE);
              *(u32x4*)((bf16*)(ws + WS_KC) + (size_t)(bl * SEQ + c * LCH + s) * 512 + h * 128 + c8 * 8) = w; }
#pragma unroll
            for (int e = 0; e < 8; ++e) KT[(c8 * 8 + e) * 72 + ((((s >> 3) ^ (c8 & 7)) << 3) | (s & 7))] = (bf16)f2bf(o[e] * sc); }
        __syncthreads();
        const int un = u + G; const bool hasn = un < 16 * NCH;
        bf16x8 bfrN[4]; u32x4 rawN[2][4];
        if (hasn) { S1_LOAD(un, bfrN, rawN); if (wave == 7) S1_GATES(un, cur ^ 1); }
        if (tid < 128) { float s = 0.f;
#pragma unroll 8
            for (int k = 0; k < 64; ++k) s += bf1(KT[tid * 72 + k]);
            ((float*)(ws + WS_NST))[(size_t)(bhl * NCH + c) * 128 + tid] = s; }
        {
#pragma unroll
            for (int db = 0; db < 4; ++db) { f32x16 acc;
#pragma unroll
                for (int e = 0; e < 16; ++e) acc[e] = 0.f;
#pragma unroll
                for (int ks = 0; ks < 4; ++ks) { const bf16x8 af = *(const LAS bf16x8*)(KT + (32 * db + r) * 72 + (((2 * ks + hh) ^ ((4 * db + (r >> 3)) & 7)) << 3)); acc = __builtin_amdgcn_mfma_f32_32x32x16_bf16(af, bfr[ks], acc, 0, 0, 0); }
#pragma unroll
                for (int q = 0; q < 4; ++q) { u32x2 w; w.x = pk2(acc[4 * q], acc[4 * q + 1]); w.y = pk2(acc[4 * q + 2], acc[4 * q + 3]); *(LAS u32x2*)(SL + (v0 + r) * 136 + 32 * db + 8 * q + 4 * hh) = w; } }
            __syncthreads();
            bf16* st = (bf16*)(ws + WS_ST) + (size_t)(bhl * NCH + c) * 32768;
#pragma unroll
            for (int rep = 0; rep < 8; ++rep) { const int idx = tid + rep * NTHR, row = idx >> 4, c16 = idx & 15; *(u32x4*)(st + row * 128 + c16 * 8) = *(const LAS u32x4*)(SL + row * 136 + c16 * 8); }
        }
        if (hasn) {
#pragma unroll
            for (int ks = 0; ks < 4; ++ks) bfr[ks] = bfrN[ks];
#pragma unroll
            for (int rep = 0; rep < 2; ++rep)
#pragma unroll
                for (int j = 0; j < 4; ++j) raw[rep][j] = rawN[rep][j]; }
        cur ^= 1;
    }
#undef S1_LOAD
#undef S1_GATES
    __syncthreads();
}
__device__ __forceinline__ void mlstm_s2(unsigned char* ws, int G, int cu, int tid) {
    for (int u = cu; u < 256; u += G) {
        const int bhl = u >> 4, part = u & 15; const size_t off = (size_t)(part * NTHR + tid) * 4;
        bf16* st = (bf16*)(ws + WS_ST) + (size_t)bhl * NCH * 32768 + off; float* ns = (float*)(ws + WS_NST) + (size_t)bhl * NCH * 128 + tid; float* cs = (float*)(ws + WS_CSC) + (size_t)bhl * NCH * 4;
        const bool nth = (part == 0 && tid < 128);
        float C[4]; float nv = 0.f, m = -1e30f;
#pragma unroll
        for (int e = 0; e < 4; ++e) C[e] = 0.f;
        for (int c0 = 0; c0 < NCH; c0 += 8) {
            u32x2 cl[8]; float nl[8], gg[8], ml[8];
#pragma unroll
            for (int i = 0; i < 8; ++i) { cl[i] = *(const u32x2*)(st + (size_t)(c0 + i) * 32768); nl[i] = nth ? ns[(c0 + i) * 128] : 0.f; gg[i] = cs[(c0 + i) * 4]; ml[i] = cs[(c0 + i) * 4 + 1]; }
#pragma unroll
            for (int i = 0; i < 8; ++i) {
                u32x2 o; o.x = pk2(C[0], C[1]); o.y = pk2(C[2], C[3]);
                *(u32x2*)(st + (size_t)(c0 + i) * 32768) = o;
                if (nth) ns[(c0 + i) * 128] = nv;
                if (part == 0 && tid == 0) cs[(c0 + i) * 4 + 2] = m;
                const float mn = fmaxf(gg[i] + m, ml[i]); const float dec = __expf(gg[i] + m - mn), sc = __expf(ml[i] - mn);
                C[0] = dec * C[0] + sc * bflo(cl[i].x); C[1] = dec * C[1] + sc * bfhi(cl[i].x); C[2] = dec * C[2] + sc * bflo(cl[i].y); C[3] = dec * C[3] + sc * bfhi(cl[i].y);
                nv = dec * nv + sc * nl[i]; m = mn;
            }
        }
    }
}
__device__ __forceinline__ void mlstm_s3(const Args& a, int l, int hf, unsigned char* ws, LAS unsigned char* lds, int G, int cu, int tid, int wave, int lane, const int out_col) {
    bf16* Zb = (bf16*)(ws + WS_Z); const bf16* ZT = (const bf16*)(ws + WS_ZT);
    const float* gi = (const float*)(ws + WS_GATE); const float* gf = gi + (size_t)M * 4;
    const float* cw = a.in[I_CONVW] + (size_t)l * 4 * 1024; const float* cb = a.in[I_CONVB] + (size_t)l * 1024;
    const float* gain = a.in[I_MNORM] + (size_t)l * 1024;
    LAS bf16* QS = (LAS bf16*)lds;
    LAS bf16* KS = (LAS bf16*)(lds + 17408);
    LAS bf16* SD = (LAS bf16*)(lds + 34816);
    LAS float* HB = (LAS float*)(lds + 44032);
    LAS float* SCB = (LAS float*)(lds + 110592);
    LAS float* CWL = (LAS float*)(lds + 114176);
    const int c8 = tid & 15, r = lane & 31, hh = lane >> 5, v0 = 32 * wave; int hcur = -1;
    u32x4 kt[2], rawq[2][4];
#define S3_LOAD_B(UU, BV, BC, OG) do { const int h_ = (UU) & 3, c_ = ((UU) >> 2) & 63, bl_ = (UU) >> 8, bhl_ = bl_ * 4 + h_; const int tokl_ = bl_ * SEQ + c_ * LCH; \
        const bf16* vrow_ = ZT + (size_t)(h_ * 256 + v0 + r) * ZTLD + tokl_ + 8 * hh; \
        const bf16* crow_ = (const bf16*)(ws + WS_ST) + (size_t)(bhl_ * NCH + c_) * 32768 + (size_t)(v0 + r) * 128 + 8 * hh; \
        _Pragma("unroll") for (int ks = 0; ks < 4; ++ks) BV[ks] = *(const bf16x8*)(vrow_ + 16 * ks); \
        _Pragma("unroll") for (int ks = 0; ks < 8; ++ks) BC[ks] = *(const bf16x8*)(crow_ + 16 * ks); \
        _Pragma("unroll") for (int i = 0; i < 4; ++i) OG[i] = *(const u32x4*)(Zb + (size_t)(tokl_ + (tid >> 3)) * ZLD + ZC_O + h_ * 256 + 32 * (tid & 7) + 8 * i); } while (0)
#define S3_LOAD_A(UU, KT_, RW) do { const int h_ = (UU) & 3, c_ = ((UU) >> 2) & 63, bl_ = (UU) >> 8; const int tokl_ = bl_ * SEQ + c_ * LCH; \
        _Pragma("unroll") for (int rep = 0; rep < 2; ++rep) { const int t_ = (tid + rep * NTHR) >> 4; KT_[rep] = *(const u32x4*)((const bf16*)(ws + WS_KC) + (size_t)(tokl_ + t_) * 512 + h_ * 128 + c8 * 8); \
            conv_load(Zb, bl_, c_ * LCH + t_, h_ * 128 + c8 * 8, RW[rep]); } } while (0)
#define S3_SCAL(UU, BUF) do { const int h_ = (UU) & 3, c_ = ((UU) >> 2) & 63, bl_ = (UU) >> 8, bhl_ = bl_ * 4 + h_; const int tokg_ = (hf * 4 + bl_) * SEQ + c_ * LCH; LAS float* SC_ = SCB + (BUF) * 448; \
        if (wave == 7) { const float lf = gf[(size_t)(tokg_ + lane) * 4 + h_], ii = gi[(size_t)(tokg_ + lane) * 4 + h_]; \
            const float bc = wave_incl_scan_add(lf, lane); const float rr = ii - bc; const float cm = wave_incl_scan_max(rr, lane); \
            const float mst = ((const float*)(ws + WS_CSC))[(size_t)(bhl_ * NCH + c_) * 4 + 2]; const float Mt = fmaxf(mst, cm); \
            SC_[lane] = rr; SC_[64 + lane] = Mt; SC_[128 + lane] = __expf(mst - Mt); SC_[192 + lane] = __expf(-(bc + Mt)); } \
        else if (wave == 5 || wave == 6) { const int d_ = (wave - 5) * 64 + lane; SC_[320 + d_] = ((const float*)(ws + WS_NST))[(size_t)(bhl_ * NCH + c_) * 128 + d_]; } } while (0)
    int u = cu, cur = 0;
    if (u < 16 * NCH) { S3_LOAD_A(u, kt, rawq); S3_SCAL(u, 0); }
    for (; u < 16 * NCH; u += G) {
        const int h = u & 3, c = (u >> 2) & 63, bl = u >> 8; const int tokl = bl * SEQ + c * LCH;
        LAS float* SC = SCB + cur * 448;
        if (h != hcur) { __syncthreads(); stage_convw(CWL, cw, cb, h * 128, 128, 0, 256, tid); hcur = h; __syncthreads(); }
        bf16x8 bV[4], bC[8]; u32x4 ogr[4];
        S3_LOAD_B(u, bV, bC, ogr);
#pragma unroll
        for (int rep = 0; rep < 2; ++rep) { const int idx = tid + rep * NTHR, t = idx >> 4; float o[8];
            conv_apply(rawq[rep], CWL + c8 * 8, 256, o);
            u32x4 w; w.x = pk2(o[0], o[1]); w.y = pk2(o[2], o[3]); w.z = pk2(o[4], o[5]); w.w = pk2(o[6], o[7]);
            *(LAS u32x4*)(QS + t * 136 + c8 * 8) = w;
            *(LAS u32x4*)(KS + t * 136 + c8 * 8) = kt[rep]; }
        __syncthreads();
        {
            const int tb = wave >> 1, fr = lane & 15, fq = lane >> 4;
#pragma unroll
            for (int i = 0; i < 2; ++i) { const int sblk = (wave & 1) * 2 + i; f32x4 acc = (f32x4){0.f, 0.f, 0.f, 0.f};
                if (sblk <= tb) {
#pragma unroll
                    for (int ks = 0; ks < 4; ++ks) { const bf16x8 af = *(const LAS bf16x8*)(QS + (16 * tb + fr) * 136 + 32 * ks + 8 * fq), bfv = *(const LAS bf16x8*)(KS + (16 * sblk + fr) * 136 + 32 * ks + 8 * fq);
                        acc = __builtin_amdgcn_mfma_f32_16x16x32_bf16(af, bfv, acc, 0, 0, 0); } }
                const int s_ = 16 * sblk + fr; const float rs_ = SC[s_];
#pragma unroll
                for (int e = 0; e < 4; ++e) { const int t = 16 * tb + 4 * fq + e; const float val = (s_ <= t) ? acc[e] * __expf(rs_ - SC[64 + t]) : 0.f; SD[t * 72 + s_] = (bf16)f2bf(val); } }
        }
        f32x16 aQ0, aQ1, aS0, aS1;
#pragma unroll
        for (int e = 0; e < 16; ++e) { aQ0[e] = 0.f; aQ1[e] = 0.f; aS0[e] = 0.f; aS1[e] = 0.f; }
#pragma unroll
        for (int ks = 0; ks < 8; ++ks) {
            const bf16x8 a0 = *(const LAS bf16x8*)(QS + r * 136 + 16 * ks + 8 * hh), a1 = *(const LAS bf16x8*)(QS + (32 + r) * 136 + 16 * ks + 8 * hh);
            aQ0 = __builtin_amdgcn_mfma_f32_32x32x16_bf16(a0, bC[ks], aQ0, 0, 0, 0); aQ1 = __builtin_amdgcn_mfma_f32_32x32x16_bf16(a1, bC[ks], aQ1, 0, 0, 0); }
        __syncthreads();
        {
            const int t = tid >> 3, p = tid & 7; float ds = 0.f, qn = 0.f;
#pragma unroll
            for (int k = 0; k < 8; ++k) ds += bf1(SD[t * 72 + 8 * p + k]);
#pragma unroll
            for (int k = 0; k < 16; ++k) qn += bf1(QS[t * 136 + 16 * p + k]) * SC[320 + 16 * p + k];
            float den = ds + SC[128 + t] * qn;
            den = grp8_sum(den);
            if (p == 0) SC[256 + t] = 1.f / fmaxf(fabsf(den), SC[192 + t]);
        }
#pragma unroll
        for (int ks = 0; ks < 4; ++ks) {
            const bf16x8 a0 = *(const LAS bf16x8*)(SD + r * 72 + 16 * ks + 8 * hh), a1 = *(const LAS bf16x8*)(SD + (32 + r) * 72 + 16 * ks + 8 * hh);
            aS0 = __builtin_amdgcn_mfma_f32_32x32x16_bf16(a0, bV[ks], aS0, 0, 0, 0); aS1 = __builtin_amdgcn_mfma_f32_32x32x16_bf16(a1, bV[ks], aS1, 0, 0, 0); }
        __syncthreads();
        const int un = u + G; const bool hasn = un < 16 * NCH;
        u32x4 ktN[2], rawN[2][4];
        if (hasn) { S3_LOAD_A(un, ktN, rawN); S3_SCAL(un, cur ^ 1); }
#pragma unroll
        for (int e = 0; e < 16; ++e) { const int t0 = (e & 3) + 8 * (e >> 2) + 4 * hh;
            HB[t0 * 260 + v0 + r] = (aS0[e] + SC[128 + t0] * aQ0[e]) * SC[256 + t0]; HB[(32 + t0) * 260 + v0 + r] = (aS1[e] + SC[128 + 32 + t0] * aQ1[e]) * SC[256 + 32 + t0]; }
        __syncthreads();
        {
            const int t = tid >> 3, p = tid & 7; f32x4 x[8]; float sm = 0.f;
#pragma unroll
            for (int k = 0; k < 8; ++k) { x[k] = *(const LAS f32x4*)(HB + t * 260 + 32 * p + 4 * k); sm += (x[k].x + x[k].y) + (x[k].z + x[k].w); }
            sm = grp8_sum(sm);
            const float mean = sm * (1.f / 256.f); float sq = 0.f;
#pragma unroll
            for (int k = 0; k < 8; ++k) { x[k] = x[k] - mean; sq += (x[k].x * x[k].x + x[k].y * x[k].y) + (x[k].z * x[k].z + x[k].w * x[k].w); }
            sq = grp8_sum(sq);
            const float rstd = rsqrtf(sq * (1.f / 256.f) + EPS);
            const float* gp = gain + h * 256 + 32 * p; bf16* op = Zb + (size_t)(tokl + t) * ZLD + out_col + h * 256 + 32 * p;
#pragma unroll
            for (int i = 0; i < 4; ++i) { const f32x4 g0 = *(const f32x4*)(gp + 8 * i), g1 = *(const f32x4*)(gp + 8 * i + 4); const f32x4 a = x[2 * i] * rstd * g0, b = x[2 * i + 1] * rstd * g1; const u32x4 og = ogr[i]; u32x4 w;
                w.x = pk2(a.x * bflo(og.x), a.y * bfhi(og.x)); w.y = pk2(a.z * bflo(og.y), a.w * bfhi(og.y)); w.z = pk2(b.x * bflo(og.z), b.y * bfhi(og.z)); w.w = pk2(b.z * bflo(og.w), b.w * bfhi(og.w));
                *(u32x4*)(op + 8 * i) = w; }
        }
        if (hasn) {
#pragma unroll
            for (int rep = 0; rep < 2; ++rep) { kt[rep] = ktN[rep];
#pragma unroll
                for (int j = 0; j < 4; ++j) rawq[rep][j] = rawN[rep][j]; } }
        cur ^= 1;
    }
#undef S3_LOAD_A
#undef S3_LOAD_B
#undef S3_SCAL
    __syncthreads();
}

__device__ __forceinline__ void sgu_phase(const Args& a, int l, unsigned char* ws, LAS unsigned char* lds, int G, int cu, int tid, int wave, int lane, const int out_col) {
    bf16* Zb = (bf16*)(ws + WS_Z); const bf16* ZT = (const bf16*)(ws + WS_ZT); const bf16* Wc = (const bf16*)(ws + WS_WSGU);
    const float* lng = a.in[I_SLNG] + (size_t)l * 1024; const float* lnb = a.in[I_SLNB] + (size_t)l * 1024; const float* bs = a.in[I_SBS] + (size_t)l * 4 * 128;
    LAS bf16* VT = (LAS bf16*)lds;
    LAS float* PS = (LAS float*)(lds + 69632);
    LAS float* ST = (LAS float*)(lds + 69632 + 8192);
    LAS bf16* WS_ = (LAS bf16*)(lds + 78848);
    const int c8 = tid & 15, dq = tid >> 4;
    int gcur = -1;
    u32x4 x[8];
    if (cu < 4 * 32 * 4) { const int g = cu & 3, cc = (cu >> 2) & 31, bl = cu >> 7;
#pragma unroll
        for (int rep = 0; rep < 8; ++rep) x[rep] = *(const u32x4*)(ZT + (size_t)(1024 + g * 256 + dq + 32 * rep) * ZTLD + bl * SEQ + cc * 128 + c8 * 8); }
    for (int u = cu; u < 4 * 32 * 4; u += G) {
        const int g = u & 3, cc = (u >> 2) & 31, bl = u >> 7; const int tokl = bl * SEQ + cc * 128;
        if (g != gcur) { __syncthreads();
#pragma unroll
            for (int rep = 0; rep < 4; ++rep) { const int idx = tid + rep * NTHR, t = idx >> 4; *(LAS u32x4*)(WS_ + t * 136 + c8 * 8) = *(const u32x4*)(Wc + (size_t)(g * 128 + t) * 128 + c8 * 8); }
            gcur = g; }
        {
            float sm[8], sq[8];
#pragma unroll
            for (int k = 0; k < 8; ++k) { sm[k] = 0.f; sq[k] = 0.f; }
#pragma unroll
            for (int rep = 0; rep < 8; ++rep) { const u32x4 v = x[rep]; const float f0 = bflo(v.x), f1 = bfhi(v.x), f2 = bflo(v.y), f3 = bfhi(v.y), f4 = bflo(v.z), f5 = bfhi(v.z), f6 = bflo(v.w), f7 = bfhi(v.w);
                sm[0] += f0; sq[0] += f0 * f0; sm[1] += f1; sq[1] += f1 * f1; sm[2] += f2; sq[2] += f2 * f2; sm[3] += f3; sq[3] += f3 * f3;
                sm[4] += f4; sq[4] += f4 * f4; sm[5] += f5; sq[5] += f5 * f5; sm[6] += f6; sq[6] += f6 * f6; sm[7] += f7; sq[7] += f7 * f7; }
#pragma unroll
            for (int k = 0; k < 8; ++k) { sm[k] += shx(sm[k], 16, lane); sq[k] += shx(sq[k], 16, lane); sm[k] += shx(sm[k], 32, lane); sq[k] += shx(sq[k], 32, lane); }
            if (lane < 16) {
#pragma unroll
                for (int k = 0; k < 8; ++k) { PS[(wave * 128 + c8 * 8 + k) * 2] = sm[k]; PS[(wave * 128 + c8 * 8 + k) * 2 + 1] = sq[k]; } }
        }
        __syncthreads();
        if (tid < 128) { float sm = 0.f, sq = 0.f;
#pragma unroll
            for (int p = 0; p < 8; ++p) { sm += PS[(p * 128 + tid) * 2]; sq += PS[(p * 128 + tid) * 2 + 1]; }
            const float mean = sm * (1.f / 256.f); const float var = fmaxf(sq * (1.f / 256.f) - mean * mean, 0.f); ST[tid] = mean; ST[128 + tid] = rsqrtf(var + EPS); }
        __syncthreads();
        { const LAS float* mp = ST + c8 * 8; const LAS float* rp = ST + 128 + c8 * 8; float mm[8], rr[8];
#pragma unroll
            for (int k = 0; k < 8; ++k) { mm[k] = mp[k]; rr[k] = rp[k]; }
#pragma unroll
            for (int rep = 0; rep < 8; ++rep) { const int d = dq + 32 * rep; const float gg = lng[g * 256 + d], bb = lnb[g * 256 + d]; u32x4 v = x[rep];
                v.x = pk2((bflo(v.x) - mm[0]) * rr[0] * gg + bb, (bfhi(v.x) - mm[1]) * rr[1] * gg + bb); v.y = pk2((bflo(v.y) - mm[2]) * rr[2] * gg + bb, (bfhi(v.y) - mm[3]) * rr[3] * gg + bb);
                v.z = pk2((bflo(v.z) - mm[4]) * rr[4] * gg + bb, (bfhi(v.z) - mm[5]) * rr[5] * gg + bb); v.w = pk2((bflo(v.w) - mm[6]) * rr[6] * gg + bb, (bfhi(v.w) - mm[7]) * rr[7] * gg + bb);
                *(LAS u32x4*)(VT + d * 136 + c8 * 8) = v; } }
        if (u + G < 4 * 32 * 4) { const int un = u + G, gn = un & 3, ccn = (un >> 2) & 31, bln = un >> 7;
#pragma unroll
            for (int rep = 0; rep < 8; ++rep) x[rep] = *(const u32x4*)(ZT + (size_t)(1024 + gn * 256 + dq + 32 * rep) * ZTLD + bln * SEQ + ccn * 128 + c8 * 8); }
        __syncthreads();
        {
            const int r = lane & 31, hh = lane >> 5, d0 = 32 * wave;
            u32x2 uu[4][4];
#pragma unroll
            for (int tb = 0; tb < 4; ++tb)
#pragma unroll
                for (int q = 0; q < 4; ++q) uu[tb][q] = *(const u32x2*)(Zb + (size_t)(tokl + 32 * tb + r) * ZLD + ZC_U + g * 256 + d0 + 4 * hh + 8 * q);
            f32x16 acc[4];
#pragma unroll
            for (int tb = 0; tb < 4; ++tb)
#pragma unroll
                for (int e = 0; e < 16; ++e) acc[tb][e] = 0.f;
#pragma unroll
            for (int ks = 0; ks < 8; ++ks) { const bf16x8 af = *(const LAS bf16x8*)(VT + (d0 + r) * 136 + 16 * ks + 8 * hh);
#pragma unroll
                for (int tb = 0; tb < 4; ++tb) if (16 * ks <= 32 * tb + 31) { const bf16x8 bfv = *(const LAS bf16x8*)(WS_ + (32 * tb + r) * 136 + 16 * ks + 8 * hh);
                    acc[tb] = __builtin_amdgcn_mfma_f32_32x32x16_bf16(af, bfv, acc[tb], 0, 0, 0); } }
#pragma unroll
            for (int tb = 0; tb < 4; ++tb) { const int t = 32 * tb + r; const float bias = bs[g * 128 + t]; bf16* rowp = Zb + (size_t)(tokl + t) * ZLD + out_col + g * 256 + d0 + 4 * hh;
#pragma unroll
                for (int q = 0; q < 4; ++q) { const u32x2 v = uu[tb][q]; u32x2 w;
                    w.x = pk2(bflo(v.x) * (acc[tb][4 * q] + bias), bfhi(v.x) * (acc[tb][4 * q + 1] + bias)); w.y = pk2(bflo(v.y) * (acc[tb][4 * q + 2] + bias), bfhi(v.y) * (acc[tb][4 * q + 3] + bias)); *(u32x2*)(rowp + 8 * q) = w; } }
        }
        __syncthreads();
    }
}

__device__ __forceinline__ void xattn_phase(unsigned char* ws, int hf, LAS unsigned char* lds, int G, int cu, int tid, int wave, int lane) {
    bf16* Zb = (bf16*)(ws + WS_Z); const bf16* Kmem = (const bf16*)(ws + WS_KMEM); const bf16* Vt = (const bf16*)(ws + WS_VTMEM);
    const int r = lane & 31, hh = lane >> 5;
#define XA_BAR() do { asm volatile("s_waitcnt lgkmcnt(0)" ::: "memory"); __builtin_amdgcn_s_barrier(); asm volatile("" ::: "memory"); } while (0)
#define XA_DMA(SRC_ROW_PTR_EXPR, BUF) do { int tt = tid; asm volatile("" : "+v"(tt)); _Pragma("unroll") for (int rep = 0; rep < 8; ++rep) { const int idx = tt + NTHR * rep, row = idx >> 5, cs = (idx & 31) ^ (row & 31); \
        __builtin_amdgcn_global_load_lds((const unsigned*)(SRC_ROW_PTR_EXPR), (LAS unsigned*)(lds + (BUF) * 65536 + (wave * 64 + NTHR * rep) * 16), 16, 0, 0); } } while (0)
    for (int u = cu; u < 4 * 16 * 4; u += G) {
        const int h = u & 3, qt = (u >> 2) & 15, bl = u >> 6, bg = hf * 4 + bl;
        bf16* qrow = Zb + (size_t)(bl * SEQ + qt * 256 + wave * 32 + r) * ZLD + ZC_XQ + h * 256;
        const bf16* kb = Kmem + (size_t)(bg * MEMLEN) * D + h * 256; const bf16* vb = Vt + (size_t)(h * 256) * MMEM + bg * MEMLEN;
        bf16x8 q[16];
#pragma unroll
        for (int i = 0; i < 16; ++i) q[i] = *(const bf16x8*)(qrow + 16 * i + 8 * hh);
        XA_DMA(kb + (size_t)row * D + cs * 8, 0);
#pragma unroll
        for (int i = 0; i < 16; ++i) asm volatile("" : "+v"(q[i]));
        asm volatile("s_waitcnt vmcnt(0)" ::: "memory");
        XA_BAR();
        XA_DMA(kb + (size_t)(128 + row) * D + cs * 8, 1);
        f32x16 acc[8];
#pragma unroll
        for (int mb = 0; mb < 8; ++mb)
#pragma unroll
            for (int e = 0; e < 16; ++e) acc[mb][e] = 0.f;
#pragma unroll
        for (int kh = 0; kh < 2; ++kh) {
#pragma unroll
            for (int ks = 0; ks < 16; ++ks) {
                int rr = r; asm volatile("" : "+v"(rr));
                const LAS unsigned char* kp = lds + kh * 65536 + rr * 512 + (((2 * ks + hh) ^ rr) << 4);
#pragma unroll
                for (int mb = 0; mb < 4; ++mb) { const bf16x8 kf = *(const LAS bf16x8*)(kp + mb * 16384);
                    acc[4 * kh + mb] = __builtin_amdgcn_mfma_f32_32x32x16_bf16(kf, q[ks], acc[4 * kh + mb], 0, 0, 0); } }
            if (kh == 0) { asm volatile("s_waitcnt vmcnt(0)" ::: "memory"); XA_BAR();
                XA_DMA(vb + (size_t)row * MMEM + cs * 8, 0); }
        }
        float mx = acc[0][0];
#pragma unroll
        for (int mb = 0; mb < 8; ++mb)
#pragma unroll
            for (int e = 0; e < 16; ++e) mx = fmaxf(mx, acc[mb][e]);
        mx = fmaxf(mx, shx(mx, 32, lane));
        float sm = 0.f;
#pragma unroll
        for (int mb = 0; mb < 8; ++mb)
#pragma unroll
            for (int e = 0; e < 16; ++e) { acc[mb][e] = __expf(acc[mb][e] - mx); sm += acc[mb][e]; }
        sm += shx(sm, 32, lane);
        const float inv = __builtin_amdgcn_rcpf(sm);
        bf16x8 P[8][2];
#pragma unroll
        for (int mb = 0; mb < 8; ++mb)
#pragma unroll
            for (int s_ = 0; s_ < 2; ++s_) { u32x4 p; p.x = pk2(acc[mb][8 * s_] * inv, acc[mb][8 * s_ + 1] * inv); p.y = pk2(acc[mb][8 * s_ + 2] * inv, acc[mb][8 * s_ + 3] * inv);
                p.z = pk2(acc[mb][8 * s_ + 4] * inv, acc[mb][8 * s_ + 5] * inv); p.w = pk2(acc[mb][8 * s_ + 6] * inv, acc[mb][8 * s_ + 7] * inv); P[mb][s_] = __builtin_bit_cast(bf16x8, p); }
#pragma unroll
        for (int mb = 0; mb < 8; ++mb) { asm volatile("" : "+v"(P[mb][0])); asm volatile("" : "+v"(P[mb][1])); }
        asm volatile("s_waitcnt vmcnt(0)" ::: "memory"); XA_BAR();
        XA_DMA(vb + (size_t)(128 + row) * MMEM + cs * 8, 1);
#pragma unroll
        for (int dh = 0; dh < 2; ++dh) {
            if (dh == 1) { asm volatile("s_waitcnt vmcnt(16)" ::: "memory"); XA_BAR(); }
            f32x16 o[4];
#pragma unroll
            for (int db = 0; db < 4; ++db)
#pragma unroll
                for (int e = 0; e < 16; ++e) o[db][e] = 0.f;
#pragma unroll
            for (int mb = 0; mb < 8; ++mb)
#pragma unroll
                for (int s_ = 0; s_ < 2; ++s_) {
                    int rr = r; asm volatile("" : "+v"(rr));
                    const LAS unsigned char* vlo = lds + dh * 65536 + rr * 512 + 8 * hh + (((4 * mb + 2 * s_) ^ rr) << 4); const LAS unsigned char* vhi = lds + dh * 65536 + rr * 512 + 8 * hh + (((4 * mb + 2 * s_ + 1) ^ rr) << 4);
#pragma unroll
                    for (int db = 0; db < 4; ++db) { const u32x2 lo = *(const LAS u32x2*)(vlo + db * 16384), hi = *(const LAS u32x2*)(vhi + db * 16384);
                        u32x4 a4; a4.x = lo.x; a4.y = lo.y; a4.z = hi.x; a4.w = hi.y;
                        o[db] = __builtin_amdgcn_mfma_f32_32x32x16_bf16(__builtin_bit_cast(bf16x8, a4), P[mb][s_], o[db], 0, 0, 0); } }
#pragma unroll
            for (int db = 0; db < 4; ++db)
#pragma unroll
                for (int g = 0; g < 4; ++g) { u32x2 w; w.x = pk2(o[db][4 * g], o[db][4 * g + 1]); w.y = pk2(o[db][4 * g + 2], o[db][4 * g + 3]); *(u32x2*)(qrow + 128 * dh + 32 * db + 8 * g + 4 * hh) = w; }
        }
        XA_BAR();
    }
#undef XA_BAR
#undef XA_DMA
    asm volatile("s_waitcnt vmcnt(0)" ::: "memory");
    __syncthreads();
}

__device__ __forceinline__ void softmax_rows(unsigned char* ws, int gw, int NGW, int lane) {
    bf16* Zb = (bf16*)(ws + WS_Z);
    for (int m = gw; m < MH; m += NGW) {
        u32x4* p = (u32x4*)(Zb + (size_t)m * ZLD + ZC_XQ + 16 * lane); const u32x4 x0 = p[0], x1 = p[1];
        float v[16] = { bflo(x0.x), bfhi(x0.x), bflo(x0.y), bfhi(x0.y), bflo(x0.z), bfhi(x0.z), bflo(x0.w), bfhi(x0.w), bflo(x1.x), bfhi(x1.x), bflo(x1.y), bfhi(x1.y), bflo(x1.z), bfhi(x1.z), bflo(x1.w), bfhi(x1.w) };
        float mx = v[0];
#pragma unroll
        for (int e = 1; e < 16; ++e) mx = fmaxf(mx, v[e]);
#pragma unroll
        for (int o = 1; o < 16; o <<= 1) mx = fmaxf(mx, shx(mx, o, lane));
        float s = 0.f;
#pragma unroll
        for (int e = 0; e < 16; ++e) { v[e] = __expf(v[e] - mx); s += v[e]; }
#pragma unroll
        for (int o = 1; o < 16; o <<= 1) s += shx(s, o, lane);
        const float inv = 1.f / s;
        u32x4 y0, y1; y0.x = pk2(v[0] * inv, v[1] * inv); y0.y = pk2(v[2] * inv, v[3] * inv); y0.z = pk2(v[4] * inv, v[5] * inv); y0.w = pk2(v[6] * inv, v[7] * inv);
        y1.x = pk2(v[8] * inv, v[9] * inv); y1.y = pk2(v[10] * inv, v[11] * inv); y1.z = pk2(v[12] * inv, v[13] * inv); y1.w = pk2(v[14] * inv, v[15] * inv);
        p[0] = y0; p[1] = y1;
    }
}

__global__ void __launch_bounds__(NTHR, 2) trunk_fwd(Args args) {
    extern __shared__ __attribute__((aligned(16))) unsigned char lds_raw[];
    LAS unsigned char* lds = (LAS unsigned char*)lds_raw;
    volatile LAS unsigned* MISC = (volatile LAS unsigned*)(lds + MISC_OFF);
    const int G = gridDim.x, cu = blockIdx.x;
    unsigned char* ws = args.ws;
#define PHASE_IDS() int tid = threadIdx.x; asm volatile("" : "+v"(tid)); const int lane = tid & 63, wave = __builtin_amdgcn_readfirstlane(tid >> 6); \
    const int vcu = (G % 8 == 0) ? (cu % 8) * (G / 8) + cu / 8 : cu; const int gw = vcu * NWAVES + wave, NGW = G * NWAVES, gtid = cu * NTHR + tid, GT = G * NTHR; (void)gw; (void)NGW; (void)gtid; (void)GT; (void)lane
    for (int u = threadIdx.x; u < (LDS_BYTES - RING_BYTES) / 4; u += NTHR) ((LAS unsigned*)(lds + RING_BYTES))[u] = 0u;
    __syncthreads();
    XcdBarrier bar = xcd_barrier_post((unsigned*)(ws + WS_CTL) + 4096, MISC + 8);
    const int lo = args.ph_lo, hi = args.ph_hi;
    int ph = 0;
#define IN() (lo <= ph && ph < hi)
#define SEAM() do { if (lo <= ph && ph + 1 < hi) xcd_barrier(bar); ++ph; } while (0)
    bf16* XN = (bf16*)(ws + WS_XN); bf16* Wb = (bf16*)(ws + WS_W); float* RSTD = (float*)(ws + WS_RSTD);
    float* hbuf = args.out;

    if (IN()) { PHASE_IDS();
        convert_layer(args, 0, ws, lds, gw, NGW, wave, lane, gtid, GT);
        thin_rows(nullptr, 0, nullptr, 0.f, args.in[I_X], nullptr, XN, RSTD, nullptr, 0, M, gw, NGW, lane, false, nullptr, nullptr, nullptr, nullptr, nullptr);
        __syncthreads();
    }
    SEAM();

    for (int sb = 0; sb < 2 * DEPTH; ++sb) {
        const int l = sb >> 1, j = sb & 1;
        const float* ng = args.in[I_NORMG] + (size_t)l * NNORM * D;
        if (IN()) { PHASE_IDS();
            pg8::Gemm g{D, D, D}; pg8::TileSched S; S.init(M / 256, 2 * DFF / 256, G, cu, XN, D * 2, (char*)Wb + (j ? WO_GU1 : WO_GU0), D * 2);
            pg8::EpiGU E{(bf16*)(ws + WS_HID), RSTD};
            pg8::gemm_phase(lds, g, S, E, tid);
        }
        SEAM();
        if (IN()) { PHASE_IDS();
            pg8::Gemm g{DFF, DFF, DFF}; pg8::TileSched S; S.init(M / 256, D / 256, G, cu, ws + WS_HID, DFF * 2, (char*)Wb + (j ? WO_D1 : WO_D0), DFF * 2);
            pg8::EpiAct E{(bf16*)(ws + WS_F), (size_t)D, 0, nullptr, nullptr};
            pg8::gemm_phase(lds, g, S, E, tid);
        }
        SEAM();
        if (IN()) { PHASE_IDS();
            if (j == 0) {
                LAS float* wif = (LAS float*)lds;
                for (int e = tid; e < D * 8 / 2; e += NTHR) { const float* src = (const float*)(ws + WS_WIF) + 2 * e; ((LAS unsigned*)wif)[e] = pk2(src[0], src[1]); }
                __syncthreads();
                float* gi = (float*)(ws + WS_GATE);
                const float* hx = (sb == 0) ? args.in[I_X] : nullptr;
                if (G == 256) {
                    const bool kvcu = (cu < 32) || (cu >= 128 && cu < 160);
                    if (kvcu) { const int gwk = ((cu < 32) ? cu : cu - 96) * NWAVES + wave;
                        thin_rows((const bf16*)(ws + WS_F), D, ng + 1 * D, 0.5f, hx, XN, XN, RSTD, nullptr, 0, 3072, gwk, 512, lane, true, wif, args.in[I_BI] + l * 4, args.in[I_BF] + l * 4, gi, gi + (size_t)M * 4); }
                    else { const int cun = (cu < 128) ? cu - 32 : cu - 64; const int gwn = cun * NWAVES + wave;
                        thin_rows((const bf16*)(ws + WS_F) + (size_t)3072 * D, D, ng + 1 * D, 0.5f, hx, XN, XN, RSTD, nullptr, 3072, M, gwn, 1536, lane, true, wif, args.in[I_BI] + l * 4, args.in[I_BF] + l * 4, gi, gi + (size_t)M * 4); }
                } else
                thin_rows((const bf16*)(ws + WS_F), D, ng + 1 * D, 0.5f, hx, XN, XN, RSTD, nullptr, 0, M, gw, NGW, lane, true, wif, args.in[I_BI] + l * 4, args.in[I_BF] + l * 4, gi, gi + (size_t)M * 4);
                __syncthreads();
                {
                    pg8::Gemm g{D, D, D};
                    pg8::TileSched S; S.init(MMEM / 256, D / 256, G, cu, ws + WS_MEMN, D * 2, (char*)Wb + WO_MKV, D * 2);
                    pg8::EpiAct E{(bf16*)(ws + WS_KMEM), (size_t)D, 0, nullptr, nullptr};
                    pg8::gemm_phase(lds, g, S, E, tid);
                    pg8::TileSched S2; S2.init(D / 256, MMEM / 256, G, (cu + G / 2) % G, (char*)Wb + WO_MKV + (size_t)D * D * 2, D * 2, ws + WS_MEMN, D * 2);
                    pg8::EpiAct E2{(bf16*)(ws + WS_VTMEM), (size_t)MMEM, 0, nullptr, nullptr};
                    pg8::gemm_phase(lds, g, S2, E2, tid);
                }
            } else {
                const bool lastl = (l + 1 == DEPTH);
                thin_rows((const bf16*)(ws + WS_F), D, ng + 5 * D, 0.5f, nullptr, XN, lastl ? nullptr : XN, RSTD, lastl ? hbuf : nullptr, 0, M, gw, NGW, lane, false, nullptr, nullptr, nullptr, nullptr, nullptr);
                if (l + 1 < DEPTH) { __syncthreads(); convert_layer(args, l + 1, ws, lds, gw, NGW, wave, lane, gtid, GT); __syncthreads(); }
            }
        }
        SEAM();
        if (j == 0) {
            for (int hf = 0; hf < 2; ++hf) {
                bf16* Zb = (bf16*)(ws + WS_Z);
                if (IN()) { PHASE_IDS();
                    if (hf == 1) { thin_rows((const bf16*)(ws + WS_ST), D, ng + 3 * D, 1.0f, nullptr, XN, XN, RSTD, nullptr, 0, MH, gw, NGW, lane, false, nullptr, nullptr, nullptr, nullptr, nullptr); __syncthreads(); }
                    pg8::Gemm g{D, D, D};
                    pg8::TileSched S; S.init(MH / 256, ZLD / 256, G, cu, XN + (size_t)hf * MH * D, D * 2, (char*)Wb + WO_IN, D * 2);
                    pg8::EpiAct E{Zb, (size_t)ZLD, 1, RSTD + (size_t)hf * MH, nullptr};
                    pg8::gemm_phase(lds, g, S, E, tid);
                    pg8::TileSched S2; S2.init(2048 / 256, MH / 256, G, cu, (char*)Wb + WO_IN + (size_t)ZLD * D * 2, D * 2, XN + (size_t)hf * MH * D, D * 2);
                    pg8::EpiAct E2{(bf16*)(ws + WS_ZT), (size_t)ZTLD, 2, nullptr, RSTD + (size_t)hf * MH};
                    pg8::gemm_phase(lds, g, S2, E2, tid);
                }
                SEAM();
                if (IN()) { PHASE_IDS();
                    mlstm_s1(args, l, hf, ws, lds, G, cu, tid, wave, lane);
                    sgu_phase(args, l, ws, lds, G, cu, tid, wave, lane, ZC_U);
                    xattn_phase(ws, hf, lds, G, cu, tid, wave, lane);
                }
                SEAM();
                if (IN()) { PHASE_IDS();
                    mlstm_s2(ws, G, cu, tid);
                }
                SEAM();
                if (IN()) { PHASE_IDS();
                    mlstm_s3(args, l, hf, ws, lds, G, cu, tid, wave, lane, ZC_O);
#ifdef PROBE_S3
                    for (int rep_ = 0; rep_ < 2; ++rep_) mlstm_s3(args, l, hf, ws, lds, G, cu, tid, wave, lane, ZC_QK);
#endif
#ifdef PROBE_SGU
                    for (int rep_ = 0; rep_ < 2; ++rep_) sgu_phase(args, l, ws, lds, G, cu, tid, wave, lane, ZC_QK);
#endif
                }
                SEAM();
                if (IN()) { PHASE_IDS();
                    pg8::Gemm g{D, ZLD, D};
                    pg8::TileSched S; S.init(MH / 256, D / 256, G, cu, Zb + ZC_O, ZLD * 2, (char*)Wb + WO_BR, D * 2);
                    S.reps = 3; S.a_rep = 1024 * 2; S.b_rep = (size_t)D * D * 2;
                    pg8::EpiBranch E{Zb};
                    pg8::gemm_phase(lds, g, S, E, tid);
                }
                SEAM();
                if (IN()) { PHASE_IDS();
                    pg8::Gemm g{D, ZLD, D};
                    pg8::TileSched S; S.init(MH / 256, D / 256, G, cu, Zb + ZC_QK, ZLD * 2, (char*)Wb + WO_OUT, D * 2);
                    pg8::EpiAct E{(hf == 0) ? (bf16*)(ws + WS_ST) : Zb + ZC_O, (hf == 0) ? (size_t)D : (size_t)ZLD, 0, nullptr, nullptr};
                    pg8::gemm_phase(lds, g, S, E, tid);
                }
                SEAM();
                if (hf == 1) {
                if (IN()) { PHASE_IDS();
                    thin_rows(Zb + ZC_O, ZLD, ng + 3 * D, 1.0f, nullptr, XN, XN, RSTD, nullptr, hf * MH, (hf + 1) * MH, gw, NGW, lane, false, nullptr, nullptr, nullptr, nullptr, nullptr);
                }
                SEAM();
                }
            }
        }
    }
#undef IN
#undef SEAM
}
constexpr int N_PHASES = 1 + 2 * DEPTH * 3 + DEPTH * (2 * 7 - 1);

#ifndef N_LAUNCH_MODE
#define N_LAUNCH_MODE 0
#endif
extern "C" void kernel_launch(void* const* d_in, const int* in_sizes, int n_in, void* d_out, int out_size, void* d_ws, size_t ws_size, hipStream_t stream) {
    static int grid = 0;
    if (grid == 0) {
        if (n_in != 18 || out_size != M * D || ws_size < WS_END) { fprintf(stderr, "kernel_launch: unexpected shapes (n_in %d out %d ws %zu)\n", n_in, out_size, ws_size); grid = -1; return; }
        int dev = 0, cus = 0, per_cu = 0;
        if (hipGetDevice(&dev) != hipSuccess || hipDeviceGetAttribute(&cus, hipDeviceAttributeMultiprocessorCount, dev) != hipSuccess) { grid = -1; return; }
        if (hipFuncSetAttribute((const void*)trunk_fwd, hipFuncAttributeMaxDynamicSharedMemorySize, LDS_BYTES) != hipSuccess) { grid = -1; return; }
        if (hipOccupancyMaxActiveBlocksPerMultiprocessor(&per_cu, (const void*)trunk_fwd, NTHR, LDS_BYTES) != hipSuccess || per_cu < 1) { fprintf(stderr, "kernel_launch: occupancy query says %d\n", per_cu); }
        (void)hipGetLastError();
        grid = cus;
    }
    if (grid < 0) return;
    (void)hipMemsetAsync((char*)d_ws + WS_CTL, 0, CTL_ZERO_BYTES, stream);
    Args a{};
    for (int i = 0; i < 18; ++i) a.in[i] = (const float*)d_in[i];
    a.out = (float*)d_out; a.ws = (unsigned char*)d_ws;
#if N_LAUNCH_MODE == 0
    a.ph_lo = 0; a.ph_hi = N_PHASES;
    hipLaunchKernelGGL(trunk_fwd, dim3(grid), dim3(NTHR), LDS_BYTES, stream, a);
#else
    for (int p = 0; p < N_PHASES; ++p) { a.ph_lo = p; a.ph_hi = p + 1; hipLaunchKernelGGL(trunk_fwd, dim3(grid), dim3(NTHR), LDS_BYTES, stream, a); }
#endif
}
```

```cpp
#include <hip/hip_runtime.h>
#include <cstdio>
#include <cstdint>

#define LAS __attribute__((address_space(3)))
#define GAS __attribute__((address_space(1)))
typedef unsigned short bf16;
typedef short bf16x8 __attribute__((ext_vector_type(8)));
typedef float f32x4 __attribute__((ext_vector_type(4)));
typedef float f32x16 __attribute__((ext_vector_type(16)));
typedef unsigned u32x4 __attribute__((ext_vector_type(4)));
typedef unsigned u32x2 __attribute__((ext_vector_type(2)));

constexpr int D = 1024, BATCH = 8, SEQ = 4096, DEPTH = 2, MEMLEN = 256, DFF = 2816, NNORM = 7;
constexpr int M = BATCH * SEQ, MH = M / 2, MMEM = BATCH * MEMLEN;
constexpr int WIN_COLS = 9224;
constexpr int LCH = 64, NCH = SEQ / LCH;
constexpr int ZLD = 7168;
constexpr int ZC_QK = 0, ZC_O = 1024, ZC_U = 2048, ZC_XQ = 3072, ZC_G = 4096;
constexpr int ZTLD = MH;
constexpr float EPS = 1e-6f;
constexpr int NWAVES = 8, NTHR = 512;

constexpr size_t MiB = 1u << 20;
constexpr size_t WS_CTL = 0, CTL_ZERO_BYTES = 32 * 1024;
constexpr size_t WS_WSGU = 1 * MiB;
constexpr size_t WS_GATE = 2 * MiB;
constexpr size_t WS_NST = 3 * MiB;
constexpr size_t WS_CSC = 4 * MiB;
constexpr size_t WS_MEMN = 5 * MiB;
constexpr size_t WS_KMEM = 9 * MiB;
constexpr size_t WS_VTMEM = 13 * MiB;
constexpr size_t WS_W = 17 * MiB;
constexpr size_t WO_GU0 = 0, WO_GU1 = 11 * MiB, WO_D0 = 22 * MiB, WO_D1 = WO_D0 + 5632 * 1024, WO_IN = 33 * MiB, WO_MKV = 51 * MiB, WO_BR = 55 * MiB, WO_OUT = 61 * MiB;
constexpr size_t WS_XN = 80 * MiB;
constexpr size_t WS_WIF = 4 * MiB + 256 * 1024;
constexpr size_t WS_RSTD = 4 * MiB + 512 * 1024;
constexpr size_t WS_BIG = 144 * MiB;
constexpr size_t WS_HID = WS_BIG, WS_F = WS_BIG + 176 * MiB, WS_Z = WS_BIG, WS_ZT = WS_BIG + 224 * MiB;
constexpr size_t WS_ST = 432 * MiB;
constexpr size_t WS_KC = 496 * MiB;
constexpr size_t WS_END = 512 * MiB;

constexpr int LDS_BYTES = 147456;
constexpr int RING_BYTES = 131072;
constexpr int MISC_OFF = RING_BYTES + 320;

typedef float f32x2_t __attribute__((ext_vector_type(2))); typedef float f32x2_t __attribute__((ext_vector_type(2)));
__device__ __forceinline__ unsigned pk4_fp8(float a, float b, float c, float d) { int w = __builtin_amdgcn_cvt_pk_fp8_f32(a, b, 0, false); w = __builtin_amdgcn_cvt_pk_fp8_f32(c, d, w, true); return (unsigned)w; }
__device__ __forceinline__ f32x2_t fp8lo2(unsigned w) { return __builtin_amdgcn_cvt_pk_f32_fp8((int)w, false); }
__device__ __forceinline__ f32x2_t fp8hi2(unsigned w) { return __builtin_amdgcn_cvt_pk_f32_fp8((int)w, true); }
typedef __bf16 bf16x2_t __attribute__((ext_vector_type(2)));
__device__ __forceinline__ unsigned pk2(float lo, float hi) { f32x2_t v = {lo, hi}; bf16x2_t b = __builtin_convertvector(v, bf16x2_t); return __builtin_bit_cast(unsigned, b); }
__device__ __forceinline__ unsigned f2bf(float f) { return pk2(f, 0.f) & 0xffffu; }
__device__ __forceinline__ float bflo(unsigned w) { return __uint_as_float(w << 16); }
__device__ __forceinline__ float bfhi(unsigned w) { return __uint_as_float(w & 0xffff0000u); }
__device__ __forceinline__ float bf1(bf16 b) { return __uint_as_float((unsigned)b << 16); }
__device__ __forceinline__ float shx(float v, int mask, int lane) { return __builtin_bit_cast(float, __builtin_amdgcn_ds_bpermute((lane ^ mask) << 2, __builtin_bit_cast(int, v))); }
__device__ __forceinline__ float shidx(float v, int src) { return __builtin_bit_cast(float, __builtin_amdgcn_ds_bpermute(src << 2, __builtin_bit_cast(int, v))); }
#define DPP_XOR1 0xB1
#define DPP_XOR2 0x4E
#define DPP_HMIR 0x141
#define DPP_MIR  0x140
template <int CTRL> __device__ __forceinline__ float dppf(float v) { return __builtin_bit_cast(float, __builtin_amdgcn_mov_dpp(__builtin_bit_cast(int, v), CTRL, 0xF, 0xF, true)); }
__device__ __forceinline__ float row16_sum(float v) { v += dppf<DPP_XOR1>(v); v += dppf<DPP_XOR2>(v); v += dppf<DPP_HMIR>(v); v += dppf<DPP_MIR>(v); return v; }
__device__ __forceinline__ float row16_max(float v) { v = fmaxf(v, dppf<DPP_XOR1>(v)); v = fmaxf(v, dppf<DPP_XOR2>(v)); v = fmaxf(v, dppf<DPP_HMIR>(v)); v = fmaxf(v, dppf<DPP_MIR>(v)); return v; }
__device__ __forceinline__ float grp8_sum(float v) { v += dppf<DPP_XOR1>(v); v += dppf<DPP_XOR2>(v); v += dppf<DPP_HMIR>(v); return v; }
__device__ __forceinline__ float wave_sum(float v, int lane) { v = row16_sum(v); v += shx(v, 16, lane); v += shx(v, 32, lane); return v; }
typedef __bf16 bf16x2_t __attribute__((ext_vector_type(2)));
__device__ __forceinline__ float dot2_bf16(unsigned w, unsigned x, float acc) { return __builtin_amdgcn_fdot2_f32_bf16(__builtin_bit_cast(bf16x2_t, w), __builtin_bit_cast(bf16x2_t, x), acc, false); }
__device__ __forceinline__ float sigmoidf_(float x) { return __builtin_amdgcn_rcpf(1.f + __expf(-x)); }
__device__ __forceinline__ float siluf_(float x) { return x * __builtin_amdgcn_rcpf(1.f + __expf(-x)); }
__device__ __forceinline__ float gelu_tanh(float x) { const float u = 1.5957691216f * (x + 0.044715f * x * x * x); return x * __builtin_amdgcn_rcpf(1.f + __expf(-u)); }
__device__ __forceinline__ float logsigmoidf_(float x) { return fminf(x, 0.f) - __logf(1.f + __expf(-fabsf(x))); }
#define LDS_WAIT() asm volatile("s_waitcnt lgkmcnt(0)" ::: "memory")
#define VM_WAIT() asm volatile("s_waitcnt vmcnt(0)" ::: "memory")

namespace pg8 {
constexpr int BM = 256, BK = 64, HALF = 128, HTB = HALF * BK * 2, STAGE_BYTES = 8 * HTB, NXCD = 8, WGM = 8;
__host__ __device__ __forceinline__ int lds_byte(int r, int c) { const int st = (r >> 4) * 2 + (c >> 5), rr = r & 15, cc = c & 31, ob = rr * 64 + cc * 2; return st * 1024 + (ob ^ (((ob >> 9) & 1) << 5)); }
__host__ __device__ __forceinline__ void stage_rc(int b, int& R, int& C) { const int st = b / 1024, sb = b % 1024, swz = sb ^ (((sb >> 9) & 1) << 5); R = (st >> 1) * 16 + swz / 64; C = (st & 1) * 32 + (swz % 64) / 2; }
__host__ __device__ __forceinline__ int perm32(int rho) { const int n = rho >> 4, i = rho & 15; return 8 * (i >> 2) + 4 * n + (i & 3); }

struct Unit { int pm, pn, aux; const char* a; const char* b; };
struct Gemm { int K, lda, ldb; };

struct TileSched {
    int nM, nN, nwg, G, c, reps, pm_per_b;
    const char* A; const char* B;
    size_t a_tile, a_pn, a_rep, b_tile, b_batch, b_rep;
    __device__ __forceinline__ void init(int nM_, int nN_, int G_, int c_, const void* A_, size_t lda_bytes, const void* B_, size_t ldb_bytes) {
        nM = nM_; nN = nN_; nwg = nM * nN; G = G_; c = c_; reps = 1; pm_per_b = 1 << 30; A = (const char*)A_; B = (const char*)B_;
        a_tile = 256 * lda_bytes; a_pn = 0; a_rep = 0; b_tile = 256 * ldb_bytes; b_batch = 0; b_rep = 0;
    }
    __device__ __forceinline__ bool next(int i, Unit& u) const {
        const int ti = i / reps, aux = i - ti * reps;
        const long L = (long)ti * G + c; if (L >= nwg) return false;
        int wgid = (int)L; { const int q = nwg / NXCD, r = nwg % NXCD, xcd = wgid % NXCD, off = wgid / NXCD; wgid = (xcd < r ? xcd * (q + 1) : r * (q + 1) + (xcd - r) * q) + off; }
        const int nig = WGM * nN, gid = wgid / nig, fm = gid * WGM, gsz = (nM - fm) < WGM ? (nM - fm) : WGM;
        u.pm = fm + ((wgid % nig) % gsz); u.pn = (wgid % nig) / gsz; u.aux = aux;
        u.a = A + (size_t)u.pm * a_tile + (size_t)u.pn * a_pn + (size_t)aux * a_rep;
        u.b = B + (size_t)u.pn * b_tile + (size_t)(u.pm / pm_per_b) * b_batch + (size_t)aux * b_rep;
        return true;
    }
};

__device__ __forceinline__ unsigned cvt_pk_bf16(float lo, float hi) { return pk2(lo, hi); }

__device__ __forceinline__ void gate_ratio8(float (&zd)[8], float (&zn)[8], float nf) {
#pragma unroll
    for (int i = 0; i < 8; ++i) { zd[i] = -1.44269504f * fminf(fmaxf(zd[i], -60.f), 60.f); zn[i] = -1.44269504f * fminf(fmaxf(zn[i], -60.f), 60.f); }
#pragma unroll
    for (int i = 0; i < 8; ++i) { zd[i] = __builtin_amdgcn_exp2f(zd[i]); zn[i] = __builtin_amdgcn_exp2f(zn[i]); }
#pragma unroll
    for (int i = 0; i < 8; ++i) zd[i] = __builtin_amdgcn_rcpf(1.f + zd[i]);
#pragma unroll
    for (int i = 0; i < 8; ++i) zd[i] = fmaf(zn[i], nf, 1.f) * zd[i];
}
__device__ __forceinline__ float gate_ratio(float zd, float zn, float nf) {
    const float ed = __expf(-fminf(fmaxf(zd, -60.f), 60.f)), en = __expf(-fminf(fmaxf(zn, -60.f), 60.f));
    return fmaf(en, nf, 1.f) * __builtin_amdgcn_rcpf(1.f + ed);
}
template <int ACT> __device__ __forceinline__ float actf(float x) {
    if (ACT == 1) return sigmoidf_(x);
    if (ACT == 2) return gelu_tanh(x);
    if (ACT == 3) return x * 0.0625f;
    return x;
}
template <int ACT> __device__ __forceinline__ void act8(float (&v)[8]) {
    if (ACT == 1 || ACT == 2) { float t[8], e[8];
#pragma unroll
        for (int i = 0; i < 8; ++i) t[i] = (ACT == 1) ? -1.44269504f * v[i] : (-1.44269504f * 1.5957691216f) * (v[i] + 0.044715f * v[i] * v[i] * v[i]);
#pragma unroll
        for (int i = 0; i < 8; ++i) e[i] = __builtin_amdgcn_exp2f(t[i]);
#pragma unroll
        for (int i = 0; i < 8; ++i) e[i] = __builtin_amdgcn_rcpf(1.f + e[i]);
#pragma unroll
        for (int i = 0; i < 8; ++i) v[i] = (ACT == 1) ? e[i] : v[i] * e[i];
    } else if (ACT == 3) {
#pragma unroll
        for (int i = 0; i < 8; ++i) v[i] *= 0.0625f;
    }
}
template <int ACT, int SC> __device__ __forceinline__ void store_tile_bf16(const f32x4 (&acc)[2][2][4][2], bf16* O, size_t ldc, int row0, int col0, const LAS float* rsl, const LAS float* csl) {
    f32x4 cs[2][2];
#pragma unroll
    for (int bj = 0; bj < 2; ++bj)
#pragma unroll
        for (int n = 0; n < 2; ++n) cs[bj][n] = (SC == 2) ? *(const LAS f32x4*)(csl + bj * HALF + 4 * n) : (f32x4){1.f, 1.f, 1.f, 1.f};
#pragma unroll
    for (int ai = 0; ai < 2; ++ai)
#pragma unroll
        for (int m = 0; m < 4; ++m) { const int row = row0 + ai * HALF + m * 16; bf16* rowp = O + (size_t)row * ldc + col0; const float rr = (SC == 1) ? rsl[ai * HALF + m * 16] : 1.f;
#pragma unroll
            for (int bj = 0; bj < 2; ++bj) { f32x4 v0 = acc[ai][bj][m][0], v1 = acc[ai][bj][m][1]; u32x4 w;
                if (SC == 1) { v0 = v0 * rr; v1 = v1 * rr; } else if (SC == 2) { v0 = v0 * cs[bj][0]; v1 = v1 * cs[bj][1]; }
                float v[8] = {v0[0], v0[1], v0[2], v0[3], v1[0], v1[1], v1[2], v1[3]};
                if (ACT == 4 || ACT == 5) {
                    const f32x4 t0 = v0 * (-1.44269504f), t1 = v1 * (-1.44269504f); f32x4 e0, e1, r0, r1;
#pragma unroll
                    for (int i = 0; i < 4; ++i) { e0[i] = __builtin_amdgcn_exp2f(t0[i]); e1[i] = __builtin_amdgcn_exp2f(t1[i]); }
                    const f32x4 d0 = e0 * (1.f / 255.f) + (1.f / 255.f), d1 = e1 * (1.f / 255.f) + (1.f / 255.f);
#pragma unroll
                    for (int i = 0; i < 4; ++i) { r0[i] = __builtin_amdgcn_rcpf(d0[i]); r1[i] = __builtin_amdgcn_rcpf(d1[i]); }
                    const f32x4 one4 = (f32x4){1.f, 1.f, 1.f, 1.f}; const f32x4 k0 = __builtin_elementwise_max(r0 + 0.5f, one4), k1 = __builtin_elementwise_max(r1 + 0.5f, one4);
                    unsigned kk[8];
#pragma unroll
                    for (int i = 0; i < 4; ++i) { kk[i] = (unsigned)k0[i]; kk[4 + i] = (unsigned)k1[i]; }
                    u32x2 wb; wb.x = kk[0] | (kk[1] << 8) | (kk[2] << 16) | (kk[3] << 24); wb.y = kk[4] | (kk[5] << 8) | (kk[6] << 16) | (kk[7] << 24);
                    constexpr int CB = (ACT == 4) ? ZC_G : ZC_O; const int cO = (col0 - CB) + bj * HALF;
                    *(u32x2*)((unsigned char*)(O + (size_t)row * ldc + CB) + ((ACT == 5) ? ((cO >> 8) << 9) + (cO & 255) : cO)) = wb;
                    continue; }
                act8<ACT>(v);
                w.x = cvt_pk_bf16(v[0], v[1]); w.y = cvt_pk_bf16(v[2], v[3]); w.z = cvt_pk_bf16(v[4], v[5]); w.w = cvt_pk_bf16(v[6], v[7]);
                if (ACT == 3) {
                    const int colh = (col0 & 255) + bj * HALF, ks = colh >> 4, hh = (colh >> 3) & 1;
                    *(u32x4*)(O + (size_t)((row & ~31) + 2 * ks + hh) * ldc + (col0 & ~255) + 8 * (row & 31)) = w;
                } else *(u32x4*)(rowp + bj * HALF) = w; } }
}
struct EpiAct {
    static constexpr bool PERM = true; static constexpr bool CHAIN = false;
    bf16* O; size_t ldc; int mode; const float* rsrow; const float* rscol;
    __device__ __forceinline__ const float* row_scale() const { return rsrow; }
    __device__ __forceinline__ const float* col_scale() const { return rscol; }
    __device__ __forceinline__ void operator()(const f32x4 (&acc)[2][2][4][2], const Unit& u, int wr, int wc, int fr, int fq, const LAS float* rsb) const {
        const int row0 = u.pm * BM + wr * 64 + fr, col0 = u.pn * BM + wc * 32 + 8 * fq;
        const LAS float* rsl = rsb + wr * 64 + fr; const LAS float* csl = rsb + wc * 32 + 8 * fq;
        if (mode == 1) { const int g = u.pn >> 2;
            if (g == 1) store_tile_bf16<5, 1>(acc, O, ldc, row0, col0, rsl, csl);
            else if (g == 2) store_tile_bf16<2, 1>(acc, O, ldc, row0, col0, rsl, csl);
            else if (g == 3) store_tile_bf16<3, 1>(acc, O, ldc, row0, col0, rsl, csl);
            else if (g >= 4) store_tile_bf16<4, 1>(acc, O, ldc, row0, col0, rsl, csl);
            else store_tile_bf16<0, 1>(acc, O, ldc, row0, col0, rsl, csl); }
        else if (mode == 2) { if (u.pm >= 4) store_tile_bf16<2, 2>(acc, O, ldc, row0, col0, rsl, csl); else store_tile_bf16<0, 2>(acc, O, ldc, row0, col0, rsl, csl); }
        else store_tile_bf16<0, 0>(acc, O, ldc, row0, col0, rsl, csl);
    }
};
struct EpiGU {
    static constexpr bool PERM = true; static constexpr bool CHAIN = false;
    bf16* O; const float* rsrow;
    __device__ __forceinline__ const float* row_scale() const { return rsrow; }
    __device__ __forceinline__ const float* col_scale() const { return nullptr; }
    __device__ __forceinline__ void operator()(const f32x4 (&acc)[2][2][4][2], const Unit& u, int wr, int wc, int fr, int fq, const LAS float* rsb) const {
        const LAS float* rsl = rsb + wr * 64 + fr;
        const int row0 = u.pm * BM + wr * 64 + fr, col0 = u.pn * HALF + wc * 32 + 8 * fq;
#pragma unroll
        for (int ai = 0; ai < 2; ++ai)
#pragma unroll
            for (int m = 0; m < 4; ++m) { const int row = row0 + ai * HALF + m * 16; bf16* rowp = O + (size_t)row * DFF + col0; const float rr = rsl[ai * HALF + m * 16];
                const float c = -1.44269504f * rr, rr2 = rr * rr;
                const f32x4 g0 = acc[ai][0][m][0], g1 = acc[ai][0][m][1], u0 = acc[ai][1][m][0], u1 = acc[ai][1][m][1];
                const f32x4 t0 = g0 * c, t1 = g1 * c; f32x4 e0, e1, r0, r1;
#pragma unroll
                for (int i = 0; i < 4; ++i) { e0[i] = __builtin_amdgcn_exp2f(t0[i]); e1[i] = __builtin_amdgcn_exp2f(t1[i]); }
                const f32x4 d0 = e0 + 1.f, d1 = e1 + 1.f;
#pragma unroll
                for (int i = 0; i < 4; ++i) { r0[i] = __builtin_amdgcn_rcpf(d0[i]); r1[i] = __builtin_amdgcn_rcpf(d1[i]); }
                const f32x4 p0 = ((g0 * u0) * rr2) * r0, p1 = ((g1 * u1) * rr2) * r1; u32x4 w;
                w.x = cvt_pk_bf16(p0[0], p0[1]); w.y = cvt_pk_bf16(p0[2], p0[3]);
                w.z = cvt_pk_bf16(p1[0], p1[1]); w.w = cvt_pk_bf16(p1[2], p1[3]);
                *(u32x4*)rowp = w; }
    }
};
struct EpiBranch {
    static constexpr bool PERM = true; static constexpr bool CHAIN = true;
    bf16* Zb;
    __device__ __forceinline__ const float* row_scale() const { return nullptr; }
    __device__ __forceinline__ const float* col_scale() const { return nullptr; }
    __device__ __forceinline__ void operator()(f32x4 (&acc)[2][2][4][2], const Unit& u, int wr, int wc, int fr, int fq, const LAS float*) const {
        const int row0 = u.pm * BM + wr * 64 + fr, col0 = u.pn * BM + wc * 32 + 8 * fq; const int j = u.aux;
        bf16* base = Zb + (size_t)row0 * ZLD + col0;
        const unsigned char* gz = (const unsigned char*)(Zb + (size_t)row0 * ZLD + ZC_G) + j * 1024 + col0; const unsigned char* gzn = gz + (j < 2 ? 1024 : 0); const bool last = (j == 2);
#pragma unroll
        for (int q = 0; q < 4; ++q) { const int ai = q >> 1, m0 = (q & 1) * 2;
            asm volatile("" ::: "memory");
            u32x2 za[2][2], zb[2][2];
#pragma unroll
            for (int m = 0; m < 2; ++m)
#pragma unroll
                for (int bj = 0; bj < 2; ++bj) za[m][bj] = *(const u32x2*)(gz + (size_t)(ai * HALF + (m0 + m) * 16) * (ZLD * 2) + bj * HALF);
#pragma unroll
            for (int m = 0; m < 2; ++m)
#pragma unroll
                for (int bj = 0; bj < 2; ++bj) zb[m][bj] = *(const u32x2*)(gzn + (size_t)(ai * HALF + (m0 + m) * 16) * (ZLD * 2) + bj * HALF);
#pragma unroll
            for (int m = 0; m < 2; ++m)
#pragma unroll
                for (int bj = 0; bj < 2; ++bj) { const u32x2 a = za[m][bj], b = zb[m][bj]; float f[8];
#pragma unroll
                    for (int i = 0; i < 4; ++i) { const float ka0 = (float)((a.x >> (8 * i)) & 255u), ka1 = (float)((a.y >> (8 * i)) & 255u);
                        const float kb0 = last ? 255.f : (float)((b.x >> (8 * i)) & 255u), kb1 = last ? 255.f : (float)((b.y >> (8 * i)) & 255u);
                        f[i] = ka0 * __builtin_amdgcn_rcpf(kb0); f[4 + i] = ka1 * __builtin_amdgcn_rcpf(kb1); }
                    acc[ai][bj][m0 + m][0] = acc[ai][bj][m0 + m][0] * (f32x4){f[0], f[1], f[2], f[3]};
                    acc[ai][bj][m0 + m][1] = acc[ai][bj][m0 + m][1] * (f32x4){f[4], f[5], f[6], f[7]}; }
        }
        if (j == 2) {
#pragma unroll
            for (int ai = 0; ai < 2; ++ai)
#pragma unroll
                for (int m = 0; m < 4; ++m)
#pragma unroll
                    for (int bj = 0; bj < 2; ++bj) { const f32x4 v0 = acc[ai][bj][m][0], v1 = acc[ai][bj][m][1]; u32x4 w;
                        w.x = cvt_pk_bf16(v0[0], v0[1]); w.y = cvt_pk_bf16(v0[2], v0[3]); w.z = cvt_pk_bf16(v1[0], v1[1]); w.w = cvt_pk_bf16(v1[2], v1[3]);
                        *(u32x4*)(base + (size_t)(ai * HALF + m * 16) * ZLD + ZC_QK + bj * HALF) = w; }
        }
    }
};

template <class Epi, class Sched>
__device__ __forceinline__ void gemm_phase(LAS unsigned char* lds, const Gemm g, const Sched& S, const Epi& E, const int tid) {
    const int wid = __builtin_amdgcn_readfirstlane(tid >> 6), lane = tid & 63, wr = wid >> 2, wc = wid & 3, fr = lane & 15, fq = lane >> 4;
    const int nt = g.K / BK;
    unsigned voffA[2], voffB[2];
#pragma unroll
    for (int i = 0; i < 2; ++i) { int R, C; stage_rc(tid * 16 + i * 8192, R, C); const int Rb = Epi::PERM ? ((R & ~31) + perm32(R & 31)) : R;
        voffA[i] = (unsigned)(R * g.lda + C) * 2u; voffB[i] = (unsigned)(Rb * g.ldb + C) * 2u; }
    const size_t kstep = (size_t)(BK * 2);
    const size_t hstepA = (size_t)HALF * g.lda * 2, hstepB = (size_t)HALF * g.ldb * 2;
    const unsigned ldsw = (unsigned)wid * 1024u;
    const int aoff = lds_byte(wr * 64 + fr, fq * 8), boff = lds_byte(wc * 32 + fr, fq * 8);
#define PG8_SA(b, h) (((b) * 2 + (h)) * HTB)
#define PG8_SB(b, h) ((4 + (b) * 2 + (h)) * HTB)
#define PG8_STAGE(bufoff, gbase, voff) do { _Pragma("unroll") for (int _i = 0; _i < 2; ++_i) \
        __builtin_amdgcn_global_load_lds((const unsigned*)((const char*)(gbase) + (voff)[_i]), (LAS unsigned*)(lds + (bufoff) + ldsw + _i * 8192), 16, 0, 0); } while (0)
#define PG8_LDA(dst, b, h) do { _Pragma("unroll") for (int m = 0; m < 4; ++m) _Pragma("unroll") for (int k = 0; k < 2; ++k) dst[m][k] = *(const LAS bf16x8*)(lds + PG8_SA(b, h) + aoff + m * 2048 + k * 1024); } while (0)
#define PG8_LDB(dst, b, h) do { _Pragma("unroll") for (int n = 0; n < 2; ++n) _Pragma("unroll") for (int k = 0; k < 2; ++k) dst[n][k] = *(const LAS bf16x8*)(lds + PG8_SB(b, h) + boff + n * 2048 + k * 1024); } while (0)
#define PG8_MMA(ai, bj, At, Bt) do { __builtin_amdgcn_s_setprio(1); _Pragma("unroll") for (int m = 0; m < 4; ++m) _Pragma("unroll") for (int n = 0; n < 2; ++n) _Pragma("unroll") for (int k = 0; k < 2; ++k) \
        acc[ai][bj][m][n] = __builtin_amdgcn_mfma_f32_16x16x32_bf16(Bt[n][k], At[m][k], acc[ai][bj][m][n], 0, 0, 0); __builtin_amdgcn_s_setprio(0); } while (0)
#define PG8_WAIT_V(n) asm volatile("s_waitcnt vmcnt(" #n ")" ::: "memory")
#define PG8_WAIT_L(n) asm volatile("s_waitcnt lgkmcnt(" #n ")" ::: "memory")
#define PG8_BAR __builtin_amdgcn_s_barrier()
#define PG8_SCHED __builtin_amdgcn_sched_barrier(0)
    Unit cur, nxt; int ui = 0;
    if (!S.next(0, cur)) return;
    const float* rs_g = E.row_scale(); const float* cs_g = E.col_scale(); const bool rs_any = (rs_g != nullptr) || (cs_g != nullptr);
#define PG8_RS(uu, par) do { if (rs_any && wid < 4) __builtin_amdgcn_global_load_lds((const unsigned*)((rs_g != nullptr ? rs_g + (uu).pm * BM : cs_g + (uu).pn * BM) + wid * 64 + lane), (LAS unsigned*)(lds + RING_BYTES + 4096 + (par) * 1024 + wid * 256), 4, 0, 0); } while (0)
    PG8_RS(cur, 0);
    f32x4 acc[2][2][4][2];
#pragma unroll
    for (int a = 0; a < 2; ++a)
#pragma unroll
        for (int b = 0; b < 2; ++b)
#pragma unroll
            for (int m = 0; m < 4; ++m)
#pragma unroll
                for (int n = 0; n < 2; ++n) acc[a][b][m][n] = (f32x4){0.f, 0.f, 0.f, 0.f};
    bf16x8 At[4][2], B0[2][2], B1[2][2];
    const char* cA = cur.a; const char* cB = cur.b;
    PG8_STAGE(PG8_SB(0, 0), cB, voffB); PG8_STAGE(PG8_SB(0, 1), cB + hstepB, voffB); PG8_STAGE(PG8_SA(0, 0), cA, voffA); PG8_STAGE(PG8_SA(0, 1), cA + hstepA, voffA);
    if (wr == 1) PG8_BAR;
    PG8_WAIT_V(2); PG8_BAR;
    PG8_STAGE(PG8_SB(1, 0), cB + kstep, voffB); PG8_STAGE(PG8_SA(1, 0), cA + kstep, voffA); PG8_STAGE(PG8_SB(1, 1), cB + hstepB + kstep, voffB);
    PG8_WAIT_V(6); PG8_BAR;
    for (;;) {
        const bool has_next = S.next(ui + 1, nxt);
        const char* nA = has_next ? nxt.a : cA; const char* nB = has_next ? nxt.b : cB;
        for (int t = 0; t < nt; t += 2) {
            const bool last = (t == nt - 2);
            const char* a1 = cA + (size_t)(t + 1) * kstep;
            const char* a2 = last ? nA : cA + (size_t)(t + 2) * kstep; const char* b2 = last ? nB : cB + (size_t)(t + 2) * kstep;
            const char* a3 = a2 + kstep; const char* b3 = b2 + kstep;
            PG8_LDB(B0, 0, 0); PG8_LDB(B1, 0, 1); PG8_SCHED; PG8_LDA(At, 0, 0); PG8_STAGE(PG8_SA(1, 1), a1 + hstepA, voffA);
            PG8_WAIT_V(8); PG8_WAIT_L(0); PG8_BAR; PG8_MMA(0, 0, At, B0); PG8_MMA(0, 1, At, B1); PG8_BAR; PG8_SCHED;
            PG8_LDA(At, 0, 1); PG8_STAGE(PG8_SB(0, 0), b2, voffB); PG8_STAGE(PG8_SB(0, 1), b2 + hstepB, voffB); PG8_STAGE(PG8_SA(0, 0), a2, voffA);
            PG8_WAIT_V(8); PG8_WAIT_L(0); PG8_BAR; PG8_MMA(1, 0, At, B0); PG8_MMA(1, 1, At, B1); PG8_BAR; PG8_SCHED;
            PG8_LDB(B0, 1, 0); PG8_LDB(B1, 1, 1); PG8_SCHED; PG8_LDA(At, 1, 0); PG8_STAGE(PG8_SA(0, 1), a2 + hstepA, voffA);
            PG8_WAIT_V(8); PG8_WAIT_L(0); PG8_BAR; PG8_MMA(0, 0, At, B0); PG8_MMA(0, 1, At, B1); PG8_BAR; PG8_SCHED;
            PG8_LDA(At, 1, 1); PG8_STAGE(PG8_SB(1, 0), b3, voffB); PG8_STAGE(PG8_SB(1, 1), b3 + hstepB, voffB); PG8_STAGE(PG8_SA(1, 0), a3, voffA);
            PG8_WAIT_V(8); PG8_WAIT_L(0); PG8_BAR; PG8_MMA(1, 0, At, B0); PG8_MMA(1, 1, At, B1); PG8_BAR; PG8_SCHED;
        }
        if (wr == 0) PG8_BAR;
        { int fr_ = fr, fq_ = fq; asm volatile("" : "+v"(fr_), "+v"(fq_));
          E(acc, cur, wr, wc, fr_, fq_, (const LAS float*)(lds + RING_BYTES + 4096 + (ui & 1) * 1024)); }
        if (!has_next) break;
        PG8_RS(nxt, (ui + 1) & 1);
        if (!Epi::CHAIN || nxt.aux == 0)
#pragma unroll
        for (int a = 0; a < 2; ++a)
#pragma unroll
            for (int b = 0; b < 2; ++b)
#pragma unroll
                for (int m = 0; m < 4; ++m)
#pragma unroll
                    for (int n = 0; n < 2; ++n) acc[a][b][m][n] = (f32x4){0.f, 0.f, 0.f, 0.f};
        cur = nxt; cA = nA; cB = nB; ++ui;
        if (wr == 1) PG8_BAR;
    }
    PG8_WAIT_V(0);
    PG8_BAR;
#undef PG8_RS
#undef PG8_SA
#undef PG8_SB
#undef PG8_STAGE
#undef PG8_LDA
#undef PG8_LDB
#undef PG8_MMA
#undef PG8_WAIT_V
#undef PG8_WAIT_L
#undef PG8_BAR
#undef PG8_SCHED
}
}

#define XB_TMO      128
#define XB_XCNT(j)  (256  + 64 * (j))
#define XB_XSUB(j)  (1280 + 64 * (j))
#define XB_XGEN(j)  (2304 + 64 * (j))
#define XB_TOP      3328
#define XB_TOPGEN   3392
#define XCD_BAR_WORDS 3456
#define XB_SPIN_CAP (1u << 18)
__device__ __forceinline__ unsigned xb_ld(unsigned* p)              { return __hip_atomic_load(p, __ATOMIC_RELAXED, __HIP_MEMORY_SCOPE_AGENT); }
__device__ __forceinline__ unsigned xb_add(unsigned* p, unsigned v) { return __hip_atomic_fetch_add(p, v, __ATOMIC_RELAXED, __HIP_MEMORY_SCOPE_AGENT); }
__device__ __forceinline__ unsigned xb_xcc_id() { return (unsigned)__builtin_amdgcn_s_getreg((3 << 11) | 20) & 0xFu; }
#define XB_SPIN(cond, bar) do { unsigned _sp = 0; while (cond) { __builtin_amdgcn_s_sleep(1); \
    if ((++_sp & 255u) == 0u) { if (xb_ld(&(bar)[XB_TMO])) break; if (_sp > XB_SPIN_CAP) { atomicAdd(&(bar)[XB_TMO], 1u); break; } } } } while (0)
struct XcdBarrier { unsigned* bar; unsigned x; volatile LAS unsigned* st; };
__device__ __forceinline__ XcdBarrier xcd_barrier_post(unsigned* bar, volatile LAS unsigned* st) {
    XcdBarrier b; b.bar = bar; b.x = xb_xcc_id(); b.st = st;
    if (threadIdx.x == 0) (void)xb_add(&bar[XB_XCNT(b.x)], 1u);
    return b;
}
__device__ __forceinline__ void xcd_barrier_complete(unsigned* bar, unsigned x, unsigned& nloc, unsigned& nx) {
    const unsigned G = gridDim.x * gridDim.y * gridDim.z;
    unsigned sum, cnt, mine, sp = 0u;
    for (;;) {
        sum = 0u; cnt = 0u; mine = 0u;
#pragma unroll
        for (unsigned j = 0; j < 16; ++j) { const unsigned c = xb_ld(&bar[XB_XCNT(j)]); sum += c; cnt += (c > 0u) ? 1u : 0u; mine = (j == x) ? c : mine; }
        if (sum == G) break;
        __builtin_amdgcn_s_sleep(1);
        if ((++sp & 255u) == 0u) { if (xb_ld(&bar[XB_TMO])) break; if (sp > XB_SPIN_CAP) { atomicAdd(&bar[XB_TMO], 1u); break; } }
    }
    nloc = mine > 0u ? mine : 1u; nx = cnt > 0u ? cnt : 1u;
}
__device__ __forceinline__ void xcd_barrier(const XcdBarrier& b, const bool is_t0) {
    asm volatile("s_waitcnt vmcnt(0)" ::: "memory");
    __syncthreads();
    if (is_t0) {
        unsigned* bar = b.bar;
        __builtin_amdgcn_s_waitcnt(0);
        unsigned nloc = b.st[0], nx = b.st[1];
        if (nloc == 0u) { xcd_barrier_complete(bar, b.x, nloc, nx); b.st[0] = nloc; b.st[1] = nx; }
        const unsigned old = xb_add(&bar[XB_XSUB(b.x)], 1u);
        const unsigned gen = old / nloc;
        if (old + 1u == (gen + 1u) * nloc) {
            __builtin_amdgcn_fence(__ATOMIC_RELEASE, "agent");
            asm volatile("s_waitcnt vmcnt(0)" ::: "memory");
            const unsigned og = xb_add(&bar[XB_TOP], 1u);
            const unsigned tg = og / nx;
            if (og + 1u == (tg + 1u) * nx) xb_add(&bar[XB_TOPGEN], 1u);
            else XB_SPIN(xb_ld(&bar[XB_TOPGEN]) == tg, bar);
            __builtin_amdgcn_fence(__ATOMIC_ACQUIRE, "agent");
            xb_add(&bar[XB_XGEN(b.x)], 1u);
            asm volatile("s_waitcnt vmcnt(0)" ::: "memory");
        } else {
            XB_SPIN(xb_ld(&bar[XB_XGEN(b.x)]) == gen, bar);
            __builtin_amdgcn_fence(__ATOMIC_ACQUIRE, "agent");
            asm volatile("s_waitcnt vmcnt(0)" ::: "memory");
        }
    }
    __syncthreads();
}

struct Args { const float* in[18]; float* out; unsigned char* ws; int ph_lo, ph_hi; };
enum { I_X = 0, I_MEM, I_NORMG, I_WGU, I_WDOWN, I_WIN, I_CONVW, I_CONVB, I_BI, I_BF, I_MNORM, I_SLNG, I_SLNB, I_SWS, I_SBS, I_WMKV, I_WBR, I_WOUT };

struct CvtItem { const float* W; bf16* WT; int gsel, Nsrc, K, srccol, dstrow, kb; };
__device__ __forceinline__ void cvt_load(const CvtItem& d, int lane, f32x4 (&x)[8]) {
    const int c4 = (lane & 7) * 4, rr = lane >> 3, k0 = 64 * d.kb;
#pragma unroll
    for (int i = 0; i < 8; ++i) { const int kk = 8 * i + rr; x[i] = *(const f32x4*)(d.W + (size_t)(k0 + kk) * d.Nsrc + d.srccol + c4); }
}
__device__ __forceinline__ void cvt_finish(const CvtItem& d, int lane, const f32x4 (&x)[8], LAS float* scr, LAS unsigned char* lds) {
    const int c4 = (lane & 7) * 4, rr = lane >> 3, k0 = 64 * d.kb;
    const LAS float* gl = (const LAS float*)(lds + (d.gsel < 0 ? 0 : d.gsel) * 16384 + 8448);
#pragma unroll
    for (int i = 0; i < 8; ++i) { const int kk = 8 * i + rr; const float g = d.gsel < 0 ? 1.f : gl[k0 + kk]; const f32x4 v = x[i] * g; LAS float* p = scr + kk * 33 + c4; p[0] = v.x; p[1] = v.y; p[2] = v.z; p[3] = v.w; }
    LDS_WAIT(); asm volatile("" ::: "memory");
    const int c = lane & 7;
#pragma unroll
    for (int j = 0; j < 4; ++j) { const int n = (lane >> 3) + 8 * j; const LAS float* s = scr + (8 * c) * 33 + n;
        u32x4 o; o.x = pk2(s[0 * 33], s[1 * 33]); o.y = pk2(s[2 * 33], s[3 * 33]); o.z = pk2(s[4 * 33], s[5 * 33]); o.w = pk2(s[6 * 33], s[7 * 33]);
        *(u32x4*)(d.WT + (size_t)(d.dstrow + n) * d.K + k0 + 8 * c) = o; }
    LDS_WAIT(); asm volatile("" ::: "memory");
}
__device__ __forceinline__ int win_srccol(int r) {
    if (r < 1024) return r;
    if (r < 2048) return 2048 + (r - 1024);
    if (r < 3072) return 3080 + (r - 2048);
    if (r < 4096) return 5128 + (r - 3072);
    if (r < 7168) return 6152 + (r - 4096);
    if (r < 8192) return 1024 + (r - 7168);
    return 4104 + (r - 8192);
}
__device__ __forceinline__ void cvt_item_of(const Args& a, const int l, bf16* Wb, const int it, CvtItem& d) {
    constexpr int I_GU = 16 * 176, I_DN = 44 * 32, I_IN = 16 * 288, I_MKV = 16 * 64, I_BR = 16 * 32;
    int r = it; d.gsel = -1;
    if (r < 2 * I_GU) { const int j = r / I_GU; r -= j * I_GU; const int kb = r / 176, nb = r % 176; const int p = nb >> 3, q = nb & 7, s_ = q >> 2, jj = (q & 3) * 32;
        d.W = a.in[I_WGU] + (size_t)(l * 2 + j) * D * 2 * DFF; d.Nsrc = 2 * DFF; d.K = D; d.srccol = s_ * DFF + 128 * p + jj; d.WT = (bf16*)((char*)Wb + (j ? WO_GU1 : WO_GU0)); d.dstrow = nb * 32; d.kb = kb;
        d.gsel = j; return; }
    r -= 2 * I_GU;
    if (r < 2 * I_DN) { const int j = r / I_DN; r -= j * I_DN; d.W = a.in[I_WDOWN] + (size_t)(l * 2 + j) * DFF * D; d.Nsrc = D; d.K = DFF; d.srccol = (r % 32) * 32; d.WT = (bf16*)((char*)Wb + (j ? WO_D1 : WO_D0)); d.dstrow = (r % 32) * 32; d.kb = r / 32; return; }
    r -= 2 * I_DN;
    if (r < I_IN) { const int kb = r / 288, nb = r % 288; d.W = a.in[I_WIN] + (size_t)l * D * WIN_COLS; d.Nsrc = WIN_COLS; d.K = D; d.srccol = win_srccol(nb * 32); d.WT = (bf16*)((char*)Wb + WO_IN); d.dstrow = nb * 32; d.kb = kb;
        d.gsel = 2; return; }
    r -= I_IN;
    if (r < I_MKV) { d.W = a.in[I_WMKV] + (size_t)l * D * 2048; d.Nsrc = 2048; d.K = D; d.srccol = (r % 64) * 32; d.WT = (bf16*)((char*)Wb + WO_MKV); d.dstrow = (r % 64) * 32; d.kb = r / 64; return; }
    r -= I_MKV;
    if (r < 3 * I_BR) { const int j = r / I_BR; r -= j * I_BR; d.W = a.in[I_WBR] + (size_t)(l * 3 + j) * D * D; d.Nsrc = D; d.K = D; d.srccol = (r % 32) * 32; d.WT = (bf16*)((char*)Wb + WO_BR) + (size_t)j * D * D; d.dstrow = (r % 32) * 32; d.kb = r / 32; return; }
    r -= 3 * I_BR;
    d.W = a.in[I_WOUT] + (size_t)l * D * D; d.Nsrc = D; d.K = D; d.srccol = (r % 32) * 32; d.WT = (bf16*)((char*)Wb + WO_OUT); d.dstrow = (r % 32) * 32; d.kb = r / 32;
}
__device__ __forceinline__ void convert_layer(const Args& a, int l, unsigned char* ws, LAS unsigned char* lds, int gw, int NGW, int wave, int lane, int gtid, int GT) {
    LAS float* scr = (LAS float*)(lds + wave * 16384);
    bf16* Wb = (bf16*)(ws + WS_W);
    constexpr int I_GU = 16 * 176, I_DN = 44 * 32, I_IN = 16 * 288, I_MKV = 16 * 64, I_BR = 16 * 32, I_OUT = 16 * 32;
    constexpr int NITEMS = 2 * I_GU + 2 * I_DN + I_IN + I_MKV + 3 * I_BR + I_OUT;
    {
        const int tid_ = wave * 64 + lane;
        for (int e = tid_; e < 3 * D; e += NTHR) { const int j = e >> 10, k = e & 1023; ((LAS float*)(lds + j * 16384 + 8448))[k] = a.in[I_NORMG][(size_t)(l * NNORM + (j == 0 ? 0 : j == 1 ? 4 : 2)) * D + k]; }
        __syncthreads();
    }
    {
        int it = gw; f32x4 xc[8]; CvtItem dc;
        if (it < NITEMS) { cvt_item_of(a, l, Wb, it, dc); cvt_load(dc, lane, xc); }
        for (; it < NITEMS; it += NGW) {
            f32x4 xn[8]; CvtItem dn = dc; const bool more = it + NGW < NITEMS;
            if (more) { cvt_item_of(a, l, Wb, it + NGW, dn); cvt_load(dn, lane, xn); }
            cvt_finish(dc, lane, xc, scr, lds);
            if (more) { dc = dn;
#pragma unroll
                for (int i = 0; i < 8; ++i) xc[i] = xn[i]; }
        }
    }
    { const float* win = a.in[I_WIN] + (size_t)l * D * WIN_COLS; const float* g2 = a.in[I_NORMG] + (size_t)(l * NNORM + 2) * D; float* wt = (float*)(ws + WS_WIF);
      for (int e = gtid; e < 8 * D; e += GT) { const int k = e >> 3, c = e & 7; wt[c * D + k] = win[(size_t)k * WIN_COLS + 3072 + c] * g2[k]; } }
    bf16* wsg = (bf16*)(ws + WS_WSGU); const float* src = a.in[I_SWS] + (size_t)l * 4 * 128 * 128;
    for (int e = gtid; e < 4 * 128 * 128; e += GT) { const int t = (e >> 7) & 127, s = e & 127; wsg[e] = (bf16)f2bf(s <= t ? src[e] : 0.f); }
    const float* g6 = a.in[I_NORMG] + (size_t)(l * NNORM + 6) * D;
    for (int m = gw; m < MMEM; m += NGW) {
        const f32x4* xr = (const f32x4*)(a.in[I_MEM] + (size_t)m * D) + lane; f32x4 v[4]; float s = 0.f;
#pragma unroll
        for (int j = 0; j < 4; ++j) { v[j] = xr[64 * j]; s += (v[j].x * v[j].x + v[j].y * v[j].y) + (v[j].z * v[j].z + v[j].w * v[j].w); }
        const float rstd = rsqrtf(wave_sum(s, lane) * (1.f / D) + EPS);
        unsigned long long* o8 = (unsigned long long*)((bf16*)(ws + WS_MEMN) + (size_t)m * D) + lane;
#pragma unroll
        for (int j = 0; j < 4; ++j) { const f32x4 gg = ((const f32x4*)g6)[lane + 64 * j];
            o8[64 * j] = (unsigned long long)pk2(v[j].x * rstd * gg.x, v[j].y * rstd * gg.y) | ((unsigned long long)pk2(v[j].z * rstd * gg.z, v[j].w * rstd * gg.w) << 32); }
    }
}

__device__ __forceinline__ void thin_rows(const bf16* fbase, size_t fld, const float* ga, float scale, const float* hin32, const bf16* hinb, bf16* hb_out, float* rstd_out, float* out32,
                                          int row_lo, int row_hi, int gw, int NGW, int lane, const bool do_gates, const LAS float* wif, const float* bi, const float* bfg, float* gate_i, float* gate_f) {
    f32x4 hn32[4]; unsigned long long hnb[4], fn[4];
    f32x4 gq[4];
#pragma unroll
    for (int j = 0; j < 4; ++j) gq[j] = fbase ? ((const f32x4*)ga)[lane + 64 * j] : (f32x4){0.f, 0.f, 0.f, 0.f};
    const float gbias = do_gates ? ((lane < 4) ? bi[lane] : (lane < 8) ? bfg[lane - 4] : 0.f) : 0.f;
    int m = row_lo + gw;
    if (m < row_hi) {
        if (hin32) { const f32x4* hr = (const f32x4*)(hin32 + (size_t)m * D) + lane;
#pragma unroll
            for (int j = 0; j < 4; ++j) hn32[j] = hr[64 * j]; }
        else { const unsigned long long* hr = (const unsigned long long*)(hinb + (size_t)m * D) + lane;
#pragma unroll
            for (int j = 0; j < 4; ++j) hnb[j] = hr[64 * j]; }
        if (fbase) { const unsigned long long* fr = (const unsigned long long*)(fbase + (size_t)(m - row_lo) * fld) + lane;
#pragma unroll
            for (int j = 0; j < 4; ++j) fn[j] = fr[64 * j]; }
    }
    for (; m < row_hi; m += NGW) {
        f32x4 v[4]; unsigned long long fc[4];
        if (hin32) {
#pragma unroll
            for (int j = 0; j < 4; ++j) v[j] = hn32[j]; }
        else {
#pragma unroll
            for (int j = 0; j < 4; ++j) { const unsigned long long w = hnb[j]; const unsigned lo = (unsigned)w, hi = (unsigned)(w >> 32); v[j] = (f32x4){bflo(lo), bfhi(lo), bflo(hi), bfhi(hi)}; } }
#pragma unroll
        for (int j = 0; j < 4; ++j) fc[j] = fn[j];
        const int mn = m + NGW;
        if (mn < row_hi) {
            if (hin32) { const f32x4* hr = (const f32x4*)(hin32 + (size_t)mn * D) + lane;
#pragma unroll
                for (int j = 0; j < 4; ++j) hn32[j] = hr[64 * j]; }
            else { const unsigned long long* hr = (const unsigned long long*)(hinb + (size_t)mn * D) + lane;
#pragma unroll
                for (int j = 0; j < 4; ++j) hnb[j] = hr[64 * j]; }
            if (fbase) { const unsigned long long* fr = (const unsigned long long*)(fbase + (size_t)(mn - row_lo) * fld) + lane;
#pragma unroll
                for (int j = 0; j < 4; ++j) fn[j] = fr[64 * j]; }
        }
        if (fbase) {
            float s = 0.f; f32x4 f[4];
#pragma unroll
            for (int j = 0; j < 4; ++j) { const unsigned long long w = fc[j]; const unsigned lo = (unsigned)w, hi = (unsigned)(w >> 32);
                f[j] = (f32x4){bflo(lo), bfhi(lo), bflo(hi), bfhi(hi)}; s += (f[j].x * f[j].x + f[j].y * f[j].y) + (f[j].z * f[j].z + f[j].w * f[j].w); }
            const float rstd = rsqrtf(wave_sum(s, lane) * (1.f / D) + EPS) * scale;
#pragma unroll
            for (int j = 0; j < 4; ++j) v[j] = v[j] + f[j] * rstd * gq[j];
        }
        if (out32) { f32x4* ho = (f32x4*)(out32 + (size_t)m * D) + lane;
#pragma unroll
            for (int j = 0; j < 4; ++j) ho[64 * j] = v[j]; }
        if (hb_out) {
            float s = 0.f;
#pragma unroll
            for (int j = 0; j < 4; ++j) s += (v[j].x * v[j].x + v[j].y * v[j].y) + (v[j].z * v[j].z + v[j].w * v[j].w);
            const float rstd = rsqrtf(wave_sum(s, lane) * (1.f / D) + EPS);
            unsigned long long* o8 = (unsigned long long*)(hb_out + (size_t)m * D) + lane;
#pragma unroll
            for (int j = 0; j < 4; ++j) o8[64 * j] = (unsigned long long)pk2(v[j].x, v[j].y) | ((unsigned long long)pk2(v[j].z, v[j].w) << 32);
            if (lane == 0) rstd_out[m] = rstd;
            if (do_gates) {
                float acc[8];
#pragma unroll
                for (int e = 0; e < 8; ++e) acc[e] = 0.f;
#pragma unroll
                for (int j = 0; j < 4; ++j) { const unsigned h01 = pk2(v[j].x, v[j].y), h23 = pk2(v[j].z, v[j].w);
#pragma unroll
                    for (int e = 0; e < 8; ++e) { const u32x2 w2 = *(const LAS u32x2*)((const LAS bf16*)wif + e * D + 4 * lane + 256 * j); acc[e] = dot2_bf16(w2.y, h23, dot2_bf16(w2.x, h01, acc[e])); } }
                {
                    float b4[4], b2[2], b1;
#pragma unroll
                    for (int e = 0; e < 4; ++e) { const float mine = (lane & 4) ? acc[4 + e] : acc[e], send = (lane & 4) ? acc[e] : acc[4 + e]; b4[e] = mine + dppf<DPP_HMIR>(send); }
#pragma unroll
                    for (int e = 0; e < 2; ++e) { const float mine = (lane & 2) ? b4[2 + e] : b4[e], send = (lane & 2) ? b4[e] : b4[2 + e]; b2[e] = mine + dppf<DPP_XOR2>(send); }
                    { const float mine = (lane & 1) ? b2[1] : b2[0], send = (lane & 1) ? b2[0] : b2[1]; b1 = mine + dppf<DPP_XOR1>(send); }
                    b1 += shx(b1, 8, lane); b1 += shx(b1, 16, lane); b1 += shx(b1, 32, lane);
                    const float val = b1 * rstd;
                    if (lane < 4) gate_i[(size_t)m * 4 + lane] = val + gbias;
                    else if (lane < 8) gate_f[(size_t)m * 4 + lane - 4] = logsigmoidf_(val + gbias);
                }
            }
        }
    }
}

__device__ __forceinline__ void conv8(const bf16* Zb, int bl, int p, int col, const float* cw, const float* cb, float (&o)[8]) {
    const f32x4 b0 = *(const f32x4*)(cb + col), b1 = *(const f32x4*)(cb + col + 4);
    o[0] = b0.x; o[1] = b0.y; o[2] = b0.z; o[3] = b0.w; o[4] = b1.x; o[5] = b1.y; o[6] = b1.z; o[7] = b1.w;
#pragma unroll
    for (int j = 0; j < 4; ++j) { const int pp = p - 3 + j;
        if (pp >= 0) { const u32x4 x = *(const u32x4*)(Zb + (size_t)(bl * SEQ + pp) * ZLD + ZC_QK + col);
            const f32x4 w0 = *(const f32x4*)(cw + j * 1024 + col), w1 = *(const f32x4*)(cw + j * 1024 + col + 4);
            o[0] += w0.x * bflo(x.x); o[1] += w0.y * bfhi(x.x); o[2] += w0.z * bflo(x.y); o[3] += w0.w * bfhi(x.y);
            o[4] += w1.x * bflo(x.z); o[5] += w1.y * bfhi(x.z); o[6] += w1.z * bflo(x.w); o[7] += w1.w * bfhi(x.w); } }
#pragma unroll
    for (int e = 0; e < 8; ++e) o[e] = siluf_(o[e]);
}
__device__ __forceinline__ float wave_incl_scan_add(float v, int lane) {
#pragma unroll
    for (int o = 1; o < 64; o <<= 1) { const float t = shidx(v, lane >= o ? lane - o : lane); if (lane >= o) v += t; }
    return v;
}
__device__ __forceinline__ float wave_incl_scan_max(float v, int lane) {
#pragma unroll
    for (int o = 1; o < 64; o <<= 1) { const float t = shidx(v, lane >= o ? lane - o : lane); if (lane >= o) v = fmaxf(v, t); }
    return v;
}
__device__ __forceinline__ float wave_max(float v, int lane) { v = row16_max(v); v = fmaxf(v, shx(v, 16, lane)); v = fmaxf(v, shx(v, 32, lane)); return v; }
constexpr float KSCALE = 0.08838834764831845f;

__device__ __forceinline__ void conv_load(const bf16* Zb, int bl, int p, int col, u32x4 (&raw)[4]) {
#pragma unroll
    for (int j = 0; j < 4; ++j) { const int pp = p - 3 + j, pc = pp < 0 ? 0 : pp;
        const u32x4 v = *(const u32x4*)(Zb + (size_t)(bl * SEQ + pc) * ZLD + ZC_QK + col); const unsigned keep = pp >= 0 ? 0xFFFFFFFFu : 0u;
        raw[j] = (u32x4){v.x & keep, v.y & keep, v.z & keep, v.w & keep}; }
}
__device__ __forceinline__ void conv_apply(const u32x4 (&raw)[4], const LAS float* wl, const int wstride, float (&o)[8]) {
    { const f32x4 b0 = *(const LAS f32x4*)(wl + 4 * wstride), b1 = *(const LAS f32x4*)(wl + 4 * wstride + 4);
      o[0] = b0.x; o[1] = b0.y; o[2] = b0.z; o[3] = b0.w; o[4] = b1.x; o[5] = b1.y; o[6] = b1.z; o[7] = b1.w; }
#pragma unroll
    for (int j = 0; j < 4; ++j) { const u32x4 x = raw[j];
        const f32x4 w0 = *(const LAS f32x4*)(wl + j * wstride), w1 = *(const LAS f32x4*)(wl + j * wstride + 4);
        o[0] += w0.x * bflo(x.x); o[1] += w0.y * bfhi(x.x); o[2] += w0.z * bflo(x.y); o[3] += w0.w * bfhi(x.y);
        o[4] += w1.x * bflo(x.z); o[5] += w1.y * bfhi(x.z); o[6] += w1.z * bflo(x.w); o[7] += w1.w * bfhi(x.w); }
#pragma unroll
    for (int e = 0; e < 8; ++e) o[e] = siluf_(o[e]);
}
__device__ __forceinline__ void stage_convw(LAS float* wl, const float* cw, const float* cb, int col0, int ncol, int dst0, int wstride, int tid) {
    for (int e = tid; e < 5 * ncol; e += NTHR) { const int j = e / ncol, cidx = e - j * ncol; wl[j * wstride + dst0 + cidx] = (j < 4) ? cw[j * 1024 + col0 + cidx] : cb[col0 + cidx]; }
}
__device__ __forceinline__ void mlstm_s1(const Args& a, int l, int hf, unsigned char* ws, LAS unsigned char* lds, int G, int cu, int tid, int wave, int lane) {
    const bf16* Zb = (const bf16*)(ws + WS_Z); const bf16* ZT = (const bf16*)(ws + WS_ZT);
    const float* gi = (const float*)(ws + WS_GATE); const float* gf = gi + (size_t)M * 4;
    const float* cw = a.in[I_CONVW] + (size_t)l * 4 * 1024; const float* cb = a.in[I_CONVB] + (size_t)l * 1024;
    LAS bf16* KT = (LAS bf16*)lds;
    LAS float* wv = (LAS float*)(lds + 18432);
    LAS float* CWL = (LAS float*)(lds + 18944);
    LAS bf16* SL = (LAS bf16*)(lds + 21504);
    const int c8 = tid & 15, r = lane & 31, hh = lane >> 5, v0 = 32 * wave; int hcur = -1;
    bf16x8 bfr[4]; u32x4 raw[2][4];
#define S1_LOAD(UU, BF, RW) do { const int h_ = (UU) & 3, c_ = ((UU) >> 2) & 63, bl_ = (UU) >> 8; \
        const bf16* vrow_ = ZT + (size_t)(h_ * 256 + v0 + r) * ZTLD + bl_ * SEQ + c_ * LCH + 8 * hh; \
        _Pragma("unroll") for (int ks = 0; ks < 4; ++ks) BF[ks] = *(const bf16x8*)(vrow_ + 16 * ks); \
        _Pragma("unroll") for (int rep = 0; rep < 2; ++rep) conv_load(Zb, bl_, c_ * LCH + ((tid + rep * NTHR) >> 4), 512 + h_ * 128 + c8 * 8, RW[rep]); } while (0)
#define S1_GATES(UU, BUF) do { const int h_ = (UU) & 3, c_ = ((UU) >> 2) & 63, bl_ = (UU) >> 8, bhl_ = bl_ * 4 + h_; const int tokg_ = (hf * 4 + bl_) * SEQ + c_ * LCH; \
        const float lf = gf[(size_t)(tokg_ + lane) * 4 + h_], ii = gi[(size_t)(tokg_ + lane) * 4 + h_]; \
        const float bc = wave_incl_scan_add(lf, lane); const float g = shidx(bc, 63); const float av = g - bc + ii; const float ml = wave_max(av, lane); \
        wv[(BUF) * 64 + lane] = __expf(av - ml); \
        if (lane == 0) { float* cs = (float*)(ws + WS_CSC) + (size_t)(bhl_ * NCH + c_) * 4; cs[0] = g; cs[1] = ml; } } while (0)
    int u = cu, cur = 0;
    if (u < 16 * NCH) { S1_LOAD(u, bfr, raw); if (wave == 7) S1_GATES(u, 0); }
    for (; u < 16 * NCH; u += G) {
        const int h = u & 3, c = (u >> 2) & 63, bl = u >> 8, bhl = bl * 4 + h;
        if (h != hcur) { __syncthreads(); stage_convw(CWL, cw, cb, 512 + h * 128, 128, 0, 128, tid); hcur = h; }
        __syncthreads();
#pragma unroll
        for (int rep = 0; rep < 2; ++rep) { const int idx = tid + rep * NTHR, s = idx >> 4; float o[8];
            conv_apply(raw[rep], CWL + c8 * 8, 128, o); const float sc = wv[cur * 64 + s] * KSCALE;
            { u32x4 w; w.x = pk2(o[0] * KSCALE, o[1] * KSCALE); w.y = pk2(o[2] * KSCALE, o[3] * KSCALE); w.z = pk2(o[4] * KSCALE, o[5] * KSCALE); w.w = pk2(o[6] * KSCALE, o[7] * KSCALE);
              *(u32x4*)((bf16*)(ws + WS_KC) + (size_t)(bl * SEQ + c * LCH + s) * 512 + h * 128 + c8 * 8) = w; }
#pragma unroll
            for (int e = 0; e < 8; ++e) KT[(c8 * 8 + e) * 72 + ((((s >> 3) ^ (c8 & 7)) << 3) | (s & 7))] = (bf16)f2bf(o[e] * sc); }
        __syncthreads();
        const int un = u + G; const bool hasn = un < 16 * NCH;
        bf16x8 bfrN[4]; u32x4 rawN[2][4];
        if (hasn) { S1_LOAD(un, bfrN, rawN); if (wave == 7) S1_GATES(un, cur ^ 1); }
        {
            const int d = tid >> 2, p = tid & 3; const u32x4 a0 = *(const LAS u32x4*)(KT + d * 72 + 16 * p), a1 = *(const LAS u32x4*)(KT + d * 72 + 16 * p + 8);
            float s = ((bflo(a0.x) + bfhi(a0.x)) + (bflo(a0.y) + bfhi(a0.y))) + ((bflo(a0.z) + bfhi(a0.z)) + (bflo(a0.w) + bfhi(a0.w)))
                    + ((bflo(a1.x) + bfhi(a1.x)) + (bflo(a1.y) + bfhi(a1.y))) + ((bflo(a1.z) + bfhi(a1.z)) + (bflo(a1.w) + bfhi(a1.w)));
            s += dppf<DPP_XOR1>(s); s += dppf<DPP_XOR2>(s);
            if (p == 0) ((float*)(ws + WS_NST))[(size_t)(bhl * NCH + c) * 128 + d] = s; }
        {
            unsigned char* st = ws + WS_ST + (size_t)(bhl * NCH + c) * 32768;
#pragma unroll
            for (int db = 0; db < 4; ++db) { f32x16 acc;
#pragma unroll
                for (int e = 0; e < 16; ++e) acc[e] = 0.f;
#pragma unroll
                for (int ks = 0; ks < 4; ++ks) { const bf16x8 af = *(const LAS bf16x8*)(KT + (32 * db + r) * 72 + (((2 * ks + hh) ^ ((4 * db + (r >> 3)) & 7)) << 3)); acc = __builtin_amdgcn_mfma_f32_32x32x16_bf16(af, bfr[ks], acc, 0, 0, 0); }
#pragma unroll
                for (int q = 0; q < 4; ++q) *(unsigned*)(st + (((wave * 8 + 2 * db + (q >> 1)) * 64 + (q & 1) * 32 + r) << 3) + 4 * hh) = pk4_fp8(acc[4 * q], acc[4 * q + 1], acc[4 * q + 2], acc[4 * q + 3]); }
            __syncthreads();
        }
        if (hasn) {
#pragma unroll
            for (int ks = 0; ks < 4; ++ks) bfr[ks] = bfrN[ks];
#pragma unroll
            for (int rep = 0; rep < 2; ++rep)
#pragma unroll
                for (int j = 0; j < 4; ++j) raw[rep][j] = rawN[rep][j]; }
        cur ^= 1;
    }
#undef S1_LOAD
#undef S1_GATES
    __syncthreads();
}
constexpr int S2B = 16;
__device__ __forceinline__ void mlstm_s2(unsigned char* ws, int G, int cu, int tid) {
    for (int u = cu; u < 256; u += G) {
        const int bhl = u >> 4, part = u & 15; const size_t off = (size_t)(part * NTHR + tid) * 4;
        unsigned char* st = ws + WS_ST + (size_t)bhl * NCH * 32768 + off; float* ns = (float*)(ws + WS_NST) + (size_t)bhl * NCH * 128 + (tid & 127); float* cs = (float*)(ws + WS_CSC) + (size_t)bhl * NCH * 4;
        const bool nth = (part == 0 && tid < 128);
        float C[4]; float nv = 0.f, m = -1e30f;
#pragma unroll
        for (int e = 0; e < 4; ++e) C[e] = 0.f;
        for (int c0 = 0; c0 < NCH; c0 += S2B) {
            unsigned cl[S2B]; float nl[S2B], gg[S2B], ml[S2B];
#pragma unroll
            for (int i = 0; i < S2B; ++i) { cl[i] = *(const unsigned*)(st + (size_t)(c0 + i) * 32768); nl[i] = ns[(c0 + i) * 128]; gg[i] = cs[(c0 + i) * 4]; ml[i] = cs[(c0 + i) * 4 + 1]; }
#pragma unroll
            for (int i = 0; i < S2B; ++i) {
                *(unsigned*)(st + (size_t)(c0 + i) * 32768) = pk4_fp8(C[0], C[1], C[2], C[3]);
                if (nth) ns[(c0 + i) * 128] = nv;
                if (part == 0 && tid == 0) cs[(c0 + i) * 4 + 2] = m;
                const float mn = fmaxf(gg[i] + m, ml[i]); const float dec = __expf(gg[i] + m - mn), sc = __expf(ml[i] - mn);
                { const f32x2_t l01 = fp8lo2(cl[i]), l23 = fp8hi2(cl[i]); C[0] = dec * C[0] + sc * l01.x; C[1] = dec * C[1] + sc * l01.y; C[2] = dec * C[2] + sc * l23.x; C[3] = dec * C[3] + sc * l23.y; }
                nv = dec * nv + sc * nl[i]; m = mn;
            }
        }
    }
}
__device__ __forceinline__ void mlstm_s3(const Args& a, int l, int hf, unsigned char* ws, LAS unsigned char* lds, int G, int cu, int tid, int wave, int lane, const int out_col) {
    bf16* Zb = (bf16*)(ws + WS_Z); const bf16* ZT = (const bf16*)(ws + WS_ZT);
    const float* gi = (const float*)(ws + WS_GATE); const float* gf = gi + (size_t)M * 4;
    const float* cw = a.in[I_CONVW] + (size_t)l * 4 * 1024; const float* cb = a.in[I_CONVB] + (size_t)l * 1024;
    const float* gain = a.in[I_MNORM] + (size_t)l * 1024;
    LAS bf16* QS = (LAS bf16*)lds;
    LAS bf16* KS = (LAS bf16*)(lds + 17408);
    LAS bf16* SD = (LAS bf16*)(lds + 34816);
    LAS float* HB = (LAS float*)(lds + 44032);
    LAS float* SCB = (LAS float*)(lds + 110592);
    LAS float* CWL = (LAS float*)(lds + 114176);
    LAS float* GNL = (LAS float*)(lds + 119296);
    const int c8 = tid & 15, r = lane & 31, hh = lane >> 5, v0 = 32 * wave; int hcur = -1;
    u32x4 kt[2], rawq[2][4];
#define S3_LOAD_B(UU, BV, BC) do { const int h_ = (UU) & 3, c_ = ((UU) >> 2) & 63, bl_ = (UU) >> 8, bhl_ = bl_ * 4 + h_; const int tokl_ = bl_ * SEQ + c_ * LCH; \
        const bf16* vrow_ = ZT + (size_t)(h_ * 256 + v0 + r) * ZTLD + tokl_ + 8 * hh; \
        const unsigned char* crow_ = ws + WS_ST + (size_t)(bhl_ * NCH + c_) * 32768 + (size_t)((wave * 8 * 64 + hh * 32 + r) << 3);     \
        _Pragma("unroll") for (int ks = 0; ks < 4; ++ks) BV[ks] = *(const bf16x8*)(vrow_ + 16 * ks); \
        _Pragma("unroll") for (int ks = 0; ks < 8; ++ks) BC[ks] = *(const u32x2*)(crow_ + 512 * ks); \
        } while (0)
#define S3_LOAD_OG(OG) do { const unsigned char* og_ = (const unsigned char*)(Zb + (size_t)(tokl + (tid >> 3)) * ZLD + ZC_O) + h * 512 + 32 * (tid & 7); OG[0] = *(const u32x4*)og_; OG[1] = *(const u32x4*)(og_ + 16); } while (0)
#define S3_LOAD_A(UU, KT_, RW) do { const int h_ = (UU) & 3, c_ = ((UU) >> 2) & 63, bl_ = (UU) >> 8; const int tokl_ = bl_ * SEQ + c_ * LCH; \
        _Pragma("unroll") for (int rep = 0; rep < 2; ++rep) { const int t_ = (tid + rep * NTHR) >> 4; KT_[rep] = *(const u32x4*)((const bf16*)(ws + WS_KC) + (size_t)(tokl_ + t_) * 512 + h_ * 128 + c8 * 8); \
            conv_load(Zb, bl_, c_ * LCH + t_, h_ * 128 + c8 * 8, RW[rep]); } } while (0)
#define S3_SCAL_LD(UU, S0, S1, S2) do { const int h_ = (UU) & 3, c_ = ((UU) >> 2) & 63, bl_ = (UU) >> 8, bhl_ = bl_ * 4 + h_; const int tokg_ = (hf * 4 + bl_) * SEQ + c_ * LCH; \
        if (wave == 7) { S0 = gf[(size_t)(tokg_ + lane) * 4 + h_]; S1 = gi[(size_t)(tokg_ + lane) * 4 + h_]; S2 = ((const float*)(ws + WS_CSC))[(size_t)(bhl_ * NCH + c_) * 4 + 2]; } \
        else if (wave == 5 || wave == 6) { const int d_ = (wave - 5) * 64 + lane; S0 = ((const float*)(ws + WS_NST))[(size_t)(bhl_ * NCH + c_) * 128 + d_]; } } while (0)
#define S3_SCAL_DO(BUF, S0, S1, S2) do { LAS float* SC_ = SCB + (BUF) * 448; \
        if (wave == 7) { const float lf = S0, ii = S1, mst = S2; \
            const float bc = wave_incl_scan_add(lf, lane); const float rr = ii - bc; const float cm = wave_incl_scan_max(rr, lane); const float Mt = fmaxf(mst, cm); \
            SC_[lane] = rr; SC_[64 + lane] = Mt; SC_[128 + lane] = __expf(mst - Mt); SC_[192 + lane] = __expf(-(bc + Mt)); } \
        else if (wave == 5 || wave == 6) { const int d_ = (wave - 5) * 64 + lane; SC_[320 + d_] = S0; } } while (0)
    int u = cu, cur = 0; float sc0 = 0.f, sc1 = 0.f, sc2 = 0.f;
    if (u < 16 * NCH) { S3_LOAD_A(u, kt, rawq); S3_SCAL_LD(u, sc0, sc1, sc2); S3_SCAL_DO(0, sc0, sc1, sc2); }
    for (; u < 16 * NCH; u += G) {
        const int h = u & 3, c = (u >> 2) & 63, bl = u >> 8; const int tokl = bl * SEQ + c * LCH;
        LAS float* SC = SCB + cur * 448;
        if (h != hcur) { __syncthreads(); stage_convw(CWL, cw, cb, h * 128, 128, 0, 256, tid); if (tid < 256) GNL[tid] = gain[h * 256 + tid]; hcur = h; __syncthreads(); }
        bf16x8 bV[4]; u32x2 bC[8];
        S3_LOAD_B(u, bV, bC);
        const int un = u + G; const bool hasn = un < 16 * NCH;
        if (hasn) S3_SCAL_LD(un, sc0, sc1, sc2);
#pragma unroll
        for (int rep = 0; rep < 2; ++rep) { const int idx = tid + rep * NTHR, t = idx >> 4; float o[8];
            conv_apply(rawq[rep], CWL + c8 * 8, 256, o);
            u32x4 w; w.x = pk2(o[0], o[1]); w.y = pk2(o[2], o[3]); w.z = pk2(o[4], o[5]); w.w = pk2(o[6], o[7]);
            *(LAS u32x4*)(QS + t * 136 + c8 * 8) = w;
            *(LAS u32x4*)(KS + t * 136 + c8 * 8) = kt[rep]; }
        __syncthreads();
        u32x4 ktN[2], rawN[2][4];
        if (hasn) S3_LOAD_A(un, ktN, rawN);
        {
            const int tb = wave >> 1, fr = lane & 15, fq = lane >> 4;
#pragma unroll
            for (int i = 0; i < 2; ++i) { const int sblk = (wave & 1) * 2 + i; f32x4 acc = (f32x4){0.f, 0.f, 0.f, 0.f};
                if (sblk <= tb) {
#pragma unroll
                    for (int ks = 0; ks < 4; ++ks) { const bf16x8 af = *(const LAS bf16x8*)(QS + (16 * tb + fr) * 136 + 32 * ks + 8 * fq), bfv = *(const LAS bf16x8*)(KS + (16 * sblk + fr) * 136 + 32 * ks + 8 * fq);
                        acc = __builtin_amdgcn_mfma_f32_16x16x32_bf16(af, bfv, acc, 0, 0, 0); } }
                const int s_ = 16 * sblk + fr; const float rs_ = SC[s_];
#pragma unroll
                for (int e = 0; e < 4; ++e) { const int t = 16 * tb + 4 * fq + e; const float val = (s_ <= t) ? acc[e] * __expf(rs_ - SC[64 + t]) : 0.f; SD[t * 72 + s_] = (bf16)f2bf(val); } }
        }
        f32x16 aQ0, aQ1, aS0, aS1;
#pragma unroll
        for (int e = 0; e < 16; ++e) { aQ0[e] = 0.f; aQ1[e] = 0.f; aS0[e] = 0.f; aS1[e] = 0.f; }
#pragma unroll
        for (int ks = 0; ks < 8; ++ks) {
            const bf16x8 a0 = *(const LAS bf16x8*)(QS + r * 136 + 16 * ks + 8 * hh), a1 = *(const LAS bf16x8*)(QS + (32 + r) * 136 + 16 * ks + 8 * hh);
            const f32x2_t c01 = fp8lo2(bC[ks].x), c23 = fp8hi2(bC[ks].x), c45 = fp8lo2(bC[ks].y), c67 = fp8hi2(bC[ks].y);
            u32x4 cw; cw.x = pk2(c01.x, c01.y); cw.y = pk2(c23.x, c23.y); cw.z = pk2(c45.x, c45.y); cw.w = pk2(c67.x, c67.y); const bf16x8 cb = __builtin_bit_cast(bf16x8, cw);
            aQ0 = __builtin_amdgcn_mfma_f32_32x32x16_bf16(a0, cb, aQ0, 0, 0, 0); aQ1 = __builtin_amdgcn_mfma_f32_32x32x16_bf16(a1, cb, aQ1, 0, 0, 0); }
        __syncthreads();
        {
            const int t = tid >> 3, p = tid & 7; float ds = 0.f, qn = 0.f;
#pragma unroll
            for (int k = 0; k < 8; ++k) ds += bf1(SD[t * 72 + 8 * p + k]);
#pragma unroll
            for (int k = 0; k < 16; ++k) qn += bf1(QS[t * 136 + 16 * p + k]) * SC[320 + 16 * p + k];
            float den = ds + SC[128 + t] * qn;
            den = grp8_sum(den);
            if (p == 0) SC[256 + t] = 1.f / fmaxf(fabsf(den), SC[192 + t]);
        }
#pragma unroll
        for (int ks = 0; ks < 4; ++ks) {
            const bf16x8 a0 = *(const LAS bf16x8*)(SD + r * 72 + 16 * ks + 8 * hh), a1 = *(const LAS bf16x8*)(SD + (32 + r) * 72 + 16 * ks + 8 * hh);
            aS0 = __builtin_amdgcn_mfma_f32_32x32x16_bf16(a0, bV[ks], aS0, 0, 0, 0); aS1 = __builtin_amdgcn_mfma_f32_32x32x16_bf16(a1, bV[ks], aS1, 0, 0, 0); }
        __syncthreads();
        u32x4 ogr[2]; S3_LOAD_OG(ogr);
        if (hasn) S3_SCAL_DO(cur ^ 1, sc0, sc1, sc2);
#pragma unroll
        for (int e = 0; e < 16; ++e) { const int t0 = (e & 3) + 8 * (e >> 2) + 4 * hh;
            HB[t0 * 260 + v0 + r] = (aS0[e] + SC[128 + t0] * aQ0[e]) * SC[256 + t0]; HB[(32 + t0) * 260 + v0 + r] = (aS1[e] + SC[128 + 32 + t0] * aQ1[e]) * SC[256 + 32 + t0]; }
        __syncthreads();
        {
            const int t = tid >> 3, p = tid & 7; f32x4 x[8]; float sm = 0.f;
#pragma unroll
            for (int k = 0; k < 8; ++k) { x[k] = *(const LAS f32x4*)(HB + t * 260 + 32 * p + 4 * k); sm += (x[k].x + x[k].y) + (x[k].z + x[k].w); }
            sm = grp8_sum(sm);
            const float mean = sm * (1.f / 256.f); float sq = 0.f;
#pragma unroll
            for (int k = 0; k < 8; ++k) { x[k] = x[k] - mean; sq += (x[k].x * x[k].x + x[k].y * x[k].y) + (x[k].z * x[k].z + x[k].w * x[k].w); }
            sq = grp8_sum(sq);
            const float rstd = rsqrtf(sq * (1.f / 256.f) + EPS);
            const LAS float* gp = GNL + 32 * p; bf16* op = Zb + (size_t)(tokl + t) * ZLD + out_col + h * 256 + 32 * p;
#pragma unroll
            for (int i = 0; i < 4; ++i) { const f32x4 g0 = *(const LAS f32x4*)(gp + 8 * i), g1 = *(const LAS f32x4*)(gp + 8 * i + 4); const f32x4 a = x[2 * i] * (rstd * (1.f / 255.f)) * g0, b = x[2 * i + 1] * (rstd * (1.f / 255.f)) * g1; u32x4 w;
                const unsigned oa = (i & 1) ? ogr[i >> 1].z : ogr[i >> 1].x, ob = (i & 1) ? ogr[i >> 1].w : ogr[i >> 1].y;
                w.x = pk2(a.x * (float)(oa & 255u), a.y * (float)((oa >> 8) & 255u)); w.y = pk2(a.z * (float)((oa >> 16) & 255u), a.w * (float)(oa >> 24));
                w.z = pk2(b.x * (float)(ob & 255u), b.y * (float)((ob >> 8) & 255u)); w.w = pk2(b.z * (float)((ob >> 16) & 255u), b.w * (float)(ob >> 24));
                *(u32x4*)(op + 8 * i) = w; }
        }
        if (hasn) {
#pragma unroll
            for (int rep = 0; rep < 2; ++rep) { kt[rep] = ktN[rep];
#pragma unroll
                for (int j = 0; j < 4; ++j) rawq[rep][j] = rawN[rep][j]; } }
        cur ^= 1;
    }
#undef S3_LOAD_A
#undef S3_LOAD_B
#undef S3_LOAD_OG
#undef S3_SCAL_LD
#undef S3_SCAL_DO
    __syncthreads();
}

__device__ __forceinline__ void sgu_phase(const Args& a, int l, unsigned char* ws, LAS unsigned char* lds, int G, int cu, int tid, int wave, int lane, const int out_col) {
    bf16* Zb = (bf16*)(ws + WS_Z); const bf16* ZT = (const bf16*)(ws + WS_ZT); const bf16* Wc = (const bf16*)(ws + WS_WSGU);
    const float* lng = a.in[I_SLNG] + (size_t)l * 1024; const float* lnb = a.in[I_SLNB] + (size_t)l * 1024; const float* bs = a.in[I_SBS] + (size_t)l * 4 * 128;
    LAS bf16* VT = (LAS bf16*)lds;
    LAS float* PS = (LAS float*)(lds + 69632);
    LAS float* ST = (LAS float*)(lds + 69632 + 8192);
    LAS bf16* WS_ = (LAS bf16*)(lds + 78848);
    LAS float* LGB = (LAS float*)(lds + 113664);
    const int c8 = tid & 15, dq = tid >> 4;
    int gcur = -1;
    u32x4 x[8];
    if (cu < 4 * 32 * 4) { const int g = cu & 3, cc = (cu >> 2) & 31, bl = cu >> 7;
#pragma unroll
        for (int rep = 0; rep < 8; ++rep) x[rep] = *(const u32x4*)(ZT + (size_t)(1024 + g * 256 + dq + 32 * rep) * ZTLD + bl * SEQ + cc * 128 + c8 * 8); }
    for (int u = cu; u < 4 * 32 * 4; u += G) {
        const int g = u & 3, cc = (u >> 2) & 31, bl = u >> 7; const int tokl = bl * SEQ + cc * 128;
        if (g != gcur) { __syncthreads();
#pragma unroll
            for (int rep = 0; rep < 4; ++rep) { const int idx = tid + rep * NTHR, t = idx >> 4; *(LAS u32x4*)(WS_ + t * 136 + c8 * 8) = *(const u32x4*)(Wc + (size_t)(g * 128 + t) * 128 + c8 * 8); }
            if (tid < 256) { LGB[tid] = lng[g * 256 + tid]; LGB[256 + tid] = lnb[g * 256 + tid]; }
            gcur = g; }
        {
            float sm[8], sq[8];
#pragma unroll
            for (int k = 0; k < 8; ++k) { sm[k] = 0.f; sq[k] = 0.f; }
#pragma unroll
            for (int rep = 0; rep < 8; ++rep) { const u32x4 v = x[rep]; const float f0 = bflo(v.x), f1 = bfhi(v.x), f2 = bflo(v.y), f3 = bfhi(v.y), f4 = bflo(v.z), f5 = bfhi(v.z), f6 = bflo(v.w), f7 = bfhi(v.w);
                sm[0] += f0; sq[0] += f0 * f0; sm[1] += f1; sq[1] += f1 * f1; sm[2] += f2; sq[2] += f2 * f2; sm[3] += f3; sq[3] += f3 * f3;
                sm[4] += f4; sq[4] += f4 * f4; sm[5] += f5; sq[5] += f5 * f5; sm[6] += f6; sq[6] += f6 * f6; sm[7] += f7; sq[7] += f7 * f7; }
#pragma unroll
            for (int k = 0; k < 8; ++k) { sm[k] += shx(sm[k], 16, lane); sq[k] += shx(sq[k], 16, lane); sm[k] += shx(sm[k], 32, lane); sq[k] += shx(sq[k], 32, lane); }
            if (lane < 16) {
#pragma unroll
                for (int k = 0; k < 8; ++k) { PS[(wave * 128 + c8 * 8 + k) * 2] = sm[k]; PS[(wave * 128 + c8 * 8 + k) * 2 + 1] = sq[k]; } }
        }
        __syncthreads();
        if (tid < 128) { float sm = 0.f, sq = 0.f;
#pragma unroll
            for (int p = 0; p < 8; ++p) { sm += PS[(p * 128 + tid) * 2]; sq += PS[(p * 128 + tid) * 2 + 1]; }
            const float mean = sm * (1.f / 256.f); const float var = fmaxf(sq * (1.f / 256.f) - mean * mean, 0.f); ST[tid] = mean; ST[128 + tid] = rsqrtf(var + EPS); }
        __syncthreads();
        { const LAS float* mp = ST + c8 * 8; const LAS float* rp = ST + 128 + c8 * 8; float mm[8], rr[8];
#pragma unroll
            for (int k = 0; k < 8; ++k) { mm[k] = mp[k]; rr[k] = rp[k]; }
#pragma unroll
            for (int rep = 0; rep < 8; ++rep) { const int d = dq + 32 * rep; const float gg = LGB[d], bb = LGB[256 + d]; u32x4 v = x[rep];
                v.x = pk2((bflo(v.x) - mm[0]) * rr[0] * gg + bb, (bfhi(v.x) - mm[1]) * rr[1] * gg + bb); v.y = pk2((bflo(v.y) - mm[2]) * rr[2] * gg + bb, (bfhi(v.y) - mm[3]) * rr[3] * gg + bb);
                v.z = pk2((bflo(v.z) - mm[4]) * rr[4] * gg + bb, (bfhi(v.z) - mm[5]) * rr[5] * gg + bb); v.w = pk2((bflo(v.w) - mm[6]) * rr[6] * gg + bb, (bfhi(v.w) - mm[7]) * rr[7] * gg + bb);
                *(LAS u32x4*)(VT + d * 136 + c8 * 8) = v; } }
        u32x4 uq[8];
#pragma unroll
        for (int i = 0; i < 8; ++i) { const int idx = tid + NTHR * i, t = idx >> 5, c = idx & 31; uq[i] = *(const u32x4*)(Zb + (size_t)(tokl + t) * ZLD + ZC_U + g * 256 + c * 8); }
        float bias[4];
#pragma unroll
        for (int tb = 0; tb < 4; ++tb) bias[tb] = bs[g * 128 + 32 * tb + (lane & 31)];
        if (u + G < 4 * 32 * 4) { const int un = u + G, gn = un & 3, ccn = (un >> 2) & 31, bln = un >> 7;
#pragma unroll
            for (int rep = 0; rep < 8; ++rep) x[rep] = *(const u32x4*)(ZT + (size_t)(1024 + gn * 256 + dq + 32 * rep) * ZTLD + bln * SEQ + ccn * 128 + c8 * 8); }
        __syncthreads();
        {
            const int r = lane & 31, hh = lane >> 5;
            f32x16 acc[4];
#pragma unroll
            for (int tb = 0; tb < 4; ++tb)
#pragma unroll
                for (int e = 0; e < 16; ++e) acc[tb][e] = 0.f;
            const int d0 = 32 * wave;
#pragma unroll
            for (int ks = 0; ks < 8; ++ks) { const bf16x8 af = *(const LAS bf16x8*)(VT + (d0 + r) * 136 + 16 * ks + 8 * hh);
#pragma unroll
                for (int tb = 0; tb < 4; ++tb) if (16 * ks <= 32 * tb + 31) { const bf16x8 bfv = *(const LAS bf16x8*)(WS_ + (32 * tb + r) * 136 + 16 * ks + 8 * hh);
                    acc[tb] = __builtin_amdgcn_mfma_f32_32x32x16_bf16(af, bfv, acc[tb], 0, 0, 0); } }
            __syncthreads();
            LAS unsigned char* MIX = lds;
#pragma unroll
            for (int tb = 0; tb < 4; ++tb) { const int t = 32 * tb + r;
#pragma unroll
                for (int q = 0; q < 4; ++q) { u32x2 w; w.x = pk2(acc[tb][4 * q] + bias[tb], acc[tb][4 * q + 1] + bias[tb]); w.y = pk2(acc[tb][4 * q + 2] + bias[tb], acc[tb][4 * q + 3] + bias[tb]);
                    *(LAS u32x2*)(MIX + t * 512 + (((4 * wave + q) ^ (t & 31)) << 4) + 8 * hh) = w; } }
            __syncthreads();
#pragma unroll
            for (int i = 0; i < 8; ++i) { const int idx = tid + NTHR * i, t = idx >> 5, c = idx & 31; const u32x4 m = *(const LAS u32x4*)(MIX + t * 512 + ((c ^ (t & 31)) << 4)); const u32x4 v = uq[i]; u32x4 w;
                w.x = pk2(bflo(v.x) * bflo(m.x), bfhi(v.x) * bfhi(m.x)); w.y = pk2(bflo(v.y) * bflo(m.y), bfhi(v.y) * bfhi(m.y));
                w.z = pk2(bflo(v.z) * bflo(m.z), bfhi(v.z) * bfhi(m.z)); w.w = pk2(bflo(v.w) * bflo(m.w), bfhi(v.w) * bfhi(m.w));
                *(u32x4*)(Zb + (size_t)(tokl + t) * ZLD + out_col + g * 256 + c * 8) = w; }
        }
        __syncthreads();
    }
}

__device__ __forceinline__ void xattn_phase(unsigned char* ws, int hf, LAS unsigned char* lds, int G, int cu, int tid, int wave, int lane) {
    bf16* Zb = (bf16*)(ws + WS_Z); const bf16* Kmem = (const bf16*)(ws + WS_KMEM); const bf16* Vt = (const bf16*)(ws + WS_VTMEM);
    const int r = lane & 31, hh = lane >> 5;
#define XA_BAR() do { asm volatile("s_waitcnt lgkmcnt(0)" ::: "memory"); __builtin_amdgcn_s_barrier(); asm volatile("" ::: "memory"); } while (0)
#define XA_DMA(SRC_ROW_PTR_EXPR, BUF) do { int tt = tid; asm volatile("" : "+v"(tt)); _Pragma("unroll") for (int rep = 0; rep < 8; ++rep) { const int idx = tt + NTHR * rep, row = idx >> 5, cs = (idx & 31) ^ (row & 31); \
        __builtin_amdgcn_global_load_lds((const unsigned*)(SRC_ROW_PTR_EXPR), (LAS unsigned*)(lds + (BUF) * 65536 + (wave * 64 + NTHR * rep) * 16), 16, 0, 0); } } while (0)
    for (int u = cu; u < 4 * 16 * 4; u += G) {
        const int h = u & 3, qt = (u >> 2) & 15, bl = u >> 6, bg = hf * 4 + bl;
        const bf16* qfrag = Zb + (size_t)(bl * SEQ + qt * 256 + wave * 32 + hh) * ZLD + ZC_XQ + h * 256 + 8 * r;
        const bf16* kb = Kmem + (size_t)(bg * MEMLEN) * D + h * 256; const bf16* vb = Vt + (size_t)(h * 256) * MMEM + bg * MEMLEN;
        bf16x8 q[16];
#pragma unroll
        for (int i = 0; i < 16; ++i) q[i] = *(const bf16x8*)(qfrag + (size_t)(2 * i) * ZLD);
        XA_DMA(kb + (size_t)row * D + cs * 8, 0);
#pragma unroll
        for (int i = 0; i < 16; ++i) asm volatile("" : "+v"(q[i]));
        asm volatile("s_waitcnt vmcnt(0)" ::: "memory");
        XA_BAR();
        XA_DMA(kb + (size_t)(128 + row) * D + cs * 8, 1);
        f32x16 acc[8];
#pragma unroll
        for (int mb = 0; mb < 8; ++mb)
#pragma unroll
            for (int e = 0; e < 16; ++e) acc[mb][e] = 0.f;
#pragma unroll
        for (int kh = 0; kh < 2; ++kh) {
            bf16x8 kf[4];
            { int rr = r; asm volatile("" : "+v"(rr)); const LAS unsigned char* kp = lds + kh * 65536 + rr * 512 + ((hh ^ rr) << 4);
#pragma unroll
              for (int mb = 0; mb < 4; ++mb) kf[mb] = *(const LAS bf16x8*)(kp + mb * 16384); }
#pragma unroll
            for (int ks = 0; ks < 16; ++ks) {
                int rr = r; asm volatile("" : "+v"(rr));
                const LAS unsigned char* kp = lds + kh * 65536 + rr * 512 + (((2 * (ks + 1) + hh) ^ rr) << 4);
#pragma unroll
                for (int mb = 0; mb < 4; ++mb) { acc[4 * kh + mb] = __builtin_amdgcn_mfma_f32_32x32x16_bf16(kf[mb], q[ks], acc[4 * kh + mb], 0, 0, 0);
                    if (ks + 1 < 16) kf[mb] = *(const LAS bf16x8*)(kp + mb * 16384); } }
            if (kh == 0) { asm volatile("s_waitcnt vmcnt(0)" ::: "memory"); XA_BAR();
                XA_DMA(vb + (size_t)row * MMEM + cs * 8, 0); }
            else { XA_BAR();
                XA_DMA(vb + (size_t)(128 + row) * MMEM + cs * 8, 1); }
        }
        float mx = acc[0][0];
#pragma unroll
        for (int mb = 0; mb < 8; ++mb)
#pragma unroll
            for (int e = 0; e < 16; ++e) mx = fmaxf(mx, acc[mb][e]);
        mx = fmaxf(mx, shx(mx, 32, lane));
        float sm = 0.f;
#pragma unroll
        for (int mb = 0; mb < 8; ++mb)
#pragma unroll
            for (int e = 0; e < 16; ++e) { acc[mb][e] = __expf(acc[mb][e] - mx); sm += acc[mb][e]; }
        sm += shx(sm, 32, lane);
        const float inv = __builtin_amdgcn_rcpf(sm);
        bf16x8 P[8][2];
#pragma unroll
        for (int mb = 0; mb < 8; ++mb)
#pragma unroll
            for (int s_ = 0; s_ < 2; ++s_) { u32x4 p; p.x = pk2(acc[mb][8 * s_] * inv, acc[mb][8 * s_ + 1] * inv); p.y = pk2(acc[mb][8 * s_ + 2] * inv, acc[mb][8 * s_ + 3] * inv);
                p.z = pk2(acc[mb][8 * s_ + 4] * inv, acc[mb][8 * s_ + 5] * inv); p.w = pk2(acc[mb][8 * s_ + 6] * inv, acc[mb][8 * s_ + 7] * inv); P[mb][s_] = __builtin_bit_cast(bf16x8, p); }
#pragma unroll
        for (int mb = 0; mb < 8; ++mb) { asm volatile("" : "+v"(P[mb][0])); asm volatile("" : "+v"(P[mb][1])); }
        asm volatile("s_waitcnt vmcnt(8)" ::: "memory"); XA_BAR();
#pragma unroll
        for (int dh = 0; dh < 2; ++dh) {
            f32x16 o[4];
#pragma unroll
            for (int db = 0; db < 4; ++db)
#pragma unroll
                for (int e = 0; e < 16; ++e) o[db][e] = 0.f;
            u32x4 vf[4];
#define XA_LDV1(ST, DB) do { const u32x2 lo = *(const LAS u32x2*)(vlo + (DB) * 16384), hi = *(const LAS u32x2*)(vhi + (DB) * 16384); vf[DB].x = lo.x; vf[DB].y = lo.y; vf[DB].z = hi.x; vf[DB].w = hi.y; } while (0)
            { int rr = r; asm volatile("" : "+v"(rr));
              const LAS unsigned char* vlo = lds + dh * 65536 + rr * 512 + 8 * hh + ((0 ^ rr) << 4); const LAS unsigned char* vhi = lds + dh * 65536 + rr * 512 + 8 * hh + ((1 ^ rr) << 4);
#pragma unroll
              for (int db = 0; db < 4; ++db) XA_LDV1(0, db); }
#pragma unroll
            for (int st = 0; st < 16; ++st) {
                int rr = r; asm volatile("" : "+v"(rr));
                const LAS unsigned char* vlo = lds + dh * 65536 + rr * 512 + 8 * hh + (((2 * (st + 1)) ^ rr) << 4); const LAS unsigned char* vhi = lds + dh * 65536 + rr * 512 + 8 * hh + (((2 * (st + 1) + 1) ^ rr) << 4);
#pragma unroll
                for (int db = 0; db < 4; ++db) { o[db] = __builtin_amdgcn_mfma_f32_32x32x16_bf16(__builtin_bit_cast(bf16x8, vf[db]), P[st >> 1][st & 1], o[db], 0, 0, 0);
                    if (st + 1 < 16) XA_LDV1(st + 1, db); } }
#undef XA_LDV1
            u32x2 wq[4][4];
#pragma unroll
            for (int db = 0; db < 4; ++db)
#pragma unroll
                for (int g = 0; g < 4; ++g) { wq[db][g].x = pk2(o[db][4 * g], o[db][4 * g + 1]); wq[db][g].y = pk2(o[db][4 * g + 2], o[db][4 * g + 3]); }
            if (dh == 0) { asm volatile("s_waitcnt vmcnt(0)" ::: "memory"); XA_BAR(); }
            {   int rr = r; asm volatile("" : "+v"(rr));
                LAS unsigned char* slot = lds + wave * 8192;
#pragma unroll
                for (int db = 0; db < 4; ++db)
#pragma unroll
                    for (int g = 0; g < 4; ++g) *(LAS u32x2*)(slot + rr * 256 + (((4 * db + g) ^ (rr & 15)) << 4) + 8 * hh) = wq[db][g];
                asm volatile("s_waitcnt lgkmcnt(0)" ::: "memory");
                const int c = lane & 15, r4 = lane >> 4;
                bf16* obase = Zb + (size_t)(bl * SEQ + qt * 256 + wave * 32) * ZLD + ZC_XQ + h * 256 + 128 * dh + 8 * c;
#pragma unroll
                for (int i = 0; i < 8; ++i) { const int row = r4 + 4 * i; const u32x4 v = *(const LAS u32x4*)(slot + row * 256 + ((c ^ (row & 15)) << 4)); *(u32x4*)(obase + (size_t)row * ZLD) = v; }
            }
        }
        XA_BAR();
    }
#undef XA_BAR
#undef XA_DMA
    asm volatile("s_waitcnt vmcnt(0)" ::: "memory");
    __syncthreads();
}

__device__ __forceinline__ void softmax_rows(unsigned char* ws, int gw, int NGW, int lane) {
    bf16* Zb = (bf16*)(ws + WS_Z);
    for (int m = gw; m < MH; m += NGW) {
        u32x4* p = (u32x4*)(Zb + (size_t)m * ZLD + ZC_XQ + 16 * lane); const u32x4 x0 = p[0], x1 = p[1];
        float v[16] = { bflo(x0.x), bfhi(x0.x), bflo(x0.y), bfhi(x0.y), bflo(x0.z), bfhi(x0.z), bflo(x0.w), bfhi(x0.w), bflo(x1.x), bfhi(x1.x), bflo(x1.y), bfhi(x1.y), bflo(x1.z), bfhi(x1.z), bflo(x1.w), bfhi(x1.w) };
        float mx = v[0];
#pragma unroll
        for (int e = 1; e < 16; ++e) mx = fmaxf(mx, v[e]);
#pragma unroll
        for (int o = 1; o < 16; o <<= 1) mx = fmaxf(mx, shx(mx, o, lane));
        float s = 0.f;
#pragma unroll
        for (int e = 0; e < 16; ++e) { v[e] = __expf(v[e] - mx); s += v[e]; }
#pragma unroll
        for (int o = 1; o < 16; o <<= 1) s += shx(s, o, lane);
        const float inv = 1.f / s;
        u32x4 y0, y1; y0.x = pk2(v[0] * inv, v[1] * inv); y0.y = pk2(v[2] * inv, v[3] * inv); y0.z = pk2(v[4] * inv, v[5] * inv); y0.w = pk2(v[6] * inv, v[7] * inv);
        y1.x = pk2(v[8] * inv, v[9] * inv); y1.y = pk2(v[10] * inv, v[11] * inv); y1.z = pk2(v[12] * inv, v[13] * inv); y1.w = pk2(v[14] * inv, v[15] * inv);
        p[0] = y0; p[1] = y1;
    }
}

__global__ void __launch_bounds__(NTHR, 2) trunk_fwd(Args args) {
    extern __shared__ __attribute__((aligned(16))) unsigned char lds_raw[];
    LAS unsigned char* lds = (LAS unsigned char*)lds_raw;
    volatile LAS unsigned* MISC = (volatile LAS unsigned*)(lds + MISC_OFF);
    const int G = gridDim.x, cu = blockIdx.x;
    unsigned char* ws = args.ws;
    const int wave_s = __builtin_amdgcn_readfirstlane((int)threadIdx.x >> 6);
#define LANE_ID() ({ int l__; asm volatile("v_mbcnt_lo_u32_b32 %0, -1, 0\n\tv_mbcnt_hi_u32_b32 %0, -1, %0" : "=v"(l__)); l__; })
#define PHASE_IDS() int tid = wave_s * 64 + LANE_ID(); asm volatile("" : "+v"(tid)); const int lane = tid & 63, wave = __builtin_amdgcn_readfirstlane(tid >> 6); \
    const int vcu = (G % 8 == 0) ? (cu % 8) * (G / 8) + cu / 8 : cu; const int gw = vcu * NWAVES + wave, NGW = G * NWAVES, gtid = cu * NTHR + tid, GT = G * NTHR; (void)gw; (void)NGW; (void)gtid; (void)GT; (void)lane
    for (int u = threadIdx.x; u < (LDS_BYTES - RING_BYTES) / 4; u += NTHR) ((LAS unsigned*)(lds + RING_BYTES))[u] = 0u;
    __syncthreads();
    XcdBarrier bar = xcd_barrier_post((unsigned*)(ws + WS_CTL) + 4096, MISC + 8);
    const int lo = args.ph_lo, hi = args.ph_hi;
    int ph = 0;
#define IN() (lo <= ph && ph < hi)
#define SEAM() do { if (lo <= ph && ph + 1 < hi) xcd_barrier(bar, wave_s == 0 && LANE_ID() == 0); ++ph; } while (0)
    bf16* XN = (bf16*)(ws + WS_XN); bf16* Wb = (bf16*)(ws + WS_W); float* RSTD = (float*)(ws + WS_RSTD);
    float* hbuf = args.out;

    if (IN()) { PHASE_IDS();
        convert_layer(args, 0, ws, lds, gw, NGW, wave, lane, gtid, GT);
        thin_rows(nullptr, 0, nullptr, 0.f, args.in[I_X], nullptr, XN, RSTD, nullptr, 0, M, gw, NGW, lane, false, nullptr, nullptr, nullptr, nullptr, nullptr);
        __syncthreads();
    }
    SEAM();

    for (int sb = 0; sb < 2 * DEPTH; ++sb) {
        const int l = sb >> 1, j = sb & 1;
        const float* ng = args.in[I_NORMG] + (size_t)l * NNORM * D;
        if (IN()) { PHASE_IDS();
            pg8::Gemm g{D, D, D}; pg8::TileSched S; S.init(M / 256, 2 * DFF / 256, G, cu, XN, D * 2, (char*)Wb + (j ? WO_GU1 : WO_GU0), D * 2);
            pg8::EpiGU E{(bf16*)(ws + WS_HID), RSTD};
            pg8::gemm_phase(lds, g, S, E, tid);
        }
        SEAM();
        if (IN()) { PHASE_IDS();
            pg8::Gemm g{DFF, DFF, DFF}; pg8::TileSched S; S.init(M / 256, D / 256, G, cu, ws + WS_HID, DFF * 2, (char*)Wb + (j ? WO_D1 : WO_D0), DFF * 2);
            pg8::EpiAct E{(bf16*)(ws + WS_F), (size_t)D, 0, nullptr, nullptr};
            pg8::gemm_phase(lds, g, S, E, tid);
        }
        SEAM();
        if (IN()) { PHASE_IDS();
            if (j == 0) {
                LAS float* wif = (LAS float*)lds;
                for (int e = tid; e < D * 8 / 2; e += NTHR) { const float* src = (const float*)(ws + WS_WIF) + 2 * e; ((LAS unsigned*)wif)[e] = pk2(src[0], src[1]); }
                __syncthreads();
                float* gi = (float*)(ws + WS_GATE);
                const float* hx = (sb == 0) ? args.in[I_X] : nullptr;
                if (G == 256) {
                    const bool kvcu = (cu < 32) || (cu >= 128 && cu < 160);
                    if (kvcu) { const int gwk = ((cu < 32) ? cu : cu - 96) * NWAVES + wave;
                        thin_rows((const bf16*)(ws + WS_F), D, ng + 1 * D, 0.5f, hx, XN, XN, RSTD, nullptr, 0, 3072, gwk, 512, lane, true, wif, args.in[I_BI] + l * 4, args.in[I_BF] + l * 4, gi, gi + (size_t)M * 4); }
                    else { const int cun = (cu < 128) ? cu - 32 : cu - 64; const int gwn = cun * NWAVES + wave;
                        thin_rows((const bf16*)(ws + WS_F) + (size_t)3072 * D, D, ng + 1 * D, 0.5f, hx, XN, XN, RSTD, nullptr, 3072, M, gwn, 1536, lane, true, wif, args.in[I_BI] + l * 4, args.in[I_BF] + l * 4, gi, gi + (size_t)M * 4); }
                } else
                thin_rows((const bf16*)(ws + WS_F), D, ng + 1 * D, 0.5f, hx, XN, XN, RSTD, nullptr, 0, M, gw, NGW, lane, true, wif, args.in[I_BI] + l * 4, args.in[I_BF] + l * 4, gi, gi + (size_t)M * 4);
                __syncthreads();
                {
                    pg8::Gemm g{D, D, D};
                    pg8::TileSched S; S.init(MMEM / 256, D / 256, G, cu, ws + WS_MEMN, D * 2, (char*)Wb + WO_MKV, D * 2);
                    pg8::EpiAct E{(bf16*)(ws + WS_KMEM), (size_t)D, 0, nullptr, nullptr};
                    pg8::gemm_phase(lds, g, S, E, tid);
                    pg8::TileSched S2; S2.init(D / 256, MMEM / 256, G, (cu + G / 2) % G, (char*)Wb + WO_MKV + (size_t)D * D * 2, D * 2, ws + WS_MEMN, D * 2);
                    pg8::EpiAct E2{(bf16*)(ws + WS_VTMEM), (size_t)MMEM, 0, nullptr, nullptr};
                    pg8::gemm_phase(lds, g, S2, E2, tid);
                }
            } else {
                const bool lastl = (l + 1 == DEPTH);
                thin_rows((const bf16*)(ws + WS_F), D, ng + 5 * D, 0.5f, nullptr, XN, lastl ? nullptr : XN, RSTD, lastl ? hbuf : nullptr, 0, M, gw, NGW, lane, false, nullptr, nullptr, nullptr, nullptr, nullptr);
                if (l + 1 < DEPTH) { __syncthreads(); convert_layer(args, l + 1, ws, lds, gw, NGW, wave, lane, gtid, GT); __syncthreads(); }
            }
        }
        SEAM();
        if (j == 0) {
            for (int hf = 0; hf < 2; ++hf) {
                bf16* Zb = (bf16*)(ws + WS_Z);
                if (IN()) { PHASE_IDS();
                    if (hf == 1) { thin_rows((const bf16*)(ws + WS_ST), D, ng + 3 * D, 1.0f, nullptr, XN, XN, RSTD, nullptr, 0, MH, gw, NGW, lane, false, nullptr, nullptr, nullptr, nullptr, nullptr); __syncthreads(); }
                    pg8::Gemm g{D, D, D};
                    pg8::TileSched S; S.init(MH / 256, ZLD / 256, G, cu, XN + (size_t)hf * MH * D, D * 2, (char*)Wb + WO_IN, D * 2);
                    pg8::EpiAct E{Zb, (size_t)ZLD, 1, RSTD + (size_t)hf * MH, nullptr};
                    pg8::gemm_phase(lds, g, S, E, tid);
                    pg8::TileSched S2; S2.init(2048 / 256, MH / 256, G, cu, (char*)Wb + WO_IN + (size_t)ZLD * D * 2, D * 2, XN + (size_t)hf * MH * D, D * 2);
                    pg8::EpiAct E2{(bf16*)(ws + WS_ZT), (size_t)ZTLD, 2, nullptr, RSTD + (size_t)hf * MH};
                    pg8::gemm_phase(lds, g, S2, E2, tid);
                }
                SEAM();
                if (IN()) { PHASE_IDS();
                    mlstm_s1(args, l, hf, ws, lds, G, cu, tid, wave, lane);
                    sgu_phase(args, l, ws, lds, G, cu, tid, wave, lane, ZC_U);
                    xattn_phase(ws, hf, lds, G, cu, tid, wave, lane);
                }
                SEAM();
                if (IN()) { PHASE_IDS();
                    mlstm_s2(ws, G, cu, tid);
                }
                SEAM();
                if (IN()) { PHASE_IDS();
                    mlstm_s3(args, l, hf, ws, lds, G, cu, tid, wave, lane, ZC_O);
#ifdef PROBE_S3
                    for (int rep_ = 0; rep_ < 2; ++rep_) mlstm_s3(args, l, hf, ws, lds, G, cu, tid, wave, lane, ZC_QK);
#endif
#ifdef PROBE_SGU
                    for (int rep_ = 0; rep_ < 2; ++rep_) sgu_phase(args, l, ws, lds, G, cu, tid, wave, lane, ZC_QK);
#endif
                }
                SEAM();
                if (IN()) { PHASE_IDS();
                    pg8::Gemm g{D, ZLD, D};
                    pg8::TileSched S; S.init(MH / 256, D / 256, G, cu, Zb + ZC_O, ZLD * 2, (char*)Wb + WO_BR, D * 2);
                    S.reps = 3; S.a_rep = 1024 * 2; S.b_rep = (size_t)D * D * 2;
                    pg8::EpiBranch E{Zb};
                    pg8::gemm_phase(lds, g, S, E, tid);
                }
                SEAM();
                if (IN()) { PHASE_IDS();
                    pg8::Gemm g{D, ZLD, D};
                    pg8::TileSched S; S.init(MH / 256, D / 256, G, cu, Zb + ZC_QK, ZLD * 2, (char*)Wb + WO_OUT, D * 2);
                    pg8::EpiAct E{(hf == 0) ? (bf16*)(ws + WS_ST) : Zb + ZC_O, (hf == 0) ? (size_t)D : (size_t)ZLD, 0, nullptr, nullptr};
                    pg8::gemm_phase(lds, g, S, E, tid);
                }
                SEAM();
                if (hf == 1) {
                if (IN()) { PHASE_IDS();
                    thin_rows(Zb + ZC_O, ZLD, ng + 3 * D, 1.0f, nullptr, XN, XN, RSTD, nullptr, hf * MH, (hf + 1) * MH, gw, NGW, lane, false, nullptr, nullptr, nullptr, nullptr, nullptr);
                }
                SEAM();
                }
            }
        }
    }
#undef IN
#undef SEAM
}
constexpr int N_PHASES = 1 + 2 * DEPTH * 3 + DEPTH * (2 * 7 - 1);

#ifndef N_LAUNCH_MODE
#define N_LAUNCH_MODE 0
#endif
extern "C" void kernel_launch(void* const* d_in, const int* in_sizes, int n_in, void* d_out, int out_size, void* d_ws, size_t ws_size, hipStream_t stream) {
    static int grid = 0;
    if (grid == 0) {
        if (n_in != 18 || out_size != M * D || ws_size < WS_END) { fprintf(stderr, "kernel_launch: unexpected shapes (n_in %d out %d ws %zu)\n", n_in, out_size, ws_size); grid = -1; return; }
        int dev = 0, cus = 0, per_cu = 0;
        if (hipGetDevice(&dev) != hipSuccess || hipDeviceGetAttribute(&cus, hipDeviceAttributeMultiprocessorCount, dev) != hipSuccess) { grid = -1; return; }
        if (hipFuncSetAttribute((const void*)trunk_fwd, hipFuncAttributeMaxDynamicSharedMemorySize, LDS_BYTES) != hipSuccess) { grid = -1; return; }
        if (hipOccupancyMaxActiveBlocksPerMultiprocessor(&per_cu, (const void*)trunk_fwd, NTHR, LDS_BYTES) != hipSuccess || per_cu < 1) { fprintf(stderr, "kernel_launch: occupancy query says %d\n", per_cu); }
        (void)hipGetLastError();
        grid = cus;
    }
    if (grid < 0) return;
    (void)hipMemsetAsync((char*)d_ws + WS_CTL, 0, CTL_ZERO_BYTES, stream);
    Args a{};
    for (int i = 0; i < 18; ++i) a.in[i] = (const float*)d_in[i];
    a.out = (float*)d_out; a.ws = (unsigned char*)d_ws;
#if N_LAUNCH_MODE == 0
    a.ph_lo = 0; a.ph_hi = N_PHASES;
    hipLaunchKernelGGL(trunk_fwd, dim3(grid), dim3(NTHR), LDS_BYTES, stream, a);
#else
    for (int p = 0; p < N_PHASES; ++p) { a.ph_lo = p; a.ph_hi = p + 1; hipLaunchKernelGGL(trunk_fwd, dim3(grid), dim3(NTHR), LDS_BYTES, stream, a); }
#endif
}
```
